# Optimizing an MI355X kernel written in HIP

```python
import jax, jax.numpy as jnp
from jax import lax
import numpy as np

D_MODEL = 1024
BATCH = 16
SEQ = 2048
DEPTH = 1

GRID_W = 64
CTX_LEN = 256

RET_HEADS = 4
RET_DK = 256
RET_DV = 512
RET_CHUNK = 128
RET_QK_W = RET_HEADS * RET_DK
RET_V_W = RET_HEADS * RET_DV

ATT_HEADS = 8
ATT_KV_HEADS = 2
ATT_HEAD_DIM = 128
ATT_Q_W = ATT_HEADS * ATT_HEAD_DIM
ATT_KV_W = ATT_KV_HEADS * ATT_HEAD_DIM
ROPE_THETA = 10000.0
Q_BLOCK = 128

NORM_EPS = 1e-6

IN_SPLITS = (RET_QK_W, RET_V_W, ATT_KV_W, ATT_KV_W,
             RET_QK_W, RET_V_W, ATT_Q_W, ATT_Q_W, D_MODEL, D_MODEL)
KV_COLS = RET_QK_W + RET_V_W + 2 * ATT_KV_W
IN_COLS = KV_COLS + RET_QK_W + RET_V_W + 2 * ATT_Q_W + 2 * D_MODEL

kernel_name = "hybrid_retention_gqa_prefix_dit_block"


def rms_norm(x, w=None):
    xf = x.astype(jnp.float32)
    y = xf * lax.rsqrt(jnp.mean(xf * xf, axis=-1, keepdims=True) + NORM_EPS)
    if w is not None:
        y = y * w.astype(jnp.float32)
    return y.astype(x.dtype)


def split_cols(p, widths):
    out, start = [], 0
    for w in widths:
        out.append(p[..., start:start + w])
        start += w
    return out


def adaln_params(cvec, w_ada, b_ada):
    mod = jax.nn.silu(cvec) @ w_ada + b_ada
    return split_cols(mod, (D_MODEL, D_MODEL, D_MODEL))


def axial_rope(L):
    rows = L // GRID_W
    row = jnp.repeat(jnp.arange(rows, dtype=jnp.float32), GRID_W)
    col = jnp.tile(jnp.arange(GRID_W, dtype=jnp.float32), rows)
    half = ATT_HEAD_DIM // 2
    freqs = ROPE_THETA ** (-jnp.arange(0, half, 2, dtype=jnp.float32) / half)
    ang = jnp.concatenate([row[:, None] * freqs, col[:, None] * freqs], axis=-1)
    return jnp.cos(ang), jnp.sin(ang)


def apply_rope(x, cos, sin):
    B, L, H, D = x.shape
    xp = x.astype(jnp.float32).reshape(B, L, H, D // 2, 2)
    x0, x1 = xp[..., 0], xp[..., 1]
    c, s = cos[None, :, None, :], sin[None, :, None, :]
    out = jnp.stack([x0 * c - x1 * s, x0 * s + x1 * c], axis=-1)
    return out.reshape(B, L, H, D).astype(x.dtype)


def ret_kv(k_flat, v_flat):
    B, L, _ = k_flat.shape
    k = k_flat.reshape(B, L, RET_HEADS, RET_DK) * (RET_DK ** -0.5)
    v = v_flat.reshape(B, L, RET_HEADS, RET_DV)
    return k, v


def retention_scan(q, k, v, log_gamma, s0):
    B, L, H, _ = q.shape
    n = L // RET_CHUNK

    def chunks(t):
        return t.astype(jnp.float32).reshape(B, n, RET_CHUNK, H, t.shape[-1]).transpose(1, 0, 3, 2, 4)

    qc, kc, vc = chunks(q), chunks(k), chunks(v)
    idx = jnp.arange(RET_CHUNK, dtype=jnp.float32)
    lg = log_gamma.astype(jnp.float32)[:, None]
    rel = idx[:, None] - idx[None, :]
    decay_mask = jnp.where(rel >= 0, jnp.exp(lg[:, :, None] * jnp.maximum(rel, 0.0)), 0.0)
    q_decay = jnp.exp(lg * (idx + 1.0))
    k_decay = jnp.exp(lg * (RET_CHUNK - 1.0 - idx))
    chunk_decay = jnp.exp(lg[:, 0] * RET_CHUNK)

    def step(s, inp):
        qi, ki, vi = inp
        scores = jnp.einsum('bhid,bhjd->bhij', qi, ki) * decay_mask
        intra = jnp.einsum('bhij,bhje->bhie', scores, vi)
        cross = jnp.einsum('bhid,bhde->bhie', qi * q_decay[..., None], s)
        s_new = s * chunk_decay[:, None, None] + jnp.einsum('bhjd,bhje->bhde', ki * k_decay[..., None], vi)
        return s_new, intra + cross

    _, out = lax.scan(step, s0.astype(jnp.float32), (qc, kc, vc))
    return out.transpose(1, 0, 3, 2, 4).reshape(B, L, H, v.shape[-1])


def ctx_final_states(k, v, log_gamma):
    L = k.shape[1]
    pos = jnp.arange(L, dtype=jnp.float32)
    w_f = jnp.exp(log_gamma[0][:, None] * (L - 1.0 - pos))
    w_b = jnp.exp(log_gamma[1][:, None] * pos)
    kf, vf = k.astype(jnp.float32), v.astype(jnp.float32)
    s_f = jnp.einsum('blhd,hl,blhe->bhde', kf, w_f, vf)
    s_b = jnp.einsum('blhd,hl,blhe->bhde', kf, w_b, vf)
    return s_f, s_b


def retention_branch(q_flat, k, v, gate_flat, log_gamma, states):
    B, L, _ = q_flat.shape
    q = q_flat.reshape(B, L, RET_HEADS, RET_DK)
    o_f = retention_scan(q, k, v, log_gamma[0], states[0])
    o_b = retention_scan(q[:, ::-1], k[:, ::-1], v[:, ::-1], log_gamma[1], states[1])[:, ::-1]
    o = rms_norm(o_f + o_b)
    return o.reshape(B, L, RET_V_W).astype(gate_flat.dtype) * jax.nn.silu(gate_flat)


def att_heads(t_flat, n_heads, norm_w, rope):
    B, L, _ = t_flat.shape
    t = rms_norm(t_flat.reshape(B, L, n_heads, ATT_HEAD_DIM), norm_w)
    if rope is not None:
        t = apply_rope(t, rope[0], rope[1])
    return t


def gqa_block_attention(q, k_all, v_all):
    B, S, Hq, D = q.shape
    nb = S // Q_BLOCK
    rep = Hq // ATT_KV_HEADS
    qb = q.reshape(B, nb, Q_BLOCK, ATT_KV_HEADS, rep, D).transpose(1, 0, 2, 3, 4, 5)
    scale = D ** -0.5

    def one_block(qi):
        s = jnp.einsum('bqgrd,bkgd->bgrqk', qi, k_all).astype(jnp.float32) * scale
        p = jax.nn.softmax(s, axis=-1)
        return jnp.einsum('bgrqk,bkgd->bqgrd', p.astype(v_all.dtype), v_all)

    o = lax.map(one_block, qb)
    return o.transpose(1, 0, 2, 3, 4, 5).reshape(B, S, Hq * D)


def merge_branches(y_ret, y_att, mg_ret, mg_att, w_o_ret, w_o_att, w_out):
    y = jax.nn.sigmoid(mg_ret) * (y_ret @ w_o_ret) + jax.nn.sigmoid(mg_att) * (y_att @ w_o_att)
    return y @ w_out


def trunk_layer(x, ctx, c, c_ctx, norm_w, w_ada, b_ada, w_in, ret_log2_decay,
                q_norm_w, k_norm_w, w_o_ret, w_o_att, w_out, update_ctx):
    B, S, _ = x.shape
    shift, scale, gate = adaln_params(c, w_ada, b_ada)
    shift_c, scale_c, gate_c = adaln_params(c_ctx, w_ada, b_ada)
    hx = rms_norm(x, norm_w) * (1 + scale[:, None]) + shift[:, None]
    hc = rms_norm(ctx, norm_w) * (1 + scale_c) + shift_c
    log_gamma = jnp.log1p(-jnp.exp2(ret_log2_decay.astype(jnp.float32)))

    px = hx @ w_in
    ret_k, ret_v, att_k, att_v, ret_q, ret_g, att_q, att_g, mg_ret, mg_att = split_cols(px, IN_SPLITS)
    pc = hc @ (w_in if update_ctx else w_in[:, :KV_COLS])
    c_ret_k, c_ret_v, c_att_k, c_att_v = split_cols(pc, IN_SPLITS[:4])

    kc, vc = ret_kv(c_ret_k, c_ret_v)
    ctx_states = ctx_final_states(kc, vc, log_gamma)
    kca = att_heads(c_att_k, ATT_KV_HEADS, k_norm_w, None)
    vca = c_att_v.reshape(B, CTX_LEN, ATT_KV_HEADS, ATT_HEAD_DIM)

    kx, vx = ret_kv(ret_k, ret_v)
    y_ret = retention_branch(ret_q, kx, vx, ret_g, log_gamma, ctx_states)

    rope = axial_rope(S)
    qxa = att_heads(att_q, ATT_HEADS, q_norm_w, rope)
    kxa = att_heads(att_k, ATT_KV_HEADS, k_norm_w, rope)
    vxa = att_v.reshape(B, S, ATT_KV_HEADS, ATT_HEAD_DIM)
    k_all = jnp.concatenate([kxa, kca], axis=1)
    v_all = jnp.concatenate([vxa, vca], axis=1)
    y_att = gqa_block_attention(qxa, k_all, v_all) * jax.nn.silu(att_g)

    out = merge_branches(y_ret, y_att, mg_ret, mg_att, w_o_ret, w_o_att, w_out)
    x_new = x + gate[:, None] * out

    if update_ctx:
        _, _, _, _, c_ret_q, c_ret_g, c_att_q, c_att_g, c_mg_ret, c_mg_att = split_cols(pc, IN_SPLITS)
        zero = jnp.zeros((B, RET_HEADS, RET_DK, RET_DV), jnp.float32)
        yc_ret = retention_branch(c_ret_q, kc, vc, c_ret_g, log_gamma, (zero, zero))
        qca = att_heads(c_att_q, ATT_HEADS, q_norm_w, None)
        yc_att = gqa_block_attention(qca, kca, vca) * jax.nn.silu(c_att_g)
        out_c = merge_branches(yc_ret, yc_att, c_mg_ret, c_mg_att, w_o_ret, w_o_att, w_out)
        ctx = ctx + gate_c * out_c
    return x_new, ctx


def setup_inputs(seed: int = 0) -> dict:
    key = jax.random.key(seed)
    ks = jax.random.split(key, 15)
    f32 = jnp.float32
    nrm = lambda k, shape: jax.random.normal(k, shape, f32)
    x = nrm(ks[0], (BATCH, SEQ, D_MODEL))
    c = nrm(ks[1], (BATCH, D_MODEL))
    ctx = nrm(ks[2], (BATCH, CTX_LEN, D_MODEL))
    c_ctx = nrm(ks[3], (D_MODEL,))
    norm_w = 1.0 + 0.02 * nrm(ks[4], (DEPTH, D_MODEL))
    w_ada = nrm(ks[5], (DEPTH, D_MODEL, 3 * D_MODEL)) * (0.5 * D_MODEL ** -0.5)
    b_ada = 0.02 * nrm(ks[6], (DEPTH, 3 * D_MODEL))
    w_in = nrm(ks[7], (DEPTH, D_MODEL, IN_COLS)) * (D_MODEL ** -0.5)
    base = -5.0 - jnp.arange(RET_HEADS, dtype=f32)
    ret_log2_decay = base[None, None, :] + 0.1 * nrm(ks[8], (DEPTH, 2, RET_HEADS))
    q_norm_w = 1.0 + 0.02 * nrm(ks[9], (DEPTH, ATT_HEAD_DIM))
    k_norm_w = 1.0 + 0.02 * nrm(ks[10], (DEPTH, ATT_HEAD_DIM))
    w_o_ret = nrm(ks[11], (DEPTH, RET_V_W, D_MODEL)) * (RET_V_W ** -0.5)
    w_o_att = nrm(ks[12], (DEPTH, ATT_Q_W, D_MODEL)) * (ATT_Q_W ** -0.5)
    w_out = nrm(ks[13], (DEPTH, D_MODEL, D_MODEL)) * (D_MODEL ** -0.5)
    return {"x": x, "c": c, "ctx": ctx, "c_ctx": c_ctx, "norm_w": norm_w,
            "w_ada": w_ada, "b_ada": b_ada, "w_in": w_in, "ret_log2_decay": ret_log2_decay,
            "q_norm_w": q_norm_w, "k_norm_w": k_norm_w, "w_o_ret": w_o_ret,
            "w_o_att": w_o_att, "w_out": w_out}


def reference(x, c, ctx, c_ctx, norm_w, w_ada, b_ada, w_in, ret_log2_decay,
              q_norm_w, k_norm_w, w_o_ret, w_o_att, w_out):
    for layer in range(DEPTH):
        x, ctx = trunk_layer(x, ctx, c, c_ctx, norm_w[layer], w_ada[layer], b_ada[layer],
                             w_in[layer], ret_log2_decay[layer], q_norm_w[layer], k_norm_w[layer],
                             w_o_ret[layer], w_o_att[layer], w_out[layer],
                             update_ctx=(layer < DEPTH - 1))
    return x
```

```cpp
#include <hip/hip_runtime.h>
#include <cstdio>
#include <cstdint>

constexpr int NB = 16, SEQ = 2048, DM = 1024, LC = 256, LT = LC + SEQ;
constexpr int MLAT = NB * SEQ, MCTX = NB * LC, MALL = MLAT + MCTX;
constexpr int RH = 4, RDK = 256, RDV = 512;
constexpr int AH = 8, AKV = 2, AHD = 128;
constexpr int NIN = 10752, NKV = 3584, N1 = 5632, NG = 5120;
constexpr float EPS = 1e-6f;

typedef unsigned short bf16_t;
typedef unsigned v4u __attribute__((ext_vector_type(4)));
typedef unsigned v2u __attribute__((ext_vector_type(2)));
typedef float v4f __attribute__((ext_vector_type(4)));
typedef float v2f __attribute__((ext_vector_type(2)));

__device__ __forceinline__ float bf2f(unsigned h) { return __uint_as_float(h << 16); }
__device__ __forceinline__ unsigned f2bf(float f) { unsigned u = __float_as_uint(f); return (u + 0x7fffu + ((u >> 16) & 1u)) >> 16; }
__device__ __forceinline__ unsigned pk2(float lo, float hi) { return f2bf(lo) | (f2bf(hi) << 16); }
__device__ __forceinline__ float bflo(unsigned w) { return __uint_as_float(w << 16); }
__device__ __forceinline__ float bfhi(unsigned w) { return __uint_as_float(w & 0xffff0000u); }
__device__ __forceinline__ float fast_sigmoid(float x) { return __builtin_amdgcn_rcpf(1.0f + __builtin_amdgcn_exp2f(-1.4426950408889634f * x)); }
__device__ __forceinline__ float fast_silu(float x) { return x * fast_sigmoid(x); }
__device__ __forceinline__ float wave_sum(float v) {
#pragma unroll
    for (int o = 1; o < 64; o <<= 1) v += __shfl_xor(v, o);
    return v;
}

typedef __bf16 bf16x2_t __attribute__((ext_vector_type(2)));
__device__ __forceinline__ unsigned cvt_pk_bf16(float lo, float hi) { v2f v = {lo, hi}; bf16x2_t b = __builtin_convertvector(v, bf16x2_t); return __builtin_bit_cast(unsigned, b); }
__device__ __forceinline__ void unpack8(const v4u w, float (&o)[8]) {
    o[0] = bflo(w.x); o[1] = bfhi(w.x); o[2] = bflo(w.y); o[3] = bfhi(w.y); o[4] = bflo(w.z); o[5] = bfhi(w.z); o[6] = bflo(w.w); o[7] = bfhi(w.w);
}
__device__ __forceinline__ v4u pack8(const float (&o)[8]) {
    v4u w; w.x = cvt_pk_bf16(o[0], o[1]); w.y = cvt_pk_bf16(o[2], o[3]); w.z = cvt_pk_bf16(o[4], o[5]); w.w = cvt_pk_bf16(o[6], o[7]); return w;
}

constexpr size_t MiB = 1u << 20;
constexpr size_t WS_CTL = 0;
constexpr size_t WS_MOD = 1 * MiB;
constexpr size_t WS_ROPE = WS_MOD + 256 * 1024;
constexpr size_t WS_SSQ = 2 * MiB;
constexpr size_t WS_WIN = 4 * MiB;
constexpr size_t WS_WOR = 25 * MiB;
constexpr size_t WS_WOA = 29 * MiB;
constexpr size_t WS_WOUT = 31 * MiB;
constexpr size_t WS_HX = 33 * MiB;
constexpr size_t WS_RK = 105 * MiB;
constexpr size_t WS_RV = 177 * MiB;
constexpr size_t WS_RQ = 321 * MiB;
constexpr size_t WS_AK = 385 * MiB;
constexpr size_t WS_AV = 403 * MiB;
constexpr size_t WS_AQ = 421 * MiB;
constexpr size_t WS_END = 485 * MiB;
constexpr size_t WS_U1 = WS_RK;
constexpr size_t WS_U2 = WS_RV;

__host__ __device__ __forceinline__ int orig_col(int n) { return n < 4608 ? n : (n < 5632 ? n + 2048 : (n < 7680 ? n - 1024 : n)); }
namespace pg8 {
#define PG8_LAS __attribute__((address_space(3)))
typedef unsigned short bf16_t;
typedef short bf16x8 __attribute__((ext_vector_type(8)));
typedef float f32x4 __attribute__((ext_vector_type(4)));
typedef unsigned u32x4 __attribute__((ext_vector_type(4)));
constexpr int BM = 256, BK = 64, HALF = 128, HTB = HALF * BK * 2  , STAGE_BYTES = 8 * HTB, NXCD = 8, WGM = 8;

__host__ __device__ __forceinline__ int lds_byte(int r, int c) { const int st = (r >> 4) * 2 + (c >> 5), rr = r & 15, cc = c & 31, ob = rr * 64 + cc * 2; return st * 1024 + (ob ^ (((ob >> 9) & 1) << 5)); }
__host__ __device__ __forceinline__ void stage_rc(int b, int& R, int& C) { const int st = b / 1024, sb = b % 1024, swz = sb ^ (((sb >> 9) & 1) << 5); R = (st >> 1) * 16 + swz / 64; C = (st & 1) * 32 + (swz % 64) / 2; }
__host__ __device__ __forceinline__ int perm32(int rho) { const int n = rho >> 4, i = rho & 15; return 8 * (i >> 2) + 4 * n + (i & 3); }

struct Unit { int pm, pn; };
struct Gemm { const bf16_t* A; const bf16_t* Bt; int M, N, K; };

struct StaticOrder {
    int nM, nN, nwg, G, c;
    __host__ __device__ void init(int M, int N, int G_, int c_) { nM = M / BM; nN = N / BM; nwg = nM * nN; G = G_; c = c_; }
    __host__ __device__ bool next(int i, Unit& u) const {
        const long L = (long)i * G + c; if (L >= nwg) return false;
        int wgid = (int)L; { const int q = nwg / NXCD, r = nwg % NXCD, xcd = wgid % NXCD, off = wgid / NXCD; wgid = (xcd < r ? xcd * (q + 1) : r * (q + 1) + (xcd - r) * q) + off; }
        const int nig = WGM * nN, gid = wgid / nig, fm = gid * WGM, gsz = (nM - fm) < WGM ? (nM - fm) : WGM;
        u.pm = fm + ((wgid % nig) % gsz); u.pn = (wgid % nig) / gsz; return true;
    }
    __device__ __forceinline__ void a_ready(const Unit&) const {}
    __device__ __forceinline__ void done(const Unit&) const {}
};


struct Sched1 {
    int G, c; StaticOrder so;
    __device__ void init(int G_, int c_) { G = G_; c = c_; so.init(MLAT, N1, G_, c_); }
    __device__ bool next(int i, Unit& u) const {
        long L = (long)i * G + c; if (L < 2816) return so.next(i, u);
        L -= 2816; if (L >= 224) return false;
        u.pm = 128 + (int)(L & 15); u.pn = (int)(L >> 4); return true;
    }
    __device__ __forceinline__ void a_ready(const Unit&) const {}
    __device__ __forceinline__ void done(const Unit&) const {}
};

#define EPI_ROWS_BEGIN const int rt0 = wr * 64 + fr, ct0 = wc * 32 + 8 * fq; \
    _Pragma("unroll") for (int ai = 0; ai < 2; ++ai) _Pragma("unroll") for (int m = 0; m < 4; ++m) { const int rt = rt0 + ai * HALF + m * 16;
#define EPI_ROWS_END }

struct Epi1 {
    static constexpr bool PERM = true, AFTER_DRAIN = false;
    bf16_t *RK, *RV, *AK, *AV, *RQ, *AQ;
    __device__ __forceinline__ void operator()(const f32x4 (&acc)[2][2][4][2], const Unit& u, int wr, int wc, int fr, int fq) const {
        const int pm = u.pm, pn = u.pn;
        const int kvrow0 = pm < 128 ? ((pm >> 3) * LT + LC + (pm & 7) * 256) : ((pm - 128) * LT);
        bf16_t* base; int ld; float sc = 1.f;
        if (pn < 4) { base = RK + (size_t)kvrow0 * 1024 + pn * 256; ld = 1024; sc = 0.0625f; }
        else if (pn < 12) { base = RV + (size_t)kvrow0 * 2048 + (pn - 4) * 256; ld = 2048; }
        else if (pn == 12) { base = AK + (size_t)kvrow0 * 256; ld = 256; }
        else if (pn == 13) { base = AV + (size_t)kvrow0 * 256; ld = 256; }
        else if (pn < 18) { base = RQ + (size_t)pm * 256 * 1024 + (pn - 14) * 256; ld = 1024; }
        else { base = AQ + (size_t)pm * 256 * 1024 + (pn - 18) * 256; ld = 1024; }
        EPI_ROWS_BEGIN
            bf16_t* rowp = base + (size_t)rt * ld + ct0;
#pragma unroll
            for (int bj = 0; bj < 2; ++bj) { const f32x4 v0 = acc[ai][bj][m][0] * sc, v1 = acc[ai][bj][m][1] * sc;
                u32x4 w; w.x = cvt_pk_bf16(v0[0], v0[1]); w.y = cvt_pk_bf16(v0[2], v0[3]); w.z = cvt_pk_bf16(v1[0], v1[1]); w.w = cvt_pk_bf16(v1[2], v1[3]);
                *(u32x4*)(rowp + bj * HALF) = w; }
        EPI_ROWS_END
    }
};

struct Epi5 {
    static constexpr bool PERM = true, AFTER_DRAIN = false;
    bf16_t *YR, *YA, *U1, *U2; const float* SSQ;
    __device__ __forceinline__ void operator()(const f32x4 (&acc)[2][2][4][2], const Unit& u, int wr, int wc, int fr, int fq) const {
        const int pn = u.pn; const size_t row0 = (size_t)u.pm * 256;
        if (pn < 8) {
            const int head = pn >> 1;
            EPI_ROWS_BEGIN
                const size_t row = row0 + rt;
                const float ss = SSQ[row * 8 + head * 2] + SSQ[row * 8 + head * 2 + 1];
                const float rstd = __builtin_amdgcn_rsqf(ss * (1.0f / 512.0f) + EPS);
#pragma unroll
                for (int bj = 0; bj < 2; ++bj) { u32x4* p = (u32x4*)(YR + row * 2048 + pn * 256 + bj * HALF + ct0); float o[8]; unpack8(*p, o);
                    const f32x4 v0 = acc[ai][bj][m][0], v1 = acc[ai][bj][m][1];
#pragma unroll
                    for (int k = 0; k < 4; ++k) { o[k] = o[k] * rstd * fast_silu(v0[k]); o[4 + k] = o[4 + k] * rstd * fast_silu(v1[k]); }
                    *p = pack8(o); }
            EPI_ROWS_END
        } else if (pn < 12) {
            EPI_ROWS_BEGIN
                const size_t row = row0 + rt;
#pragma unroll
                for (int bj = 0; bj < 2; ++bj) { u32x4* p = (u32x4*)(YA + row * 1024 + (pn - 8) * 256 + bj * HALF + ct0); float o[8]; unpack8(*p, o);
                    const f32x4 v0 = acc[ai][bj][m][0], v1 = acc[ai][bj][m][1];
#pragma unroll
                    for (int k = 0; k < 4; ++k) { o[k] = o[k] * fast_silu(v0[k]); o[4 + k] = o[4 + k] * fast_silu(v1[k]); }
                    *p = pack8(o); }
            EPI_ROWS_END
        } else {
            bf16_t* U = pn < 16 ? U1 + (pn - 12) * 256 : U2 + (pn - 16) * 256;
            EPI_ROWS_BEGIN
                const size_t row = row0 + rt;
#pragma unroll
                for (int bj = 0; bj < 2; ++bj) { float o[8]; const f32x4 v0 = acc[ai][bj][m][0], v1 = acc[ai][bj][m][1];
#pragma unroll
                    for (int k = 0; k < 4; ++k) { o[k] = fast_sigmoid(v0[k]); o[4 + k] = fast_sigmoid(v1[k]); }
                    *(u32x4*)(U + row * 1024 + bj * HALF + ct0) = pack8(o); }
            EPI_ROWS_END
        }
    }
};

struct Epi6 {
    static constexpr bool PERM = true, AFTER_DRAIN = false;
    bf16_t* U1;
    __device__ __forceinline__ void operator()(const f32x4 (&acc)[2][2][4][2], const Unit& u, int wr, int wc, int fr, int fq) const {
        const size_t row0 = (size_t)u.pm * 256; const int c0 = u.pn * 256;
        EPI_ROWS_BEGIN
            const size_t row = row0 + rt;
#pragma unroll
            for (int bj = 0; bj < 2; ++bj) { u32x4* p = (u32x4*)(U1 + row * 1024 + c0 + bj * HALF + ct0); float o[8]; unpack8(*p, o);
                const f32x4 v0 = acc[ai][bj][m][0], v1 = acc[ai][bj][m][1];
#pragma unroll
                for (int k = 0; k < 4; ++k) { o[k] *= v0[k]; o[4 + k] *= v1[k]; }
                *p = pack8(o); }
        EPI_ROWS_END
    }
};
struct Epi7 {
    static constexpr bool PERM = true, AFTER_DRAIN = false;
    bf16_t* U1; const bf16_t* U2;
    __device__ __forceinline__ void operator()(const f32x4 (&acc)[2][2][4][2], const Unit& u, int wr, int wc, int fr, int fq) const {
        const size_t row0 = (size_t)u.pm * 256; const int c0 = u.pn * 256;
        EPI_ROWS_BEGIN
            const size_t row = row0 + rt;
#pragma unroll
            for (int bj = 0; bj < 2; ++bj) { const size_t off = row * 1024 + c0 + bj * HALF + ct0; u32x4* p = (u32x4*)(U1 + off); float o[8], g[8]; unpack8(*p, o); unpack8(*(const u32x4*)(U2 + off), g);
                const f32x4 v0 = acc[ai][bj][m][0], v1 = acc[ai][bj][m][1];
#pragma unroll
                for (int k = 0; k < 4; ++k) { o[k] += g[k] * v0[k]; o[4 + k] += g[4 + k] * v1[k]; }
                *p = pack8(o); }
        EPI_ROWS_END
    }
};
struct Epi8 {
    static constexpr bool PERM = true, AFTER_DRAIN = false;
    const float* X; const float* MOD; float* OUT;
    __device__ __forceinline__ void operator()(const f32x4 (&acc)[2][2][4][2], const Unit& u, int wr, int wc, int fr, int fq) const {
        const size_t row0 = (size_t)u.pm * 256; const int c0 = u.pn * 256; const float* gate = MOD + (size_t)(u.pm >> 3) * 3072 + 2048;
        EPI_ROWS_BEGIN
            const size_t row = row0 + rt;
#pragma unroll
            for (int bj = 0; bj < 2; ++bj) { const int col = c0 + bj * HALF + ct0; const size_t off = row * 1024 + col;
#pragma unroll
                for (int n = 0; n < 2; ++n) { const f32x4 xv = *(const f32x4*)(X + off + 4 * n), gv = *(const f32x4*)(gate + col + 4 * n);
                    *(f32x4*)(OUT + off + 4 * n) = xv + gv * acc[ai][bj][m][n]; } }
        EPI_ROWS_END
    }
};
template <class Epi, class Sched, bool ALIGN_EPI = false, bool SP2 = false>
__device__ __forceinline__ void gemm_phase(PG8_LAS unsigned char* lds, const Gemm g, const Sched& S, const Epi& E) {
    const int tid = threadIdx.x, wid = __builtin_amdgcn_readfirstlane(tid >> 6), lane = tid & 63, wr = wid >> 2, wc = wid & 3, fr = lane & 15, fq = lane >> 4;
    const int K = g.K, nt = K / BK;
    unsigned voffA[2], voffB[2];
#pragma unroll
    for (int i = 0; i < 2; ++i) { int R, C; stage_rc(tid * 16 + i * 8192, R, C); const int Rb = Epi::PERM ? ((R & ~31) + perm32(R & 31)) : R;
        voffA[i] = (unsigned)(R * K + C) * 2u; voffB[i] = (unsigned)(Rb * K + C) * 2u; }
    const size_t kstep = (size_t)(BK * 2);
    const size_t hstep = (size_t)HALF * K * 2;
    const size_t tstep = 2 * hstep;
    const unsigned ldsw = (unsigned)wid * 1024u;
    const int aoff = lds_byte(wr * 64 + fr, fq * 8), boff = lds_byte(wc * 32 + fr, fq * 8);
#define PG8_SA(b, h) (((b) * 2 + (h)) * HTB)
#define PG8_SB(b, h) ((4 + (b) * 2 + (h)) * HTB)
#define PG8_STAGE(bufoff, gbase, voff) do { _Pragma("unroll") for (int _i = 0; _i < 2; ++_i) \
        __builtin_amdgcn_global_load_lds((const unsigned*)((const char*)(gbase) + (voff)[_i]), (PG8_LAS unsigned*)(lds + (bufoff) + ldsw + _i * 8192), 16, 0, 0); } while (0)
#define PG8_LDA(dst, b, h) do { _Pragma("unroll") for (int m = 0; m < 4; ++m) _Pragma("unroll") for (int k = 0; k < 2; ++k) dst[m][k] = *(const PG8_LAS bf16x8*)(lds + PG8_SA(b, h) + aoff + m * 2048 + k * 1024); } while (0)
#define PG8_LDB(dst, b, h) do { _Pragma("unroll") for (int n = 0; n < 2; ++n) _Pragma("unroll") for (int k = 0; k < 2; ++k) dst[n][k] = *(const PG8_LAS bf16x8*)(lds + PG8_SB(b, h) + boff + n * 2048 + k * 1024); } while (0)
#define PG8_MMA(ai, bj, At, Bt) do { __builtin_amdgcn_s_setprio(1); _Pragma("unroll") for (int m = 0; m < 4; ++m) _Pragma("unroll") for (int n = 0; n < 2; ++n) _Pragma("unroll") for (int k = 0; k < 2; ++k) \
        acc[ai][bj][m][n] = __builtin_amdgcn_mfma_f32_16x16x32_bf16(Bt[n][k], At[m][k], acc[ai][bj][m][n], 0, 0, 0); __builtin_amdgcn_s_setprio(0); } while (0)
#define PG8_WAIT_V(n) asm volatile("s_waitcnt vmcnt(" #n ")" ::: "memory")
#define PG8_WAIT_L(n) asm volatile("s_waitcnt lgkmcnt(" #n ")" ::: "memory")
#define PG8_BAR __builtin_amdgcn_s_barrier()
#define PG8_SCHED __builtin_amdgcn_sched_barrier(0)
    Unit cur, nxt; int ui = 0;
    if (!S.next(0, cur)) return;
    f32x4 acc[2][2][4][2];
#pragma unroll
    for (int a = 0; a < 2; ++a)
#pragma unroll
        for (int b = 0; b < 2; ++b)
#pragma unroll
            for (int m = 0; m < 4; ++m)
#pragma unroll
                for (int n = 0; n < 2; ++n) acc[a][b][m][n] = (f32x4){0.f, 0.f, 0.f, 0.f};
    bf16x8 At[4][2], B0[2][2], B1[2][2];
    const char* cA = (const char*)g.A + (size_t)cur.pm * tstep; const char* cB = (const char*)g.Bt + (size_t)cur.pn * tstep;
    S.a_ready(cur);
    if constexpr (SP2) {
        PG8_STAGE(PG8_SB(0, 0), cB, voffB); PG8_STAGE(PG8_SB(0, 1), cB + hstep, voffB); PG8_STAGE(PG8_SA(0, 0), cA, voffA); PG8_STAGE(PG8_SA(0, 1), cA + hstep, voffA);
        if (wr == 1) PG8_BAR;
        PG8_WAIT_V(2); PG8_BAR;
        PG8_STAGE(PG8_SB(1, 0), cB + kstep, voffB); PG8_STAGE(PG8_SA(1, 0), cA + kstep, voffA); PG8_STAGE(PG8_SB(1, 1), cB + hstep + kstep, voffB);
        PG8_WAIT_V(6); PG8_BAR;
    } else {
        PG8_STAGE(PG8_SB(0, 0), cB, voffB); PG8_STAGE(PG8_SA(0, 0), cA, voffA); PG8_STAGE(PG8_SB(0, 1), cB + hstep, voffB); PG8_STAGE(PG8_SA(0, 1), cA + hstep, voffA);
        if (wr == 1) PG8_BAR;
        PG8_WAIT_V(4); PG8_BAR;
        PG8_STAGE(PG8_SB(1, 0), cB + kstep, voffB); PG8_STAGE(PG8_SA(1, 0), cA + kstep, voffA); PG8_STAGE(PG8_SB(1, 1), cB + hstep + kstep, voffB);
        PG8_WAIT_V(6); PG8_BAR;
    }
    for (;;) {
        const bool has_next = S.next(ui + 1, nxt);
        const char* nA = has_next ? (const char*)g.A + (size_t)nxt.pm * tstep : cA; const char* nB = has_next ? (const char*)g.Bt + (size_t)nxt.pn * tstep : cB;
        for (int t = 0; t < nt; t += 2) {
            const bool last = (t == nt - 2);
            const char* a1 = cA + (size_t)(t + 1) * kstep;
            const char* a2 = last ? nA : cA + (size_t)(t + 2) * kstep; const char* b2 = last ? nB : cB + (size_t)(t + 2) * kstep;
            const char* a3 = a2 + kstep; const char* b3 = b2 + kstep;
            if (last && has_next) S.a_ready(nxt);
            if constexpr (SP2) {
            PG8_LDB(B0, 0, 0); PG8_LDB(B1, 0, 1); PG8_SCHED; PG8_LDA(At, 0, 0); PG8_STAGE(PG8_SA(1, 1), a1 + hstep, voffA);
            PG8_WAIT_V(8); PG8_WAIT_L(0); PG8_BAR; PG8_MMA(0, 0, At, B0); PG8_MMA(0, 1, At, B1); PG8_BAR; PG8_SCHED;
            PG8_LDA(At, 0, 1); PG8_STAGE(PG8_SB(0, 0), b2, voffB); PG8_STAGE(PG8_SB(0, 1), b2 + hstep, voffB); PG8_STAGE(PG8_SA(0, 0), a2, voffA);
            PG8_WAIT_V(8); PG8_WAIT_L(0); PG8_BAR; PG8_MMA(1, 0, At, B0); PG8_MMA(1, 1, At, B1); PG8_BAR; PG8_SCHED;
            PG8_LDB(B0, 1, 0); PG8_LDB(B1, 1, 1); PG8_SCHED; PG8_LDA(At, 1, 0); PG8_STAGE(PG8_SA(0, 1), a2 + hstep, voffA);
            PG8_WAIT_V(8); PG8_WAIT_L(0); PG8_BAR; PG8_MMA(0, 0, At, B0); PG8_MMA(0, 1, At, B1); PG8_BAR; PG8_SCHED;
            PG8_LDA(At, 1, 1); PG8_STAGE(PG8_SB(1, 0), b3, voffB); PG8_STAGE(PG8_SB(1, 1), b3 + hstep, voffB); PG8_STAGE(PG8_SA(1, 0), a3, voffA);
            PG8_WAIT_V(8); PG8_WAIT_L(0); PG8_BAR; PG8_MMA(1, 0, At, B0); PG8_MMA(1, 1, At, B1); PG8_BAR; PG8_SCHED;
            } else {
            PG8_LDB(B0, 0, 0); PG8_SCHED; PG8_LDA(At, 0, 0); PG8_STAGE(PG8_SA(1, 1), a1 + hstep, voffA);
            PG8_WAIT_L(8); PG8_BAR; PG8_WAIT_L(0); PG8_MMA(0, 0, At, B0); PG8_BAR; PG8_SCHED;
            PG8_LDB(B1, 0, 1); PG8_STAGE(PG8_SB(0, 0), b2, voffB);
            PG8_BAR; PG8_WAIT_L(0); PG8_MMA(0, 1, At, B1); PG8_BAR;
            PG8_LDA(At, 0, 1); PG8_STAGE(PG8_SA(0, 0), a2, voffA);
            PG8_BAR; PG8_WAIT_L(0); PG8_MMA(1, 0, At, B0); PG8_BAR; PG8_SCHED;
            PG8_STAGE(PG8_SB(0, 1), b2 + hstep, voffB);
            PG8_WAIT_V(6); PG8_BAR; PG8_MMA(1, 1, At, B1); PG8_BAR;
            PG8_LDB(B0, 1, 0); PG8_SCHED; PG8_LDA(At, 1, 0); PG8_STAGE(PG8_SA(0, 1), a2 + hstep, voffA);
            PG8_WAIT_L(8); PG8_BAR; PG8_WAIT_L(0); PG8_MMA(0, 0, At, B0); PG8_BAR; PG8_SCHED;
            PG8_LDB(B1, 1, 1); PG8_STAGE(PG8_SB(1, 0), b3, voffB);
            PG8_BAR; PG8_WAIT_L(0); PG8_MMA(0, 1, At, B1); PG8_BAR;
            PG8_LDA(At, 1, 1); PG8_STAGE(PG8_SA(1, 0), a3, voffA);
            PG8_BAR; PG8_WAIT_L(0); PG8_MMA(1, 0, At, B0); PG8_BAR; PG8_SCHED;
            PG8_STAGE(PG8_SB(1, 1), b3 + hstep, voffB);
            PG8_WAIT_V(6); PG8_BAR; PG8_MMA(1, 1, At, B1); PG8_BAR;
            }
        }
        if constexpr (ALIGN_EPI) { if (wr == 0) PG8_BAR; }
        if constexpr (!Epi::AFTER_DRAIN) { E(acc, cur, wr, wc, fr, fq); S.done(cur); }
        if (!has_next) break;
#pragma unroll
        for (int a = 0; a < 2; ++a)
#pragma unroll
            for (int b = 0; b < 2; ++b)
#pragma unroll
                for (int m = 0; m < 4; ++m)
#pragma unroll
                    for (int n = 0; n < 2; ++n) acc[a][b][m][n] = (f32x4){0.f, 0.f, 0.f, 0.f};
        cur = nxt; cA = nA; cB = nB; ++ui;
        if constexpr (ALIGN_EPI) { if (wr == 1) PG8_BAR; }
    }
    PG8_WAIT_V(0);
    if constexpr (!ALIGN_EPI) { if (wr == 0) PG8_BAR; }
    PG8_BAR;
    if constexpr (Epi::AFTER_DRAIN) { E.fused(acc, cur, wr, wc, fr, fq, lds, wid, lane); S.done(cur); }
#undef PG8_SA
#undef PG8_SB
#undef PG8_STAGE
#undef PG8_LDA
#undef PG8_LDB
#undef PG8_MMA
#undef PG8_WAIT_V
#undef PG8_WAIT_L
#undef PG8_BAR
#undef PG8_SCHED
}
}

constexpr int NWAVES = 8, NTHR = 512;
constexpr int RING_BYTES = 131072, LDS_BYTES = 147456;
#ifndef MK_ONE_LAUNCH
#define MK_ONE_LAUNCH 0
#endif
constexpr int N_PHASES = 10;
#define LDS_WAIT() asm volatile("s_waitcnt lgkmcnt(0)" ::: "memory")

struct Args { const float* in[14]; float* out; unsigned char* ws; int ph_lo, ph_hi; };

__device__ __forceinline__ void p0_mod_item(const float* c, const float* c_ctx, const float* w_ada, const float* b_ada, float* MOD, float* ldsf, int item, int tid) {
    float* sc = ldsf; float* red = ldsf + 17 * 1024;
    for (int i = tid; i < 17 * 1024; i += NTHR) { const float v = i < 16 * 1024 ? c[i] : c_ctx[i - 16 * 1024]; sc[i] = v / (1.0f + expf(-v)); }
    __syncthreads();
    const int col = tid & 31, ks = tid >> 5, n = item * 32 + col;
    float acc[17];
#pragma unroll
    for (int r = 0; r < 17; ++r) acc[r] = 0.f;
    for (int k = ks * 64; k < ks * 64 + 64; ++k) { const float w = w_ada[(size_t)k * 3072 + n];
#pragma unroll
        for (int r = 0; r < 17; ++r) acc[r] += sc[r * 1024 + k] * w; }
#pragma unroll
    for (int r = 0; r < 17; ++r) red[(ks * 17 + r) * 32 + col] = acc[r];
    __syncthreads();
    for (int o = tid; o < 17 * 32; o += NTHR) { const int r = o >> 5, cc = o & 31; float s = b_ada[item * 32 + cc];
        for (int k2 = 0; k2 < 16; ++k2) s += red[(k2 * 17 + r) * 32 + cc];
        MOD[r * 3072 + item * 32 + cc] = s; }
    __syncthreads();
}
__device__ __forceinline__ void p0_transpose_item(const float* W, int K, int N, bf16_t* WT, int row_off, float* scr, int item, int lane) {
    const int nblk = N / 32, kb = item / nblk, nb = item % nblk, k0 = 64 * kb, n0 = 32 * nb;
#pragma unroll 8
    for (int i = 0; i < 32; ++i) { const int kk = 2 * i + (lane >> 5); scr[kk * 33 + (lane & 31)] = W[(size_t)(k0 + kk) * N + n0 + (lane & 31)]; }
    LDS_WAIT(); asm volatile("" ::: "memory");
    const int c = lane & 7;
#pragma unroll
    for (int j = 0; j < 4; ++j) { const int n = (lane >> 3) + 8 * j; const float* s = scr + (8 * c) * 33 + n;
        v4u o; o.x = pk2(s[0 * 33], s[1 * 33]); o.y = pk2(s[2 * 33], s[3 * 33]); o.z = pk2(s[4 * 33], s[5 * 33]); o.w = pk2(s[6 * 33], s[7 * 33]);
        *(v4u*)(WT + (size_t)(row_off + n0 + n) * K + k0 + 8 * c) = o; }
    LDS_WAIT(); asm volatile("" ::: "memory");
}
__device__ __forceinline__ int new_col(int o) { return o < 4608 ? o : (o < 6656 ? o + 1024 : (o < 7680 ? o - 2048 : o)); }

__device__ __forceinline__ void sincos_d(double a, float& c, float& s) {
    const double TWO_PI = 6.283185307179586476925;
    const double k = (double)(long long)(a / TWO_PI + (a >= 0 ? 0.5 : -0.5)); const double r = a - k * TWO_PI, r2 = r * r;
    double ts = r, ss = r, tc = 1.0, cc = 1.0;
    for (int n = 1; n <= 15; ++n) { tc *= -r2 / (double)((2 * n - 1) * (2 * n)); cc += tc; ts *= -r2 / (double)((2 * n) * (2 * n + 1)); ss += ts; }
    c = (float)cc; s = (float)ss;
}

__device__ __forceinline__ void p1_row(const float* xrow, const float* nw, const float* shift, const float* scale, bf16_t* orow, int lane) {
    const v4f* xr = (const v4f*)xrow + lane; v4f v[4]; float s = 0.f;
#pragma unroll
    for (int j = 0; j < 4; ++j) { v[j] = xr[64 * j]; s += (v[j].x * v[j].x + v[j].y * v[j].y) + (v[j].z * v[j].z + v[j].w * v[j].w); }
    const float rstd = 1.0f / sqrtf(wave_sum(s) * (1.0f / 1024.0f) + EPS);
    v2u* o8 = (v2u*)orow + lane;
#pragma unroll
    for (int j = 0; j < 4; ++j) { const v4f w = ((const v4f*)nw)[lane + 64 * j], sh = ((const v4f*)shift)[lane + 64 * j], sc = ((const v4f*)scale)[lane + 64 * j];
        const v4f y = v[j] * rstd * w * (sc + 1.0f) + sh; v2u o; o.x = pk2(y.x, y.y); o.y = pk2(y.z, y.w); o8[64 * j] = o; }
}

__device__ __forceinline__ void p3_item(bf16_t* buf, int ldlog2, bool isK, const float* nw, const float* ROPE, size_t item, int lane) {
    const size_t e = item * 512 + (size_t)lane * 8; const size_t row = e >> ldlog2; const int col = (int)(e & ((1u << ldlog2) - 1)), d0 = col & 127;
    float t[8]; unpack8(*(const v4u*)(buf + e), t);
    float ss = 0.f;
#pragma unroll
    for (int k = 0; k < 8; ++k) ss += t[k] * t[k];
    ss += __shfl_xor(ss, 1); ss += __shfl_xor(ss, 2); ss += __shfl_xor(ss, 4); ss += __shfl_xor(ss, 8);
    const float rstd = 1.0f / sqrtf(ss * (1.0f / 128.0f) + EPS);
#pragma unroll
    for (int k = 0; k < 8; ++k) t[k] = t[k] * rstd * nw[d0 + k];
    int l; bool rope = true;
    if (isK) { const int p = (int)(row % LT); rope = p >= LC; l = p - LC; } else l = (int)(row & (SEQ - 1));
    if (rope) { const int ri = l >> 6, ci = l & 63, p0 = d0 >> 1; const float* tab = p0 < 32 ? ROPE + (ri * 32 + p0) * 2 : ROPE + (ci * 32 + (p0 - 32)) * 2;
#pragma unroll
        for (int q = 0; q < 4; ++q) { const float cs = tab[2 * q], sn = tab[2 * q + 1], x0 = t[2 * q], x1 = t[2 * q + 1]; t[2 * q] = x0 * cs - x1 * sn; t[2 * q + 1] = x0 * sn + x1 * cs; } }
    *(v4u*)(buf + e) = pack8(t);
}

__device__ __forceinline__ void p4_naive_item(const bf16_t* RQ, const bf16_t* RK, const bf16_t* RV, bf16_t* YR, float* SSQ, const float* l2d, float* ldsf, int item, int tid) {
    const int rb = item & 255, h = (item >> 8) & 3, b = item >> 10, i0 = rb * 8;
    float* qs = ldsf; float* sc = ldsf + 2048; float* red = sc + 8 * LT;
    for (int t = tid; t < 2048; t += NTHR) { const int r = t >> 8, d = t & 255; qs[t] = bf2f(RQ[((size_t)(b * SEQ + i0 + r)) * 1024 + h * 256 + d]); }
    __syncthreads();
    const float lgf = log1pf(-exp2f(l2d[h])), lgb = log1pf(-exp2f(l2d[4 + h]));
    for (int p = tid; p < LT; p += NTHR) {
        const bf16_t* kr = RK + ((size_t)(b * LT + p)) * 1024 + h * 256;
        float dot[8];
#pragma unroll
        for (int r = 0; r < 8; ++r) dot[r] = 0.f;
        for (int d8 = 0; d8 < 32; ++d8) { float kk[8]; unpack8(*(const v4u*)(kr + d8 * 8), kk);
#pragma unroll
            for (int r = 0; r < 8; ++r)
#pragma unroll
                for (int k = 0; k < 8; ++k) dot[r] += qs[r * 256 + d8 * 8 + k] * kk[k]; }
#pragma unroll
        for (int r = 0; r < 8; ++r) { const int i = i0 + r; float W;
            if (p < LC) W = expf(lgf * (float)(i + LC - p)) + expf(lgb * (float)(SEQ - i + p));
            else { const int j = p - LC; W = (j <= i ? expf(lgf * (float)(i - j)) : 0.f) + (j >= i ? expf(lgb * (float)(j - i)) : 0.f); }
            sc[r * LT + p] = dot[r] * W; }
    }
    __syncthreads();
    float acc[8];
#pragma unroll
    for (int r = 0; r < 8; ++r) acc[r] = 0.f;
    const bf16_t* vp = RV + (size_t)(b * LT) * 2048 + h * 512 + tid;
    for (int p = 0; p < LT; ++p) { const float v = bf2f(vp[(size_t)p * 2048]);
#pragma unroll
        for (int r = 0; r < 8; ++r) acc[r] += sc[r * LT + p] * v; }
    const int wid = tid >> 6, lane = tid & 63;
#pragma unroll
    for (int r = 0; r < 8; ++r) { YR[((size_t)(b * SEQ + i0 + r)) * 2048 + h * 512 + tid] = (bf16_t)f2bf(acc[r]); const float s = wave_sum(acc[r] * acc[r]); if (lane == 0) red[r * 8 + wid] = s; }
    __syncthreads();
    if (tid < 16) { const int r = tid >> 1, hf = tid & 1; const float s = (red[r * 8 + hf * 4] + red[r * 8 + hf * 4 + 1]) + (red[r * 8 + hf * 4 + 2] + red[r * 8 + hf * 4 + 3]);
        SSQ[((size_t)(b * SEQ + i0 + r)) * 8 + h * 2 + hf] = s; }
    __syncthreads();
}

__device__ __forceinline__ void p5_naive_item(bf16_t* AQ, const bf16_t* AK, const bf16_t* AV, float* ldsf, int item, int tid) {
    const int rb = item & 255, head = (item >> 8) & 7, b = item >> 11, g = head >> 2, i0 = rb * 8;
    float* qs = ldsf; float* sc = ldsf + 1024;
    for (int t = tid; t < 1024; t += NTHR) { const int r = t >> 7, d = t & 127; qs[t] = bf2f(AQ[((size_t)(b * SEQ + i0 + r)) * 1024 + head * 128 + d]); }
    __syncthreads();
    for (int p = tid; p < LT; p += NTHR) {
        const bf16_t* kr = AK + ((size_t)(b * LT + p)) * 256 + g * 128;
        float dot[8];
#pragma unroll
        for (int r = 0; r < 8; ++r) dot[r] = 0.f;
        for (int d8 = 0; d8 < 16; ++d8) { float kk[8]; unpack8(*(const v4u*)(kr + d8 * 8), kk);
#pragma unroll
            for (int r = 0; r < 8; ++r)
#pragma unroll
                for (int k = 0; k < 8; ++k) dot[r] += qs[r * 128 + d8 * 8 + k] * kk[k]; }
#pragma unroll
        for (int r = 0; r < 8; ++r) sc[r * LT + p] = dot[r] * 0.08838834764831845f;
    }
    __syncthreads();
    { const int wid = tid >> 6, lane = tid & 63; float* row = sc + wid * LT; float m = -1e30f;
      for (int p = lane; p < LT; p += 64) m = fmaxf(m, row[p]);
#pragma unroll
      for (int o = 1; o < 64; o <<= 1) m = fmaxf(m, __shfl_xor(m, o));
      float s = 0.f;
      for (int p = lane; p < LT; p += 64) { const float ex = expf(row[p] - m); row[p] = ex; s += ex; }
      s = wave_sum(s); const float inv = 1.0f / s;
      for (int p = lane; p < LT; p += 64) row[p] *= inv; }
    __syncthreads();
    const int e = tid & 127, r0 = (tid >> 7) * 2; float a0 = 0.f, a1 = 0.f;
    const bf16_t* vp = AV + (size_t)(b * LT) * 256 + g * 128 + e;
    for (int p = 0; p < LT; ++p) { const float v = bf2f(vp[(size_t)p * 256]); a0 += sc[r0 * LT + p] * v; a1 += sc[(r0 + 1) * LT + p] * v; }
    AQ[((size_t)(b * SEQ + i0 + r0)) * 1024 + head * 128 + e] = (bf16_t)f2bf(a0);
    AQ[((size_t)(b * SEQ + i0 + r0 + 1)) * 1024 + head * 128 + e] = (bf16_t)f2bf(a1);
    __syncthreads();
}

__global__ void __launch_bounds__(NTHR, 2) mk_fwd(Args args) {
    extern __shared__ __attribute__((aligned(16))) unsigned char lds[];
    const int tid = threadIdx.x, lane = tid & 63, wave = __builtin_amdgcn_readfirstlane(tid >> 6);
    const int G = gridDim.x, bid = blockIdx.x;
    const int gw = bid * NWAVES + wave, NGW = G * NWAVES;
    float* ldsf = (float*)lds;
    unsigned char* ws = args.ws;
    const float *x = args.in[0], *cvec = args.in[1], *ctx = args.in[2], *c_ctx = args.in[3], *norm_w = args.in[4], *w_ada = args.in[5], *b_ada = args.in[6], *w_in = args.in[7],
                *l2d = args.in[8], *q_norm_w = args.in[9], *k_norm_w = args.in[10], *w_o_ret = args.in[11], *w_o_att = args.in[12], *w_out = args.in[13];
    float* MOD = (float*)(ws + WS_MOD); float* ROPE = (float*)(ws + WS_ROPE); float* SSQ = (float*)(ws + WS_SSQ);
    bf16_t *WIN = (bf16_t*)(ws + WS_WIN), *WOR = (bf16_t*)(ws + WS_WOR), *WOA = (bf16_t*)(ws + WS_WOA), *WOUT = (bf16_t*)(ws + WS_WOUT), *HX = (bf16_t*)(ws + WS_HX);
    bf16_t *RK = (bf16_t*)(ws + WS_RK), *RV = (bf16_t*)(ws + WS_RV), *RQ = (bf16_t*)(ws + WS_RQ), *AK = (bf16_t*)(ws + WS_AK), *AV = (bf16_t*)(ws + WS_AV), *AQ = (bf16_t*)(ws + WS_AQ);
    bf16_t *U1 = (bf16_t*)(ws + WS_U1), *U2 = (bf16_t*)(ws + WS_U2), *YR = (bf16_t*)args.out;
    const int lo = args.ph_lo, hi = args.ph_hi;
#define IN(k) (lo <= (k) && (k) < hi)
#define BOTH(k) (IN(k) && IN((k) + 1))
#define GRID_BAR() do { } while (0)

    if (IN(0)) {
        for (int it = bid; it < 96; it += G) p0_mod_item(cvec, c_ctx, w_ada, b_ada, MOD, ldsf, it, tid);
        if (bid == G - 1) for (int t = tid; t < 2048; t += NTHR) { const int v = t >> 5, i = t & 31; double fd = 1.0; for (int k = 0; k < i; ++k) fd *= 0.7498942093324559;
            const float ang = (float)v * (float)fd; float cs, sn; sincos_d((double)ang, cs, sn); ROPE[2 * t] = cs; ROPE[2 * t + 1] = sn; }
        float* scr = ldsf + wave * (64 * 33);
        constexpr int I_IN = 16 * (NIN / 32), I_OR = 32 * 32, I_OA = 16 * 32, I_OUT = 16 * 32;
        for (int it = gw; it < I_IN + I_OR + I_OA + I_OUT; it += NGW) {
            int r = it;
            if (r < I_IN) { const int n0 = 32 * (r % (NIN / 32)); p0_transpose_item(w_in, 1024, NIN, WIN, new_col(n0) - n0, scr, r, lane); continue; } r -= I_IN;
            if (r < I_OR) { p0_transpose_item(w_o_ret, 2048, 1024, WOR, 0, scr, r, lane); continue; } r -= I_OR;
            if (r < I_OA) { p0_transpose_item(w_o_att, 1024, 1024, WOA, 0, scr, r, lane); continue; } r -= I_OA;
            p0_transpose_item(w_out, 1024, 1024, WOUT, 0, scr, r, lane);
        }
        if (BOTH(0)) GRID_BAR();
    }
    if (IN(1)) {
        for (int m = gw; m < MALL; m += NGW) {
            if (m < MLAT) { const int b = m >> 11; p1_row(x + (size_t)m * 1024, norm_w, MOD + b * 3072, MOD + b * 3072 + 1024, HX + (size_t)m * 1024, lane); }
            else p1_row(ctx + (size_t)(m - MLAT) * 1024, norm_w, MOD + 16 * 3072, MOD + 16 * 3072 + 1024, HX + (size_t)m * 1024, lane);
        }
        if (BOTH(1)) GRID_BAR();
    }
    if (IN(2)) {
        pg8::Gemm g{HX, WIN, MALL, N1, 1024}; pg8::Sched1 S; S.init(G, bid);
        pg8::Epi1 E{RK, RV, AK, AV, RQ, AQ};
        pg8::gemm_phase<pg8::Epi1, pg8::Sched1, true, true>((PG8_LAS unsigned char*)lds, g, S, E);
        if (BOTH(2)) GRID_BAR();
    }
    if (IN(3)) {
        constexpr size_t IQ = (size_t)MLAT * 1024 / 512, IK = (size_t)NB * LT * 256 / 512;
        for (size_t it = gw; it < IQ + IK; it += NGW) {
            if (it < IQ) p3_item(AQ, 10, false, q_norm_w, ROPE, it, lane); else p3_item(AK, 8, true, k_norm_w, ROPE, it - IQ, lane);
        }
        if (BOTH(3)) GRID_BAR();
    }
    if (IN(4)) {
        for (int it = bid; it < NB * RH * 256; it += G) p4_naive_item(RQ, RK, RV, YR, SSQ, l2d, ldsf, it, tid);
    }
    if (IN(5)) {
        for (int it = bid; it < NB * AH * 256; it += G) p5_naive_item(AQ, AK, AV, ldsf, it, tid);
        if (BOTH(5)) GRID_BAR();
    }
    if (IN(6)) {
        pg8::Gemm g{HX, WIN + (size_t)N1 * 1024, MLAT, NG, 1024}; pg8::StaticOrder S; S.init(MLAT, NG, G, bid);
        pg8::Epi5 E{YR, AQ, U1, U2, SSQ};
        pg8::gemm_phase<pg8::Epi5, pg8::StaticOrder, true, true>((PG8_LAS unsigned char*)lds, g, S, E);
        if (BOTH(6)) GRID_BAR();
    }
    if (IN(7)) {
        pg8::Gemm g{YR, WOR, MLAT, 1024, 2048}; pg8::StaticOrder S; S.init(MLAT, 1024, G, bid);
        pg8::Epi6 E{U1};
        pg8::gemm_phase<pg8::Epi6, pg8::StaticOrder, true, true>((PG8_LAS unsigned char*)lds, g, S, E);
    }
    if (IN(8)) {
        pg8::Gemm g{AQ, WOA, MLAT, 1024, 1024}; pg8::StaticOrder S; S.init(MLAT, 1024, G, bid);
        pg8::Epi7 E{U1, U2};
        pg8::gemm_phase<pg8::Epi7, pg8::StaticOrder, true, true>((PG8_LAS unsigned char*)lds, g, S, E);
        if (BOTH(8)) GRID_BAR();
    }
    if (IN(9)) {
        pg8::Gemm g{U1, WOUT, MLAT, 1024, 1024}; pg8::StaticOrder S; S.init(MLAT, 1024, G, bid);
        pg8::Epi8 E{x, MOD, args.out};
        pg8::gemm_phase<pg8::Epi8, pg8::StaticOrder, true, true>((PG8_LAS unsigned char*)lds, g, S, E);
    }
#undef IN
#undef BOTH
}

extern "C" void kernel_launch(void* const* d_in, const int* in_sizes, int n_in, void* d_out, int out_size, void* d_ws, size_t ws_size, hipStream_t stream) {
    static int grid = 0;
    if (grid == 0) {
        if (n_in != 14 || in_sizes[0] != MLAT * DM || out_size != MLAT * DM || ws_size < WS_END) {
            fprintf(stderr, "kernel_launch: unexpected shapes: n_in %d in0 %d out %d ws %zu (need >= %zu)\n", n_in, n_in > 0 ? in_sizes[0] : -1, out_size, ws_size, (size_t)WS_END); grid = -1; return; }
        int dev = 0, cus = 0;
        if (hipGetDevice(&dev) != hipSuccess || hipDeviceGetAttribute(&cus, hipDeviceAttributeMultiprocessorCount, dev) != hipSuccess) { grid = -1; return; }
        if (hipFuncSetAttribute((const void*)mk_fwd, hipFuncAttributeMaxDynamicSharedMemorySize, LDS_BYTES) != hipSuccess) { fprintf(stderr, "kernel_launch: hipFuncSetAttribute failed\n"); grid = -1; return; }
        grid = cus;
    }
    if (grid < 0) return;
    Args a{};
    for (int i = 0; i < 14; ++i) a.in[i] = (const float*)d_in[i];
    a.out = (float*)d_out; a.ws = (unsigned char*)d_ws;
    for (int ph = 0; ph < N_PHASES; ++ph) {
        a.ph_lo = ph; a.ph_hi = ph + 1;
        hipLaunchKernelGGL(mk_fwd, dim3(grid), dim3(NTHR), LDS_BYTES, stream, a);
    }
    const hipError_t le = hipPeekAtLastError();
    if (le != hipSuccess) fprintf(stderr, "kernel_launch: launch failed: %s\n", hipGetErrorName(le));
}
```

```cpp
#include <hip/hip_runtime.h>
#include <cstdio>
#include <cstdint>
#include <hip/hip_cooperative_groups.h>

constexpr int NB = 16, SEQ = 2048, DM = 1024, LC = 256, LT = LC + SEQ;
constexpr int MLAT = NB * SEQ, MCTX = NB * LC, MALL = MLAT + MCTX;
constexpr int RH = 4, RDK = 256, RDV = 512;
constexpr int AH = 8, AKV = 2, AHD = 128;
constexpr int NIN = 10752, NKV = 3584, N1 = 5632, NG = 5120;
constexpr float EPS = 1e-6f;

typedef unsigned short bf16_t;
typedef unsigned v4u __attribute__((ext_vector_type(4)));
typedef unsigned v2u __attribute__((ext_vector_type(2)));
typedef float v4f __attribute__((ext_vector_type(4)));
typedef float v2f __attribute__((ext_vector_type(2)));

__device__ __forceinline__ float bf2f(unsigned h) { return __uint_as_float(h << 16); }
__device__ __forceinline__ unsigned f2bf(float f) { unsigned u = __float_as_uint(f); return (u + 0x7fffu + ((u >> 16) & 1u)) >> 16; }
__device__ __forceinline__ unsigned pk2(float lo, float hi) { return f2bf(lo) | (f2bf(hi) << 16); }
__device__ __forceinline__ float bflo(unsigned w) { return __uint_as_float(w << 16); }
__device__ __forceinline__ float bfhi(unsigned w) { return __uint_as_float(w & 0xffff0000u); }
__device__ __forceinline__ float fast_sigmoid(float x) { return __builtin_amdgcn_rcpf(1.0f + __builtin_amdgcn_exp2f(-1.4426950408889634f * x)); }
__device__ __forceinline__ float fast_silu(float x) { return x * fast_sigmoid(x); }
__device__ __forceinline__ float wave_sum(float v) {
#pragma unroll
    for (int o = 1; o < 64; o <<= 1) v += __shfl_xor(v, o);
    return v;
}

typedef __bf16 bf16x2_t __attribute__((ext_vector_type(2)));
__device__ __forceinline__ unsigned cvt_pk_bf16(float lo, float hi) { v2f v = {lo, hi}; bf16x2_t b = __builtin_convertvector(v, bf16x2_t); return __builtin_bit_cast(unsigned, b); }
__device__ __forceinline__ void unpack8(const v4u w, float (&o)[8]) {
    o[0] = bflo(w.x); o[1] = bfhi(w.x); o[2] = bflo(w.y); o[3] = bfhi(w.y); o[4] = bflo(w.z); o[5] = bfhi(w.z); o[6] = bflo(w.w); o[7] = bfhi(w.w);
}
__device__ __forceinline__ v4u pack8(const float (&o)[8]) {
    v4u w; w.x = cvt_pk_bf16(o[0], o[1]); w.y = cvt_pk_bf16(o[2], o[3]); w.z = cvt_pk_bf16(o[4], o[5]); w.w = cvt_pk_bf16(o[6], o[7]); return w;
}

constexpr size_t MiB = 1u << 20;
constexpr size_t WS_CTL = 0;
constexpr size_t WS_MOD = 1 * MiB;
constexpr size_t WS_ROPE = WS_MOD + 256 * 1024;
constexpr size_t WS_SSQ = 2 * MiB;
constexpr size_t WS_WIN = 4 * MiB;
constexpr size_t WS_WOR = 25 * MiB;
constexpr size_t WS_WOA = 29 * MiB;
constexpr size_t WS_WOUT = 31 * MiB;
constexpr size_t WS_HX = 33 * MiB;
constexpr size_t WS_RK = 105 * MiB;
constexpr size_t WS_RV = 177 * MiB;
constexpr size_t WS_RQ = 321 * MiB;
constexpr size_t WS_AK = 385 * MiB;
constexpr size_t WS_AV = 403 * MiB;
constexpr size_t WS_AQ = 421 * MiB;
constexpr size_t WS_END = 485 * MiB;
constexpr size_t WS_U1 = WS_RK;
constexpr size_t WS_U2 = WS_RV;

__host__ __device__ __forceinline__ int orig_col(int n) { return n < 4608 ? n : (n < 5632 ? n + 2048 : (n < 7680 ? n - 1024 : n)); }
namespace pg8 {
#define PG8_LAS __attribute__((address_space(3)))
typedef unsigned short bf16_t;
typedef short bf16x8 __attribute__((ext_vector_type(8)));
typedef float f32x4 __attribute__((ext_vector_type(4)));
typedef unsigned u32x4 __attribute__((ext_vector_type(4)));
constexpr int BM = 256, BK = 64, HALF = 128, HTB = HALF * BK * 2  , STAGE_BYTES = 8 * HTB, NXCD = 8, WGM = 8;

__host__ __device__ __forceinline__ int lds_byte(int r, int c) { const int st = (r >> 4) * 2 + (c >> 5), rr = r & 15, cc = c & 31, ob = rr * 64 + cc * 2; return st * 1024 + (ob ^ (((ob >> 9) & 1) << 5)); }
__host__ __device__ __forceinline__ void stage_rc(int b, int& R, int& C) { const int st = b / 1024, sb = b % 1024, swz = sb ^ (((sb >> 9) & 1) << 5); R = (st >> 1) * 16 + swz / 64; C = (st & 1) * 32 + (swz % 64) / 2; }
__host__ __device__ __forceinline__ int perm32(int rho) { const int n = rho >> 4, i = rho & 15; return 8 * (i >> 2) + 4 * n + (i & 3); }

struct Unit { int pm, pn; };
struct Gemm { const bf16_t* A; const bf16_t* Bt; int M, N, K; };

struct StaticOrder {
    int nM, nN, nwg, G, c;
    __host__ __device__ void init(int M, int N, int G_, int c_) { nM = M / BM; nN = N / BM; nwg = nM * nN; G = G_; c = c_; }
    __host__ __device__ bool next(int i, Unit& u) const {
        const long L = (long)i * G + c; if (L >= nwg) return false;
        int wgid = (int)L; { const int q = nwg / NXCD, r = nwg % NXCD, xcd = wgid % NXCD, off = wgid / NXCD; wgid = (xcd < r ? xcd * (q + 1) : r * (q + 1) + (xcd - r) * q) + off; }
        const int nig = WGM * nN, gid = wgid / nig, fm = gid * WGM, gsz = (nM - fm) < WGM ? (nM - fm) : WGM;
        u.pm = fm + ((wgid % nig) % gsz); u.pn = (wgid % nig) / gsz; return true;
    }
    __device__ __forceinline__ void a_ready(const Unit&) const {}
    __device__ __forceinline__ void done(const Unit&) const {}
};


struct Sched1 {
    int G, c; StaticOrder so;
    __device__ void init(int G_, int c_) { G = G_; c = c_; so.init(MLAT, N1, G_, c_); }
    __device__ bool next(int i, Unit& u) const {
        long L = (long)i * G + c; if (L < 2816) return so.next(i, u);
        L -= 2816; if (L >= 224) return false;
        u.pm = 128 + (int)(L & 15); u.pn = (int)(L >> 4); return true;
    }
    __device__ __forceinline__ void a_ready(const Unit&) const {}
    __device__ __forceinline__ void done(const Unit&) const {}
};

#define EPI_ROWS_BEGIN const int rt0 = wr * 64 + fr, ct0 = wc * 32 + 8 * fq; \
    _Pragma("unroll") for (int ai = 0; ai < 2; ++ai) _Pragma("unroll") for (int m = 0; m < 4; ++m) { const int rt = rt0 + ai * HALF + m * 16;
#define EPI_ROWS_END }

struct Epi1 {
    static constexpr bool PERM = true, AFTER_DRAIN = false;
    bf16_t *RK, *RV, *AK, *AV, *RQ, *AQ;
    __device__ __forceinline__ void operator()(const f32x4 (&acc)[2][2][4][2], const Unit& u, int wr, int wc, int fr, int fq) const {
        const int pm = u.pm, pn = u.pn;
        const int kvrow0 = pm < 128 ? ((pm >> 3) * LT + LC + (pm & 7) * 256) : ((pm - 128) * LT);
        bf16_t* base; int ld; float sc = 1.f;
        if (pn < 4) { base = RK + (size_t)kvrow0 * 1024 + pn * 256; ld = 1024; sc = 0.0625f; }
        else if (pn < 12) { base = RV + (size_t)kvrow0 * 2048 + (pn - 4) * 256; ld = 2048; }
        else if (pn == 12) { base = AK + (size_t)kvrow0 * 256; ld = 256; }
        else if (pn == 13) { base = AV + (size_t)kvrow0 * 256; ld = 256; }
        else if (pn < 18) { base = RQ + (size_t)pm * 256 * 1024 + (pn - 14) * 256; ld = 1024; }
        else { base = AQ + (size_t)pm * 256 * 1024 + (pn - 18) * 256; ld = 1024; }
        EPI_ROWS_BEGIN
            bf16_t* rowp = base + (size_t)rt * ld + ct0;
#pragma unroll
            for (int bj = 0; bj < 2; ++bj) { const f32x4 v0 = acc[ai][bj][m][0] * sc, v1 = acc[ai][bj][m][1] * sc;
                u32x4 w; w.x = cvt_pk_bf16(v0[0], v0[1]); w.y = cvt_pk_bf16(v0[2], v0[3]); w.z = cvt_pk_bf16(v1[0], v1[1]); w.w = cvt_pk_bf16(v1[2], v1[3]);
                *(u32x4*)(rowp + bj * HALF) = w; }
        EPI_ROWS_END
    }
};

struct Epi5 {
    static constexpr bool PERM = true, AFTER_DRAIN = false;
    bf16_t *YR, *YA, *U1, *U2; const float* SSQ;
    __device__ __forceinline__ void operator()(const f32x4 (&acc)[2][2][4][2], const Unit& u, int wr, int wc, int fr, int fq) const {
        const int pn = u.pn; const size_t row0 = (size_t)u.pm * 256;
        if (pn < 8) {
            const int head = pn >> 1;
            EPI_ROWS_BEGIN
                const size_t row = row0 + rt;
                const float ss = SSQ[row * 8 + head * 2] + SSQ[row * 8 + head * 2 + 1];
                const float rstd = __builtin_amdgcn_rsqf(ss * (1.0f / 512.0f) + EPS);
#pragma unroll
                for (int bj = 0; bj < 2; ++bj) { u32x4* p = (u32x4*)(YR + row * 2048 + pn * 256 + bj * HALF + ct0); float o[8]; unpack8(*p, o);
                    const f32x4 v0 = acc[ai][bj][m][0], v1 = acc[ai][bj][m][1];
#pragma unroll
                    for (int k = 0; k < 4; ++k) { o[k] = o[k] * rstd * fast_silu(v0[k]); o[4 + k] = o[4 + k] * rstd * fast_silu(v1[k]); }
                    *p = pack8(o); }
            EPI_ROWS_END
        } else if (pn < 12) {
            EPI_ROWS_BEGIN
                const size_t row = row0 + rt;
#pragma unroll
                for (int bj = 0; bj < 2; ++bj) { u32x4* p = (u32x4*)(YA + row * 1024 + (pn - 8) * 256 + bj * HALF + ct0); float o[8]; unpack8(*p, o);
                    const f32x4 v0 = acc[ai][bj][m][0], v1 = acc[ai][bj][m][1];
#pragma unroll
                    for (int k = 0; k < 4; ++k) { o[k] = o[k] * fast_silu(v0[k]); o[4 + k] = o[4 + k] * fast_silu(v1[k]); }
                    *p = pack8(o); }
            EPI_ROWS_END
        } else {
            bf16_t* U = pn < 16 ? U1 + (pn - 12) * 256 : U2 + (pn - 16) * 256;
            EPI_ROWS_BEGIN
                const size_t row = row0 + rt;
#pragma unroll
                for (int bj = 0; bj < 2; ++bj) { float o[8]; const f32x4 v0 = acc[ai][bj][m][0], v1 = acc[ai][bj][m][1];
#pragma unroll
                    for (int k = 0; k < 4; ++k) { o[k] = fast_sigmoid(v0[k]); o[4 + k] = fast_sigmoid(v1[k]); }
                    *(u32x4*)(U + row * 1024 + bj * HALF + ct0) = pack8(o); }
            EPI_ROWS_END
        }
    }
};

struct Epi6 {
    static constexpr bool PERM = true, AFTER_DRAIN = false;
    bf16_t* U1;
    __device__ __forceinline__ void operator()(const f32x4 (&acc)[2][2][4][2], const Unit& u, int wr, int wc, int fr, int fq) const {
        const size_t row0 = (size_t)u.pm * 256; const int c0 = u.pn * 256;
        EPI_ROWS_BEGIN
            const size_t row = row0 + rt;
#pragma unroll
            for (int bj = 0; bj < 2; ++bj) { u32x4* p = (u32x4*)(U1 + row * 1024 + c0 + bj * HALF + ct0); float o[8]; unpack8(*p, o);
                const f32x4 v0 = acc[ai][bj][m][0], v1 = acc[ai][bj][m][1];
#pragma unroll
                for (int k = 0; k < 4; ++k) { o[k] *= v0[k]; o[4 + k] *= v1[k]; }
                *p = pack8(o); }
        EPI_ROWS_END
    }
};
struct Epi7 {
    static constexpr bool PERM = true, AFTER_DRAIN = false;
    bf16_t* U1; const bf16_t* U2;
    __device__ __forceinline__ void operator()(const f32x4 (&acc)[2][2][4][2], const Unit& u, int wr, int wc, int fr, int fq) const {
        const size_t row0 = (size_t)u.pm * 256; const int c0 = u.pn * 256;
        EPI_ROWS_BEGIN
            const size_t row = row0 + rt;
#pragma unroll
            for (int bj = 0; bj < 2; ++bj) { const size_t off = row * 1024 + c0 + bj * HALF + ct0; u32x4* p = (u32x4*)(U1 + off); float o[8], g[8]; unpack8(*p, o); unpack8(*(const u32x4*)(U2 + off), g);
                const f32x4 v0 = acc[ai][bj][m][0], v1 = acc[ai][bj][m][1];
#pragma unroll
                for (int k = 0; k < 4; ++k) { o[k] += g[k] * v0[k]; o[4 + k] += g[4 + k] * v1[k]; }
                *p = pack8(o); }
        EPI_ROWS_END
    }
};
struct Epi8 {
    static constexpr bool PERM = true, AFTER_DRAIN = false;
    const float* X; const float* MOD; float* OUT;
    __device__ __forceinline__ void operator()(const f32x4 (&acc)[2][2][4][2], const Unit& u, int wr, int wc, int fr, int fq) const {
        const size_t row0 = (size_t)u.pm * 256; const int c0 = u.pn * 256; const float* gate = MOD + (size_t)(u.pm >> 3) * 3072 + 2048;
        EPI_ROWS_BEGIN
            const size_t row = row0 + rt;
#pragma unroll
            for (int bj = 0; bj < 2; ++bj) { const int col = c0 + bj * HALF + ct0; const size_t off = row * 1024 + col;
#pragma unroll
                for (int n = 0; n < 2; ++n) { const f32x4 xv = *(const f32x4*)(X + off + 4 * n), gv = *(const f32x4*)(gate + col + 4 * n);
                    *(f32x4*)(OUT + off + 4 * n) = xv + gv * acc[ai][bj][m][n]; } }
        EPI_ROWS_END
    }
};
template <class Epi, class Sched, bool ALIGN_EPI = false, bool SP2 = false>
__device__ __forceinline__ void gemm_phase(PG8_LAS unsigned char* lds, const Gemm g, const Sched& S, const Epi& E) {
    const int tid = threadIdx.x, wid = __builtin_amdgcn_readfirstlane(tid >> 6), lane = tid & 63, wr = wid >> 2, wc = wid & 3, fr = lane & 15, fq = lane >> 4;
    const int K = g.K, nt = K / BK;
    unsigned voffA[2], voffB[2];
#pragma unroll
    for (int i = 0; i < 2; ++i) { int R, C; stage_rc(tid * 16 + i * 8192, R, C); const int Rb = Epi::PERM ? ((R & ~31) + perm32(R & 31)) : R;
        voffA[i] = (unsigned)(R * K + C) * 2u; voffB[i] = (unsigned)(Rb * K + C) * 2u; }
    const size_t kstep = (size_t)(BK * 2);
    const size_t hstep = (size_t)HALF * K * 2;
    const size_t tstep = 2 * hstep;
    const unsigned ldsw = (unsigned)wid * 1024u;
    const int aoff = lds_byte(wr * 64 + fr, fq * 8), boff = lds_byte(wc * 32 + fr, fq * 8);
#define PG8_SA(b, h) (((b) * 2 + (h)) * HTB)
#define PG8_SB(b, h) ((4 + (b) * 2 + (h)) * HTB)
#define PG8_STAGE(bufoff, gbase, voff) do { _Pragma("unroll") for (int _i = 0; _i < 2; ++_i) \
        __builtin_amdgcn_global_load_lds((const unsigned*)((const char*)(gbase) + (voff)[_i]), (PG8_LAS unsigned*)(lds + (bufoff) + ldsw + _i * 8192), 16, 0, 0); } while (0)
#define PG8_LDA(dst, b, h) do { _Pragma("unroll") for (int m = 0; m < 4; ++m) _Pragma("unroll") for (int k = 0; k < 2; ++k) dst[m][k] = *(const PG8_LAS bf16x8*)(lds + PG8_SA(b, h) + aoff + m * 2048 + k * 1024); } while (0)
#define PG8_LDB(dst, b, h) do { _Pragma("unroll") for (int n = 0; n < 2; ++n) _Pragma("unroll") for (int k = 0; k < 2; ++k) dst[n][k] = *(const PG8_LAS bf16x8*)(lds + PG8_SB(b, h) + boff + n * 2048 + k * 1024); } while (0)
#define PG8_MMA(ai, bj, At, Bt) do { __builtin_amdgcn_s_setprio(1); _Pragma("unroll") for (int m = 0; m < 4; ++m) _Pragma("unroll") for (int n = 0; n < 2; ++n) _Pragma("unroll") for (int k = 0; k < 2; ++k) \
        acc[ai][bj][m][n] = __builtin_amdgcn_mfma_f32_16x16x32_bf16(Bt[n][k], At[m][k], acc[ai][bj][m][n], 0, 0, 0); __builtin_amdgcn_s_setprio(0); } while (0)
#define PG8_WAIT_V(n) asm volatile("s_waitcnt vmcnt(" #n ")" ::: "memory")
#define PG8_WAIT_L(n) asm volatile("s_waitcnt lgkmcnt(" #n ")" ::: "memory")
#define PG8_BAR __builtin_amdgcn_s_barrier()
#define PG8_SCHED __builtin_amdgcn_sched_barrier(0)
    Unit cur, nxt; int ui = 0;
    if (!S.next(0, cur)) return;
    f32x4 acc[2][2][4][2];
#pragma unroll
    for (int a = 0; a < 2; ++a)
#pragma unroll
        for (int b = 0; b < 2; ++b)
#pragma unroll
            for (int m = 0; m < 4; ++m)
#pragma unroll
                for (int n = 0; n < 2; ++n) acc[a][b][m][n] = (f32x4){0.f, 0.f, 0.f, 0.f};
    bf16x8 At[4][2], B0[2][2], B1[2][2];
    const char* cA = (const char*)g.A + (size_t)cur.pm * tstep; const char* cB = (const char*)g.Bt + (size_t)cur.pn * tstep;
    S.a_ready(cur);
    if constexpr (SP2) {
        PG8_STAGE(PG8_SB(0, 0), cB, voffB); PG8_STAGE(PG8_SB(0, 1), cB + hstep, voffB); PG8_STAGE(PG8_SA(0, 0), cA, voffA); PG8_STAGE(PG8_SA(0, 1), cA + hstep, voffA);
        if (wr == 1) PG8_BAR;
        PG8_WAIT_V(2); PG8_BAR;
        PG8_STAGE(PG8_SB(1, 0), cB + kstep, voffB); PG8_STAGE(PG8_SA(1, 0), cA + kstep, voffA); PG8_STAGE(PG8_SB(1, 1), cB + hstep + kstep, voffB);
        PG8_WAIT_V(6); PG8_BAR;
    } else {
        PG8_STAGE(PG8_SB(0, 0), cB, voffB); PG8_STAGE(PG8_SA(0, 0), cA, voffA); PG8_STAGE(PG8_SB(0, 1), cB + hstep, voffB); PG8_STAGE(PG8_SA(0, 1), cA + hstep, voffA);
        if (wr == 1) PG8_BAR;
        PG8_WAIT_V(4); PG8_BAR;
        PG8_STAGE(PG8_SB(1, 0), cB + kstep, voffB); PG8_STAGE(PG8_SA(1, 0), cA + kstep, voffA); PG8_STAGE(PG8_SB(1, 1), cB + hstep + kstep, voffB);
        PG8_WAIT_V(6); PG8_BAR;
    }
    for (;;) {
        const bool has_next = S.next(ui + 1, nxt);
        const char* nA = has_next ? (const char*)g.A + (size_t)nxt.pm * tstep : cA; const char* nB = has_next ? (const char*)g.Bt + (size_t)nxt.pn * tstep : cB;
        for (int t = 0; t < nt; t += 2) {
            const bool last = (t == nt - 2);
            const char* a1 = cA + (size_t)(t + 1) * kstep;
            const char* a2 = last ? nA : cA + (size_t)(t + 2) * kstep; const char* b2 = last ? nB : cB + (size_t)(t + 2) * kstep;
            const char* a3 = a2 + kstep; const char* b3 = b2 + kstep;
            if (last && has_next) S.a_ready(nxt);
            if constexpr (SP2) {
            PG8_LDB(B0, 0, 0); PG8_LDB(B1, 0, 1); PG8_SCHED; PG8_LDA(At, 0, 0); PG8_STAGE(PG8_SA(1, 1), a1 + hstep, voffA);
            PG8_WAIT_V(8); PG8_WAIT_L(0); PG8_BAR; PG8_MMA(0, 0, At, B0); PG8_MMA(0, 1, At, B1); PG8_BAR; PG8_SCHED;
            PG8_LDA(At, 0, 1); PG8_STAGE(PG8_SB(0, 0), b2, voffB); PG8_STAGE(PG8_SB(0, 1), b2 + hstep, voffB); PG8_STAGE(PG8_SA(0, 0), a2, voffA);
            PG8_WAIT_V(8); PG8_WAIT_L(0); PG8_BAR; PG8_MMA(1, 0, At, B0); PG8_MMA(1, 1, At, B1); PG8_BAR; PG8_SCHED;
            PG8_LDB(B0, 1, 0); PG8_LDB(B1, 1, 1); PG8_SCHED; PG8_LDA(At, 1, 0); PG8_STAGE(PG8_SA(0, 1), a2 + hstep, voffA);
            PG8_WAIT_V(8); PG8_WAIT_L(0); PG8_BAR; PG8_MMA(0, 0, At, B0); PG8_MMA(0, 1, At, B1); PG8_BAR; PG8_SCHED;
            PG8_LDA(At, 1, 1); PG8_STAGE(PG8_SB(1, 0), b3, voffB); PG8_STAGE(PG8_SB(1, 1), b3 + hstep, voffB); PG8_STAGE(PG8_SA(1, 0), a3, voffA);
            PG8_WAIT_V(8); PG8_WAIT_L(0); PG8_BAR; PG8_MMA(1, 0, At, B0); PG8_MMA(1, 1, At, B1); PG8_BAR; PG8_SCHED;
            } else {
            PG8_LDB(B0, 0, 0); PG8_SCHED; PG8_LDA(At, 0, 0); PG8_STAGE(PG8_SA(1, 1), a1 + hstep, voffA);
            PG8_WAIT_L(8); PG8_BAR; PG8_WAIT_L(0); PG8_MMA(0, 0, At, B0); PG8_BAR; PG8_SCHED;
            PG8_LDB(B1, 0, 1); PG8_STAGE(PG8_SB(0, 0), b2, voffB);
            PG8_BAR; PG8_WAIT_L(0); PG8_MMA(0, 1, At, B1); PG8_BAR;
            PG8_LDA(At, 0, 1); PG8_STAGE(PG8_SA(0, 0), a2, voffA);
            PG8_BAR; PG8_WAIT_L(0); PG8_MMA(1, 0, At, B0); PG8_BAR; PG8_SCHED;
            PG8_STAGE(PG8_SB(0, 1), b2 + hstep, voffB);
            PG8_WAIT_V(6); PG8_BAR; PG8_MMA(1, 1, At, B1); PG8_BAR;
            PG8_LDB(B0, 1, 0); PG8_SCHED; PG8_LDA(At, 1, 0); PG8_STAGE(PG8_SA(0, 1), a2 + hstep, voffA);
            PG8_WAIT_L(8); PG8_BAR; PG8_WAIT_L(0); PG8_MMA(0, 0, At, B0); PG8_BAR; PG8_SCHED;
            PG8_LDB(B1, 1, 1); PG8_STAGE(PG8_SB(1, 0), b3, voffB);
            PG8_BAR; PG8_WAIT_L(0); PG8_MMA(0, 1, At, B1); PG8_BAR;
            PG8_LDA(At, 1, 1); PG8_STAGE(PG8_SA(1, 0), a3, voffA);
            PG8_BAR; PG8_WAIT_L(0); PG8_MMA(1, 0, At, B0); PG8_BAR; PG8_SCHED;
            PG8_STAGE(PG8_SB(1, 1), b3 + hstep, voffB);
            PG8_WAIT_V(6); PG8_BAR; PG8_MMA(1, 1, At, B1); PG8_BAR;
            }
        }
        if constexpr (ALIGN_EPI) { if (wr == 0) PG8_BAR; }
        if constexpr (!Epi::AFTER_DRAIN) { E(acc, cur, wr, wc, fr, fq); S.done(cur); }
        if (!has_next) break;
#pragma unroll
        for (int a = 0; a < 2; ++a)
#pragma unroll
            for (int b = 0; b < 2; ++b)
#pragma unroll
                for (int m = 0; m < 4; ++m)
#pragma unroll
                    for (int n = 0; n < 2; ++n) acc[a][b][m][n] = (f32x4){0.f, 0.f, 0.f, 0.f};
        cur = nxt; cA = nA; cB = nB; ++ui;
        if constexpr (ALIGN_EPI) { if (wr == 1) PG8_BAR; }
    }
    PG8_WAIT_V(0);
    if constexpr (!ALIGN_EPI) { if (wr == 0) PG8_BAR; }
    PG8_BAR;
    if constexpr (Epi::AFTER_DRAIN) { E.fused(acc, cur, wr, wc, fr, fq, lds, wid, lane); S.done(cur); }
#undef PG8_SA
#undef PG8_SB
#undef PG8_STAGE
#undef PG8_LDA
#undef PG8_LDB
#undef PG8_MMA
#undef PG8_WAIT_V
#undef PG8_WAIT_L
#undef PG8_BAR
#undef PG8_SCHED
}
}

constexpr int NWAVES = 8, NTHR = 512;
constexpr int RING_BYTES = 131072, LDS_BYTES = 147456;
#ifndef MK_ONE_LAUNCH
#define MK_ONE_LAUNCH 1
#endif
constexpr int N_PHASES = 10;
#define LDS_WAIT() asm volatile("s_waitcnt lgkmcnt(0)" ::: "memory")
#define LAS __attribute__((address_space(3)))
constexpr int MISC_OFF = RING_BYTES + 320;
constexpr int CW_BAR = 4096;
constexpr size_t CTL_ZERO_BYTES = 65536;
#ifndef MK_BARRIER
#define MK_BARRIER 1
#endif
#define XB_TMO      128
#define XB_XCNT(j)  (256  + 64 * (j))
#define XB_XSUB(j)  (1280 + 64 * (j))
#define XB_XGEN(j)  (2304 + 64 * (j))
#define XB_TOP      3328
#define XB_TOPGEN   3392
#define XCD_BAR_WORDS 3456
#define XB_SPIN_CAP (1u << 18)

__device__ __forceinline__ unsigned xb_ld(unsigned* p)              { return __hip_atomic_load(p, __ATOMIC_RELAXED, __HIP_MEMORY_SCOPE_AGENT); }
__device__ __forceinline__ unsigned xb_add(unsigned* p, unsigned v) { return __hip_atomic_fetch_add(p, v, __ATOMIC_RELAXED, __HIP_MEMORY_SCOPE_AGENT); }
__device__ __forceinline__ unsigned xb_xcc_id() { return (unsigned)__builtin_amdgcn_s_getreg((3 << 11) | 20) & 0xFu; }
#define XB_SPIN(cond, bar) do { unsigned _sp = 0; while (cond) { __builtin_amdgcn_s_sleep(1); \
    if ((++_sp & 255u) == 0u) { if (xb_ld(&(bar)[XB_TMO])) break; if (_sp > XB_SPIN_CAP) { atomicAdd(&(bar)[XB_TMO], 1u); break; } } } } while (0)

struct XcdBarrier {
    unsigned* bar; unsigned x;
    volatile LAS unsigned* st;
};

__device__ __forceinline__ XcdBarrier xcd_barrier_post(unsigned* bar, volatile LAS unsigned* st) {
    XcdBarrier b; b.bar = bar; b.x = xb_xcc_id(); b.st = st;
    if (threadIdx.x == 0) (void)xb_add(&bar[XB_XCNT(b.x)], 1u);
    return b;
}
__device__ __forceinline__ void xcd_barrier_complete(unsigned* bar, unsigned x, unsigned& nloc, unsigned& nx) {
    const unsigned G = gridDim.x * gridDim.y * gridDim.z;
    unsigned sum, cnt, mine, sp = 0u;
    for (;;) {
        sum = 0u; cnt = 0u; mine = 0u;
#pragma unroll
        for (unsigned j = 0; j < 16; ++j) { const unsigned c = xb_ld(&bar[XB_XCNT(j)]); sum += c; cnt += (c > 0u) ? 1u : 0u; mine = (j == x) ? c : mine; }
        if (sum == G) break;
        __builtin_amdgcn_s_sleep(1);
        if ((++sp & 255u) == 0u) { if (xb_ld(&bar[XB_TMO])) break; if (sp > XB_SPIN_CAP) { atomicAdd(&bar[XB_TMO], 1u); break; } }
    }
    nloc = mine > 0u ? mine : 1u; nx = cnt > 0u ? cnt : 1u;
}

__device__ __forceinline__ void xcd_barrier(const XcdBarrier& b) {
    asm volatile("s_waitcnt vmcnt(0)" ::: "memory");
    __syncthreads();
    if (threadIdx.x == 0) {
        unsigned* bar = b.bar;
        __builtin_amdgcn_s_waitcnt(0);
        unsigned nloc = b.st[0], nx = b.st[1];
        if (nloc == 0u) { xcd_barrier_complete(bar, b.x, nloc, nx); b.st[0] = nloc; b.st[1] = nx; }
        const unsigned old = xb_add(&bar[XB_XSUB(b.x)], 1u);
        const unsigned gen = old / nloc;
        if (old + 1u == (gen + 1u) * nloc) {
            __builtin_amdgcn_fence(__ATOMIC_RELEASE, "agent");
            asm volatile("s_waitcnt vmcnt(0)" ::: "memory");
            const unsigned og = xb_add(&bar[XB_TOP], 1u);
            const unsigned tg = og / nx;
            if (og + 1u == (tg + 1u) * nx) xb_add(&bar[XB_TOPGEN], 1u);
            else XB_SPIN(xb_ld(&bar[XB_TOPGEN]) == tg, bar);
            __builtin_amdgcn_fence(__ATOMIC_ACQUIRE, "agent");
            xb_add(&bar[XB_XGEN(b.x)], 1u);
            asm volatile("s_waitcnt vmcnt(0)" ::: "memory");
        } else {
            XB_SPIN(xb_ld(&bar[XB_XGEN(b.x)]) == gen, bar);
            __builtin_amdgcn_fence(__ATOMIC_ACQUIRE, "agent");
            asm volatile("s_waitcnt vmcnt(0)" ::: "memory");
        }
    }
    __syncthreads();
}


struct Args { const float* in[14]; float* out; unsigned char* ws; int ph_lo, ph_hi; };

__device__ __forceinline__ void p0_mod_item(const float* c, const float* c_ctx, const float* w_ada, const float* b_ada, float* MOD, float* ldsf, int item, int tid) {
    float* sc = ldsf; float* red = ldsf + 17 * 1024;
    for (int i = tid; i < 17 * 1024; i += NTHR) { const float v = i < 16 * 1024 ? c[i] : c_ctx[i - 16 * 1024]; sc[i] = v / (1.0f + expf(-v)); }
    __syncthreads();
    const int col = tid & 31, ks = tid >> 5, n = item * 32 + col;
    float acc[17];
#pragma unroll
    for (int r = 0; r < 17; ++r) acc[r] = 0.f;
    for (int k = ks * 64; k < ks * 64 + 64; ++k) { const float w = w_ada[(size_t)k * 3072 + n];
#pragma unroll
        for (int r = 0; r < 17; ++r) acc[r] += sc[r * 1024 + k] * w; }
#pragma unroll
    for (int r = 0; r < 17; ++r) red[(ks * 17 + r) * 32 + col] = acc[r];
    __syncthreads();
    for (int o = tid; o < 17 * 32; o += NTHR) { const int r = o >> 5, cc = o & 31; float s = b_ada[item * 32 + cc];
        for (int k2 = 0; k2 < 16; ++k2) s += red[(k2 * 17 + r) * 32 + cc];
        MOD[r * 3072 + item * 32 + cc] = s; }
    __syncthreads();
}
__device__ __forceinline__ void p0_transpose_item(const float* W, int K, int N, bf16_t* WT, int row_off, float* scr, int item, int lane) {
    const int nblk = N / 32, kb = item / nblk, nb = item % nblk, k0 = 64 * kb, n0 = 32 * nb;
#pragma unroll 8
    for (int i = 0; i < 32; ++i) { const int kk = 2 * i + (lane >> 5); scr[kk * 33 + (lane & 31)] = W[(size_t)(k0 + kk) * N + n0 + (lane & 31)]; }
    LDS_WAIT(); asm volatile("" ::: "memory");
    const int c = lane & 7;
#pragma unroll
    for (int j = 0; j < 4; ++j) { const int n = (lane >> 3) + 8 * j; const float* s = scr + (8 * c) * 33 + n;
        v4u o; o.x = pk2(s[0 * 33], s[1 * 33]); o.y = pk2(s[2 * 33], s[3 * 33]); o.z = pk2(s[4 * 33], s[5 * 33]); o.w = pk2(s[6 * 33], s[7 * 33]);
        *(v4u*)(WT + (size_t)(row_off + n0 + n) * K + k0 + 8 * c) = o; }
    LDS_WAIT(); asm volatile("" ::: "memory");
}
__device__ __forceinline__ int new_col(int o) { return o < 4608 ? o : (o < 6656 ? o + 1024 : (o < 7680 ? o - 2048 : o)); }

__device__ __forceinline__ void sincos_d(double a, float& c, float& s) {
    const double TWO_PI = 6.283185307179586476925;
    const double k = (double)(long long)(a / TWO_PI + (a >= 0 ? 0.5 : -0.5)); const double r = a - k * TWO_PI, r2 = r * r;
    double ts = r, ss = r, tc = 1.0, cc = 1.0;
    for (int n = 1; n <= 15; ++n) { tc *= -r2 / (double)((2 * n - 1) * (2 * n)); cc += tc; ts *= -r2 / (double)((2 * n) * (2 * n + 1)); ss += ts; }
    c = (float)cc; s = (float)ss;
}

__device__ __forceinline__ void p1_row(const float* xrow, const float* nw, const float* shift, const float* scale, bf16_t* orow, int lane) {
    const v4f* xr = (const v4f*)xrow + lane; v4f v[4]; float s = 0.f;
#pragma unroll
    for (int j = 0; j < 4; ++j) { v[j] = xr[64 * j]; s += (v[j].x * v[j].x + v[j].y * v[j].y) + (v[j].z * v[j].z + v[j].w * v[j].w); }
    const float rstd = 1.0f / sqrtf(wave_sum(s) * (1.0f / 1024.0f) + EPS);
    v2u* o8 = (v2u*)orow + lane;
#pragma unroll
    for (int j = 0; j < 4; ++j) { const v4f w = ((const v4f*)nw)[lane + 64 * j], sh = ((const v4f*)shift)[lane + 64 * j], sc = ((const v4f*)scale)[lane + 64 * j];
        const v4f y = v[j] * rstd * w * (sc + 1.0f) + sh; v2u o; o.x = pk2(y.x, y.y); o.y = pk2(y.z, y.w); o8[64 * j] = o; }
}

__device__ __forceinline__ void p3_item(bf16_t* buf, int ldlog2, bool isK, const float* nw, const float* ROPE, size_t item, int lane) {
    const size_t e = item * 512 + (size_t)lane * 8; const size_t row = e >> ldlog2; const int col = (int)(e & ((1u << ldlog2) - 1)), d0 = col & 127;
    float t[8]; unpack8(*(const v4u*)(buf + e), t);
    float ss = 0.f;
#pragma unroll
    for (int k = 0; k < 8; ++k) ss += t[k] * t[k];
    ss += __shfl_xor(ss, 1); ss += __shfl_xor(ss, 2); ss += __shfl_xor(ss, 4); ss += __shfl_xor(ss, 8);
    const float rstd = 1.0f / sqrtf(ss * (1.0f / 128.0f) + EPS);
#pragma unroll
    for (int k = 0; k < 8; ++k) t[k] = t[k] * rstd * nw[d0 + k];
    int l; bool rope = true;
    if (isK) { const int p = (int)(row % LT); rope = p >= LC; l = p - LC; } else l = (int)(row & (SEQ - 1));
    if (rope) { const int ri = l >> 6, ci = l & 63, p0 = d0 >> 1; const float* tab = p0 < 32 ? ROPE + (ri * 32 + p0) * 2 : ROPE + (ci * 32 + (p0 - 32)) * 2;
#pragma unroll
        for (int q = 0; q < 4; ++q) { const float cs = tab[2 * q], sn = tab[2 * q + 1], x0 = t[2 * q], x1 = t[2 * q + 1]; t[2 * q] = x0 * cs - x1 * sn; t[2 * q + 1] = x0 * sn + x1 * cs; } }
    *(v4u*)(buf + e) = pack8(t);
}

__device__ __forceinline__ void p4_naive_item(const bf16_t* RQ, const bf16_t* RK, const bf16_t* RV, bf16_t* YR, float* SSQ, const float* l2d, float* ldsf, int item, int tid) {
    const int rb = item & 255, h = (item >> 8) & 3, b = item >> 10, i0 = rb * 8;
    float* qs = ldsf; float* sc = ldsf + 2048; float* red = sc + 8 * LT;
    for (int t = tid; t < 2048; t += NTHR) { const int r = t >> 8, d = t & 255; qs[t] = bf2f(RQ[((size_t)(b * SEQ + i0 + r)) * 1024 + h * 256 + d]); }
    __syncthreads();
    const float lgf = log1pf(-exp2f(l2d[h])), lgb = log1pf(-exp2f(l2d[4 + h]));
    for (int p = tid; p < LT; p += NTHR) {
        const bf16_t* kr = RK + ((size_t)(b * LT + p)) * 1024 + h * 256;
        float dot[8];
#pragma unroll
        for (int r = 0; r < 8; ++r) dot[r] = 0.f;
        for (int d8 = 0; d8 < 32; ++d8) { float kk[8]; unpack8(*(const v4u*)(kr + d8 * 8), kk);
#pragma unroll
            for (int r = 0; r < 8; ++r)
#pragma unroll
                for (int k = 0; k < 8; ++k) dot[r] += qs[r * 256 + d8 * 8 + k] * kk[k]; }
#pragma unroll
        for (int r = 0; r < 8; ++r) { const int i = i0 + r; float W;
            if (p < LC) W = expf(lgf * (float)(i + LC - p)) + expf(lgb * (float)(SEQ - i + p));
            else { const int j = p - LC; W = (j <= i ? expf(lgf * (float)(i - j)) : 0.f) + (j >= i ? expf(lgb * (float)(j - i)) : 0.f); }
            sc[r * LT + p] = dot[r] * W; }
    }
    __syncthreads();
    float acc[8];
#pragma unroll
    for (int r = 0; r < 8; ++r) acc[r] = 0.f;
    const bf16_t* vp = RV + (size_t)(b * LT) * 2048 + h * 512 + tid;
    for (int p = 0; p < LT; ++p) { const float v = bf2f(vp[(size_t)p * 2048]);
#pragma unroll
        for (int r = 0; r < 8; ++r) acc[r] += sc[r * LT + p] * v; }
    const int wid = tid >> 6, lane = tid & 63;
#pragma unroll
    for (int r = 0; r < 8; ++r) { YR[((size_t)(b * SEQ + i0 + r)) * 2048 + h * 512 + tid] = (bf16_t)f2bf(acc[r]); const float s = wave_sum(acc[r] * acc[r]); if (lane == 0) red[r * 8 + wid] = s; }
    __syncthreads();
    if (tid < 16) { const int r = tid >> 1, hf = tid & 1; const float s = (red[r * 8 + hf * 4] + red[r * 8 + hf * 4 + 1]) + (red[r * 8 + hf * 4 + 2] + red[r * 8 + hf * 4 + 3]);
        SSQ[((size_t)(b * SEQ + i0 + r)) * 8 + h * 2 + hf] = s; }
    __syncthreads();
}

__device__ __forceinline__ void p5_naive_item(bf16_t* AQ, const bf16_t* AK, const bf16_t* AV, float* ldsf, int item, int tid) {
    const int rb = item & 255, head = (item >> 8) & 7, b = item >> 11, g = head >> 2, i0 = rb * 8;
    float* qs = ldsf; float* sc = ldsf + 1024;
    for (int t = tid; t < 1024; t += NTHR) { const int r = t >> 7, d = t & 127; qs[t] = bf2f(AQ[((size_t)(b * SEQ + i0 + r)) * 1024 + head * 128 + d]); }
    __syncthreads();
    for (int p = tid; p < LT; p += NTHR) {
        const bf16_t* kr = AK + ((size_t)(b * LT + p)) * 256 + g * 128;
        float dot[8];
#pragma unroll
        for (int r = 0; r < 8; ++r) dot[r] = 0.f;
        for (int d8 = 0; d8 < 16; ++d8) { float kk[8]; unpack8(*(const v4u*)(kr + d8 * 8), kk);
#pragma unroll
            for (int r = 0; r < 8; ++r)
#pragma unroll
                for (int k = 0; k < 8; ++k) dot[r] += qs[r * 128 + d8 * 8 + k] * kk[k]; }
#pragma unroll
        for (int r = 0; r < 8; ++r) sc[r * LT + p] = dot[r] * 0.08838834764831845f;
    }
    __syncthreads();
    { const int wid = tid >> 6, lane = tid & 63; float* row = sc + wid * LT; float m = -1e30f;
      for (int p = lane; p < LT; p += 64) m = fmaxf(m, row[p]);
#pragma unroll
      for (int o = 1; o < 64; o <<= 1) m = fmaxf(m, __shfl_xor(m, o));
      float s = 0.f;
      for (int p = lane; p < LT; p += 64) { const float ex = expf(row[p] - m); row[p] = ex; s += ex; }
      s = wave_sum(s); const float inv = 1.0f / s;
      for (int p = lane; p < LT; p += 64) row[p] *= inv; }
    __syncthreads();
    const int e = tid & 127, r0 = (tid >> 7) * 2; float a0 = 0.f, a1 = 0.f;
    const bf16_t* vp = AV + (size_t)(b * LT) * 256 + g * 128 + e;
    for (int p = 0; p < LT; ++p) { const float v = bf2f(vp[(size_t)p * 256]); a0 += sc[r0 * LT + p] * v; a1 += sc[(r0 + 1) * LT + p] * v; }
    AQ[((size_t)(b * SEQ + i0 + r0)) * 1024 + head * 128 + e] = (bf16_t)f2bf(a0);
    AQ[((size_t)(b * SEQ + i0 + r0 + 1)) * 1024 + head * 128 + e] = (bf16_t)f2bf(a1);
    __syncthreads();
}

__global__ void __launch_bounds__(NTHR, 2) mk_fwd(Args args) {
    extern __shared__ __attribute__((aligned(16))) unsigned char lds[];
    const int tid = threadIdx.x, lane = tid & 63, wave = __builtin_amdgcn_readfirstlane(tid >> 6);
    const int G = gridDim.x, bid = blockIdx.x;
    const int gw = bid * NWAVES + wave, NGW = G * NWAVES;
    float* ldsf = (float*)lds;
    unsigned char* ws = args.ws;
    const float *x = args.in[0], *cvec = args.in[1], *ctx = args.in[2], *c_ctx = args.in[3], *norm_w = args.in[4], *w_ada = args.in[5], *b_ada = args.in[6], *w_in = args.in[7],
                *l2d = args.in[8], *q_norm_w = args.in[9], *k_norm_w = args.in[10], *w_o_ret = args.in[11], *w_o_att = args.in[12], *w_out = args.in[13];
    float* MOD = (float*)(ws + WS_MOD); float* ROPE = (float*)(ws + WS_ROPE); float* SSQ = (float*)(ws + WS_SSQ);
    bf16_t *WIN = (bf16_t*)(ws + WS_WIN), *WOR = (bf16_t*)(ws + WS_WOR), *WOA = (bf16_t*)(ws + WS_WOA), *WOUT = (bf16_t*)(ws + WS_WOUT), *HX = (bf16_t*)(ws + WS_HX);
    bf16_t *RK = (bf16_t*)(ws + WS_RK), *RV = (bf16_t*)(ws + WS_RV), *RQ = (bf16_t*)(ws + WS_RQ), *AK = (bf16_t*)(ws + WS_AK), *AV = (bf16_t*)(ws + WS_AV), *AQ = (bf16_t*)(ws + WS_AQ);
    bf16_t *U1 = (bf16_t*)(ws + WS_U1), *U2 = (bf16_t*)(ws + WS_U2), *YR = (bf16_t*)args.out;
    const int lo = args.ph_lo, hi = args.ph_hi;
#define IN(k) (lo <= (k) && (k) < hi)
#define BOTH(k) (IN(k) && IN((k) + 1))
    if (tid < 32) ((LAS unsigned*)(lds + MISC_OFF))[tid] = 0u;
    __syncthreads();
#if MK_BARRIER == 1
    XcdBarrier bar; bar.bar = (unsigned*)(ws + WS_CTL) + CW_BAR; bar.x = 0; bar.st = nullptr;
    if (hi - lo > 1) bar = xcd_barrier_post((unsigned*)(ws + WS_CTL) + CW_BAR, (volatile LAS unsigned*)(lds + MISC_OFF) + 8);
#define GRID_BAR() xcd_barrier(bar)
#else
#define GRID_BAR() cooperative_groups::this_grid().sync()
#endif

    if (IN(0)) {
        for (int it = bid; it < 96; it += G) p0_mod_item(cvec, c_ctx, w_ada, b_ada, MOD, ldsf, it, tid);
        if (bid == G - 1) for (int t = tid; t < 2048; t += NTHR) { const int v = t >> 5, i = t & 31; double fd = 1.0; for (int k = 0; k < i; ++k) fd *= 0.7498942093324559;
            const float ang = (float)v * (float)fd; float cs, sn; sincos_d((double)ang, cs, sn); ROPE[2 * t] = cs; ROPE[2 * t + 1] = sn; }
        float* scr = ldsf + wave * (64 * 33);
        constexpr int I_IN = 16 * (NIN / 32), I_OR = 32 * 32, I_OA = 16 * 32, I_OUT = 16 * 32;
        for (int it = gw; it < I_IN + I_OR + I_OA + I_OUT; it += NGW) {
            int r = it;
            if (r < I_IN) { const int n0 = 32 * (r % (NIN / 32)); p0_transpose_item(w_in, 1024, NIN, WIN, new_col(n0) - n0, scr, r, lane); continue; } r -= I_IN;
            if (r < I_OR) { p0_transpose_item(w_o_ret, 2048, 1024, WOR, 0, scr, r, lane); continue; } r -= I_OR;
            if (r < I_OA) { p0_transpose_item(w_o_att, 1024, 1024, WOA, 0, scr, r, lane); continue; } r -= I_OA;
            p0_transpose_item(w_out, 1024, 1024, WOUT, 0, scr, r, lane);
        }
        if (BOTH(0)) GRID_BAR();
    }
    if (IN(1)) {
        for (int m = gw; m < MALL; m += NGW) {
            if (m < MLAT) { const int b = m >> 11; p1_row(x + (size_t)m * 1024, norm_w, MOD + b * 3072, MOD + b * 3072 + 1024, HX + (size_t)m * 1024, lane); }
            else p1_row(ctx + (size_t)(m - MLAT) * 1024, norm_w, MOD + 16 * 3072, MOD + 16 * 3072 + 1024, HX + (size_t)m * 1024, lane);
        }
        if (BOTH(1)) GRID_BAR();
    }
    if (IN(2)) {
        pg8::Gemm g{HX, WIN, MALL, N1, 1024}; pg8::Sched1 S; S.init(G, bid);
        pg8::Epi1 E{RK, RV, AK, AV, RQ, AQ};
        pg8::gemm_phase<pg8::Epi1, pg8::Sched1, true, true>((PG8_LAS unsigned char*)lds, g, S, E);
        if (BOTH(2)) GRID_BAR();
    }
    if (IN(3)) {
        constexpr size_t IQ = (size_t)MLAT * 1024 / 512, IK = (size_t)NB * LT * 256 / 512;
        for (size_t it = gw; it < IQ + IK; it += NGW) {
            if (it < IQ) p3_item(AQ, 10, false, q_norm_w, ROPE, it, lane); else p3_item(AK, 8, true, k_norm_w, ROPE, it - IQ, lane);
        }
        if (BOTH(3)) GRID_BAR();
    }
    if (IN(4)) {
        for (int it = bid; it < NB * RH * 256; it += G) p4_naive_item(RQ, RK, RV, YR, SSQ, l2d, ldsf, it, tid);
    }
    if (IN(5)) {
        for (int it = bid; it < NB * AH * 256; it += G) p5_naive_item(AQ, AK, AV, ldsf, it, tid);
        if (BOTH(5)) GRID_BAR();
    }
    if (IN(6)) {
        pg8::Gemm g{HX, WIN + (size_t)N1 * 1024, MLAT, NG, 1024}; pg8::StaticOrder S; S.init(MLAT, NG, G, bid);
        pg8::Epi5 E{YR, AQ, U1, U2, SSQ};
        pg8::gemm_phase<pg8::Epi5, pg8::StaticOrder, true, true>((PG8_LAS unsigned char*)lds, g, S, E);
        if (BOTH(6)) GRID_BAR();
    }
    if (IN(7)) {
        pg8::Gemm g{YR, WOR, MLAT, 1024, 2048}; pg8::StaticOrder S; S.init(MLAT, 1024, G, bid);
        pg8::Epi6 E{U1};
        pg8::gemm_phase<pg8::Epi6, pg8::StaticOrder, true, true>((PG8_LAS unsigned char*)lds, g, S, E);
    }
    if (IN(8)) {
        pg8::Gemm g{AQ, WOA, MLAT, 1024, 1024}; pg8::StaticOrder S; S.init(MLAT, 1024, G, bid);
        pg8::Epi7 E{U1, U2};
        pg8::gemm_phase<pg8::Epi7, pg8::StaticOrder, true, true>((PG8_LAS unsigned char*)lds, g, S, E);
        if (BOTH(8)) GRID_BAR();
    }
    if (IN(9)) {
        pg8::Gemm g{U1, WOUT, MLAT, 1024, 1024}; pg8::StaticOrder S; S.init(MLAT, 1024, G, bid);
        pg8::Epi8 E{x, MOD, args.out};
        pg8::gemm_phase<pg8::Epi8, pg8::StaticOrder, true, true>((PG8_LAS unsigned char*)lds, g, S, E);
    }
#undef IN
#undef BOTH
}

extern "C" void kernel_launch(void* const* d_in, const int* in_sizes, int n_in, void* d_out, int out_size, void* d_ws, size_t ws_size, hipStream_t stream) {
    static int grid = 0;
    if (grid == 0) {
        if (n_in != 14 || in_sizes[0] != MLAT * DM || out_size != MLAT * DM || ws_size < WS_END) {
            fprintf(stderr, "kernel_launch: unexpected shapes: n_in %d in0 %d out %d ws %zu (need >= %zu)\n", n_in, n_in > 0 ? in_sizes[0] : -1, out_size, ws_size, (size_t)WS_END); grid = -1; return; }
        int dev = 0, cus = 0;
        if (hipGetDevice(&dev) != hipSuccess || hipDeviceGetAttribute(&cus, hipDeviceAttributeMultiprocessorCount, dev) != hipSuccess) { grid = -1; return; }
        if (hipFuncSetAttribute((const void*)mk_fwd, hipFuncAttributeMaxDynamicSharedMemorySize, LDS_BYTES) != hipSuccess) { fprintf(stderr, "kernel_launch: hipFuncSetAttribute failed\n"); grid = -1; return; }
        grid = cus;
    }
    if (grid < 0) return;
    Args a{};
    for (int i = 0; i < 14; ++i) a.in[i] = (const float*)d_in[i];
    a.out = (float*)d_out; a.ws = (unsigned char*)d_ws;
#if MK_ONE_LAUNCH
    a.ph_lo = 0; a.ph_hi = N_PHASES;
#if MK_BARRIER == 1
    if (hipMemsetAsync((char*)d_ws + WS_CTL, 0, CTL_ZERO_BYTES, stream) != hipSuccess) { fprintf(stderr, "kernel_launch: hipMemsetAsync failed\n"); return; }
    hipLaunchKernelGGL(mk_fwd, dim3(grid), dim3(NTHR), LDS_BYTES, stream, a);
#else
    void* kargs[] = {&a};
    const hipError_t ce = hipLaunchCooperativeKernel((const void*)mk_fwd, dim3(grid), dim3(NTHR), kargs, LDS_BYTES, stream);
    if (ce != hipSuccess) fprintf(stderr, "kernel_launch: cooperative launch failed: %s\n", hipGetErrorName(ce));
#endif
#else
    for (int ph = 0; ph < N_PHASES; ++ph) {
        a.ph_lo = ph; a.ph_hi = ph + 1;
        hipLaunchKernelGGL(mk_fwd, dim3(grid), dim3(NTHR), LDS_BYTES, stream, a);
    }
#endif
    const hipError_t le = hipPeekAtLastError();
    if (le != hipSuccess) fprintf(stderr, "kernel_launch: launch failed: %s\n", hipGetErrorName(le));
}
```

```cpp
#include <hip/hip_runtime.h>
#include <cstdio>
#include <cstdint>
#include <hip/hip_cooperative_groups.h>

constexpr int NB = 16, SEQ = 2048, DM = 1024, LC = 256, LT = LC + SEQ;
constexpr int MLAT = NB * SEQ, MCTX = NB * LC, MALL = MLAT + MCTX;
constexpr int RH = 4, RDK = 256, RDV = 512;
constexpr int AH = 8, AKV = 2, AHD = 128;
constexpr int NIN = 10752, NKV = 3584, N1 = 5632, NG = 5120;
constexpr float EPS = 1e-6f;

typedef unsigned short bf16_t;
typedef unsigned v4u __attribute__((ext_vector_type(4)));
typedef unsigned v2u __attribute__((ext_vector_type(2)));
typedef float v4f __attribute__((ext_vector_type(4)));
typedef float v2f __attribute__((ext_vector_type(2)));

__device__ __forceinline__ float bf2f(unsigned h) { return __uint_as_float(h << 16); }
__device__ __forceinline__ unsigned f2bf(float f) { unsigned u = __float_as_uint(f); return (u + 0x7fffu + ((u >> 16) & 1u)) >> 16; }
__device__ __forceinline__ unsigned pk2(float lo, float hi) { return f2bf(lo) | (f2bf(hi) << 16); }
__device__ __forceinline__ float bflo(unsigned w) { return __uint_as_float(w << 16); }
__device__ __forceinline__ float bfhi(unsigned w) { return __uint_as_float(w & 0xffff0000u); }
__device__ __forceinline__ float fast_sigmoid(float x) { return __builtin_amdgcn_rcpf(1.0f + __builtin_amdgcn_exp2f(-1.4426950408889634f * x)); }
__device__ __forceinline__ float fast_silu(float x) { return x * fast_sigmoid(x); }
__device__ __forceinline__ float wave_sum(float v) {
#pragma unroll
    for (int o = 1; o < 64; o <<= 1) v += __shfl_xor(v, o);
    return v;
}

typedef __bf16 bf16x2_t __attribute__((ext_vector_type(2)));
__device__ __forceinline__ unsigned cvt_pk_bf16(float lo, float hi) { v2f v = {lo, hi}; bf16x2_t b = __builtin_convertvector(v, bf16x2_t); return __builtin_bit_cast(unsigned, b); }
__device__ __forceinline__ void unpack8(const v4u w, float (&o)[8]) {
    o[0] = bflo(w.x); o[1] = bfhi(w.x); o[2] = bflo(w.y); o[3] = bfhi(w.y); o[4] = bflo(w.z); o[5] = bfhi(w.z); o[6] = bflo(w.w); o[7] = bfhi(w.w);
}
__device__ __forceinline__ v4u pack8(const float (&o)[8]) {
    v4u w; w.x = cvt_pk_bf16(o[0], o[1]); w.y = cvt_pk_bf16(o[2], o[3]); w.z = cvt_pk_bf16(o[4], o[5]); w.w = cvt_pk_bf16(o[6], o[7]); return w;
}

constexpr size_t MiB = 1u << 20;
constexpr size_t WS_CTL = 0;
constexpr size_t WS_MOD = 1 * MiB;
constexpr size_t WS_ROPE = WS_MOD + 256 * 1024;
constexpr size_t WS_SSQ = 2 * MiB;
constexpr size_t WS_WIN = 4 * MiB;
constexpr size_t WS_WOR = 25 * MiB;
constexpr size_t WS_WOA = 29 * MiB;
constexpr size_t WS_WOUT = 31 * MiB;
constexpr size_t WS_HX = 33 * MiB;
constexpr size_t WS_RK = 105 * MiB;
constexpr size_t WS_RV = 177 * MiB;
constexpr size_t WS_RQ = 321 * MiB;
constexpr size_t WS_AK = 385 * MiB;
constexpr size_t WS_AV = 403 * MiB;
constexpr size_t WS_AQ = 421 * MiB;
constexpr size_t WS_END = 485 * MiB;
constexpr size_t WS_U1 = WS_RK;
constexpr size_t WS_U2 = WS_RV;

__host__ __device__ __forceinline__ int orig_col(int n) { return n < 4608 ? n : (n < 5632 ? n + 2048 : (n < 7680 ? n - 1024 : n)); }
namespace pg8 {
#define PG8_LAS __attribute__((address_space(3)))
typedef unsigned short bf16_t;
typedef short bf16x8 __attribute__((ext_vector_type(8)));
typedef float f32x4 __attribute__((ext_vector_type(4)));
typedef unsigned u32x4 __attribute__((ext_vector_type(4)));
constexpr int BM = 256, BK = 64, HALF = 128, HTB = HALF * BK * 2  , STAGE_BYTES = 8 * HTB, NXCD = 8, WGM = 8;

__host__ __device__ __forceinline__ int lds_byte(int r, int c) { const int st = (r >> 4) * 2 + (c >> 5), rr = r & 15, cc = c & 31, ob = rr * 64 + cc * 2; return st * 1024 + (ob ^ (((ob >> 9) & 1) << 5)); }
__host__ __device__ __forceinline__ void stage_rc(int b, int& R, int& C) { const int st = b / 1024, sb = b % 1024, swz = sb ^ (((sb >> 9) & 1) << 5); R = (st >> 1) * 16 + swz / 64; C = (st & 1) * 32 + (swz % 64) / 2; }
__host__ __device__ __forceinline__ int perm32(int rho) { const int n = rho >> 4, i = rho & 15; return 8 * (i >> 2) + 4 * n + (i & 3); }

struct Unit { int pm, pn; };
struct Gemm { const bf16_t* A; const bf16_t* Bt; int M, N, K; };

struct StaticOrder {
    int nM, nN, nwg, G, c;
    __host__ __device__ void init(int M, int N, int G_, int c_) { nM = M / BM; nN = N / BM; nwg = nM * nN; G = G_; c = c_; }
    __host__ __device__ bool next(int i, Unit& u) const {
        const long L = (long)i * G + c; if (L >= nwg) return false;
        int wgid = (int)L; { const int q = nwg / NXCD, r = nwg % NXCD, xcd = wgid % NXCD, off = wgid / NXCD; wgid = (xcd < r ? xcd * (q + 1) : r * (q + 1) + (xcd - r) * q) + off; }
        const int nig = WGM * nN, gid = wgid / nig, fm = gid * WGM, gsz = (nM - fm) < WGM ? (nM - fm) : WGM;
        u.pm = fm + ((wgid % nig) % gsz); u.pn = (wgid % nig) / gsz; return true;
    }
    __device__ __forceinline__ void a_ready(const Unit&) const {}
    __device__ __forceinline__ void done(const Unit&) const {}
};


struct Sched1 {
    int G, c; StaticOrder so;
    __device__ void init(int G_, int c_) { G = G_; c = c_; so.init(MLAT, N1, G_, c_); }
    __device__ bool next(int i, Unit& u) const {
        long L = (long)i * G + c; if (L < 2816) return so.next(i, u);
        L -= 2816; if (L >= 224) return false;
        u.pm = 128 + (int)(L & 15); u.pn = (int)(L >> 4); return true;
    }
    __device__ __forceinline__ void a_ready(const Unit&) const {}
    __device__ __forceinline__ void done(const Unit&) const {}
};

#define EPI_ROWS_BEGIN const int rt0 = wr * 64 + fr, ct0 = wc * 32 + 8 * fq; \
    _Pragma("unroll") for (int ai = 0; ai < 2; ++ai) _Pragma("unroll") for (int m = 0; m < 4; ++m) { const int rt = rt0 + ai * HALF + m * 16;
#define EPI_ROWS_END }

struct Epi1 {
    static constexpr bool PERM = true, AFTER_DRAIN = false;
    bf16_t *RK, *RV, *AK, *AV, *RQ, *AQ;
    __device__ __forceinline__ void operator()(const f32x4 (&acc)[2][2][4][2], const Unit& u, int wr, int wc, int fr, int fq) const {
        const int pm = u.pm, pn = u.pn;
        const int kvrow0 = pm < 128 ? ((pm >> 3) * LT + LC + (pm & 7) * 256) : ((pm - 128) * LT);
        bf16_t* base; int ld; float sc = 1.f;
        if (pn < 4) { base = RK + (size_t)kvrow0 * 1024 + pn * 256; ld = 1024; sc = 0.0625f; }
        else if (pn < 12) { base = RV + (size_t)kvrow0 * 2048 + (pn - 4) * 256; ld = 2048; }
        else if (pn == 12) { base = AK + (size_t)kvrow0 * 256; ld = 256; }
        else if (pn == 13) { base = AV + (size_t)kvrow0 * 256; ld = 256; }
        else if (pn < 18) { base = RQ + (size_t)pm * 256 * 1024 + (pn - 14) * 256; ld = 1024; }
        else { base = AQ + (size_t)pm * 256 * 1024 + (pn - 18) * 256; ld = 1024; }
        EPI_ROWS_BEGIN
            bf16_t* rowp = base + (size_t)rt * ld + ct0;
#pragma unroll
            for (int bj = 0; bj < 2; ++bj) { const f32x4 v0 = acc[ai][bj][m][0] * sc, v1 = acc[ai][bj][m][1] * sc;
                u32x4 w; w.x = cvt_pk_bf16(v0[0], v0[1]); w.y = cvt_pk_bf16(v0[2], v0[3]); w.z = cvt_pk_bf16(v1[0], v1[1]); w.w = cvt_pk_bf16(v1[2], v1[3]);
                *(u32x4*)(rowp + bj * HALF) = w; }
        EPI_ROWS_END
    }
};

struct Epi5 {
    static constexpr bool PERM = true, AFTER_DRAIN = false;
    bf16_t *YR, *YA, *U1, *U2; const float* SSQ;
    __device__ __forceinline__ void operator()(const f32x4 (&acc)[2][2][4][2], const Unit& u, int wr, int wc, int fr, int fq) const {
        const int pn = u.pn; const size_t row0 = (size_t)u.pm * 256;
        if (pn < 8) {
            const int head = pn >> 1;
            EPI_ROWS_BEGIN
                const size_t row = row0 + rt;
                const float ss = SSQ[row * 8 + head * 2] + SSQ[row * 8 + head * 2 + 1];
                const float rstd = __builtin_amdgcn_rsqf(ss * (1.0f / 512.0f) + EPS);
#pragma unroll
                for (int bj = 0; bj < 2; ++bj) { u32x4* p = (u32x4*)(YR + row * 2048 + pn * 256 + bj * HALF + ct0); float o[8]; unpack8(*p, o);
                    const f32x4 v0 = acc[ai][bj][m][0], v1 = acc[ai][bj][m][1];
#pragma unroll
                    for (int k = 0; k < 4; ++k) { o[k] = o[k] * rstd * fast_silu(v0[k]); o[4 + k] = o[4 + k] * rstd * fast_silu(v1[k]); }
                    *p = pack8(o); }
            EPI_ROWS_END
        } else if (pn < 12) {
            EPI_ROWS_BEGIN
                const size_t row = row0 + rt;
#pragma unroll
                for (int bj = 0; bj < 2; ++bj) { u32x4* p = (u32x4*)(YA + row * 1024 + (pn - 8) * 256 + bj * HALF + ct0); float o[8]; unpack8(*p, o);
                    const f32x4 v0 = acc[ai][bj][m][0], v1 = acc[ai][bj][m][1];
#pragma unroll
                    for (int k = 0; k < 4; ++k) { o[k] = o[k] * fast_silu(v0[k]); o[4 + k] = o[4 + k] * fast_silu(v1[k]); }
                    *p = pack8(o); }
            EPI_ROWS_END
        } else {
            bf16_t* U = pn < 16 ? U1 + (pn - 12) * 256 : U2 + (pn - 16) * 256;
            EPI_ROWS_BEGIN
                const size_t row = row0 + rt;
#pragma unroll
                for (int bj = 0; bj < 2; ++bj) { float o[8]; const f32x4 v0 = acc[ai][bj][m][0], v1 = acc[ai][bj][m][1];
#pragma unroll
                    for (int k = 0; k < 4; ++k) { o[k] = fast_sigmoid(v0[k]); o[4 + k] = fast_sigmoid(v1[k]); }
                    *(u32x4*)(U + row * 1024 + bj * HALF + ct0) = pack8(o); }
            EPI_ROWS_END
        }
    }
};

struct Epi6 {
    static constexpr bool PERM = true, AFTER_DRAIN = false;
    bf16_t* U1;
    __device__ __forceinline__ void operator()(const f32x4 (&acc)[2][2][4][2], const Unit& u, int wr, int wc, int fr, int fq) const {
        const size_t row0 = (size_t)u.pm * 256; const int c0 = u.pn * 256;
        EPI_ROWS_BEGIN
            const size_t row = row0 + rt;
#pragma unroll
            for (int bj = 0; bj < 2; ++bj) { u32x4* p = (u32x4*)(U1 + row * 1024 + c0 + bj * HALF + ct0); float o[8]; unpack8(*p, o);
                const f32x4 v0 = acc[ai][bj][m][0], v1 = acc[ai][bj][m][1];
#pragma unroll
                for (int k = 0; k < 4; ++k) { o[k] *= v0[k]; o[4 + k] *= v1[k]; }
                *p = pack8(o); }
        EPI_ROWS_END
    }
};
struct Epi7 {
    static constexpr bool PERM = true, AFTER_DRAIN = false;
    bf16_t* U1; const bf16_t* U2;
    __device__ __forceinline__ void operator()(const f32x4 (&acc)[2][2][4][2], const Unit& u, int wr, int wc, int fr, int fq) const {
        const size_t row0 = (size_t)u.pm * 256; const int c0 = u.pn * 256;
        EPI_ROWS_BEGIN
            const size_t row = row0 + rt;
#pragma unroll
            for (int bj = 0; bj < 2; ++bj) { const size_t off = row * 1024 + c0 + bj * HALF + ct0; u32x4* p = (u32x4*)(U1 + off); float o[8], g[8]; unpack8(*p, o); unpack8(*(const u32x4*)(U2 + off), g);
                const f32x4 v0 = acc[ai][bj][m][0], v1 = acc[ai][bj][m][1];
#pragma unroll
                for (int k = 0; k < 4; ++k) { o[k] += g[k] * v0[k]; o[4 + k] += g[4 + k] * v1[k]; }
                *p = pack8(o); }
        EPI_ROWS_END
    }
};
struct Epi8 {
    static constexpr bool PERM = true, AFTER_DRAIN = false;
    const float* X; const float* MOD; float* OUT;
    __device__ __forceinline__ void operator()(const f32x4 (&acc)[2][2][4][2], const Unit& u, int wr, int wc, int fr, int fq) const {
        const size_t row0 = (size_t)u.pm * 256; const int c0 = u.pn * 256; const float* gate = MOD + (size_t)(u.pm >> 3) * 3072 + 2048;
        EPI_ROWS_BEGIN
            const size_t row = row0 + rt;
#pragma unroll
            for (int bj = 0; bj < 2; ++bj) { const int col = c0 + bj * HALF + ct0; const size_t off = row * 1024 + col;
#pragma unroll
                for (int n = 0; n < 2; ++n) { const f32x4 xv = *(const f32x4*)(X + off + 4 * n), gv = *(const f32x4*)(gate + col + 4 * n);
                    *(f32x4*)(OUT + off + 4 * n) = xv + gv * acc[ai][bj][m][n]; } }
        EPI_ROWS_END
    }
};
template <class Epi, class Sched, bool ALIGN_EPI = false, bool SP2 = false>
__device__ __forceinline__ void gemm_phase(PG8_LAS unsigned char* lds, const Gemm g, const Sched& S, const Epi& E) {
    const int tid = threadIdx.x, wid = __builtin_amdgcn_readfirstlane(tid >> 6), lane = tid & 63, wr = wid >> 2, wc = wid & 3, fr = lane & 15, fq = lane >> 4;
    const int K = g.K, nt = K / BK;
    unsigned voffA[2], voffB[2];
#pragma unroll
    for (int i = 0; i < 2; ++i) { int R, C; stage_rc(tid * 16 + i * 8192, R, C); const int Rb = Epi::PERM ? ((R & ~31) + perm32(R & 31)) : R;
        voffA[i] = (unsigned)(R * K + C) * 2u; voffB[i] = (unsigned)(Rb * K + C) * 2u; }
    const size_t kstep = (size_t)(BK * 2);
    const size_t hstep = (size_t)HALF * K * 2;
    const size_t tstep = 2 * hstep;
    const unsigned ldsw = (unsigned)wid * 1024u;
    const int aoff = lds_byte(wr * 64 + fr, fq * 8), boff = lds_byte(wc * 32 + fr, fq * 8);
#define PG8_SA(b, h) (((b) * 2 + (h)) * HTB)
#define PG8_SB(b, h) ((4 + (b) * 2 + (h)) * HTB)
#define PG8_STAGE(bufoff, gbase, voff) do { _Pragma("unroll") for (int _i = 0; _i < 2; ++_i) \
        __builtin_amdgcn_global_load_lds((const unsigned*)((const char*)(gbase) + (voff)[_i]), (PG8_LAS unsigned*)(lds + (bufoff) + ldsw + _i * 8192), 16, 0, 0); } while (0)
#define PG8_LDA(dst, b, h) do { _Pragma("unroll") for (int m = 0; m < 4; ++m) _Pragma("unroll") for (int k = 0; k < 2; ++k) dst[m][k] = *(const PG8_LAS bf16x8*)(lds + PG8_SA(b, h) + aoff + m * 2048 + k * 1024); } while (0)
#define PG8_LDB(dst, b, h) do { _Pragma("unroll") for (int n = 0; n < 2; ++n) _Pragma("unroll") for (int k = 0; k < 2; ++k) dst[n][k] = *(const PG8_LAS bf16x8*)(lds + PG8_SB(b, h) + boff + n * 2048 + k * 1024); } while (0)
#define PG8_MMA(ai, bj, At, Bt) do { __builtin_amdgcn_s_setprio(1); _Pragma("unroll") for (int m = 0; m < 4; ++m) _Pragma("unroll") for (int n = 0; n < 2; ++n) _Pragma("unroll") for (int k = 0; k < 2; ++k) \
        acc[ai][bj][m][n] = __builtin_amdgcn_mfma_f32_16x16x32_bf16(Bt[n][k], At[m][k], acc[ai][bj][m][n], 0, 0, 0); __builtin_amdgcn_s_setprio(0); } while (0)
#define PG8_WAIT_V(n) asm volatile("s_waitcnt vmcnt(" #n ")" ::: "memory")
#define PG8_WAIT_L(n) asm volatile("s_waitcnt lgkmcnt(" #n ")" ::: "memory")
#define PG8_BAR __builtin_amdgcn_s_barrier()
#define PG8_SCHED __builtin_amdgcn_sched_barrier(0)
    Unit cur, nxt; int ui = 0;
    if (!S.next(0, cur)) return;
    f32x4 acc[2][2][4][2];
#pragma unroll
    for (int a = 0; a < 2; ++a)
#pragma unroll
        for (int b = 0; b < 2; ++b)
#pragma unroll
            for (int m = 0; m < 4; ++m)
#pragma unroll
                for (int n = 0; n < 2; ++n) acc[a][b][m][n] = (f32x4){0.f, 0.f, 0.f, 0.f};
    bf16x8 At[4][2], B0[2][2], B1[2][2];
    const char* cA = (const char*)g.A + (size_t)cur.pm * tstep; const char* cB = (const char*)g.Bt + (size_t)cur.pn * tstep;
    S.a_ready(cur);
    if constexpr (SP2) {
        PG8_STAGE(PG8_SB(0, 0), cB, voffB); PG8_STAGE(PG8_SB(0, 1), cB + hstep, voffB); PG8_STAGE(PG8_SA(0, 0), cA, voffA); PG8_STAGE(PG8_SA(0, 1), cA + hstep, voffA);
        if (wr == 1) PG8_BAR;
        PG8_WAIT_V(2); PG8_BAR;
        PG8_STAGE(PG8_SB(1, 0), cB + kstep, voffB); PG8_STAGE(PG8_SA(1, 0), cA + kstep, voffA); PG8_STAGE(PG8_SB(1, 1), cB + hstep + kstep, voffB);
        PG8_WAIT_V(6); PG8_BAR;
    } else {
        PG8_STAGE(PG8_SB(0, 0), cB, voffB); PG8_STAGE(PG8_SA(0, 0), cA, voffA); PG8_STAGE(PG8_SB(0, 1), cB + hstep, voffB); PG8_STAGE(PG8_SA(0, 1), cA + hstep, voffA);
        if (wr == 1) PG8_BAR;
        PG8_WAIT_V(4); PG8_BAR;
        PG8_STAGE(PG8_SB(1, 0), cB + kstep, voffB); PG8_STAGE(PG8_SA(1, 0), cA + kstep, voffA); PG8_STAGE(PG8_SB(1, 1), cB + hstep + kstep, voffB);
        PG8_WAIT_V(6); PG8_BAR;
    }
    for (;;) {
        const bool has_next = S.next(ui + 1, nxt);
        const char* nA = has_next ? (const char*)g.A + (size_t)nxt.pm * tstep : cA; const char* nB = has_next ? (const char*)g.Bt + (size_t)nxt.pn * tstep : cB;
        for (int t = 0; t < nt; t += 2) {
            const bool last = (t == nt - 2);
            const char* a1 = cA + (size_t)(t + 1) * kstep;
            const char* a2 = last ? nA : cA + (size_t)(t + 2) * kstep; const char* b2 = last ? nB : cB + (size_t)(t + 2) * kstep;
            const char* a3 = a2 + kstep; const char* b3 = b2 + kstep;
            if (last && has_next) S.a_ready(nxt);
            if constexpr (SP2) {
            PG8_LDB(B0, 0, 0); PG8_LDB(B1, 0, 1); PG8_SCHED; PG8_LDA(At, 0, 0); PG8_STAGE(PG8_SA(1, 1), a1 + hstep, voffA);
            PG8_WAIT_V(8); PG8_WAIT_L(0); PG8_BAR; PG8_MMA(0, 0, At, B0); PG8_MMA(0, 1, At, B1); PG8_BAR; PG8_SCHED;
            PG8_LDA(At, 0, 1); PG8_STAGE(PG8_SB(0, 0), b2, voffB); PG8_STAGE(PG8_SB(0, 1), b2 + hstep, voffB); PG8_STAGE(PG8_SA(0, 0), a2, voffA);
            PG8_WAIT_V(8); PG8_WAIT_L(0); PG8_BAR; PG8_MMA(1, 0, At, B0); PG8_MMA(1, 1, At, B1); PG8_BAR; PG8_SCHED;
            PG8_LDB(B0, 1, 0); PG8_LDB(B1, 1, 1); PG8_SCHED; PG8_LDA(At, 1, 0); PG8_STAGE(PG8_SA(0, 1), a2 + hstep, voffA);
            PG8_WAIT_V(8); PG8_WAIT_L(0); PG8_BAR; PG8_MMA(0, 0, At, B0); PG8_MMA(0, 1, At, B1); PG8_BAR; PG8_SCHED;
            PG8_LDA(At, 1, 1); PG8_STAGE(PG8_SB(1, 0), b3, voffB); PG8_STAGE(PG8_SB(1, 1), b3 + hstep, voffB); PG8_STAGE(PG8_SA(1, 0), a3, voffA);
            PG8_WAIT_V(8); PG8_WAIT_L(0); PG8_BAR; PG8_MMA(1, 0, At, B0); PG8_MMA(1, 1, At, B1); PG8_BAR; PG8_SCHED;
            } else {
            PG8_LDB(B0, 0, 0); PG8_SCHED; PG8_LDA(At, 0, 0); PG8_STAGE(PG8_SA(1, 1), a1 + hstep, voffA);
            PG8_WAIT_L(8); PG8_BAR; PG8_WAIT_L(0); PG8_MMA(0, 0, At, B0); PG8_BAR; PG8_SCHED;
            PG8_LDB(B1, 0, 1); PG8_STAGE(PG8_SB(0, 0), b2, voffB);
            PG8_BAR; PG8_WAIT_L(0); PG8_MMA(0, 1, At, B1); PG8_BAR;
            PG8_LDA(At, 0, 1); PG8_STAGE(PG8_SA(0, 0), a2, voffA);
            PG8_BAR; PG8_WAIT_L(0); PG8_MMA(1, 0, At, B0); PG8_BAR; PG8_SCHED;
            PG8_STAGE(PG8_SB(0, 1), b2 + hstep, voffB);
            PG8_WAIT_V(6); PG8_BAR; PG8_MMA(1, 1, At, B1); PG8_BAR;
            PG8_LDB(B0, 1, 0); PG8_SCHED; PG8_LDA(At, 1, 0); PG8_STAGE(PG8_SA(0, 1), a2 + hstep, voffA);
            PG8_WAIT_L(8); PG8_BAR; PG8_WAIT_L(0); PG8_MMA(0, 0, At, B0); PG8_BAR; PG8_SCHED;
            PG8_LDB(B1, 1, 1); PG8_STAGE(PG8_SB(1, 0), b3, voffB);
            PG8_BAR; PG8_WAIT_L(0); PG8_MMA(0, 1, At, B1); PG8_BAR;
            PG8_LDA(At, 1, 1); PG8_STAGE(PG8_SA(1, 0), a3, voffA);
            PG8_BAR; PG8_WAIT_L(0); PG8_MMA(1, 0, At, B0); PG8_BAR; PG8_SCHED;
            PG8_STAGE(PG8_SB(1, 1), b3 + hstep, voffB);
            PG8_WAIT_V(6); PG8_BAR; PG8_MMA(1, 1, At, B1); PG8_BAR;
            }
        }
        if constexpr (ALIGN_EPI) { if (wr == 0) PG8_BAR; }
        if constexpr (!Epi::AFTER_DRAIN) { E(acc, cur, wr, wc, fr, fq); S.done(cur); }
        if (!has_next) break;
#pragma unroll
        for (int a = 0; a < 2; ++a)
#pragma unroll
            for (int b = 0; b < 2; ++b)
#pragma unroll
                for (int m = 0; m < 4; ++m)
#pragma unroll
                    for (int n = 0; n < 2; ++n) acc[a][b][m][n] = (f32x4){0.f, 0.f, 0.f, 0.f};
        cur = nxt; cA = nA; cB = nB; ++ui;
        if constexpr (ALIGN_EPI) { if (wr == 1) PG8_BAR; }
    }
    PG8_WAIT_V(0);
    if constexpr (!ALIGN_EPI) { if (wr == 0) PG8_BAR; }
    PG8_BAR;
    if constexpr (Epi::AFTER_DRAIN) { E.fused(acc, cur, wr, wc, fr, fq, lds, wid, lane); S.done(cur); }
#undef PG8_SA
#undef PG8_SB
#undef PG8_STAGE
#undef PG8_LDA
#undef PG8_LDB
#undef PG8_MMA
#undef PG8_WAIT_V
#undef PG8_WAIT_L
#undef PG8_BAR
#undef PG8_SCHED
}
}

namespace attn {
constexpr int   D = 128, NW = 8, QBLK = 32, KVBLK = 64;
constexpr float SCALE = 0.088388347648318440f;
constexpr float THR = 8.f;
constexpr int SDEPTH = 2;
constexpr int LDQ = 1024, LDK = 256, LDO = 1024;
constexpr size_t SHM_V = KVBLK * D * 2, SHM_K = KVBLK * D * 2, SHM_ATTN = 2 * SHM_V + 2 * SHM_K + NW * 64 * 4;
typedef unsigned short bf16;
using bf16x8 = __attribute__((ext_vector_type(8))) short;
using s16x4  = __attribute__((ext_vector_type(4))) short;
using f32x16 = __attribute__((ext_vector_type(16))) float;
using f32x8  = __attribute__((ext_vector_type(8))) float;
using u32x4  = __attribute__((ext_vector_type(4))) unsigned;
#define KSWZ(row, colB) ((row) * 256 + ((colB) ^ (((row) & 7) << 4)))
#define SBAR() __builtin_amdgcn_sched_barrier(0)
__device__ __forceinline__ int crow(int r, int hi) { return (r & 3) + 8 * (r >> 2) + 4 * hi; }
__device__ __forceinline__ unsigned cvtpk(float lo, float hi) { return cvt_pk_bf16(lo, hi); }
template <typename TIn> struct Stage;
template <> struct Stage<bf16>  { using T = bf16x8;
  __device__ static __forceinline__ T ld8(const bf16* p) { return *reinterpret_cast<const bf16x8*>(p); }
  __device__ static __forceinline__ bf16x8 tobf(T x) { return x; } };
__device__ __forceinline__ void partialSM(f32x16& p0, f32x16& p1, float& m_reg, float& mn, float& alpha) {
  constexpr float C = SCALE * 1.4426950408889634f;
  float pmax = p0[0]; for (int r = 1; r < 16; ++r) pmax = fmaxf(pmax, p0[r]); for (int r = 0; r < 16; ++r) pmax = fmaxf(pmax, p1[r]);
  { auto rr = __builtin_amdgcn_permlane32_swap(__float_as_uint(pmax), __float_as_uint(pmax), false, false);
    pmax = fmaxf(__uint_as_float(rr[0]), __uint_as_float(rr[1])); }
  if (__builtin_expect(__all(pmax - m_reg <= THR / SCALE), 1)) { mn = m_reg; alpha = 1.f; }
  else { mn = fmaxf(m_reg, pmax); alpha = __builtin_amdgcn_exp2f((m_reg - mn) * C); m_reg = mn; }
  float mnC = -mn * C;
  for (int r = 0; r < 16; ++r) p0[r] = fmaf(p0[r], C, mnC); for (int r = 0; r < 16; ++r) p1[r] = fmaf(p1[r], C, mnC);
  for (int r = 0; r < 16; ++r) p0[r] = __builtin_amdgcn_exp2f(p0[r]);
}
__device__ __forceinline__ void finishSM(f32x16& p0, f32x16& p1, float alpha, float& l_reg, bf16x8& pa0, bf16x8& pa1, bf16x8& pa2, bf16x8& pa3) {
  for (int r = 0; r < 16; ++r) p1[r] = __builtin_amdgcn_exp2f(p1[r]);
  float ps = 0; for (int r = 0; r < 16; ++r) ps += p0[r]; for (int r = 0; r < 16; ++r) ps += p1[r];
  { auto rr = __builtin_amdgcn_permlane32_swap(__float_as_uint(ps), __float_as_uint(ps), false, false);
    ps = __uint_as_float(rr[0]) + __uint_as_float(rr[1]); }
  l_reg = l_reg * alpha + ps;
#define PK4(P, BASE, OUT) do { unsigned a0 = cvtpk(P[BASE + 0], P[BASE + 1]), a1 = cvtpk(P[BASE + 2], P[BASE + 3]);   \
    unsigned b0 = cvtpk(P[BASE + 4], P[BASE + 5]), b1 = cvtpk(P[BASE + 6], P[BASE + 7]);                              \
    auto r0 = __builtin_amdgcn_permlane32_swap(a0, b0, false, false); auto r1 = __builtin_amdgcn_permlane32_swap(a1, b1, false, false); \
    u32x4 w = {r0[0], r1[0], r0[1], r1[1]}; OUT = *reinterpret_cast<bf16x8*>(&w); } while (0)
  PK4(p0, 0, pa0); PK4(p0, 8, pa1); PK4(p1, 0, pa2); PK4(p1, 8, pa3);
#undef PK4
}
__device__ __forceinline__ void qkt(f32x16& p0, f32x16& p1, const bf16* Ks, const bf16x8* qr, int r32, int hi) {
  p0 = f32x16{}; p1 = f32x16{};
  for (int d0 = 0; d0 < 8; ++d0) { int cb = (d0 * 16 + hi * 8) * 2;
    bf16x8 b0 = *reinterpret_cast<const bf16x8*>((const char*)Ks + KSWZ(r32, cb));
    bf16x8 b1 = *reinterpret_cast<const bf16x8*>((const char*)Ks + KSWZ(32 + r32, cb));
    p0 = __builtin_amdgcn_mfma_f32_32x32x16_bf16(b0, qr[d0], p0, 0, 0, 0);
    p1 = __builtin_amdgcn_mfma_f32_32x32x16_bf16(b1, qr[d0], p1, 0, 0, 0); }
}
__device__ __forceinline__ int v_st(int k, int c) { const int kk = (k & ~0xC) | ((k & 4) << 1) | ((k & 8) >> 1); return ((kk >> 3) * 4 + (c >> 5)) * 512 + ((kk & 7) * 32 + (c & 31)) * 2; }
__device__ __forceinline__ int v_rd_base(int lane) { return ((lane & 3) << 3) | (((lane >> 2) & 3) << 6) | (((lane >> 4) & 1) << 5) | (((lane >> 5) & 1) << 8); }
constexpr int v_rd_off(int d0, int ks, int half) { return d0 * 512 + ks * 4096 + half * 2048; }
template <int OFF> __device__ __forceinline__ s16x4 tr_read(int vb) {
  s16x4 r; asm volatile("ds_read_b64_tr_b16 %0, %1 offset:%2" : "=&v"(r) : "v"(vb), "i"(OFF) : "memory"); return r;
}
template <int D0> __device__ __forceinline__ void pv_one(f32x16& od, int vb, bf16x8 pa0, bf16x8 pa1, bf16x8 pa2, bf16x8 pa3) {
  const s16x4 l0 = tr_read<v_rd_off(D0, 0, 0)>(vb), h0 = tr_read<v_rd_off(D0, 0, 1)>(vb), l1 = tr_read<v_rd_off(D0, 1, 0)>(vb), h1 = tr_read<v_rd_off(D0, 1, 1)>(vb);
  const s16x4 l2 = tr_read<v_rd_off(D0, 2, 0)>(vb), h2 = tr_read<v_rd_off(D0, 2, 1)>(vb), l3 = tr_read<v_rd_off(D0, 3, 0)>(vb), h3 = tr_read<v_rd_off(D0, 3, 1)>(vb);
  asm volatile("s_waitcnt lgkmcnt(0)" ::: "memory"); SBAR();
#define PK(L, H) (bf16x8){L[0], L[1], L[2], L[3], H[0], H[1], H[2], H[3]}
  od = __builtin_amdgcn_mfma_f32_32x32x16_bf16(pa0, PK(l0, h0), od, 0, 0, 0);
  od = __builtin_amdgcn_mfma_f32_32x32x16_bf16(pa1, PK(l1, h1), od, 0, 0, 0);
  od = __builtin_amdgcn_mfma_f32_32x32x16_bf16(pa2, PK(l2, h2), od, 0, 0, 0);
  od = __builtin_amdgcn_mfma_f32_32x32x16_bf16(pa3, PK(l3, h3), od, 0, 0, 0);
#undef PK
}
__device__ __forceinline__ void pv_d0(f32x16* o, int vb, bf16x8 pa0, bf16x8 pa1, bf16x8 pa2, bf16x8 pa3) {
  pv_one<0>(o[0], vb, pa0, pa1, pa2, pa3); pv_one<1>(o[1], vb, pa0, pa1, pa2, pa3); pv_one<2>(o[2], vb, pa0, pa1, pa2, pa3); pv_one<3>(o[3], vb, pa0, pa1, pa2, pa3);
}

template <typename TQ>
__device__ __forceinline__ void attn_dense_body(const TQ* Qb, const bf16* __restrict__ Kh, const bf16* __restrict__ Vh,
                                                bf16* Ob, int seq, char* lds) {
  using St = Stage<bf16>; using SQ = Stage<TQ>;
  const int tid = threadIdx.x, wid = tid >> 6, lane = tid & 63, r32 = lane & 31, hi = lane >> 5;
  bf16* V_lds = (bf16*)lds; bf16* K_lds = (bf16*)(lds + 2 * SHM_V);
  float* ws = (float*)(lds + 2 * SHM_V + 2 * SHM_K) + wid * 64; float* li_l = ws; float* al_l = ws + 32;
  float m_reg = -1e30f, l_reg = 0; f32x16 o[4] = {}; bf16x8 qr[8];
  const TQ* Qw = Qb + (long)(wid * QBLK + r32) * LDQ + hi * 8;
#pragma unroll
  for (int d0 = 0; d0 < 8; ++d0) qr[d0] = SQ::tobf(SQ::ld8(Qw + d0 * 16));
  const int sr = tid >> 4, sc = (tid & 15) * 8, vst0 = v_st(sr, sc), vst1 = v_st(32 + sr, sc);
  const int vb0 = (int)(uintptr_t)V_lds + v_rd_base(lane);
  struct { typename St::T vs0, vs1, ks0, ks1; } sr_[SDEPTH];
#define SLOAD(i, k0) do { sr_[i].vs0 = St::ld8(&Vh[(long)((k0) + sr) * LDK + sc]); sr_[i].vs1 = St::ld8(&Vh[(long)((k0) + 32 + sr) * LDK + sc]); \
    sr_[i].ks0 = St::ld8(&Kh[(long)((k0) + sr) * LDK + sc]); sr_[i].ks1 = St::ld8(&Kh[(long)((k0) + 32 + sr) * LDK + sc]); } while (0)
#define SWRITE(b, i) do { *(bf16x8*)((char*)V_lds + (b) * SHM_V + vst0) = St::tobf(sr_[i].vs0);          \
    *(bf16x8*)((char*)V_lds + (b) * SHM_V + vst1) = St::tobf(sr_[i].vs1); int kc = sc * 2;               \
    *(bf16x8*)((char*)K_lds + (b) * SHM_K + KSWZ(sr, kc)) = St::tobf(sr_[i].ks0);                       \
    *(bf16x8*)((char*)K_lds + (b) * SHM_K + KSWZ(32 + sr, kc)) = St::tobf(sr_[i].ks1); } while (0)
#define SWAIT() do { if constexpr (SDEPTH == 2) asm volatile("s_waitcnt vmcnt(4)" ::: "memory"); else asm volatile("s_waitcnt vmcnt(0)" ::: "memory"); } while (0)
#define RESC(a) do { if (__any((a) < 1.f)) { if (hi == 0) al_l[r32] = (a); asm volatile("s_waitcnt lgkmcnt(0)" ::: "memory"); \
    for (int d = 0; d < 4; ++d) for (int r = 0; r < 16; ++r) o[d][r] *= al_l[crow(r, hi)]; } } while (0)
  f32x16 pA0, pA1, pB0, pB1; float mnA, mnB, alA, alB; bf16x8 pa0, pa1, pa2, pa3; const int NT = seq / KVBLK;
  constexpr int SE = 0, SO = SDEPTH - 1;
  SLOAD(SE, 0); asm volatile("s_waitcnt vmcnt(0)" ::: "memory"); SWRITE(0, SE); __syncthreads();
  qkt(pA0, pA1, K_lds, qr, r32, hi); partialSM(pA0, pA1, m_reg, mnA, alA);
  SLOAD(SO, KVBLK); if constexpr (SDEPTH == 2) { if (2 < NT) SLOAD(SE, 2 * KVBLK); }
  SWAIT(); SWRITE(1, SO); __syncthreads();
  for (int j = 1; j + 1 < NT; j += 2) {
    SBAR(); qkt(pB0, pB1, (bf16*)((char*)K_lds + SHM_K), qr, r32, hi);
    finishSM(pA0, pA1, alA, l_reg, pa0, pa1, pa2, pa3); SBAR();
    SLOAD(SO, (j + SDEPTH) * KVBLK); SBAR();
    pv_d0(o, vb0, pa0, pa1, pa2, pa3); partialSM(pB0, pB1, m_reg, mnB, alB);
    __syncthreads(); SWAIT(); SWRITE(0, SE);
    RESC(alB); __syncthreads();
    SBAR(); qkt(pA0, pA1, K_lds, qr, r32, hi);
    finishSM(pB0, pB1, alB, l_reg, pa0, pa1, pa2, pa3); SBAR();
    if (SDEPTH == 1 || j + 3 < NT) SLOAD(SE, (j + 1 + SDEPTH) * KVBLK); SBAR();
    pv_d0(o, vb0 + (int)SHM_V, pa0, pa1, pa2, pa3); partialSM(pA0, pA1, m_reg, mnA, alA);
    __syncthreads(); SWAIT(); SWRITE(1, SO);
    RESC(alA); __syncthreads();
  }
  SBAR(); qkt(pB0, pB1, (bf16*)((char*)K_lds + SHM_K), qr, r32, hi);
  finishSM(pA0, pA1, alA, l_reg, pa0, pa1, pa2, pa3); SBAR();
  pv_d0(o, vb0, pa0, pa1, pa2, pa3); partialSM(pB0, pB1, m_reg, mnB, alB);
  __syncthreads(); RESC(alB);
  finishSM(pB0, pB1, alB, l_reg, pa0, pa1, pa2, pa3); SBAR();
  pv_d0(o, vb0 + (int)SHM_V, pa0, pa1, pa2, pa3);
  if (hi == 0) li_l[r32] = l_reg; asm volatile("s_waitcnt lgkmcnt(0)" ::: "memory");
  float rli[16];
#pragma unroll
  for (int r = 0; r < 16; ++r) rli[r] = __builtin_amdgcn_rcpf(li_l[crow(r, hi)]);
  bf16* Ow = Ob + (long)(wid * QBLK) * LDO;
#pragma unroll
  for (int r = 0; r < 16; ++r) { int orow = crow(r, hi);
    for (int d0 = 0; d0 < 4; ++d0) Ow[(long)orow * LDO + d0 * 32 + r32] = (bf16)f2bf(o[d0][r] * rli[r]); }
#undef SLOAD
#undef SWRITE
#undef SWAIT
#undef RESC
}

#undef KSWZ
#undef SBAR
}

constexpr int NWAVES = 8, NTHR = 512;
constexpr int RING_BYTES = 131072, LDS_BYTES = 147456;
#ifndef MK_ONE_LAUNCH
#define MK_ONE_LAUNCH 1
#endif
constexpr int N_PHASES = 10;
#define LDS_WAIT() asm volatile("s_waitcnt lgkmcnt(0)" ::: "memory")
#define LAS __attribute__((address_space(3)))
constexpr int MISC_OFF = RING_BYTES + 320;
constexpr int CW_BAR = 4096;
constexpr size_t CTL_ZERO_BYTES = 65536;
#ifndef MK_NAIVE_ATTN
#define MK_NAIVE_ATTN 0
#endif
#ifndef MK_NAIVE_RET
#define MK_NAIVE_RET 1
#endif
#ifndef MK_BARRIER
#define MK_BARRIER 1
#endif
#define XB_TMO      128
#define XB_XCNT(j)  (256  + 64 * (j))
#define XB_XSUB(j)  (1280 + 64 * (j))
#define XB_XGEN(j)  (2304 + 64 * (j))
#define XB_TOP      3328
#define XB_TOPGEN   3392
#define XCD_BAR_WORDS 3456
#define XB_SPIN_CAP (1u << 18)

__device__ __forceinline__ unsigned xb_ld(unsigned* p)              { return __hip_atomic_load(p, __ATOMIC_RELAXED, __HIP_MEMORY_SCOPE_AGENT); }
__device__ __forceinline__ unsigned xb_add(unsigned* p, unsigned v) { return __hip_atomic_fetch_add(p, v, __ATOMIC_RELAXED, __HIP_MEMORY_SCOPE_AGENT); }
__device__ __forceinline__ unsigned xb_xcc_id() { return (unsigned)__builtin_amdgcn_s_getreg((3 << 11) | 20) & 0xFu; }
#define XB_SPIN(cond, bar) do { unsigned _sp = 0; while (cond) { __builtin_amdgcn_s_sleep(1); \
    if ((++_sp & 255u) == 0u) { if (xb_ld(&(bar)[XB_TMO])) break; if (_sp > XB_SPIN_CAP) { atomicAdd(&(bar)[XB_TMO], 1u); break; } } } } while (0)

struct XcdBarrier {
    unsigned* bar; unsigned x;
    volatile LAS unsigned* st;
};

__device__ __forceinline__ XcdBarrier xcd_barrier_post(unsigned* bar, volatile LAS unsigned* st) {
    XcdBarrier b; b.bar = bar; b.x = xb_xcc_id(); b.st = st;
    if (threadIdx.x == 0) (void)xb_add(&bar[XB_XCNT(b.x)], 1u);
    return b;
}
__device__ __forceinline__ void xcd_barrier_complete(unsigned* bar, unsigned x, unsigned& nloc, unsigned& nx) {
    const unsigned G = gridDim.x * gridDim.y * gridDim.z;
    unsigned sum, cnt, mine, sp = 0u;
    for (;;) {
        sum = 0u; cnt = 0u; mine = 0u;
#pragma unroll
        for (unsigned j = 0; j < 16; ++j) { const unsigned c = xb_ld(&bar[XB_XCNT(j)]); sum += c; cnt += (c > 0u) ? 1u : 0u; mine = (j == x) ? c : mine; }
        if (sum == G) break;
        __builtin_amdgcn_s_sleep(1);
        if ((++sp & 255u) == 0u) { if (xb_ld(&bar[XB_TMO])) break; if (sp > XB_SPIN_CAP) { atomicAdd(&bar[XB_TMO], 1u); break; } }
    }
    nloc = mine > 0u ? mine : 1u; nx = cnt > 0u ? cnt : 1u;
}

__device__ __forceinline__ void xcd_barrier(const XcdBarrier& b) {
    asm volatile("s_waitcnt vmcnt(0)" ::: "memory");
    __syncthreads();
    if (threadIdx.x == 0) {
        unsigned* bar = b.bar;
        __builtin_amdgcn_s_waitcnt(0);
        unsigned nloc = b.st[0], nx = b.st[1];
        if (nloc == 0u) { xcd_barrier_complete(bar, b.x, nloc, nx); b.st[0] = nloc; b.st[1] = nx; }
        const unsigned old = xb_add(&bar[XB_XSUB(b.x)], 1u);
        const unsigned gen = old / nloc;
        if (old + 1u == (gen + 1u) * nloc) {
            __builtin_amdgcn_fence(__ATOMIC_RELEASE, "agent");
            asm volatile("s_waitcnt vmcnt(0)" ::: "memory");
            const unsigned og = xb_add(&bar[XB_TOP], 1u);
            const unsigned tg = og / nx;
            if (og + 1u == (tg + 1u) * nx) xb_add(&bar[XB_TOPGEN], 1u);
            else XB_SPIN(xb_ld(&bar[XB_TOPGEN]) == tg, bar);
            __builtin_amdgcn_fence(__ATOMIC_ACQUIRE, "agent");
            xb_add(&bar[XB_XGEN(b.x)], 1u);
            asm volatile("s_waitcnt vmcnt(0)" ::: "memory");
        } else {
            XB_SPIN(xb_ld(&bar[XB_XGEN(b.x)]) == gen, bar);
            __builtin_amdgcn_fence(__ATOMIC_ACQUIRE, "agent");
            asm volatile("s_waitcnt vmcnt(0)" ::: "memory");
        }
    }
    __syncthreads();
}


struct Args { const float* in[14]; float* out; unsigned char* ws; int ph_lo, ph_hi; };

__device__ __forceinline__ void p0_mod_item(const float* c, const float* c_ctx, const float* w_ada, const float* b_ada, float* MOD, float* ldsf, int item, int tid) {
    float* sc = ldsf; float* red = ldsf + 17 * 1024;
    for (int i = tid; i < 17 * 1024; i += NTHR) { const float v = i < 16 * 1024 ? c[i] : c_ctx[i - 16 * 1024]; sc[i] = v / (1.0f + expf(-v)); }
    __syncthreads();
    const int col = tid & 31, ks = tid >> 5, n = item * 32 + col;
    float acc[17];
#pragma unroll
    for (int r = 0; r < 17; ++r) acc[r] = 0.f;
    for (int k = ks * 64; k < ks * 64 + 64; ++k) { const float w = w_ada[(size_t)k * 3072 + n];
#pragma unroll
        for (int r = 0; r < 17; ++r) acc[r] += sc[r * 1024 + k] * w; }
#pragma unroll
    for (int r = 0; r < 17; ++r) red[(ks * 17 + r) * 32 + col] = acc[r];
    __syncthreads();
    for (int o = tid; o < 17 * 32; o += NTHR) { const int r = o >> 5, cc = o & 31; float s = b_ada[item * 32 + cc];
        for (int k2 = 0; k2 < 16; ++k2) s += red[(k2 * 17 + r) * 32 + cc];
        MOD[r * 3072 + item * 32 + cc] = s; }
    __syncthreads();
}
__device__ __forceinline__ void p0_transpose_item(const float* W, int K, int N, bf16_t* WT, int row_off, float* scr, int item, int lane) {
    const int nblk = N / 32, kb = item / nblk, nb = item % nblk, k0 = 64 * kb, n0 = 32 * nb;
#pragma unroll 8
    for (int i = 0; i < 32; ++i) { const int kk = 2 * i + (lane >> 5); scr[kk * 33 + (lane & 31)] = W[(size_t)(k0 + kk) * N + n0 + (lane & 31)]; }
    LDS_WAIT(); asm volatile("" ::: "memory");
    const int c = lane & 7;
#pragma unroll
    for (int j = 0; j < 4; ++j) { const int n = (lane >> 3) + 8 * j; const float* s = scr + (8 * c) * 33 + n;
        v4u o; o.x = pk2(s[0 * 33], s[1 * 33]); o.y = pk2(s[2 * 33], s[3 * 33]); o.z = pk2(s[4 * 33], s[5 * 33]); o.w = pk2(s[6 * 33], s[7 * 33]);
        *(v4u*)(WT + (size_t)(row_off + n0 + n) * K + k0 + 8 * c) = o; }
    LDS_WAIT(); asm volatile("" ::: "memory");
}
__device__ __forceinline__ int new_col(int o) { return o < 4608 ? o : (o < 6656 ? o + 1024 : (o < 7680 ? o - 2048 : o)); }

__device__ __forceinline__ void sincos_d(double a, float& c, float& s) {
    const double TWO_PI = 6.283185307179586476925;
    const double k = (double)(long long)(a / TWO_PI + (a >= 0 ? 0.5 : -0.5)); const double r = a - k * TWO_PI, r2 = r * r;
    double ts = r, ss = r, tc = 1.0, cc = 1.0;
    for (int n = 1; n <= 15; ++n) { tc *= -r2 / (double)((2 * n - 1) * (2 * n)); cc += tc; ts *= -r2 / (double)((2 * n) * (2 * n + 1)); ss += ts; }
    c = (float)cc; s = (float)ss;
}

__device__ __forceinline__ void p1_row(const float* xrow, const float* nw, const float* shift, const float* scale, bf16_t* orow, int lane) {
    const v4f* xr = (const v4f*)xrow + lane; v4f v[4]; float s = 0.f;
#pragma unroll
    for (int j = 0; j < 4; ++j) { v[j] = xr[64 * j]; s += (v[j].x * v[j].x + v[j].y * v[j].y) + (v[j].z * v[j].z + v[j].w * v[j].w); }
    const float rstd = 1.0f / sqrtf(wave_sum(s) * (1.0f / 1024.0f) + EPS);
    v2u* o8 = (v2u*)orow + lane;
#pragma unroll
    for (int j = 0; j < 4; ++j) { const v4f w = ((const v4f*)nw)[lane + 64 * j], sh = ((const v4f*)shift)[lane + 64 * j], sc = ((const v4f*)scale)[lane + 64 * j];
        const v4f y = v[j] * rstd * w * (sc + 1.0f) + sh; v2u o; o.x = pk2(y.x, y.y); o.y = pk2(y.z, y.w); o8[64 * j] = o; }
}

__device__ __forceinline__ void p3_item(bf16_t* buf, int ldlog2, bool isK, const float* nw, const float* ROPE, size_t item, int lane) {
    const size_t e = item * 512 + (size_t)lane * 8; const size_t row = e >> ldlog2; const int col = (int)(e & ((1u << ldlog2) - 1)), d0 = col & 127;
    float t[8]; unpack8(*(const v4u*)(buf + e), t);
    float ss = 0.f;
#pragma unroll
    for (int k = 0; k < 8; ++k) ss += t[k] * t[k];
    ss += __shfl_xor(ss, 1); ss += __shfl_xor(ss, 2); ss += __shfl_xor(ss, 4); ss += __shfl_xor(ss, 8);
    const float rstd = 1.0f / sqrtf(ss * (1.0f / 128.0f) + EPS);
#pragma unroll
    for (int k = 0; k < 8; ++k) t[k] = t[k] * rstd * nw[d0 + k];
    int l; bool rope = true;
    if (isK) { const int p = (int)(row % LT); rope = p >= LC; l = p - LC; } else l = (int)(row & (SEQ - 1));
    if (rope) { const int ri = l >> 6, ci = l & 63, p0 = d0 >> 1; const float* tab = p0 < 32 ? ROPE + (ri * 32 + p0) * 2 : ROPE + (ci * 32 + (p0 - 32)) * 2;
#pragma unroll
        for (int q = 0; q < 4; ++q) { const float cs = tab[2 * q], sn = tab[2 * q + 1], x0 = t[2 * q], x1 = t[2 * q + 1]; t[2 * q] = x0 * cs - x1 * sn; t[2 * q + 1] = x0 * sn + x1 * cs; } }
    *(v4u*)(buf + e) = pack8(t);
}

__device__ __forceinline__ void p4_naive_item(const bf16_t* RQ, const bf16_t* RK, const bf16_t* RV, bf16_t* YR, float* SSQ, const float* l2d, float* ldsf, int item, int tid) {
    const int rb = item & 255, h = (item >> 8) & 3, b = item >> 10, i0 = rb * 8;
    float* qs = ldsf; float* sc = ldsf + 2048; float* red = sc + 8 * LT;
    for (int t = tid; t < 2048; t += NTHR) { const int r = t >> 8, d = t & 255; qs[t] = bf2f(RQ[((size_t)(b * SEQ + i0 + r)) * 1024 + h * 256 + d]); }
    __syncthreads();
    const float lgf = log1pf(-exp2f(l2d[h])), lgb = log1pf(-exp2f(l2d[4 + h]));
    for (int p = tid; p < LT; p += NTHR) {
        const bf16_t* kr = RK + ((size_t)(b * LT + p)) * 1024 + h * 256;
        float dot[8];
#pragma unroll
        for (int r = 0; r < 8; ++r) dot[r] = 0.f;
        for (int d8 = 0; d8 < 32; ++d8) { float kk[8]; unpack8(*(const v4u*)(kr + d8 * 8), kk);
#pragma unroll
            for (int r = 0; r < 8; ++r)
#pragma unroll
                for (int k = 0; k < 8; ++k) dot[r] += qs[r * 256 + d8 * 8 + k] * kk[k]; }
#pragma unroll
        for (int r = 0; r < 8; ++r) { const int i = i0 + r; float W;
            if (p < LC) W = expf(lgf * (float)(i + LC - p)) + expf(lgb * (float)(SEQ - i + p));
            else { const int j = p - LC; W = (j <= i ? expf(lgf * (float)(i - j)) : 0.f) + (j >= i ? expf(lgb * (float)(j - i)) : 0.f); }
            sc[r * LT + p] = dot[r] * W; }
    }
    __syncthreads();
    float acc[8];
#pragma unroll
    for (int r = 0; r < 8; ++r) acc[r] = 0.f;
    const bf16_t* vp = RV + (size_t)(b * LT) * 2048 + h * 512 + tid;
    for (int p = 0; p < LT; ++p) { const float v = bf2f(vp[(size_t)p * 2048]);
#pragma unroll
        for (int r = 0; r < 8; ++r) acc[r] += sc[r * LT + p] * v; }
    const int wid = tid >> 6, lane = tid & 63;
#pragma unroll
    for (int r = 0; r < 8; ++r) { YR[((size_t)(b * SEQ + i0 + r)) * 2048 + h * 512 + tid] = (bf16_t)f2bf(acc[r]); const float s = wave_sum(acc[r] * acc[r]); if (lane == 0) red[r * 8 + wid] = s; }
    __syncthreads();
    if (tid < 16) { const int r = tid >> 1, hf = tid & 1; const float s = (red[r * 8 + hf * 4] + red[r * 8 + hf * 4 + 1]) + (red[r * 8 + hf * 4 + 2] + red[r * 8 + hf * 4 + 3]);
        SSQ[((size_t)(b * SEQ + i0 + r)) * 8 + h * 2 + hf] = s; }
    __syncthreads();
}

__device__ __forceinline__ void p5_naive_item(bf16_t* AQ, const bf16_t* AK, const bf16_t* AV, float* ldsf, int item, int tid) {
    const int rb = item & 255, head = (item >> 8) & 7, b = item >> 11, g = head >> 2, i0 = rb * 8;
    float* qs = ldsf; float* sc = ldsf + 1024;
    for (int t = tid; t < 1024; t += NTHR) { const int r = t >> 7, d = t & 127; qs[t] = bf2f(AQ[((size_t)(b * SEQ + i0 + r)) * 1024 + head * 128 + d]); }
    __syncthreads();
    for (int p = tid; p < LT; p += NTHR) {
        const bf16_t* kr = AK + ((size_t)(b * LT + p)) * 256 + g * 128;
        float dot[8];
#pragma unroll
        for (int r = 0; r < 8; ++r) dot[r] = 0.f;
        for (int d8 = 0; d8 < 16; ++d8) { float kk[8]; unpack8(*(const v4u*)(kr + d8 * 8), kk);
#pragma unroll
            for (int r = 0; r < 8; ++r)
#pragma unroll
                for (int k = 0; k < 8; ++k) dot[r] += qs[r * 128 + d8 * 8 + k] * kk[k]; }
#pragma unroll
        for (int r = 0; r < 8; ++r) sc[r * LT + p] = dot[r] * 0.08838834764831845f;
    }
    __syncthreads();
    { const int wid = tid >> 6, lane = tid & 63; float* row = sc + wid * LT; float m = -1e30f;
      for (int p = lane; p < LT; p += 64) m = fmaxf(m, row[p]);
#pragma unroll
      for (int o = 1; o < 64; o <<= 1) m = fmaxf(m, __shfl_xor(m, o));
      float s = 0.f;
      for (int p = lane; p < LT; p += 64) { const float ex = expf(row[p] - m); row[p] = ex; s += ex; }
      s = wave_sum(s); const float inv = 1.0f / s;
      for (int p = lane; p < LT; p += 64) row[p] *= inv; }
    __syncthreads();
    const int e = tid & 127, r0 = (tid >> 7) * 2; float a0 = 0.f, a1 = 0.f;
    const bf16_t* vp = AV + (size_t)(b * LT) * 256 + g * 128 + e;
    for (int p = 0; p < LT; ++p) { const float v = bf2f(vp[(size_t)p * 256]); a0 += sc[r0 * LT + p] * v; a1 += sc[(r0 + 1) * LT + p] * v; }
    AQ[((size_t)(b * SEQ + i0 + r0)) * 1024 + head * 128 + e] = (bf16_t)f2bf(a0);
    AQ[((size_t)(b * SEQ + i0 + r0 + 1)) * 1024 + head * 128 + e] = (bf16_t)f2bf(a1);
    __syncthreads();
}

__global__ void __launch_bounds__(NTHR, 2) mk_fwd(Args args) {
    extern __shared__ __attribute__((aligned(16))) unsigned char lds[];
    const int tid = threadIdx.x, lane = tid & 63, wave = __builtin_amdgcn_readfirstlane(tid >> 6);
    const int G = gridDim.x, bid = blockIdx.x;
    const int gw = bid * NWAVES + wave, NGW = G * NWAVES;
    float* ldsf = (float*)lds;
    unsigned char* ws = args.ws;
    const float *x = args.in[0], *cvec = args.in[1], *ctx = args.in[2], *c_ctx = args.in[3], *norm_w = args.in[4], *w_ada = args.in[5], *b_ada = args.in[6], *w_in = args.in[7],
                *l2d = args.in[8], *q_norm_w = args.in[9], *k_norm_w = args.in[10], *w_o_ret = args.in[11], *w_o_att = args.in[12], *w_out = args.in[13];
    float* MOD = (float*)(ws + WS_MOD); float* ROPE = (float*)(ws + WS_ROPE); float* SSQ = (float*)(ws + WS_SSQ);
    bf16_t *WIN = (bf16_t*)(ws + WS_WIN), *WOR = (bf16_t*)(ws + WS_WOR), *WOA = (bf16_t*)(ws + WS_WOA), *WOUT = (bf16_t*)(ws + WS_WOUT), *HX = (bf16_t*)(ws + WS_HX);
    bf16_t *RK = (bf16_t*)(ws + WS_RK), *RV = (bf16_t*)(ws + WS_RV), *RQ = (bf16_t*)(ws + WS_RQ), *AK = (bf16_t*)(ws + WS_AK), *AV = (bf16_t*)(ws + WS_AV), *AQ = (bf16_t*)(ws + WS_AQ);
    bf16_t *U1 = (bf16_t*)(ws + WS_U1), *U2 = (bf16_t*)(ws + WS_U2), *YR = (bf16_t*)args.out;
    const int lo = args.ph_lo, hi = args.ph_hi;
#define IN(k) (lo <= (k) && (k) < hi)
#define BOTH(k) (IN(k) && IN((k) + 1))
    if (tid < 32) ((LAS unsigned*)(lds + MISC_OFF))[tid] = 0u;
    __syncthreads();
#if MK_BARRIER == 1
    XcdBarrier bar; bar.bar = (unsigned*)(ws + WS_CTL) + CW_BAR; bar.x = 0; bar.st = nullptr;
    if (hi - lo > 1) bar = xcd_barrier_post((unsigned*)(ws + WS_CTL) + CW_BAR, (volatile LAS unsigned*)(lds + MISC_OFF) + 8);
#define GRID_BAR() xcd_barrier(bar)
#else
#define GRID_BAR() cooperative_groups::this_grid().sync()
#endif

    if (IN(0)) {
        for (int it = bid; it < 96; it += G) p0_mod_item(cvec, c_ctx, w_ada, b_ada, MOD, ldsf, it, tid);
        if (bid == G - 1) for (int t = tid; t < 2048; t += NTHR) { const int v = t >> 5, i = t & 31; double fd = 1.0; for (int k = 0; k < i; ++k) fd *= 0.7498942093324559;
            const float ang = (float)v * (float)fd; float cs, sn; sincos_d((double)ang, cs, sn); ROPE[2 * t] = cs; ROPE[2 * t + 1] = sn; }
        float* scr = ldsf + wave * (64 * 33);
        constexpr int I_IN = 16 * (NIN / 32), I_OR = 32 * 32, I_OA = 16 * 32, I_OUT = 16 * 32;
        for (int it = gw; it < I_IN + I_OR + I_OA + I_OUT; it += NGW) {
            int r = it;
            if (r < I_IN) { const int n0 = 32 * (r % (NIN / 32)); p0_transpose_item(w_in, 1024, NIN, WIN, new_col(n0) - n0, scr, r, lane); continue; } r -= I_IN;
            if (r < I_OR) { p0_transpose_item(w_o_ret, 2048, 1024, WOR, 0, scr, r, lane); continue; } r -= I_OR;
            if (r < I_OA) { p0_transpose_item(w_o_att, 1024, 1024, WOA, 0, scr, r, lane); continue; } r -= I_OA;
            p0_transpose_item(w_out, 1024, 1024, WOUT, 0, scr, r, lane);
        }
        if (BOTH(0)) GRID_BAR();
    }
    if (IN(1)) {
        for (int m = gw; m < MALL; m += NGW) {
            if (m < MLAT) { const int b = m >> 11; p1_row(x + (size_t)m * 1024, norm_w, MOD + b * 3072, MOD + b * 3072 + 1024, HX + (size_t)m * 1024, lane); }
            else p1_row(ctx + (size_t)(m - MLAT) * 1024, norm_w, MOD + 16 * 3072, MOD + 16 * 3072 + 1024, HX + (size_t)m * 1024, lane);
        }
        if (BOTH(1)) GRID_BAR();
    }
    if (IN(2)) {
        pg8::Gemm g{HX, WIN, MALL, N1, 1024}; pg8::Sched1 S; S.init(G, bid);
        pg8::Epi1 E{RK, RV, AK, AV, RQ, AQ};
        pg8::gemm_phase<pg8::Epi1, pg8::Sched1, true, true>((PG8_LAS unsigned char*)lds, g, S, E);
        if (BOTH(2)) GRID_BAR();
    }
    if (IN(3)) {
        constexpr size_t IQ = (size_t)MLAT * 1024 / 512, IK = (size_t)NB * LT * 256 / 512;
        for (size_t it = gw; it < IQ + IK; it += NGW) {
            if (it < IQ) p3_item(AQ, 10, false, q_norm_w, ROPE, it, lane); else p3_item(AK, 8, true, k_norm_w, ROPE, it - IQ, lane);
        }
        if (BOTH(3)) GRID_BAR();
    }
    if (IN(4)) {
        for (int it = bid; it < NB * RH * 256; it += G) p4_naive_item(RQ, RK, RV, YR, SSQ, l2d, ldsf, it, tid);
    }
    if (IN(5)) {
#if MK_NAIVE_ATTN
        for (int it = bid; it < NB * AH * 256; it += G) p5_naive_item(AQ, AK, AV, ldsf, it, tid);
#else
        const int vcu = (G % 8 == 0) ? (bid & 7) * (G >> 3) + (bid >> 3) : bid;
        for (int idx = vcu; idx < NB * AH * 8; idx += G) {
            const int qb = idx & 7, r = (idx >> 3) & 3, g = (idx >> 5) & 1, b = idx >> 6, head = g * 4 + r;
            bf16_t* Q = AQ + ((size_t)(b * SEQ + qb * 256)) * 1024 + head * 128;
            const bf16_t* K = AK + (size_t)(b * LT) * 256 + g * 128; const bf16_t* V = AV + (size_t)(b * LT) * 256 + g * 128;
            attn::attn_dense_body<attn::bf16>(Q, K, V, Q, LT, (char*)lds);
        }
#endif
        if (BOTH(5)) GRID_BAR();
    }
    if (IN(6)) {
        pg8::Gemm g{HX, WIN + (size_t)N1 * 1024, MLAT, NG, 1024}; pg8::StaticOrder S; S.init(MLAT, NG, G, bid);
        pg8::Epi5 E{YR, AQ, U1, U2, SSQ};
        pg8::gemm_phase<pg8::Epi5, pg8::StaticOrder, true, true>((PG8_LAS unsigned char*)lds, g, S, E);
        if (BOTH(6)) GRID_BAR();
    }
    if (IN(7)) {
        pg8::Gemm g{YR, WOR, MLAT, 1024, 2048}; pg8::StaticOrder S; S.init(MLAT, 1024, G, bid);
        pg8::Epi6 E{U1};
        pg8::gemm_phase<pg8::Epi6, pg8::StaticOrder, true, true>((PG8_LAS unsigned char*)lds, g, S, E);
    }
    if (IN(8)) {
        pg8::Gemm g{AQ, WOA, MLAT, 1024, 1024}; pg8::StaticOrder S; S.init(MLAT, 1024, G, bid);
        pg8::Epi7 E{U1, U2};
        pg8::gemm_phase<pg8::Epi7, pg8::StaticOrder, true, true>((PG8_LAS unsigned char*)lds, g, S, E);
        if (BOTH(8)) GRID_BAR();
    }
    if (IN(9)) {
        pg8::Gemm g{U1, WOUT, MLAT, 1024, 1024}; pg8::StaticOrder S; S.init(MLAT, 1024, G, bid);
        pg8::Epi8 E{x, MOD, args.out};
        pg8::gemm_phase<pg8::Epi8, pg8::StaticOrder, true, true>((PG8_LAS unsigned char*)lds, g, S, E);
    }
#undef IN
#undef BOTH
}

extern "C" void kernel_launch(void* const* d_in, const int* in_sizes, int n_in, void* d_out, int out_size, void* d_ws, size_t ws_size, hipStream_t stream) {
    static int grid = 0;
    if (grid == 0) {
        if (n_in != 14 || in_sizes[0] != MLAT * DM || out_size != MLAT * DM || ws_size < WS_END) {
            fprintf(stderr, "kernel_launch: unexpected shapes: n_in %d in0 %d out %d ws %zu (need >= %zu)\n", n_in, n_in > 0 ? in_sizes[0] : -1, out_size, ws_size, (size_t)WS_END); grid = -1; return; }
        int dev = 0, cus = 0;
        if (hipGetDevice(&dev) != hipSuccess || hipDeviceGetAttribute(&cus, hipDeviceAttributeMultiprocessorCount, dev) != hipSuccess) { grid = -1; return; }
        if (hipFuncSetAttribute((const void*)mk_fwd, hipFuncAttributeMaxDynamicSharedMemorySize, LDS_BYTES) != hipSuccess) { fprintf(stderr, "kernel_launch: hipFuncSetAttribute failed\n"); grid = -1; return; }
        grid = cus;
    }
    if (grid < 0) return;
    Args a{};
    for (int i = 0; i < 14; ++i) a.in[i] = (const float*)d_in[i];
    a.out = (float*)d_out; a.ws = (unsigned char*)d_ws;
#if MK_ONE_LAUNCH
    a.ph_lo = 0; a.ph_hi = N_PHASES;
#if MK_BARRIER == 1
    if (hipMemsetAsync((char*)d_ws + WS_CTL, 0, CTL_ZERO_BYTES, stream) != hipSuccess) { fprintf(stderr, "kernel_launch: hipMemsetAsync failed\n"); return; }
    hipLaunchKernelGGL(mk_fwd, dim3(grid), dim3(NTHR), LDS_BYTES, stream, a);
#else
    void* kargs[] = {&a};
    const hipError_t ce = hipLaunchCooperativeKernel((const void*)mk_fwd, dim3(grid), dim3(NTHR), kargs, LDS_BYTES, stream);
    if (ce != hipSuccess) fprintf(stderr, "kernel_launch: cooperative launch failed: %s\n", hipGetErrorName(ce));
#endif
#else
    for (int ph = 0; ph < N_PHASES; ++ph) {
        a.ph_lo = ph; a.ph_hi = ph + 1;
        hipLaunchKernelGGL(mk_fwd, dim3(grid), dim3(NTHR), LDS_BYTES, stream, a);
    }
#endif
    const hipError_t le = hipPeekAtLastError();
    if (le != hipSuccess) fprintf(stderr, "kernel_launch: launch failed: %s\n", hipGetErrorName(le));
}
```

```cpp
#include <hip/hip_runtime.h>
#include <cstdio>
#include <cstdint>
#include <hip/hip_cooperative_groups.h>

constexpr int NB = 16, SEQ = 2048, DM = 1024, LC = 256, LT = LC + SEQ;
constexpr int MLAT = NB * SEQ, MCTX = NB * LC, MALL = MLAT + MCTX;
constexpr int RH = 4, RDK = 256, RDV = 512;
constexpr int AH = 8, AKV = 2, AHD = 128;
constexpr int NIN = 10752, NKV = 3584, N1 = 5632, NG = 5120;
constexpr float EPS = 1e-6f;
#ifndef MK_DBG_NOCTX
#define MK_DBG_NOCTX 0
#endif
constexpr int NWAVES = 8, NTHR = 512;
#define LAS __attribute__((address_space(3)))

typedef unsigned short bf16_t;
typedef unsigned v4u __attribute__((ext_vector_type(4)));
typedef unsigned v2u __attribute__((ext_vector_type(2)));
typedef float v4f __attribute__((ext_vector_type(4)));
typedef float v2f __attribute__((ext_vector_type(2)));

__device__ __forceinline__ float bf2f(unsigned h) { return __uint_as_float(h << 16); }
__device__ __forceinline__ unsigned f2bf(float f) { unsigned u = __float_as_uint(f); return (u + 0x7fffu + ((u >> 16) & 1u)) >> 16; }
__device__ __forceinline__ unsigned pk2(float lo, float hi) { return f2bf(lo) | (f2bf(hi) << 16); }
__device__ __forceinline__ float bflo(unsigned w) { return __uint_as_float(w << 16); }
__device__ __forceinline__ float bfhi(unsigned w) { return __uint_as_float(w & 0xffff0000u); }
__device__ __forceinline__ float fast_sigmoid(float x) { return __builtin_amdgcn_rcpf(1.0f + __builtin_amdgcn_exp2f(-1.4426950408889634f * x)); }
__device__ __forceinline__ float fast_silu(float x) { return x * fast_sigmoid(x); }
__device__ __forceinline__ float wave_sum(float v) {
#pragma unroll
    for (int o = 1; o < 64; o <<= 1) v += __shfl_xor(v, o);
    return v;
}

typedef __bf16 bf16x2_t __attribute__((ext_vector_type(2)));
__device__ __forceinline__ unsigned cvt_pk_bf16(float lo, float hi) { v2f v = {lo, hi}; bf16x2_t b = __builtin_convertvector(v, bf16x2_t); return __builtin_bit_cast(unsigned, b); }
__device__ __forceinline__ void unpack8(const v4u w, float (&o)[8]) {
    o[0] = bflo(w.x); o[1] = bfhi(w.x); o[2] = bflo(w.y); o[3] = bfhi(w.y); o[4] = bflo(w.z); o[5] = bfhi(w.z); o[6] = bflo(w.w); o[7] = bfhi(w.w);
}
__device__ __forceinline__ v4u pack8(const float (&o)[8]) {
    v4u w; w.x = cvt_pk_bf16(o[0], o[1]); w.y = cvt_pk_bf16(o[2], o[3]); w.z = cvt_pk_bf16(o[4], o[5]); w.w = cvt_pk_bf16(o[6], o[7]); return w;
}

constexpr size_t MiB = 1u << 20;
constexpr size_t WS_CTL = 0;
constexpr size_t WS_MOD = 1 * MiB;
constexpr size_t WS_ROPE = WS_MOD + 256 * 1024;
constexpr size_t WS_SSQ = 2 * MiB;
constexpr size_t WS_WIN = 4 * MiB;
constexpr size_t WS_WOR = 25 * MiB;
constexpr size_t WS_WOA = 29 * MiB;
constexpr size_t WS_WOUT = 31 * MiB;
constexpr size_t WS_HX = 33 * MiB;
constexpr size_t WS_RK = 105 * MiB;
constexpr size_t WS_RV = 177 * MiB;
constexpr size_t WS_RQ = 321 * MiB;
constexpr size_t WS_AK = 385 * MiB;
constexpr size_t WS_AV = 403 * MiB;
constexpr size_t WS_AQ = 421 * MiB;
constexpr size_t WS_END = 485 * MiB;
constexpr size_t WS_U1 = WS_RK;
constexpr size_t WS_U2 = WS_RV;

__host__ __device__ __forceinline__ int orig_col(int n) { return n < 4608 ? n : (n < 5632 ? n + 2048 : (n < 7680 ? n - 1024 : n)); }
namespace pg8 {
#define PG8_LAS __attribute__((address_space(3)))
typedef unsigned short bf16_t;
typedef short bf16x8 __attribute__((ext_vector_type(8)));
typedef float f32x4 __attribute__((ext_vector_type(4)));
typedef unsigned u32x4 __attribute__((ext_vector_type(4)));
constexpr int BM = 256, BK = 64, HALF = 128, HTB = HALF * BK * 2  , STAGE_BYTES = 8 * HTB, NXCD = 8, WGM = 8;

__host__ __device__ __forceinline__ int lds_byte(int r, int c) { const int st = (r >> 4) * 2 + (c >> 5), rr = r & 15, cc = c & 31, ob = rr * 64 + cc * 2; return st * 1024 + (ob ^ (((ob >> 9) & 1) << 5)); }
__host__ __device__ __forceinline__ void stage_rc(int b, int& R, int& C) { const int st = b / 1024, sb = b % 1024, swz = sb ^ (((sb >> 9) & 1) << 5); R = (st >> 1) * 16 + swz / 64; C = (st & 1) * 32 + (swz % 64) / 2; }
__host__ __device__ __forceinline__ int perm32(int rho) { const int n = rho >> 4, i = rho & 15; return 8 * (i >> 2) + 4 * n + (i & 3); }

struct Unit { int pm, pn; };
struct Gemm { const bf16_t* A; const bf16_t* Bt; int M, N, K; };

struct StaticOrder {
    int nM, nN, nwg, G, c;
    __host__ __device__ void init(int M, int N, int G_, int c_) { nM = M / BM; nN = N / BM; nwg = nM * nN; G = G_; c = c_; }
    __host__ __device__ bool next(int i, Unit& u) const {
        const long L = (long)i * G + c; if (L >= nwg) return false;
        int wgid = (int)L; { const int q = nwg / NXCD, r = nwg % NXCD, xcd = wgid % NXCD, off = wgid / NXCD; wgid = (xcd < r ? xcd * (q + 1) : r * (q + 1) + (xcd - r) * q) + off; }
        const int nig = WGM * nN, gid = wgid / nig, fm = gid * WGM, gsz = (nM - fm) < WGM ? (nM - fm) : WGM;
        u.pm = fm + ((wgid % nig) % gsz); u.pn = (wgid % nig) / gsz; return true;
    }
    __device__ __forceinline__ void a_ready(const Unit&) const {}
    __device__ __forceinline__ void done(const Unit&) const {}
};


struct Sched1 {
    int G, c; StaticOrder so;
    __device__ void init(int G_, int c_) { G = G_; c = c_; so.init(MLAT, N1, G_, c_); }
    __device__ bool next(int i, Unit& u) const {
        long L = (long)i * G + c; if (L < 2816) return so.next(i, u);
        L -= 2816; if (L >= 224) return false;
        u.pm = 128 + (int)(L & 15); u.pn = (int)(L >> 4); return true;
    }
    __device__ __forceinline__ void a_ready(const Unit&) const {}
    __device__ __forceinline__ void done(const Unit&) const {}
};

#define EPI_ROWS_BEGIN const int rt0 = wr * 64 + fr, ct0 = wc * 32 + 8 * fq; \
    _Pragma("unroll") for (int ai = 0; ai < 2; ++ai) _Pragma("unroll") for (int m = 0; m < 4; ++m) { const int rt = rt0 + ai * HALF + m * 16;
#define EPI_ROWS_END }

struct Epi1 {
    static constexpr bool PERM = true, AFTER_DRAIN = false;
    bf16_t *RK, *RV, *AK, *AV, *RQ, *AQ;
    __device__ __forceinline__ void operator()(const f32x4 (&acc)[2][2][4][2], const Unit& u, int wr, int wc, int fr, int fq) const {
        const int pm = u.pm, pn = u.pn;
        const int kvrow0 = pm < 128 ? ((pm >> 3) * LT + LC + (pm & 7) * 256) : ((pm - 128) * LT);
        bf16_t* base; int ld; float sc = 1.f;
        if (pn < 4) { base = RK + (size_t)kvrow0 * 1024 + pn * 256; ld = 1024; sc = 0.0625f; }
        else if (pn < 12) { base = RV + (size_t)kvrow0 * 2048 + (pn - 4) * 256; ld = 2048; }
        else if (pn == 12) { base = AK + (size_t)kvrow0 * 256; ld = 256; }
        else if (pn == 13) { base = AV + (size_t)kvrow0 * 256; ld = 256; }
        else if (pn < 18) { base = RQ + (size_t)pm * 256 * 1024 + (pn - 14) * 256; ld = 1024; }
        else { base = AQ + (size_t)pm * 256 * 1024 + (pn - 18) * 256; ld = 1024; }
        EPI_ROWS_BEGIN
            bf16_t* rowp = base + (size_t)rt * ld + ct0;
#pragma unroll
            for (int bj = 0; bj < 2; ++bj) { const f32x4 v0 = acc[ai][bj][m][0] * sc, v1 = acc[ai][bj][m][1] * sc;
                u32x4 w; w.x = cvt_pk_bf16(v0[0], v0[1]); w.y = cvt_pk_bf16(v0[2], v0[3]); w.z = cvt_pk_bf16(v1[0], v1[1]); w.w = cvt_pk_bf16(v1[2], v1[3]);
                *(u32x4*)(rowp + bj * HALF) = w; }
        EPI_ROWS_END
    }
};

struct Epi5 {
    static constexpr bool PERM = true, AFTER_DRAIN = false;
    bf16_t *YR, *YA, *U1, *U2; const float* SSQ;
    __device__ __forceinline__ void operator()(const f32x4 (&acc)[2][2][4][2], const Unit& u, int wr, int wc, int fr, int fq) const {
        const int pn = u.pn; const size_t row0 = (size_t)u.pm * 256;
        if (pn < 8) {
            const int head = pn >> 1;
            EPI_ROWS_BEGIN
                const size_t row = row0 + rt;
                const float ss = SSQ[row * 8 + head * 2] + SSQ[row * 8 + head * 2 + 1];
                const float rstd = __builtin_amdgcn_rsqf(ss * (1.0f / 512.0f) + EPS);
#pragma unroll
                for (int bj = 0; bj < 2; ++bj) { u32x4* p = (u32x4*)(YR + row * 2048 + pn * 256 + bj * HALF + ct0); float o[8]; unpack8(*p, o);
                    const f32x4 v0 = acc[ai][bj][m][0], v1 = acc[ai][bj][m][1];
#pragma unroll
                    for (int k = 0; k < 4; ++k) { o[k] = o[k] * rstd * fast_silu(v0[k]); o[4 + k] = o[4 + k] * rstd * fast_silu(v1[k]); }
                    *p = pack8(o); }
            EPI_ROWS_END
        } else if (pn < 12) {
            EPI_ROWS_BEGIN
                const size_t row = row0 + rt;
#pragma unroll
                for (int bj = 0; bj < 2; ++bj) { u32x4* p = (u32x4*)(YA + row * 1024 + (pn - 8) * 256 + bj * HALF + ct0); float o[8]; unpack8(*p, o);
                    const f32x4 v0 = acc[ai][bj][m][0], v1 = acc[ai][bj][m][1];
#pragma unroll
                    for (int k = 0; k < 4; ++k) { o[k] = o[k] * fast_silu(v0[k]); o[4 + k] = o[4 + k] * fast_silu(v1[k]); }
                    *p = pack8(o); }
            EPI_ROWS_END
        } else {
            bf16_t* U = pn < 16 ? U1 + (pn - 12) * 256 : U2 + (pn - 16) * 256;
            EPI_ROWS_BEGIN
                const size_t row = row0 + rt;
#pragma unroll
                for (int bj = 0; bj < 2; ++bj) { float o[8]; const f32x4 v0 = acc[ai][bj][m][0], v1 = acc[ai][bj][m][1];
#pragma unroll
                    for (int k = 0; k < 4; ++k) { o[k] = fast_sigmoid(v0[k]); o[4 + k] = fast_sigmoid(v1[k]); }
                    *(u32x4*)(U + row * 1024 + bj * HALF + ct0) = pack8(o); }
            EPI_ROWS_END
        }
    }
};

struct Epi6 {
    static constexpr bool PERM = true, AFTER_DRAIN = false;
    bf16_t* U1;
    __device__ __forceinline__ void operator()(const f32x4 (&acc)[2][2][4][2], const Unit& u, int wr, int wc, int fr, int fq) const {
        const size_t row0 = (size_t)u.pm * 256; const int c0 = u.pn * 256;
        EPI_ROWS_BEGIN
            const size_t row = row0 + rt;
#pragma unroll
            for (int bj = 0; bj < 2; ++bj) { u32x4* p = (u32x4*)(U1 + row * 1024 + c0 + bj * HALF + ct0); float o[8]; unpack8(*p, o);
                const f32x4 v0 = acc[ai][bj][m][0], v1 = acc[ai][bj][m][1];
#pragma unroll
                for (int k = 0; k < 4; ++k) { o[k] *= v0[k]; o[4 + k] *= v1[k]; }
                *p = pack8(o); }
        EPI_ROWS_END
    }
};
struct Epi7 {
    static constexpr bool PERM = true, AFTER_DRAIN = false;
    bf16_t* U1; const bf16_t* U2;
    __device__ __forceinline__ void operator()(const f32x4 (&acc)[2][2][4][2], const Unit& u, int wr, int wc, int fr, int fq) const {
        const size_t row0 = (size_t)u.pm * 256; const int c0 = u.pn * 256;
        EPI_ROWS_BEGIN
            const size_t row = row0 + rt;
#pragma unroll
            for (int bj = 0; bj < 2; ++bj) { const size_t off = row * 1024 + c0 + bj * HALF + ct0; u32x4* p = (u32x4*)(U1 + off); float o[8], g[8]; unpack8(*p, o); unpack8(*(const u32x4*)(U2 + off), g);
                const f32x4 v0 = acc[ai][bj][m][0], v1 = acc[ai][bj][m][1];
#pragma unroll
                for (int k = 0; k < 4; ++k) { o[k] += g[k] * v0[k]; o[4 + k] += g[4 + k] * v1[k]; }
                *p = pack8(o); }
        EPI_ROWS_END
    }
};
struct Epi8 {
    static constexpr bool PERM = true, AFTER_DRAIN = false;
    const float* X; const float* MOD; float* OUT;
    __device__ __forceinline__ void operator()(const f32x4 (&acc)[2][2][4][2], const Unit& u, int wr, int wc, int fr, int fq) const {
        const size_t row0 = (size_t)u.pm * 256; const int c0 = u.pn * 256; const float* gate = MOD + (size_t)(u.pm >> 3) * 3072 + 2048;
        EPI_ROWS_BEGIN
            const size_t row = row0 + rt;
#pragma unroll
            for (int bj = 0; bj < 2; ++bj) { const int col = c0 + bj * HALF + ct0; const size_t off = row * 1024 + col;
#pragma unroll
                for (int n = 0; n < 2; ++n) { const f32x4 xv = *(const f32x4*)(X + off + 4 * n), gv = *(const f32x4*)(gate + col + 4 * n);
                    *(f32x4*)(OUT + off + 4 * n) = xv + gv * acc[ai][bj][m][n]; } }
        EPI_ROWS_END
    }
};
template <class Epi, class Sched, bool ALIGN_EPI = false, bool SP2 = false>
__device__ __forceinline__ void gemm_phase(PG8_LAS unsigned char* lds, const Gemm g, const Sched& S, const Epi& E) {
    const int tid = threadIdx.x, wid = __builtin_amdgcn_readfirstlane(tid >> 6), lane = tid & 63, wr = wid >> 2, wc = wid & 3, fr = lane & 15, fq = lane >> 4;
    const int K = g.K, nt = K / BK;
    unsigned voffA[2], voffB[2];
#pragma unroll
    for (int i = 0; i < 2; ++i) { int R, C; stage_rc(tid * 16 + i * 8192, R, C); const int Rb = Epi::PERM ? ((R & ~31) + perm32(R & 31)) : R;
        voffA[i] = (unsigned)(R * K + C) * 2u; voffB[i] = (unsigned)(Rb * K + C) * 2u; }
    const size_t kstep = (size_t)(BK * 2);
    const size_t hstep = (size_t)HALF * K * 2;
    const size_t tstep = 2 * hstep;
    const unsigned ldsw = (unsigned)wid * 1024u;
    const int aoff = lds_byte(wr * 64 + fr, fq * 8), boff = lds_byte(wc * 32 + fr, fq * 8);
#define PG8_SA(b, h) (((b) * 2 + (h)) * HTB)
#define PG8_SB(b, h) ((4 + (b) * 2 + (h)) * HTB)
#define PG8_STAGE(bufoff, gbase, voff) do { _Pragma("unroll") for (int _i = 0; _i < 2; ++_i) \
        __builtin_amdgcn_global_load_lds((const unsigned*)((const char*)(gbase) + (voff)[_i]), (PG8_LAS unsigned*)(lds + (bufoff) + ldsw + _i * 8192), 16, 0, 0); } while (0)
#define PG8_LDA(dst, b, h) do { _Pragma("unroll") for (int m = 0; m < 4; ++m) _Pragma("unroll") for (int k = 0; k < 2; ++k) dst[m][k] = *(const PG8_LAS bf16x8*)(lds + PG8_SA(b, h) + aoff + m * 2048 + k * 1024); } while (0)
#define PG8_LDB(dst, b, h) do { _Pragma("unroll") for (int n = 0; n < 2; ++n) _Pragma("unroll") for (int k = 0; k < 2; ++k) dst[n][k] = *(const PG8_LAS bf16x8*)(lds + PG8_SB(b, h) + boff + n * 2048 + k * 1024); } while (0)
#define PG8_MMA(ai, bj, At, Bt) do { __builtin_amdgcn_s_setprio(1); _Pragma("unroll") for (int m = 0; m < 4; ++m) _Pragma("unroll") for (int n = 0; n < 2; ++n) _Pragma("unroll") for (int k = 0; k < 2; ++k) \
        acc[ai][bj][m][n] = __builtin_amdgcn_mfma_f32_16x16x32_bf16(Bt[n][k], At[m][k], acc[ai][bj][m][n], 0, 0, 0); __builtin_amdgcn_s_setprio(0); } while (0)
#define PG8_WAIT_V(n) asm volatile("s_waitcnt vmcnt(" #n ")" ::: "memory")
#define PG8_WAIT_L(n) asm volatile("s_waitcnt lgkmcnt(" #n ")" ::: "memory")
#define PG8_BAR __builtin_amdgcn_s_barrier()
#define PG8_SCHED __builtin_amdgcn_sched_barrier(0)
    Unit cur, nxt; int ui = 0;
    if (!S.next(0, cur)) return;
    f32x4 acc[2][2][4][2];
#pragma unroll
    for (int a = 0; a < 2; ++a)
#pragma unroll
        for (int b = 0; b < 2; ++b)
#pragma unroll
            for (int m = 0; m < 4; ++m)
#pragma unroll
                for (int n = 0; n < 2; ++n) acc[a][b][m][n] = (f32x4){0.f, 0.f, 0.f, 0.f};
    bf16x8 At[4][2], B0[2][2], B1[2][2];
    const char* cA = (const char*)g.A + (size_t)cur.pm * tstep; const char* cB = (const char*)g.Bt + (size_t)cur.pn * tstep;
    S.a_ready(cur);
    if constexpr (SP2) {
        PG8_STAGE(PG8_SB(0, 0), cB, voffB); PG8_STAGE(PG8_SB(0, 1), cB + hstep, voffB); PG8_STAGE(PG8_SA(0, 0), cA, voffA); PG8_STAGE(PG8_SA(0, 1), cA + hstep, voffA);
        if (wr == 1) PG8_BAR;
        PG8_WAIT_V(2); PG8_BAR;
        PG8_STAGE(PG8_SB(1, 0), cB + kstep, voffB); PG8_STAGE(PG8_SA(1, 0), cA + kstep, voffA); PG8_STAGE(PG8_SB(1, 1), cB + hstep + kstep, voffB);
        PG8_WAIT_V(6); PG8_BAR;
    } else {
        PG8_STAGE(PG8_SB(0, 0), cB, voffB); PG8_STAGE(PG8_SA(0, 0), cA, voffA); PG8_STAGE(PG8_SB(0, 1), cB + hstep, voffB); PG8_STAGE(PG8_SA(0, 1), cA + hstep, voffA);
        if (wr == 1) PG8_BAR;
        PG8_WAIT_V(4); PG8_BAR;
        PG8_STAGE(PG8_SB(1, 0), cB + kstep, voffB); PG8_STAGE(PG8_SA(1, 0), cA + kstep, voffA); PG8_STAGE(PG8_SB(1, 1), cB + hstep + kstep, voffB);
        PG8_WAIT_V(6); PG8_BAR;
    }
    for (;;) {
        const bool has_next = S.next(ui + 1, nxt);
        const char* nA = has_next ? (const char*)g.A + (size_t)nxt.pm * tstep : cA; const char* nB = has_next ? (const char*)g.Bt + (size_t)nxt.pn * tstep : cB;
        for (int t = 0; t < nt; t += 2) {
            const bool last = (t == nt - 2);
            const char* a1 = cA + (size_t)(t + 1) * kstep;
            const char* a2 = last ? nA : cA + (size_t)(t + 2) * kstep; const char* b2 = last ? nB : cB + (size_t)(t + 2) * kstep;
            const char* a3 = a2 + kstep; const char* b3 = b2 + kstep;
            if (last && has_next) S.a_ready(nxt);
            if constexpr (SP2) {
            PG8_LDB(B0, 0, 0); PG8_LDB(B1, 0, 1); PG8_SCHED; PG8_LDA(At, 0, 0); PG8_STAGE(PG8_SA(1, 1), a1 + hstep, voffA);
            PG8_WAIT_V(8); PG8_WAIT_L(0); PG8_BAR; PG8_MMA(0, 0, At, B0); PG8_MMA(0, 1, At, B1); PG8_BAR; PG8_SCHED;
            PG8_LDA(At, 0, 1); PG8_STAGE(PG8_SB(0, 0), b2, voffB); PG8_STAGE(PG8_SB(0, 1), b2 + hstep, voffB); PG8_STAGE(PG8_SA(0, 0), a2, voffA);
            PG8_WAIT_V(8); PG8_WAIT_L(0); PG8_BAR; PG8_MMA(1, 0, At, B0); PG8_MMA(1, 1, At, B1); PG8_BAR; PG8_SCHED;
            PG8_LDB(B0, 1, 0); PG8_LDB(B1, 1, 1); PG8_SCHED; PG8_LDA(At, 1, 0); PG8_STAGE(PG8_SA(0, 1), a2 + hstep, voffA);
            PG8_WAIT_V(8); PG8_WAIT_L(0); PG8_BAR; PG8_MMA(0, 0, At, B0); PG8_MMA(0, 1, At, B1); PG8_BAR; PG8_SCHED;
            PG8_LDA(At, 1, 1); PG8_STAGE(PG8_SB(1, 0), b3, voffB); PG8_STAGE(PG8_SB(1, 1), b3 + hstep, voffB); PG8_STAGE(PG8_SA(1, 0), a3, voffA);
            PG8_WAIT_V(8); PG8_WAIT_L(0); PG8_BAR; PG8_MMA(1, 0, At, B0); PG8_MMA(1, 1, At, B1); PG8_BAR; PG8_SCHED;
            } else {
            PG8_LDB(B0, 0, 0); PG8_SCHED; PG8_LDA(At, 0, 0); PG8_STAGE(PG8_SA(1, 1), a1 + hstep, voffA);
            PG8_WAIT_L(8); PG8_BAR; PG8_WAIT_L(0); PG8_MMA(0, 0, At, B0); PG8_BAR; PG8_SCHED;
            PG8_LDB(B1, 0, 1); PG8_STAGE(PG8_SB(0, 0), b2, voffB);
            PG8_BAR; PG8_WAIT_L(0); PG8_MMA(0, 1, At, B1); PG8_BAR;
            PG8_LDA(At, 0, 1); PG8_STAGE(PG8_SA(0, 0), a2, voffA);
            PG8_BAR; PG8_WAIT_L(0); PG8_MMA(1, 0, At, B0); PG8_BAR; PG8_SCHED;
            PG8_STAGE(PG8_SB(0, 1), b2 + hstep, voffB);
            PG8_WAIT_V(6); PG8_BAR; PG8_MMA(1, 1, At, B1); PG8_BAR;
            PG8_LDB(B0, 1, 0); PG8_SCHED; PG8_LDA(At, 1, 0); PG8_STAGE(PG8_SA(0, 1), a2 + hstep, voffA);
            PG8_WAIT_L(8); PG8_BAR; PG8_WAIT_L(0); PG8_MMA(0, 0, At, B0); PG8_BAR; PG8_SCHED;
            PG8_LDB(B1, 1, 1); PG8_STAGE(PG8_SB(1, 0), b3, voffB);
            PG8_BAR; PG8_WAIT_L(0); PG8_MMA(0, 1, At, B1); PG8_BAR;
            PG8_LDA(At, 1, 1); PG8_STAGE(PG8_SA(1, 0), a3, voffA);
            PG8_BAR; PG8_WAIT_L(0); PG8_MMA(1, 0, At, B0); PG8_BAR; PG8_SCHED;
            PG8_STAGE(PG8_SB(1, 1), b3 + hstep, voffB);
            PG8_WAIT_V(6); PG8_BAR; PG8_MMA(1, 1, At, B1); PG8_BAR;
            }
        }
        if constexpr (ALIGN_EPI) { if (wr == 0) PG8_BAR; }
        if constexpr (!Epi::AFTER_DRAIN) { E(acc, cur, wr, wc, fr, fq); S.done(cur); }
        if (!has_next) break;
#pragma unroll
        for (int a = 0; a < 2; ++a)
#pragma unroll
            for (int b = 0; b < 2; ++b)
#pragma unroll
                for (int m = 0; m < 4; ++m)
#pragma unroll
                    for (int n = 0; n < 2; ++n) acc[a][b][m][n] = (f32x4){0.f, 0.f, 0.f, 0.f};
        cur = nxt; cA = nA; cB = nB; ++ui;
        if constexpr (ALIGN_EPI) { if (wr == 1) PG8_BAR; }
    }
    PG8_WAIT_V(0);
    if constexpr (!ALIGN_EPI) { if (wr == 0) PG8_BAR; }
    PG8_BAR;
    if constexpr (Epi::AFTER_DRAIN) { E.fused(acc, cur, wr, wc, fr, fq, lds, wid, lane); S.done(cur); }
#undef PG8_SA
#undef PG8_SB
#undef PG8_STAGE
#undef PG8_LDA
#undef PG8_LDB
#undef PG8_MMA
#undef PG8_WAIT_V
#undef PG8_WAIT_L
#undef PG8_BAR
#undef PG8_SCHED
}
}

namespace attn {
constexpr int   D = 128, NW = 8, QBLK = 32, KVBLK = 64;
constexpr float SCALE = 0.088388347648318440f;
constexpr float THR = 8.f;
constexpr int SDEPTH = 2;
constexpr int LDQ = 1024, LDK = 256, LDO = 1024;
constexpr size_t SHM_V = KVBLK * D * 2, SHM_K = KVBLK * D * 2, SHM_ATTN = 2 * SHM_V + 2 * SHM_K + NW * 64 * 4;
typedef unsigned short bf16;
using bf16x8 = __attribute__((ext_vector_type(8))) short;
using s16x4  = __attribute__((ext_vector_type(4))) short;
using f32x16 = __attribute__((ext_vector_type(16))) float;
using f32x8  = __attribute__((ext_vector_type(8))) float;
using u32x4  = __attribute__((ext_vector_type(4))) unsigned;
#define KSWZ(row, colB) ((row) * 256 + ((colB) ^ (((row) & 7) << 4)))
#define SBAR() __builtin_amdgcn_sched_barrier(0)
__device__ __forceinline__ int crow(int r, int hi) { return (r & 3) + 8 * (r >> 2) + 4 * hi; }
__device__ __forceinline__ unsigned cvtpk(float lo, float hi) { return cvt_pk_bf16(lo, hi); }
template <typename TIn> struct Stage;
template <> struct Stage<bf16>  { using T = bf16x8;
  __device__ static __forceinline__ T ld8(const bf16* p) { return *reinterpret_cast<const bf16x8*>(p); }
  __device__ static __forceinline__ bf16x8 tobf(T x) { return x; } };
__device__ __forceinline__ void partialSM(f32x16& p0, f32x16& p1, float& m_reg, float& mn, float& alpha) {
  constexpr float C = SCALE * 1.4426950408889634f;
  float pmax = p0[0]; for (int r = 1; r < 16; ++r) pmax = fmaxf(pmax, p0[r]); for (int r = 0; r < 16; ++r) pmax = fmaxf(pmax, p1[r]);
  { auto rr = __builtin_amdgcn_permlane32_swap(__float_as_uint(pmax), __float_as_uint(pmax), false, false);
    pmax = fmaxf(__uint_as_float(rr[0]), __uint_as_float(rr[1])); }
  if (__builtin_expect(__all(pmax - m_reg <= THR / SCALE), 1)) { mn = m_reg; alpha = 1.f; }
  else { mn = fmaxf(m_reg, pmax); alpha = __builtin_amdgcn_exp2f((m_reg - mn) * C); m_reg = mn; }
  float mnC = -mn * C;
  for (int r = 0; r < 16; ++r) p0[r] = fmaf(p0[r], C, mnC); for (int r = 0; r < 16; ++r) p1[r] = fmaf(p1[r], C, mnC);
  for (int r = 0; r < 16; ++r) p0[r] = __builtin_amdgcn_exp2f(p0[r]);
}
__device__ __forceinline__ void finishSM(f32x16& p0, f32x16& p1, float alpha, float& l_reg, bf16x8& pa0, bf16x8& pa1, bf16x8& pa2, bf16x8& pa3) {
  for (int r = 0; r < 16; ++r) p1[r] = __builtin_amdgcn_exp2f(p1[r]);
  float ps = 0; for (int r = 0; r < 16; ++r) ps += p0[r]; for (int r = 0; r < 16; ++r) ps += p1[r];
  { auto rr = __builtin_amdgcn_permlane32_swap(__float_as_uint(ps), __float_as_uint(ps), false, false);
    ps = __uint_as_float(rr[0]) + __uint_as_float(rr[1]); }
  l_reg = l_reg * alpha + ps;
#define PK4(P, BASE, OUT) do { unsigned a0 = cvtpk(P[BASE + 0], P[BASE + 1]), a1 = cvtpk(P[BASE + 2], P[BASE + 3]);   \
    unsigned b0 = cvtpk(P[BASE + 4], P[BASE + 5]), b1 = cvtpk(P[BASE + 6], P[BASE + 7]);                              \
    auto r0 = __builtin_amdgcn_permlane32_swap(a0, b0, false, false); auto r1 = __builtin_amdgcn_permlane32_swap(a1, b1, false, false); \
    u32x4 w = {r0[0], r1[0], r0[1], r1[1]}; OUT = *reinterpret_cast<bf16x8*>(&w); } while (0)
  PK4(p0, 0, pa0); PK4(p0, 8, pa1); PK4(p1, 0, pa2); PK4(p1, 8, pa3);
#undef PK4
}
__device__ __forceinline__ void qkt(f32x16& p0, f32x16& p1, const bf16* Ks, const bf16x8* qr, int r32, int hi) {
  p0 = f32x16{}; p1 = f32x16{};
  for (int d0 = 0; d0 < 8; ++d0) { int cb = (d0 * 16 + hi * 8) * 2;
    bf16x8 b0 = *reinterpret_cast<const bf16x8*>((const char*)Ks + KSWZ(r32, cb));
    bf16x8 b1 = *reinterpret_cast<const bf16x8*>((const char*)Ks + KSWZ(32 + r32, cb));
    p0 = __builtin_amdgcn_mfma_f32_32x32x16_bf16(b0, qr[d0], p0, 0, 0, 0);
    p1 = __builtin_amdgcn_mfma_f32_32x32x16_bf16(b1, qr[d0], p1, 0, 0, 0); }
}
__device__ __forceinline__ int v_st(int k, int c) { const int kk = (k & ~0xC) | ((k & 4) << 1) | ((k & 8) >> 1); return ((kk >> 3) * 4 + (c >> 5)) * 512 + ((kk & 7) * 32 + (c & 31)) * 2; }
__device__ __forceinline__ int v_rd_base(int lane) { return ((lane & 3) << 3) | (((lane >> 2) & 3) << 6) | (((lane >> 4) & 1) << 5) | (((lane >> 5) & 1) << 8); }
constexpr int v_rd_off(int d0, int ks, int half) { return d0 * 512 + ks * 4096 + half * 2048; }
template <int OFF> __device__ __forceinline__ s16x4 tr_read(int vb) {
  s16x4 r; asm volatile("ds_read_b64_tr_b16 %0, %1 offset:%2" : "=&v"(r) : "v"(vb), "i"(OFF) : "memory"); return r;
}
template <int D0> __device__ __forceinline__ void pv_one(f32x16& od, int vb, bf16x8 pa0, bf16x8 pa1, bf16x8 pa2, bf16x8 pa3) {
  const s16x4 l0 = tr_read<v_rd_off(D0, 0, 0)>(vb), h0 = tr_read<v_rd_off(D0, 0, 1)>(vb), l1 = tr_read<v_rd_off(D0, 1, 0)>(vb), h1 = tr_read<v_rd_off(D0, 1, 1)>(vb);
  const s16x4 l2 = tr_read<v_rd_off(D0, 2, 0)>(vb), h2 = tr_read<v_rd_off(D0, 2, 1)>(vb), l3 = tr_read<v_rd_off(D0, 3, 0)>(vb), h3 = tr_read<v_rd_off(D0, 3, 1)>(vb);
  asm volatile("s_waitcnt lgkmcnt(0)" ::: "memory"); SBAR();
#define PK(L, H) (bf16x8){L[0], L[1], L[2], L[3], H[0], H[1], H[2], H[3]}
  od = __builtin_amdgcn_mfma_f32_32x32x16_bf16(pa0, PK(l0, h0), od, 0, 0, 0);
  od = __builtin_amdgcn_mfma_f32_32x32x16_bf16(pa1, PK(l1, h1), od, 0, 0, 0);
  od = __builtin_amdgcn_mfma_f32_32x32x16_bf16(pa2, PK(l2, h2), od, 0, 0, 0);
  od = __builtin_amdgcn_mfma_f32_32x32x16_bf16(pa3, PK(l3, h3), od, 0, 0, 0);
#undef PK
}
__device__ __forceinline__ void pv_d0(f32x16* o, int vb, bf16x8 pa0, bf16x8 pa1, bf16x8 pa2, bf16x8 pa3) {
  pv_one<0>(o[0], vb, pa0, pa1, pa2, pa3); pv_one<1>(o[1], vb, pa0, pa1, pa2, pa3); pv_one<2>(o[2], vb, pa0, pa1, pa2, pa3); pv_one<3>(o[3], vb, pa0, pa1, pa2, pa3);
}

template <typename TQ>
__device__ __forceinline__ void attn_dense_body(const TQ* Qb, const bf16* __restrict__ Kh, const bf16* __restrict__ Vh,
                                                bf16* Ob, int seq, char* lds) {
  using St = Stage<bf16>; using SQ = Stage<TQ>;
  const int tid = threadIdx.x, wid = tid >> 6, lane = tid & 63, r32 = lane & 31, hi = lane >> 5;
  bf16* V_lds = (bf16*)lds; bf16* K_lds = (bf16*)(lds + 2 * SHM_V);
  float* ws = (float*)(lds + 2 * SHM_V + 2 * SHM_K) + wid * 64; float* li_l = ws; float* al_l = ws + 32;
  float m_reg = -1e30f, l_reg = 0; f32x16 o[4] = {}; bf16x8 qr[8];
  const TQ* Qw = Qb + (long)(wid * QBLK + r32) * LDQ + hi * 8;
#pragma unroll
  for (int d0 = 0; d0 < 8; ++d0) qr[d0] = SQ::tobf(SQ::ld8(Qw + d0 * 16));
  const int sr = tid >> 4, sc = (tid & 15) * 8, vst0 = v_st(sr, sc), vst1 = v_st(32 + sr, sc);
  const int vb0 = (int)(uintptr_t)V_lds + v_rd_base(lane);
  struct { typename St::T vs0, vs1, ks0, ks1; } sr_[SDEPTH];
#define SLOAD(i, k0) do { sr_[i].vs0 = St::ld8(&Vh[(long)((k0) + sr) * LDK + sc]); sr_[i].vs1 = St::ld8(&Vh[(long)((k0) + 32 + sr) * LDK + sc]); \
    sr_[i].ks0 = St::ld8(&Kh[(long)((k0) + sr) * LDK + sc]); sr_[i].ks1 = St::ld8(&Kh[(long)((k0) + 32 + sr) * LDK + sc]); } while (0)
#define SWRITE(b, i) do { *(bf16x8*)((char*)V_lds + (b) * SHM_V + vst0) = St::tobf(sr_[i].vs0);          \
    *(bf16x8*)((char*)V_lds + (b) * SHM_V + vst1) = St::tobf(sr_[i].vs1); int kc = sc * 2;               \
    *(bf16x8*)((char*)K_lds + (b) * SHM_K + KSWZ(sr, kc)) = St::tobf(sr_[i].ks0);                       \
    *(bf16x8*)((char*)K_lds + (b) * SHM_K + KSWZ(32 + sr, kc)) = St::tobf(sr_[i].ks1); } while (0)
#define SWAIT() do { if constexpr (SDEPTH == 2) asm volatile("s_waitcnt vmcnt(4)" ::: "memory"); else asm volatile("s_waitcnt vmcnt(0)" ::: "memory"); } while (0)
#define RESC(a) do { if (__any((a) < 1.f)) { if (hi == 0) al_l[r32] = (a); asm volatile("s_waitcnt lgkmcnt(0)" ::: "memory"); \
    for (int d = 0; d < 4; ++d) for (int r = 0; r < 16; ++r) o[d][r] *= al_l[crow(r, hi)]; } } while (0)
  f32x16 pA0, pA1, pB0, pB1; float mnA, mnB, alA, alB; bf16x8 pa0, pa1, pa2, pa3; const int NT = seq / KVBLK;
  constexpr int SE = 0, SO = SDEPTH - 1;
  SLOAD(SE, 0); asm volatile("s_waitcnt vmcnt(0)" ::: "memory"); SWRITE(0, SE); __syncthreads();
  qkt(pA0, pA1, K_lds, qr, r32, hi); partialSM(pA0, pA1, m_reg, mnA, alA);
  SLOAD(SO, KVBLK); if constexpr (SDEPTH == 2) { if (2 < NT) SLOAD(SE, 2 * KVBLK); }
  SWAIT(); SWRITE(1, SO); __syncthreads();
  for (int j = 1; j + 1 < NT; j += 2) {
    SBAR(); qkt(pB0, pB1, (bf16*)((char*)K_lds + SHM_K), qr, r32, hi);
    finishSM(pA0, pA1, alA, l_reg, pa0, pa1, pa2, pa3); SBAR();
    SLOAD(SO, (j + SDEPTH) * KVBLK); SBAR();
    pv_d0(o, vb0, pa0, pa1, pa2, pa3); partialSM(pB0, pB1, m_reg, mnB, alB);
    __syncthreads(); SWAIT(); SWRITE(0, SE);
    RESC(alB); __syncthreads();
    SBAR(); qkt(pA0, pA1, K_lds, qr, r32, hi);
    finishSM(pB0, pB1, alB, l_reg, pa0, pa1, pa2, pa3); SBAR();
    if (SDEPTH == 1 || j + 3 < NT) SLOAD(SE, (j + 1 + SDEPTH) * KVBLK); SBAR();
    pv_d0(o, vb0 + (int)SHM_V, pa0, pa1, pa2, pa3); partialSM(pA0, pA1, m_reg, mnA, alA);
    __syncthreads(); SWAIT(); SWRITE(1, SO);
    RESC(alA); __syncthreads();
  }
  SBAR(); qkt(pB0, pB1, (bf16*)((char*)K_lds + SHM_K), qr, r32, hi);
  finishSM(pA0, pA1, alA, l_reg, pa0, pa1, pa2, pa3); SBAR();
  pv_d0(o, vb0, pa0, pa1, pa2, pa3); partialSM(pB0, pB1, m_reg, mnB, alB);
  __syncthreads(); RESC(alB);
  finishSM(pB0, pB1, alB, l_reg, pa0, pa1, pa2, pa3); SBAR();
  pv_d0(o, vb0 + (int)SHM_V, pa0, pa1, pa2, pa3);
  if (hi == 0) li_l[r32] = l_reg; asm volatile("s_waitcnt lgkmcnt(0)" ::: "memory");
  float rli[16];
#pragma unroll
  for (int r = 0; r < 16; ++r) rli[r] = __builtin_amdgcn_rcpf(li_l[crow(r, hi)]);
  bf16* Ow = Ob + (long)(wid * QBLK) * LDO;
#pragma unroll
  for (int r = 0; r < 16; ++r) { int orow = crow(r, hi);
    for (int d0 = 0; d0 < 4; ++d0) Ow[(long)orow * LDO + d0 * 32 + r32] = (bf16)f2bf(o[d0][r] * rli[r]); }
#undef SLOAD
#undef SWRITE
#undef SWAIT
#undef RESC
}

#undef KSWZ
#undef SBAR
}

namespace ret {
typedef short bf16x8 __attribute__((ext_vector_type(8)));
typedef short s16x4 __attribute__((ext_vector_type(4)));
typedef float f32x16 __attribute__((ext_vector_type(16)));
constexpr int QSTR = 528, KSTR = 576, VSTR = 576, PSTR = 144;
constexpr int QS = 0, KS = QS + 64 * QSTR, VS = KS + 64 * KSTR, PS = VS + 64 * VSTR, LDS_RET = PS + 64 * PSTR;
constexpr int NSTEP = 36, SPLIT = 20;
__device__ __forceinline__ int crow(int r, int hi) { return (r & 3) + 8 * (r >> 2) + 4 * hi; }
__device__ __forceinline__ s16x4 tr_read(const LAS unsigned char* p) { return __builtin_bit_cast(s16x4, __builtin_amdgcn_ds_read_tr16_b64_v4i16((LAS s16x4*)p)); }
__device__ __forceinline__ bf16x8 cat(s16x4 lo, s16x4 hi) { return (bf16x8){lo[0], lo[1], lo[2], lo[3], hi[0], hi[1], hi[2], hi[3]}; }

template <class GridBar>
__device__ __forceinline__ void scan_unit(const bf16_t* RQ, const bf16_t* RK, const bf16_t* RV, bf16_t* YR, const float* l2d, LAS unsigned char* lds, int unit, const GridBar& gridbar, int nb_limit) {
    const int tid = threadIdx.x, lane = tid & 63, w = __builtin_amdgcn_readfirstlane(tid >> 6), r = lane & 31, hh = lane >> 5;
    const int x = unit & 7, y = unit >> 3, eh = y & 1, dir = (y >> 1) & 1, bh = (y >> 2) * 8 + x, b = bh >> 2, h = bh & 3;
    if (b >= nb_limit) { gridbar(); return; }
    const float lg2 = log1pf(-exp2f(l2d[dir * 4 + h])) * 1.4426950408889634f;
    const float gC = exp2f(lg2 * 64.0f);
    const int qA = QS + r * QSTR + hh * 16, kA = KS + r * KSTR + hh * 16, pA = PS + r * PSTR + hh * 16;
    const int sw = ((lane & 1) << 1) | ((lane >> 1) & 1);
    const int trrow = (hh * 8 + ((lane >> 2) & 3));
    const int ktr = KS + trrow * KSTR + (16 * ((lane >> 4) & 1) + 4 * sw) * 2;
    const int vtr = VS + trrow * VSTR + (32 * w + 16 * ((lane >> 4) & 1) + 4 * (lane & 3)) * 2;
    f32x16 S[8];
#pragma unroll
    for (int T = 0; T < 8; ++T) S[T] = (f32x16){0.f};
    for (int s = 0; s < NSTEP; ++s) {
        if (s == SPLIT) gridbar();
        const bool latent = s >= 4;
#if MK_DBG_NOCTX
        if (!latent) continue;
#endif
        const int lc = latent ? (dir ? 35 - s : s - 4) : 0;
        const int krow0 = b * LT + (latent ? LC + 64 * lc : (dir ? 64 * (3 - s) : 64 * s));
        const int qrow0 = b * SEQ + 64 * lc;
        float lg2s = lg2; int hv = hh, rv = r; asm volatile("" : "+v"(lg2s), "+v"(hv), "+v"(rv));
        { v4u kv[4];
#pragma unroll
          for (int n = 0; n < 4; ++n) { const int c = tid + NTHR * n, row = c >> 5, ch = c & 31; kv[n] = *(const v4u*)(RK + (size_t)(krow0 + row) * 1024 + h * 256 + ch * 8); }
#pragma unroll
          for (int n = 0; n < 4; ++n) { const int c = tid + NTHR * n, row = c >> 5, ch = c & 31; *(LAS v4u*)(lds + KS + row * KSTR + ch * 16) = kv[n]; } }
        asm volatile("" ::: "memory");
        { v4u vv[4];
#pragma unroll
          for (int n = 0; n < 4; ++n) { const int c = tid + NTHR * n, row = c >> 5, ch = c & 31; vv[n] = *(const v4u*)(RV + (size_t)(krow0 + row) * 2048 + h * 512 + eh * 256 + ch * 8); }
#pragma unroll
          for (int n = 0; n < 4; ++n) { const int c = tid + NTHR * n, row = c >> 5, ch = c & 31; float t[8]; unpack8(vv[n], t); const float wgt = exp2f(lg2s * (float)(dir ? row : 63 - row));
#pragma unroll
              for (int k = 0; k < 8; ++k) t[k] *= wgt;
              *(LAS v4u*)(lds + VS + row * VSTR + ch * 16) = pack8(t); } }
        asm volatile("" ::: "memory");
        if (latent) { v4u qv[4];
#pragma unroll
          for (int n = 0; n < 4; ++n) { const int c = tid + NTHR * n, row = c >> 5, ch = c & 31; qv[n] = *(const v4u*)(RQ + (size_t)(qrow0 + row) * 1024 + h * 256 + ch * 8); }
#pragma unroll
          for (int n = 0; n < 4; ++n) { const int c = tid + NTHR * n, row = c >> 5, ch = c & 31; *(LAS v4u*)(lds + QS + row * QSTR + ch * 16) = qv[n]; } }
        __syncthreads();
        bf16x8 vf[4];
#define LOAD_VF() _Pragma("unroll") for (int js = 0; js < 4; ++js) vf[js] = cat(tr_read(lds + vtr + (16 * js) * VSTR), tr_read(lds + vtr + (16 * js + 4) * VSTR))
        if (!latent) LOAD_VF();
        if (latent) {
            if (w < 4) { const int it = w >> 1, jt = w & 1; f32x16 sc = (f32x16){0.f};
#pragma unroll
                for (int kk = 0; kk < 16; ++kk) { const bf16x8 a = *(const LAS bf16x8*)(lds + kA + jt * 32 * KSTR + kk * 32), bq = *(const LAS bf16x8*)(lds + qA + it * 32 * QSTR + kk * 32);
                    sc = __builtin_amdgcn_mfma_f32_32x32x16_bf16(a, bq, sc, 0, 0, 0); }
                const int i = it * 32 + rv;
#pragma unroll
                for (int g = 0; g < 4; ++g) { float v4[4];
#pragma unroll
                    for (int k = 0; k < 4; ++k) { const int j = jt * 32 + 8 * g + 4 * hv + k; const bool keep = dir ? (j >= i) : (j <= i); v4[k] = keep ? sc[4 * g + k] : 0.f; }
                    v2u pw; pw.x = cvt_pk_bf16(v4[0], v4[1]); pw.y = cvt_pk_bf16(v4[2], v4[3]);
                    *(LAS v2u*)(lds + PS + i * PSTR + (jt * 32 + 8 * g + 4 * hv) * 2) = pw; } }
            f32x16 acc[2]; acc[0] = (f32x16){0.f}; acc[1] = (f32x16){0.f};
#pragma unroll
            for (int T = 0; T < 8; ++T)
#pragma unroll
                for (int s2 = 0; s2 < 2; ++s2) { v4u bw; bw.x = cvt_pk_bf16(S[T][8 * s2 + 0], S[T][8 * s2 + 1]); bw.y = cvt_pk_bf16(S[T][8 * s2 + 2], S[T][8 * s2 + 3]);
                    bw.z = cvt_pk_bf16(S[T][8 * s2 + 4], S[T][8 * s2 + 5]); bw.w = cvt_pk_bf16(S[T][8 * s2 + 6], S[T][8 * s2 + 7]); const bf16x8 bs = __builtin_bit_cast(bf16x8, bw);
                    const bf16x8 a0 = *(const LAS bf16x8*)(lds + qA + (2 * T + s2) * 32), a1 = *(const LAS bf16x8*)(lds + qA + 32 * QSTR + (2 * T + s2) * 32);
                    acc[0] = __builtin_amdgcn_mfma_f32_32x32x16_bf16(a0, bs, acc[0], 0, 0, 0); acc[1] = __builtin_amdgcn_mfma_f32_32x32x16_bf16(a1, bs, acc[1], 0, 0, 0); }
            LOAD_VF();
            __syncthreads();
#pragma unroll
            for (int js = 0; js < 4; ++js) { const bf16x8 p0 = *(const LAS bf16x8*)(lds + pA + js * 32), p1 = *(const LAS bf16x8*)(lds + pA + 32 * PSTR + js * 32);
                acc[0] = __builtin_amdgcn_mfma_f32_32x32x16_bf16(p0, vf[js], acc[0], 0, 0, 0); acc[1] = __builtin_amdgcn_mfma_f32_32x32x16_bf16(p1, vf[js], acc[1], 0, 0, 0); }
            bf16_t* op = YR + (size_t)qrow0 * 2048 + h * 512 + eh * 256 + 32 * w + rv;
#pragma unroll
            for (int it = 0; it < 2; ++it)
#pragma unroll
                for (int q = 0; q < 16; ++q) { const int i = it * 32 + crow(q, hv); const float rf = exp2f(lg2s * (float)(dir ? -i : i - 63)); float o = acc[it][q] * rf;
                    bf16_t* p = op + (size_t)i * 2048; if (s >= SPLIT) o += bf2f(*p); *p = (bf16_t)f2bf(o); }
        }
#pragma unroll
        for (int T = 0; T < 8; ++T) {
#pragma unroll
            for (int js = 0; js < 4; ++js) { const bf16x8 ka = cat(tr_read(lds + ktr + (16 * js) * KSTR + T * 64), tr_read(lds + ktr + (16 * js + 4) * KSTR + T * 64));
                S[T] = __builtin_amdgcn_mfma_f32_32x32x16_bf16(ka, vf[js], S[T], 0, 0, 0); }
            S[T] *= gC; }
        __syncthreads();
    }
}
#undef LOAD_VF
}

constexpr int RING_BYTES = 131072, LDS_BYTES = 147456;
#ifndef MK_ONE_LAUNCH
#define MK_ONE_LAUNCH 1
#endif
constexpr int N_PHASES = 10;
#define LDS_WAIT() asm volatile("s_waitcnt lgkmcnt(0)" ::: "memory")
constexpr int MISC_OFF = RING_BYTES + 320;
constexpr int CW_BAR = 4096;
constexpr size_t CTL_ZERO_BYTES = 65536;
#ifndef MK_NAIVE_ATTN
#define MK_NAIVE_ATTN 0
#endif
#ifndef MK_NAIVE_RET
#define MK_NAIVE_RET 0
#endif
#ifndef MK_DEBUG_ATTN
#define MK_DEBUG_ATTN 0
#endif
#ifndef MK_DBG_H
#define MK_DBG_H 0
#endif
#ifndef MK_DBG_L0
#define MK_DBG_L0 768
#define MK_DBG_L1 1280
#endif
#ifndef MK_DEBUG_RET
#define MK_DEBUG_RET 0
#endif
#ifndef MK_BARRIER
#define MK_BARRIER 1
#endif
#define XB_TMO      128
#define XB_XCNT(j)  (256  + 64 * (j))
#define XB_XSUB(j)  (1280 + 64 * (j))
#define XB_XGEN(j)  (2304 + 64 * (j))
#define XB_TOP      3328
#define XB_TOPGEN   3392
#define XCD_BAR_WORDS 3456
#define XB_SPIN_CAP (1u << 18)

__device__ __forceinline__ unsigned xb_ld(unsigned* p)              { return __hip_atomic_load(p, __ATOMIC_RELAXED, __HIP_MEMORY_SCOPE_AGENT); }
__device__ __forceinline__ unsigned xb_add(unsigned* p, unsigned v) { return __hip_atomic_fetch_add(p, v, __ATOMIC_RELAXED, __HIP_MEMORY_SCOPE_AGENT); }
__device__ __forceinline__ unsigned xb_xcc_id() { return (unsigned)__builtin_amdgcn_s_getreg((3 << 11) | 20) & 0xFu; }
#define XB_SPIN(cond, bar) do { unsigned _sp = 0; while (cond) { __builtin_amdgcn_s_sleep(1); \
    if ((++_sp & 255u) == 0u) { if (xb_ld(&(bar)[XB_TMO])) break; if (_sp > XB_SPIN_CAP) { atomicAdd(&(bar)[XB_TMO], 1u); break; } } } } while (0)

struct XcdBarrier {
    unsigned* bar; unsigned x;
    volatile LAS unsigned* st;
};

__device__ __forceinline__ XcdBarrier xcd_barrier_post(unsigned* bar, volatile LAS unsigned* st) {
    XcdBarrier b; b.bar = bar; b.x = xb_xcc_id(); b.st = st;
    if (threadIdx.x == 0) (void)xb_add(&bar[XB_XCNT(b.x)], 1u);
    return b;
}
__device__ __forceinline__ void xcd_barrier_complete(unsigned* bar, unsigned x, unsigned& nloc, unsigned& nx) {
    const unsigned G = gridDim.x * gridDim.y * gridDim.z;
    unsigned sum, cnt, mine, sp = 0u;
    for (;;) {
        sum = 0u; cnt = 0u; mine = 0u;
#pragma unroll
        for (unsigned j = 0; j < 16; ++j) { const unsigned c = xb_ld(&bar[XB_XCNT(j)]); sum += c; cnt += (c > 0u) ? 1u : 0u; mine = (j == x) ? c : mine; }
        if (sum == G) break;
        __builtin_amdgcn_s_sleep(1);
        if ((++sp & 255u) == 0u) { if (xb_ld(&bar[XB_TMO])) break; if (sp > XB_SPIN_CAP) { atomicAdd(&bar[XB_TMO], 1u); break; } }
    }
    nloc = mine > 0u ? mine : 1u; nx = cnt > 0u ? cnt : 1u;
}

__device__ __forceinline__ void xcd_barrier(const XcdBarrier& b) {
    asm volatile("s_waitcnt vmcnt(0)" ::: "memory");
    __syncthreads();
    if (threadIdx.x == 0) {
        unsigned* bar = b.bar;
        __builtin_amdgcn_s_waitcnt(0);
        unsigned nloc = b.st[0], nx = b.st[1];
        if (nloc == 0u) { xcd_barrier_complete(bar, b.x, nloc, nx); b.st[0] = nloc; b.st[1] = nx; }
        const unsigned old = xb_add(&bar[XB_XSUB(b.x)], 1u);
        const unsigned gen = old / nloc;
        if (old + 1u == (gen + 1u) * nloc) {
            __builtin_amdgcn_fence(__ATOMIC_RELEASE, "agent");
            asm volatile("s_waitcnt vmcnt(0)" ::: "memory");
            const unsigned og = xb_add(&bar[XB_TOP], 1u);
            const unsigned tg = og / nx;
            if (og + 1u == (tg + 1u) * nx) xb_add(&bar[XB_TOPGEN], 1u);
            else XB_SPIN(xb_ld(&bar[XB_TOPGEN]) == tg, bar);
            __builtin_amdgcn_fence(__ATOMIC_ACQUIRE, "agent");
            xb_add(&bar[XB_XGEN(b.x)], 1u);
            asm volatile("s_waitcnt vmcnt(0)" ::: "memory");
        } else {
            XB_SPIN(xb_ld(&bar[XB_XGEN(b.x)]) == gen, bar);
            __builtin_amdgcn_fence(__ATOMIC_ACQUIRE, "agent");
            asm volatile("s_waitcnt vmcnt(0)" ::: "memory");
        }
    }
    __syncthreads();
}


struct Args { const float* in[14]; float* out; unsigned char* ws; int ph_lo, ph_hi; };

__device__ __forceinline__ void p0_mod_item(const float* c, const float* c_ctx, const float* w_ada, const float* b_ada, float* MOD, float* ldsf, int item, int tid) {
    float* sc = ldsf; float* red = ldsf + 17 * 1024;
    for (int i = tid; i < 17 * 1024; i += NTHR) { const float v = i < 16 * 1024 ? c[i] : c_ctx[i - 16 * 1024]; sc[i] = v / (1.0f + expf(-v)); }
    __syncthreads();
    const int col = tid & 31, ks = tid >> 5, n = item * 32 + col;
    float acc[17];
#pragma unroll
    for (int r = 0; r < 17; ++r) acc[r] = 0.f;
    for (int k = ks * 64; k < ks * 64 + 64; ++k) { const float w = w_ada[(size_t)k * 3072 + n];
#pragma unroll
        for (int r = 0; r < 17; ++r) acc[r] += sc[r * 1024 + k] * w; }
#pragma unroll
    for (int r = 0; r < 17; ++r) red[(ks * 17 + r) * 32 + col] = acc[r];
    __syncthreads();
    for (int o = tid; o < 17 * 32; o += NTHR) { const int r = o >> 5, cc = o & 31; float s = b_ada[item * 32 + cc];
        for (int k2 = 0; k2 < 16; ++k2) s += red[(k2 * 17 + r) * 32 + cc];
        MOD[r * 3072 + item * 32 + cc] = s; }
    __syncthreads();
}
__device__ __forceinline__ void p0_transpose_item(const float* W, int K, int N, bf16_t* WT, int row_off, float* scr, int item, int lane) {
    const int nblk = N / 32, kb = item / nblk, nb = item % nblk, k0 = 64 * kb, n0 = 32 * nb;
#pragma unroll 8
    for (int i = 0; i < 32; ++i) { const int kk = 2 * i + (lane >> 5); scr[kk * 33 + (lane & 31)] = W[(size_t)(k0 + kk) * N + n0 + (lane & 31)]; }
    LDS_WAIT(); asm volatile("" ::: "memory");
    const int c = lane & 7;
#pragma unroll
    for (int j = 0; j < 4; ++j) { const int n = (lane >> 3) + 8 * j; const float* s = scr + (8 * c) * 33 + n;
        v4u o; o.x = pk2(s[0 * 33], s[1 * 33]); o.y = pk2(s[2 * 33], s[3 * 33]); o.z = pk2(s[4 * 33], s[5 * 33]); o.w = pk2(s[6 * 33], s[7 * 33]);
        *(v4u*)(WT + (size_t)(row_off + n0 + n) * K + k0 + 8 * c) = o; }
    LDS_WAIT(); asm volatile("" ::: "memory");
}
__device__ __forceinline__ int new_col(int o) { return o < 4608 ? o : (o < 6656 ? o + 1024 : (o < 7680 ? o - 2048 : o)); }

__device__ __forceinline__ void sincos_d(double a, float& c, float& s) {
    const double TWO_PI = 6.283185307179586476925;
    const double k = (double)(long long)(a / TWO_PI + (a >= 0 ? 0.5 : -0.5)); const double r = a - k * TWO_PI, r2 = r * r;
    double ts = r, ss = r, tc = 1.0, cc = 1.0;
    for (int n = 1; n <= 15; ++n) { tc *= -r2 / (double)((2 * n - 1) * (2 * n)); cc += tc; ts *= -r2 / (double)((2 * n) * (2 * n + 1)); ss += ts; }
    c = (float)cc; s = (float)ss;
}

__device__ __forceinline__ void p1_row(const float* xrow, const float* nw, const float* shift, const float* scale, bf16_t* orow, int lane) {
    const v4f* xr = (const v4f*)xrow + lane; v4f v[4]; float s = 0.f;
#pragma unroll
    for (int j = 0; j < 4; ++j) { v[j] = xr[64 * j]; s += (v[j].x * v[j].x + v[j].y * v[j].y) + (v[j].z * v[j].z + v[j].w * v[j].w); }
    const float rstd = 1.0f / sqrtf(wave_sum(s) * (1.0f / 1024.0f) + EPS);
    v2u* o8 = (v2u*)orow + lane;
#pragma unroll
    for (int j = 0; j < 4; ++j) { const v4f w = ((const v4f*)nw)[lane + 64 * j], sh = ((const v4f*)shift)[lane + 64 * j], sc = ((const v4f*)scale)[lane + 64 * j];
        const v4f y = v[j] * rstd * w * (sc + 1.0f) + sh; v2u o; o.x = pk2(y.x, y.y); o.y = pk2(y.z, y.w); o8[64 * j] = o; }
}

__device__ __forceinline__ void p3_item(bf16_t* buf, int ldlog2, bool isK, const float* nw, const float* ROPE, size_t item, int lane) {
    const size_t e = item * 512 + (size_t)lane * 8; const size_t row = e >> ldlog2; const int col = (int)(e & ((1u << ldlog2) - 1)), d0 = col & 127;
    float t[8]; unpack8(*(const v4u*)(buf + e), t);
    float ss = 0.f;
#pragma unroll
    for (int k = 0; k < 8; ++k) ss += t[k] * t[k];
    ss += __shfl_xor(ss, 1); ss += __shfl_xor(ss, 2); ss += __shfl_xor(ss, 4); ss += __shfl_xor(ss, 8);
    const float rstd = 1.0f / sqrtf(ss * (1.0f / 128.0f) + EPS);
#pragma unroll
    for (int k = 0; k < 8; ++k) t[k] = t[k] * rstd * nw[d0 + k];
    int l; bool rope = true;
    if (isK) { const int p = (int)(row % LT); rope = p >= LC; l = p - LC; } else l = (int)(row & (SEQ - 1));
    if (rope) { const int ri = l >> 6, ci = l & 63, p0 = d0 >> 1; const float* tab = p0 < 32 ? ROPE + (ri * 32 + p0) * 2 : ROPE + (ci * 32 + (p0 - 32)) * 2;
#pragma unroll
        for (int q = 0; q < 4; ++q) { const float cs = tab[2 * q], sn = tab[2 * q + 1], x0 = t[2 * q], x1 = t[2 * q + 1]; t[2 * q] = x0 * cs - x1 * sn; t[2 * q + 1] = x0 * sn + x1 * cs; } }
    *(v4u*)(buf + e) = pack8(t);
}

__device__ __forceinline__ void p4_naive_item(const bf16_t* RQ, const bf16_t* RK, const bf16_t* RV, bf16_t* YR, float* SSQ, const float* l2d, float* ldsf, int item, int tid) {
    const int rb = item & 255, h = (item >> 8) & 3, b = item >> 10, i0 = rb * 8;
    float* qs = ldsf; float* sc = ldsf + 2048; float* red = sc + 8 * LT;
    for (int t = tid; t < 2048; t += NTHR) { const int r = t >> 8, d = t & 255; qs[t] = bf2f(RQ[((size_t)(b * SEQ + i0 + r)) * 1024 + h * 256 + d]); }
    __syncthreads();
    const float lgf = log1pf(-exp2f(l2d[h])), lgb = log1pf(-exp2f(l2d[4 + h]));
    for (int p = tid; p < LT; p += NTHR) {
        const bf16_t* kr = RK + ((size_t)(b * LT + p)) * 1024 + h * 256;
        float dot[8];
#pragma unroll
        for (int r = 0; r < 8; ++r) dot[r] = 0.f;
        for (int d8 = 0; d8 < 32; ++d8) { float kk[8]; unpack8(*(const v4u*)(kr + d8 * 8), kk);
#pragma unroll
            for (int r = 0; r < 8; ++r)
#pragma unroll
                for (int k = 0; k < 8; ++k) dot[r] += qs[r * 256 + d8 * 8 + k] * kk[k]; }
#pragma unroll
        for (int r = 0; r < 8; ++r) { const int i = i0 + r; float W;
            if (p < LC) W = MK_DBG_NOCTX ? 0.f : expf(lgf * (float)(i + LC - p)) + expf(lgb * (float)(SEQ - i + p));
            else { const int j = p - LC; W = (j <= i ? expf(lgf * (float)(i - j)) : 0.f) + (j >= i ? expf(lgb * (float)(j - i)) : 0.f); }
            sc[r * LT + p] = dot[r] * W; }
    }
    __syncthreads();
    float acc[8];
#pragma unroll
    for (int r = 0; r < 8; ++r) acc[r] = 0.f;
    const bf16_t* vp = RV + (size_t)(b * LT) * 2048 + h * 512 + tid;
    for (int p = 0; p < LT; ++p) { const float v = bf2f(vp[(size_t)p * 2048]);
#pragma unroll
        for (int r = 0; r < 8; ++r) acc[r] += sc[r * LT + p] * v; }
    const int wid = tid >> 6, lane = tid & 63;
#pragma unroll
    for (int r = 0; r < 8; ++r) { YR[((size_t)(b * SEQ + i0 + r)) * 2048 + h * 512 + tid] = (bf16_t)f2bf(acc[r]); const float s = wave_sum(acc[r] * acc[r]); if (lane == 0) red[r * 8 + wid] = s; }
    __syncthreads();
    if (tid < 16) { const int r = tid >> 1, hf = tid & 1; const float s = (red[r * 8 + hf * 4] + red[r * 8 + hf * 4 + 1]) + (red[r * 8 + hf * 4 + 2] + red[r * 8 + hf * 4 + 3]);
        SSQ[((size_t)(b * SEQ + i0 + r)) * 8 + h * 2 + hf] = s; }
    __syncthreads();
}

__device__ __forceinline__ void p5_naive_item(bf16_t* AQ, const bf16_t* AK, const bf16_t* AV, float* ldsf, int item, int tid) {
    const int rb = item & 255, head = (item >> 8) & 7, b = item >> 11, g = head >> 2, i0 = rb * 8;
    float* qs = ldsf; float* sc = ldsf + 1024;
    for (int t = tid; t < 1024; t += NTHR) { const int r = t >> 7, d = t & 127; qs[t] = bf2f(AQ[((size_t)(b * SEQ + i0 + r)) * 1024 + head * 128 + d]); }
    __syncthreads();
    for (int p = tid; p < LT; p += NTHR) {
        const bf16_t* kr = AK + ((size_t)(b * LT + p)) * 256 + g * 128;
        float dot[8];
#pragma unroll
        for (int r = 0; r < 8; ++r) dot[r] = 0.f;
        for (int d8 = 0; d8 < 16; ++d8) { float kk[8]; unpack8(*(const v4u*)(kr + d8 * 8), kk);
#pragma unroll
            for (int r = 0; r < 8; ++r)
#pragma unroll
                for (int k = 0; k < 8; ++k) dot[r] += qs[r * 128 + d8 * 8 + k] * kk[k]; }
#pragma unroll
        for (int r = 0; r < 8; ++r) sc[r * LT + p] = dot[r] * 0.08838834764831845f;
    }
    __syncthreads();
    { const int wid = tid >> 6, lane = tid & 63; float* row = sc + wid * LT; float m = -1e30f;
      for (int p = lane; p < LT; p += 64) m = fmaxf(m, row[p]);
#pragma unroll
      for (int o = 1; o < 64; o <<= 1) m = fmaxf(m, __shfl_xor(m, o));
      float s = 0.f;
      for (int p = lane; p < LT; p += 64) { const float ex = expf(row[p] - m); row[p] = ex; s += ex; }
      s = wave_sum(s); const float inv = 1.0f / s;
      for (int p = lane; p < LT; p += 64) row[p] *= inv; }
    __syncthreads();
    const int e = tid & 127, r0 = (tid >> 7) * 2; float a0 = 0.f, a1 = 0.f;
    const bf16_t* vp = AV + (size_t)(b * LT) * 256 + g * 128 + e;
    for (int p = 0; p < LT; ++p) { const float v = bf2f(vp[(size_t)p * 256]); a0 += sc[r0 * LT + p] * v; a1 += sc[(r0 + 1) * LT + p] * v; }
    AQ[((size_t)(b * SEQ + i0 + r0)) * 1024 + head * 128 + e] = (bf16_t)f2bf(a0);
    AQ[((size_t)(b * SEQ + i0 + r0 + 1)) * 1024 + head * 128 + e] = (bf16_t)f2bf(a1);
    __syncthreads();
}

#if MK_BARRIER == 1
struct GridBarF { XcdBarrier b; __device__ __forceinline__ void operator()() const { xcd_barrier(b); } };
#else
struct GridBarF { __device__ __forceinline__ void operator()() const { cooperative_groups::this_grid().sync(); } };
#endif
__device__ __forceinline__ void ssq_item(const bf16_t* YR, float* SSQ, int it, int lane) {
    const int row = it >> 2, head = it & 3; float t[8]; unpack8(*(const v4u*)(YR + (size_t)row * 2048 + head * 512 + lane * 8), t);
    float ss = 0.f;
#pragma unroll
    for (int k = 0; k < 8; ++k) ss += t[k] * t[k];
    ss = wave_sum(ss);
    if (lane == 0) { SSQ[(size_t)row * 8 + head * 2] = ss; SSQ[(size_t)row * 8 + head * 2 + 1] = 0.f; }
}
__global__ void __launch_bounds__(NTHR, 2) mk_fwd(Args args) {
    extern __shared__ __attribute__((aligned(16))) unsigned char lds[];
    const int tid = threadIdx.x, lane = tid & 63, wave = __builtin_amdgcn_readfirstlane(tid >> 6);
    const int G = gridDim.x, bid = blockIdx.x;
    const int gw = bid * NWAVES + wave, NGW = G * NWAVES;
    float* ldsf = (float*)lds;
    unsigned char* ws = args.ws;
    const float *x = args.in[0], *cvec = args.in[1], *ctx = args.in[2], *c_ctx = args.in[3], *norm_w = args.in[4], *w_ada = args.in[5], *b_ada = args.in[6], *w_in = args.in[7],
                *l2d = args.in[8], *q_norm_w = args.in[9], *k_norm_w = args.in[10], *w_o_ret = args.in[11], *w_o_att = args.in[12], *w_out = args.in[13];
    float* MOD = (float*)(ws + WS_MOD); float* ROPE = (float*)(ws + WS_ROPE); float* SSQ = (float*)(ws + WS_SSQ);
    bf16_t *WIN = (bf16_t*)(ws + WS_WIN), *WOR = (bf16_t*)(ws + WS_WOR), *WOA = (bf16_t*)(ws + WS_WOA), *WOUT = (bf16_t*)(ws + WS_WOUT), *HX = (bf16_t*)(ws + WS_HX);
    bf16_t *RK = (bf16_t*)(ws + WS_RK), *RV = (bf16_t*)(ws + WS_RV), *RQ = (bf16_t*)(ws + WS_RQ), *AK = (bf16_t*)(ws + WS_AK), *AV = (bf16_t*)(ws + WS_AV), *AQ = (bf16_t*)(ws + WS_AQ);
    bf16_t *U1 = (bf16_t*)(ws + WS_U1), *U2 = (bf16_t*)(ws + WS_U2), *YR = (bf16_t*)args.out;
    const int lo = args.ph_lo, hi = args.ph_hi;
#define IN(k) (lo <= (k) && (k) < hi)
#define BOTH(k) (IN(k) && IN((k) + 1))
    if (tid < 32) ((LAS unsigned*)(lds + MISC_OFF))[tid] = 0u;
    __syncthreads();
#if MK_BARRIER == 1
    XcdBarrier bar; bar.bar = (unsigned*)(ws + WS_CTL) + CW_BAR; bar.x = 0; bar.st = nullptr;
    if (hi - lo > 1) bar = xcd_barrier_post((unsigned*)(ws + WS_CTL) + CW_BAR, (volatile LAS unsigned*)(lds + MISC_OFF) + 8);
#define GRID_BAR() xcd_barrier(bar)
#else
#define GRID_BAR() cooperative_groups::this_grid().sync()
#endif

    if (IN(0)) {
        for (int it = bid; it < 96; it += G) p0_mod_item(cvec, c_ctx, w_ada, b_ada, MOD, ldsf, it, tid);
        if (bid == G - 1) for (int t = tid; t < 2048; t += NTHR) { const int v = t >> 5, i = t & 31; double fd = 1.0; for (int k = 0; k < i; ++k) fd *= 0.7498942093324559;
            const float ang = (float)v * (float)fd; float cs, sn; sincos_d((double)ang, cs, sn); ROPE[2 * t] = cs; ROPE[2 * t + 1] = sn; }
        float* scr = ldsf + wave * (64 * 33);
        constexpr int I_IN = 16 * (NIN / 32), I_OR = 32 * 32, I_OA = 16 * 32, I_OUT = 16 * 32;
        for (int it = gw; it < I_IN + I_OR + I_OA + I_OUT; it += NGW) {
            int r = it;
            if (r < I_IN) { const int n0 = 32 * (r % (NIN / 32)); p0_transpose_item(w_in, 1024, NIN, WIN, new_col(n0) - n0, scr, r, lane); continue; } r -= I_IN;
            if (r < I_OR) { p0_transpose_item(w_o_ret, 2048, 1024, WOR, 0, scr, r, lane); continue; } r -= I_OR;
            if (r < I_OA) { p0_transpose_item(w_o_att, 1024, 1024, WOA, 0, scr, r, lane); continue; } r -= I_OA;
            p0_transpose_item(w_out, 1024, 1024, WOUT, 0, scr, r, lane);
        }
        if (BOTH(0)) GRID_BAR();
    }
    if (IN(1)) {
        for (int m = gw; m < MALL; m += NGW) {
            if (m < MLAT) { const int b = m >> 11; p1_row(x + (size_t)m * 1024, norm_w, MOD + b * 3072, MOD + b * 3072 + 1024, HX + (size_t)m * 1024, lane); }
            else p1_row(ctx + (size_t)(m - MLAT) * 1024, norm_w, MOD + 16 * 3072, MOD + 16 * 3072 + 1024, HX + (size_t)m * 1024, lane);
        }
        if (BOTH(1)) GRID_BAR();
    }
    if (IN(2)) {
        pg8::Gemm g{HX, WIN, MALL, N1, 1024}; pg8::Sched1 S; S.init(G, bid);
        pg8::Epi1 E{RK, RV, AK, AV, RQ, AQ};
        pg8::gemm_phase<pg8::Epi1, pg8::Sched1, true, true>((PG8_LAS unsigned char*)lds, g, S, E);
        if (BOTH(2)) GRID_BAR();
    }
    if (IN(3)) {
        constexpr size_t IQ = (size_t)MLAT * 1024 / 512, IK = (size_t)NB * LT * 256 / 512;
        for (size_t it = gw; it < IQ + IK; it += NGW) {
            if (it < IQ) p3_item(AQ, 10, false, q_norm_w, ROPE, it, lane); else p3_item(AK, 8, true, k_norm_w, ROPE, it - IQ, lane);
        }
        if (BOTH(3)) GRID_BAR();
    }
#if MK_DEBUG_ATTN
    {
        bf16_t* AQ2 = (bf16_t*)(ws + WS_RK); float* acc2 = (float*)(ws + WS_CTL) + 64;
        for (size_t i = (size_t)bid * NTHR + tid; i < (size_t)MLAT * 1024 / 8; i += (size_t)G * NTHR) ((v4u*)AQ2)[i] = ((const v4u*)AQ)[i];
        GRID_BAR();
        { const int vcu = (bid & 7) * (G >> 3) + (bid >> 3);
          for (int idx = vcu; idx < NB * AH * 8; idx += G) { const int qb = idx & 7, r = (idx >> 3) & 3, g = (idx >> 5) & 1, b = idx >> 6, head = g * 4 + r;
            bf16_t* Q = AQ + ((size_t)(b * SEQ + qb * 256)) * 1024 + head * 128; const bf16_t* K = AK + (size_t)(b * LT) * 256 + g * 128; const bf16_t* V = AV + (size_t)(b * LT) * 256 + g * 128;
            attn::attn_dense_body<attn::bf16>(Q, K, V, Q, LT, (char*)lds); } }
        __syncthreads();
        for (int it = bid; it < NB * AH * 256; it += G) p5_naive_item(AQ2, AK, AV, ldsf, it, tid);
        GRID_BAR();
        float sd = 0.f, sb = 0.f;
        for (size_t i = (size_t)bid * NTHR + tid; i < (size_t)MLAT * 1024; i += (size_t)G * NTHR) { const float a = bf2f(AQ[i]), b2 = bf2f(AQ2[i]); sd += (a - b2) * (a - b2); sb += b2 * b2; }
        sd = wave_sum(sd); sb = wave_sum(sb);
        if (lane == 0) { atomicAdd(acc2, sd); atomicAdd(acc2 + 1, sb); }
        GRID_BAR();
        if (bid == 0 && tid == 0) { const float s0 = __hip_atomic_load(acc2, __ATOMIC_RELAXED, __HIP_MEMORY_SCOPE_AGENT), s1 = __hip_atomic_load(acc2 + 1, __ATOMIC_RELAXED, __HIP_MEMORY_SCOPE_AGENT);
            args.out[0] = 1e6f * sqrtf(s0 / s1); args.out[1] = 1e3f * sqrtf(s1 / ((float)MLAT * 1024.f)); }
        return;
    }
#endif
#if MK_DEBUG_RET
    {
        bf16_t* YR2 = (bf16_t*)(ws + WS_AQ); float* acc2 = (float*)(ws + WS_CTL) + 64;
        for (int it = bid; it < 8 * RH * 256; it += G) p4_naive_item(RQ, RK, RV, YR, SSQ, l2d, ldsf, it, tid);
        __syncthreads();
        { GridBarF gb{bar}; ret::scan_unit(RQ, RK, RV, YR2, l2d, (LAS unsigned char*)lds, bid, gb, 8); }
        GRID_BAR();
        float sd = 0.f, sb = 0.f;
        for (size_t i = (size_t)bid * NTHR + tid; i < (size_t)8 * SEQ * 2048; i += (size_t)G * NTHR) { const int l = (int)((i >> 11) & 2047); if (l < MK_DBG_L0 || l >= MK_DBG_L1 || (int)((i >> 9) & 3) != MK_DBG_H) continue; const float a = bf2f(YR2[i]), b2 = bf2f(YR[i]); sd += (a - b2) * (a - b2); sb += b2 * b2; }
        sd = wave_sum(sd); sb = wave_sum(sb);
        if (lane == 0) { atomicAdd(acc2, sd); atomicAdd(acc2 + 1, sb); }
        GRID_BAR();
        if (bid == 0 && tid == 0) { const float s0 = __hip_atomic_load(acc2, __ATOMIC_RELAXED, __HIP_MEMORY_SCOPE_AGENT), s1 = __hip_atomic_load(acc2 + 1, __ATOMIC_RELAXED, __HIP_MEMORY_SCOPE_AGENT);
            ((float*)(ws + WS_SSQ))[0] = 1e6f * sqrtf(s0 / s1); ((float*)(ws + WS_SSQ))[1] = 1e3f * sqrtf(s1 / (8.f * SEQ * 2048.f)); }
        GRID_BAR();
        if (bid == 0 && tid == 0) { args.out[0] = ((float*)(ws + WS_SSQ))[0]; args.out[1] = ((float*)(ws + WS_SSQ))[1]; }
        return;
    }
#endif
    if (IN(4)) {
#if MK_NAIVE_RET
        for (int it = bid; it < NB * RH * 256; it += G) p4_naive_item(RQ, RK, RV, YR, SSQ, l2d, ldsf, it, tid);
#else
        if (G == 256) { GridBarF gb{bar}; ret::scan_unit(RQ, RK, RV, YR, l2d, (LAS unsigned char*)lds, bid, gb, NB); }
        else for (int it = bid; it < NB * RH * 256; it += G) p4_naive_item(RQ, RK, RV, YR, SSQ, l2d, ldsf, it, tid);
        if (BOTH(4)) GRID_BAR();
#endif
    }
    if (IN(5)) {
#if MK_NAIVE_ATTN
        for (int it = bid; it < NB * AH * 256; it += G) p5_naive_item(AQ, AK, AV, ldsf, it, tid);
#else
        const int vcu = (G % 8 == 0) ? (bid & 7) * (G >> 3) + (bid >> 3) : bid;
        for (int idx = vcu; idx < NB * AH * 8; idx += G) {
            const int qb = idx & 7, r = (idx >> 3) & 3, g = (idx >> 5) & 1, b = idx >> 6, head = g * 4 + r;
            bf16_t* Q = AQ + ((size_t)(b * SEQ + qb * 256)) * 1024 + head * 128;
            const bf16_t* K = AK + (size_t)(b * LT) * 256 + g * 128; const bf16_t* V = AV + (size_t)(b * LT) * 256 + g * 128;
            attn::attn_dense_body<attn::bf16>(Q, K, V, Q, LT, (char*)lds);
        }
#endif
#if !MK_NAIVE_RET
        for (int it = gw; it < MLAT * 4; it += NGW) ssq_item(YR, SSQ, it, lane);
#endif
        if (BOTH(5)) GRID_BAR();
    }
    if (IN(6)) {
        pg8::Gemm g{HX, WIN + (size_t)N1 * 1024, MLAT, NG, 1024}; pg8::StaticOrder S; S.init(MLAT, NG, G, bid);
        pg8::Epi5 E{YR, AQ, U1, U2, SSQ};
        pg8::gemm_phase<pg8::Epi5, pg8::StaticOrder, true, true>((PG8_LAS unsigned char*)lds, g, S, E);
        if (BOTH(6)) GRID_BAR();
    }
    if (IN(7)) {
        pg8::Gemm g{YR, WOR, MLAT, 1024, 2048}; pg8::StaticOrder S; S.init(MLAT, 1024, G, bid);
        pg8::Epi6 E{U1};
        pg8::gemm_phase<pg8::Epi6, pg8::StaticOrder, true, true>((PG8_LAS unsigned char*)lds, g, S, E);
    }
    if (IN(8)) {
        pg8::Gemm g{AQ, WOA, MLAT, 1024, 1024}; pg8::StaticOrder S; S.init(MLAT, 1024, G, bid);
        pg8::Epi7 E{U1, U2};
        pg8::gemm_phase<pg8::Epi7, pg8::StaticOrder, true, true>((PG8_LAS unsigned char*)lds, g, S, E);
        if (BOTH(8)) GRID_BAR();
    }
    if (IN(9)) {
        pg8::Gemm g{U1, WOUT, MLAT, 1024, 1024}; pg8::StaticOrder S; S.init(MLAT, 1024, G, bid);
        pg8::Epi8 E{x, MOD, args.out};
        pg8::gemm_phase<pg8::Epi8, pg8::StaticOrder, true, true>((PG8_LAS unsigned char*)lds, g, S, E);
    }
#undef IN
#undef BOTH
}

extern "C" void kernel_launch(void* const* d_in, const int* in_sizes, int n_in, void* d_out, int out_size, void* d_ws, size_t ws_size, hipStream_t stream) {
    static int grid = 0;
    if (grid == 0) {
        if (n_in != 14 || in_sizes[0] != MLAT * DM || out_size != MLAT * DM || ws_size < WS_END) {
            fprintf(stderr, "kernel_launch: unexpected shapes: n_in %d in0 %d out %d ws %zu (need >= %zu)\n", n_in, n_in > 0 ? in_sizes[0] : -1, out_size, ws_size, (size_t)WS_END); grid = -1; return; }
        int dev = 0, cus = 0;
        if (hipGetDevice(&dev) != hipSuccess || hipDeviceGetAttribute(&cus, hipDeviceAttributeMultiprocessorCount, dev) != hipSuccess) { grid = -1; return; }
        if (hipFuncSetAttribute((const void*)mk_fwd, hipFuncAttributeMaxDynamicSharedMemorySize, LDS_BYTES) != hipSuccess) { fprintf(stderr, "kernel_launch: hipFuncSetAttribute failed\n"); grid = -1; return; }
        grid = cus;
    }
    if (grid < 0) return;
    Args a{};
    for (int i = 0; i < 14; ++i) a.in[i] = (const float*)d_in[i];
    a.out = (float*)d_out; a.ws = (unsigned char*)d_ws;
#if MK_ONE_LAUNCH
    a.ph_lo = 0; a.ph_hi = N_PHASES;
#if MK_BARRIER == 1
    if (hipMemsetAsync((char*)d_ws + WS_CTL, 0, CTL_ZERO_BYTES, stream) != hipSuccess) { fprintf(stderr, "kernel_launch: hipMemsetAsync failed\n"); return; }
    hipLaunchKernelGGL(mk_fwd, dim3(grid), dim3(NTHR), LDS_BYTES, stream, a);
#else
    void* kargs[] = {&a};
    const hipError_t ce = hipLaunchCooperativeKernel((const void*)mk_fwd, dim3(grid), dim3(NTHR), kargs, LDS_BYTES, stream);
    if (ce != hipSuccess) fprintf(stderr, "kernel_launch: cooperative launch failed: %s\n", hipGetErrorName(ce));
#endif
#else
    for (int ph = 0; ph < N_PHASES; ++ph) {
        a.ph_lo = ph; a.ph_hi = ph + 1;
        hipLaunchKernelGGL(mk_fwd, dim3(grid), dim3(NTHR), LDS_BYTES, stream, a);
    }
#endif
    const hipError_t le = hipPeekAtLastError();
    if (le != hipSuccess) fprintf(stderr, "kernel_launch: launch failed: %s\n", hipGetErrorName(le));
}
```

```cpp
#include <hip/hip_runtime.h>
#include <cstdio>
#include <cstdint>
#include <hip/hip_cooperative_groups.h>

constexpr int NB = 16, SEQ = 2048, DM = 1024, LC = 256, LT = LC + SEQ;
constexpr int MLAT = NB * SEQ, MCTX = NB * LC, MALL = MLAT + MCTX;
constexpr int RH = 4, RDK = 256, RDV = 512;
constexpr int AH = 8, AKV = 2, AHD = 128;
constexpr int NIN = 10752, NKV = 3584, N1 = 5632, NG = 5120;
constexpr float EPS = 1e-6f;
#ifndef MK_TIMING
#define MK_TIMING 0
#define MK_TSEL 0
#endif
#ifndef MK_WT
#define MK_WT 1
#endif
#ifndef MK_WT_AUX
#define MK_WT_AUX 18
#endif
#ifndef MK_E6B
#define MK_E6B 4
#define MK_E7B 2
#define MK_E8B 2
#endif
#ifndef MK_E5B
#define MK_E5B 1
#endif
#ifndef MK_P2PROBE
#define MK_P2PROBE 0
#endif
#ifndef MK_RPROBE
#define MK_RPROBE 0
#endif
#ifndef MK_DBG_NOCTX
#define MK_DBG_NOCTX 0
#endif
constexpr int NWAVES = 8, NTHR = 512;
#define LAS __attribute__((address_space(3)))

typedef unsigned short bf16_t;
typedef unsigned v4u __attribute__((ext_vector_type(4)));
typedef unsigned v2u __attribute__((ext_vector_type(2)));
typedef float v4f __attribute__((ext_vector_type(4)));
typedef float v2f __attribute__((ext_vector_type(2)));

__device__ __forceinline__ float bf2f(unsigned h) { return __uint_as_float(h << 16); }
__device__ __forceinline__ unsigned f2bf(float f) { unsigned u = __float_as_uint(f); return (u + 0x7fffu + ((u >> 16) & 1u)) >> 16; }
__device__ __forceinline__ unsigned pk2(float lo, float hi) { return f2bf(lo) | (f2bf(hi) << 16); }
__device__ __forceinline__ float bflo(unsigned w) { return __uint_as_float(w << 16); }
__device__ __forceinline__ float bfhi(unsigned w) { return __uint_as_float(w & 0xffff0000u); }
__device__ __forceinline__ float fast_sigmoid(float x) { return __builtin_amdgcn_rcpf(1.0f + __builtin_amdgcn_exp2f(-1.4426950408889634f * x)); }
__device__ __forceinline__ float fast_silu(float x) { return x * fast_sigmoid(x); }
__device__ __forceinline__ void sigmoid4(const float (&x)[4], float (&s)[4]) {
    float a[4];
#pragma unroll
    for (int k = 0; k < 4; ++k) a[k] = 1.0f + __builtin_amdgcn_exp2f(-1.4426950408889634f * fmaxf(x[k], -20.0f));
    const float p01 = a[0] * a[1], p23 = a[2] * a[3], r = __builtin_amdgcn_rcpf(p01 * p23), r01 = r * p23, r23 = r * p01;
    s[0] = r01 * a[1]; s[1] = r01 * a[0]; s[2] = r23 * a[3]; s[3] = r23 * a[2];
}
__device__ __forceinline__ float wave_sum(float v) {
#pragma unroll
    for (int o = 1; o < 64; o <<= 1) v += __shfl_xor(v, o);
    return v;
}

typedef __bf16 bf16x2_t __attribute__((ext_vector_type(2)));
__device__ __forceinline__ unsigned cvt_pk_bf16(float lo, float hi) { v2f v = {lo, hi}; bf16x2_t b = __builtin_convertvector(v, bf16x2_t); return __builtin_bit_cast(unsigned, b); }
__device__ __forceinline__ void unpack8(const v4u w, float (&o)[8]) {
    o[0] = bflo(w.x); o[1] = bfhi(w.x); o[2] = bflo(w.y); o[3] = bfhi(w.y); o[4] = bflo(w.z); o[5] = bfhi(w.z); o[6] = bflo(w.w); o[7] = bfhi(w.w);
}
__device__ __forceinline__ v4u pack8(const float (&o)[8]) {
    v4u w; w.x = cvt_pk_bf16(o[0], o[1]); w.y = cvt_pk_bf16(o[2], o[3]); w.z = cvt_pk_bf16(o[4], o[5]); w.w = cvt_pk_bf16(o[6], o[7]); return w;
}

constexpr size_t MiB = 1u << 20;
constexpr size_t WS_CTL = 0;
constexpr size_t WS_MOD = 1 * MiB;
constexpr size_t WS_ROPE = WS_MOD + 256 * 1024;
constexpr size_t WS_SSQ = 2 * MiB;
constexpr size_t WS_WIN = 4 * MiB;
constexpr size_t WS_WOR = 25 * MiB;
constexpr size_t WS_WOA = 29 * MiB;
constexpr size_t WS_WOUT = 31 * MiB;
constexpr size_t WS_HX = 33 * MiB;
constexpr size_t WS_RK = 105 * MiB;
constexpr size_t WS_RV = 177 * MiB;
constexpr size_t WS_RQ = 321 * MiB;
constexpr size_t WS_AK = 385 * MiB;
constexpr size_t WS_AV = 403 * MiB;
constexpr size_t WS_AQ = 421 * MiB;
constexpr size_t WS_END = 485 * MiB;
constexpr size_t WS_U1 = WS_RK;
constexpr size_t WS_U2 = WS_RV;

__host__ __device__ __forceinline__ int orig_col(int n) { return n < 4608 ? n : (n < 5632 ? n + 2048 : (n < 7680 ? n - 1024 : n)); }
namespace pg8 {
#define PG8_LAS __attribute__((address_space(3)))
typedef unsigned short bf16_t;
typedef short bf16x8 __attribute__((ext_vector_type(8)));
typedef float f32x4 __attribute__((ext_vector_type(4)));
typedef unsigned u32x4 __attribute__((ext_vector_type(4)));
constexpr int BM = 256, BK = 64, HALF = 128, HTB = HALF * BK * 2  , STAGE_BYTES = 8 * HTB, NXCD = 8, WGM = 8;

__host__ __device__ __forceinline__ int lds_byte(int r, int c) { const int st = (r >> 4) * 2 + (c >> 5), rr = r & 15, cc = c & 31, ob = rr * 64 + cc * 2; return st * 1024 + (ob ^ (((ob >> 9) & 1) << 5)); }
__host__ __device__ __forceinline__ void stage_rc(int b, int& R, int& C) { const int st = b / 1024, sb = b % 1024, swz = sb ^ (((sb >> 9) & 1) << 5); R = (st >> 1) * 16 + swz / 64; C = (st & 1) * 32 + (swz % 64) / 2; }
__host__ __device__ __forceinline__ int perm32(int rho) { const int n = rho >> 4, i = rho & 15; return 8 * (i >> 2) + 4 * n + (i & 3); }

struct Unit { int pm, pn; };
struct Gemm { const bf16_t* A; const bf16_t* Bt; int M, N, K; };

struct StaticOrder {
    int nM, nN, nwg, G, c;
    __host__ __device__ void init(int M, int N, int G_, int c_) { nM = M / BM; nN = N / BM; nwg = nM * nN; G = G_; c = c_; }
    __host__ __device__ bool next(int i, Unit& u) const {
        const long L = (long)i * G + c; if (L >= nwg) return false;
        int wgid = (int)L; { const int q = nwg / NXCD, r = nwg % NXCD, xcd = wgid % NXCD, off = wgid / NXCD; wgid = (xcd < r ? xcd * (q + 1) : r * (q + 1) + (xcd - r) * q) + off; }
        const int nig = WGM * nN, gid = wgid / nig, fm = gid * WGM, gsz = (nM - fm) < WGM ? (nM - fm) : WGM;
        u.pm = fm + ((wgid % nig) % gsz); u.pn = (wgid % nig) / gsz; return true;
    }
    __device__ __forceinline__ void a_ready(const Unit&) const {}
    __device__ __forceinline__ void done(const Unit&) const {}
};


#if MK_WT
#define WT_RSRC(name, baseptr) const __amdgpu_buffer_rsrc_t name = __builtin_amdgcn_make_buffer_rsrc((void*)(baseptr), 0, 0x7ffffff0, 0x00020000)
#define WT_ST16(name, byteoff, val) __builtin_amdgcn_raw_buffer_store_b128((val), name, (unsigned)(byteoff), 0, MK_WT_AUX)
#endif
struct Sched1 {
    int G, c; StaticOrder so;
    __device__ void init(int G_, int c_) { G = G_; c = c_; so.init(MLAT, N1, G_, c_); }
    __device__ bool next(int i, Unit& u) const {
        long L = (long)i * G + c; if (L < 2816) return so.next(i, u);
        L -= 2816; if (L >= 224) return false;
        u.pm = 128 + (int)(L & 15); u.pn = (int)(L >> 4); return true;
    }
    __device__ __forceinline__ void a_ready(const Unit&) const {}
    __device__ __forceinline__ void done(const Unit&) const {}
};

struct RepOrder {
    StaticOrder so; int reps;
    __device__ bool next(int i, Unit& u) const { const int per = (so.nwg - so.c + so.G - 1) / so.G; if (i >= per * reps) return false; return so.next(i % per, u); }
    __device__ __forceinline__ void a_ready(const Unit&) const {}
    __device__ __forceinline__ void done(const Unit&) const {}
};

#define EPI_ROWS_BEGIN const int rt0 = wr * 64 + fr, ct0 = wc * 32 + 8 * fq; \
    _Pragma("unroll") for (int ai = 0; ai < 2; ++ai) _Pragma("unroll") for (int m = 0; m < 4; ++m) { const int rt = rt0 + ai * HALF + m * 16;
#define EPI_ROWS_END }

template <int DUM> struct Epi1T {
    static constexpr bool PERM = true, AFTER_DRAIN = false;
    bf16_t *RK, *RV, *AK, *AV, *RQ, *AQ; bf16_t* DUMMY;
    __device__ __forceinline__ void operator()(const f32x4 (&acc)[2][2][4][2], const Unit& u, int wr, int wc, int fr, int fq) const {
        const int pm = u.pm, pn = u.pn;
        const int kvrow0 = pm < 128 ? ((pm >> 3) * LT + LC + (pm & 7) * 256) : ((pm - 128) * LT);
        bf16_t* base; int ld; float sc = 1.f;
        if (pn < 4) { base = RK + (size_t)kvrow0 * 1024 + pn * 256; ld = 1024; sc = 0.0625f; }
        else if (pn < 12) { base = RV + (size_t)kvrow0 * 2048 + (pn - 4) * 256; ld = 2048; }
        else if (pn == 12) { base = AK + (size_t)kvrow0 * 256; ld = 256; }
        else if (pn == 13) { base = AV + (size_t)kvrow0 * 256; ld = 256; }
        else if (pn < 18) { base = RQ + (size_t)pm * 256 * 1024 + (pn - 14) * 256; ld = 1024; }
        else { base = AQ + (size_t)pm * 256 * 1024 + (pn - 18) * 256; ld = 1024; }
#if MK_P2PROBE
        if constexpr (DUM == 1) { base = DUMMY + (size_t)blockIdx.x * 32768; ld = 256; }
        if constexpr (DUM == 2) {
            const int rb = kvrow0 >> 8;
            if (pn < 4) base = RK + ((size_t)rb * 4 + pn) * 65536; else if (pn < 12) base = RV + ((size_t)rb * 8 + (pn - 4)) * 65536;
            else if (pn < 14) { } else if (pn < 18) base = RQ + ((size_t)pm * 4 + (pn - 14)) * 65536; else base = AQ + ((size_t)pm * 4 + (pn - 18)) * 65536;
            ld = 256; }
#endif
#if (MK_WT & 1)
        const __amdgpu_buffer_rsrc_t rs = __builtin_amdgcn_make_buffer_rsrc((void*)base, 0, 0x7ffffff0, 0x00020000);
#endif
        EPI_ROWS_BEGIN
            bf16_t* rowp = base + (size_t)(DUM == 1 ? (rt & 127) : rt) * ld + ct0;
#pragma unroll
            for (int bj = 0; bj < 2; ++bj) { const f32x4 v0 = acc[ai][bj][m][0] * sc, v1 = acc[ai][bj][m][1] * sc;
                u32x4 w; w.x = cvt_pk_bf16(v0[0], v0[1]); w.y = cvt_pk_bf16(v0[2], v0[3]); w.z = cvt_pk_bf16(v1[0], v1[1]); w.w = cvt_pk_bf16(v1[2], v1[3]);
#if (MK_WT & 1)
                __builtin_amdgcn_raw_buffer_store_b128(w, rs, (unsigned)(((DUM == 1 ? (rt & 127) : rt) * ld + ct0 + bj * HALF) * 2), 0, MK_WT_AUX);
#else
                *(u32x4*)(rowp + bj * HALF) = w;
#endif
                }
        EPI_ROWS_END
    }
};

typedef Epi1T<0> Epi1;
#define EPI_FOR_PIECES _Pragma("unroll") for (int ai = 0; ai < 2; ++ai) _Pragma("unroll") for (int m = 0; m < 4; ++m) _Pragma("unroll") for (int bj = 0; bj < 2; ++bj)
struct Epi5 {
    static constexpr bool PERM = true, AFTER_DRAIN = false;
    bf16_t *YR, *YA, *U1, *U2; const float* SSQ; int dry_unused;
    __device__ __forceinline__ void operator()(const f32x4 (&acc)[2][2][4][2], const Unit& u, int wr, int wc, int fr, int fq) const {
        const int pn = u.pn; const size_t row0 = (size_t)u.pm * 256;
        if (pn < 8) {
            const int head = pn >> 1;
            EPI_ROWS_BEGIN
                const size_t row = row0 + rt;
                const float ss = SSQ[row * 8 + head * 2] + SSQ[row * 8 + head * 2 + 1];
                const float rstd = __builtin_amdgcn_rsqf(ss * (1.0f / 512.0f) + EPS);
#pragma unroll
                for (int bj = 0; bj < 2; ++bj) { u32x4* p = (u32x4*)(YR + row * 2048 + pn * 256 + bj * HALF + ct0); float o[8]; unpack8(*p, o);
                    const f32x4 v0 = acc[ai][bj][m][0], v1 = acc[ai][bj][m][1];
                    { const float x0[4] = {v0[0], v0[1], v0[2], v0[3]}, x1[4] = {v1[0], v1[1], v1[2], v1[3]}; float s0[4], s1[4]; sigmoid4(x0, s0); sigmoid4(x1, s1);
#pragma unroll
                    for (int k = 0; k < 4; ++k) { o[k] = o[k] * rstd * (x0[k] * s0[k]); o[4 + k] = o[4 + k] * rstd * (x1[k] * s1[k]); } }
                    *p = pack8(o); }
            EPI_ROWS_END
        } else if (pn < 12) {
            EPI_ROWS_BEGIN
                const size_t row = row0 + rt;
#pragma unroll
                for (int bj = 0; bj < 2; ++bj) { u32x4* p = (u32x4*)(YA + row * 1024 + (pn - 8) * 256 + bj * HALF + ct0); float o[8]; unpack8(*p, o);
                    const f32x4 v0 = acc[ai][bj][m][0], v1 = acc[ai][bj][m][1];
                    { const float x0[4] = {v0[0], v0[1], v0[2], v0[3]}, x1[4] = {v1[0], v1[1], v1[2], v1[3]}; float s0[4], s1[4]; sigmoid4(x0, s0); sigmoid4(x1, s1);
#pragma unroll
                    for (int k = 0; k < 4; ++k) { o[k] = o[k] * (x0[k] * s0[k]); o[4 + k] = o[4 + k] * (x1[k] * s1[k]); } }
                    *p = pack8(o); }
            EPI_ROWS_END
        } else {
            bf16_t* U = pn < 16 ? U1 + (pn - 12) * 256 : U2 + (pn - 16) * 256;
            EPI_ROWS_BEGIN
                const size_t row = row0 + rt;
#pragma unroll
                for (int bj = 0; bj < 2; ++bj) { float o[8]; const f32x4 v0 = acc[ai][bj][m][0], v1 = acc[ai][bj][m][1];
                    { const float x0[4] = {v0[0], v0[1], v0[2], v0[3]}, x1[4] = {v1[0], v1[1], v1[2], v1[3]}; float s0[4], s1[4]; sigmoid4(x0, s0); sigmoid4(x1, s1);
#pragma unroll
                    for (int k = 0; k < 4; ++k) { o[k] = s0[k]; o[4 + k] = s1[k]; } }
                    *(u32x4*)(U + row * 1024 + bj * HALF + ct0) = pack8(o); }
            EPI_ROWS_END
        }
    }
};

struct Epi6 {
    static constexpr bool PERM = true, AFTER_DRAIN = false;
    bf16_t* U1;
    __device__ __forceinline__ void operator()(const f32x4 (&acc)[2][2][4][2], const Unit& u, int wr, int wc, int fr, int fq) const {
        bf16_t* base = U1 + ((size_t)u.pm * 256 + wr * 64 + fr) * 1024 + u.pn * 256 + wc * 32 + 8 * fq;
#if (MK_WT & 2)
        WT_RSRC(rs, U1 + (size_t)u.pm * 256 * 1024 + u.pn * 256);
#endif
#pragma unroll
        for (int ai = 0; ai < 2; ++ai)
#pragma unroll
          for (int mb = 0; mb < 4; mb += MK_E6B) {
            u32x4 pc[MK_E6B][2];
#pragma unroll
            for (int mi = 0; mi < MK_E6B; ++mi)
#pragma unroll
                for (int bj = 0; bj < 2; ++bj) pc[mi][bj] = *(const u32x4*)(base + (size_t)(ai * HALF + (mb + mi) * 16) * 1024 + bj * HALF);
#pragma unroll
            for (int mi = 0; mi < MK_E6B; ++mi)
#pragma unroll
                for (int bj = 0; bj < 2; ++bj) { const int m = mb + mi; float o[8]; unpack8(pc[mi][bj], o); const f32x4 v0 = acc[ai][bj][m][0], v1 = acc[ai][bj][m][1];
#pragma unroll
                    for (int k = 0; k < 4; ++k) { o[k] *= v0[k]; o[4 + k] *= v1[k]; }
                    *(u32x4*)(base + (size_t)(ai * HALF + m * 16) * 1024 + bj * HALF) = pack8(o); }
          }
    }
};
struct Epi7 {
    static constexpr bool PERM = true, AFTER_DRAIN = false;
    bf16_t* U1; const bf16_t* U2;
    __device__ __forceinline__ void operator()(const f32x4 (&acc)[2][2][4][2], const Unit& u, int wr, int wc, int fr, int fq) const {
        const size_t off0 = ((size_t)u.pm * 256 + wr * 64 + fr) * 1024 + u.pn * 256 + wc * 32 + 8 * fq;
#if (MK_WT & 4)
        WT_RSRC(rs, U1 + (size_t)u.pm * 256 * 1024 + u.pn * 256);
#endif
#pragma unroll
        for (int q4 = 0; q4 < 8; q4 += MK_E7B) {
            const int ai = q4 >> 2, mb = q4 & 3; u32x4 pc[MK_E7B][2], pg[MK_E7B][2];
#pragma unroll
            for (int m2 = 0; m2 < MK_E7B; ++m2)
#pragma unroll
                for (int bj = 0; bj < 2; ++bj) { const size_t off = off0 + (size_t)(ai * HALF + (mb + m2) * 16) * 1024 + bj * HALF; pc[m2][bj] = *(const u32x4*)(U1 + off); pg[m2][bj] = *(const u32x4*)(U2 + off); }
#pragma unroll
            for (int m2 = 0; m2 < MK_E7B; ++m2)
#pragma unroll
                for (int bj = 0; bj < 2; ++bj) { const int m = mb + m2; const size_t off = off0 + (size_t)(ai * HALF + m * 16) * 1024 + bj * HALF; float o[8], g[8]; unpack8(pc[m2][bj], o); unpack8(pg[m2][bj], g);
                    const f32x4 v0 = acc[ai][bj][m][0], v1 = acc[ai][bj][m][1];
#pragma unroll
                    for (int k = 0; k < 4; ++k) { o[k] += g[k] * v0[k]; o[4 + k] += g[4 + k] * v1[k]; }
                    *(u32x4*)(U1 + off) = pack8(o); }
        }
    }
};
struct Epi8 {
    static constexpr bool PERM = true, AFTER_DRAIN = false;
    const float* X; const float* MOD; float* OUT;
    __device__ __forceinline__ void operator()(const f32x4 (&acc)[2][2][4][2], const Unit& u, int wr, int wc, int fr, int fq) const {
        const int col0 = u.pn * 256 + wc * 32 + 8 * fq; const size_t off0 = ((size_t)u.pm * 256 + wr * 64 + fr) * 1024 + col0; const float* gate = MOD + (size_t)(u.pm >> 3) * 3072 + 2048 + col0;
        f32x4 gv[2][2];
#if (MK_WT & 8)
        WT_RSRC(rs, OUT + (size_t)u.pm * 256 * 1024 + u.pn * 256);
#endif
#pragma unroll
        for (int bj = 0; bj < 2; ++bj)
#pragma unroll
            for (int n = 0; n < 2; ++n) gv[bj][n] = *(const f32x4*)(gate + bj * HALF + 4 * n);
#pragma unroll
        for (int q4 = 0; q4 < 8; q4 += MK_E8B) {
            const int ai = q4 >> 2, mb = q4 & 3; f32x4 xv[MK_E8B][2][2];
#pragma unroll
            for (int m2 = 0; m2 < MK_E8B; ++m2)
#pragma unroll
                for (int bj = 0; bj < 2; ++bj)
#pragma unroll
                    for (int n = 0; n < 2; ++n) xv[m2][bj][n] = *(const f32x4*)(X + off0 + (size_t)(ai * HALF + (mb + m2) * 16) * 1024 + bj * HALF + 4 * n);
#pragma unroll
            for (int m2 = 0; m2 < MK_E8B; ++m2)
#pragma unroll
                for (int bj = 0; bj < 2; ++bj)
#pragma unroll
                    for (int n = 0; n < 2; ++n) *(f32x4*)(OUT + off0 + (size_t)(ai * HALF + (mb + m2) * 16) * 1024 + bj * HALF + 4 * n) = xv[m2][bj][n] + gv[bj][n] * acc[ai][bj][mb + m2][n];
        }
    }
};
struct EpiNull {
    static constexpr bool PERM = true, AFTER_DRAIN = false;
    __device__ __forceinline__ void operator()(const f32x4 (&acc)[2][2][4][2], const Unit& u, int wr, int wc, int fr, int fq) const {
#pragma unroll
        for (int ai = 0; ai < 2; ++ai)
#pragma unroll
            for (int bj = 0; bj < 2; ++bj)
#pragma unroll
                for (int m = 0; m < 4; ++m)
#pragma unroll
                    for (int n = 0; n < 2; ++n) asm volatile("" :: "v"(acc[ai][bj][m][n]));
    }
};
template <int N> __device__ __forceinline__ void wait_vm_sel(int sel) { asm volatile("s_waitcnt vmcnt(%1)\n\ts_cmp_lg_u32 %0, 0\n\ts_cbranch_scc1 .Lwvs%=\n\ts_waitcnt vmcnt(8)\n.Lwvs%=:" :: "s"(sel), "n"(N) : "memory", "scc"); }
template <class Epi, class Sched, bool ALIGN_EPI = false, bool SP2 = false, int EPIW = 0>
__device__ __forceinline__ void gemm_phase(PG8_LAS unsigned char* lds, const Gemm g, const Sched& S, const Epi& E) {
    const int tid = threadIdx.x, wid = __builtin_amdgcn_readfirstlane(tid >> 6), lane = tid & 63, wr = wid >> 2, wc = wid & 3, fr = lane & 15, fq = lane >> 4;
    const int K = g.K, nt = K / BK;
    unsigned voffA[2], voffB[2];
#pragma unroll
    for (int i = 0; i < 2; ++i) { int R, C; stage_rc(tid * 16 + i * 8192, R, C); const int Rb = Epi::PERM ? ((R & ~31) + perm32(R & 31)) : R;
        voffA[i] = (unsigned)(R * K + C) * 2u; voffB[i] = (unsigned)(Rb * K + C) * 2u; }
    const size_t kstep = (size_t)(BK * 2);
    const size_t hstep = (size_t)HALF * K * 2;
    const size_t tstep = 2 * hstep;
    const unsigned ldsw = (unsigned)wid * 1024u;
    const int aoff = lds_byte(wr * 64 + fr, fq * 8), boff = lds_byte(wc * 32 + fr, fq * 8);
#define PG8_SA(b, h) (((b) * 2 + (h)) * HTB)
#define PG8_SB(b, h) ((4 + (b) * 2 + (h)) * HTB)
#define PG8_STAGE(bufoff, gbase, voff) do { _Pragma("unroll") for (int _i = 0; _i < 2; ++_i) \
        __builtin_amdgcn_global_load_lds((const unsigned*)((const char*)(gbase) + (voff)[_i]), (PG8_LAS unsigned*)(lds + (bufoff) + ldsw + _i * 8192), 16, 0, 0); } while (0)
#define PG8_LDA(dst, b, h) do { _Pragma("unroll") for (int m = 0; m < 4; ++m) _Pragma("unroll") for (int k = 0; k < 2; ++k) dst[m][k] = *(const PG8_LAS bf16x8*)(lds + PG8_SA(b, h) + aoff + m * 2048 + k * 1024); } while (0)
#define PG8_LDB(dst, b, h) do { _Pragma("unroll") for (int n = 0; n < 2; ++n) _Pragma("unroll") for (int k = 0; k < 2; ++k) dst[n][k] = *(const PG8_LAS bf16x8*)(lds + PG8_SB(b, h) + boff + n * 2048 + k * 1024); } while (0)
#define PG8_MMA(ai, bj, At, Bt) do { __builtin_amdgcn_s_setprio(1); _Pragma("unroll") for (int m = 0; m < 4; ++m) _Pragma("unroll") for (int n = 0; n < 2; ++n) _Pragma("unroll") for (int k = 0; k < 2; ++k) \
        acc[ai][bj][m][n] = __builtin_amdgcn_mfma_f32_16x16x32_bf16(Bt[n][k], At[m][k], acc[ai][bj][m][n], 0, 0, 0); __builtin_amdgcn_s_setprio(0); } while (0)
#define PG8_WAIT_V(n) asm volatile("s_waitcnt vmcnt(" #n ")" ::: "memory")
#define PG8_WAIT_L(n) asm volatile("s_waitcnt lgkmcnt(" #n ")" ::: "memory")
#define PG8_BAR __builtin_amdgcn_s_barrier()
#define PG8_SCHED __builtin_amdgcn_sched_barrier(0)
    Unit cur, nxt; int ui = 0;
    if (!S.next(0, cur)) return;
    f32x4 acc[2][2][4][2];
#pragma unroll
    for (int a = 0; a < 2; ++a)
#pragma unroll
        for (int b = 0; b < 2; ++b)
#pragma unroll
            for (int m = 0; m < 4; ++m)
#pragma unroll
                for (int n = 0; n < 2; ++n) acc[a][b][m][n] = (f32x4){0.f, 0.f, 0.f, 0.f};
    bf16x8 At[4][2], B0[2][2], B1[2][2];
    const char* cA = (const char*)g.A + (size_t)cur.pm * tstep; const char* cB = (const char*)g.Bt + (size_t)cur.pn * tstep;
    S.a_ready(cur);
    if constexpr (SP2) {
        PG8_STAGE(PG8_SB(0, 0), cB, voffB); PG8_STAGE(PG8_SB(0, 1), cB + hstep, voffB); PG8_STAGE(PG8_SA(0, 0), cA, voffA); PG8_STAGE(PG8_SA(0, 1), cA + hstep, voffA);
        if (wr == 1) PG8_BAR;
        PG8_WAIT_V(2); PG8_BAR;
        PG8_STAGE(PG8_SB(1, 0), cB + kstep, voffB); PG8_STAGE(PG8_SA(1, 0), cA + kstep, voffA); PG8_STAGE(PG8_SB(1, 1), cB + hstep + kstep, voffB);
        PG8_WAIT_V(6); PG8_BAR;
    } else {
        PG8_STAGE(PG8_SB(0, 0), cB, voffB); PG8_STAGE(PG8_SA(0, 0), cA, voffA); PG8_STAGE(PG8_SB(0, 1), cB + hstep, voffB); PG8_STAGE(PG8_SA(0, 1), cA + hstep, voffA);
        if (wr == 1) PG8_BAR;
        PG8_WAIT_V(4); PG8_BAR;
        PG8_STAGE(PG8_SB(1, 0), cB + kstep, voffB); PG8_STAGE(PG8_SA(1, 0), cA + kstep, voffA); PG8_STAGE(PG8_SB(1, 1), cB + hstep + kstep, voffB);
        PG8_WAIT_V(6); PG8_BAR;
    }
    for (;;) {
        const bool has_next = S.next(ui + 1, nxt);
        const char* nA = has_next ? (const char*)g.A + (size_t)nxt.pm * tstep : cA; const char* nB = has_next ? (const char*)g.Bt + (size_t)nxt.pn * tstep : cB;
        for (int t = 0; t < nt; t += 2) {
            const bool last = (t == nt - 2);
            const char* a1 = cA + (size_t)(t + 1) * kstep;
            const char* a2 = last ? nA : cA + (size_t)(t + 2) * kstep; const char* b2 = last ? nB : cB + (size_t)(t + 2) * kstep;
            const char* a3 = a2 + kstep; const char* b3 = b2 + kstep;
            if (last && has_next) S.a_ready(nxt);
            const int fe = __builtin_amdgcn_readfirstlane(((EPIW > 0) && (t == 0) && (ui > 0)) ? 1 : 0);
            if constexpr (SP2) {
            PG8_LDB(B0, 0, 0); PG8_LDB(B1, 0, 1); PG8_SCHED; PG8_LDA(At, 0, 0); PG8_STAGE(PG8_SA(1, 1), a1 + hstep, voffA);
            if constexpr (EPIW > 0) wait_vm_sel<8 + EPIW>(fe); else PG8_WAIT_V(8); PG8_WAIT_L(0); PG8_BAR; PG8_MMA(0, 0, At, B0); PG8_MMA(0, 1, At, B1); PG8_BAR; PG8_SCHED;
            PG8_LDA(At, 0, 1); PG8_STAGE(PG8_SB(0, 0), b2, voffB); PG8_STAGE(PG8_SB(0, 1), b2 + hstep, voffB); PG8_STAGE(PG8_SA(0, 0), a2, voffA);
            if constexpr (EPIW > 0) wait_vm_sel<8 + EPIW>(fe); else PG8_WAIT_V(8); PG8_WAIT_L(0); PG8_BAR; PG8_MMA(1, 0, At, B0); PG8_MMA(1, 1, At, B1); PG8_BAR; PG8_SCHED;
            PG8_LDB(B0, 1, 0); PG8_LDB(B1, 1, 1); PG8_SCHED; PG8_LDA(At, 1, 0); PG8_STAGE(PG8_SA(0, 1), a2 + hstep, voffA);
            PG8_WAIT_V(8); PG8_WAIT_L(0); PG8_BAR; PG8_MMA(0, 0, At, B0); PG8_MMA(0, 1, At, B1); PG8_BAR; PG8_SCHED;
            PG8_LDA(At, 1, 1); PG8_STAGE(PG8_SB(1, 0), b3, voffB); PG8_STAGE(PG8_SB(1, 1), b3 + hstep, voffB); PG8_STAGE(PG8_SA(1, 0), a3, voffA);
            PG8_WAIT_V(8); PG8_WAIT_L(0); PG8_BAR; PG8_MMA(1, 0, At, B0); PG8_MMA(1, 1, At, B1); PG8_BAR; PG8_SCHED;
            } else {
            PG8_LDB(B0, 0, 0); PG8_SCHED; PG8_LDA(At, 0, 0); PG8_STAGE(PG8_SA(1, 1), a1 + hstep, voffA);
            PG8_WAIT_L(8); PG8_BAR; PG8_WAIT_L(0); PG8_MMA(0, 0, At, B0); PG8_BAR; PG8_SCHED;
            PG8_LDB(B1, 0, 1); PG8_STAGE(PG8_SB(0, 0), b2, voffB);
            PG8_BAR; PG8_WAIT_L(0); PG8_MMA(0, 1, At, B1); PG8_BAR;
            PG8_LDA(At, 0, 1); PG8_STAGE(PG8_SA(0, 0), a2, voffA);
            PG8_BAR; PG8_WAIT_L(0); PG8_MMA(1, 0, At, B0); PG8_BAR; PG8_SCHED;
            PG8_STAGE(PG8_SB(0, 1), b2 + hstep, voffB);
            PG8_WAIT_V(6); PG8_BAR; PG8_MMA(1, 1, At, B1); PG8_BAR;
            PG8_LDB(B0, 1, 0); PG8_SCHED; PG8_LDA(At, 1, 0); PG8_STAGE(PG8_SA(0, 1), a2 + hstep, voffA);
            PG8_WAIT_L(8); PG8_BAR; PG8_WAIT_L(0); PG8_MMA(0, 0, At, B0); PG8_BAR; PG8_SCHED;
            PG8_LDB(B1, 1, 1); PG8_STAGE(PG8_SB(1, 0), b3, voffB);
            PG8_BAR; PG8_WAIT_L(0); PG8_MMA(0, 1, At, B1); PG8_BAR;
            PG8_LDA(At, 1, 1); PG8_STAGE(PG8_SA(1, 0), a3, voffA);
            PG8_BAR; PG8_WAIT_L(0); PG8_MMA(1, 0, At, B0); PG8_BAR; PG8_SCHED;
            PG8_STAGE(PG8_SB(1, 1), b3 + hstep, voffB);
            PG8_WAIT_V(6); PG8_BAR; PG8_MMA(1, 1, At, B1); PG8_BAR;
            }
        }
        if constexpr (ALIGN_EPI) { if (wr == 0) PG8_BAR; }
        if constexpr (EPIW > 0) { static_assert(EPIW == 0 || (ALIGN_EPI && SP2), "EPIW needs ALIGN_EPI and SP2");
            }
        if constexpr (!Epi::AFTER_DRAIN) { E(acc, cur, wr, wc, fr, fq); S.done(cur); }
        if (!has_next) break;
#pragma unroll
        for (int a = 0; a < 2; ++a)
#pragma unroll
            for (int b = 0; b < 2; ++b)
#pragma unroll
                for (int m = 0; m < 4; ++m)
#pragma unroll
                    for (int n = 0; n < 2; ++n) acc[a][b][m][n] = (f32x4){0.f, 0.f, 0.f, 0.f};
        cur = nxt; cA = nA; cB = nB; ++ui;
        if constexpr (ALIGN_EPI) { if (wr == 1) PG8_BAR; }
    }
    PG8_WAIT_V(0);
    if constexpr (!ALIGN_EPI) { if (wr == 0) PG8_BAR; }
    PG8_BAR;
    if constexpr (Epi::AFTER_DRAIN) { E.fused(acc, cur, wr, wc, fr, fq, lds, wid, lane); S.done(cur); }
#undef PG8_SA
#undef PG8_SB
#undef PG8_STAGE
#undef PG8_LDA
#undef PG8_LDB
#undef PG8_MMA
#undef PG8_WAIT_V
#undef PG8_WAIT_L
#undef PG8_BAR
#undef PG8_SCHED
}
}

namespace attn {
constexpr int   D = 128, NW = 8, QBLK = 32, KVBLK = 64;
constexpr float SCALE = 0.088388347648318440f;
constexpr float THR = 8.f;
constexpr int SDEPTH = 2;
constexpr int LDQ = 1024, LDK = 256, LDO = 1024;
constexpr size_t SHM_V = KVBLK * D * 2, SHM_K = KVBLK * D * 2, SHM_ATTN = 2 * SHM_V + 2 * SHM_K + NW * 64 * 4;
typedef unsigned short bf16;
using bf16x8 = __attribute__((ext_vector_type(8))) short;
using s16x4  = __attribute__((ext_vector_type(4))) short;
using f32x16 = __attribute__((ext_vector_type(16))) float;
using f32x8  = __attribute__((ext_vector_type(8))) float;
using u32x4  = __attribute__((ext_vector_type(4))) unsigned;
#define KSWZ(row, colB) ((row) * 256 + ((colB) ^ (((row) & 7) << 4)))
#define SBAR() __builtin_amdgcn_sched_barrier(0)
__device__ __forceinline__ int crow(int r, int hi) { return (r & 3) + 8 * (r >> 2) + 4 * hi; }
__device__ __forceinline__ unsigned cvtpk(float lo, float hi) { return cvt_pk_bf16(lo, hi); }
template <typename TIn> struct Stage;
template <> struct Stage<bf16>  { using T = bf16x8;
  __device__ static __forceinline__ T ld8(const bf16* p) { return *reinterpret_cast<const bf16x8*>(p); }
  __device__ static __forceinline__ bf16x8 tobf(T x) { return x; } };
__device__ __forceinline__ void partialSM(f32x16& p0, f32x16& p1, float& m_reg, float& mn, float& alpha) {
  constexpr float C = SCALE * 1.4426950408889634f;
  float pmax = p0[0]; for (int r = 1; r < 16; ++r) pmax = fmaxf(pmax, p0[r]); for (int r = 0; r < 16; ++r) pmax = fmaxf(pmax, p1[r]);
  { auto rr = __builtin_amdgcn_permlane32_swap(__float_as_uint(pmax), __float_as_uint(pmax), false, false);
    pmax = fmaxf(__uint_as_float(rr[0]), __uint_as_float(rr[1])); }
  if (__builtin_expect(__all(pmax - m_reg <= THR / SCALE), 1)) { mn = m_reg; alpha = 1.f; }
  else { mn = fmaxf(m_reg, pmax); alpha = __builtin_amdgcn_exp2f((m_reg - mn) * C); m_reg = mn; }
  float mnC = -mn * C;
  for (int r = 0; r < 16; ++r) p0[r] = fmaf(p0[r], C, mnC); for (int r = 0; r < 16; ++r) p1[r] = fmaf(p1[r], C, mnC);
  for (int r = 0; r < 16; ++r) p0[r] = __builtin_amdgcn_exp2f(p0[r]);
}
__device__ __forceinline__ void finishSM(f32x16& p0, f32x16& p1, float alpha, float& l_reg, bf16x8& pa0, bf16x8& pa1, bf16x8& pa2, bf16x8& pa3) {
  for (int r = 0; r < 16; ++r) p1[r] = __builtin_amdgcn_exp2f(p1[r]);
  float ps = 0; for (int r = 0; r < 16; ++r) ps += p0[r]; for (int r = 0; r < 16; ++r) ps += p1[r];
  { auto rr = __builtin_amdgcn_permlane32_swap(__float_as_uint(ps), __float_as_uint(ps), false, false);
    ps = __uint_as_float(rr[0]) + __uint_as_float(rr[1]); }
  l_reg = l_reg * alpha + ps;
#define PK4(P, BASE, OUT) do { unsigned a0 = cvtpk(P[BASE + 0], P[BASE + 1]), a1 = cvtpk(P[BASE + 2], P[BASE + 3]);   \
    unsigned b0 = cvtpk(P[BASE + 4], P[BASE + 5]), b1 = cvtpk(P[BASE + 6], P[BASE + 7]);                              \
    auto r0 = __builtin_amdgcn_permlane32_swap(a0, b0, false, false); auto r1 = __builtin_amdgcn_permlane32_swap(a1, b1, false, false); \
    u32x4 w = {r0[0], r1[0], r0[1], r1[1]}; OUT = *reinterpret_cast<bf16x8*>(&w); } while (0)
  PK4(p0, 0, pa0); PK4(p0, 8, pa1); PK4(p1, 0, pa2); PK4(p1, 8, pa3);
#undef PK4
}
__device__ __forceinline__ void qkt(f32x16& p0, f32x16& p1, const bf16* Ks, const bf16x8* qr, int r32, int hi) {
  p0 = f32x16{}; p1 = f32x16{};
  for (int d0 = 0; d0 < 8; ++d0) { int cb = (d0 * 16 + hi * 8) * 2;
    bf16x8 b0 = *reinterpret_cast<const bf16x8*>((const char*)Ks + KSWZ(r32, cb));
    bf16x8 b1 = *reinterpret_cast<const bf16x8*>((const char*)Ks + KSWZ(32 + r32, cb));
    p0 = __builtin_amdgcn_mfma_f32_32x32x16_bf16(b0, qr[d0], p0, 0, 0, 0);
    p1 = __builtin_amdgcn_mfma_f32_32x32x16_bf16(b1, qr[d0], p1, 0, 0, 0); }
}
__device__ __forceinline__ int v_st(int k, int c) { const int kk = (k & ~0xC) | ((k & 4) << 1) | ((k & 8) >> 1); return ((kk >> 3) * 4 + (c >> 5)) * 512 + ((kk & 7) * 32 + (c & 31)) * 2; }
__device__ __forceinline__ int v_rd_base(int lane) { return ((lane & 3) << 3) | (((lane >> 2) & 3) << 6) | (((lane >> 4) & 1) << 5) | (((lane >> 5) & 1) << 8); }
constexpr int v_rd_off(int d0, int ks, int half) { return d0 * 512 + ks * 4096 + half * 2048; }
template <int OFF> __device__ __forceinline__ s16x4 tr_read(int vb) {
  s16x4 r; asm volatile("ds_read_b64_tr_b16 %0, %1 offset:%2" : "=&v"(r) : "v"(vb), "i"(OFF) : "memory"); return r;
}
template <int D0> __device__ __forceinline__ void pv_one(f32x16& od, int vb, bf16x8 pa0, bf16x8 pa1, bf16x8 pa2, bf16x8 pa3) {
  const s16x4 l0 = tr_read<v_rd_off(D0, 0, 0)>(vb), h0 = tr_read<v_rd_off(D0, 0, 1)>(vb), l1 = tr_read<v_rd_off(D0, 1, 0)>(vb), h1 = tr_read<v_rd_off(D0, 1, 1)>(vb);
  const s16x4 l2 = tr_read<v_rd_off(D0, 2, 0)>(vb), h2 = tr_read<v_rd_off(D0, 2, 1)>(vb), l3 = tr_read<v_rd_off(D0, 3, 0)>(vb), h3 = tr_read<v_rd_off(D0, 3, 1)>(vb);
  asm volatile("s_waitcnt lgkmcnt(0)" ::: "memory"); SBAR();
#define PK(L, H) (bf16x8){L[0], L[1], L[2], L[3], H[0], H[1], H[2], H[3]}
  od = __builtin_amdgcn_mfma_f32_32x32x16_bf16(pa0, PK(l0, h0), od, 0, 0, 0);
  od = __builtin_amdgcn_mfma_f32_32x32x16_bf16(pa1, PK(l1, h1), od, 0, 0, 0);
  od = __builtin_amdgcn_mfma_f32_32x32x16_bf16(pa2, PK(l2, h2), od, 0, 0, 0);
  od = __builtin_amdgcn_mfma_f32_32x32x16_bf16(pa3, PK(l3, h3), od, 0, 0, 0);
#undef PK
}
__device__ __forceinline__ void pv_d0(f32x16* o, int vb, bf16x8 pa0, bf16x8 pa1, bf16x8 pa2, bf16x8 pa3) {
  pv_one<0>(o[0], vb, pa0, pa1, pa2, pa3); pv_one<1>(o[1], vb, pa0, pa1, pa2, pa3); pv_one<2>(o[2], vb, pa0, pa1, pa2, pa3); pv_one<3>(o[3], vb, pa0, pa1, pa2, pa3);
}

struct Pre { bf16x8 q[8]; };
__device__ __forceinline__ void attn_prefetch(const bf16* Qb, const bf16* __restrict__ Kh, const bf16* __restrict__ Vh, Pre& p) {
  const int tid = threadIdx.x, wid = tid >> 6, lane = tid & 63, r32 = lane & 31, hi = lane >> 5;
  const bf16* Qw = Qb + (long)(wid * QBLK + r32) * LDQ + hi * 8;
#pragma unroll
  for (int d0 = 0; d0 < 8; ++d0) p.q[d0] = *reinterpret_cast<const bf16x8*>(Qw + d0 * 16);
}
template <typename TQ>
__device__ __forceinline__ void attn_dense_body(const TQ* Qb, const bf16* __restrict__ Kh, const bf16* __restrict__ Vh,
                                                bf16* Ob, int seq, char* lds, const float* __restrict__ qnw, const float* __restrict__ rope, int lpos0,
                                                Pre& pre, const bf16* Qn, const bf16* Kn, const bf16* Vn) {
  using St = Stage<bf16>; using SQ = Stage<TQ>;
  const int tid = threadIdx.x, wid = tid >> 6, lane = tid & 63, r32 = lane & 31, hi = lane >> 5;
  bf16* V_lds = (bf16*)lds; bf16* K_lds = (bf16*)(lds + 2 * SHM_V);
  float* ws = (float*)(lds + 2 * SHM_V + 2 * SHM_K) + wid * 64; float* li_l = ws; float* al_l = ws + 32;
  float m_reg = -1e30f, l_reg = 0; f32x16 o[4] = {}; bf16x8 qr[8];
#pragma unroll
  for (int d0 = 0; d0 < 8; ++d0) qr[d0] = pre.q[d0];
  const int sr = tid >> 4, sc = (tid & 15) * 8, vst0 = v_st(sr, sc), vst1 = v_st(32 + sr, sc);
  const int vb0 = (int)(uintptr_t)V_lds + v_rd_base(lane);
  struct { typename St::T vs0, vs1, ks0, ks1; } sr_[SDEPTH];
#define SLOAD(i, k0) do { sr_[i].vs0 = St::ld8(&Vh[(long)((k0) + sr) * LDK + sc]); sr_[i].vs1 = St::ld8(&Vh[(long)((k0) + 32 + sr) * LDK + sc]); \
    sr_[i].ks0 = St::ld8(&Kh[(long)((k0) + sr) * LDK + sc]); sr_[i].ks1 = St::ld8(&Kh[(long)((k0) + 32 + sr) * LDK + sc]); } while (0)
#define SWRITE(b, i) do { *(bf16x8*)((char*)V_lds + (b) * SHM_V + vst0) = St::tobf(sr_[i].vs0);          \
    *(bf16x8*)((char*)V_lds + (b) * SHM_V + vst1) = St::tobf(sr_[i].vs1); int kc = sc * 2;               \
    *(bf16x8*)((char*)K_lds + (b) * SHM_K + KSWZ(sr, kc)) = St::tobf(sr_[i].ks0);                       \
    *(bf16x8*)((char*)K_lds + (b) * SHM_K + KSWZ(32 + sr, kc)) = St::tobf(sr_[i].ks1); } while (0)
#define SWAIT() do { if constexpr (SDEPTH == 2) asm volatile("s_waitcnt vmcnt(4)" ::: "memory"); else asm volatile("s_waitcnt vmcnt(0)" ::: "memory"); } while (0)
#define RESC(a) do { if (__any((a) < 1.f)) { if (hi == 0) al_l[r32] = (a); asm volatile("s_waitcnt lgkmcnt(0)" ::: "memory"); \
    for (int d = 0; d < 4; ++d) for (int r = 0; r < 16; ++r) o[d][r] *= al_l[crow(r, hi)]; } } while (0)
  f32x16 pA0, pA1, pB0, pB1; float mnA, mnB, alA, alB; bf16x8 pa0, pa1, pa2, pa3; const int NT = seq / KVBLK;
  constexpr int SE = 0, SO = SDEPTH - 1;
  SLOAD(SE, 0); SLOAD(SO, KVBLK);
  if (qnw) {
    float ssq = 0.f;
#pragma unroll
    for (int d0 = 0; d0 < 8; ++d0)
#pragma unroll
      for (int j = 0; j < 8; ++j) { const float f = bf2f((unsigned short)qr[d0][j]); ssq += f * f; }
    { auto rr = __builtin_amdgcn_permlane32_swap(__float_as_uint(ssq), __float_as_uint(ssq), false, false); ssq = __uint_as_float(rr[0]) + __uint_as_float(rr[1]); }
    const float rstd = 1.0f / sqrtf(ssq * (1.0f / 128.0f) + 1e-6f);
    const int lq = lpos0 + wid * QBLK + r32, ri = lq >> 6, ci = lq & 63;
#pragma unroll
    for (int d0 = 0; d0 < 8; ++d0) {
      const float* wp = qnw + 16 * d0 + 8 * hi; const v4f w0 = *(const v4f*)wp, w1 = *(const v4f*)(wp + 4);
      const float* tp = d0 < 4 ? rope + (ri * 32 + 8 * d0 + 4 * hi) * 2 : rope + (ci * 32 + 8 * (d0 - 4) + 4 * hi) * 2; const v4f t0 = *(const v4f*)tp, t1 = *(const v4f*)(tp + 4);
      const float wv[8] = {w0.x, w0.y, w0.z, w0.w, w1.x, w1.y, w1.z, w1.w}, tv[8] = {t0.x, t0.y, t0.z, t0.w, t1.x, t1.y, t1.z, t1.w};
      float y[8];
#pragma unroll
      for (int q = 0; q < 4; ++q) { const float x0 = bf2f((unsigned short)qr[d0][2 * q]) * rstd * wv[2 * q], x1 = bf2f((unsigned short)qr[d0][2 * q + 1]) * rstd * wv[2 * q + 1], cs = tv[2 * q], sn = tv[2 * q + 1];
        y[2 * q] = x0 * cs - x1 * sn; y[2 * q + 1] = x0 * sn + x1 * cs; }
      u32x4 pw = {cvtpk(y[0], y[1]), cvtpk(y[2], y[3]), cvtpk(y[4], y[5]), cvtpk(y[6], y[7])}; qr[d0] = *reinterpret_cast<bf16x8*>(&pw);
    }
  }
  asm volatile("s_waitcnt vmcnt(4)" ::: "memory"); SWRITE(0, SE); if constexpr (SDEPTH == 2) { if (2 < NT) SLOAD(SE, 2 * KVBLK); } __syncthreads();
  qkt(pA0, pA1, K_lds, qr, r32, hi); partialSM(pA0, pA1, m_reg, mnA, alA);
  SWAIT(); SWRITE(1, SO); __syncthreads();
  for (int j = 1; j + 1 < NT; j += 2) {
    SBAR(); qkt(pB0, pB1, (bf16*)((char*)K_lds + SHM_K), qr, r32, hi);
    finishSM(pA0, pA1, alA, l_reg, pa0, pa1, pa2, pa3); SBAR();
    SLOAD(SO, (j + SDEPTH) * KVBLK); SBAR();
    pv_d0(o, vb0, pa0, pa1, pa2, pa3); partialSM(pB0, pB1, m_reg, mnB, alB);
    __syncthreads(); SWAIT(); SWRITE(0, SE);
    RESC(alB); __syncthreads();
    SBAR(); qkt(pA0, pA1, K_lds, qr, r32, hi);
    finishSM(pB0, pB1, alB, l_reg, pa0, pa1, pa2, pa3); SBAR();
    if (SDEPTH == 1 || j + 3 < NT) SLOAD(SE, (j + 1 + SDEPTH) * KVBLK); SBAR();
    pv_d0(o, vb0 + (int)SHM_V, pa0, pa1, pa2, pa3); partialSM(pA0, pA1, m_reg, mnA, alA);
    __syncthreads(); SWAIT(); SWRITE(1, SO);
    RESC(alA); __syncthreads();
  }
  attn_prefetch(Qn, Kn, Vn, pre);
  SBAR(); qkt(pB0, pB1, (bf16*)((char*)K_lds + SHM_K), qr, r32, hi);
  finishSM(pA0, pA1, alA, l_reg, pa0, pa1, pa2, pa3); SBAR();
  pv_d0(o, vb0, pa0, pa1, pa2, pa3); partialSM(pB0, pB1, m_reg, mnB, alB);
  __syncthreads(); RESC(alB);
  finishSM(pB0, pB1, alB, l_reg, pa0, pa1, pa2, pa3); SBAR();
  pv_d0(o, vb0 + (int)SHM_V, pa0, pa1, pa2, pa3);
  if (hi == 0) li_l[r32] = l_reg; asm volatile("s_waitcnt lgkmcnt(0)" ::: "memory");
  float rli[16];
#pragma unroll
  for (int r = 0; r < 16; ++r) rli[r] = __builtin_amdgcn_rcpf(li_l[crow(r, hi)]);
  if (!Ob) return;
  bf16* Ow = Ob + (long)(wid * QBLK) * LDO;
#pragma unroll
  for (int r = 0; r < 16; ++r) { int orow = crow(r, hi);
    for (int d0 = 0; d0 < 4; ++d0) Ow[(long)orow * LDO + d0 * 32 + r32] = (bf16)f2bf(o[d0][r] * rli[r]); }
#undef SLOAD
#undef SWRITE
#undef SWAIT
#undef RESC
}

#undef KSWZ
#undef SBAR
}

namespace ret {
typedef short bf16x8 __attribute__((ext_vector_type(8)));
typedef short s16x4 __attribute__((ext_vector_type(4)));
typedef float f32x16 __attribute__((ext_vector_type(16)));
constexpr int QSTR = 528, KSTR = 576, VSTR = 576, PSTR = 144;
constexpr int QS = 0, KS = QS + 64 * QSTR, VS = KS + 64 * KSTR, PS = VS + 64 * VSTR, OST = PS + 64 * PSTR, OSTR = 144, SSL = OST + 8 * 32 * OSTR, LDS_RET = SSL + 64 * 8 * 4;
constexpr int NSTEP = 36, SPLIT = 20;
__device__ __forceinline__ int crow(int r, int hi) { return (r & 3) + 8 * (r >> 2) + 4 * hi; }
__device__ __forceinline__ s16x4 tr_read(const LAS unsigned char* p) { return __builtin_bit_cast(s16x4, __builtin_amdgcn_ds_read_tr16_b64_v4i16((LAS s16x4*)p)); }
__device__ __forceinline__ bf16x8 cat(s16x4 lo, s16x4 hi) { return (bf16x8){lo[0], lo[1], lo[2], lo[3], hi[0], hi[1], hi[2], hi[3]}; }

struct NoPre { __device__ __forceinline__ void operator()() const {} };
template <class GridBar, class PreWork = NoPre>
__device__ __forceinline__ void scan_unit(const bf16_t* RQ, const bf16_t* RK, const bf16_t* RV, bf16_t* YR, float* SSQ, const float* l2d, LAS unsigned char* lds, int unit, const GridBar& gridbar, int nb_limit, const PreWork& prework = PreWork()) {
    const int tid = threadIdx.x, lane = tid & 63, w = __builtin_amdgcn_readfirstlane(tid >> 6), r = lane & 31, hh = lane >> 5;
    const int x = unit & 7, y = unit >> 3, eh = y & 1, dir = (y >> 1) & 1, bh = (y >> 2) * 8 + x, b = bh >> 2, h = bh & 3;
    if (b >= nb_limit) { prework(); gridbar(); return; }
    const float lg2 = log1pf(-exp2f(l2d[dir * 4 + h])) * 1.4426950408889634f;
    const float gC = exp2f(lg2 * 64.0f);
#if MK_TIMING
    unsigned long long tl_ = __builtin_amdgcn_s_memrealtime(); unsigned ta0 = 0, ta1 = 0, ta2 = 0, ta3 = 0, ta4 = 0, ta5 = 0, ta6 = 0;
#define TMARK(v_) do { const unsigned long long n_ = __builtin_amdgcn_s_memrealtime(); v_ += (unsigned)(n_ - tl_); tl_ = n_; } while (0)
#else
#define TMARK(v_) do { } while (0)
#endif
    f32x16 S[8];
#pragma unroll
    for (int T = 0; T < 8; ++T) S[T] = (f32x16){0.f};
#define STEP_ROWS(s_, krow_, qrow_) do { const bool l_ = (s_) >= 4; const int lc_ = l_ ? (dir ? 35 - (s_) : (s_) - 4) : 0; \
        krow_ = b * LT + (l_ ? LC + 64 * lc_ : (dir ? 64 * (3 - (s_)) : 64 * (s_))); qrow_ = b * SEQ + 64 * lc_; } while (0)
    v4u kv[4], vv[4], qv[4];
    const int poff = (tid >> 5) * 1024 + (tid & 31) * 8, voff = (tid >> 5) * 2048 + (tid & 31) * 8;
#define PREFETCHK(s_) do { int kr_, qr_; STEP_ROWS(s_, kr_, qr_); const bf16_t* kb_ = RK + (size_t)kr_ * 1024 + h * 256; \
        _Pragma("unroll") for (int n = 0; n < 4; ++n) { const bf16_t* kbn_ = kb_ + n * 16 * 1024; kv[n] = *(const v4u*)(kbn_ + poff); } } while (0)
#define PREFETCHQ(s_) do { int kr_, qr_; STEP_ROWS(s_, kr_, qr_); const bf16_t* qb_ = RQ + (size_t)qr_ * 1024 + h * 256; \
        _Pragma("unroll") for (int n = 0; n < 4; ++n) { const bf16_t* qbn_ = qb_ + n * 16 * 1024; qv[n] = *(const v4u*)(qbn_ + poff); } } while (0)
#define LOADV(s_) do { int kr_, qr_; STEP_ROWS(s_, kr_, qr_); const bf16_t* vb_ = RV + (size_t)kr_ * 2048 + h * 512 + eh * 256; \
        _Pragma("unroll") for (int n = 0; n < 4; ++n) { const bf16_t* vbn_ = vb_ + n * 16 * 2048; vv[n] = *(const v4u*)(vbn_ + voff); } } while (0)
#define WRITEQ() do { _Pragma("unroll") for (int n = 0; n < 4; ++n) { const int c = tid + NTHR * n, row = c >> 5, ch = c & 31; *(LAS v4u*)(lds + QS + row * QSTR + ch * 16) = qv[n]; } } while (0)
    PREFETCHK(0); PREFETCHQ(0); LOADV(0);
    prework();
    LAS unsigned char* ost = lds + OST + w * (32 * OSTR);
    for (int s = 0; s < NSTEP; ++s) {
        if (s == SPLIT) gridbar();
        int krow0, qrow0; STEP_ROWS(s, krow0, qrow0); const bool latent = s >= 4; const int sn = s + 1 < NSTEP ? s + 1 : s;
        float lg2s = lg2; int hv = hh, rv = r; asm volatile("" : "+v"(lg2s), "+v"(hv), "+v"(rv));
        const int lane_l = hv * 32 + rv;
        const int qA = QS + rv * QSTR + hv * 16, pA = PS + rv * PSTR + hv * 16;
        const int sw = ((lane_l & 1) << 1) | ((lane_l >> 1) & 1);
        const int trrow = (hv * 8 + ((lane_l >> 2) & 3));
        const int ktr = KS + trrow * KSTR + (16 * ((lane_l >> 4) & 1) + 4 * sw) * 2;
        const int vtr = VS + trrow * VSTR + (32 * w + 16 * ((lane_l >> 4) & 1) + 4 * (lane_l & 3)) * 2;
        { float wgt = __builtin_amdgcn_exp2f(lg2s * (float)(dir ? (tid >> 5) : 63 - (tid >> 5))); const float wstep = __builtin_amdgcn_exp2f(lg2s * (dir ? 16.0f : -16.0f));
#pragma unroll
          for (int n = 0; n < 4; ++n) { const int c = tid + NTHR * n, row = c >> 5, ch = c & 31;
            *(LAS v4u*)(lds + KS + row * KSTR + ch * 16) = kv[n];
            *(LAS v4u*)(lds + QS + row * QSTR + ch * 16) = qv[n];
            float t[8]; unpack8(vv[n], t);
#pragma unroll
            for (int k = 0; k < 8; ++k) t[k] *= wgt;
            wgt *= wstep;
            *(LAS v4u*)(lds + VS + row * VSTR + ch * 16) = pack8(t); } }
        __syncthreads();
        TMARK(ta0);
        v4u pp[4]; bf16_t* op = YR + (size_t)qrow0 * 2048 + h * 512 + eh * 256 + 32 * w + (size_t)((hv * 32 + rv) >> 2) * 2048 + ((hv * 32 + rv) & 3) * 8;
        if (s >= SPLIT) {
#pragma unroll
            for (int x4 = 0; x4 < 4; ++x4) pp[x4] = *(const v4u*)(op + (size_t)(16 * x4) * 2048); }
        if (latent) {
            { typedef float f32x4_t __attribute__((ext_vector_type(4)));
              const int i0 = 16 * (w >> 1), j0 = 32 * (w & 1), l15 = rv & 15, g4 = (hv << 1) | (rv >> 4);
              const LAS unsigned char* qp = lds + QS + (i0 + l15) * QSTR + g4 * 16; const LAS unsigned char* kp0 = lds + KS + (j0 + l15) * KSTR + g4 * 16; const LAS unsigned char* kp1 = kp0 + 16 * KSTR;
              f32x4_t s0 = (f32x4_t){0.f, 0.f, 0.f, 0.f}, s1 = s0;
              bf16x8 qn = *(const LAS bf16x8*)qp, k0n = *(const LAS bf16x8*)kp0, k1n = *(const LAS bf16x8*)kp1;
#pragma unroll
              for (int kk = 0; kk < 8; ++kk) { const bf16x8 qc = qn, k0c = k0n, k1c = k1n;
                if (kk + 1 < 8) { qn = *(const LAS bf16x8*)(qp + (kk + 1) * 64); k0n = *(const LAS bf16x8*)(kp0 + (kk + 1) * 64); k1n = *(const LAS bf16x8*)(kp1 + (kk + 1) * 64); }
                __builtin_amdgcn_sched_barrier(0);
                s0 = __builtin_amdgcn_mfma_f32_16x16x32_bf16(k0c, qc, s0, 0, 0, 0); s1 = __builtin_amdgcn_mfma_f32_16x16x32_bf16(k1c, qc, s1, 0, 0, 0); }
              const int i = i0 + l15;
#pragma unroll
              for (int t2 = 0; t2 < 2; ++t2) { const f32x4_t sv = t2 ? s1 : s0; const int jb = j0 + 16 * t2 + 4 * g4; float v4[4];
#pragma unroll
                for (int k = 0; k < 4; ++k) { const int j = jb + k; const bool keep = dir ? (j >= i) : (j <= i); v4[k] = keep ? sv[k] : 0.f; }
                v2u pw; pw.x = cvt_pk_bf16(v4[0], v4[1]); pw.y = cvt_pk_bf16(v4[2], v4[3]);
                *(LAS v2u*)(lds + PS + i * PSTR + jb * 2) = pw; } }
            TMARK(ta1);
            f32x16 acc[2]; acc[0] = (f32x16){0.f}; acc[1] = (f32x16){0.f};
            { const LAS unsigned char* q0 = lds + qA; const LAS unsigned char* q1 = lds + qA + 32 * QSTR;
              bf16x8 n0 = *(const LAS bf16x8*)q0, n1 = *(const LAS bf16x8*)q1, m0 = *(const LAS bf16x8*)(q0 + 32), m1 = *(const LAS bf16x8*)(q1 + 32);
#pragma unroll
              for (int ix = 0; ix < 16; ++ix) { const int T = ix >> 1, s2 = ix & 1; const bf16x8 a0 = n0, a1 = n1; n0 = m0; n1 = m1;
                if (ix + 2 < 16) { m0 = *(const LAS bf16x8*)(q0 + (ix + 2) * 32); m1 = *(const LAS bf16x8*)(q1 + (ix + 2) * 32); }
                v4u bw; bw.x = cvt_pk_bf16(S[T][8 * s2 + 0], S[T][8 * s2 + 1]); bw.y = cvt_pk_bf16(S[T][8 * s2 + 2], S[T][8 * s2 + 3]);
                bw.z = cvt_pk_bf16(S[T][8 * s2 + 4], S[T][8 * s2 + 5]); bw.w = cvt_pk_bf16(S[T][8 * s2 + 6], S[T][8 * s2 + 7]); const bf16x8 bs = __builtin_bit_cast(bf16x8, bw);
                __builtin_amdgcn_sched_barrier(0);
                acc[0] = __builtin_amdgcn_mfma_f32_32x32x16_bf16(a0, bs, acc[0], 0, 0, 0); acc[1] = __builtin_amdgcn_mfma_f32_32x32x16_bf16(a1, bs, acc[1], 0, 0, 0); } }
            TMARK(ta2);
            __syncthreads();
            LOADV(sn);
            TMARK(ta3);
            { bf16x8 vn = cat(tr_read(lds + vtr), tr_read(lds + vtr + 4 * VSTR)), pn0 = *(const LAS bf16x8*)(lds + pA), pn1 = *(const LAS bf16x8*)(lds + pA + 32 * PSTR);
#pragma unroll
              for (int js = 0; js < 4; ++js) { const bf16x8 vfj = vn, p0 = pn0, p1 = pn1;
                if (js + 1 < 4) { vn = cat(tr_read(lds + vtr + (16 * (js + 1)) * VSTR), tr_read(lds + vtr + (16 * (js + 1) + 4) * VSTR)); pn0 = *(const LAS bf16x8*)(lds + pA + (js + 1) * 32); pn1 = *(const LAS bf16x8*)(lds + pA + 32 * PSTR + (js + 1) * 32); }
                __builtin_amdgcn_sched_barrier(0);
                acc[0] = __builtin_amdgcn_mfma_f32_32x32x16_bf16(p0, vfj, acc[0], 0, 0, 0); acc[1] = __builtin_amdgcn_mfma_f32_32x32x16_bf16(p1, vfj, acc[1], 0, 0, 0); } }
#pragma unroll
            for (int it = 0; it < 2; ++it) {
#pragma unroll
                for (int q = 0; q < 16; ++q) { const int il = crow(q, hv); const int i = it * 32 + il; const float rf = __builtin_amdgcn_exp2f(lg2s * (float)(dir ? -i : i - 63));
                    *(LAS float*)(ost + il * OSTR + rv * 4) = acc[it][q] * rf; }
#pragma unroll
                for (int n = 0; n < 2; ++n) { const int c = (hv * 32 + rv) + 64 * n, row = c >> 2, cq = c & 3;
                    const v4f x0 = *(const LAS v4f*)(ost + row * OSTR + cq * 32), x1 = *(const LAS v4f*)(ost + row * OSTR + cq * 32 + 16);
                    float o[8] = {x0.x, x0.y, x0.z, x0.w, x1.x, x1.y, x1.z, x1.w};
                    if (s >= SPLIT) { float pv[8]; unpack8(pp[2 * it + n], pv); float ss = 0.f;
#pragma unroll
                        for (int k = 0; k < 8; ++k) { o[k] += pv[k]; ss += o[k] * o[k]; }
                        ss += __shfl_xor(ss, 1); ss += __shfl_xor(ss, 2);
                        if (cq == 0) *(LAS float*)(lds + SSL + ((it * 32 + row) * 8 + w) * 4) = ss; }
                    *(v4u*)(op + (size_t)(it * 32 + 16 * n) * 2048) = pack8(o); }
            }
        }
        TMARK(ta4);
        __builtin_amdgcn_sched_barrier(0);
        PREFETCHK(sn);
        PREFETCHQ(sn);
        if (!latent) LOADV(sn);
        {
#define KA_LD(ix_) cat(tr_read(lds + ktr + (16 * ((ix_) >> 3)) * KSTR + ((ix_) & 7) * 64), tr_read(lds + ktr + (16 * ((ix_) >> 3) + 4) * KSTR + ((ix_) & 7) * 64))
#define VF_LD(js_) cat(tr_read(lds + vtr + (16 * (js_)) * VSTR), tr_read(lds + vtr + (16 * (js_) + 4) * VSTR))
          bf16x8 vcur = VF_LD(0), vnx = vcur, kn0 = KA_LD(0), kn1 = KA_LD(1);
#pragma unroll
          for (int ix = 0; ix < 32; ++ix) { const int T = ix & 7, js = ix >> 3; const bf16x8 ka = kn0; kn0 = kn1;
            if (ix + 2 < 32) kn1 = KA_LD(ix + 2);
            if (T == 4 && js < 3) vnx = VF_LD(js + 1);
            __builtin_amdgcn_sched_barrier(0);
            S[T] = __builtin_amdgcn_mfma_f32_32x32x16_bf16(ka, vcur, S[T], 0, 0, 0);
            if (T == 7) vcur = vnx; }
#undef KA_LD
#undef VF_LD
        }
#pragma unroll
        for (int T = 0; T < 8; ++T) S[T] *= gC;
        TMARK(ta5);
        __syncthreads();
        TMARK(ta6);
        if (s >= SPLIT && tid < 64) { const LAS float* pr = (const LAS float*)(lds + SSL + tid * 32); const v4f a = *(const LAS v4f*)pr, c4 = *(const LAS v4f*)(pr + 4);
            SSQ[(size_t)(qrow0 + tid) * 8 + h * 2 + eh] = ((a.x + a.y) + (a.z + a.w)) + ((c4.x + c4.y) + (c4.z + c4.w)); }
    }
#if MK_TIMING
    if (unit == 0 && tid == 0) { unsigned* tw = (unsigned*)SSQ - 64; tw[0] = ta0; tw[1] = ta1; tw[2] = ta2; tw[3] = ta3; tw[4] = ta4; tw[5] = ta5; tw[6] = ta6; }
#endif
#undef STEP_ROWS
#undef PREFETCHK
#undef PREFETCHQ
#undef WRITEQ
#undef LOADV
}
}

constexpr int RING_BYTES = 131072, LDS_BYTES = 157696;
#ifndef MK_ONE_LAUNCH
#define MK_ONE_LAUNCH 1
#endif
constexpr int N_PHASES = 10;
#define LDS_WAIT() asm volatile("s_waitcnt lgkmcnt(0)" ::: "memory")
constexpr int MISC_OFF = 155648 + 320;
constexpr int CW_BAR = 4096;
constexpr size_t CTL_ZERO_BYTES = 65536;
#ifndef MK_NAIVE_ATTN
#define MK_NAIVE_ATTN 0
#endif
#ifndef MK_NAIVE_RET
#define MK_NAIVE_RET 0
#endif
#ifndef MK_DEBUG_ATTN
#define MK_DEBUG_ATTN 0
#endif
#ifndef MK_DBG_H
#define MK_DBG_H 0
#endif
#ifndef MK_DBG_L0
#define MK_DBG_L0 768
#define MK_DBG_L1 1280
#endif
#ifndef MK_DEBUG_RET
#define MK_DEBUG_RET 0
#endif
#ifndef MK_STAMP_A
#define MK_STAMP_A -1
#define MK_STAMP_B -1
#endif
#ifndef MK_REP_P4
#define MK_REP_P4 1
#endif
#ifndef MK_REP_P5
#define MK_REP_P5 1
#endif
#ifndef MK_REP_P6
#define MK_REP_P6 1
#endif
#ifndef MK_REP_P2
#define MK_REP_P2 1
#endif
#ifndef MK_REP_P9
#define MK_REP_P9 1
#endif
#ifndef MK_NSTAG
#define MK_NSTAG 1
#define MK_STAG_TICKS 500
#endif
#ifndef MK_EPIW
#define MK_EPIW 16
#endif
#ifndef MK_BARRIER
#define MK_BARRIER 1
#endif
#define XB_TMO      128
#define XB_XCNT(j)  (256  + 64 * (j))
#define XB_XSUB(j)  (1280 + 64 * (j))
#define XB_XGEN(j)  (2304 + 64 * (j))
#define XB_TOP      3328
#define XB_TOPGEN   3392
#define XCD_BAR_WORDS 3456
#define XB_SPIN_CAP (1u << 18)

__device__ __forceinline__ unsigned xb_ld(unsigned* p)              { return __hip_atomic_load(p, __ATOMIC_RELAXED, __HIP_MEMORY_SCOPE_AGENT); }
__device__ __forceinline__ unsigned xb_add(unsigned* p, unsigned v) { return __hip_atomic_fetch_add(p, v, __ATOMIC_RELAXED, __HIP_MEMORY_SCOPE_AGENT); }
__device__ __forceinline__ unsigned xb_xcc_id() { return (unsigned)__builtin_amdgcn_s_getreg((3 << 11) | 20) & 0xFu; }
#define XB_SPIN(cond, bar) do { unsigned _sp = 0; while (cond) { __builtin_amdgcn_s_sleep(1); \
    if ((++_sp & 255u) == 0u) { if (xb_ld(&(bar)[XB_TMO])) break; if (_sp > XB_SPIN_CAP) { atomicAdd(&(bar)[XB_TMO], 1u); break; } } } } while (0)

struct XcdBarrier {
    unsigned* bar; unsigned x;
    volatile LAS unsigned* st;
};

__device__ __forceinline__ XcdBarrier xcd_barrier_post(unsigned* bar, volatile LAS unsigned* st) {
    XcdBarrier b; b.bar = bar; b.x = xb_xcc_id(); b.st = st;
    if (threadIdx.x == 0) (void)xb_add(&bar[XB_XCNT(b.x)], 1u);
    return b;
}
__device__ __forceinline__ void xcd_barrier_complete(unsigned* bar, unsigned x, unsigned& nloc, unsigned& nx) {
    const unsigned G = gridDim.x * gridDim.y * gridDim.z;
    unsigned sum, cnt, mine, sp = 0u;
    for (;;) {
        sum = 0u; cnt = 0u; mine = 0u;
#pragma unroll
        for (unsigned j = 0; j < 16; ++j) { const unsigned c = xb_ld(&bar[XB_XCNT(j)]); sum += c; cnt += (c > 0u) ? 1u : 0u; mine = (j == x) ? c : mine; }
        if (sum == G) break;
        __builtin_amdgcn_s_sleep(1);
        if ((++sp & 255u) == 0u) { if (xb_ld(&bar[XB_TMO])) break; if (sp > XB_SPIN_CAP) { atomicAdd(&bar[XB_TMO], 1u); break; } }
    }
    nloc = mine > 0u ? mine : 1u; nx = cnt > 0u ? cnt : 1u;
}

__device__ __forceinline__ void xcd_barrier(const XcdBarrier& b) {
    asm volatile("s_waitcnt vmcnt(0)" ::: "memory");
    __syncthreads();
    if (threadIdx.x == 0) {
        unsigned* bar = b.bar;
        __builtin_amdgcn_s_waitcnt(0);
        unsigned nloc = b.st[0], nx = b.st[1];
        if (nloc == 0u) { xcd_barrier_complete(bar, b.x, nloc, nx); b.st[0] = nloc; b.st[1] = nx; }
        const unsigned old = xb_add(&bar[XB_XSUB(b.x)], 1u);
        const unsigned gen = old / nloc;
        if (old + 1u == (gen + 1u) * nloc) {
            __builtin_amdgcn_fence(__ATOMIC_RELEASE, "agent");
            asm volatile("s_waitcnt vmcnt(0)" ::: "memory");
            const unsigned og = xb_add(&bar[XB_TOP], 1u);
            const unsigned tg = og / nx;
            if (og + 1u == (tg + 1u) * nx) xb_add(&bar[XB_TOPGEN], 1u);
            else XB_SPIN(xb_ld(&bar[XB_TOPGEN]) == tg, bar);
            __builtin_amdgcn_fence(__ATOMIC_ACQUIRE, "agent");
            xb_add(&bar[XB_XGEN(b.x)], 1u);
            asm volatile("s_waitcnt vmcnt(0)" ::: "memory");
        } else {
            XB_SPIN(xb_ld(&bar[XB_XGEN(b.x)]) == gen, bar);
            __builtin_amdgcn_fence(__ATOMIC_ACQUIRE, "agent");
            asm volatile("s_waitcnt vmcnt(0)" ::: "memory");
        }
    }
    __syncthreads();
}


struct Args { const float* in[14]; float* out; unsigned char* ws; int ph_lo, ph_hi; };

__device__ __forceinline__ void p0_mod_item(const float* c, const float* c_ctx, const float* w_ada, const float* b_ada, float* MOD, float* ldsf, int item, int tid) {
    float* sc = ldsf; float* red = ldsf + 17 * 1024;
    for (int i = tid; i < 17 * 1024; i += NTHR) { const float v = i < 16 * 1024 ? c[i] : c_ctx[i - 16 * 1024]; sc[i] = v / (1.0f + expf(-v)); }
    const int col = tid & 15, ks = tid >> 4, n = item * 16 + col;
    float wv[32];
#pragma unroll
    for (int k = 0; k < 32; ++k) wv[k] = w_ada[(size_t)(ks * 32 + k) * 3072 + n];
    __syncthreads();
    float acc[17];
#pragma unroll
    for (int r = 0; r < 17; ++r) acc[r] = 0.f;
#pragma unroll
    for (int k = 0; k < 32; ++k) {
#pragma unroll
        for (int r = 0; r < 17; ++r) acc[r] += sc[r * 1024 + ks * 32 + k] * wv[k]; }
#pragma unroll
    for (int r = 0; r < 17; ++r) red[(ks * 17 + r) * 16 + col] = acc[r];
    __syncthreads();
    if (tid < 17 * 16) { const int r = tid >> 4, cc = tid & 15; float s = b_ada[item * 16 + cc];
        for (int k2 = 0; k2 < 32; ++k2) s += red[(k2 * 17 + r) * 16 + cc];
        MOD[r * 3072 + item * 16 + cc] = s; }
    __syncthreads();
}
__device__ __forceinline__ void p0_transpose_item(const float* W, int K, int N, bf16_t* WT, int row_off, float* scr, int item, int lane) {
    const int nblk = N / 32, kb = item / nblk, nb = item % nblk, k0 = 64 * kb, n0 = 32 * nb;
    float tv[32];
#pragma unroll
    for (int i = 0; i < 32; ++i) { const int kk = 2 * i + (lane >> 5); tv[i] = W[(size_t)(k0 + kk) * N + n0 + (lane & 31)]; }
#pragma unroll
    for (int i = 0; i < 32; ++i) { const int kk = 2 * i + (lane >> 5); scr[kk * 33 + (lane & 31)] = tv[i]; }
    LDS_WAIT(); asm volatile("" ::: "memory");
    const int c = lane & 7;
#pragma unroll
    for (int j = 0; j < 4; ++j) { const int n = (lane >> 3) + 8 * j; const float* s = scr + (8 * c) * 33 + n;
        v4u o; o.x = pk2(s[0 * 33], s[1 * 33]); o.y = pk2(s[2 * 33], s[3 * 33]); o.z = pk2(s[4 * 33], s[5 * 33]); o.w = pk2(s[6 * 33], s[7 * 33]);
        *(v4u*)(WT + (size_t)(row_off + n0 + n) * K + k0 + 8 * c) = o; }
    LDS_WAIT(); asm volatile("" ::: "memory");
}
__device__ __forceinline__ void p0_transpose64_item(const float* W, int K, int N, bf16_t* WT, int row_off, float* scr, int item, int lane) {
    const int nblk = N / 64, kb = item / nblk, nb = item % nblk, k0 = 64 * kb, n0 = 64 * nb;
    v4f tv[16]; const int lr = lane >> 4, lc = (lane & 15) * 4;
#pragma unroll
    for (int i = 0; i < 16; ++i) tv[i] = *(const v4f*)(W + (size_t)(k0 + 4 * i + lr) * N + n0 + lc);
#pragma unroll
    for (int i = 0; i < 16; ++i) { float* d = scr + (4 * i + lr) * 65 + lc; d[0] = tv[i].x; d[1] = tv[i].y; d[2] = tv[i].z; d[3] = tv[i].w; }
    LDS_WAIT(); asm volatile("" ::: "memory");
    const int c = lane & 7;
#pragma unroll
    for (int j = 0; j < 8; ++j) { const int n = (lane >> 3) + 8 * j; const float* s = scr + (8 * c) * 65 + n;
        v4u o; o.x = pk2(s[0 * 65], s[1 * 65]); o.y = pk2(s[2 * 65], s[3 * 65]); o.z = pk2(s[4 * 65], s[5 * 65]); o.w = pk2(s[6 * 65], s[7 * 65]);
        *(v4u*)(WT + (size_t)(row_off + n0 + n) * K + k0 + 8 * c) = o; }
    LDS_WAIT(); asm volatile("" ::: "memory");
}
__device__ __forceinline__ int new_col(int o) { return o < 4608 ? o : (o < 6656 ? o + 1024 : (o < 7680 ? o - 2048 : o)); }

__device__ __forceinline__ void sincos_d(double a, float& c, float& s) {
    const double TWO_PI = 6.283185307179586476925;
    const double k = (double)(long long)(a / TWO_PI + (a >= 0 ? 0.5 : -0.5)); const double r = a - k * TWO_PI, r2 = r * r;
    double ts = r, ss = r, tc = 1.0, cc = 1.0;
    for (int n = 1; n <= 15; ++n) { tc *= -r2 / (double)((2 * n - 1) * (2 * n)); cc += tc; ts *= -r2 / (double)((2 * n) * (2 * n + 1)); ss += ts; }
    c = (float)cc; s = (float)ss;
}

__device__ __forceinline__ void p1_row(const float* xrow, const float* nw, const float* shift, const float* scale, bf16_t* orow, int lane) {
    const v4f* xr = (const v4f*)xrow + lane; v4f v[4]; float s = 0.f;
#pragma unroll
    for (int j = 0; j < 4; ++j) { v[j] = xr[64 * j]; s += (v[j].x * v[j].x + v[j].y * v[j].y) + (v[j].z * v[j].z + v[j].w * v[j].w); }
    const float rstd = 1.0f / sqrtf(wave_sum(s) * (1.0f / 1024.0f) + EPS);
    v2u* o8 = (v2u*)orow + lane;
#pragma unroll
    for (int j = 0; j < 4; ++j) { const v4f w = ((const v4f*)nw)[lane + 64 * j], sh = ((const v4f*)shift)[lane + 64 * j], sc = ((const v4f*)scale)[lane + 64 * j];
        const v4f y = v[j] * rstd * w * (sc + 1.0f) + sh; v2u o; o.x = pk2(y.x, y.y); o.y = pk2(y.z, y.w); o8[64 * j] = o; }
}

template <int NR>
__device__ __forceinline__ void p1_rowsN(const float* x, const float* ctx, const float* MOD, const v4f (&nwv)[4], bf16_t* HX, int r0, int rlast, int lane) {
    v4f v[NR][4];
#pragma unroll
    for (int k = 0; k < NR; ++k) { const int m = r0 + k < rlast ? r0 + k : rlast; const float* xr = m < MLAT ? x + (size_t)m * 1024 : ctx + (size_t)(m - MLAT) * 1024;
#pragma unroll
        for (int j = 0; j < 4; ++j) v[k][j] = __builtin_nontemporal_load((const v4f*)xr + lane + 64 * j); }
#pragma unroll
    for (int k = 0; k < NR; ++k) { const int m = r0 + k < rlast ? r0 + k : rlast; const float* mp = MOD + (m < MLAT ? (m >> 11) : 16) * 3072; float s = 0.f;
        v4f sh[4], sc[4];
#pragma unroll
        for (int j = 0; j < 4; ++j) { sh[j] = ((const v4f*)mp)[lane + 64 * j]; sc[j] = ((const v4f*)(mp + 1024))[lane + 64 * j]; }
#pragma unroll
        for (int j = 0; j < 4; ++j) s += (v[k][j].x * v[k][j].x + v[k][j].y * v[k][j].y) + (v[k][j].z * v[k][j].z + v[k][j].w * v[k][j].w);
        const float rstd = 1.0f / sqrtf(wave_sum(s) * (1.0f / 1024.0f) + EPS);
        v2u* o8 = (v2u*)(HX + (size_t)m * 1024) + lane;
#pragma unroll
        for (int j = 0; j < 4; ++j) { const v4f y = v[k][j] * rstd * nwv[j] * (sc[j] + 1.0f) + sh[j]; v2u o; o.x = pk2(y.x, y.y); o.y = pk2(y.z, y.w); o8[64 * j] = o; } }
}

__device__ __forceinline__ void p3_item(bf16_t* buf, int ldlog2, bool isK, const float* nw, const float* ROPE, size_t item, int lane) {
    const size_t e = item * 512 + (size_t)lane * 8; const size_t row = e >> ldlog2; const int col = (int)(e & ((1u << ldlog2) - 1)), d0 = col & 127;
    float t[8]; unpack8(*(const v4u*)(buf + e), t);
    float ss = 0.f;
#pragma unroll
    for (int k = 0; k < 8; ++k) ss += t[k] * t[k];
    ss += __shfl_xor(ss, 1); ss += __shfl_xor(ss, 2); ss += __shfl_xor(ss, 4); ss += __shfl_xor(ss, 8);
    const float rstd = 1.0f / sqrtf(ss * (1.0f / 128.0f) + EPS);
#pragma unroll
    for (int k = 0; k < 8; ++k) t[k] = t[k] * rstd * nw[d0 + k];
    int l; bool rope = true;
    if (isK) { const int p = (int)(row % LT); rope = p >= LC; l = p - LC; } else l = (int)(row & (SEQ - 1));
    if (rope) { const int ri = l >> 6, ci = l & 63, p0 = d0 >> 1; const float* tab = p0 < 32 ? ROPE + (ri * 32 + p0) * 2 : ROPE + (ci * 32 + (p0 - 32)) * 2;
#pragma unroll
        for (int q = 0; q < 4; ++q) { const float cs = tab[2 * q], sn = tab[2 * q + 1], x0 = t[2 * q], x1 = t[2 * q + 1]; t[2 * q] = x0 * cs - x1 * sn; t[2 * q + 1] = x0 * sn + x1 * cs; } }
    *(v4u*)(buf + e) = pack8(t);
}

template <int NI>
__device__ __forceinline__ void p3_items_k(bf16_t* AK, const float* nw, const float* ROPE, size_t it0, size_t itend, int lane) {
    v4u raw[NI];
#pragma unroll
    for (int i = 0; i < NI; ++i) if (it0 + i < itend) raw[i] = *(const v4u*)(AK + (it0 + i) * 512 + (size_t)lane * 8);
#pragma unroll
    for (int i = 0; i < NI; ++i) if (it0 + i < itend) {
        const size_t e = (it0 + i) * 512 + (size_t)lane * 8; const size_t row = e >> 8; const int d0 = (int)(e & 255) & 127;
        float t[8]; unpack8(raw[i], t); float ss = 0.f;
#pragma unroll
        for (int k = 0; k < 8; ++k) ss += t[k] * t[k];
        ss += __shfl_xor(ss, 1); ss += __shfl_xor(ss, 2); ss += __shfl_xor(ss, 4); ss += __shfl_xor(ss, 8);
        const float rstd = 1.0f / sqrtf(ss * (1.0f / 128.0f) + EPS);
#pragma unroll
        for (int k = 0; k < 8; ++k) t[k] = t[k] * rstd * nw[d0 + k];
        const int p = (int)(row % LT);
        if (p >= LC) { const int l = p - LC, ri = l >> 6, ci = l & 63, p0 = d0 >> 1; const float* tab = p0 < 32 ? ROPE + (ri * 32 + p0) * 2 : ROPE + (ci * 32 + (p0 - 32)) * 2;
#pragma unroll
            for (int q = 0; q < 4; ++q) { const float cs = tab[2 * q], sn = tab[2 * q + 1], x0 = t[2 * q], x1 = t[2 * q + 1]; t[2 * q] = x0 * cs - x1 * sn; t[2 * q + 1] = x0 * sn + x1 * cs; } }
        *(v4u*)(AK + e) = pack8(t); }
}

__device__ __forceinline__ void p4_naive_item(const bf16_t* RQ, const bf16_t* RK, const bf16_t* RV, bf16_t* YR, float* SSQ, const float* l2d, float* ldsf, int item, int tid) {
    const int rb = item & 255, h = (item >> 8) & 3, b = item >> 10, i0 = rb * 8;
    float* qs = ldsf; float* sc = ldsf + 2048; float* red = sc + 8 * LT;
    for (int t = tid; t < 2048; t += NTHR) { const int r = t >> 8, d = t & 255; qs[t] = bf2f(RQ[((size_t)(b * SEQ + i0 + r)) * 1024 + h * 256 + d]); }
    __syncthreads();
    const float lgf = log1pf(-exp2f(l2d[h])), lgb = log1pf(-exp2f(l2d[4 + h]));
    for (int p = tid; p < LT; p += NTHR) {
        const bf16_t* kr = RK + ((size_t)(b * LT + p)) * 1024 + h * 256;
        float dot[8];
#pragma unroll
        for (int r = 0; r < 8; ++r) dot[r] = 0.f;
        for (int d8 = 0; d8 < 32; ++d8) { float kk[8]; unpack8(*(const v4u*)(kr + d8 * 8), kk);
#pragma unroll
            for (int r = 0; r < 8; ++r)
#pragma unroll
                for (int k = 0; k < 8; ++k) dot[r] += qs[r * 256 + d8 * 8 + k] * kk[k]; }
#pragma unroll
        for (int r = 0; r < 8; ++r) { const int i = i0 + r; float W;
            if (p < LC) W = MK_DBG_NOCTX ? 0.f : expf(lgf * (float)(i + LC - p)) + expf(lgb * (float)(SEQ - i + p));
            else { const int j = p - LC; W = (j <= i ? expf(lgf * (float)(i - j)) : 0.f) + (j >= i ? expf(lgb * (float)(j - i)) : 0.f); }
            sc[r * LT + p] = dot[r] * W; }
    }
    __syncthreads();
    float acc[8];
#pragma unroll
    for (int r = 0; r < 8; ++r) acc[r] = 0.f;
    const bf16_t* vp = RV + (size_t)(b * LT) * 2048 + h * 512 + tid;
    for (int p = 0; p < LT; ++p) { const float v = bf2f(vp[(size_t)p * 2048]);
#pragma unroll
        for (int r = 0; r < 8; ++r) acc[r] += sc[r * LT + p] * v; }
    const int wid = tid >> 6, lane = tid & 63;
#pragma unroll
    for (int r = 0; r < 8; ++r) { YR[((size_t)(b * SEQ + i0 + r)) * 2048 + h * 512 + tid] = (bf16_t)f2bf(acc[r]); const float s = wave_sum(acc[r] * acc[r]); if (lane == 0) red[r * 8 + wid] = s; }
    __syncthreads();
    if (tid < 16) { const int r = tid >> 1, hf = tid & 1; const float s = (red[r * 8 + hf * 4] + red[r * 8 + hf * 4 + 1]) + (red[r * 8 + hf * 4 + 2] + red[r * 8 + hf * 4 + 3]);
        SSQ[((size_t)(b * SEQ + i0 + r)) * 8 + h * 2 + hf] = s; }
    __syncthreads();
}

__device__ __forceinline__ void p5_naive_item(bf16_t* AQ, const bf16_t* AK, const bf16_t* AV, float* ldsf, int item, int tid) {
    const int rb = item & 255, head = (item >> 8) & 7, b = item >> 11, g = head >> 2, i0 = rb * 8;
    float* qs = ldsf; float* sc = ldsf + 1024;
    for (int t = tid; t < 1024; t += NTHR) { const int r = t >> 7, d = t & 127; qs[t] = bf2f(AQ[((size_t)(b * SEQ + i0 + r)) * 1024 + head * 128 + d]); }
    __syncthreads();
    for (int p = tid; p < LT; p += NTHR) {
        const bf16_t* kr = AK + ((size_t)(b * LT + p)) * 256 + g * 128;
        float dot[8];
#pragma unroll
        for (int r = 0; r < 8; ++r) dot[r] = 0.f;
        for (int d8 = 0; d8 < 16; ++d8) { float kk[8]; unpack8(*(const v4u*)(kr + d8 * 8), kk);
#pragma unroll
            for (int r = 0; r < 8; ++r)
#pragma unroll
                for (int k = 0; k < 8; ++k) dot[r] += qs[r * 128 + d8 * 8 + k] * kk[k]; }
#pragma unroll
        for (int r = 0; r < 8; ++r) sc[r * LT + p] = dot[r] * 0.08838834764831845f;
    }
    __syncthreads();
    { const int wid = tid >> 6, lane = tid & 63; float* row = sc + wid * LT; float m = -1e30f;
      for (int p = lane; p < LT; p += 64) m = fmaxf(m, row[p]);
#pragma unroll
      for (int o = 1; o < 64; o <<= 1) m = fmaxf(m, __shfl_xor(m, o));
      float s = 0.f;
      for (int p = lane; p < LT; p += 64) { const float ex = expf(row[p] - m); row[p] = ex; s += ex; }
      s = wave_sum(s); const float inv = 1.0f / s;
      for (int p = lane; p < LT; p += 64) row[p] *= inv; }
    __syncthreads();
    const int e = tid & 127, r0 = (tid >> 7) * 2; float a0 = 0.f, a1 = 0.f;
    const bf16_t* vp = AV + (size_t)(b * LT) * 256 + g * 128 + e;
    for (int p = 0; p < LT; ++p) { const float v = bf2f(vp[(size_t)p * 256]); a0 += sc[r0 * LT + p] * v; a1 += sc[(r0 + 1) * LT + p] * v; }
    AQ[((size_t)(b * SEQ + i0 + r0)) * 1024 + head * 128 + e] = (bf16_t)f2bf(a0);
    AQ[((size_t)(b * SEQ + i0 + r0 + 1)) * 1024 + head * 128 + e] = (bf16_t)f2bf(a1);
    __syncthreads();
}

#if MK_BARRIER == 1
struct GridBarF { XcdBarrier b; __device__ __forceinline__ void operator()() const { xcd_barrier(b); } };
#else
struct GridBarF { __device__ __forceinline__ void operator()() const { cooperative_groups::this_grid().sync(); } };
#endif
__device__ __forceinline__ void ssq_item(const bf16_t* YR, float* SSQ, int it, int lane) {
    const int row = it >> 2, head = it & 3; float t[8]; unpack8(*(const v4u*)(YR + (size_t)row * 2048 + head * 512 + lane * 8), t);
    float ss = 0.f;
#pragma unroll
    for (int k = 0; k < 8; ++k) ss += t[k] * t[k];
    ss = wave_sum(ss);
    if (lane == 0) { SSQ[(size_t)row * 8 + head * 2] = ss; SSQ[(size_t)row * 8 + head * 2 + 1] = 0.f; }
}
__global__ void __launch_bounds__(NTHR, 2) mk_fwd(Args args) {
    extern __shared__ __attribute__((aligned(16))) unsigned char lds[];
    const int tid = threadIdx.x, lane = tid & 63, wave = __builtin_amdgcn_readfirstlane(tid >> 6);
    const int G = gridDim.x, bid = blockIdx.x;
    const int gw = bid * NWAVES + wave, NGW = G * NWAVES;
    float* ldsf = (float*)lds;
    unsigned char* ws = args.ws;
    const float *x = args.in[0], *cvec = args.in[1], *ctx = args.in[2], *c_ctx = args.in[3], *norm_w = args.in[4], *w_ada = args.in[5], *b_ada = args.in[6], *w_in = args.in[7],
                *l2d = args.in[8], *q_norm_w = args.in[9], *k_norm_w = args.in[10], *w_o_ret = args.in[11], *w_o_att = args.in[12], *w_out = args.in[13];
    float* MOD = (float*)(ws + WS_MOD); float* ROPE = (float*)(ws + WS_ROPE); float* SSQ = (float*)(ws + WS_SSQ);
    bf16_t *WIN = (bf16_t*)(ws + WS_WIN), *WOR = (bf16_t*)(ws + WS_WOR), *WOA = (bf16_t*)(ws + WS_WOA), *WOUT = (bf16_t*)(ws + WS_WOUT), *HX = (bf16_t*)(ws + WS_HX);
    bf16_t *RK = (bf16_t*)(ws + WS_RK), *RV = (bf16_t*)(ws + WS_RV), *RQ = (bf16_t*)(ws + WS_RQ), *AK = (bf16_t*)(ws + WS_AK), *AV = (bf16_t*)(ws + WS_AV), *AQ = (bf16_t*)(ws + WS_AQ);
    bf16_t *U1 = (bf16_t*)(ws + WS_U1), *U2 = (bf16_t*)(ws + WS_U2), *YR = (bf16_t*)args.out;
    const int lo = args.ph_lo, hi = args.ph_hi;
#define IN(k) (lo <= (k) && (k) < hi)
#define BOTH(k) (IN(k) && IN((k) + 1))
    if (tid < 32) ((LAS unsigned*)(lds + MISC_OFF))[tid] = 0u;
    __syncthreads();
#if MK_BARRIER == 1
    XcdBarrier bar; bar.bar = (unsigned*)(ws + WS_CTL) + CW_BAR; bar.x = 0; bar.st = nullptr;
    if (hi - lo > 1) bar = xcd_barrier_post((unsigned*)(ws + WS_CTL) + CW_BAR, (volatile LAS unsigned*)(lds + MISC_OFF) + 8);
#define GRID_BAR() xcd_barrier(bar)
#else
#define GRID_BAR() cooperative_groups::this_grid().sync()
#endif

#if MK_STAMP_A >= 0
#define STAMP(k) do { if (bid == 0 && tid == 0) { if ((k) == MK_STAMP_A) ((volatile LAS unsigned*)(lds + MISC_OFF))[17] = (unsigned)__builtin_amdgcn_s_memrealtime(); if ((k) == MK_STAMP_B) ((volatile LAS unsigned*)(lds + MISC_OFF))[18] = (unsigned)__builtin_amdgcn_s_memrealtime(); } } while (0)
#else
#define STAMP(k) do { } while (0)
#endif
#define STAGGER() do { if (MK_NSTAG > 1) { const unsigned grp = ((unsigned)bid >> 3) % MK_NSTAG; const unsigned long long t0_ = __builtin_amdgcn_s_memrealtime(); \
        while (__builtin_amdgcn_s_memrealtime() - t0_ < (unsigned long long)grp * MK_STAG_TICKS) __builtin_amdgcn_s_sleep(16); } } while (0)
    STAMP(0);
    if (IN(0)) {
        for (int it = bid; it < 192; it += G) p0_mod_item(cvec, c_ctx, w_ada, b_ada, MOD, ldsf, it, tid);
        if (bid == G - 1) for (int t = tid; t < 2048; t += NTHR) { const int v = t >> 5, i = t & 31; double fd = 1.0; for (int k = 0; k < i; ++k) fd *= 0.7498942093324559;
            const float ang = (float)v * (float)fd; float cs, sn; sincos_d((double)ang, cs, sn); ROPE[2 * t] = cs; ROPE[2 * t + 1] = sn; }
        if (BOTH(0)) GRID_BAR();
    }
    STAMP(1);
    if (IN(1)) {
        {
        float* scr = ldsf + wave * (64 * 65);
        constexpr int I_IN = 16 * (NIN / 64), I_OR = 32 * 16, I_OA = 16 * 16, I_OUT = 16 * 16;
        for (int it = gw; it < I_IN + I_OR + I_OA + I_OUT; it += NGW) {
            int r = it;
            if (r < I_IN) { const int n0 = 64 * (r % (NIN / 64)); p0_transpose64_item(w_in, 1024, NIN, WIN, new_col(n0) - n0, scr, r, lane); continue; } r -= I_IN;
            if (r < I_OR) { p0_transpose64_item(w_o_ret, 2048, 1024, WOR, 0, scr, r, lane); continue; } r -= I_OR;
            if (r < I_OA) { p0_transpose64_item(w_o_att, 1024, 1024, WOA, 0, scr, r, lane); continue; } r -= I_OA;
            p0_transpose64_item(w_out, 1024, 1024, WOUT, 0, scr, r, lane);
        }
        }
        {
            const int rpw = (MALL + NGW - 1) / NGW, m0 = gw * rpw, m1 = m0 + rpw < MALL ? m0 + rpw : MALL;
            v4f nwv[4];
#pragma unroll
            for (int j = 0; j < 4; ++j) nwv[j] = ((const v4f*)norm_w)[lane + 64 * j];
            for (int m = m0; m < m1; m += 9) p1_rowsN<9>(x, ctx, MOD, nwv, HX, m, m1 - 1, lane);
        }
        if (BOTH(1)) GRID_BAR();
    }
    STAMP(2);
    if (IN(2)) {
        STAGGER();
        pg8::Gemm g{HX, WIN, MALL, N1, 1024}; pg8::Sched1 S; S.init(G, bid);
        pg8::Epi1 E{RK, RV, AK, AV, RQ, AQ, nullptr};
#if MK_P2PROBE == 4
        { pg8::Epi1T<2> EC{RK, RV, AK, AV, RQ, AQ, nullptr}; pg8::gemm_phase<pg8::Epi1T<2>, pg8::Sched1, true, true, MK_EPIW>((PG8_LAS unsigned char*)lds, g, S, EC); }
        __syncthreads();
#endif
        for (int rep = 0; rep < MK_REP_P2; ++rep) pg8::gemm_phase<pg8::Epi1, pg8::Sched1, true, true, MK_EPIW>((PG8_LAS unsigned char*)lds, g, S, E);
#if MK_P2PROBE == 1
        { pg8::Epi1T<1> ED{RK, RV, AK, AV, RQ, AQ, (bf16_t*)(ws + WS_END)}; pg8::gemm_phase<pg8::Epi1T<1>, pg8::Sched1, true, true, MK_EPIW>((PG8_LAS unsigned char*)lds, g, S, ED); }
#endif
#if MK_P2PROBE == 3
        { pg8::Epi1T<0> ER{RK, RV, AK, AV, RQ, AQ, nullptr}; pg8::gemm_phase<pg8::Epi1T<0>, pg8::Sched1, true, true, MK_EPIW>((PG8_LAS unsigned char*)lds, g, S, ER); }
#endif
#if MK_P2PROBE == 2
        { pg8::EpiNull EN; pg8::gemm_phase<pg8::EpiNull, pg8::Sched1, true, true, 0>((PG8_LAS unsigned char*)lds, g, S, EN); }
#endif
        if (BOTH(2)) GRID_BAR();
    }
    STAMP(3);
#if MK_NAIVE_ATTN
    if (IN(3)) {
        constexpr size_t IQ = (size_t)MLAT * 1024 / 512, IK = (size_t)NB * LT * 256 / 512;
        for (size_t it = gw; it < IQ + IK; it += NGW) {
            if (it < IQ) p3_item(AQ, 10, false, q_norm_w, ROPE, it, lane); else p3_item(AK, 8, true, k_norm_w, ROPE, it - IQ, lane);
        }
        if (BOTH(3)) GRID_BAR();
    }
#endif
#if MK_DEBUG_ATTN
    {
        bf16_t* AQ2 = (bf16_t*)(ws + WS_RK); float* acc2 = (float*)(ws + WS_CTL) + 64;
        for (size_t i = (size_t)bid * NTHR + tid; i < (size_t)MLAT * 1024 / 8; i += (size_t)G * NTHR) ((v4u*)AQ2)[i] = ((const v4u*)AQ)[i];
        { int tl = threadIdx.x; asm volatile("" : "+v"(tl)); const int lane_l = tl & 63, gw_l = bid * NWAVES + (tl >> 6);
          constexpr size_t IK = (size_t)NB * LT * 256 / 512; for (size_t it = gw_l; it < IK; it += NGW) p3_item(AK, 8, true, k_norm_w, ROPE, it, lane_l); }
        GRID_BAR();
        { int tl = threadIdx.x; asm volatile("" : "+v"(tl)); const int lane_l = tl & 63, gw_l = bid * NWAVES + (tl >> 6);
          constexpr size_t IQ = (size_t)MLAT * 1024 / 512; for (size_t it = gw_l; it < IQ; it += NGW) p3_item(AQ2, 10, false, q_norm_w, ROPE, it, lane_l); }
        GRID_BAR();
        { const int vcu = (bid & 7) * (G >> 3) + (bid >> 3);
          for (int idx = vcu; idx < NB * AH * 8; idx += G) { const int qb = idx & 7, r = (idx >> 3) & 3, g = (idx >> 5) & 1, b = idx >> 6, head = g * 4 + r;
            bf16_t* Q = AQ + ((size_t)(b * SEQ + qb * 256)) * 1024 + head * 128; const bf16_t* K = AK + (size_t)(b * LT) * 256 + g * 128; const bf16_t* V = AV + (size_t)(b * LT) * 256 + g * 128;
            attn::attn_dense_body<attn::bf16>(Q, K, V, Q, LT, (char*)lds, q_norm_w, ROPE, qb * 256); } }
        __syncthreads();
        { const int vcu = (bid & 7) * (G >> 3) + (bid >> 3);
          for (int idx = vcu; idx < NB * AH * 8; idx += G) { const int qb = idx & 7, r = (idx >> 3) & 3, g = (idx >> 5) & 1, b = idx >> 6, head = g * 4 + r;
            bf16_t* Q = AQ2 + ((size_t)(b * SEQ + qb * 256)) * 1024 + head * 128; const bf16_t* K = AK + (size_t)(b * LT) * 256 + g * 128; const bf16_t* V = AV + (size_t)(b * LT) * 256 + g * 128;
            attn::attn_dense_body<attn::bf16>(Q, K, V, Q, LT, (char*)lds, nullptr, ROPE, qb * 256); } }
        GRID_BAR();
        float sd = 0.f, sb = 0.f;
        for (size_t i = (size_t)bid * NTHR + tid; i < (size_t)MLAT * 1024; i += (size_t)G * NTHR) { const float a = bf2f(AQ[i]), b2 = bf2f(AQ2[i]); sd += (a - b2) * (a - b2); sb += b2 * b2; }
        sd = wave_sum(sd); sb = wave_sum(sb);
        if (lane == 0) { atomicAdd(acc2, sd); atomicAdd(acc2 + 1, sb); }
        GRID_BAR();
        if (bid == 0 && tid == 0) { const float s0 = __hip_atomic_load(acc2, __ATOMIC_RELAXED, __HIP_MEMORY_SCOPE_AGENT), s1 = __hip_atomic_load(acc2 + 1, __ATOMIC_RELAXED, __HIP_MEMORY_SCOPE_AGENT);
            args.out[0] = 1e6f * sqrtf(s0 / s1); args.out[1] = 1e3f * sqrtf(s1 / ((float)MLAT * 1024.f)); }
        return;
    }
#endif
    STAMP(4);
#if MK_DEBUG_RET
    {
        bf16_t* YR2 = (bf16_t*)(ws + WS_AQ); float* acc2 = (float*)(ws + WS_CTL) + 64;
        for (int it = bid; it < 8 * RH * 256; it += G) p4_naive_item(RQ, RK, RV, YR, SSQ, l2d, ldsf, it, tid);
        __syncthreads();
        { GridBarF gb{bar}; ret::scan_unit(RQ, RK, RV, YR2, SSQ + 2 * MLAT * 8, l2d, (LAS unsigned char*)lds, bid, gb, 8); }
        GRID_BAR();
        float sd = 0.f, sb = 0.f;
        for (size_t i = (size_t)bid * NTHR + tid; i < (size_t)8 * SEQ * 2048; i += (size_t)G * NTHR) { const int l = (int)((i >> 11) & 2047); if (l < MK_DBG_L0 || l >= MK_DBG_L1 || (int)((i >> 9) & 3) != MK_DBG_H) continue; const float a = bf2f(YR2[i]), b2 = bf2f(YR[i]); sd += (a - b2) * (a - b2); sb += b2 * b2; }
        sd = wave_sum(sd); sb = wave_sum(sb);
        if (lane == 0) { atomicAdd(acc2, sd); atomicAdd(acc2 + 1, sb); }
        GRID_BAR();
        if (bid == 0 && tid == 0) { const float s0 = __hip_atomic_load(acc2, __ATOMIC_RELAXED, __HIP_MEMORY_SCOPE_AGENT), s1 = __hip_atomic_load(acc2 + 1, __ATOMIC_RELAXED, __HIP_MEMORY_SCOPE_AGENT);
            ((float*)(ws + WS_SSQ))[0] = 1e6f * sqrtf(s0 / s1); ((float*)(ws + WS_SSQ))[1] = 1e3f * sqrtf(s1 / (8.f * SEQ * 2048.f)); }
        GRID_BAR();
        if (bid == 0 && tid == 0) { args.out[0] = ((float*)(ws + WS_SSQ))[0]; args.out[1] = ((float*)(ws + WS_SSQ))[1]; }
        return;
    }
#endif
    if (IN(4)) {
        auto kfix = [&]() {
#if !MK_NAIVE_ATTN
          int tl = threadIdx.x; asm volatile("" : "+v"(tl)); const int lane_l = tl & 63, gw_l = bid * NWAVES + (tl >> 6);
          constexpr size_t IK = (size_t)NB * LT * 256 / 512; const size_t ipw = (IK + NGW - 1) / NGW, i0 = (size_t)gw_l * ipw, i1 = i0 + ipw < IK ? i0 + ipw : IK;
          for (size_t it = i0; it < i1; it += 3) p3_items_k<3>(AK, k_norm_w, ROPE, it, i1, lane_l);
#endif
        };
#if MK_NAIVE_RET
        kfix(); for (int it = bid; it < NB * RH * 256; it += G) p4_naive_item(RQ, RK, RV, YR, SSQ, l2d, ldsf, it, tid);
#else
        if (G == 256) { GridBarF gb{bar}; ret::scan_unit(RQ, RK, RV, YR, SSQ, l2d, (LAS unsigned char*)lds, bid, gb, NB, kfix); }
        else { kfix(); for (int it = bid; it < NB * RH * 256; it += G) p4_naive_item(RQ, RK, RV, YR, SSQ, l2d, ldsf, it, tid); if (BOTH(4)) GRID_BAR(); }
#endif
    }
    STAMP(5);
    if (IN(5)) {
#if MK_NAIVE_ATTN
        for (int it = bid; it < NB * AH * 256; it += G) p5_naive_item(AQ, AK, AV, ldsf, it, tid);
#else
        const int vcu = (G % 8 == 0) ? (bid & 7) * (G >> 3) + (bid >> 3) : bid;
#define ATT_UNIT(idx_, Q_, K_, V_, qb_) const int qb_ = (idx_) & 7; bf16_t* Q_; const bf16_t *K_, *V_; \
            { const int r_ = ((idx_) >> 3) & 3, g_ = ((idx_) >> 5) & 1, b_ = (idx_) >> 6, head_ = g_ * 4 + r_; Q_ = AQ + ((size_t)(b_ * SEQ + qb_ * 256)) * 1024 + head_ * 128; \
              K_ = AK + (size_t)(b_ * LT) * 256 + g_ * 128; V_ = AV + (size_t)(b_ * LT) * 256 + g_ * 128; }
        attn::Pre pre;
        if (vcu < NB * AH * 8) { ATT_UNIT(vcu, Q0, K0, V0, qb0); attn::attn_prefetch(Q0, K0, V0, pre); }
        for (int idx = vcu; idx < NB * AH * 8; idx += G) {
            ATT_UNIT(idx, Q, K, V, qb);
            const int nidx = idx + G; const bool hn = nidx < NB * AH * 8; ATT_UNIT(hn ? nidx : idx, Qn, Kn, Vn, qbn);
            attn::attn_dense_body<attn::bf16>(Q, K, V, Q, LT, (char*)lds, q_norm_w, ROPE, qb * 256, pre, Qn, Kn, Vn); __syncthreads();
        }
#undef ATT_UNIT
#endif
#if !MK_NAIVE_RET
        if (G != 256) { int tl = threadIdx.x; asm volatile("" : "+v"(tl)); const int lane_l = tl & 63, gw_l = bid * NWAVES + (tl >> 6);
          for (int it = gw_l; it < MLAT * 4; it += NGW) ssq_item(YR, SSQ, it, lane_l); }
#endif
        if (BOTH(5)) GRID_BAR();
    }
    STAMP(6);
    if (IN(6)) {
        STAGGER();
        pg8::Gemm g{HX, WIN + (size_t)N1 * 1024, MLAT, NG, 1024}; pg8::StaticOrder S; S.init(MLAT, NG, G, bid);
        pg8::Epi5 E{YR, AQ, U1, U2, SSQ, 0};
        pg8::gemm_phase<pg8::Epi5, pg8::StaticOrder, true, true, MK_EPIW>((PG8_LAS unsigned char*)lds, g, S, E);
        if (BOTH(6)) GRID_BAR();
    }
    STAMP(7);
    if (IN(7)) {
        pg8::Gemm g{YR, WOR, MLAT, 1024, 2048}; pg8::StaticOrder S; S.init(MLAT, 1024, G, bid);
        pg8::Epi6 E{U1};
        pg8::gemm_phase<pg8::Epi6, pg8::StaticOrder, true, true, MK_EPIW>((PG8_LAS unsigned char*)lds, g, S, E);
    }
    STAMP(8);
    if (IN(8)) {
        pg8::Gemm g{AQ, WOA, MLAT, 1024, 1024}; pg8::StaticOrder S; S.init(MLAT, 1024, G, bid);
        pg8::Epi7 E{U1, U2};
        pg8::gemm_phase<pg8::Epi7, pg8::StaticOrder, true, true, MK_EPIW>((PG8_LAS unsigned char*)lds, g, S, E);
        if (BOTH(8)) GRID_BAR();
    }
    STAMP(9);
    if (IN(9)) {
        pg8::Gemm g{U1, WOUT, MLAT, 1024, 1024}; pg8::StaticOrder S; S.init(MLAT, 1024, G, bid);
        pg8::Epi8 E{x, MOD, args.out};
        { pg8::RepOrder SR; SR.so = S; SR.reps = MK_REP_P9; pg8::gemm_phase<pg8::Epi8, pg8::RepOrder, true, true, MK_EPIW>((PG8_LAS unsigned char*)lds, g, SR, E); }
    }
    STAMP(10);
#if MK_TIMING
    if (bid == 0) { const unsigned spin = __builtin_amdgcn_readfirstlane(((const unsigned*)SSQ - 64)[MK_TSEL]); const unsigned long long t0_ = __builtin_amdgcn_s_memrealtime();
        while (__builtin_amdgcn_s_memrealtime() - t0_ < (unsigned long long)spin) __builtin_amdgcn_s_sleep(8); }
#endif
#if MK_STAMP_A >= 0
    __syncthreads();
    if (bid == 0) { __syncthreads(); const unsigned sp = ((volatile LAS unsigned*)(lds + MISC_OFF))[18] - ((volatile LAS unsigned*)(lds + MISC_OFF))[17]; const unsigned long long t0_ = __builtin_amdgcn_s_memrealtime();
        while (__builtin_amdgcn_s_memrealtime() - t0_ < (unsigned long long)sp) __builtin_amdgcn_s_sleep(8); }
#endif
#undef IN
#undef BOTH
}

extern "C" void kernel_launch(void* const* d_in, const int* in_sizes, int n_in, void* d_out, int out_size, void* d_ws, size_t ws_size, hipStream_t stream) {
    static int grid = 0;
    if (grid == 0) {
        if (n_in != 14 || in_sizes[0] != MLAT * DM || out_size != MLAT * DM || ws_size < WS_END) {
            fprintf(stderr, "kernel_launch: unexpected shapes: n_in %d in0 %d out %d ws %zu (need >= %zu)\n", n_in, n_in > 0 ? in_sizes[0] : -1, out_size, ws_size, (size_t)WS_END); grid = -1; return; }
        int dev = 0, cus = 0;
        if (hipGetDevice(&dev) != hipSuccess || hipDeviceGetAttribute(&cus, hipDeviceAttributeMultiprocessorCount, dev) != hipSuccess) { grid = -1; return; }
        if (hipFuncSetAttribute((const void*)mk_fwd, hipFuncAttributeMaxDynamicSharedMemorySize, LDS_BYTES) != hipSuccess) { fprintf(stderr, "kernel_launch: hipFuncSetAttribute failed\n"); grid = -1; return; }
        grid = cus;
    }
    if (grid < 0) return;
    Args a{};
    for (int i = 0; i < 14; ++i) a.in[i] = (const float*)d_in[i];
    a.out = (float*)d_out; a.ws = (unsigned char*)d_ws;
#if MK_ONE_LAUNCH
    a.ph_lo = 0; a.ph_hi = N_PHASES;
#if MK_BARRIER == 1
    if (hipMemsetAsync((char*)d_ws + WS_CTL, 0, CTL_ZERO_BYTES, stream) != hipSuccess) { fprintf(stderr, "kernel_launch: hipMemsetAsync failed\n"); return; }
    hipLaunchKernelGGL(mk_fwd, dim3(grid), dim3(NTHR), LDS_BYTES, stream, a);
#else
    void* kargs[] = {&a};
    const hipError_t ce = hipLaunchCooperativeKernel((const void*)mk_fwd, dim3(grid), dim3(NTHR), kargs, LDS_BYTES, stream);
    if (ce != hipSuccess) fprintf(stderr, "kernel_launch: cooperative launch failed: %s\n", hipGetErrorName(ce));
#endif
#else
    for (int ph = 0; ph < N_PHASES; ++ph) {
        a.ph_lo = ph; a.ph_hi = ph + 1;
        hipLaunchKernelGGL(mk_fwd, dim3(grid), dim3(NTHR), LDS_BYTES, stream, a);
    }
#endif
    const hipError_t le = hipPeekAtLastError();
    if (le != hipSuccess) fprintf(stderr, "kernel_launch: launch failed: %s\n", hipGetErrorName(le));
}
```

```cpp
#include <hip/hip_runtime.h>
#include <cstdio>
#include <cstdint>
#include <hip/hip_cooperative_groups.h>

constexpr int NB = 16, SEQ = 2048, DM = 1024, LC = 256, LT = LC + SEQ;
constexpr int MLAT = NB * SEQ, MCTX = NB * LC, MALL = MLAT + MCTX;
constexpr int RH = 4, RDK = 256, RDV = 512;
constexpr int AH = 8, AKV = 2, AHD = 128;
constexpr int NIN = 10752, NKV = 3584, N1 = 5632, NG = 5120;
constexpr float EPS = 1e-6f;
#ifndef MK_TIMING
#define MK_TIMING 0
#define MK_TSEL 0
#endif
#ifndef MK_WT
#define MK_WT 1
#endif
#ifndef MK_WT_AUX
#define MK_WT_AUX 18
#endif
#ifndef MK_P2PROBE
#define MK_P2PROBE 0
#endif
#ifndef MK_RPROBE
#define MK_RPROBE 0
#endif
#ifndef MK_DBG_NOCTX
#define MK_DBG_NOCTX 0
#endif
constexpr int NWAVES = 8, NTHR = 512;
#define LAS __attribute__((address_space(3)))

typedef unsigned short bf16_t;
typedef unsigned v4u __attribute__((ext_vector_type(4)));
typedef unsigned v2u __attribute__((ext_vector_type(2)));
typedef float v4f __attribute__((ext_vector_type(4)));
typedef float v2f __attribute__((ext_vector_type(2)));

__device__ __forceinline__ float bf2f(unsigned h) { return __uint_as_float(h << 16); }
__device__ __forceinline__ unsigned f2bf(float f) { unsigned u = __float_as_uint(f); return (u + 0x7fffu + ((u >> 16) & 1u)) >> 16; }
__device__ __forceinline__ unsigned pk2(float lo, float hi) { return f2bf(lo) | (f2bf(hi) << 16); }
__device__ __forceinline__ float bflo(unsigned w) { return __uint_as_float(w << 16); }
__device__ __forceinline__ float bfhi(unsigned w) { return __uint_as_float(w & 0xffff0000u); }
__device__ __forceinline__ float fast_sigmoid(float x) { return __builtin_amdgcn_rcpf(1.0f + __builtin_amdgcn_exp2f(-1.4426950408889634f * x)); }
__device__ __forceinline__ float fast_silu(float x) { return x * fast_sigmoid(x); }
__device__ __forceinline__ void sigmoid4(const float (&x)[4], float (&s)[4]) {
    float a[4];
#pragma unroll
    for (int k = 0; k < 4; ++k) a[k] = 1.0f + __builtin_amdgcn_exp2f(-1.4426950408889634f * fmaxf(x[k], -20.0f));
    const float p01 = a[0] * a[1], p23 = a[2] * a[3], r = __builtin_amdgcn_rcpf(p01 * p23), r01 = r * p23, r23 = r * p01;
    s[0] = r01 * a[1]; s[1] = r01 * a[0]; s[2] = r23 * a[3]; s[3] = r23 * a[2];
}
__device__ __forceinline__ float wave_sum(float v) {
#pragma unroll
    for (int o = 1; o < 64; o <<= 1) v += __shfl_xor(v, o);
    return v;
}

typedef __bf16 bf16x2_t __attribute__((ext_vector_type(2)));
__device__ __forceinline__ unsigned cvt_pk_bf16(float lo, float hi) { v2f v = {lo, hi}; bf16x2_t b = __builtin_convertvector(v, bf16x2_t); return __builtin_bit_cast(unsigned, b); }
__device__ __forceinline__ void unpack8(const v4u w, float (&o)[8]) {
    o[0] = bflo(w.x); o[1] = bfhi(w.x); o[2] = bflo(w.y); o[3] = bfhi(w.y); o[4] = bflo(w.z); o[5] = bfhi(w.z); o[6] = bflo(w.w); o[7] = bfhi(w.w);
}
__device__ __forceinline__ v4u pack8(const float (&o)[8]) {
    v4u w; w.x = cvt_pk_bf16(o[0], o[1]); w.y = cvt_pk_bf16(o[2], o[3]); w.z = cvt_pk_bf16(o[4], o[5]); w.w = cvt_pk_bf16(o[6], o[7]); return w;
}

constexpr size_t MiB = 1u << 20;
constexpr size_t WS_CTL = 0;
constexpr size_t WS_MOD = 1 * MiB;
constexpr size_t WS_ROPE = WS_MOD + 256 * 1024;
constexpr size_t WS_SSQ = 2 * MiB;
constexpr size_t WS_WIN = 4 * MiB;
constexpr size_t WS_WOR = 25 * MiB;
constexpr size_t WS_WOA = 29 * MiB;
constexpr size_t WS_WOUT = 31 * MiB;
constexpr size_t WS_HX = 33 * MiB;
constexpr size_t WS_RK = 105 * MiB;
constexpr size_t WS_RV = 177 * MiB;
constexpr size_t WS_RQ = 321 * MiB;
constexpr size_t WS_AK = 385 * MiB;
constexpr size_t WS_AV = 403 * MiB;
constexpr size_t WS_AQ = 421 * MiB;
constexpr size_t WS_END = 485 * MiB;
constexpr size_t WS_U1 = WS_RK;
constexpr size_t WS_U2 = WS_RV;

__host__ __device__ __forceinline__ int orig_col(int n) { return n < 4608 ? n : (n < 5632 ? n + 2048 : (n < 7680 ? n - 1024 : n)); }
namespace pg8 {
#define PG8_LAS __attribute__((address_space(3)))
typedef unsigned short bf16_t;
typedef short bf16x8 __attribute__((ext_vector_type(8)));
typedef float f32x4 __attribute__((ext_vector_type(4)));
typedef unsigned u32x4 __attribute__((ext_vector_type(4)));
constexpr int BM = 256, BK = 64, HALF = 128, HTB = HALF * BK * 2  , STAGE_BYTES = 8 * HTB, NXCD = 8, WGM = 8;

__host__ __device__ __forceinline__ int lds_byte(int r, int c) { const int st = (r >> 4) * 2 + (c >> 5), rr = r & 15, cc = c & 31, ob = rr * 64 + cc * 2; return st * 1024 + (ob ^ (((ob >> 9) & 1) << 5)); }
__host__ __device__ __forceinline__ void stage_rc(int b, int& R, int& C) { const int st = b / 1024, sb = b % 1024, swz = sb ^ (((sb >> 9) & 1) << 5); R = (st >> 1) * 16 + swz / 64; C = (st & 1) * 32 + (swz % 64) / 2; }
__host__ __device__ __forceinline__ int perm32(int rho) { const int n = rho >> 4, i = rho & 15; return 8 * (i >> 2) + 4 * n + (i & 3); }

struct Unit { int pm, pn; };
struct Gemm { const bf16_t* A; const bf16_t* Bt; int M, N, K; };

struct StaticOrder {
    int nM, nN, nwg, G, c;
    __host__ __device__ void init(int M, int N, int G_, int c_) { nM = M / BM; nN = N / BM; nwg = nM * nN; G = G_; c = c_; }
    __host__ __device__ bool next(int i, Unit& u) const {
        const long L = (long)i * G + c; if (L >= nwg) return false;
        int wgid = (int)L; { const int q = nwg / NXCD, r = nwg % NXCD, xcd = wgid % NXCD, off = wgid / NXCD; wgid = (xcd < r ? xcd * (q + 1) : r * (q + 1) + (xcd - r) * q) + off; }
        const int nig = WGM * nN, gid = wgid / nig, fm = gid * WGM, gsz = (nM - fm) < WGM ? (nM - fm) : WGM;
        u.pm = fm + ((wgid % nig) % gsz); u.pn = (wgid % nig) / gsz; return true;
    }
    __device__ __forceinline__ void a_ready(const Unit&) const {}
    __device__ __forceinline__ void done(const Unit&) const {}
};


#if MK_WT
#define WT_RSRC(name, baseptr) const __amdgpu_buffer_rsrc_t name = __builtin_amdgcn_make_buffer_rsrc((void*)(baseptr), 0, 0x7ffffff0, 0x00020000)
#define WT_ST16(name, byteoff, val) __builtin_amdgcn_raw_buffer_store_b128((val), name, (unsigned)(byteoff), 0, MK_WT_AUX)
#endif
struct Sched1 {
    int G, c; StaticOrder so;
    __device__ void init(int G_, int c_) { G = G_; c = c_; so.init(MLAT, N1, G_, c_); }
    __device__ bool next(int i, Unit& u) const {
        long L = (long)i * G + c; if (L < 2816) return so.next(i, u);
        L -= 2816; if (L >= 224) return false;
        u.pm = 128 + (int)(L & 15); u.pn = (int)(L >> 4); return true;
    }
    __device__ __forceinline__ void a_ready(const Unit&) const {}
    __device__ __forceinline__ void done(const Unit&) const {}
};

struct RepOrder {
    StaticOrder so; int reps;
    __device__ bool next(int i, Unit& u) const { const int per = (so.nwg - so.c + so.G - 1) / so.G; if (i >= per * reps) return false; return so.next(i % per, u); }
    __device__ __forceinline__ void a_ready(const Unit&) const {}
    __device__ __forceinline__ void done(const Unit&) const {}
};

#define EPI_ROWS_BEGIN const int rt0 = wr * 64 + fr, ct0 = wc * 32 + 8 * fq; \
    _Pragma("unroll") for (int ai = 0; ai < 2; ++ai) _Pragma("unroll") for (int m = 0; m < 4; ++m) { const int rt = rt0 + ai * HALF + m * 16;
#define EPI_ROWS_END }

template <int DUM> struct Epi1T {
    static constexpr bool PERM = true, AFTER_DRAIN = false;
    bf16_t *RK, *RV, *AK, *AV, *RQ, *AQ; bf16_t* DUMMY;
    __device__ __forceinline__ void operator()(const f32x4 (&acc)[2][2][4][2], const Unit& u, int wr, int wc, int fr, int fq) const {
        const int pm = u.pm, pn = u.pn;
        const int kvrow0 = pm < 128 ? ((pm >> 3) * LT + LC + (pm & 7) * 256) : ((pm - 128) * LT);
        bf16_t* base; int ld; float sc = 1.f;
        if (pn < 4) { base = RK + (size_t)kvrow0 * 1024 + pn * 256; ld = 1024; sc = 0.0625f; }
        else if (pn < 12) { base = RV + (size_t)kvrow0 * 2048 + (pn - 4) * 256; ld = 2048; }
        else if (pn == 12) { base = AK + (size_t)kvrow0 * 256; ld = 256; }
        else if (pn == 13) { base = AV + (size_t)kvrow0 * 256; ld = 256; }
        else if (pn < 18) { base = RQ + (size_t)pm * 256 * 1024 + (pn - 14) * 256; ld = 1024; }
        else { base = AQ + (size_t)pm * 256 * 1024 + (pn - 18) * 256; ld = 1024; }
#if MK_P2PROBE
        if constexpr (DUM == 1) { base = DUMMY + (size_t)blockIdx.x * 32768; ld = 256; }
        if constexpr (DUM == 2) {
            const int rb = kvrow0 >> 8;
            if (pn < 4) base = RK + ((size_t)rb * 4 + pn) * 65536; else if (pn < 12) base = RV + ((size_t)rb * 8 + (pn - 4)) * 65536;
            else if (pn < 14) { } else if (pn < 18) base = RQ + ((size_t)pm * 4 + (pn - 14)) * 65536; else base = AQ + ((size_t)pm * 4 + (pn - 18)) * 65536;
            ld = 256; }
#endif
#if (MK_WT & 1)
        const __amdgpu_buffer_rsrc_t rs = __builtin_amdgcn_make_buffer_rsrc((void*)base, 0, 0x7ffffff0, 0x00020000);
#endif
        EPI_ROWS_BEGIN
            bf16_t* rowp = base + (size_t)(DUM == 1 ? (rt & 127) : rt) * ld + ct0;
#pragma unroll
            for (int bj = 0; bj < 2; ++bj) { const f32x4 v0 = acc[ai][bj][m][0] * sc, v1 = acc[ai][bj][m][1] * sc;
                u32x4 w; w.x = cvt_pk_bf16(v0[0], v0[1]); w.y = cvt_pk_bf16(v0[2], v0[3]); w.z = cvt_pk_bf16(v1[0], v1[1]); w.w = cvt_pk_bf16(v1[2], v1[3]);
#if (MK_WT & 1)
                __builtin_amdgcn_raw_buffer_store_b128(w, rs, (unsigned)(((DUM == 1 ? (rt & 127) : rt) * ld + ct0 + bj * HALF) * 2), 0, MK_WT_AUX);
#else
                *(u32x4*)(rowp + bj * HALF) = w;
#endif
                }
        EPI_ROWS_END
    }
};

typedef Epi1T<0> Epi1;
#define EPI_FOR_PIECES _Pragma("unroll") for (int ai = 0; ai < 2; ++ai) _Pragma("unroll") for (int m = 0; m < 4; ++m) _Pragma("unroll") for (int bj = 0; bj < 2; ++bj)
struct Epi5 {
    static constexpr bool PERM = true, AFTER_DRAIN = false;
    bf16_t *YR, *YA, *U1, *U2; const float* SSQ; int dry_unused;
    __device__ __forceinline__ void operator()(const f32x4 (&acc)[2][2][4][2], const Unit& u, int wr, int wc, int fr, int fq) const {
        const int pn = u.pn; const size_t row0 = (size_t)u.pm * 256;
        if (pn < 8) {
            const int head = pn >> 1;
            EPI_ROWS_BEGIN
                const size_t row = row0 + rt;
                const float ss = SSQ[row * 8 + head * 2] + SSQ[row * 8 + head * 2 + 1];
                const float rstd = __builtin_amdgcn_rsqf(ss * (1.0f / 512.0f) + EPS);
#pragma unroll
                for (int bj = 0; bj < 2; ++bj) { u32x4* p = (u32x4*)(YR + row * 2048 + pn * 256 + bj * HALF + ct0); float o[8]; unpack8(*p, o);
                    const f32x4 v0 = acc[ai][bj][m][0], v1 = acc[ai][bj][m][1];
                    { const float x0[4] = {v0[0], v0[1], v0[2], v0[3]}, x1[4] = {v1[0], v1[1], v1[2], v1[3]}; float s0[4], s1[4]; sigmoid4(x0, s0); sigmoid4(x1, s1);
#pragma unroll
                    for (int k = 0; k < 4; ++k) { o[k] = o[k] * rstd * (x0[k] * s0[k]); o[4 + k] = o[4 + k] * rstd * (x1[k] * s1[k]); } }
                    *p = pack8(o); }
            EPI_ROWS_END
        } else if (pn < 12) {
            EPI_ROWS_BEGIN
                const size_t row = row0 + rt;
#pragma unroll
                for (int bj = 0; bj < 2; ++bj) { u32x4* p = (u32x4*)(YA + row * 1024 + (pn - 8) * 256 + bj * HALF + ct0); float o[8]; unpack8(*p, o);
                    const f32x4 v0 = acc[ai][bj][m][0], v1 = acc[ai][bj][m][1];
                    { const float x0[4] = {v0[0], v0[1], v0[2], v0[3]}, x1[4] = {v1[0], v1[1], v1[2], v1[3]}; float s0[4], s1[4]; sigmoid4(x0, s0); sigmoid4(x1, s1);
#pragma unroll
                    for (int k = 0; k < 4; ++k) { o[k] = o[k] * (x0[k] * s0[k]); o[4 + k] = o[4 + k] * (x1[k] * s1[k]); } }
                    *p = pack8(o); }
            EPI_ROWS_END
        } else {
            bf16_t* U = pn < 16 ? U1 + (pn - 12) * 256 : U2 + (pn - 16) * 256;
            EPI_ROWS_BEGIN
                const size_t row = row0 + rt;
#pragma unroll
                for (int bj = 0; bj < 2; ++bj) { float o[8]; const f32x4 v0 = acc[ai][bj][m][0], v1 = acc[ai][bj][m][1];
                    { const float x0[4] = {v0[0], v0[1], v0[2], v0[3]}, x1[4] = {v1[0], v1[1], v1[2], v1[3]}; float s0[4], s1[4]; sigmoid4(x0, s0); sigmoid4(x1, s1);
#pragma unroll
                    for (int k = 0; k < 4; ++k) { o[k] = s0[k]; o[4 + k] = s1[k]; } }
                    *(u32x4*)(U + row * 1024 + bj * HALF + ct0) = pack8(o); }
            EPI_ROWS_END
        }
    }
};

struct Epi6 {
    static constexpr bool PERM = true, AFTER_DRAIN = false;
    bf16_t* U1;
    __device__ __forceinline__ void operator()(const f32x4 (&acc)[2][2][4][2], const Unit& u, int wr, int wc, int fr, int fq) const {
        bf16_t* base = U1 + ((size_t)u.pm * 256 + wr * 64 + fr) * 1024 + u.pn * 256 + wc * 32 + 8 * fq;
#if (MK_WT & 2)
        WT_RSRC(rs, U1 + (size_t)u.pm * 256 * 1024 + u.pn * 256);
#endif
#pragma unroll
        for (int ai = 0; ai < 2; ++ai) {
            u32x4 pc[4][2];
#pragma unroll
            for (int m = 0; m < 4; ++m)
#pragma unroll
                for (int bj = 0; bj < 2; ++bj) pc[m][bj] = *(const u32x4*)(base + (size_t)(ai * HALF + m * 16) * 1024 + bj * HALF);
#pragma unroll
            for (int m = 0; m < 4; ++m)
#pragma unroll
                for (int bj = 0; bj < 2; ++bj) { float o[8]; unpack8(pc[m][bj], o); const f32x4 v0 = acc[ai][bj][m][0], v1 = acc[ai][bj][m][1];
#pragma unroll
                    for (int k = 0; k < 4; ++k) { o[k] *= v0[k]; o[4 + k] *= v1[k]; }
#if (MK_WT & 2)
                    WT_ST16(rs, (((wr * 64 + fr) + ai * HALF + m * 16) * 1024 + wc * 32 + 8 * fq + bj * HALF) * 2, pack8(o)); }
#else
                    *(u32x4*)(base + (size_t)(ai * HALF + m * 16) * 1024 + bj * HALF) = pack8(o); }
#endif
        }
    }
};
struct Epi7 {
    static constexpr bool PERM = true, AFTER_DRAIN = false;
    bf16_t* U1; const bf16_t* U2;
    __device__ __forceinline__ void operator()(const f32x4 (&acc)[2][2][4][2], const Unit& u, int wr, int wc, int fr, int fq) const {
        const size_t off0 = ((size_t)u.pm * 256 + wr * 64 + fr) * 1024 + u.pn * 256 + wc * 32 + 8 * fq;
#if (MK_WT & 4)
        WT_RSRC(rs, U1 + (size_t)u.pm * 256 * 1024 + u.pn * 256);
#endif
#pragma unroll
        for (int q4 = 0; q4 < 4; ++q4) {
            const int ai = q4 >> 1, mb = (q4 & 1) * 2; u32x4 pc[2][2], pg[2][2];
#pragma unroll
            for (int m2 = 0; m2 < 2; ++m2)
#pragma unroll
                for (int bj = 0; bj < 2; ++bj) { const size_t off = off0 + (size_t)(ai * HALF + (mb + m2) * 16) * 1024 + bj * HALF; pc[m2][bj] = *(const u32x4*)(U1 + off); pg[m2][bj] = *(const u32x4*)(U2 + off); }
#pragma unroll
            for (int m2 = 0; m2 < 2; ++m2)
#pragma unroll
                for (int bj = 0; bj < 2; ++bj) { const int m = mb + m2; const size_t off = off0 + (size_t)(ai * HALF + m * 16) * 1024 + bj * HALF; float o[8], g[8]; unpack8(pc[m2][bj], o); unpack8(pg[m2][bj], g);
                    const f32x4 v0 = acc[ai][bj][m][0], v1 = acc[ai][bj][m][1];
#pragma unroll
                    for (int k = 0; k < 4; ++k) { o[k] += g[k] * v0[k]; o[4 + k] += g[4 + k] * v1[k]; }
#if (MK_WT & 4)
                    WT_ST16(rs, (((wr * 64 + fr) + ai * HALF + m * 16) * 1024 + wc * 32 + 8 * fq + bj * HALF) * 2, pack8(o)); }
#else
                    *(u32x4*)(U1 + off) = pack8(o); }
#endif
        }
    }
};
struct Epi8 {
    static constexpr bool PERM = true, AFTER_DRAIN = false;
    const float* X; const float* MOD; float* OUT;
    __device__ __forceinline__ void operator()(const f32x4 (&acc)[2][2][4][2], const Unit& u, int wr, int wc, int fr, int fq) const {
        const int col0 = u.pn * 256 + wc * 32 + 8 * fq; const size_t off0 = ((size_t)u.pm * 256 + wr * 64 + fr) * 1024 + col0; const float* gate = MOD + (size_t)(u.pm >> 3) * 3072 + 2048 + col0;
        f32x4 gv[2][2];
#if (MK_WT & 8)
        WT_RSRC(rs, OUT + (size_t)u.pm * 256 * 1024 + u.pn * 256);
#endif
#pragma unroll
        for (int bj = 0; bj < 2; ++bj)
#pragma unroll
            for (int n = 0; n < 2; ++n) gv[bj][n] = *(const f32x4*)(gate + bj * HALF + 4 * n);
#pragma unroll
        for (int q4 = 0; q4 < 4; ++q4) {
            const int ai = q4 >> 1, mb = (q4 & 1) * 2; f32x4 xv[2][2][2];
#pragma unroll
            for (int m2 = 0; m2 < 2; ++m2)
#pragma unroll
                for (int bj = 0; bj < 2; ++bj)
#pragma unroll
                    for (int n = 0; n < 2; ++n) xv[m2][bj][n] = *(const f32x4*)(X + off0 + (size_t)(ai * HALF + (mb + m2) * 16) * 1024 + bj * HALF + 4 * n);
#pragma unroll
            for (int m2 = 0; m2 < 2; ++m2)
#pragma unroll
                for (int bj = 0; bj < 2; ++bj)
#pragma unroll
#if (MK_WT & 8)
                    for (int n = 0; n < 2; ++n) { const f32x4 r = xv[m2][bj][n] + gv[bj][n] * acc[ai][bj][mb + m2][n]; WT_ST16(rs, (((wr * 64 + fr) + ai * HALF + (mb + m2) * 16) * 1024 + wc * 32 + 8 * fq + bj * HALF + 4 * n) * 4, __builtin_bit_cast(u32x4, r)); }
#else
                    for (int n = 0; n < 2; ++n) *(f32x4*)(OUT + off0 + (size_t)(ai * HALF + (mb + m2) * 16) * 1024 + bj * HALF + 4 * n) = xv[m2][bj][n] + gv[bj][n] * acc[ai][bj][mb + m2][n];
#endif
        }
    }
};
struct EpiNull {
    static constexpr bool PERM = true, AFTER_DRAIN = false;
    __device__ __forceinline__ void operator()(const f32x4 (&acc)[2][2][4][2], const Unit& u, int wr, int wc, int fr, int fq) const {
#pragma unroll
        for (int ai = 0; ai < 2; ++ai)
#pragma unroll
            for (int bj = 0; bj < 2; ++bj)
#pragma unroll
                for (int m = 0; m < 4; ++m)
#pragma unroll
                    for (int n = 0; n < 2; ++n) asm volatile("" :: "v"(acc[ai][bj][m][n]));
    }
};
template <int N> __device__ __forceinline__ void wait_vm_sel(int sel) { asm volatile("s_waitcnt vmcnt(%1)\n\ts_cmp_lg_u32 %0, 0\n\ts_cbranch_scc1 .Lwvs%=\n\ts_waitcnt vmcnt(8)\n.Lwvs%=:" :: "s"(sel), "n"(N) : "memory", "scc"); }
template <class Epi, class Sched, bool ALIGN_EPI = false, bool SP2 = false, int EPIW = 0>
__device__ __forceinline__ void gemm_phase(PG8_LAS unsigned char* lds, const Gemm g, const Sched& S, const Epi& E) {
    const int tid = threadIdx.x, wid = __builtin_amdgcn_readfirstlane(tid >> 6), lane = tid & 63, wr = wid >> 2, wc = wid & 3, fr = lane & 15, fq = lane >> 4;
    const int K = g.K, nt = K / BK;
    unsigned voffA[2], voffB[2];
#pragma unroll
    for (int i = 0; i < 2; ++i) { int R, C; stage_rc(tid * 16 + i * 8192, R, C); const int Rb = Epi::PERM ? ((R & ~31) + perm32(R & 31)) : R;
        voffA[i] = (unsigned)(R * K + C) * 2u; voffB[i] = (unsigned)(Rb * K + C) * 2u; }
    const size_t kstep = (size_t)(BK * 2);
    const size_t hstep = (size_t)HALF * K * 2;
    const size_t tstep = 2 * hstep;
    const unsigned ldsw = (unsigned)wid * 1024u;
    const int aoff = lds_byte(wr * 64 + fr, fq * 8), boff = lds_byte(wc * 32 + fr, fq * 8);
#define PG8_SA(b, h) (((b) * 2 + (h)) * HTB)
#define PG8_SB(b, h) ((4 + (b) * 2 + (h)) * HTB)
#define PG8_STAGE(bufoff, gbase, voff) do { _Pragma("unroll") for (int _i = 0; _i < 2; ++_i) \
        __builtin_amdgcn_global_load_lds((const unsigned*)((const char*)(gbase) + (voff)[_i]), (PG8_LAS unsigned*)(lds + (bufoff) + ldsw + _i * 8192), 16, 0, 0); } while (0)
#define PG8_LDA(dst, b, h) do { _Pragma("unroll") for (int m = 0; m < 4; ++m) _Pragma("unroll") for (int k = 0; k < 2; ++k) dst[m][k] = *(const PG8_LAS bf16x8*)(lds + PG8_SA(b, h) + aoff + m * 2048 + k * 1024); } while (0)
#define PG8_LDB(dst, b, h) do { _Pragma("unroll") for (int n = 0; n < 2; ++n) _Pragma("unroll") for (int k = 0; k < 2; ++k) dst[n][k] = *(const PG8_LAS bf16x8*)(lds + PG8_SB(b, h) + boff + n * 2048 + k * 1024); } while (0)
#define PG8_MMA(ai, bj, At, Bt) do { __builtin_amdgcn_s_setprio(1); _Pragma("unroll") for (int m = 0; m < 4; ++m) _Pragma("unroll") for (int n = 0; n < 2; ++n) _Pragma("unroll") for (int k = 0; k < 2; ++k) \
        acc[ai][bj][m][n] = __builtin_amdgcn_mfma_f32_16x16x32_bf16(Bt[n][k], At[m][k], acc[ai][bj][m][n], 0, 0, 0); __builtin_amdgcn_s_setprio(0); } while (0)
#define PG8_WAIT_V(n) asm volatile("s_waitcnt vmcnt(" #n ")" ::: "memory")
#define PG8_WAIT_L(n) asm volatile("s_waitcnt lgkmcnt(" #n ")" ::: "memory")
#define PG8_BAR __builtin_amdgcn_s_barrier()
#define PG8_SCHED __builtin_amdgcn_sched_barrier(0)
    Unit cur, nxt; int ui = 0;
    if (!S.next(0, cur)) return;
    f32x4 acc[2][2][4][2];
#pragma unroll
    for (int a = 0; a < 2; ++a)
#pragma unroll
        for (int b = 0; b < 2; ++b)
#pragma unroll
            for (int m = 0; m < 4; ++m)
#pragma unroll
                for (int n = 0; n < 2; ++n) acc[a][b][m][n] = (f32x4){0.f, 0.f, 0.f, 0.f};
    bf16x8 At[4][2], B0[2][2], B1[2][2];
    const char* cA = (const char*)g.A + (size_t)cur.pm * tstep; const char* cB = (const char*)g.Bt + (size_t)cur.pn * tstep;
    S.a_ready(cur);
    if constexpr (SP2) {
        PG8_STAGE(PG8_SB(0, 0), cB, voffB); PG8_STAGE(PG8_SB(0, 1), cB + hstep, voffB); PG8_STAGE(PG8_SA(0, 0), cA, voffA); PG8_STAGE(PG8_SA(0, 1), cA + hstep, voffA);
        if (wr == 1) PG8_BAR;
        PG8_WAIT_V(2); PG8_BAR;
        PG8_STAGE(PG8_SB(1, 0), cB + kstep, voffB); PG8_STAGE(PG8_SA(1, 0), cA + kstep, voffA); PG8_STAGE(PG8_SB(1, 1), cB + hstep + kstep, voffB);
        PG8_WAIT_V(6); PG8_BAR;
    } else {
        PG8_STAGE(PG8_SB(0, 0), cB, voffB); PG8_STAGE(PG8_SA(0, 0), cA, voffA); PG8_STAGE(PG8_SB(0, 1), cB + hstep, voffB); PG8_STAGE(PG8_SA(0, 1), cA + hstep, voffA);
        if (wr == 1) PG8_BAR;
        PG8_WAIT_V(4); PG8_BAR;
        PG8_STAGE(PG8_SB(1, 0), cB + kstep, voffB); PG8_STAGE(PG8_SA(1, 0), cA + kstep, voffA); PG8_STAGE(PG8_SB(1, 1), cB + hstep + kstep, voffB);
        PG8_WAIT_V(6); PG8_BAR;
    }
    for (;;) {
        const bool has_next = S.next(ui + 1, nxt);
        const char* nA = has_next ? (const char*)g.A + (size_t)nxt.pm * tstep : cA; const char* nB = has_next ? (const char*)g.Bt + (size_t)nxt.pn * tstep : cB;
        for (int t = 0; t < nt; t += 2) {
            const bool last = (t == nt - 2);
            const char* a1 = cA + (size_t)(t + 1) * kstep;
            const char* a2 = last ? nA : cA + (size_t)(t + 2) * kstep; const char* b2 = last ? nB : cB + (size_t)(t + 2) * kstep;
            const char* a3 = a2 + kstep; const char* b3 = b2 + kstep;
            if (last && has_next) S.a_ready(nxt);
            const int fe = __builtin_amdgcn_readfirstlane(((EPIW > 0) && (t == 0) && (ui > 0)) ? 1 : 0);
            if constexpr (SP2) {
            PG8_LDB(B0, 0, 0); PG8_LDB(B1, 0, 1); PG8_SCHED; PG8_LDA(At, 0, 0); PG8_STAGE(PG8_SA(1, 1), a1 + hstep, voffA);
            if constexpr (EPIW > 0) wait_vm_sel<8 + EPIW>(fe); else PG8_WAIT_V(8); PG8_WAIT_L(0); PG8_BAR; PG8_MMA(0, 0, At, B0); PG8_MMA(0, 1, At, B1); PG8_BAR; PG8_SCHED;
            PG8_LDA(At, 0, 1); PG8_STAGE(PG8_SB(0, 0), b2, voffB); PG8_STAGE(PG8_SB(0, 1), b2 + hstep, voffB); PG8_STAGE(PG8_SA(0, 0), a2, voffA);
            if constexpr (EPIW > 0) wait_vm_sel<8 + EPIW>(fe); else PG8_WAIT_V(8); PG8_WAIT_L(0); PG8_BAR; PG8_MMA(1, 0, At, B0); PG8_MMA(1, 1, At, B1); PG8_BAR; PG8_SCHED;
            PG8_LDB(B0, 1, 0); PG8_LDB(B1, 1, 1); PG8_SCHED; PG8_LDA(At, 1, 0); PG8_STAGE(PG8_SA(0, 1), a2 + hstep, voffA);
            PG8_WAIT_V(8); PG8_WAIT_L(0); PG8_BAR; PG8_MMA(0, 0, At, B0); PG8_MMA(0, 1, At, B1); PG8_BAR; PG8_SCHED;
            PG8_LDA(At, 1, 1); PG8_STAGE(PG8_SB(1, 0), b3, voffB); PG8_STAGE(PG8_SB(1, 1), b3 + hstep, voffB); PG8_STAGE(PG8_SA(1, 0), a3, voffA);
            PG8_WAIT_V(8); PG8_WAIT_L(0); PG8_BAR; PG8_MMA(1, 0, At, B0); PG8_MMA(1, 1, At, B1); PG8_BAR; PG8_SCHED;
            } else {
            PG8_LDB(B0, 0, 0); PG8_SCHED; PG8_LDA(At, 0, 0); PG8_STAGE(PG8_SA(1, 1), a1 + hstep, voffA);
            PG8_WAIT_L(8); PG8_BAR; PG8_WAIT_L(0); PG8_MMA(0, 0, At, B0); PG8_BAR; PG8_SCHED;
            PG8_LDB(B1, 0, 1); PG8_STAGE(PG8_SB(0, 0), b2, voffB);
            PG8_BAR; PG8_WAIT_L(0); PG8_MMA(0, 1, At, B1); PG8_BAR;
            PG8_LDA(At, 0, 1); PG8_STAGE(PG8_SA(0, 0), a2, voffA);
            PG8_BAR; PG8_WAIT_L(0); PG8_MMA(1, 0, At, B0); PG8_BAR; PG8_SCHED;
            PG8_STAGE(PG8_SB(0, 1), b2 + hstep, voffB);
            PG8_WAIT_V(6); PG8_BAR; PG8_MMA(1, 1, At, B1); PG8_BAR;
            PG8_LDB(B0, 1, 0); PG8_SCHED; PG8_LDA(At, 1, 0); PG8_STAGE(PG8_SA(0, 1), a2 + hstep, voffA);
            PG8_WAIT_L(8); PG8_BAR; PG8_WAIT_L(0); PG8_MMA(0, 0, At, B0); PG8_BAR; PG8_SCHED;
            PG8_LDB(B1, 1, 1); PG8_STAGE(PG8_SB(1, 0), b3, voffB);
            PG8_BAR; PG8_WAIT_L(0); PG8_MMA(0, 1, At, B1); PG8_BAR;
            PG8_LDA(At, 1, 1); PG8_STAGE(PG8_SA(1, 0), a3, voffA);
            PG8_BAR; PG8_WAIT_L(0); PG8_MMA(1, 0, At, B0); PG8_BAR; PG8_SCHED;
            PG8_STAGE(PG8_SB(1, 1), b3 + hstep, voffB);
            PG8_WAIT_V(6); PG8_BAR; PG8_MMA(1, 1, At, B1); PG8_BAR;
            }
        }
        if constexpr (ALIGN_EPI) { if (wr == 0) PG8_BAR; }
        if constexpr (EPIW > 0) { static_assert(EPIW == 0 || (ALIGN_EPI && SP2), "EPIW needs ALIGN_EPI and SP2");
            }
        if constexpr (!Epi::AFTER_DRAIN) { E(acc, cur, wr, wc, fr, fq); S.done(cur); }
        if (!has_next) break;
#pragma unroll
        for (int a = 0; a < 2; ++a)
#pragma unroll
            for (int b = 0; b < 2; ++b)
#pragma unroll
                for (int m = 0; m < 4; ++m)
#pragma unroll
                    for (int n = 0; n < 2; ++n) acc[a][b][m][n] = (f32x4){0.f, 0.f, 0.f, 0.f};
        cur = nxt; cA = nA; cB = nB; ++ui;
        if constexpr (ALIGN_EPI) { if (wr == 1) PG8_BAR; }
    }
    PG8_WAIT_V(0);
    if constexpr (!ALIGN_EPI) { if (wr == 0) PG8_BAR; }
    PG8_BAR;
    if constexpr (Epi::AFTER_DRAIN) { E.fused(acc, cur, wr, wc, fr, fq, lds, wid, lane); S.done(cur); }
#undef PG8_SA
#undef PG8_SB
#undef PG8_STAGE
#undef PG8_LDA
#undef PG8_LDB
#undef PG8_MMA
#undef PG8_WAIT_V
#undef PG8_WAIT_L
#undef PG8_BAR
#undef PG8_SCHED
}
}

namespace attn {
constexpr int   D = 128, NW = 8, QBLK = 32, KVBLK = 64;
constexpr float SCALE = 0.088388347648318440f;
constexpr float THR = 8.f;
constexpr int SDEPTH = 2;
constexpr int LDQ = 1024, LDK = 256, LDO = 1024;
constexpr size_t SHM_V = KVBLK * D * 2, SHM_K = KVBLK * D * 2, SHM_ATTN = 2 * SHM_V + 2 * SHM_K + NW * 64 * 4;
typedef unsigned short bf16;
using bf16x8 = __attribute__((ext_vector_type(8))) short;
using s16x4  = __attribute__((ext_vector_type(4))) short;
using f32x16 = __attribute__((ext_vector_type(16))) float;
using f32x8  = __attribute__((ext_vector_type(8))) float;
using u32x4  = __attribute__((ext_vector_type(4))) unsigned;
#define KSWZ(row, colB) ((row) * 256 + ((colB) ^ (((row) & 7) << 4)))
#define SBAR() __builtin_amdgcn_sched_barrier(0)
__device__ __forceinline__ int crow(int r, int hi) { return (r & 3) + 8 * (r >> 2) + 4 * hi; }
__device__ __forceinline__ unsigned cvtpk(float lo, float hi) { return cvt_pk_bf16(lo, hi); }
template <typename TIn> struct Stage;
template <> struct Stage<bf16>  { using T = bf16x8;
  __device__ static __forceinline__ T ld8(const bf16* p) { return *reinterpret_cast<const bf16x8*>(p); }
  __device__ static __forceinline__ bf16x8 tobf(T x) { return x; } };
__device__ __forceinline__ void partialSM(f32x16& p0, f32x16& p1, float& m_reg, float& mn, float& alpha) {
  constexpr float C = SCALE * 1.4426950408889634f;
  float pmax = p0[0]; for (int r = 1; r < 16; ++r) pmax = fmaxf(pmax, p0[r]); for (int r = 0; r < 16; ++r) pmax = fmaxf(pmax, p1[r]);
  { auto rr = __builtin_amdgcn_permlane32_swap(__float_as_uint(pmax), __float_as_uint(pmax), false, false);
    pmax = fmaxf(__uint_as_float(rr[0]), __uint_as_float(rr[1])); }
  if (__builtin_expect(__all(pmax - m_reg <= THR / SCALE), 1)) { mn = m_reg; alpha = 1.f; }
  else { mn = fmaxf(m_reg, pmax); alpha = __builtin_amdgcn_exp2f((m_reg - mn) * C); m_reg = mn; }
  float mnC = -mn * C;
  for (int r = 0; r < 16; ++r) p0[r] = fmaf(p0[r], C, mnC); for (int r = 0; r < 16; ++r) p1[r] = fmaf(p1[r], C, mnC);
  for (int r = 0; r < 16; ++r) p0[r] = __builtin_amdgcn_exp2f(p0[r]);
}
__device__ __forceinline__ void finishSM(f32x16& p0, f32x16& p1, float alpha, float& l_reg, bf16x8& pa0, bf16x8& pa1, bf16x8& pa2, bf16x8& pa3) {
  for (int r = 0; r < 16; ++r) p1[r] = __builtin_amdgcn_exp2f(p1[r]);
  float ps = 0; for (int r = 0; r < 16; ++r) ps += p0[r]; for (int r = 0; r < 16; ++r) ps += p1[r];
  { auto rr = __builtin_amdgcn_permlane32_swap(__float_as_uint(ps), __float_as_uint(ps), false, false);
    ps = __uint_as_float(rr[0]) + __uint_as_float(rr[1]); }
  l_reg = l_reg * alpha + ps;
#define PK4(P, BASE, OUT) do { unsigned a0 = cvtpk(P[BASE + 0], P[BASE + 1]), a1 = cvtpk(P[BASE + 2], P[BASE + 3]);   \
    unsigned b0 = cvtpk(P[BASE + 4], P[BASE + 5]), b1 = cvtpk(P[BASE + 6], P[BASE + 7]);                              \
    auto r0 = __builtin_amdgcn_permlane32_swap(a0, b0, false, false); auto r1 = __builtin_amdgcn_permlane32_swap(a1, b1, false, false); \
    u32x4 w = {r0[0], r1[0], r0[1], r1[1]}; OUT = *reinterpret_cast<bf16x8*>(&w); } while (0)
  PK4(p0, 0, pa0); PK4(p0, 8, pa1); PK4(p1, 0, pa2); PK4(p1, 8, pa3);
#undef PK4
}
__device__ __forceinline__ void qkt(f32x16& p0, f32x16& p1, const bf16* Ks, const bf16x8* qr, int r32, int hi) {
  p0 = f32x16{}; p1 = f32x16{};
  for (int d0 = 0; d0 < 8; ++d0) { int cb = (d0 * 16 + hi * 8) * 2;
    bf16x8 b0 = *reinterpret_cast<const bf16x8*>((const char*)Ks + KSWZ(r32, cb));
    bf16x8 b1 = *reinterpret_cast<const bf16x8*>((const char*)Ks + KSWZ(32 + r32, cb));
    p0 = __builtin_amdgcn_mfma_f32_32x32x16_bf16(b0, qr[d0], p0, 0, 0, 0);
    p1 = __builtin_amdgcn_mfma_f32_32x32x16_bf16(b1, qr[d0], p1, 0, 0, 0); }
}
__device__ __forceinline__ int v_st(int k, int c) { const int kk = (k & ~0xC) | ((k & 4) << 1) | ((k & 8) >> 1); return ((kk >> 3) * 4 + (c >> 5)) * 512 + ((kk & 7) * 32 + (c & 31)) * 2; }
__device__ __forceinline__ int v_rd_base(int lane) { return ((lane & 3) << 3) | (((lane >> 2) & 3) << 6) | (((lane >> 4) & 1) << 5) | (((lane >> 5) & 1) << 8); }
constexpr int v_rd_off(int d0, int ks, int half) { return d0 * 512 + ks * 4096 + half * 2048; }
template <int OFF> __device__ __forceinline__ s16x4 tr_read(int vb) {
  s16x4 r; asm volatile("ds_read_b64_tr_b16 %0, %1 offset:%2" : "=&v"(r) : "v"(vb), "i"(OFF) : "memory"); return r;
}
template <int D0> __device__ __forceinline__ void pv_one(f32x16& od, int vb, bf16x8 pa0, bf16x8 pa1, bf16x8 pa2, bf16x8 pa3) {
  const s16x4 l0 = tr_read<v_rd_off(D0, 0, 0)>(vb), h0 = tr_read<v_rd_off(D0, 0, 1)>(vb), l1 = tr_read<v_rd_off(D0, 1, 0)>(vb), h1 = tr_read<v_rd_off(D0, 1, 1)>(vb);
  const s16x4 l2 = tr_read<v_rd_off(D0, 2, 0)>(vb), h2 = tr_read<v_rd_off(D0, 2, 1)>(vb), l3 = tr_read<v_rd_off(D0, 3, 0)>(vb), h3 = tr_read<v_rd_off(D0, 3, 1)>(vb);
  asm volatile("s_waitcnt lgkmcnt(0)" ::: "memory"); SBAR();
#define PK(L, H) (bf16x8){L[0], L[1], L[2], L[3], H[0], H[1], H[2], H[3]}
  od = __builtin_amdgcn_mfma_f32_32x32x16_bf16(pa0, PK(l0, h0), od, 0, 0, 0);
  od = __builtin_amdgcn_mfma_f32_32x32x16_bf16(pa1, PK(l1, h1), od, 0, 0, 0);
  od = __builtin_amdgcn_mfma_f32_32x32x16_bf16(pa2, PK(l2, h2), od, 0, 0, 0);
  od = __builtin_amdgcn_mfma_f32_32x32x16_bf16(pa3, PK(l3, h3), od, 0, 0, 0);
#undef PK
}
__device__ __forceinline__ void pv_d0(f32x16* o, int vb, bf16x8 pa0, bf16x8 pa1, bf16x8 pa2, bf16x8 pa3) {
  pv_one<0>(o[0], vb, pa0, pa1, pa2, pa3); pv_one<1>(o[1], vb, pa0, pa1, pa2, pa3); pv_one<2>(o[2], vb, pa0, pa1, pa2, pa3); pv_one<3>(o[3], vb, pa0, pa1, pa2, pa3);
}

struct Pre { bf16x8 q[8]; };
__device__ __forceinline__ void attn_prefetch(const bf16* Qb, const bf16* __restrict__ Kh, const bf16* __restrict__ Vh, Pre& p) {
  const int tid = threadIdx.x, wid = tid >> 6, lane = tid & 63, r32 = lane & 31, hi = lane >> 5;
  const bf16* Qw = Qb + (long)(wid * QBLK + r32) * LDQ + hi * 8;
#pragma unroll
  for (int d0 = 0; d0 < 8; ++d0) p.q[d0] = *reinterpret_cast<const bf16x8*>(Qw + d0 * 16);
}
template <typename TQ>
__device__ __forceinline__ void attn_dense_body(const TQ* Qb, const bf16* __restrict__ Kh, const bf16* __restrict__ Vh,
                                                bf16* Ob, int seq, char* lds, const float* __restrict__ qnw, const float* __restrict__ rope, int lpos0,
                                                Pre& pre, const bf16* Qn, const bf16* Kn, const bf16* Vn) {
  using St = Stage<bf16>; using SQ = Stage<TQ>;
  const int tid = threadIdx.x, wid = tid >> 6, lane = tid & 63, r32 = lane & 31, hi = lane >> 5;
  bf16* V_lds = (bf16*)lds; bf16* K_lds = (bf16*)(lds + 2 * SHM_V);
  float* ws = (float*)(lds + 2 * SHM_V + 2 * SHM_K) + wid * 64; float* li_l = ws; float* al_l = ws + 32;
  float m_reg = -1e30f, l_reg = 0; f32x16 o[4] = {}; bf16x8 qr[8];
#pragma unroll
  for (int d0 = 0; d0 < 8; ++d0) qr[d0] = pre.q[d0];
  const int sr = tid >> 4, sc = (tid & 15) * 8, vst0 = v_st(sr, sc), vst1 = v_st(32 + sr, sc);
  const int vb0 = (int)(uintptr_t)V_lds + v_rd_base(lane);
  struct { typename St::T vs0, vs1, ks0, ks1; } sr_[SDEPTH];
#define SLOAD(i, k0) do { sr_[i].vs0 = St::ld8(&Vh[(long)((k0) + sr) * LDK + sc]); sr_[i].vs1 = St::ld8(&Vh[(long)((k0) + 32 + sr) * LDK + sc]); \
    sr_[i].ks0 = St::ld8(&Kh[(long)((k0) + sr) * LDK + sc]); sr_[i].ks1 = St::ld8(&Kh[(long)((k0) + 32 + sr) * LDK + sc]); } while (0)
#define SWRITE(b, i) do { *(bf16x8*)((char*)V_lds + (b) * SHM_V + vst0) = St::tobf(sr_[i].vs0);          \
    *(bf16x8*)((char*)V_lds + (b) * SHM_V + vst1) = St::tobf(sr_[i].vs1); int kc = sc * 2;               \
    *(bf16x8*)((char*)K_lds + (b) * SHM_K + KSWZ(sr, kc)) = St::tobf(sr_[i].ks0);                       \
    *(bf16x8*)((char*)K_lds + (b) * SHM_K + KSWZ(32 + sr, kc)) = St::tobf(sr_[i].ks1); } while (0)
#define SWAIT() do { if constexpr (SDEPTH == 2) asm volatile("s_waitcnt vmcnt(4)" ::: "memory"); else asm volatile("s_waitcnt vmcnt(0)" ::: "memory"); } while (0)
#define RESC(a) do { if (__any((a) < 1.f)) { if (hi == 0) al_l[r32] = (a); asm volatile("s_waitcnt lgkmcnt(0)" ::: "memory"); \
    for (int d = 0; d < 4; ++d) for (int r = 0; r < 16; ++r) o[d][r] *= al_l[crow(r, hi)]; } } while (0)
  f32x16 pA0, pA1, pB0, pB1; float mnA, mnB, alA, alB; bf16x8 pa0, pa1, pa2, pa3; const int NT = seq / KVBLK;
  constexpr int SE = 0, SO = SDEPTH - 1;
  SLOAD(SE, 0);
  if (qnw) {
    float ssq = 0.f;
#pragma unroll
    for (int d0 = 0; d0 < 8; ++d0)
#pragma unroll
      for (int j = 0; j < 8; ++j) { const float f = bf2f((unsigned short)qr[d0][j]); ssq += f * f; }
    { auto rr = __builtin_amdgcn_permlane32_swap(__float_as_uint(ssq), __float_as_uint(ssq), false, false); ssq = __uint_as_float(rr[0]) + __uint_as_float(rr[1]); }
    const float rstd = 1.0f / sqrtf(ssq * (1.0f / 128.0f) + 1e-6f);
    const int lq = lpos0 + wid * QBLK + r32, ri = lq >> 6, ci = lq & 63;
#pragma unroll
    for (int d0 = 0; d0 < 8; ++d0) {
      const float* wp = qnw + 16 * d0 + 8 * hi; const v4f w0 = *(const v4f*)wp, w1 = *(const v4f*)(wp + 4);
      const float* tp = d0 < 4 ? rope + (ri * 32 + 8 * d0 + 4 * hi) * 2 : rope + (ci * 32 + 8 * (d0 - 4) + 4 * hi) * 2; const v4f t0 = *(const v4f*)tp, t1 = *(const v4f*)(tp + 4);
      const float wv[8] = {w0.x, w0.y, w0.z, w0.w, w1.x, w1.y, w1.z, w1.w}, tv[8] = {t0.x, t0.y, t0.z, t0.w, t1.x, t1.y, t1.z, t1.w};
      float y[8];
#pragma unroll
      for (int q = 0; q < 4; ++q) { const float x0 = bf2f((unsigned short)qr[d0][2 * q]) * rstd * wv[2 * q], x1 = bf2f((unsigned short)qr[d0][2 * q + 1]) * rstd * wv[2 * q + 1], cs = tv[2 * q], sn = tv[2 * q + 1];
        y[2 * q] = x0 * cs - x1 * sn; y[2 * q + 1] = x0 * sn + x1 * cs; }
      u32x4 pw = {cvtpk(y[0], y[1]), cvtpk(y[2], y[3]), cvtpk(y[4], y[5]), cvtpk(y[6], y[7])}; qr[d0] = *reinterpret_cast<bf16x8*>(&pw);
    }
  }
  asm volatile("s_waitcnt vmcnt(0)" ::: "memory"); SWRITE(0, SE); __syncthreads();
  qkt(pA0, pA1, K_lds, qr, r32, hi); partialSM(pA0, pA1, m_reg, mnA, alA);
  SLOAD(SO, KVBLK); if constexpr (SDEPTH == 2) { if (2 < NT) SLOAD(SE, 2 * KVBLK); }
  SWAIT(); SWRITE(1, SO); __syncthreads();
  for (int j = 1; j + 1 < NT; j += 2) {
    SBAR(); qkt(pB0, pB1, (bf16*)((char*)K_lds + SHM_K), qr, r32, hi);
    finishSM(pA0, pA1, alA, l_reg, pa0, pa1, pa2, pa3); SBAR();
    SLOAD(SO, (j + SDEPTH) * KVBLK); SBAR();
    pv_d0(o, vb0, pa0, pa1, pa2, pa3); partialSM(pB0, pB1, m_reg, mnB, alB);
    __syncthreads(); SWAIT(); SWRITE(0, SE);
    RESC(alB); __syncthreads();
    SBAR(); qkt(pA0, pA1, K_lds, qr, r32, hi);
    finishSM(pB0, pB1, alB, l_reg, pa0, pa1, pa2, pa3); SBAR();
    if (SDEPTH == 1 || j + 3 < NT) SLOAD(SE, (j + 1 + SDEPTH) * KVBLK); SBAR();
    pv_d0(o, vb0 + (int)SHM_V, pa0, pa1, pa2, pa3); partialSM(pA0, pA1, m_reg, mnA, alA);
    __syncthreads(); SWAIT(); SWRITE(1, SO);
    RESC(alA); __syncthreads();
  }
  attn_prefetch(Qn, Kn, Vn, pre);
  SBAR(); qkt(pB0, pB1, (bf16*)((char*)K_lds + SHM_K), qr, r32, hi);
  finishSM(pA0, pA1, alA, l_reg, pa0, pa1, pa2, pa3); SBAR();
  pv_d0(o, vb0, pa0, pa1, pa2, pa3); partialSM(pB0, pB1, m_reg, mnB, alB);
  __syncthreads(); RESC(alB);
  finishSM(pB0, pB1, alB, l_reg, pa0, pa1, pa2, pa3); SBAR();
  pv_d0(o, vb0 + (int)SHM_V, pa0, pa1, pa2, pa3);
  if (hi == 0) li_l[r32] = l_reg; asm volatile("s_waitcnt lgkmcnt(0)" ::: "memory");
  float rli[16];
#pragma unroll
  for (int r = 0; r < 16; ++r) rli[r] = __builtin_amdgcn_rcpf(li_l[crow(r, hi)]);
  if (!Ob) return;
  bf16* Ow = Ob + (long)(wid * QBLK) * LDO;
#pragma unroll
  for (int r = 0; r < 16; ++r) { int orow = crow(r, hi);
    for (int d0 = 0; d0 < 4; ++d0) Ow[(long)orow * LDO + d0 * 32 + r32] = (bf16)f2bf(o[d0][r] * rli[r]); }
#undef SLOAD
#undef SWRITE
#undef SWAIT
#undef RESC
}

#undef KSWZ
#undef SBAR
}

namespace ret {
typedef short bf16x8 __attribute__((ext_vector_type(8)));
typedef short s16x4 __attribute__((ext_vector_type(4)));
typedef float f32x16 __attribute__((ext_vector_type(16)));
constexpr int QSTR = 528, KSTR = 576, VSTR = 576, PSTR = 144;
constexpr int QS = 0, KS = QS + 64 * QSTR, VS = KS + 64 * KSTR, PS = VS + 64 * VSTR, OST = PS + 64 * PSTR, OSTR = 144, SSL = OST + 8 * 32 * OSTR, LDS_RET = SSL + 64 * 8 * 4;
constexpr int NSTEP = 36, SPLIT = 20;
__device__ __forceinline__ int crow(int r, int hi) { return (r & 3) + 8 * (r >> 2) + 4 * hi; }
__device__ __forceinline__ s16x4 tr_read(const LAS unsigned char* p) { return __builtin_bit_cast(s16x4, __builtin_amdgcn_ds_read_tr16_b64_v4i16((LAS s16x4*)p)); }
__device__ __forceinline__ bf16x8 cat(s16x4 lo, s16x4 hi) { return (bf16x8){lo[0], lo[1], lo[2], lo[3], hi[0], hi[1], hi[2], hi[3]}; }

template <class GridBar>
__device__ __forceinline__ void scan_unit(const bf16_t* RQ, const bf16_t* RK, const bf16_t* RV, bf16_t* YR, float* SSQ, const float* l2d, LAS unsigned char* lds, int unit, const GridBar& gridbar, int nb_limit) {
    const int tid = threadIdx.x, lane = tid & 63, w = __builtin_amdgcn_readfirstlane(tid >> 6), r = lane & 31, hh = lane >> 5;
    const int x = unit & 7, y = unit >> 3, eh = y & 1, dir = (y >> 1) & 1, bh = (y >> 2) * 8 + x, b = bh >> 2, h = bh & 3;
    if (b >= nb_limit) { gridbar(); return; }
    const float lg2 = log1pf(-exp2f(l2d[dir * 4 + h])) * 1.4426950408889634f;
    const float gC = exp2f(lg2 * 64.0f);
#if MK_TIMING
    unsigned long long tl_ = __builtin_amdgcn_s_memrealtime(); unsigned ta0 = 0, ta1 = 0, ta2 = 0, ta3 = 0, ta4 = 0, ta5 = 0, ta6 = 0;
#define TMARK(v_) do { const unsigned long long n_ = __builtin_amdgcn_s_memrealtime(); v_ += (unsigned)(n_ - tl_); tl_ = n_; } while (0)
#else
#define TMARK(v_) do { } while (0)
#endif
    f32x16 S[8];
#pragma unroll
    for (int T = 0; T < 8; ++T) S[T] = (f32x16){0.f};
#define STEP_ROWS(s_, krow_, qrow_) do { const bool l_ = (s_) >= 4; const int lc_ = l_ ? (dir ? 35 - (s_) : (s_) - 4) : 0; \
        krow_ = b * LT + (l_ ? LC + 64 * lc_ : (dir ? 64 * (3 - (s_)) : 64 * (s_))); qrow_ = b * SEQ + 64 * lc_; } while (0)
    v4u kv[4], vv[4], qv[4];
    const int poff = (tid >> 5) * 1024 + (tid & 31) * 8, voff = (tid >> 5) * 2048 + (tid & 31) * 8;
#define PREFETCHK(s_) do { int kr_, qr_; STEP_ROWS(s_, kr_, qr_); const bf16_t* kb_ = RK + (size_t)kr_ * 1024 + h * 256; \
        _Pragma("unroll") for (int n = 0; n < 4; ++n) { const bf16_t* kbn_ = kb_ + n * 16 * 1024; kv[n] = *(const v4u*)(kbn_ + poff); } } while (0)
#define PREFETCHQ(s_) do { int kr_, qr_; STEP_ROWS(s_, kr_, qr_); const bf16_t* qb_ = RQ + (size_t)qr_ * 1024 + h * 256; \
        _Pragma("unroll") for (int n = 0; n < 4; ++n) { const bf16_t* qbn_ = qb_ + n * 16 * 1024; qv[n] = *(const v4u*)(qbn_ + poff); } } while (0)
#define LOADV(s_) do { int kr_, qr_; STEP_ROWS(s_, kr_, qr_); const bf16_t* vb_ = RV + (size_t)kr_ * 2048 + h * 512 + eh * 256; \
        _Pragma("unroll") for (int n = 0; n < 4; ++n) { const bf16_t* vbn_ = vb_ + n * 16 * 2048; vv[n] = *(const v4u*)(vbn_ + voff); } } while (0)
#define WRITEQ() do { _Pragma("unroll") for (int n = 0; n < 4; ++n) { const int c = tid + NTHR * n, row = c >> 5, ch = c & 31; *(LAS v4u*)(lds + QS + row * QSTR + ch * 16) = qv[n]; } } while (0)
    PREFETCHK(0); PREFETCHQ(0); LOADV(0);
    LAS unsigned char* ost = lds + OST + w * (32 * OSTR);
    for (int s = 0; s < NSTEP; ++s) {
        if (s == SPLIT) gridbar();
        int krow0, qrow0; STEP_ROWS(s, krow0, qrow0); const bool latent = s >= 4; const int sn = s + 1 < NSTEP ? s + 1 : s;
        float lg2s = lg2; int hv = hh, rv = r; asm volatile("" : "+v"(lg2s), "+v"(hv), "+v"(rv));
        const int lane_l = hv * 32 + rv;
        const int qA = QS + rv * QSTR + hv * 16, pA = PS + rv * PSTR + hv * 16;
        const int sw = ((lane_l & 1) << 1) | ((lane_l >> 1) & 1);
        const int trrow = (hv * 8 + ((lane_l >> 2) & 3));
        const int ktr = KS + trrow * KSTR + (16 * ((lane_l >> 4) & 1) + 4 * sw) * 2;
        const int vtr = VS + trrow * VSTR + (32 * w + 16 * ((lane_l >> 4) & 1) + 4 * (lane_l & 3)) * 2;
        { float wgt = __builtin_amdgcn_exp2f(lg2s * (float)(dir ? (tid >> 5) : 63 - (tid >> 5))); const float wstep = __builtin_amdgcn_exp2f(lg2s * (dir ? 16.0f : -16.0f));
#pragma unroll
          for (int n = 0; n < 4; ++n) { const int c = tid + NTHR * n, row = c >> 5, ch = c & 31;
            *(LAS v4u*)(lds + KS + row * KSTR + ch * 16) = kv[n];
            *(LAS v4u*)(lds + QS + row * QSTR + ch * 16) = qv[n];
            float t[8]; unpack8(vv[n], t);
#pragma unroll
            for (int k = 0; k < 8; ++k) t[k] *= wgt;
            wgt *= wstep;
            *(LAS v4u*)(lds + VS + row * VSTR + ch * 16) = pack8(t); } }
        __syncthreads();
        TMARK(ta0);
        v4u pp[4]; bf16_t* op = YR + (size_t)qrow0 * 2048 + h * 512 + eh * 256 + 32 * w + (size_t)((hv * 32 + rv) >> 2) * 2048 + ((hv * 32 + rv) & 3) * 8;
        if (s >= SPLIT) {
#pragma unroll
            for (int x4 = 0; x4 < 4; ++x4) pp[x4] = *(const v4u*)(op + (size_t)(16 * x4) * 2048); }
        if (latent) {
            { typedef float f32x4_t __attribute__((ext_vector_type(4)));
              const int i0 = 16 * (w >> 1), j0 = 32 * (w & 1), l15 = rv & 15, g4 = (hv << 1) | (rv >> 4);
              const LAS unsigned char* qp = lds + QS + (i0 + l15) * QSTR + g4 * 16; const LAS unsigned char* kp0 = lds + KS + (j0 + l15) * KSTR + g4 * 16; const LAS unsigned char* kp1 = kp0 + 16 * KSTR;
              f32x4_t s0 = (f32x4_t){0.f, 0.f, 0.f, 0.f}, s1 = s0;
              bf16x8 qn = *(const LAS bf16x8*)qp, k0n = *(const LAS bf16x8*)kp0, k1n = *(const LAS bf16x8*)kp1;
#pragma unroll
              for (int kk = 0; kk < 8; ++kk) { const bf16x8 qc = qn, k0c = k0n, k1c = k1n;
                if (kk + 1 < 8) { qn = *(const LAS bf16x8*)(qp + (kk + 1) * 64); k0n = *(const LAS bf16x8*)(kp0 + (kk + 1) * 64); k1n = *(const LAS bf16x8*)(kp1 + (kk + 1) * 64); }
                __builtin_amdgcn_sched_barrier(0);
                s0 = __builtin_amdgcn_mfma_f32_16x16x32_bf16(k0c, qc, s0, 0, 0, 0); s1 = __builtin_amdgcn_mfma_f32_16x16x32_bf16(k1c, qc, s1, 0, 0, 0); }
              const int i = i0 + l15;
#pragma unroll
              for (int t2 = 0; t2 < 2; ++t2) { const f32x4_t sv = t2 ? s1 : s0; const int jb = j0 + 16 * t2 + 4 * g4; float v4[4];
#pragma unroll
                for (int k = 0; k < 4; ++k) { const int j = jb + k; const bool keep = dir ? (j >= i) : (j <= i); v4[k] = keep ? sv[k] : 0.f; }
                v2u pw; pw.x = cvt_pk_bf16(v4[0], v4[1]); pw.y = cvt_pk_bf16(v4[2], v4[3]);
                *(LAS v2u*)(lds + PS + i * PSTR + jb * 2) = pw; } }
            TMARK(ta1);
            f32x16 acc[2]; acc[0] = (f32x16){0.f}; acc[1] = (f32x16){0.f};
            { const LAS unsigned char* q0 = lds + qA; const LAS unsigned char* q1 = lds + qA + 32 * QSTR;
              bf16x8 n0 = *(const LAS bf16x8*)q0, n1 = *(const LAS bf16x8*)q1, m0 = *(const LAS bf16x8*)(q0 + 32), m1 = *(const LAS bf16x8*)(q1 + 32);
#pragma unroll
              for (int ix = 0; ix < 16; ++ix) { const int T = ix >> 1, s2 = ix & 1; const bf16x8 a0 = n0, a1 = n1; n0 = m0; n1 = m1;
                if (ix + 2 < 16) { m0 = *(const LAS bf16x8*)(q0 + (ix + 2) * 32); m1 = *(const LAS bf16x8*)(q1 + (ix + 2) * 32); }
                v4u bw; bw.x = cvt_pk_bf16(S[T][8 * s2 + 0], S[T][8 * s2 + 1]); bw.y = cvt_pk_bf16(S[T][8 * s2 + 2], S[T][8 * s2 + 3]);
                bw.z = cvt_pk_bf16(S[T][8 * s2 + 4], S[T][8 * s2 + 5]); bw.w = cvt_pk_bf16(S[T][8 * s2 + 6], S[T][8 * s2 + 7]); const bf16x8 bs = __builtin_bit_cast(bf16x8, bw);
                __builtin_amdgcn_sched_barrier(0);
                acc[0] = __builtin_amdgcn_mfma_f32_32x32x16_bf16(a0, bs, acc[0], 0, 0, 0); acc[1] = __builtin_amdgcn_mfma_f32_32x32x16_bf16(a1, bs, acc[1], 0, 0, 0); } }
            TMARK(ta2);
            __syncthreads();
            LOADV(sn);
            TMARK(ta3);
            { bf16x8 vn = cat(tr_read(lds + vtr), tr_read(lds + vtr + 4 * VSTR)), pn0 = *(const LAS bf16x8*)(lds + pA), pn1 = *(const LAS bf16x8*)(lds + pA + 32 * PSTR);
#pragma unroll
              for (int js = 0; js < 4; ++js) { const bf16x8 vfj = vn, p0 = pn0, p1 = pn1;
                if (js + 1 < 4) { vn = cat(tr_read(lds + vtr + (16 * (js + 1)) * VSTR), tr_read(lds + vtr + (16 * (js + 1) + 4) * VSTR)); pn0 = *(const LAS bf16x8*)(lds + pA + (js + 1) * 32); pn1 = *(const LAS bf16x8*)(lds + pA + 32 * PSTR + (js + 1) * 32); }
                __builtin_amdgcn_sched_barrier(0);
                acc[0] = __builtin_amdgcn_mfma_f32_32x32x16_bf16(p0, vfj, acc[0], 0, 0, 0); acc[1] = __builtin_amdgcn_mfma_f32_32x32x16_bf16(p1, vfj, acc[1], 0, 0, 0); } }
#pragma unroll
            for (int it = 0; it < 2; ++it) {
#pragma unroll
                for (int q = 0; q < 16; ++q) { const int il = crow(q, hv); const int i = it * 32 + il; const float rf = __builtin_amdgcn_exp2f(lg2s * (float)(dir ? -i : i - 63));
                    *(LAS float*)(ost + il * OSTR + rv * 4) = acc[it][q] * rf; }
#pragma unroll
                for (int n = 0; n < 2; ++n) { const int c = (hv * 32 + rv) + 64 * n, row = c >> 2, cq = c & 3;
                    const v4f x0 = *(const LAS v4f*)(ost + row * OSTR + cq * 32), x1 = *(const LAS v4f*)(ost + row * OSTR + cq * 32 + 16);
                    float o[8] = {x0.x, x0.y, x0.z, x0.w, x1.x, x1.y, x1.z, x1.w};
                    if (s >= SPLIT) { float pv[8]; unpack8(pp[2 * it + n], pv); float ss = 0.f;
#pragma unroll
                        for (int k = 0; k < 8; ++k) { o[k] += pv[k]; ss += o[k] * o[k]; }
                        ss += __shfl_xor(ss, 1); ss += __shfl_xor(ss, 2);
                        if (cq == 0) *(LAS float*)(lds + SSL + ((it * 32 + row) * 8 + w) * 4) = ss; }
                    *(v4u*)(op + (size_t)(it * 32 + 16 * n) * 2048) = pack8(o); }
            }
        }
        TMARK(ta4);
        __builtin_amdgcn_sched_barrier(0);
        PREFETCHK(sn);
        PREFETCHQ(sn);
        if (!latent) LOADV(sn);
        {
#define KA_LD(ix_) cat(tr_read(lds + ktr + (16 * ((ix_) >> 3)) * KSTR + ((ix_) & 7) * 64), tr_read(lds + ktr + (16 * ((ix_) >> 3) + 4) * KSTR + ((ix_) & 7) * 64))
#define VF_LD(js_) cat(tr_read(lds + vtr + (16 * (js_)) * VSTR), tr_read(lds + vtr + (16 * (js_) + 4) * VSTR))
          bf16x8 vcur = VF_LD(0), vnx = vcur, kn0 = KA_LD(0), kn1 = KA_LD(1);
#pragma unroll
          for (int ix = 0; ix < 32; ++ix) { const int T = ix & 7, js = ix >> 3; const bf16x8 ka = kn0; kn0 = kn1;
            if (ix + 2 < 32) kn1 = KA_LD(ix + 2);
            if (T == 4 && js < 3) vnx = VF_LD(js + 1);
            __builtin_amdgcn_sched_barrier(0);
            S[T] = __builtin_amdgcn_mfma_f32_32x32x16_bf16(ka, vcur, S[T], 0, 0, 0);
            if (T == 7) vcur = vnx; }
#undef KA_LD
#undef VF_LD
        }
#pragma unroll
        for (int T = 0; T < 8; ++T) S[T] *= gC;
        TMARK(ta5);
        __syncthreads();
        TMARK(ta6);
        if (s >= SPLIT && tid < 64) { const LAS float* pr = (const LAS float*)(lds + SSL + tid * 32); const v4f a = *(const LAS v4f*)pr, c4 = *(const LAS v4f*)(pr + 4);
            SSQ[(size_t)(qrow0 + tid) * 8 + h * 2 + eh] = ((a.x + a.y) + (a.z + a.w)) + ((c4.x + c4.y) + (c4.z + c4.w)); }
    }
#if MK_TIMING
    if (unit == 0 && tid == 0) { unsigned* tw = (unsigned*)SSQ - 64; tw[0] = ta0; tw[1] = ta1; tw[2] = ta2; tw[3] = ta3; tw[4] = ta4; tw[5] = ta5; tw[6] = ta6; }
#endif
#undef STEP_ROWS
#undef PREFETCHK
#undef PREFETCHQ
#undef WRITEQ
#undef LOADV
}
}

constexpr int RING_BYTES = 131072, LDS_BYTES = 157696;
#ifndef MK_ONE_LAUNCH
#define MK_ONE_LAUNCH 1
#endif
constexpr int N_PHASES = 10;
#define LDS_WAIT() asm volatile("s_waitcnt lgkmcnt(0)" ::: "memory")
constexpr int MISC_OFF = 155648 + 320;
constexpr int CW_BAR = 4096;
constexpr size_t CTL_ZERO_BYTES = 65536;
#ifndef MK_NAIVE_ATTN
#define MK_NAIVE_ATTN 0
#endif
#ifndef MK_NAIVE_RET
#define MK_NAIVE_RET 0
#endif
#ifndef MK_DEBUG_ATTN
#define MK_DEBUG_ATTN 0
#endif
#ifndef MK_DBG_H
#define MK_DBG_H 0
#endif
#ifndef MK_DBG_L0
#define MK_DBG_L0 768
#define MK_DBG_L1 1280
#endif
#ifndef MK_DEBUG_RET
#define MK_DEBUG_RET 0
#endif
#ifndef MK_STAMP_A
#define MK_STAMP_A -1
#define MK_STAMP_B -1
#endif
#ifndef MK_REP_P4
#define MK_REP_P4 1
#endif
#ifndef MK_REP_P5
#define MK_REP_P5 1
#endif
#ifndef MK_REP_P6
#define MK_REP_P6 1
#endif
#ifndef MK_REP_P2
#define MK_REP_P2 1
#endif
#ifndef MK_REP_P9
#define MK_REP_P9 1
#endif
#ifndef MK_NSTAG
#define MK_NSTAG 1
#define MK_STAG_TICKS 500
#endif
#ifndef MK_EPIW
#define MK_EPIW 0
#endif
#ifndef MK_BARRIER
#define MK_BARRIER 1
#endif
#define XB_TMO      128
#define XB_XCNT(j)  (256  + 64 * (j))
#define XB_XSUB(j)  (1280 + 64 * (j))
#define XB_XGEN(j)  (2304 + 64 * (j))
#define XB_TOP      3328
#define XB_TOPGEN   3392
#define XCD_BAR_WORDS 3456
#define XB_SPIN_CAP (1u << 18)

__device__ __forceinline__ unsigned xb_ld(unsigned* p)              { return __hip_atomic_load(p, __ATOMIC_RELAXED, __HIP_MEMORY_SCOPE_AGENT); }
__device__ __forceinline__ unsigned xb_add(unsigned* p, unsigned v) { return __hip_atomic_fetch_add(p, v, __ATOMIC_RELAXED, __HIP_MEMORY_SCOPE_AGENT); }
__device__ __forceinline__ unsigned xb_xcc_id() { return (unsigned)__builtin_amdgcn_s_getreg((3 << 11) | 20) & 0xFu; }
#define XB_SPIN(cond, bar) do { unsigned _sp = 0; while (cond) { __builtin_amdgcn_s_sleep(1); \
    if ((++_sp & 255u) == 0u) { if (xb_ld(&(bar)[XB_TMO])) break; if (_sp > XB_SPIN_CAP) { atomicAdd(&(bar)[XB_TMO], 1u); break; } } } } while (0)

struct XcdBarrier {
    unsigned* bar; unsigned x;
    volatile LAS unsigned* st;
};

__device__ __forceinline__ XcdBarrier xcd_barrier_post(unsigned* bar, volatile LAS unsigned* st) {
    XcdBarrier b; b.bar = bar; b.x = xb_xcc_id(); b.st = st;
    if (threadIdx.x == 0) (void)xb_add(&bar[XB_XCNT(b.x)], 1u);
    return b;
}
__device__ __forceinline__ void xcd_barrier_complete(unsigned* bar, unsigned x, unsigned& nloc, unsigned& nx) {
    const unsigned G = gridDim.x * gridDim.y * gridDim.z;
    unsigned sum, cnt, mine, sp = 0u;
    for (;;) {
        sum = 0u; cnt = 0u; mine = 0u;
#pragma unroll
        for (unsigned j = 0; j < 16; ++j) { const unsigned c = xb_ld(&bar[XB_XCNT(j)]); sum += c; cnt += (c > 0u) ? 1u : 0u; mine = (j == x) ? c : mine; }
        if (sum == G) break;
        __builtin_amdgcn_s_sleep(1);
        if ((++sp & 255u) == 0u) { if (xb_ld(&bar[XB_TMO])) break; if (sp > XB_SPIN_CAP) { atomicAdd(&bar[XB_TMO], 1u); break; } }
    }
    nloc = mine > 0u ? mine : 1u; nx = cnt > 0u ? cnt : 1u;
}

__device__ __forceinline__ void xcd_barrier(const XcdBarrier& b) {
    asm volatile("s_waitcnt vmcnt(0)" ::: "memory");
    __syncthreads();
    if (threadIdx.x == 0) {
        unsigned* bar = b.bar;
        __builtin_amdgcn_s_waitcnt(0);
        unsigned nloc = b.st[0], nx = b.st[1];
        if (nloc == 0u) { xcd_barrier_complete(bar, b.x, nloc, nx); b.st[0] = nloc; b.st[1] = nx; }
        const unsigned old = xb_add(&bar[XB_XSUB(b.x)], 1u);
        const unsigned gen = old / nloc;
        if (old + 1u == (gen + 1u) * nloc) {
            __builtin_amdgcn_fence(__ATOMIC_RELEASE, "agent");
            asm volatile("s_waitcnt vmcnt(0)" ::: "memory");
            const unsigned og = xb_add(&bar[XB_TOP], 1u);
            const unsigned tg = og / nx;
            if (og + 1u == (tg + 1u) * nx) xb_add(&bar[XB_TOPGEN], 1u);
            else XB_SPIN(xb_ld(&bar[XB_TOPGEN]) == tg, bar);
            __builtin_amdgcn_fence(__ATOMIC_ACQUIRE, "agent");
            xb_add(&bar[XB_XGEN(b.x)], 1u);
            asm volatile("s_waitcnt vmcnt(0)" ::: "memory");
        } else {
            XB_SPIN(xb_ld(&bar[XB_XGEN(b.x)]) == gen, bar);
            __builtin_amdgcn_fence(__ATOMIC_ACQUIRE, "agent");
            asm volatile("s_waitcnt vmcnt(0)" ::: "memory");
        }
    }
    __syncthreads();
}


struct Args { const float* in[14]; float* out; unsigned char* ws; int ph_lo, ph_hi; };

__device__ __forceinline__ void p0_mod_item(const float* c, const float* c_ctx, const float* w_ada, const float* b_ada, float* MOD, float* ldsf, int item, int tid) {
    float* sc = ldsf; float* red = ldsf + 17 * 1024;
    for (int i = tid; i < 17 * 1024; i += NTHR) { const float v = i < 16 * 1024 ? c[i] : c_ctx[i - 16 * 1024]; sc[i] = v / (1.0f + expf(-v)); }
    const int col = tid & 15, ks = tid >> 4, n = item * 16 + col;
    float wv[32];
#pragma unroll
    for (int k = 0; k < 32; ++k) wv[k] = w_ada[(size_t)(ks * 32 + k) * 3072 + n];
    __syncthreads();
    float acc[17];
#pragma unroll
    for (int r = 0; r < 17; ++r) acc[r] = 0.f;
#pragma unroll
    for (int k = 0; k < 32; ++k) {
#pragma unroll
        for (int r = 0; r < 17; ++r) acc[r] += sc[r * 1024 + ks * 32 + k] * wv[k]; }
#pragma unroll
    for (int r = 0; r < 17; ++r) red[(ks * 17 + r) * 16 + col] = acc[r];
    __syncthreads();
    if (tid < 17 * 16) { const int r = tid >> 4, cc = tid & 15; float s = b_ada[item * 16 + cc];
        for (int k2 = 0; k2 < 32; ++k2) s += red[(k2 * 17 + r) * 16 + cc];
        MOD[r * 3072 + item * 16 + cc] = s; }
    __syncthreads();
}
__device__ __forceinline__ void p0_transpose_item(const float* W, int K, int N, bf16_t* WT, int row_off, float* scr, int item, int lane) {
    const int nblk = N / 32, kb = item / nblk, nb = item % nblk, k0 = 64 * kb, n0 = 32 * nb;
    float tv[32];
#pragma unroll
    for (int i = 0; i < 32; ++i) { const int kk = 2 * i + (lane >> 5); tv[i] = W[(size_t)(k0 + kk) * N + n0 + (lane & 31)]; }
#pragma unroll
    for (int i = 0; i < 32; ++i) { const int kk = 2 * i + (lane >> 5); scr[kk * 33 + (lane & 31)] = tv[i]; }
    LDS_WAIT(); asm volatile("" ::: "memory");
    const int c = lane & 7;
#pragma unroll
    for (int j = 0; j < 4; ++j) { const int n = (lane >> 3) + 8 * j; const float* s = scr + (8 * c) * 33 + n;
        v4u o; o.x = pk2(s[0 * 33], s[1 * 33]); o.y = pk2(s[2 * 33], s[3 * 33]); o.z = pk2(s[4 * 33], s[5 * 33]); o.w = pk2(s[6 * 33], s[7 * 33]);
        *(v4u*)(WT + (size_t)(row_off + n0 + n) * K + k0 + 8 * c) = o; }
    LDS_WAIT(); asm volatile("" ::: "memory");
}
__device__ __forceinline__ void p0_transpose64_item(const float* W, int K, int N, bf16_t* WT, int row_off, float* scr, int item, int lane) {
    const int nblk = N / 64, kb = item / nblk, nb = item % nblk, k0 = 64 * kb, n0 = 64 * nb;
    v4f tv[16]; const int lr = lane >> 4, lc = (lane & 15) * 4;
#pragma unroll
    for (int i = 0; i < 16; ++i) tv[i] = *(const v4f*)(W + (size_t)(k0 + 4 * i + lr) * N + n0 + lc);
#pragma unroll
    for (int i = 0; i < 16; ++i) { float* d = scr + (4 * i + lr) * 65 + lc; d[0] = tv[i].x; d[1] = tv[i].y; d[2] = tv[i].z; d[3] = tv[i].w; }
    LDS_WAIT(); asm volatile("" ::: "memory");
    const int c = lane & 7;
#pragma unroll
    for (int j = 0; j < 8; ++j) { const int n = (lane >> 3) + 8 * j; const float* s = scr + (8 * c) * 65 + n;
        v4u o; o.x = pk2(s[0 * 65], s[1 * 65]); o.y = pk2(s[2 * 65], s[3 * 65]); o.z = pk2(s[4 * 65], s[5 * 65]); o.w = pk2(s[6 * 65], s[7 * 65]);
        *(v4u*)(WT + (size_t)(row_off + n0 + n) * K + k0 + 8 * c) = o; }
    LDS_WAIT(); asm volatile("" ::: "memory");
}
__device__ __forceinline__ int new_col(int o) { return o < 4608 ? o : (o < 6656 ? o + 1024 : (o < 7680 ? o - 2048 : o)); }

__device__ __forceinline__ void sincos_d(double a, float& c, float& s) {
    const double TWO_PI = 6.283185307179586476925;
    const double k = (double)(long long)(a / TWO_PI + (a >= 0 ? 0.5 : -0.5)); const double r = a - k * TWO_PI, r2 = r * r;
    double ts = r, ss = r, tc = 1.0, cc = 1.0;
    for (int n = 1; n <= 15; ++n) { tc *= -r2 / (double)((2 * n - 1) * (2 * n)); cc += tc; ts *= -r2 / (double)((2 * n) * (2 * n + 1)); ss += ts; }
    c = (float)cc; s = (float)ss;
}

__device__ __forceinline__ void p1_row(const float* xrow, const float* nw, const float* shift, const float* scale, bf16_t* orow, int lane) {
    const v4f* xr = (const v4f*)xrow + lane; v4f v[4]; float s = 0.f;
#pragma unroll
    for (int j = 0; j < 4; ++j) { v[j] = xr[64 * j]; s += (v[j].x * v[j].x + v[j].y * v[j].y) + (v[j].z * v[j].z + v[j].w * v[j].w); }
    const float rstd = 1.0f / sqrtf(wave_sum(s) * (1.0f / 1024.0f) + EPS);
    v2u* o8 = (v2u*)orow + lane;
#pragma unroll
    for (int j = 0; j < 4; ++j) { const v4f w = ((const v4f*)nw)[lane + 64 * j], sh = ((const v4f*)shift)[lane + 64 * j], sc = ((const v4f*)scale)[lane + 64 * j];
        const v4f y = v[j] * rstd * w * (sc + 1.0f) + sh; v2u o; o.x = pk2(y.x, y.y); o.y = pk2(y.z, y.w); o8[64 * j] = o; }
}

template <int NR>
__device__ __forceinline__ void p1_rowsN(const float* x, const float* ctx, const float* MOD, const v4f (&nwv)[4], bf16_t* HX, int r0, int rlast, int lane) {
    v4f v[NR][4];
#pragma unroll
    for (int k = 0; k < NR; ++k) { const int m = r0 + k < rlast ? r0 + k : rlast; const float* xr = m < MLAT ? x + (size_t)m * 1024 : ctx + (size_t)(m - MLAT) * 1024;
#pragma unroll
        for (int j = 0; j < 4; ++j) v[k][j] = __builtin_nontemporal_load((const v4f*)xr + lane + 64 * j); }
#pragma unroll
    for (int k = 0; k < NR; ++k) { const int m = r0 + k < rlast ? r0 + k : rlast; const float* mp = MOD + (m < MLAT ? (m >> 11) : 16) * 3072; float s = 0.f;
        v4f sh[4], sc[4];
#pragma unroll
        for (int j = 0; j < 4; ++j) { sh[j] = ((const v4f*)mp)[lane + 64 * j]; sc[j] = ((const v4f*)(mp + 1024))[lane + 64 * j]; }
#pragma unroll
        for (int j = 0; j < 4; ++j) s += (v[k][j].x * v[k][j].x + v[k][j].y * v[k][j].y) + (v[k][j].z * v[k][j].z + v[k][j].w * v[k][j].w);
        const float rstd = 1.0f / sqrtf(wave_sum(s) * (1.0f / 1024.0f) + EPS);
        v2u* o8 = (v2u*)(HX + (size_t)m * 1024) + lane;
#pragma unroll
        for (int j = 0; j < 4; ++j) { const v4f y = v[k][j] * rstd * nwv[j] * (sc[j] + 1.0f) + sh[j]; v2u o; o.x = pk2(y.x, y.y); o.y = pk2(y.z, y.w); o8[64 * j] = o; } }
}

__device__ __forceinline__ void p3_item(bf16_t* buf, int ldlog2, bool isK, const float* nw, const float* ROPE, size_t item, int lane) {
    const size_t e = item * 512 + (size_t)lane * 8; const size_t row = e >> ldlog2; const int col = (int)(e & ((1u << ldlog2) - 1)), d0 = col & 127;
    float t[8]; unpack8(*(const v4u*)(buf + e), t);
    float ss = 0.f;
#pragma unroll
    for (int k = 0; k < 8; ++k) ss += t[k] * t[k];
    ss += __shfl_xor(ss, 1); ss += __shfl_xor(ss, 2); ss += __shfl_xor(ss, 4); ss += __shfl_xor(ss, 8);
    const float rstd = 1.0f / sqrtf(ss * (1.0f / 128.0f) + EPS);
#pragma unroll
    for (int k = 0; k < 8; ++k) t[k] = t[k] * rstd * nw[d0 + k];
    int l; bool rope = true;
    if (isK) { const int p = (int)(row % LT); rope = p >= LC; l = p - LC; } else l = (int)(row & (SEQ - 1));
    if (rope) { const int ri = l >> 6, ci = l & 63, p0 = d0 >> 1; const float* tab = p0 < 32 ? ROPE + (ri * 32 + p0) * 2 : ROPE + (ci * 32 + (p0 - 32)) * 2;
#pragma unroll
        for (int q = 0; q < 4; ++q) { const float cs = tab[2 * q], sn = tab[2 * q + 1], x0 = t[2 * q], x1 = t[2 * q + 1]; t[2 * q] = x0 * cs - x1 * sn; t[2 * q + 1] = x0 * sn + x1 * cs; } }
    *(v4u*)(buf + e) = pack8(t);
}

template <int NI>
__device__ __forceinline__ void p3_items_k(bf16_t* AK, const float* nw, const float* ROPE, size_t it0, size_t itend, int lane) {
    v4u raw[NI];
#pragma unroll
    for (int i = 0; i < NI; ++i) if (it0 + i < itend) raw[i] = *(const v4u*)(AK + (it0 + i) * 512 + (size_t)lane * 8);
#pragma unroll
    for (int i = 0; i < NI; ++i) if (it0 + i < itend) {
        const size_t e = (it0 + i) * 512 + (size_t)lane * 8; const size_t row = e >> 8; const int d0 = (int)(e & 255) & 127;
        float t[8]; unpack8(raw[i], t); float ss = 0.f;
#pragma unroll
        for (int k = 0; k < 8; ++k) ss += t[k] * t[k];
        ss += __shfl_xor(ss, 1); ss += __shfl_xor(ss, 2); ss += __shfl_xor(ss, 4); ss += __shfl_xor(ss, 8);
        const float rstd = 1.0f / sqrtf(ss * (1.0f / 128.0f) + EPS);
#pragma unroll
        for (int k = 0; k < 8; ++k) t[k] = t[k] * rstd * nw[d0 + k];
        const int p = (int)(row % LT);
        if (p >= LC) { const int l = p - LC, ri = l >> 6, ci = l & 63, p0 = d0 >> 1; const float* tab = p0 < 32 ? ROPE + (ri * 32 + p0) * 2 : ROPE + (ci * 32 + (p0 - 32)) * 2;
#pragma unroll
            for (int q = 0; q < 4; ++q) { const float cs = tab[2 * q], sn = tab[2 * q + 1], x0 = t[2 * q], x1 = t[2 * q + 1]; t[2 * q] = x0 * cs - x1 * sn; t[2 * q + 1] = x0 * sn + x1 * cs; } }
        *(v4u*)(AK + e) = pack8(t); }
}

__device__ __forceinline__ void p4_naive_item(const bf16_t* RQ, const bf16_t* RK, const bf16_t* RV, bf16_t* YR, float* SSQ, const float* l2d, float* ldsf, int item, int tid) {
    const int rb = item & 255, h = (item >> 8) & 3, b = item >> 10, i0 = rb * 8;
    float* qs = ldsf; float* sc = ldsf + 2048; float* red = sc + 8 * LT;
    for (int t = tid; t < 2048; t += NTHR) { const int r = t >> 8, d = t & 255; qs[t] = bf2f(RQ[((size_t)(b * SEQ + i0 + r)) * 1024 + h * 256 + d]); }
    __syncthreads();
    const float lgf = log1pf(-exp2f(l2d[h])), lgb = log1pf(-exp2f(l2d[4 + h]));
    for (int p = tid; p < LT; p += NTHR) {
        const bf16_t* kr = RK + ((size_t)(b * LT + p)) * 1024 + h * 256;
        float dot[8];
#pragma unroll
        for (int r = 0; r < 8; ++r) dot[r] = 0.f;
        for (int d8 = 0; d8 < 32; ++d8) { float kk[8]; unpack8(*(const v4u*)(kr + d8 * 8), kk);
#pragma unroll
            for (int r = 0; r < 8; ++r)
#pragma unroll
                for (int k = 0; k < 8; ++k) dot[r] += qs[r * 256 + d8 * 8 + k] * kk[k]; }
#pragma unroll
        for (int r = 0; r < 8; ++r) { const int i = i0 + r; float W;
            if (p < LC) W = MK_DBG_NOCTX ? 0.f : expf(lgf * (float)(i + LC - p)) + expf(lgb * (float)(SEQ - i + p));
            else { const int j = p - LC; W = (j <= i ? expf(lgf * (float)(i - j)) : 0.f) + (j >= i ? expf(lgb * (float)(j - i)) : 0.f); }
            sc[r * LT + p] = dot[r] * W; }
    }
    __syncthreads();
    float acc[8];
#pragma unroll
    for (int r = 0; r < 8; ++r) acc[r] = 0.f;
    const bf16_t* vp = RV + (size_t)(b * LT) * 2048 + h * 512 + tid;
    for (int p = 0; p < LT; ++p) { const float v = bf2f(vp[(size_t)p * 2048]);
#pragma unroll
        for (int r = 0; r < 8; ++r) acc[r] += sc[r * LT + p] * v; }
    const int wid = tid >> 6, lane = tid & 63;
#pragma unroll
    for (int r = 0; r < 8; ++r) { YR[((size_t)(b * SEQ + i0 + r)) * 2048 + h * 512 + tid] = (bf16_t)f2bf(acc[r]); const float s = wave_sum(acc[r] * acc[r]); if (lane == 0) red[r * 8 + wid] = s; }
    __syncthreads();
    if (tid < 16) { const int r = tid >> 1, hf = tid & 1; const float s = (red[r * 8 + hf * 4] + red[r * 8 + hf * 4 + 1]) + (red[r * 8 + hf * 4 + 2] + red[r * 8 + hf * 4 + 3]);
        SSQ[((size_t)(b * SEQ + i0 + r)) * 8 + h * 2 + hf] = s; }
    __syncthreads();
}

__device__ __forceinline__ void p5_naive_item(bf16_t* AQ, const bf16_t* AK, const bf16_t* AV, float* ldsf, int item, int tid) {
    const int rb = item & 255, head = (item >> 8) & 7, b = item >> 11, g = head >> 2, i0 = rb * 8;
    float* qs = ldsf; float* sc = ldsf + 1024;
    for (int t = tid; t < 1024; t += NTHR) { const int r = t >> 7, d = t & 127; qs[t] = bf2f(AQ[((size_t)(b * SEQ + i0 + r)) * 1024 + head * 128 + d]); }
    __syncthreads();
    for (int p = tid; p < LT; p += NTHR) {
        const bf16_t* kr = AK + ((size_t)(b * LT + p)) * 256 + g * 128;
        float dot[8];
#pragma unroll
        for (int r = 0; r < 8; ++r) dot[r] = 0.f;
        for (int d8 = 0; d8 < 16; ++d8) { float kk[8]; unpack8(*(const v4u*)(kr + d8 * 8), kk);
#pragma unroll
            for (int r = 0; r < 8; ++r)
#pragma unroll
                for (int k = 0; k < 8; ++k) dot[r] += qs[r * 128 + d8 * 8 + k] * kk[k]; }
#pragma unroll
        for (int r = 0; r < 8; ++r) sc[r * LT + p] = dot[r] * 0.08838834764831845f;
    }
    __syncthreads();
    { const int wid = tid >> 6, lane = tid & 63; float* row = sc + wid * LT; float m = -1e30f;
      for (int p = lane; p < LT; p += 64) m = fmaxf(m, row[p]);
#pragma unroll
      for (int o = 1; o < 64; o <<= 1) m = fmaxf(m, __shfl_xor(m, o));
      float s = 0.f;
      for (int p = lane; p < LT; p += 64) { const float ex = expf(row[p] - m); row[p] = ex; s += ex; }
      s = wave_sum(s); const float inv = 1.0f / s;
      for (int p = lane; p < LT; p += 64) row[p] *= inv; }
    __syncthreads();
    const int e = tid & 127, r0 = (tid >> 7) * 2; float a0 = 0.f, a1 = 0.f;
    const bf16_t* vp = AV + (size_t)(b * LT) * 256 + g * 128 + e;
    for (int p = 0; p < LT; ++p) { const float v = bf2f(vp[(size_t)p * 256]); a0 += sc[r0 * LT + p] * v; a1 += sc[(r0 + 1) * LT + p] * v; }
    AQ[((size_t)(b * SEQ + i0 + r0)) * 1024 + head * 128 + e] = (bf16_t)f2bf(a0);
    AQ[((size_t)(b * SEQ + i0 + r0 + 1)) * 1024 + head * 128 + e] = (bf16_t)f2bf(a1);
    __syncthreads();
}

#if MK_BARRIER == 1
struct GridBarF { XcdBarrier b; __device__ __forceinline__ void operator()() const { xcd_barrier(b); } };
#else
struct GridBarF { __device__ __forceinline__ void operator()() const { cooperative_groups::this_grid().sync(); } };
#endif
__device__ __forceinline__ void ssq_item(const bf16_t* YR, float* SSQ, int it, int lane) {
    const int row = it >> 2, head = it & 3; float t[8]; unpack8(*(const v4u*)(YR + (size_t)row * 2048 + head * 512 + lane * 8), t);
    float ss = 0.f;
#pragma unroll
    for (int k = 0; k < 8; ++k) ss += t[k] * t[k];
    ss = wave_sum(ss);
    if (lane == 0) { SSQ[(size_t)row * 8 + head * 2] = ss; SSQ[(size_t)row * 8 + head * 2 + 1] = 0.f; }
}
__global__ void __launch_bounds__(NTHR, 2) mk_fwd(Args args) {
    extern __shared__ __attribute__((aligned(16))) unsigned char lds[];
    const int tid = threadIdx.x, lane = tid & 63, wave = __builtin_amdgcn_readfirstlane(tid >> 6);
    const int G = gridDim.x, bid = blockIdx.x;
    const int gw = bid * NWAVES + wave, NGW = G * NWAVES;
    float* ldsf = (float*)lds;
    unsigned char* ws = args.ws;
    const float *x = args.in[0], *cvec = args.in[1], *ctx = args.in[2], *c_ctx = args.in[3], *norm_w = args.in[4], *w_ada = args.in[5], *b_ada = args.in[6], *w_in = args.in[7],
                *l2d = args.in[8], *q_norm_w = args.in[9], *k_norm_w = args.in[10], *w_o_ret = args.in[11], *w_o_att = args.in[12], *w_out = args.in[13];
    float* MOD = (float*)(ws + WS_MOD); float* ROPE = (float*)(ws + WS_ROPE); float* SSQ = (float*)(ws + WS_SSQ);
    bf16_t *WIN = (bf16_t*)(ws + WS_WIN), *WOR = (bf16_t*)(ws + WS_WOR), *WOA = (bf16_t*)(ws + WS_WOA), *WOUT = (bf16_t*)(ws + WS_WOUT), *HX = (bf16_t*)(ws + WS_HX);
    bf16_t *RK = (bf16_t*)(ws + WS_RK), *RV = (bf16_t*)(ws + WS_RV), *RQ = (bf16_t*)(ws + WS_RQ), *AK = (bf16_t*)(ws + WS_AK), *AV = (bf16_t*)(ws + WS_AV), *AQ = (bf16_t*)(ws + WS_AQ);
    bf16_t *U1 = (bf16_t*)(ws + WS_U1), *U2 = (bf16_t*)(ws + WS_U2), *YR = (bf16_t*)args.out;
    const int lo = args.ph_lo, hi = args.ph_hi;
#define IN(k) (lo <= (k) && (k) < hi)
#define BOTH(k) (IN(k) && IN((k) + 1))
    if (tid < 32) ((LAS unsigned*)(lds + MISC_OFF))[tid] = 0u;
    __syncthreads();
#if MK_BARRIER == 1
    XcdBarrier bar; bar.bar = (unsigned*)(ws + WS_CTL) + CW_BAR; bar.x = 0; bar.st = nullptr;
    if (hi - lo > 1) bar = xcd_barrier_post((unsigned*)(ws + WS_CTL) + CW_BAR, (volatile LAS unsigned*)(lds + MISC_OFF) + 8);
#define GRID_BAR() xcd_barrier(bar)
#else
#define GRID_BAR() cooperative_groups::this_grid().sync()
#endif

#if MK_STAMP_A >= 0
#define STAMP(k) do { if (bid == 0 && tid == 0) { if ((k) == MK_STAMP_A) ((volatile LAS unsigned*)(lds + MISC_OFF))[17] = (unsigned)__builtin_amdgcn_s_memrealtime(); if ((k) == MK_STAMP_B) ((volatile LAS unsigned*)(lds + MISC_OFF))[18] = (unsigned)__builtin_amdgcn_s_memrealtime(); } } while (0)
#else
#define STAMP(k) do { } while (0)
#endif
#define STAGGER() do { if (MK_NSTAG > 1) { const unsigned grp = ((unsigned)bid >> 3) % MK_NSTAG; const unsigned long long t0_ = __builtin_amdgcn_s_memrealtime(); \
        while (__builtin_amdgcn_s_memrealtime() - t0_ < (unsigned long long)grp * MK_STAG_TICKS) __builtin_amdgcn_s_sleep(16); } } while (0)
    STAMP(0);
    if (IN(0)) {
        for (int it = bid; it < 192; it += G) p0_mod_item(cvec, c_ctx, w_ada, b_ada, MOD, ldsf, it, tid);
        if (bid == G - 1) for (int t = tid; t < 2048; t += NTHR) { const int v = t >> 5, i = t & 31; double fd = 1.0; for (int k = 0; k < i; ++k) fd *= 0.7498942093324559;
            const float ang = (float)v * (float)fd; float cs, sn; sincos_d((double)ang, cs, sn); ROPE[2 * t] = cs; ROPE[2 * t + 1] = sn; }
        if (BOTH(0)) GRID_BAR();
    }
    STAMP(1);
    if (IN(1)) {
        {
        float* scr = ldsf + wave * (64 * 65);
        constexpr int I_IN = 16 * (NIN / 64), I_OR = 32 * 16, I_OA = 16 * 16, I_OUT = 16 * 16;
        for (int it = gw; it < I_IN + I_OR + I_OA + I_OUT; it += NGW) {
            int r = it;
            if (r < I_IN) { const int n0 = 64 * (r % (NIN / 64)); p0_transpose64_item(w_in, 1024, NIN, WIN, new_col(n0) - n0, scr, r, lane); continue; } r -= I_IN;
            if (r < I_OR) { p0_transpose64_item(w_o_ret, 2048, 1024, WOR, 0, scr, r, lane); continue; } r -= I_OR;
            if (r < I_OA) { p0_transpose64_item(w_o_att, 1024, 1024, WOA, 0, scr, r, lane); continue; } r -= I_OA;
            p0_transpose64_item(w_out, 1024, 1024, WOUT, 0, scr, r, lane);
        }
        }
        {
            const int rpw = (MALL + NGW - 1) / NGW, m0 = gw * rpw, m1 = m0 + rpw < MALL ? m0 + rpw : MALL;
            v4f nwv[4];
#pragma unroll
            for (int j = 0; j < 4; ++j) nwv[j] = ((const v4f*)norm_w)[lane + 64 * j];
            for (int m = m0; m < m1; m += 9) p1_rowsN<9>(x, ctx, MOD, nwv, HX, m, m1 - 1, lane);
        }
        if (BOTH(1)) GRID_BAR();
    }
    STAMP(2);
    if (IN(2)) {
        STAGGER();
        pg8::Gemm g{HX, WIN, MALL, N1, 1024}; pg8::Sched1 S; S.init(G, bid);
        pg8::Epi1 E{RK, RV, AK, AV, RQ, AQ, nullptr};
#if MK_P2PROBE == 4
        { pg8::Epi1T<2> EC{RK, RV, AK, AV, RQ, AQ, nullptr}; pg8::gemm_phase<pg8::Epi1T<2>, pg8::Sched1, true, true, MK_EPIW>((PG8_LAS unsigned char*)lds, g, S, EC); }
        __syncthreads();
#endif
        for (int rep = 0; rep < MK_REP_P2; ++rep) pg8::gemm_phase<pg8::Epi1, pg8::Sched1, true, true, MK_EPIW>((PG8_LAS unsigned char*)lds, g, S, E);
#if MK_P2PROBE == 1
        { pg8::Epi1T<1> ED{RK, RV, AK, AV, RQ, AQ, (bf16_t*)(ws + WS_END)}; pg8::gemm_phase<pg8::Epi1T<1>, pg8::Sched1, true, true, MK_EPIW>((PG8_LAS unsigned char*)lds, g, S, ED); }
#endif
#if MK_P2PROBE == 3
        { pg8::Epi1T<0> ER{RK, RV, AK, AV, RQ, AQ, nullptr}; pg8::gemm_phase<pg8::Epi1T<0>, pg8::Sched1, true, true, MK_EPIW>((PG8_LAS unsigned char*)lds, g, S, ER); }
#endif
#if MK_P2PROBE == 2
        { pg8::EpiNull EN; pg8::gemm_phase<pg8::EpiNull, pg8::Sched1, true, true, 0>((PG8_LAS unsigned char*)lds, g, S, EN); }
#endif
        if (BOTH(2)) GRID_BAR();
    }
    STAMP(3);
#if MK_NAIVE_ATTN
    if (IN(3)) {
        constexpr size_t IQ = (size_t)MLAT * 1024 / 512, IK = (size_t)NB * LT * 256 / 512;
        for (size_t it = gw; it < IQ + IK; it += NGW) {
            if (it < IQ) p3_item(AQ, 10, false, q_norm_w, ROPE, it, lane); else p3_item(AK, 8, true, k_norm_w, ROPE, it - IQ, lane);
        }
        if (BOTH(3)) GRID_BAR();
    }
#endif
#if MK_DEBUG_ATTN
    {
        bf16_t* AQ2 = (bf16_t*)(ws + WS_RK); float* acc2 = (float*)(ws + WS_CTL) + 64;
        for (size_t i = (size_t)bid * NTHR + tid; i < (size_t)MLAT * 1024 / 8; i += (size_t)G * NTHR) ((v4u*)AQ2)[i] = ((const v4u*)AQ)[i];
        { int tl = threadIdx.x; asm volatile("" : "+v"(tl)); const int lane_l = tl & 63, gw_l = bid * NWAVES + (tl >> 6);
          constexpr size_t IK = (size_t)NB * LT * 256 / 512; for (size_t it = gw_l; it < IK; it += NGW) p3_item(AK, 8, true, k_norm_w, ROPE, it, lane_l); }
        GRID_BAR();
        { int tl = threadIdx.x; asm volatile("" : "+v"(tl)); const int lane_l = tl & 63, gw_l = bid * NWAVES + (tl >> 6);
          constexpr size_t IQ = (size_t)MLAT * 1024 / 512; for (size_t it = gw_l; it < IQ; it += NGW) p3_item(AQ2, 10, false, q_norm_w, ROPE, it, lane_l); }
        GRID_BAR();
        { const int vcu = (bid & 7) * (G >> 3) + (bid >> 3);
          for (int idx = vcu; idx < NB * AH * 8; idx += G) { const int qb = idx & 7, r = (idx >> 3) & 3, g = (idx >> 5) & 1, b = idx >> 6, head = g * 4 + r;
            bf16_t* Q = AQ + ((size_t)(b * SEQ + qb * 256)) * 1024 + head * 128; const bf16_t* K = AK + (size_t)(b * LT) * 256 + g * 128; const bf16_t* V = AV + (size_t)(b * LT) * 256 + g * 128;
            attn::attn_dense_body<attn::bf16>(Q, K, V, Q, LT, (char*)lds, q_norm_w, ROPE, qb * 256); } }
        __syncthreads();
        { const int vcu = (bid & 7) * (G >> 3) + (bid >> 3);
          for (int idx = vcu; idx < NB * AH * 8; idx += G) { const int qb = idx & 7, r = (idx >> 3) & 3, g = (idx >> 5) & 1, b = idx >> 6, head = g * 4 + r;
            bf16_t* Q = AQ2 + ((size_t)(b * SEQ + qb * 256)) * 1024 + head * 128; const bf16_t* K = AK + (size_t)(b * LT) * 256 + g * 128; const bf16_t* V = AV + (size_t)(b * LT) * 256 + g * 128;
            attn::attn_dense_body<attn::bf16>(Q, K, V, Q, LT, (char*)lds, nullptr, ROPE, qb * 256); } }
        GRID_BAR();
        float sd = 0.f, sb = 0.f;
        for (size_t i = (size_t)bid * NTHR + tid; i < (size_t)MLAT * 1024; i += (size_t)G * NTHR) { const float a = bf2f(AQ[i]), b2 = bf2f(AQ2[i]); sd += (a - b2) * (a - b2); sb += b2 * b2; }
        sd = wave_sum(sd); sb = wave_sum(sb);
        if (lane == 0) { atomicAdd(acc2, sd); atomicAdd(acc2 + 1, sb); }
        GRID_BAR();
        if (bid == 0 && tid == 0) { const float s0 = __hip_atomic_load(acc2, __ATOMIC_RELAXED, __HIP_MEMORY_SCOPE_AGENT), s1 = __hip_atomic_load(acc2 + 1, __ATOMIC_RELAXED, __HIP_MEMORY_SCOPE_AGENT);
            args.out[0] = 1e6f * sqrtf(s0 / s1); args.out[1] = 1e3f * sqrtf(s1 / ((float)MLAT * 1024.f)); }
        return;
    }
#endif
    STAMP(4);
#if MK_DEBUG_RET
    {
        bf16_t* YR2 = (bf16_t*)(ws + WS_AQ); float* acc2 = (float*)(ws + WS_CTL) + 64;
        for (int it = bid; it < 8 * RH * 256; it += G) p4_naive_item(RQ, RK, RV, YR, SSQ, l2d, ldsf, it, tid);
        __syncthreads();
        { GridBarF gb{bar}; ret::scan_unit(RQ, RK, RV, YR2, SSQ + 2 * MLAT * 8, l2d, (LAS unsigned char*)lds, bid, gb, 8); }
        GRID_BAR();
        float sd = 0.f, sb = 0.f;
        for (size_t i = (size_t)bid * NTHR + tid; i < (size_t)8 * SEQ * 2048; i += (size_t)G * NTHR) { const int l = (int)((i >> 11) & 2047); if (l < MK_DBG_L0 || l >= MK_DBG_L1 || (int)((i >> 9) & 3) != MK_DBG_H) continue; const float a = bf2f(YR2[i]), b2 = bf2f(YR[i]); sd += (a - b2) * (a - b2); sb += b2 * b2; }
        sd = wave_sum(sd); sb = wave_sum(sb);
        if (lane == 0) { atomicAdd(acc2, sd); atomicAdd(acc2 + 1, sb); }
        GRID_BAR();
        if (bid == 0 && tid == 0) { const float s0 = __hip_atomic_load(acc2, __ATOMIC_RELAXED, __HIP_MEMORY_SCOPE_AGENT), s1 = __hip_atomic_load(acc2 + 1, __ATOMIC_RELAXED, __HIP_MEMORY_SCOPE_AGENT);
            ((float*)(ws + WS_SSQ))[0] = 1e6f * sqrtf(s0 / s1); ((float*)(ws + WS_SSQ))[1] = 1e3f * sqrtf(s1 / (8.f * SEQ * 2048.f)); }
        GRID_BAR();
        if (bid == 0 && tid == 0) { args.out[0] = ((float*)(ws + WS_SSQ))[0]; args.out[1] = ((float*)(ws + WS_SSQ))[1]; }
        return;
    }
#endif
    if (IN(4)) {
#if !MK_NAIVE_ATTN
        { int tl = threadIdx.x; asm volatile("" : "+v"(tl)); const int lane_l = tl & 63, gw_l = bid * NWAVES + (tl >> 6);
          constexpr size_t IK = (size_t)NB * LT * 256 / 512; const size_t ipw = (IK + NGW - 1) / NGW, i0 = (size_t)gw_l * ipw, i1 = i0 + ipw < IK ? i0 + ipw : IK;
          for (size_t it = i0; it < i1; it += 3) p3_items_k<3>(AK, k_norm_w, ROPE, it, i1, lane_l); }
#endif
#if MK_NAIVE_RET
        for (int it = bid; it < NB * RH * 256; it += G) p4_naive_item(RQ, RK, RV, YR, SSQ, l2d, ldsf, it, tid);
#else
        if (G == 256) { GridBarF gb{bar}; for (int rep = 0; rep < MK_REP_P4; ++rep) { if (rep) GRID_BAR(); ret::scan_unit(RQ, RK, RV, YR, SSQ, l2d, (LAS unsigned char*)lds, bid, gb, NB); } }
        else { for (int it = bid; it < NB * RH * 256; it += G) p4_naive_item(RQ, RK, RV, YR, SSQ, l2d, ldsf, it, tid); if (BOTH(4)) GRID_BAR(); }
#endif
    }
    STAMP(5);
    if (IN(5)) {
#if MK_NAIVE_ATTN
        for (int it = bid; it < NB * AH * 256; it += G) p5_naive_item(AQ, AK, AV, ldsf, it, tid);
#else
        const int vcu = (G % 8 == 0) ? (bid & 7) * (G >> 3) + (bid >> 3) : bid;
#define ATT_UNIT(idx_, Q_, K_, V_, qb_) const int qb_ = (idx_) & 7; bf16_t* Q_; const bf16_t *K_, *V_; \
            { const int r_ = ((idx_) >> 3) & 3, g_ = ((idx_) >> 5) & 1, b_ = (idx_) >> 6, head_ = g_ * 4 + r_; Q_ = AQ + ((size_t)(b_ * SEQ + qb_ * 256)) * 1024 + head_ * 128; \
              K_ = AK + (size_t)(b_ * LT) * 256 + g_ * 128; V_ = AV + (size_t)(b_ * LT) * 256 + g_ * 128; }
        attn::Pre pre;
        if (vcu < NB * AH * 8) { ATT_UNIT(vcu, Q0, K0, V0, qb0); attn::attn_prefetch(Q0, K0, V0, pre); }
        for (int idx = vcu; idx < NB * AH * 8; idx += G) {
            ATT_UNIT(idx, Q, K, V, qb);
            const int nidx = idx + G; const bool hn = nidx < NB * AH * 8; ATT_UNIT(hn ? nidx : idx, Qn, Kn, Vn, qbn);
            attn::attn_dense_body<attn::bf16>(Q, K, V, Q, LT, (char*)lds, q_norm_w, ROPE, qb * 256, pre, Qn, Kn, Vn); __syncthreads();
        }
#undef ATT_UNIT
#endif
#if !MK_NAIVE_RET
        if (G != 256) { int tl = threadIdx.x; asm volatile("" : "+v"(tl)); const int lane_l = tl & 63, gw_l = bid * NWAVES + (tl >> 6);
          for (int it = gw_l; it < MLAT * 4; it += NGW) ssq_item(YR, SSQ, it, lane_l); }
#endif
        if (BOTH(5)) GRID_BAR();
    }
    STAMP(6);
    if (IN(6)) {
        STAGGER();
        pg8::Gemm g{HX, WIN + (size_t)N1 * 1024, MLAT, NG, 1024}; pg8::StaticOrder S; S.init(MLAT, NG, G, bid);
        pg8::Epi5 E{YR, AQ, U1, U2, SSQ, 0};
        pg8::gemm_phase<pg8::Epi5, pg8::StaticOrder, true, true, MK_EPIW>((PG8_LAS unsigned char*)lds, g, S, E);
        if (BOTH(6)) GRID_BAR();
    }
    STAMP(7);
    if (IN(7)) {
        pg8::Gemm g{YR, WOR, MLAT, 1024, 2048}; pg8::StaticOrder S; S.init(MLAT, 1024, G, bid);
        pg8::Epi6 E{U1};
        pg8::gemm_phase<pg8::Epi6, pg8::StaticOrder, true, true, MK_EPIW>((PG8_LAS unsigned char*)lds, g, S, E);
    }
    STAMP(8);
    if (IN(8)) {
        pg8::Gemm g{AQ, WOA, MLAT, 1024, 1024}; pg8::StaticOrder S; S.init(MLAT, 1024, G, bid);
        pg8::Epi7 E{U1, U2};
        pg8::gemm_phase<pg8::Epi7, pg8::StaticOrder, true, true, MK_EPIW>((PG8_LAS unsigned char*)lds, g, S, E);
        if (BOTH(8)) GRID_BAR();
    }
    STAMP(9);
    if (IN(9)) {
        pg8::Gemm g{U1, WOUT, MLAT, 1024, 1024}; pg8::StaticOrder S; S.init(MLAT, 1024, G, bid);
        pg8::Epi8 E{x, MOD, args.out};
        { pg8::RepOrder SR; SR.so = S; SR.reps = MK_REP_P9; pg8::gemm_phase<pg8::Epi8, pg8::RepOrder, true, true, MK_EPIW>((PG8_LAS unsigned char*)lds, g, SR, E); }
    }
    STAMP(10);
#if MK_TIMING
    if (bid == 0) { const unsigned spin = __builtin_amdgcn_readfirstlane(((const unsigned*)SSQ - 64)[MK_TSEL]); const unsigned long long t0_ = __builtin_amdgcn_s_memrealtime();
        while (__builtin_amdgcn_s_memrealtime() - t0_ < (unsigned long long)spin) __builtin_amdgcn_s_sleep(8); }
#endif
#if MK_STAMP_A >= 0
    __syncthreads();
    if (bid == 0) { __syncthreads(); const unsigned sp = ((volatile LAS unsigned*)(lds + MISC_OFF))[18] - ((volatile LAS unsigned*)(lds + MISC_OFF))[17]; const unsigned long long t0_ = __builtin_amdgcn_s_memrealtime();
        while (__builtin_amdgcn_s_memrealtime() - t0_ < (unsigned long long)sp) __builtin_amdgcn_s_sleep(8); }
#endif
#undef IN
#undef BOTH
}

extern "C" void kernel_launch(void* const* d_in, const int* in_sizes, int n_in, void* d_out, int out_size, void* d_ws, size_t ws_size, hipStream_t stream) {
    static int grid = 0;
    if (grid == 0) {
        if (n_in != 14 || in_sizes[0] != MLAT * DM || out_size != MLAT * DM || ws_size < WS_END) {
            fprintf(stderr, "kernel_launch: unexpected shapes: n_in %d in0 %d out %d ws %zu (need >= %zu)\n", n_in, n_in > 0 ? in_sizes[0] : -1, out_size, ws_size, (size_t)WS_END); grid = -1; return; }
        int dev = 0, cus = 0;
        if (hipGetDevice(&dev) != hipSuccess || hipDeviceGetAttribute(&cus, hipDeviceAttributeMultiprocessorCount, dev) != hipSuccess) { grid = -1; return; }
        if (hipFuncSetAttribute((const void*)mk_fwd, hipFuncAttributeMaxDynamicSharedMemorySize, LDS_BYTES) != hipSuccess) { fprintf(stderr, "kernel_launch: hipFuncSetAttribute failed\n"); grid = -1; return; }
        grid = cus;
    }
    if (grid < 0) return;
    Args a{};
    for (int i = 0; i < 14; ++i) a.in[i] = (const float*)d_in[i];
    a.out = (float*)d_out; a.ws = (unsigned char*)d_ws;
#if MK_ONE_LAUNCH
    a.ph_lo = 0; a.ph_hi = N_PHASES;
#if MK_BARRIER == 1
    if (hipMemsetAsync((char*)d_ws + WS_CTL, 0, CTL_ZERO_BYTES, stream) != hipSuccess) { fprintf(stderr, "kernel_launch: hipMemsetAsync failed\n"); return; }
    hipLaunchKernelGGL(mk_fwd, dim3(grid), dim3(NTHR), LDS_BYTES, stream, a);
#else
    void* kargs[] = {&a};
    const hipError_t ce = hipLaunchCooperativeKernel((const void*)mk_fwd, dim3(grid), dim3(NTHR), kargs, LDS_BYTES, stream);
    if (ce != hipSuccess) fprintf(stderr, "kernel_launch: cooperative launch failed: %s\n", hipGetErrorName(ce));
#endif
#else
    for (int ph = 0; ph < N_PHASES; ++ph) {
        a.ph_lo = ph; a.ph_hi = ph + 1;
        hipLaunchKernelGGL(mk_fwd, dim3(grid), dim3(NTHR), LDS_BYTES, stream, a);
    }
#endif
    const hipError_t le = hipPeekAtLastError();
    if (le != hipSuccess) fprintf(stderr, "kernel_launch: launch failed: %s\n", hipGetErrorName(le));
}
```

```cpp
#include <hip/hip_runtime.h>
#include <cstdio>
#include <cstdint>
#include <hip/hip_cooperative_groups.h>

constexpr int NB = 16, SEQ = 2048, DM = 1024, LC = 256, LT = LC + SEQ;
constexpr int MLAT = NB * SEQ, MCTX = NB * LC, MALL = MLAT + MCTX;
constexpr int RH = 4, RDK = 256, RDV = 512;
constexpr int AH = 8, AKV = 2, AHD = 128;
constexpr int NIN = 10752, NKV = 3584, N1 = 5632, NG = 5120;
constexpr float EPS = 1e-6f;
#ifndef MK_TIMING
#define MK_TIMING 0
#define MK_TSEL 0
#endif
#ifndef MK_WT
#define MK_WT 1
#endif
#ifndef MK_WT_AUX
#define MK_WT_AUX 18
#endif
#ifndef MK_FP8K
#define MK_FP8K 1
#endif
#ifndef MK_E6B
#define MK_E6B 4
#define MK_E7B 2
#define MK_E8B 2
#endif
#ifndef MK_E5B
#define MK_E5B 1
#endif
#ifndef MK_P2PROBE
#define MK_P2PROBE 0
#endif
#ifndef MK_RPROBE
#define MK_RPROBE 0
#endif
#ifndef MK_DBG_NOCTX
#define MK_DBG_NOCTX 0
#endif
constexpr int NWAVES = 8, NTHR = 512;
#define LAS __attribute__((address_space(3)))

typedef unsigned short bf16_t;
typedef unsigned v4u __attribute__((ext_vector_type(4)));
typedef unsigned v2u __attribute__((ext_vector_type(2)));
typedef float v4f __attribute__((ext_vector_type(4)));
typedef float v2f __attribute__((ext_vector_type(2)));

__device__ __forceinline__ float bf2f(unsigned h) { return __uint_as_float(h << 16); }
__device__ __forceinline__ unsigned f2bf(float f) { unsigned u = __float_as_uint(f); return (u + 0x7fffu + ((u >> 16) & 1u)) >> 16; }
__device__ __forceinline__ unsigned pk2(float lo, float hi) { return f2bf(lo) | (f2bf(hi) << 16); }
__device__ __forceinline__ float bflo(unsigned w) { return __uint_as_float(w << 16); }
__device__ __forceinline__ float bfhi(unsigned w) { return __uint_as_float(w & 0xffff0000u); }
__device__ __forceinline__ float fast_sigmoid(float x) { return __builtin_amdgcn_rcpf(1.0f + __builtin_amdgcn_exp2f(-1.4426950408889634f * x)); }
__device__ __forceinline__ float fast_silu(float x) { return x * fast_sigmoid(x); }
__device__ __forceinline__ void sigmoid4(const float (&x)[4], float (&s)[4]) {
    float a[4];
#pragma unroll
    for (int k = 0; k < 4; ++k) a[k] = 1.0f + __builtin_amdgcn_exp2f(-1.4426950408889634f * fmaxf(x[k], -20.0f));
    const float p01 = a[0] * a[1], p23 = a[2] * a[3], r = __builtin_amdgcn_rcpf(p01 * p23), r01 = r * p23, r23 = r * p01;
    s[0] = r01 * a[1]; s[1] = r01 * a[0]; s[2] = r23 * a[3]; s[3] = r23 * a[2];
}
__device__ __forceinline__ float wave_sum(float v) {
#pragma unroll
    for (int o = 1; o < 64; o <<= 1) v += __shfl_xor(v, o);
    return v;
}

typedef __bf16 bf16x2_t __attribute__((ext_vector_type(2)));
__device__ __forceinline__ unsigned cvt_pk_bf16(float lo, float hi) { v2f v = {lo, hi}; bf16x2_t b = __builtin_convertvector(v, bf16x2_t); return __builtin_bit_cast(unsigned, b); }
__device__ __forceinline__ void unpack8(const v4u w, float (&o)[8]) {
    o[0] = bflo(w.x); o[1] = bfhi(w.x); o[2] = bflo(w.y); o[3] = bfhi(w.y); o[4] = bflo(w.z); o[5] = bfhi(w.z); o[6] = bflo(w.w); o[7] = bfhi(w.w);
}
__device__ __forceinline__ v4u pack8(const float (&o)[8]) {
    v4u w; w.x = cvt_pk_bf16(o[0], o[1]); w.y = cvt_pk_bf16(o[2], o[3]); w.z = cvt_pk_bf16(o[4], o[5]); w.w = cvt_pk_bf16(o[6], o[7]); return w;
}

constexpr size_t MiB = 1u << 20;
constexpr size_t WS_CTL = 0;
constexpr size_t WS_MOD = 1 * MiB;
constexpr size_t WS_ROPE = WS_MOD + 256 * 1024;
constexpr size_t WS_SSQ = 2 * MiB;
constexpr size_t WS_WIN = 4 * MiB;
constexpr size_t WS_WOR = 25 * MiB;
constexpr size_t WS_WOA = 29 * MiB;
constexpr size_t WS_WOUT = 31 * MiB;
constexpr size_t WS_HX = 33 * MiB;
constexpr size_t WS_RK = 105 * MiB;
constexpr size_t WS_RV = 177 * MiB;
constexpr size_t WS_RQ = 321 * MiB;
constexpr size_t WS_AK = 385 * MiB;
constexpr size_t WS_AV = 403 * MiB;
constexpr size_t WS_AQ = 421 * MiB;
constexpr size_t WS_K8 = 485 * MiB;
constexpr size_t WS_END = 495 * MiB;
constexpr size_t WS_U1 = WS_RK;
constexpr size_t WS_U2 = WS_RV;

__host__ __device__ __forceinline__ int orig_col(int n) { return n < 4608 ? n : (n < 5632 ? n + 2048 : (n < 7680 ? n - 1024 : n)); }
namespace pg8 {
#define PG8_LAS __attribute__((address_space(3)))
typedef unsigned short bf16_t;
typedef short bf16x8 __attribute__((ext_vector_type(8)));
typedef float f32x4 __attribute__((ext_vector_type(4)));
typedef unsigned u32x4 __attribute__((ext_vector_type(4)));
constexpr int BM = 256, BK = 64, HALF = 128, HTB = HALF * BK * 2  , STAGE_BYTES = 8 * HTB, NXCD = 8, WGM = 8;

__host__ __device__ __forceinline__ int lds_byte(int r, int c) { const int st = (r >> 4) * 2 + (c >> 5), rr = r & 15, cc = c & 31, ob = rr * 64 + cc * 2; return st * 1024 + (ob ^ (((ob >> 9) & 1) << 5)); }
__host__ __device__ __forceinline__ void stage_rc(int b, int& R, int& C) { const int st = b / 1024, sb = b % 1024, swz = sb ^ (((sb >> 9) & 1) << 5); R = (st >> 1) * 16 + swz / 64; C = (st & 1) * 32 + (swz % 64) / 2; }
__host__ __device__ __forceinline__ int perm32(int rho) { const int n = rho >> 4, i = rho & 15; return 8 * (i >> 2) + 4 * n + (i & 3); }

struct Unit { int pm, pn; };
struct Gemm { const bf16_t* A; const bf16_t* Bt; int M, N, K; };

struct StaticOrder {
    int nM, nN, nwg, G, c;
    __host__ __device__ void init(int M, int N, int G_, int c_) { nM = M / BM; nN = N / BM; nwg = nM * nN; G = G_; c = c_; }
    __host__ __device__ bool next(int i, Unit& u) const {
        const long L = (long)i * G + c; if (L >= nwg) return false;
        int wgid = (int)L; { const int q = nwg / NXCD, r = nwg % NXCD, xcd = wgid % NXCD, off = wgid / NXCD; wgid = (xcd < r ? xcd * (q + 1) : r * (q + 1) + (xcd - r) * q) + off; }
        const int nig = WGM * nN, gid = wgid / nig, fm = gid * WGM, gsz = (nM - fm) < WGM ? (nM - fm) : WGM;
        u.pm = fm + ((wgid % nig) % gsz); u.pn = (wgid % nig) / gsz; return true;
    }
    __device__ __forceinline__ void a_ready(const Unit&) const {}
    __device__ __forceinline__ void done(const Unit&) const {}
};


#if MK_WT
#define WT_RSRC(name, baseptr) const __amdgpu_buffer_rsrc_t name = __builtin_amdgcn_make_buffer_rsrc((void*)(baseptr), 0, 0x7ffffff0, 0x00020000)
#define WT_ST16(name, byteoff, val) __builtin_amdgcn_raw_buffer_store_b128((val), name, (unsigned)(byteoff), 0, MK_WT_AUX)
#endif
struct Sched1 {
    int G, c; StaticOrder so;
    __device__ void init(int G_, int c_) { G = G_; c = c_; so.init(MLAT, N1, G_, c_); }
    __device__ bool next(int i, Unit& u) const {
        long L = (long)i * G + c; if (L < 2816) return so.next(i, u);
        L -= 2816; if (L >= 224) return false;
        u.pm = 128 + (int)(L & 15); u.pn = (int)(L >> 4); return true;
    }
    __device__ __forceinline__ void a_ready(const Unit&) const {}
    __device__ __forceinline__ void done(const Unit&) const {}
};

struct SchedGates {
    StaticOrder so; int mode;
    __device__ void init(int G_, int c_, int mode_) { mode = mode_; so.init(MLAT, (mode_ ? 4 : 16) * 256, G_, c_); }
    __device__ bool next(int i, Unit& u) const { if (!so.next(i, u)) return false; u.pn = mode ? u.pn + 8 : (u.pn < 8 ? u.pn : u.pn + 4); return true; }
    __device__ __forceinline__ void a_ready(const Unit&) const {}
    __device__ __forceinline__ void done(const Unit&) const {}
};
struct RepOrder {
    StaticOrder so; int reps;
    __device__ bool next(int i, Unit& u) const { const int per = (so.nwg - so.c + so.G - 1) / so.G; if (i >= per * reps) return false; return so.next(i % per, u); }
    __device__ __forceinline__ void a_ready(const Unit&) const {}
    __device__ __forceinline__ void done(const Unit&) const {}
};

#define EPI_ROWS_BEGIN const int rt0 = wr * 64 + fr, ct0 = wc * 32 + 8 * fq; \
    _Pragma("unroll") for (int ai = 0; ai < 2; ++ai) _Pragma("unroll") for (int m = 0; m < 4; ++m) { const int rt = rt0 + ai * HALF + m * 16;
#define EPI_ROWS_END }

template <int DUM> struct Epi1T {
    static constexpr bool PERM = true, AFTER_DRAIN = false;
    bf16_t *RK, *RV, *AK, *AV, *RQ, *AQ; bf16_t* DUMMY;
    __device__ __forceinline__ void operator()(const f32x4 (&acc)[2][2][4][2], const Unit& u, int wr, int wc, int fr, int fq) const {
        const int pm = u.pm, pn = u.pn;
        const int kvrow0 = pm < 128 ? ((pm >> 3) * LT + LC + (pm & 7) * 256) : ((pm - 128) * LT);
        bf16_t* base; int ld; float sc = 1.f;
        if (pn < 4) { base = RK + (size_t)kvrow0 * 1024 + pn * 256; ld = 1024; sc = 0.0625f; }
        else if (pn < 12) { base = RV + (size_t)kvrow0 * 2048 + (pn - 4) * 256; ld = 2048; }
        else if (pn == 12) { base = AK + (size_t)kvrow0 * 256; ld = 256; }
        else if (pn == 13) { base = AV + (size_t)kvrow0 * 256; ld = 256; }
        else if (pn < 18) { base = RQ + (size_t)pm * 256 * 1024 + (pn - 14) * 256; ld = 1024; }
        else { base = AQ + (size_t)pm * 256 * 1024 + (pn - 18) * 256; ld = 1024; }
#if MK_P2PROBE
        if constexpr (DUM == 1) { base = DUMMY + (size_t)blockIdx.x * 32768; ld = 256; }
        if constexpr (DUM == 2) {
            const int rb = kvrow0 >> 8;
            if (pn < 4) base = RK + ((size_t)rb * 4 + pn) * 65536; else if (pn < 12) base = RV + ((size_t)rb * 8 + (pn - 4)) * 65536;
            else if (pn < 14) { } else if (pn < 18) base = RQ + ((size_t)pm * 4 + (pn - 14)) * 65536; else base = AQ + ((size_t)pm * 4 + (pn - 18)) * 65536;
            ld = 256; }
#endif
#if (MK_WT & 1)
        const __amdgpu_buffer_rsrc_t rs = __builtin_amdgcn_make_buffer_rsrc((void*)base, 0, 0x7ffffff0, 0x00020000);
#endif
        EPI_ROWS_BEGIN
            bf16_t* rowp = base + (size_t)(DUM == 1 ? (rt & 127) : rt) * ld + ct0;
#pragma unroll
            for (int bj = 0; bj < 2; ++bj) { const f32x4 v0 = acc[ai][bj][m][0] * sc, v1 = acc[ai][bj][m][1] * sc;
                u32x4 w; w.x = cvt_pk_bf16(v0[0], v0[1]); w.y = cvt_pk_bf16(v0[2], v0[3]); w.z = cvt_pk_bf16(v1[0], v1[1]); w.w = cvt_pk_bf16(v1[2], v1[3]);
#if (MK_WT & 1)
                __builtin_amdgcn_raw_buffer_store_b128(w, rs, (unsigned)(((DUM == 1 ? (rt & 127) : rt) * ld + ct0 + bj * HALF) * 2), 0, MK_WT_AUX);
#else
                *(u32x4*)(rowp + bj * HALF) = w;
#endif
                }
        EPI_ROWS_END
    }
};

typedef Epi1T<0> Epi1;
#define EPI_FOR_PIECES _Pragma("unroll") for (int ai = 0; ai < 2; ++ai) _Pragma("unroll") for (int m = 0; m < 4; ++m) _Pragma("unroll") for (int bj = 0; bj < 2; ++bj)
struct Epi5 {
    static constexpr bool PERM = true, AFTER_DRAIN = false;
    bf16_t *YR, *YA, *U1, *U2; const float* SSQ; int dry_unused;
    __device__ __forceinline__ void operator()(const f32x4 (&acc)[2][2][4][2], const Unit& u, int wr, int wc, int fr, int fq) const {
        const int pn = u.pn; const size_t row0 = (size_t)u.pm * 256;
        if (pn < 8) {
            const int head = pn >> 1;
            EPI_ROWS_BEGIN
                const size_t row = row0 + rt;
                const float ss = SSQ[row * 8 + head * 2] + SSQ[row * 8 + head * 2 + 1];
                const float rstd = __builtin_amdgcn_rsqf(ss * (1.0f / 512.0f) + EPS);
#pragma unroll
                for (int bj = 0; bj < 2; ++bj) { u32x4* p = (u32x4*)(YR + row * 2048 + pn * 256 + bj * HALF + ct0); float o[8]; unpack8(*p, o);
                    const f32x4 v0 = acc[ai][bj][m][0], v1 = acc[ai][bj][m][1];
                    { const float x0[4] = {v0[0], v0[1], v0[2], v0[3]}, x1[4] = {v1[0], v1[1], v1[2], v1[3]}; float s0[4], s1[4]; sigmoid4(x0, s0); sigmoid4(x1, s1);
#pragma unroll
                    for (int k = 0; k < 4; ++k) { o[k] = o[k] * rstd * (x0[k] * s0[k]); o[4 + k] = o[4 + k] * rstd * (x1[k] * s1[k]); } }
                    *p = pack8(o); }
            EPI_ROWS_END
        } else if (pn < 12) {
            EPI_ROWS_BEGIN
                const size_t row = row0 + rt;
#pragma unroll
                for (int bj = 0; bj < 2; ++bj) { u32x4* p = (u32x4*)(YA + row * 1024 + (pn - 8) * 256 + bj * HALF + ct0); float o[8]; unpack8(*p, o);
                    const f32x4 v0 = acc[ai][bj][m][0], v1 = acc[ai][bj][m][1];
                    { const float x0[4] = {v0[0], v0[1], v0[2], v0[3]}, x1[4] = {v1[0], v1[1], v1[2], v1[3]}; float s0[4], s1[4]; sigmoid4(x0, s0); sigmoid4(x1, s1);
#pragma unroll
                    for (int k = 0; k < 4; ++k) { o[k] = o[k] * (x0[k] * s0[k]); o[4 + k] = o[4 + k] * (x1[k] * s1[k]); } }
                    *p = pack8(o); }
            EPI_ROWS_END
        } else {
            bf16_t* U = pn < 16 ? U1 + (pn - 12) * 256 : U2 + (pn - 16) * 256;
            EPI_ROWS_BEGIN
                const size_t row = row0 + rt;
#pragma unroll
                for (int bj = 0; bj < 2; ++bj) { float o[8]; const f32x4 v0 = acc[ai][bj][m][0], v1 = acc[ai][bj][m][1];
                    { const float x0[4] = {v0[0], v0[1], v0[2], v0[3]}, x1[4] = {v1[0], v1[1], v1[2], v1[3]}; float s0[4], s1[4]; sigmoid4(x0, s0); sigmoid4(x1, s1);
#pragma unroll
                    for (int k = 0; k < 4; ++k) { o[k] = s0[k]; o[4 + k] = s1[k]; } }
                    *(u32x4*)(U + row * 1024 + bj * HALF + ct0) = pack8(o); }
            EPI_ROWS_END
        }
    }
};

struct Epi6 {
    static constexpr bool PERM = true, AFTER_DRAIN = false;
    bf16_t* U1;
    __device__ __forceinline__ void operator()(const f32x4 (&acc)[2][2][4][2], const Unit& u, int wr, int wc, int fr, int fq) const {
        bf16_t* base = U1 + ((size_t)u.pm * 256 + wr * 64 + fr) * 1024 + u.pn * 256 + wc * 32 + 8 * fq;
#if (MK_WT & 2)
        WT_RSRC(rs, U1 + (size_t)u.pm * 256 * 1024 + u.pn * 256);
#endif
#pragma unroll
        for (int ai = 0; ai < 2; ++ai)
#pragma unroll
          for (int mb = 0; mb < 4; mb += MK_E6B) {
            u32x4 pc[MK_E6B][2];
#pragma unroll
            for (int mi = 0; mi < MK_E6B; ++mi)
#pragma unroll
                for (int bj = 0; bj < 2; ++bj) pc[mi][bj] = *(const u32x4*)(base + (size_t)(ai * HALF + (mb + mi) * 16) * 1024 + bj * HALF);
#pragma unroll
            for (int mi = 0; mi < MK_E6B; ++mi)
#pragma unroll
                for (int bj = 0; bj < 2; ++bj) { const int m = mb + mi; float o[8]; unpack8(pc[mi][bj], o); const f32x4 v0 = acc[ai][bj][m][0], v1 = acc[ai][bj][m][1];
#pragma unroll
                    for (int k = 0; k < 4; ++k) { o[k] *= v0[k]; o[4 + k] *= v1[k]; }
                    *(u32x4*)(base + (size_t)(ai * HALF + m * 16) * 1024 + bj * HALF) = pack8(o); }
          }
    }
};
struct Epi7 {
    static constexpr bool PERM = true, AFTER_DRAIN = false;
    bf16_t* U1; const bf16_t* U2;
    __device__ __forceinline__ void operator()(const f32x4 (&acc)[2][2][4][2], const Unit& u, int wr, int wc, int fr, int fq) const {
        const size_t off0 = ((size_t)u.pm * 256 + wr * 64 + fr) * 1024 + u.pn * 256 + wc * 32 + 8 * fq;
#if (MK_WT & 4)
        WT_RSRC(rs, U1 + (size_t)u.pm * 256 * 1024 + u.pn * 256);
#endif
#pragma unroll
        for (int q4 = 0; q4 < 8; q4 += MK_E7B) {
            const int ai = q4 >> 2, mb = q4 & 3; u32x4 pc[MK_E7B][2], pg[MK_E7B][2];
#pragma unroll
            for (int m2 = 0; m2 < MK_E7B; ++m2)
#pragma unroll
                for (int bj = 0; bj < 2; ++bj) { const size_t off = off0 + (size_t)(ai * HALF + (mb + m2) * 16) * 1024 + bj * HALF; pc[m2][bj] = *(const u32x4*)(U1 + off); pg[m2][bj] = *(const u32x4*)(U2 + off); }
#pragma unroll
            for (int m2 = 0; m2 < MK_E7B; ++m2)
#pragma unroll
                for (int bj = 0; bj < 2; ++bj) { const int m = mb + m2; const size_t off = off0 + (size_t)(ai * HALF + m * 16) * 1024 + bj * HALF; float o[8], g[8]; unpack8(pc[m2][bj], o); unpack8(pg[m2][bj], g);
                    const f32x4 v0 = acc[ai][bj][m][0], v1 = acc[ai][bj][m][1];
#pragma unroll
                    for (int k = 0; k < 4; ++k) { o[k] += g[k] * v0[k]; o[4 + k] += g[4 + k] * v1[k]; }
                    *(u32x4*)(U1 + off) = pack8(o); }
        }
    }
};
struct Epi8 {
    static constexpr bool PERM = true, AFTER_DRAIN = false;
    const float* X; const float* MOD; float* OUT;
    __device__ __forceinline__ void operator()(const f32x4 (&acc)[2][2][4][2], const Unit& u, int wr, int wc, int fr, int fq) const {
        const int col0 = u.pn * 256 + wc * 32 + 8 * fq; const size_t off0 = ((size_t)u.pm * 256 + wr * 64 + fr) * 1024 + col0; const float* gate = MOD + (size_t)(u.pm >> 3) * 3072 + 2048 + col0;
        f32x4 gv[2][2];
#if (MK_WT & 8)
        WT_RSRC(rs, OUT + (size_t)u.pm * 256 * 1024 + u.pn * 256);
#endif
#pragma unroll
        for (int bj = 0; bj < 2; ++bj)
#pragma unroll
            for (int n = 0; n < 2; ++n) gv[bj][n] = *(const f32x4*)(gate + bj * HALF + 4 * n);
#pragma unroll
        for (int q4 = 0; q4 < 8; q4 += MK_E8B) {
            const int ai = q4 >> 2, mb = q4 & 3; f32x4 xv[MK_E8B][2][2];
#pragma unroll
            for (int m2 = 0; m2 < MK_E8B; ++m2)
#pragma unroll
                for (int bj = 0; bj < 2; ++bj)
#pragma unroll
                    for (int n = 0; n < 2; ++n) xv[m2][bj][n] = *(const f32x4*)(X + off0 + (size_t)(ai * HALF + (mb + m2) * 16) * 1024 + bj * HALF + 4 * n);
#pragma unroll
            for (int m2 = 0; m2 < MK_E8B; ++m2)
#pragma unroll
                for (int bj = 0; bj < 2; ++bj)
#pragma unroll
                    for (int n = 0; n < 2; ++n) *(f32x4*)(OUT + off0 + (size_t)(ai * HALF + (mb + m2) * 16) * 1024 + bj * HALF + 4 * n) = xv[m2][bj][n] + gv[bj][n] * acc[ai][bj][mb + m2][n];
        }
    }
};
struct EpiNull {
    static constexpr bool PERM = true, AFTER_DRAIN = false;
    __device__ __forceinline__ void operator()(const f32x4 (&acc)[2][2][4][2], const Unit& u, int wr, int wc, int fr, int fq) const {
#pragma unroll
        for (int ai = 0; ai < 2; ++ai)
#pragma unroll
            for (int bj = 0; bj < 2; ++bj)
#pragma unroll
                for (int m = 0; m < 4; ++m)
#pragma unroll
                    for (int n = 0; n < 2; ++n) asm volatile("" :: "v"(acc[ai][bj][m][n]));
    }
};
template <int N> __device__ __forceinline__ void wait_vm_sel(int sel) { asm volatile("s_waitcnt vmcnt(%1)\n\ts_cmp_lg_u32 %0, 0\n\ts_cbranch_scc1 .Lwvs%=\n\ts_waitcnt vmcnt(8)\n.Lwvs%=:" :: "s"(sel), "n"(N) : "memory", "scc"); }
template <class Epi, class Sched, bool ALIGN_EPI = false, bool SP2 = false, int EPIW = 0>
__device__ __forceinline__ void gemm_phase(PG8_LAS unsigned char* lds, const Gemm g, const Sched& S, const Epi& E) {
    const int tid = threadIdx.x, wid = __builtin_amdgcn_readfirstlane(tid >> 6), lane = tid & 63, wr = wid >> 2, wc = wid & 3, fr = lane & 15, fq = lane >> 4;
    const int K = g.K, nt = K / BK;
    unsigned voffA[2], voffB[2];
#pragma unroll
    for (int i = 0; i < 2; ++i) { int R, C; stage_rc(tid * 16 + i * 8192, R, C); const int Rb = Epi::PERM ? ((R & ~31) + perm32(R & 31)) : R;
        voffA[i] = (unsigned)(R * K + C) * 2u; voffB[i] = (unsigned)(Rb * K + C) * 2u; }
    const size_t kstep = (size_t)(BK * 2);
    const size_t hstep = (size_t)HALF * K * 2;
    const size_t tstep = 2 * hstep;
    const unsigned ldsw = (unsigned)wid * 1024u;
    const int aoff = lds_byte(wr * 64 + fr, fq * 8), boff = lds_byte(wc * 32 + fr, fq * 8);
#define PG8_SA(b, h) (((b) * 2 + (h)) * HTB)
#define PG8_SB(b, h) ((4 + (b) * 2 + (h)) * HTB)
#define PG8_STAGE(bufoff, gbase, voff) do { _Pragma("unroll") for (int _i = 0; _i < 2; ++_i) \
        __builtin_amdgcn_global_load_lds((const unsigned*)((const char*)(gbase) + (voff)[_i]), (PG8_LAS unsigned*)(lds + (bufoff) + ldsw + _i * 8192), 16, 0, 0); } while (0)
#define PG8_LDA(dst, b, h) do { _Pragma("unroll") for (int m = 0; m < 4; ++m) _Pragma("unroll") for (int k = 0; k < 2; ++k) dst[m][k] = *(const PG8_LAS bf16x8*)(lds + PG8_SA(b, h) + aoff + m * 2048 + k * 1024); } while (0)
#define PG8_LDB(dst, b, h) do { _Pragma("unroll") for (int n = 0; n < 2; ++n) _Pragma("unroll") for (int k = 0; k < 2; ++k) dst[n][k] = *(const PG8_LAS bf16x8*)(lds + PG8_SB(b, h) + boff + n * 2048 + k * 1024); } while (0)
#define PG8_MMA(ai, bj, At, Bt) do { __builtin_amdgcn_s_setprio(1); _Pragma("unroll") for (int m = 0; m < 4; ++m) _Pragma("unroll") for (int n = 0; n < 2; ++n) _Pragma("unroll") for (int k = 0; k < 2; ++k) \
        acc[ai][bj][m][n] = __builtin_amdgcn_mfma_f32_16x16x32_bf16(Bt[n][k], At[m][k], acc[ai][bj][m][n], 0, 0, 0); __builtin_amdgcn_s_setprio(0); } while (0)
#define PG8_WAIT_V(n) asm volatile("s_waitcnt vmcnt(" #n ")" ::: "memory")
#define PG8_WAIT_L(n) asm volatile("s_waitcnt lgkmcnt(" #n ")" ::: "memory")
#define PG8_BAR __builtin_amdgcn_s_barrier()
#define PG8_SCHED __builtin_amdgcn_sched_barrier(0)
    Unit cur, nxt; int ui = 0;
    if (!S.next(0, cur)) return;
    f32x4 acc[2][2][4][2];
#pragma unroll
    for (int a = 0; a < 2; ++a)
#pragma unroll
        for (int b = 0; b < 2; ++b)
#pragma unroll
            for (int m = 0; m < 4; ++m)
#pragma unroll
                for (int n = 0; n < 2; ++n) acc[a][b][m][n] = (f32x4){0.f, 0.f, 0.f, 0.f};
    bf16x8 At[4][2], B0[2][2], B1[2][2];
    const char* cA = (const char*)g.A + (size_t)cur.pm * tstep; const char* cB = (const char*)g.Bt + (size_t)cur.pn * tstep;
    S.a_ready(cur);
    if constexpr (SP2) {
        PG8_STAGE(PG8_SB(0, 0), cB, voffB); PG8_STAGE(PG8_SB(0, 1), cB + hstep, voffB); PG8_STAGE(PG8_SA(0, 0), cA, voffA); PG8_STAGE(PG8_SA(0, 1), cA + hstep, voffA);
        if (wr == 1) PG8_BAR;
        PG8_WAIT_V(2); PG8_BAR;
        PG8_STAGE(PG8_SB(1, 0), cB + kstep, voffB); PG8_STAGE(PG8_SA(1, 0), cA + kstep, voffA); PG8_STAGE(PG8_SB(1, 1), cB + hstep + kstep, voffB);
        PG8_WAIT_V(6); PG8_BAR;
    } else {
        PG8_STAGE(PG8_SB(0, 0), cB, voffB); PG8_STAGE(PG8_SA(0, 0), cA, voffA); PG8_STAGE(PG8_SB(0, 1), cB + hstep, voffB); PG8_STAGE(PG8_SA(0, 1), cA + hstep, voffA);
        if (wr == 1) PG8_BAR;
        PG8_WAIT_V(4); PG8_BAR;
        PG8_STAGE(PG8_SB(1, 0), cB + kstep, voffB); PG8_STAGE(PG8_SA(1, 0), cA + kstep, voffA); PG8_STAGE(PG8_SB(1, 1), cB + hstep + kstep, voffB);
        PG8_WAIT_V(6); PG8_BAR;
    }
    for (;;) {
        const bool has_next = S.next(ui + 1, nxt);
        const char* nA = has_next ? (const char*)g.A + (size_t)nxt.pm * tstep : cA; const char* nB = has_next ? (const char*)g.Bt + (size_t)nxt.pn * tstep : cB;
        for (int t = 0; t < nt; t += 2) {
            const bool last = (t == nt - 2);
            const char* a1 = cA + (size_t)(t + 1) * kstep;
            const char* a2 = last ? nA : cA + (size_t)(t + 2) * kstep; const char* b2 = last ? nB : cB + (size_t)(t + 2) * kstep;
            const char* a3 = a2 + kstep; const char* b3 = b2 + kstep;
            if (last && has_next) S.a_ready(nxt);
            const int fe = __builtin_amdgcn_readfirstlane(((EPIW > 0) && (t == 0) && (ui > 0)) ? 1 : 0);
            if constexpr (SP2) {
            PG8_LDB(B0, 0, 0); PG8_LDB(B1, 0, 1); PG8_SCHED; PG8_LDA(At, 0, 0); PG8_STAGE(PG8_SA(1, 1), a1 + hstep, voffA);
            if constexpr (EPIW > 0) wait_vm_sel<8 + EPIW>(fe); else PG8_WAIT_V(8); PG8_WAIT_L(0); PG8_BAR; PG8_MMA(0, 0, At, B0); PG8_MMA(0, 1, At, B1); PG8_BAR; PG8_SCHED;
            PG8_LDA(At, 0, 1); PG8_STAGE(PG8_SB(0, 0), b2, voffB); PG8_STAGE(PG8_SB(0, 1), b2 + hstep, voffB); PG8_STAGE(PG8_SA(0, 0), a2, voffA);
            if constexpr (EPIW > 0) wait_vm_sel<8 + EPIW>(fe); else PG8_WAIT_V(8); PG8_WAIT_L(0); PG8_BAR; PG8_MMA(1, 0, At, B0); PG8_MMA(1, 1, At, B1); PG8_BAR; PG8_SCHED;
            PG8_LDB(B0, 1, 0); PG8_LDB(B1, 1, 1); PG8_SCHED; PG8_LDA(At, 1, 0); PG8_STAGE(PG8_SA(0, 1), a2 + hstep, voffA);
            PG8_WAIT_V(8); PG8_WAIT_L(0); PG8_BAR; PG8_MMA(0, 0, At, B0); PG8_MMA(0, 1, At, B1); PG8_BAR; PG8_SCHED;
            PG8_LDA(At, 1, 1); PG8_STAGE(PG8_SB(1, 0), b3, voffB); PG8_STAGE(PG8_SB(1, 1), b3 + hstep, voffB); PG8_STAGE(PG8_SA(1, 0), a3, voffA);
            PG8_WAIT_V(8); PG8_WAIT_L(0); PG8_BAR; PG8_MMA(1, 0, At, B0); PG8_MMA(1, 1, At, B1); PG8_BAR; PG8_SCHED;
            } else {
            PG8_LDB(B0, 0, 0); PG8_SCHED; PG8_LDA(At, 0, 0); PG8_STAGE(PG8_SA(1, 1), a1 + hstep, voffA);
            PG8_WAIT_L(8); PG8_BAR; PG8_WAIT_L(0); PG8_MMA(0, 0, At, B0); PG8_BAR; PG8_SCHED;
            PG8_LDB(B1, 0, 1); PG8_STAGE(PG8_SB(0, 0), b2, voffB);
            PG8_BAR; PG8_WAIT_L(0); PG8_MMA(0, 1, At, B1); PG8_BAR;
            PG8_LDA(At, 0, 1); PG8_STAGE(PG8_SA(0, 0), a2, voffA);
            PG8_BAR; PG8_WAIT_L(0); PG8_MMA(1, 0, At, B0); PG8_BAR; PG8_SCHED;
            PG8_STAGE(PG8_SB(0, 1), b2 + hstep, voffB);
            PG8_WAIT_V(6); PG8_BAR; PG8_MMA(1, 1, At, B1); PG8_BAR;
            PG8_LDB(B0, 1, 0); PG8_SCHED; PG8_LDA(At, 1, 0); PG8_STAGE(PG8_SA(0, 1), a2 + hstep, voffA);
            PG8_WAIT_L(8); PG8_BAR; PG8_WAIT_L(0); PG8_MMA(0, 0, At, B0); PG8_BAR; PG8_SCHED;
            PG8_LDB(B1, 1, 1); PG8_STAGE(PG8_SB(1, 0), b3, voffB);
            PG8_BAR; PG8_WAIT_L(0); PG8_MMA(0, 1, At, B1); PG8_BAR;
            PG8_LDA(At, 1, 1); PG8_STAGE(PG8_SA(1, 0), a3, voffA);
            PG8_BAR; PG8_WAIT_L(0); PG8_MMA(1, 0, At, B0); PG8_BAR; PG8_SCHED;
            PG8_STAGE(PG8_SB(1, 1), b3 + hstep, voffB);
            PG8_WAIT_V(6); PG8_BAR; PG8_MMA(1, 1, At, B1); PG8_BAR;
            }
        }
        if constexpr (ALIGN_EPI) { if (wr == 0) PG8_BAR; }
        if constexpr (EPIW > 0) { static_assert(EPIW == 0 || (ALIGN_EPI && SP2), "EPIW needs ALIGN_EPI and SP2");
            }
        if constexpr (!Epi::AFTER_DRAIN) { E(acc, cur, wr, wc, fr, fq); S.done(cur); }
        if (!has_next) break;
#pragma unroll
        for (int a = 0; a < 2; ++a)
#pragma unroll
            for (int b = 0; b < 2; ++b)
#pragma unroll
                for (int m = 0; m < 4; ++m)
#pragma unroll
                    for (int n = 0; n < 2; ++n) acc[a][b][m][n] = (f32x4){0.f, 0.f, 0.f, 0.f};
        cur = nxt; cA = nA; cB = nB; ++ui;
        if constexpr (ALIGN_EPI) { if (wr == 1) PG8_BAR; }
    }
    PG8_WAIT_V(0);
    if constexpr (!ALIGN_EPI) { if (wr == 0) PG8_BAR; }
    PG8_BAR;
    if constexpr (Epi::AFTER_DRAIN) { E.fused(acc, cur, wr, wc, fr, fq, lds, wid, lane); S.done(cur); }
#undef PG8_SA
#undef PG8_SB
#undef PG8_STAGE
#undef PG8_LDA
#undef PG8_LDB
#undef PG8_MMA
#undef PG8_WAIT_V
#undef PG8_WAIT_L
#undef PG8_BAR
#undef PG8_SCHED
}
}

namespace attn {
constexpr int   D = 128, NW = 8, QBLK = 32, KVBLK = 64;
constexpr float SCALE = 0.088388347648318440f;
constexpr float THR = 8.f;
constexpr int SDEPTH = 2;
constexpr int LDQ = 1024, LDK = 256, LDO = 1024;
constexpr size_t SHM_V = KVBLK * D * 2, SHM_K = KVBLK * D * 2, SHM_ATTN = 2 * SHM_V + 2 * SHM_K + NW * 64 * 4;
typedef unsigned short bf16;
using bf16x8 = __attribute__((ext_vector_type(8))) short;
using s16x4  = __attribute__((ext_vector_type(4))) short;
using f32x16 = __attribute__((ext_vector_type(16))) float;
using f32x8  = __attribute__((ext_vector_type(8))) float;
using u32x4  = __attribute__((ext_vector_type(4))) unsigned;
#define KSWZ(row, colB) ((row) * 256 + ((colB) ^ (((row) & 7) << 4)))
#define K8SWZ(row, c16) ((row) * 128 + ((((c16) ^ ((row) & 7))) << 4))
typedef int v8i __attribute__((ext_vector_type(8)));
#define SBAR() __builtin_amdgcn_sched_barrier(0)
__device__ __forceinline__ int crow(int r, int hi) { return (r & 3) + 8 * (r >> 2) + 4 * hi; }
__device__ __forceinline__ unsigned cvtpk(float lo, float hi) { return cvt_pk_bf16(lo, hi); }
template <typename TIn> struct Stage;
template <> struct Stage<bf16>  { using T = bf16x8;
  __device__ static __forceinline__ T ld8(const bf16* p) { return *reinterpret_cast<const bf16x8*>(p); }
  __device__ static __forceinline__ bf16x8 tobf(T x) { return x; } };
__device__ __forceinline__ void partialSM(f32x16& p0, f32x16& p1, float& m_reg, float& mn, float& alpha) {
  constexpr float C = SCALE * 1.4426950408889634f;
  float pmax = p0[0]; for (int r = 1; r < 16; ++r) pmax = fmaxf(pmax, p0[r]); for (int r = 0; r < 16; ++r) pmax = fmaxf(pmax, p1[r]);
  { auto rr = __builtin_amdgcn_permlane32_swap(__float_as_uint(pmax), __float_as_uint(pmax), false, false);
    pmax = fmaxf(__uint_as_float(rr[0]), __uint_as_float(rr[1])); }
  if (__builtin_expect(__all(pmax - m_reg <= THR / SCALE), 1)) { mn = m_reg; alpha = 1.f; }
  else { mn = fmaxf(m_reg, pmax); alpha = __builtin_amdgcn_exp2f((m_reg - mn) * C); m_reg = mn; }
  float mnC = -mn * C;
  for (int r = 0; r < 16; ++r) p0[r] = fmaf(p0[r], C, mnC); for (int r = 0; r < 16; ++r) p1[r] = fmaf(p1[r], C, mnC);
  for (int r = 0; r < 16; ++r) p0[r] = __builtin_amdgcn_exp2f(p0[r]);
}
__device__ __forceinline__ void finishSM(f32x16& p0, f32x16& p1, float alpha, float& l_reg, bf16x8& pa0, bf16x8& pa1, bf16x8& pa2, bf16x8& pa3) {
  for (int r = 0; r < 16; ++r) p1[r] = __builtin_amdgcn_exp2f(p1[r]);
  float ps = 0; for (int r = 0; r < 16; ++r) ps += p0[r]; for (int r = 0; r < 16; ++r) ps += p1[r];
  { auto rr = __builtin_amdgcn_permlane32_swap(__float_as_uint(ps), __float_as_uint(ps), false, false);
    ps = __uint_as_float(rr[0]) + __uint_as_float(rr[1]); }
  l_reg = l_reg * alpha + ps;
#define PK4(P, BASE, OUT) do { unsigned a0 = cvtpk(P[BASE + 0], P[BASE + 1]), a1 = cvtpk(P[BASE + 2], P[BASE + 3]);   \
    unsigned b0 = cvtpk(P[BASE + 4], P[BASE + 5]), b1 = cvtpk(P[BASE + 6], P[BASE + 7]);                              \
    auto r0 = __builtin_amdgcn_permlane32_swap(a0, b0, false, false); auto r1 = __builtin_amdgcn_permlane32_swap(a1, b1, false, false); \
    u32x4 w = {r0[0], r1[0], r0[1], r1[1]}; OUT = *reinterpret_cast<bf16x8*>(&w); } while (0)
  PK4(p0, 0, pa0); PK4(p0, 8, pa1); PK4(p1, 0, pa2); PK4(p1, 8, pa3);
#undef PK4
}
__device__ __forceinline__ void qkt(f32x16& p0, f32x16& p1, const bf16* Ks, const bf16x8* qr, int r32, int hi) {
  p0 = f32x16{}; p1 = f32x16{};
  for (int d0 = 0; d0 < 8; ++d0) { int cb = (d0 * 16 + hi * 8) * 2;
    bf16x8 b0 = *reinterpret_cast<const bf16x8*>((const char*)Ks + KSWZ(r32, cb));
    bf16x8 b1 = *reinterpret_cast<const bf16x8*>((const char*)Ks + KSWZ(32 + r32, cb));
    p0 = __builtin_amdgcn_mfma_f32_32x32x16_bf16(b0, qr[d0], p0, 0, 0, 0);
    p1 = __builtin_amdgcn_mfma_f32_32x32x16_bf16(b1, qr[d0], p1, 0, 0, 0); }
}
__device__ __forceinline__ void qkt8(f32x16& p0, f32x16& p1, const char* Ks, const v8i* q8, int r32, int hi) {
  p0 = f32x16{}; p1 = f32x16{};
#pragma unroll
  for (int m = 0; m < 2; ++m) { const int c = 4 * m + 2 * hi;
    const u32x4 a00 = *reinterpret_cast<const u32x4*>(Ks + K8SWZ(r32, c)), a01 = *reinterpret_cast<const u32x4*>(Ks + K8SWZ(r32, c + 1));
    const u32x4 a10 = *reinterpret_cast<const u32x4*>(Ks + K8SWZ(32 + r32, c)), a11 = *reinterpret_cast<const u32x4*>(Ks + K8SWZ(32 + r32, c + 1));
    const v8i A0 = {(int)a00.x, (int)a00.y, (int)a00.z, (int)a00.w, (int)a01.x, (int)a01.y, (int)a01.z, (int)a01.w};
    const v8i A1 = {(int)a10.x, (int)a10.y, (int)a10.z, (int)a10.w, (int)a11.x, (int)a11.y, (int)a11.z, (int)a11.w};
    p0 = __builtin_amdgcn_mfma_scale_f32_32x32x64_f8f6f4(A0, q8[m], p0, 0, 0, 0, 0x7F7F7F7F, 0, 0x7F7F7F7F);
    p1 = __builtin_amdgcn_mfma_scale_f32_32x32x64_f8f6f4(A1, q8[m], p1, 0, 0, 0, 0x7F7F7F7F, 0, 0x7F7F7F7F); }
}
__device__ __forceinline__ int v_st(int k, int c) { const int kk = (k & ~0xC) | ((k & 4) << 1) | ((k & 8) >> 1); return ((kk >> 3) * 4 + (c >> 5)) * 512 + ((kk & 7) * 32 + (c & 31)) * 2; }
__device__ __forceinline__ int v_rd_base(int lane) { return ((lane & 3) << 3) | (((lane >> 2) & 3) << 6) | (((lane >> 4) & 1) << 5) | (((lane >> 5) & 1) << 8); }
constexpr int v_rd_off(int d0, int ks, int half) { return d0 * 512 + ks * 4096 + half * 2048; }
template <int OFF> __device__ __forceinline__ s16x4 tr_read(int vb) {
  s16x4 r; asm volatile("ds_read_b64_tr_b16 %0, %1 offset:%2" : "=&v"(r) : "v"(vb), "i"(OFF) : "memory"); return r;
}
template <int D0> __device__ __forceinline__ void pv_one(f32x16& od, int vb, bf16x8 pa0, bf16x8 pa1, bf16x8 pa2, bf16x8 pa3) {
  const s16x4 l0 = tr_read<v_rd_off(D0, 0, 0)>(vb), h0 = tr_read<v_rd_off(D0, 0, 1)>(vb), l1 = tr_read<v_rd_off(D0, 1, 0)>(vb), h1 = tr_read<v_rd_off(D0, 1, 1)>(vb);
  const s16x4 l2 = tr_read<v_rd_off(D0, 2, 0)>(vb), h2 = tr_read<v_rd_off(D0, 2, 1)>(vb), l3 = tr_read<v_rd_off(D0, 3, 0)>(vb), h3 = tr_read<v_rd_off(D0, 3, 1)>(vb);
  asm volatile("s_waitcnt lgkmcnt(0)" ::: "memory"); SBAR();
#define PK(L, H) (bf16x8){L[0], L[1], L[2], L[3], H[0], H[1], H[2], H[3]}
  od = __builtin_amdgcn_mfma_f32_32x32x16_bf16(pa0, PK(l0, h0), od, 0, 0, 0);
  od = __builtin_amdgcn_mfma_f32_32x32x16_bf16(pa1, PK(l1, h1), od, 0, 0, 0);
  od = __builtin_amdgcn_mfma_f32_32x32x16_bf16(pa2, PK(l2, h2), od, 0, 0, 0);
  od = __builtin_amdgcn_mfma_f32_32x32x16_bf16(pa3, PK(l3, h3), od, 0, 0, 0);
#undef PK
}
__device__ __forceinline__ void pv_d0(f32x16* o, int vb, bf16x8 pa0, bf16x8 pa1, bf16x8 pa2, bf16x8 pa3) {
  pv_one<0>(o[0], vb, pa0, pa1, pa2, pa3); pv_one<1>(o[1], vb, pa0, pa1, pa2, pa3); pv_one<2>(o[2], vb, pa0, pa1, pa2, pa3); pv_one<3>(o[3], vb, pa0, pa1, pa2, pa3);
}

struct Pre { bf16x8 q[8]; };
__device__ __forceinline__ void attn_prefetch(const bf16* Qb, const bf16* __restrict__ Kh, const bf16* __restrict__ Vh, Pre& p) {
  const int tid = threadIdx.x, wid = tid >> 6, lane = tid & 63, r32 = lane & 31, hi = lane >> 5;
  const bf16* Qw = Qb + (long)(wid * QBLK + r32) * LDQ + hi * 8;
#pragma unroll
  for (int d0 = 0; d0 < 8; ++d0) p.q[d0] = *reinterpret_cast<const bf16x8*>(Qw + d0 * 16);
}
template <typename TQ>
__device__ __forceinline__ void attn_dense_body(const TQ* Qb, const bf16* __restrict__ Kh, const bf16* __restrict__ Vh,
                                                bf16* Ob, int seq, char* lds, const float* __restrict__ qnw, const float* __restrict__ rope, int lpos0,
                                                Pre& pre, const bf16* Qn, const bf16* Kn, const bf16* Vn) {
  using St = Stage<bf16>; using SQ = Stage<TQ>;
  const int tid = threadIdx.x, wid = __builtin_amdgcn_readfirstlane(tid >> 6), lane = tid & 63, r32 = lane & 31, hi = lane >> 5;
  bf16* V_lds = (bf16*)lds; bf16* K_lds = (bf16*)(lds + 2 * SHM_V);
  float* ws = (float*)(lds + 2 * SHM_V + 2 * SHM_K) + wid * 64; float* li_l = ws; float* al_l = ws + 32;
  float m_reg = -1e30f, l_reg = 0; f32x16 o[4] = {}; bf16x8 qr[8];
#if MK_FP8K
  v8i q8[2]; const unsigned char* K8h = (const unsigned char*)Kh;
#endif
#pragma unroll
  for (int d0 = 0; d0 < 8; ++d0) qr[d0] = pre.q[d0];
  const int sr = tid >> 4, sc = (tid & 15) * 8, vst0 = v_st(sr, sc), vst1 = v_st(32 + sr, sc);
  const int vb0 = (int)(uintptr_t)V_lds + v_rd_base(lane);
#if MK_FP8K
  struct { typename St::T vs0, vs1; u32x4 k8; } sr_[SDEPTH];
  const unsigned vo0 = (unsigned)(sr * LDK + sc), vo1 = vo0 + 32u * LDK, ko = (unsigned)((tid >> 3) * 256 + (tid & 7) * 16);
#define SLOAD(i, k0) do { const bf16* vt_ = Vh + (size_t)(k0) * LDK; const unsigned char* kt_ = K8h + (size_t)(k0) * 256; \
    sr_[i].vs0 = *reinterpret_cast<const bf16x8*>(vt_ + vo0); sr_[i].vs1 = *reinterpret_cast<const bf16x8*>(vt_ + vo1); sr_[i].k8 = *reinterpret_cast<const u32x4*>(kt_ + ko); } while (0)
#define SWRITE(b, i) do { *(bf16x8*)((char*)V_lds + (b) * SHM_V + vst0) = St::tobf(sr_[i].vs0);          \
    *(bf16x8*)((char*)V_lds + (b) * SHM_V + vst1) = St::tobf(sr_[i].vs1);                                \
    *(u32x4*)((char*)K_lds + (b) * SHM_K + K8SWZ(tid >> 3, tid & 7)) = sr_[i].k8; } while (0)
#define SWAIT() asm volatile("s_waitcnt vmcnt(3)" ::: "memory")
#define QKT(P0, P1, KB) qkt8(P0, P1, (const char*)K_lds + (KB) * SHM_K, q8, r32, hi)
#else
#define QKT(P0, P1, KB) qkt(P0, P1, (bf16*)((char*)K_lds + (KB) * SHM_K), qr, r32, hi)
  struct { typename St::T vs0, vs1, ks0, ks1; } sr_[SDEPTH];
#define SLOAD(i, k0) do { sr_[i].vs0 = St::ld8(&Vh[(long)((k0) + sr) * LDK + sc]); sr_[i].vs1 = St::ld8(&Vh[(long)((k0) + 32 + sr) * LDK + sc]); \
    sr_[i].ks0 = St::ld8(&Kh[(long)((k0) + sr) * LDK + sc]); sr_[i].ks1 = St::ld8(&Kh[(long)((k0) + 32 + sr) * LDK + sc]); } while (0)
#define SWRITE(b, i) do { *(bf16x8*)((char*)V_lds + (b) * SHM_V + vst0) = St::tobf(sr_[i].vs0);          \
    *(bf16x8*)((char*)V_lds + (b) * SHM_V + vst1) = St::tobf(sr_[i].vs1); int kc = sc * 2;               \
    *(bf16x8*)((char*)K_lds + (b) * SHM_K + KSWZ(sr, kc)) = St::tobf(sr_[i].ks0);                       \
    *(bf16x8*)((char*)K_lds + (b) * SHM_K + KSWZ(32 + sr, kc)) = St::tobf(sr_[i].ks1); } while (0)
#define SWAIT() do { if constexpr (SDEPTH == 2) asm volatile("s_waitcnt vmcnt(4)" ::: "memory"); else asm volatile("s_waitcnt vmcnt(0)" ::: "memory"); } while (0)
#endif
#define RESC(a) do { if (__any((a) < 1.f)) { if (hi == 0) al_l[r32] = (a); asm volatile("s_waitcnt lgkmcnt(0)" ::: "memory"); \
    for (int d = 0; d < 4; ++d) for (int r = 0; r < 16; ++r) o[d][r] *= al_l[crow(r, hi)]; } } while (0)
  f32x16 pA0, pA1, pB0, pB1; float mnA, mnB, alA, alB; bf16x8 pa0, pa1, pa2, pa3; const int NT = seq / KVBLK;
  constexpr int SE = 0, SO = SDEPTH - 1;
  SLOAD(SE, 0); SLOAD(SO, KVBLK);
  if (qnw) {
    float ssq = 0.f;
#pragma unroll
    for (int d0 = 0; d0 < 8; ++d0)
#pragma unroll
      for (int j = 0; j < 8; ++j) { const float f = bf2f((unsigned short)qr[d0][j]); ssq += f * f; }
    { auto rr = __builtin_amdgcn_permlane32_swap(__float_as_uint(ssq), __float_as_uint(ssq), false, false); ssq = __uint_as_float(rr[0]) + __uint_as_float(rr[1]); }
    const float rstd = 1.0f / sqrtf(ssq * (1.0f / 128.0f) + 1e-6f);
    const int lq = lpos0 + wid * QBLK + r32, ri = lq >> 6, ci = lq & 63;
#pragma unroll
    for (int d0 = 0; d0 < 8; ++d0) {
      const float* wp = qnw + 16 * d0 + 8 * hi; const v4f w0 = *(const v4f*)wp, w1 = *(const v4f*)(wp + 4);
      const float* tp = d0 < 4 ? rope + (ri * 32 + 8 * d0 + 4 * hi) * 2 : rope + (ci * 32 + 8 * (d0 - 4) + 4 * hi) * 2; const v4f t0 = *(const v4f*)tp, t1 = *(const v4f*)(tp + 4);
      const float wv[8] = {w0.x, w0.y, w0.z, w0.w, w1.x, w1.y, w1.z, w1.w}, tv[8] = {t0.x, t0.y, t0.z, t0.w, t1.x, t1.y, t1.z, t1.w};
      float y[8];
#pragma unroll
      for (int q = 0; q < 4; ++q) { const float x0 = bf2f((unsigned short)qr[d0][2 * q]) * rstd * wv[2 * q], x1 = bf2f((unsigned short)qr[d0][2 * q + 1]) * rstd * wv[2 * q + 1], cs = tv[2 * q], sn = tv[2 * q + 1];
        y[2 * q] = x0 * cs - x1 * sn; y[2 * q + 1] = x0 * sn + x1 * cs; }
#if MK_FP8K
      { int w0 = __builtin_amdgcn_cvt_pk_fp8_f32(y[0], y[1], 0, false); w0 = __builtin_amdgcn_cvt_pk_fp8_f32(y[2], y[3], w0, true);
        int w1 = __builtin_amdgcn_cvt_pk_fp8_f32(y[4], y[5], 0, false); w1 = __builtin_amdgcn_cvt_pk_fp8_f32(y[6], y[7], w1, true);
        q8[d0 >> 2][2 * (d0 & 3)] = w0; q8[d0 >> 2][2 * (d0 & 3) + 1] = w1; }
#else
      u32x4 pw = {cvtpk(y[0], y[1]), cvtpk(y[2], y[3]), cvtpk(y[4], y[5]), cvtpk(y[6], y[7])}; qr[d0] = *reinterpret_cast<bf16x8*>(&pw);
#endif
    }
  }
  SWAIT(); SWRITE(0, SE); if constexpr (SDEPTH == 2) { if (2 < NT) SLOAD(SE, 2 * KVBLK); } __syncthreads();
  QKT(pA0, pA1, 0); partialSM(pA0, pA1, m_reg, mnA, alA);
  SWAIT(); SWRITE(1, SO); __syncthreads();
  for (int j = 1; j + 1 < NT; j += 2) {
    SBAR(); QKT(pB0, pB1, 1);
    finishSM(pA0, pA1, alA, l_reg, pa0, pa1, pa2, pa3); SBAR();
    SLOAD(SO, (j + SDEPTH) * KVBLK); SBAR();
    pv_d0(o, vb0, pa0, pa1, pa2, pa3); partialSM(pB0, pB1, m_reg, mnB, alB);
    __syncthreads(); SWAIT(); SWRITE(0, SE);
    RESC(alB); __syncthreads();
    SBAR(); QKT(pA0, pA1, 0);
    finishSM(pB0, pB1, alB, l_reg, pa0, pa1, pa2, pa3); SBAR();
    if (SDEPTH == 1 || j + 3 < NT) SLOAD(SE, (j + 1 + SDEPTH) * KVBLK); SBAR();
    pv_d0(o, vb0 + (int)SHM_V, pa0, pa1, pa2, pa3); partialSM(pA0, pA1, m_reg, mnA, alA);
    __syncthreads(); SWAIT(); SWRITE(1, SO);
    RESC(alA); __syncthreads();
  }
  attn_prefetch(Qn, Kn, Vn, pre);
  SBAR(); QKT(pB0, pB1, 1);
  finishSM(pA0, pA1, alA, l_reg, pa0, pa1, pa2, pa3); SBAR();
  pv_d0(o, vb0, pa0, pa1, pa2, pa3); partialSM(pB0, pB1, m_reg, mnB, alB);
  __syncthreads(); RESC(alB);
  finishSM(pB0, pB1, alB, l_reg, pa0, pa1, pa2, pa3); SBAR();
  pv_d0(o, vb0 + (int)SHM_V, pa0, pa1, pa2, pa3);
  if (hi == 0) li_l[r32] = l_reg; asm volatile("s_waitcnt lgkmcnt(0)" ::: "memory");
  float rli[16];
#pragma unroll
  for (int r = 0; r < 16; ++r) rli[r] = __builtin_amdgcn_rcpf(li_l[crow(r, hi)]);
  if (!Ob) return;
  bf16* Ow = Ob + (long)(wid * QBLK) * LDO;
#pragma unroll
  for (int r = 0; r < 16; ++r) { int orow = crow(r, hi);
    for (int d0 = 0; d0 < 4; ++d0) Ow[(long)orow * LDO + d0 * 32 + r32] = (bf16)f2bf(o[d0][r] * rli[r]); }
#undef SLOAD
#undef QKT
#undef SWRITE
#undef SWAIT
#undef RESC
}

#undef KSWZ
#undef SBAR
}

namespace ret {
typedef short bf16x8 __attribute__((ext_vector_type(8)));
typedef short s16x4 __attribute__((ext_vector_type(4)));
typedef float f32x16 __attribute__((ext_vector_type(16)));
constexpr int QSTR = 528, KSTR = 576, VSTR = 576, PSTR = 144;
constexpr int QS = 0, KS = QS + 64 * QSTR, VS = KS + 64 * KSTR, PS = VS + 64 * VSTR, OST = PS + 64 * PSTR, OSTR = 144, SSL = OST + 8 * 32 * OSTR, LDS_RET = SSL + 64 * 8 * 4;
constexpr int NSTEP = 36, SPLIT = 20;
__device__ __forceinline__ int crow(int r, int hi) { return (r & 3) + 8 * (r >> 2) + 4 * hi; }
__device__ __forceinline__ s16x4 tr_read(const LAS unsigned char* p) { return __builtin_bit_cast(s16x4, __builtin_amdgcn_ds_read_tr16_b64_v4i16((LAS s16x4*)p)); }
__device__ __forceinline__ bf16x8 cat(s16x4 lo, s16x4 hi) { return (bf16x8){lo[0], lo[1], lo[2], lo[3], hi[0], hi[1], hi[2], hi[3]}; }

struct NoPre { __device__ __forceinline__ void operator()() const {} };
template <class GridBar, class PreWork = NoPre>
__device__ __forceinline__ void scan_unit(const bf16_t* RQ, const bf16_t* RK, const bf16_t* RV, bf16_t* YR, float* SSQ, const float* l2d, LAS unsigned char* lds, int unit, const GridBar& gridbar, int nb_limit, const PreWork& prework = PreWork()) {
    const int tid = threadIdx.x, lane = tid & 63, w = __builtin_amdgcn_readfirstlane(tid >> 6), r = lane & 31, hh = lane >> 5;
    const int x = unit & 7, y = unit >> 3, eh = y & 1, dir = (y >> 1) & 1, bh = (y >> 2) * 8 + x, b = bh >> 2, h = bh & 3;
    if (b >= nb_limit) { prework(); gridbar(); return; }
    const float lg2 = log1pf(-exp2f(l2d[dir * 4 + h])) * 1.4426950408889634f;
    const float gC = exp2f(lg2 * 64.0f);
#if MK_TIMING
    unsigned long long tl_ = __builtin_amdgcn_s_memrealtime(); unsigned ta0 = 0, ta1 = 0, ta2 = 0, ta3 = 0, ta4 = 0, ta5 = 0, ta6 = 0;
#define TMARK(v_) do { const unsigned long long n_ = __builtin_amdgcn_s_memrealtime(); v_ += (unsigned)(n_ - tl_); tl_ = n_; } while (0)
#else
#define TMARK(v_) do { } while (0)
#endif
    f32x16 S[8];
#pragma unroll
    for (int T = 0; T < 8; ++T) S[T] = (f32x16){0.f};
#define STEP_ROWS(s_, krow_, qrow_) do { const bool l_ = (s_) >= 4; const int lc_ = l_ ? (dir ? 35 - (s_) : (s_) - 4) : 0; \
        krow_ = b * LT + (l_ ? LC + 64 * lc_ : (dir ? 64 * (3 - (s_)) : 64 * (s_))); qrow_ = b * SEQ + 64 * lc_; } while (0)
    v4u kv[4], vv[4], qv[4];
    const int poff = (tid >> 5) * 1024 + (tid & 31) * 8, voff = (tid >> 5) * 2048 + (tid & 31) * 8;
#define PREFETCHK(s_) do { int kr_, qr_; STEP_ROWS(s_, kr_, qr_); const bf16_t* kb_ = RK + (size_t)kr_ * 1024 + h * 256; \
        _Pragma("unroll") for (int n = 0; n < 4; ++n) { const bf16_t* kbn_ = kb_ + n * 16 * 1024; kv[n] = *(const v4u*)(kbn_ + poff); } } while (0)
#define PREFETCHQ(s_) do { int kr_, qr_; STEP_ROWS(s_, kr_, qr_); const bf16_t* qb_ = RQ + (size_t)qr_ * 1024 + h * 256; \
        _Pragma("unroll") for (int n = 0; n < 4; ++n) { const bf16_t* qbn_ = qb_ + n * 16 * 1024; qv[n] = *(const v4u*)(qbn_ + poff); } } while (0)
#define LOADV(s_) do { int kr_, qr_; STEP_ROWS(s_, kr_, qr_); const bf16_t* vb_ = RV + (size_t)kr_ * 2048 + h * 512 + eh * 256; \
        _Pragma("unroll") for (int n = 0; n < 4; ++n) { const bf16_t* vbn_ = vb_ + n * 16 * 2048; vv[n] = *(const v4u*)(vbn_ + voff); } } while (0)
#define WRITEQ() do { _Pragma("unroll") for (int n = 0; n < 4; ++n) { const int c = tid + NTHR * n, row = c >> 5, ch = c & 31; *(LAS v4u*)(lds + QS + row * QSTR + ch * 16) = qv[n]; } } while (0)
    PREFETCHK(0); PREFETCHQ(0); LOADV(0);
    prework();
    LAS unsigned char* ost = lds + OST + w * (32 * OSTR);
    for (int s = 0; s < NSTEP; ++s) {
        if (s == SPLIT) gridbar();
        int krow0, qrow0; STEP_ROWS(s, krow0, qrow0); const bool latent = s >= 4; const int sn = s + 1 < NSTEP ? s + 1 : s;
        float lg2s = lg2; int hv = hh, rv = r; asm volatile("" : "+v"(lg2s), "+v"(hv), "+v"(rv));
        const int lane_l = hv * 32 + rv;
        const int qA = QS + rv * QSTR + hv * 16, pA = PS + rv * PSTR + hv * 16;
        const int sw = ((lane_l & 1) << 1) | ((lane_l >> 1) & 1);
        const int trrow = (hv * 8 + ((lane_l >> 2) & 3));
        const int ktr = KS + trrow * KSTR + (16 * ((lane_l >> 4) & 1) + 4 * sw) * 2;
        const int vtr = VS + trrow * VSTR + (32 * w + 16 * ((lane_l >> 4) & 1) + 4 * (lane_l & 3)) * 2;
        { float wgt = __builtin_amdgcn_exp2f(lg2s * (float)(dir ? (tid >> 5) : 63 - (tid >> 5))); const float wstep = __builtin_amdgcn_exp2f(lg2s * (dir ? 16.0f : -16.0f));
#pragma unroll
          for (int n = 0; n < 4; ++n) { const int c = tid + NTHR * n, row = c >> 5, ch = c & 31;
            *(LAS v4u*)(lds + KS + row * KSTR + ch * 16) = kv[n];
            *(LAS v4u*)(lds + QS + row * QSTR + ch * 16) = qv[n];
            float t[8]; unpack8(vv[n], t);
#pragma unroll
            for (int k = 0; k < 8; ++k) t[k] *= wgt;
            wgt *= wstep;
            *(LAS v4u*)(lds + VS + row * VSTR + ch * 16) = pack8(t); } }
        __syncthreads();
        TMARK(ta0);
        v4u pp[4]; bf16_t* op = YR + (size_t)qrow0 * 2048 + h * 512 + eh * 256 + 32 * w + (size_t)((hv * 32 + rv) >> 2) * 2048 + ((hv * 32 + rv) & 3) * 8;
        if (s >= SPLIT) {
#pragma unroll
            for (int x4 = 0; x4 < 4; ++x4) pp[x4] = *(const v4u*)(op + (size_t)(16 * x4) * 2048); }
        if (latent) {
            { typedef float f32x4_t __attribute__((ext_vector_type(4)));
              const int i0 = 16 * (w >> 1), j0 = 32 * (w & 1), l15 = rv & 15, g4 = (hv << 1) | (rv >> 4);
              const LAS unsigned char* qp = lds + QS + (i0 + l15) * QSTR + g4 * 16; const LAS unsigned char* kp0 = lds + KS + (j0 + l15) * KSTR + g4 * 16; const LAS unsigned char* kp1 = kp0 + 16 * KSTR;
              f32x4_t s0 = (f32x4_t){0.f, 0.f, 0.f, 0.f}, s1 = s0;
              bf16x8 qn = *(const LAS bf16x8*)qp, k0n = *(const LAS bf16x8*)kp0, k1n = *(const LAS bf16x8*)kp1;
#pragma unroll
              for (int kk = 0; kk < 8; ++kk) { const bf16x8 qc = qn, k0c = k0n, k1c = k1n;
                if (kk + 1 < 8) { qn = *(const LAS bf16x8*)(qp + (kk + 1) * 64); k0n = *(const LAS bf16x8*)(kp0 + (kk + 1) * 64); k1n = *(const LAS bf16x8*)(kp1 + (kk + 1) * 64); }
                __builtin_amdgcn_sched_barrier(0);
                s0 = __builtin_amdgcn_mfma_f32_16x16x32_bf16(k0c, qc, s0, 0, 0, 0); s1 = __builtin_amdgcn_mfma_f32_16x16x32_bf16(k1c, qc, s1, 0, 0, 0); }
              const int i = i0 + l15;
#pragma unroll
              for (int t2 = 0; t2 < 2; ++t2) { const f32x4_t sv = t2 ? s1 : s0; const int jb = j0 + 16 * t2 + 4 * g4; float v4[4];
#pragma unroll
                for (int k = 0; k < 4; ++k) { const int j = jb + k; const bool keep = dir ? (j >= i) : (j <= i); v4[k] = keep ? sv[k] : 0.f; }
                v2u pw; pw.x = cvt_pk_bf16(v4[0], v4[1]); pw.y = cvt_pk_bf16(v4[2], v4[3]);
                *(LAS v2u*)(lds + PS + i * PSTR + jb * 2) = pw; } }
            TMARK(ta1);
            f32x16 acc[2]; acc[0] = (f32x16){0.f}; acc[1] = (f32x16){0.f};
            { const LAS unsigned char* q0 = lds + qA; const LAS unsigned char* q1 = lds + qA + 32 * QSTR;
              bf16x8 n0 = *(const LAS bf16x8*)q0, n1 = *(const LAS bf16x8*)q1, m0 = *(const LAS bf16x8*)(q0 + 32), m1 = *(const LAS bf16x8*)(q1 + 32);
#pragma unroll
              for (int ix = 0; ix < 16; ++ix) { const int T = ix >> 1, s2 = ix & 1; const bf16x8 a0 = n0, a1 = n1; n0 = m0; n1 = m1;
                if (ix + 2 < 16) { m0 = *(const LAS bf16x8*)(q0 + (ix + 2) * 32); m1 = *(const LAS bf16x8*)(q1 + (ix + 2) * 32); }
                v4u bw; bw.x = cvt_pk_bf16(S[T][8 * s2 + 0], S[T][8 * s2 + 1]); bw.y = cvt_pk_bf16(S[T][8 * s2 + 2], S[T][8 * s2 + 3]);
                bw.z = cvt_pk_bf16(S[T][8 * s2 + 4], S[T][8 * s2 + 5]); bw.w = cvt_pk_bf16(S[T][8 * s2 + 6], S[T][8 * s2 + 7]); const bf16x8 bs = __builtin_bit_cast(bf16x8, bw);
                __builtin_amdgcn_sched_barrier(0);
                acc[0] = __builtin_amdgcn_mfma_f32_32x32x16_bf16(a0, bs, acc[0], 0, 0, 0); acc[1] = __builtin_amdgcn_mfma_f32_32x32x16_bf16(a1, bs, acc[1], 0, 0, 0); } }
            TMARK(ta2);
            __syncthreads();
            LOADV(sn);
            TMARK(ta3);
            { bf16x8 vn = cat(tr_read(lds + vtr), tr_read(lds + vtr + 4 * VSTR)), pn0 = *(const LAS bf16x8*)(lds + pA), pn1 = *(const LAS bf16x8*)(lds + pA + 32 * PSTR);
#pragma unroll
              for (int js = 0; js < 4; ++js) { const bf16x8 vfj = vn, p0 = pn0, p1 = pn1;
                if (js + 1 < 4) { vn = cat(tr_read(lds + vtr + (16 * (js + 1)) * VSTR), tr_read(lds + vtr + (16 * (js + 1) + 4) * VSTR)); pn0 = *(const LAS bf16x8*)(lds + pA + (js + 1) * 32); pn1 = *(const LAS bf16x8*)(lds + pA + 32 * PSTR + (js + 1) * 32); }
                __builtin_amdgcn_sched_barrier(0);
                acc[0] = __builtin_amdgcn_mfma_f32_32x32x16_bf16(p0, vfj, acc[0], 0, 0, 0); acc[1] = __builtin_amdgcn_mfma_f32_32x32x16_bf16(p1, vfj, acc[1], 0, 0, 0); } }
#pragma unroll
            for (int it = 0; it < 2; ++it) {
#pragma unroll
                for (int q = 0; q < 16; ++q) { const int il = crow(q, hv); const int i = it * 32 + il; const float rf = __builtin_amdgcn_exp2f(lg2s * (float)(dir ? -i : i - 63));
                    *(LAS float*)(ost + il * OSTR + rv * 4) = acc[it][q] * rf; }
#pragma unroll
                for (int n = 0; n < 2; ++n) { const int c = (hv * 32 + rv) + 64 * n, row = c >> 2, cq = c & 3;
                    const v4f x0 = *(const LAS v4f*)(ost + row * OSTR + cq * 32), x1 = *(const LAS v4f*)(ost + row * OSTR + cq * 32 + 16);
                    float o[8] = {x0.x, x0.y, x0.z, x0.w, x1.x, x1.y, x1.z, x1.w};
                    if (s >= SPLIT) { float pv[8]; unpack8(pp[2 * it + n], pv); float ss = 0.f;
#pragma unroll
                        for (int k = 0; k < 8; ++k) { o[k] += pv[k]; ss += o[k] * o[k]; }
                        ss += __shfl_xor(ss, 1); ss += __shfl_xor(ss, 2);
                        if (cq == 0) *(LAS float*)(lds + SSL + ((it * 32 + row) * 8 + w) * 4) = ss; }
                    *(v4u*)(op + (size_t)(it * 32 + 16 * n) * 2048) = pack8(o); }
            }
        }
        TMARK(ta4);
        __builtin_amdgcn_sched_barrier(0);
        PREFETCHK(sn);
        PREFETCHQ(sn);
        if (!latent) LOADV(sn);
        {
#define KA_LD(ix_) cat(tr_read(lds + ktr + (16 * ((ix_) >> 3)) * KSTR + ((ix_) & 7) * 64), tr_read(lds + ktr + (16 * ((ix_) >> 3) + 4) * KSTR + ((ix_) & 7) * 64))
#define VF_LD(js_) cat(tr_read(lds + vtr + (16 * (js_)) * VSTR), tr_read(lds + vtr + (16 * (js_) + 4) * VSTR))
          bf16x8 vcur = VF_LD(0), vnx = vcur, kn0 = KA_LD(0), kn1 = KA_LD(1);
#pragma unroll
          for (int ix = 0; ix < 32; ++ix) { const int T = ix & 7, js = ix >> 3; const bf16x8 ka = kn0; kn0 = kn1;
            if (ix + 2 < 32) kn1 = KA_LD(ix + 2);
            if (T == 4 && js < 3) vnx = VF_LD(js + 1);
            __builtin_amdgcn_sched_barrier(0);
            S[T] = __builtin_amdgcn_mfma_f32_32x32x16_bf16(ka, vcur, S[T], 0, 0, 0);
            if (T == 7) vcur = vnx; }
#undef KA_LD
#undef VF_LD
        }
#pragma unroll
        for (int T = 0; T < 8; ++T) S[T] *= gC;
        TMARK(ta5);
        __syncthreads();
        TMARK(ta6);
        if (s >= SPLIT && tid < 64) { const LAS float* pr = (const LAS float*)(lds + SSL + tid * 32); const v4f a = *(const LAS v4f*)pr, c4 = *(const LAS v4f*)(pr + 4);
            SSQ[(size_t)(qrow0 + tid) * 8 + h * 2 + eh] = ((a.x + a.y) + (a.z + a.w)) + ((c4.x + c4.y) + (c4.z + c4.w)); }
    }
#if MK_TIMING
    if (unit == 0 && tid == 0) { unsigned* tw = (unsigned*)SSQ - 64; tw[0] = ta0; tw[1] = ta1; tw[2] = ta2; tw[3] = ta3; tw[4] = ta4; tw[5] = ta5; tw[6] = ta6; }
#endif
#undef STEP_ROWS
#undef PREFETCHK
#undef PREFETCHQ
#undef WRITEQ
#undef LOADV
}
}

constexpr int RING_BYTES = 131072, LDS_BYTES = 157696;
#ifndef MK_ONE_LAUNCH
#define MK_ONE_LAUNCH 1
#endif
constexpr int N_PHASES = 10;
#define LDS_WAIT() asm volatile("s_waitcnt lgkmcnt(0)" ::: "memory")
constexpr int MISC_OFF = 155648 + 320;
constexpr int CW_BAR = 4096;
constexpr size_t CTL_ZERO_BYTES = 65536;
#ifndef MK_NAIVE_ATTN
#define MK_NAIVE_ATTN 0
#endif
#ifndef MK_NAIVE_RET
#define MK_NAIVE_RET 0
#endif
#ifndef MK_DEBUG_ATTN
#define MK_DEBUG_ATTN 0
#endif
#ifndef MK_DBG_H
#define MK_DBG_H 0
#endif
#ifndef MK_DBG_L0
#define MK_DBG_L0 768
#define MK_DBG_L1 1280
#endif
#ifndef MK_DEBUG_RET
#define MK_DEBUG_RET 0
#endif
#ifndef MK_STAMP_A
#define MK_STAMP_A -1
#define MK_STAMP_B -1
#endif
#ifndef MK_REP_P4
#define MK_REP_P4 1
#endif
#ifndef MK_REP_P5
#define MK_REP_P5 1
#endif
#ifndef MK_REP_P6
#define MK_REP_P6 1
#endif
#ifndef MK_REP_P2
#define MK_REP_P2 1
#endif
#ifndef MK_REP_P9
#define MK_REP_P9 1
#endif
#ifndef MK_NSTAG
#define MK_NSTAG 1
#define MK_STAG_TICKS 500
#endif
#ifndef MK_ATTN_PROBE
#define MK_ATTN_PROBE 0
#endif
#ifndef MK_MIX
#define MK_MIX 0
#endif
#ifndef MK_EPIW
#define MK_EPIW 16
#endif
#ifndef MK_BARRIER
#define MK_BARRIER 1
#endif
#define XB_TMO      128
#define XB_XCNT(j)  (256  + 64 * (j))
#define XB_XSUB(j)  (1280 + 64 * (j))
#define XB_XGEN(j)  (2304 + 64 * (j))
#define XB_TOP      3328
#define XB_TOPGEN   3392
#define XCD_BAR_WORDS 3456
#define XB_SPIN_CAP (1u << 18)

__device__ __forceinline__ unsigned xb_ld(unsigned* p)              { return __hip_atomic_load(p, __ATOMIC_RELAXED, __HIP_MEMORY_SCOPE_AGENT); }
__device__ __forceinline__ unsigned xb_add(unsigned* p, unsigned v) { return __hip_atomic_fetch_add(p, v, __ATOMIC_RELAXED, __HIP_MEMORY_SCOPE_AGENT); }
__device__ __forceinline__ unsigned xb_xcc_id() { return (unsigned)__builtin_amdgcn_s_getreg((3 << 11) | 20) & 0xFu; }
#define XB_SPIN(cond, bar) do { unsigned _sp = 0; while (cond) { __builtin_amdgcn_s_sleep(1); \
    if ((++_sp & 255u) == 0u) { if (xb_ld(&(bar)[XB_TMO])) break; if (_sp > XB_SPIN_CAP) { atomicAdd(&(bar)[XB_TMO], 1u); break; } } } } while (0)

struct XcdBarrier {
    unsigned* bar; unsigned x;
    volatile LAS unsigned* st;
};

__device__ __forceinline__ XcdBarrier xcd_barrier_post(unsigned* bar, volatile LAS unsigned* st) {
    XcdBarrier b; b.bar = bar; b.x = xb_xcc_id(); b.st = st;
    if (threadIdx.x == 0) (void)xb_add(&bar[XB_XCNT(b.x)], 1u);
    return b;
}
__device__ __forceinline__ void xcd_barrier_complete(unsigned* bar, unsigned x, unsigned& nloc, unsigned& nx) {
    const unsigned G = gridDim.x * gridDim.y * gridDim.z;
    unsigned sum, cnt, mine, sp = 0u;
    for (;;) {
        sum = 0u; cnt = 0u; mine = 0u;
#pragma unroll
        for (unsigned j = 0; j < 16; ++j) { const unsigned c = xb_ld(&bar[XB_XCNT(j)]); sum += c; cnt += (c > 0u) ? 1u : 0u; mine = (j == x) ? c : mine; }
        if (sum == G) break;
        __builtin_amdgcn_s_sleep(1);
        if ((++sp & 255u) == 0u) { if (xb_ld(&bar[XB_TMO])) break; if (sp > XB_SPIN_CAP) { atomicAdd(&bar[XB_TMO], 1u); break; } }
    }
    nloc = mine > 0u ? mine : 1u; nx = cnt > 0u ? cnt : 1u;
}

__device__ __forceinline__ void xcd_barrier(const XcdBarrier& b) {
    asm volatile("s_waitcnt vmcnt(0)" ::: "memory");
    __syncthreads();
    if (threadIdx.x == 0) {
        unsigned* bar = b.bar;
        __builtin_amdgcn_s_waitcnt(0);
        unsigned nloc = b.st[0], nx = b.st[1];
        if (nloc == 0u) { xcd_barrier_complete(bar, b.x, nloc, nx); b.st[0] = nloc; b.st[1] = nx; }
        const unsigned old = xb_add(&bar[XB_XSUB(b.x)], 1u);
        const unsigned gen = old / nloc;
        if (old + 1u == (gen + 1u) * nloc) {
            __builtin_amdgcn_fence(__ATOMIC_RELEASE, "agent");
            asm volatile("s_waitcnt vmcnt(0)" ::: "memory");
            const unsigned og = xb_add(&bar[XB_TOP], 1u);
            const unsigned tg = og / nx;
            if (og + 1u == (tg + 1u) * nx) xb_add(&bar[XB_TOPGEN], 1u);
            else XB_SPIN(xb_ld(&bar[XB_TOPGEN]) == tg, bar);
            __builtin_amdgcn_fence(__ATOMIC_ACQUIRE, "agent");
            xb_add(&bar[XB_XGEN(b.x)], 1u);
            asm volatile("s_waitcnt vmcnt(0)" ::: "memory");
        } else {
            XB_SPIN(xb_ld(&bar[XB_XGEN(b.x)]) == gen, bar);
            __builtin_amdgcn_fence(__ATOMIC_ACQUIRE, "agent");
            asm volatile("s_waitcnt vmcnt(0)" ::: "memory");
        }
    }
    __syncthreads();
}


struct Args { const float* in[14]; float* out; unsigned char* ws; int ph_lo, ph_hi; };

__device__ __forceinline__ void p0_mod_item(const float* c, const float* c_ctx, const float* w_ada, const float* b_ada, float* MOD, float* ldsf, int item, int tid) {
    float* sc = ldsf; float* red = ldsf + 17 * 1024;
    for (int i = tid; i < 17 * 1024; i += NTHR) { const float v = i < 16 * 1024 ? c[i] : c_ctx[i - 16 * 1024]; sc[i] = v / (1.0f + expf(-v)); }
    const int col = tid & 15, ks = tid >> 4, n = item * 16 + col;
    float wv[32];
#pragma unroll
    for (int k = 0; k < 32; ++k) wv[k] = w_ada[(size_t)(ks * 32 + k) * 3072 + n];
    __syncthreads();
    float acc[17];
#pragma unroll
    for (int r = 0; r < 17; ++r) acc[r] = 0.f;
#pragma unroll
    for (int k = 0; k < 32; ++k) {
#pragma unroll
        for (int r = 0; r < 17; ++r) acc[r] += sc[r * 1024 + ks * 32 + k] * wv[k]; }
#pragma unroll
    for (int r = 0; r < 17; ++r) red[(ks * 17 + r) * 16 + col] = acc[r];
    __syncthreads();
    if (tid < 17 * 16) { const int r = tid >> 4, cc = tid & 15; float s = b_ada[item * 16 + cc];
        for (int k2 = 0; k2 < 32; ++k2) s += red[(k2 * 17 + r) * 16 + cc];
        MOD[r * 3072 + item * 16 + cc] = s; }
    __syncthreads();
}
__device__ __forceinline__ void p0_transpose_item(const float* W, int K, int N, bf16_t* WT, int row_off, float* scr, int item, int lane) {
    const int nblk = N / 32, kb = item / nblk, nb = item % nblk, k0 = 64 * kb, n0 = 32 * nb;
    float tv[32];
#pragma unroll
    for (int i = 0; i < 32; ++i) { const int kk = 2 * i + (lane >> 5); tv[i] = W[(size_t)(k0 + kk) * N + n0 + (lane & 31)]; }
#pragma unroll
    for (int i = 0; i < 32; ++i) { const int kk = 2 * i + (lane >> 5); scr[kk * 33 + (lane & 31)] = tv[i]; }
    LDS_WAIT(); asm volatile("" ::: "memory");
    const int c = lane & 7;
#pragma unroll
    for (int j = 0; j < 4; ++j) { const int n = (lane >> 3) + 8 * j; const float* s = scr + (8 * c) * 33 + n;
        v4u o; o.x = pk2(s[0 * 33], s[1 * 33]); o.y = pk2(s[2 * 33], s[3 * 33]); o.z = pk2(s[4 * 33], s[5 * 33]); o.w = pk2(s[6 * 33], s[7 * 33]);
        *(v4u*)(WT + (size_t)(row_off + n0 + n) * K + k0 + 8 * c) = o; }
    LDS_WAIT(); asm volatile("" ::: "memory");
}
__device__ __forceinline__ void p0_transpose64_item(const float* W, int K, int N, bf16_t* WT, int row_off, float* scr, int item, int lane) {
    const int nblk = N / 64, kb = item / nblk, nb = item % nblk, k0 = 64 * kb, n0 = 64 * nb;
    v4f tv[16]; const int lr = lane >> 4, lc = (lane & 15) * 4;
#pragma unroll
    for (int i = 0; i < 16; ++i) tv[i] = *(const v4f*)(W + (size_t)(k0 + 4 * i + lr) * N + n0 + lc);
#pragma unroll
    for (int i = 0; i < 16; ++i) { float* d = scr + (4 * i + lr) * 65 + lc; d[0] = tv[i].x; d[1] = tv[i].y; d[2] = tv[i].z; d[3] = tv[i].w; }
    LDS_WAIT(); asm volatile("" ::: "memory");
    const int c = lane & 7;
#pragma unroll
    for (int j = 0; j < 8; ++j) { const int n = (lane >> 3) + 8 * j; const float* s = scr + (8 * c) * 65 + n;
        v4u o; o.x = pk2(s[0 * 65], s[1 * 65]); o.y = pk2(s[2 * 65], s[3 * 65]); o.z = pk2(s[4 * 65], s[5 * 65]); o.w = pk2(s[6 * 65], s[7 * 65]);
        *(v4u*)(WT + (size_t)(row_off + n0 + n) * K + k0 + 8 * c) = o; }
    LDS_WAIT(); asm volatile("" ::: "memory");
}
__device__ __forceinline__ int new_col(int o) { return o < 4608 ? o : (o < 6656 ? o + 1024 : (o < 7680 ? o - 2048 : o)); }

__device__ __forceinline__ void sincos_d(double a, float& c, float& s) {
    const double TWO_PI = 6.283185307179586476925;
    const double k = (double)(long long)(a / TWO_PI + (a >= 0 ? 0.5 : -0.5)); const double r = a - k * TWO_PI, r2 = r * r;
    double ts = r, ss = r, tc = 1.0, cc = 1.0;
    for (int n = 1; n <= 15; ++n) { tc *= -r2 / (double)((2 * n - 1) * (2 * n)); cc += tc; ts *= -r2 / (double)((2 * n) * (2 * n + 1)); ss += ts; }
    c = (float)cc; s = (float)ss;
}

__device__ __forceinline__ void p1_row(const float* xrow, const float* nw, const float* shift, const float* scale, bf16_t* orow, int lane) {
    const v4f* xr = (const v4f*)xrow + lane; v4f v[4]; float s = 0.f;
#pragma unroll
    for (int j = 0; j < 4; ++j) { v[j] = xr[64 * j]; s += (v[j].x * v[j].x + v[j].y * v[j].y) + (v[j].z * v[j].z + v[j].w * v[j].w); }
    const float rstd = 1.0f / sqrtf(wave_sum(s) * (1.0f / 1024.0f) + EPS);
    v2u* o8 = (v2u*)orow + lane;
#pragma unroll
    for (int j = 0; j < 4; ++j) { const v4f w = ((const v4f*)nw)[lane + 64 * j], sh = ((const v4f*)shift)[lane + 64 * j], sc = ((const v4f*)scale)[lane + 64 * j];
        const v4f y = v[j] * rstd * w * (sc + 1.0f) + sh; v2u o; o.x = pk2(y.x, y.y); o.y = pk2(y.z, y.w); o8[64 * j] = o; }
}

template <int NR>
__device__ __forceinline__ void p1_rowsN(const float* x, const float* ctx, const float* MOD, const v4f (&nwv)[4], bf16_t* HX, int r0, int rlast, int lane) {
    v4f v[NR][4];
#pragma unroll
    for (int k = 0; k < NR; ++k) { const int m = r0 + k < rlast ? r0 + k : rlast; const float* xr = m < MLAT ? x + (size_t)m * 1024 : ctx + (size_t)(m - MLAT) * 1024;
#pragma unroll
        for (int j = 0; j < 4; ++j) v[k][j] = __builtin_nontemporal_load((const v4f*)xr + lane + 64 * j); }
#pragma unroll
    for (int k = 0; k < NR; ++k) { const int m = r0 + k < rlast ? r0 + k : rlast; const float* mp = MOD + (m < MLAT ? (m >> 11) : 16) * 3072; float s = 0.f;
        v4f sh[4], sc[4];
#pragma unroll
        for (int j = 0; j < 4; ++j) { sh[j] = ((const v4f*)mp)[lane + 64 * j]; sc[j] = ((const v4f*)(mp + 1024))[lane + 64 * j]; }
#pragma unroll
        for (int j = 0; j < 4; ++j) s += (v[k][j].x * v[k][j].x + v[k][j].y * v[k][j].y) + (v[k][j].z * v[k][j].z + v[k][j].w * v[k][j].w);
        const float rstd = 1.0f / sqrtf(wave_sum(s) * (1.0f / 1024.0f) + EPS);
        v2u* o8 = (v2u*)(HX + (size_t)m * 1024) + lane;
#pragma unroll
        for (int j = 0; j < 4; ++j) { const v4f y = v[k][j] * rstd * nwv[j] * (sc[j] + 1.0f) + sh[j]; v2u o; o.x = pk2(y.x, y.y); o.y = pk2(y.z, y.w); o8[64 * j] = o; } }
}

__device__ __forceinline__ void p3_item(bf16_t* buf, int ldlog2, bool isK, const float* nw, const float* ROPE, size_t item, int lane) {
    const size_t e = item * 512 + (size_t)lane * 8; const size_t row = e >> ldlog2; const int col = (int)(e & ((1u << ldlog2) - 1)), d0 = col & 127;
    float t[8]; unpack8(*(const v4u*)(buf + e), t);
    float ss = 0.f;
#pragma unroll
    for (int k = 0; k < 8; ++k) ss += t[k] * t[k];
    ss += __shfl_xor(ss, 1); ss += __shfl_xor(ss, 2); ss += __shfl_xor(ss, 4); ss += __shfl_xor(ss, 8);
    const float rstd = 1.0f / sqrtf(ss * (1.0f / 128.0f) + EPS);
#pragma unroll
    for (int k = 0; k < 8; ++k) t[k] = t[k] * rstd * nw[d0 + k];
    int l; bool rope = true;
    if (isK) { const int p = (int)(row % LT); rope = p >= LC; l = p - LC; } else l = (int)(row & (SEQ - 1));
    if (rope) { const int ri = l >> 6, ci = l & 63, p0 = d0 >> 1; const float* tab = p0 < 32 ? ROPE + (ri * 32 + p0) * 2 : ROPE + (ci * 32 + (p0 - 32)) * 2;
#pragma unroll
        for (int q = 0; q < 4; ++q) { const float cs = tab[2 * q], sn = tab[2 * q + 1], x0 = t[2 * q], x1 = t[2 * q + 1]; t[2 * q] = x0 * cs - x1 * sn; t[2 * q + 1] = x0 * sn + x1 * cs; } }
    *(v4u*)(buf + e) = pack8(t);
}

template <int NI>
__device__ __forceinline__ void p3_items_k(bf16_t* AK, const float* nw, const float* ROPE, size_t it0, size_t itend, int lane, unsigned char* K8 = nullptr) {
    v4u raw[NI];
#pragma unroll
    for (int i = 0; i < NI; ++i) if (it0 + i < itend) raw[i] = *(const v4u*)(AK + (it0 + i) * 512 + (size_t)lane * 8);
#pragma unroll
    for (int i = 0; i < NI; ++i) if (it0 + i < itend) {
        const size_t e = (it0 + i) * 512 + (size_t)lane * 8; const size_t row = e >> 8; const int d0 = (int)(e & 255) & 127;
        float t[8]; unpack8(raw[i], t); float ss = 0.f;
#pragma unroll
        for (int k = 0; k < 8; ++k) ss += t[k] * t[k];
        ss += __shfl_xor(ss, 1); ss += __shfl_xor(ss, 2); ss += __shfl_xor(ss, 4); ss += __shfl_xor(ss, 8);
        const float rstd = 1.0f / sqrtf(ss * (1.0f / 128.0f) + EPS);
#pragma unroll
        for (int k = 0; k < 8; ++k) t[k] = t[k] * rstd * nw[d0 + k];
        const int p = (int)(row % LT);
        if (p >= LC) { const int l = p - LC, ri = l >> 6, ci = l & 63, p0 = d0 >> 1; const float* tab = p0 < 32 ? ROPE + (ri * 32 + p0) * 2 : ROPE + (ci * 32 + (p0 - 32)) * 2;
#pragma unroll
            for (int q = 0; q < 4; ++q) { const float cs = tab[2 * q], sn = tab[2 * q + 1], x0 = t[2 * q], x1 = t[2 * q + 1]; t[2 * q] = x0 * cs - x1 * sn; t[2 * q + 1] = x0 * sn + x1 * cs; } }
        *(v4u*)(AK + e) = pack8(t);
#if MK_FP8K
        if (K8) { int w0 = __builtin_amdgcn_cvt_pk_fp8_f32(t[0], t[1], 0, false); w0 = __builtin_amdgcn_cvt_pk_fp8_f32(t[2], t[3], w0, true);
            int w1 = __builtin_amdgcn_cvt_pk_fp8_f32(t[4], t[5], 0, false); w1 = __builtin_amdgcn_cvt_pk_fp8_f32(t[6], t[7], w1, true);
            const int g = ((int)(e & 255)) >> 7, pb = (d0 & 64) + 32 * ((d0 >> 3) & 1) + 8 * ((d0 >> 4) & 3); v2u w; w.x = (unsigned)w0; w.y = (unsigned)w1;
            *(v2u*)(K8 + row * 256 + g * 128 + pb) = w; }
#endif
        }
}

__device__ __forceinline__ void p4_naive_item(const bf16_t* RQ, const bf16_t* RK, const bf16_t* RV, bf16_t* YR, float* SSQ, const float* l2d, float* ldsf, int item, int tid) {
    const int rb = item & 255, h = (item >> 8) & 3, b = item >> 10, i0 = rb * 8;
    float* qs = ldsf; float* sc = ldsf + 2048; float* red = sc + 8 * LT;
    for (int t = tid; t < 2048; t += NTHR) { const int r = t >> 8, d = t & 255; qs[t] = bf2f(RQ[((size_t)(b * SEQ + i0 + r)) * 1024 + h * 256 + d]); }
    __syncthreads();
    const float lgf = log1pf(-exp2f(l2d[h])), lgb = log1pf(-exp2f(l2d[4 + h]));
    for (int p = tid; p < LT; p += NTHR) {
        const bf16_t* kr = RK + ((size_t)(b * LT + p)) * 1024 + h * 256;
        float dot[8];
#pragma unroll
        for (int r = 0; r < 8; ++r) dot[r] = 0.f;
        for (int d8 = 0; d8 < 32; ++d8) { float kk[8]; unpack8(*(const v4u*)(kr + d8 * 8), kk);
#pragma unroll
            for (int r = 0; r < 8; ++r)
#pragma unroll
                for (int k = 0; k < 8; ++k) dot[r] += qs[r * 256 + d8 * 8 + k] * kk[k]; }
#pragma unroll
        for (int r = 0; r < 8; ++r) { const int i = i0 + r; float W;
            if (p < LC) W = MK_DBG_NOCTX ? 0.f : expf(lgf * (float)(i + LC - p)) + expf(lgb * (float)(SEQ - i + p));
            else { const int j = p - LC; W = (j <= i ? expf(lgf * (float)(i - j)) : 0.f) + (j >= i ? expf(lgb * (float)(j - i)) : 0.f); }
            sc[r * LT + p] = dot[r] * W; }
    }
    __syncthreads();
    float acc[8];
#pragma unroll
    for (int r = 0; r < 8; ++r) acc[r] = 0.f;
    const bf16_t* vp = RV + (size_t)(b * LT) * 2048 + h * 512 + tid;
    for (int p = 0; p < LT; ++p) { const float v = bf2f(vp[(size_t)p * 2048]);
#pragma unroll
        for (int r = 0; r < 8; ++r) acc[r] += sc[r * LT + p] * v; }
    const int wid = tid >> 6, lane = tid & 63;
#pragma unroll
    for (int r = 0; r < 8; ++r) { YR[((size_t)(b * SEQ + i0 + r)) * 2048 + h * 512 + tid] = (bf16_t)f2bf(acc[r]); const float s = wave_sum(acc[r] * acc[r]); if (lane == 0) red[r * 8 + wid] = s; }
    __syncthreads();
    if (tid < 16) { const int r = tid >> 1, hf = tid & 1; const float s = (red[r * 8 + hf * 4] + red[r * 8 + hf * 4 + 1]) + (red[r * 8 + hf * 4 + 2] + red[r * 8 + hf * 4 + 3]);
        SSQ[((size_t)(b * SEQ + i0 + r)) * 8 + h * 2 + hf] = s; }
    __syncthreads();
}

__device__ __forceinline__ void p5_naive_item(bf16_t* AQ, const bf16_t* AK, const bf16_t* AV, float* ldsf, int item, int tid) {
    const int rb = item & 255, head = (item >> 8) & 7, b = item >> 11, g = head >> 2, i0 = rb * 8;
    float* qs = ldsf; float* sc = ldsf + 1024;
    for (int t = tid; t < 1024; t += NTHR) { const int r = t >> 7, d = t & 127; qs[t] = bf2f(AQ[((size_t)(b * SEQ + i0 + r)) * 1024 + head * 128 + d]); }
    __syncthreads();
    for (int p = tid; p < LT; p += NTHR) {
        const bf16_t* kr = AK + ((size_t)(b * LT + p)) * 256 + g * 128;
        float dot[8];
#pragma unroll
        for (int r = 0; r < 8; ++r) dot[r] = 0.f;
        for (int d8 = 0; d8 < 16; ++d8) { float kk[8]; unpack8(*(const v4u*)(kr + d8 * 8), kk);
#pragma unroll
            for (int r = 0; r < 8; ++r)
#pragma unroll
                for (int k = 0; k < 8; ++k) dot[r] += qs[r * 128 + d8 * 8 + k] * kk[k]; }
#pragma unroll
        for (int r = 0; r < 8; ++r) sc[r * LT + p] = dot[r] * 0.08838834764831845f;
    }
    __syncthreads();
    { const int wid = tid >> 6, lane = tid & 63; float* row = sc + wid * LT; float m = -1e30f;
      for (int p = lane; p < LT; p += 64) m = fmaxf(m, row[p]);
#pragma unroll
      for (int o = 1; o < 64; o <<= 1) m = fmaxf(m, __shfl_xor(m, o));
      float s = 0.f;
      for (int p = lane; p < LT; p += 64) { const float ex = expf(row[p] - m); row[p] = ex; s += ex; }
      s = wave_sum(s); const float inv = 1.0f / s;
      for (int p = lane; p < LT; p += 64) row[p] *= inv; }
    __syncthreads();
    const int e = tid & 127, r0 = (tid >> 7) * 2; float a0 = 0.f, a1 = 0.f;
    const bf16_t* vp = AV + (size_t)(b * LT) * 256 + g * 128 + e;
    for (int p = 0; p < LT; ++p) { const float v = bf2f(vp[(size_t)p * 256]); a0 += sc[r0 * LT + p] * v; a1 += sc[(r0 + 1) * LT + p] * v; }
    AQ[((size_t)(b * SEQ + i0 + r0)) * 1024 + head * 128 + e] = (bf16_t)f2bf(a0);
    AQ[((size_t)(b * SEQ + i0 + r0 + 1)) * 1024 + head * 128 + e] = (bf16_t)f2bf(a1);
    __syncthreads();
}

#if MK_BARRIER == 1
struct GridBarF { XcdBarrier b; __device__ __forceinline__ void operator()() const { xcd_barrier(b); } };
#else
struct GridBarF { __device__ __forceinline__ void operator()() const { cooperative_groups::this_grid().sync(); } };
#endif
__device__ __forceinline__ void ssq_item(const bf16_t* YR, float* SSQ, int it, int lane) {
    const int row = it >> 2, head = it & 3; float t[8]; unpack8(*(const v4u*)(YR + (size_t)row * 2048 + head * 512 + lane * 8), t);
    float ss = 0.f;
#pragma unroll
    for (int k = 0; k < 8; ++k) ss += t[k] * t[k];
    ss = wave_sum(ss);
    if (lane == 0) { SSQ[(size_t)row * 8 + head * 2] = ss; SSQ[(size_t)row * 8 + head * 2 + 1] = 0.f; }
}
__global__ void __launch_bounds__(NTHR, 2) mk_fwd(Args args) {
    extern __shared__ __attribute__((aligned(16))) unsigned char lds[];
    const int tid = threadIdx.x, lane = tid & 63, wave = __builtin_amdgcn_readfirstlane(tid >> 6);
    const int G = gridDim.x, bid = blockIdx.x;
    const int gw = bid * NWAVES + wave, NGW = G * NWAVES;
    float* ldsf = (float*)lds;
    unsigned char* ws = args.ws;
    const float *x = args.in[0], *cvec = args.in[1], *ctx = args.in[2], *c_ctx = args.in[3], *norm_w = args.in[4], *w_ada = args.in[5], *b_ada = args.in[6], *w_in = args.in[7],
                *l2d = args.in[8], *q_norm_w = args.in[9], *k_norm_w = args.in[10], *w_o_ret = args.in[11], *w_o_att = args.in[12], *w_out = args.in[13];
    float* MOD = (float*)(ws + WS_MOD); float* ROPE = (float*)(ws + WS_ROPE); float* SSQ = (float*)(ws + WS_SSQ);
    bf16_t *WIN = (bf16_t*)(ws + WS_WIN), *WOR = (bf16_t*)(ws + WS_WOR), *WOA = (bf16_t*)(ws + WS_WOA), *WOUT = (bf16_t*)(ws + WS_WOUT), *HX = (bf16_t*)(ws + WS_HX);
    bf16_t *RK = (bf16_t*)(ws + WS_RK), *RV = (bf16_t*)(ws + WS_RV), *RQ = (bf16_t*)(ws + WS_RQ), *AK = (bf16_t*)(ws + WS_AK), *AV = (bf16_t*)(ws + WS_AV), *AQ = (bf16_t*)(ws + WS_AQ);
    bf16_t *U1 = (bf16_t*)(ws + WS_U1), *U2 = (bf16_t*)(ws + WS_U2), *YR = (bf16_t*)args.out;
    const int lo = args.ph_lo, hi = args.ph_hi;
#define IN(k) (lo <= (k) && (k) < hi)
#define BOTH(k) (IN(k) && IN((k) + 1))
    if (tid < 32) ((LAS unsigned*)(lds + MISC_OFF))[tid] = 0u;
    __syncthreads();
#if MK_BARRIER == 1
    XcdBarrier bar; bar.bar = (unsigned*)(ws + WS_CTL) + CW_BAR; bar.x = 0; bar.st = nullptr;
    if (hi - lo > 1) bar = xcd_barrier_post((unsigned*)(ws + WS_CTL) + CW_BAR, (volatile LAS unsigned*)(lds + MISC_OFF) + 8);
#define GRID_BAR() xcd_barrier(bar)
#else
#define GRID_BAR() cooperative_groups::this_grid().sync()
#endif

#if MK_STAMP_A >= 0
#define STAMP(k) do { if (bid == 0 && tid == 0) { if ((k) == MK_STAMP_A) ((volatile LAS unsigned*)(lds + MISC_OFF))[17] = (unsigned)__builtin_amdgcn_s_memrealtime(); if ((k) == MK_STAMP_B) ((volatile LAS unsigned*)(lds + MISC_OFF))[18] = (unsigned)__builtin_amdgcn_s_memrealtime(); } } while (0)
#else
#define STAMP(k) do { } while (0)
#endif
#define STAGGER() do { if (MK_NSTAG > 1) { const unsigned grp = ((unsigned)bid >> 3) % MK_NSTAG; const unsigned long long t0_ = __builtin_amdgcn_s_memrealtime(); \
        while (__builtin_amdgcn_s_memrealtime() - t0_ < (unsigned long long)grp * MK_STAG_TICKS) __builtin_amdgcn_s_sleep(16); } } while (0)
    STAMP(0);
    if (IN(0)) {
        for (int it = bid; it < 192; it += G) p0_mod_item(cvec, c_ctx, w_ada, b_ada, MOD, ldsf, it, tid);
        if (bid == G - 1) for (int t = tid; t < 2048; t += NTHR) { const int v = t >> 5, i = t & 31; double fd = 1.0; for (int k = 0; k < i; ++k) fd *= 0.7498942093324559;
            const float ang = (float)v * (float)fd; float cs, sn; sincos_d((double)ang, cs, sn); ROPE[2 * t] = cs; ROPE[2 * t + 1] = sn; }
        if (BOTH(0)) GRID_BAR();
    }
    STAMP(1);
    if (IN(1)) {
        {
        float* scr = ldsf + wave * (64 * 65);
        constexpr int I_IN = 16 * (NIN / 64), I_OR = 32 * 16, I_OA = 16 * 16, I_OUT = 16 * 16;
        for (int it = gw; it < I_IN + I_OR + I_OA + I_OUT; it += NGW) {
            int r = it;
            if (r < I_IN) { const int n0 = 64 * (r % (NIN / 64)); p0_transpose64_item(w_in, 1024, NIN, WIN, new_col(n0) - n0, scr, r, lane); continue; } r -= I_IN;
            if (r < I_OR) { p0_transpose64_item(w_o_ret, 2048, 1024, WOR, 0, scr, r, lane); continue; } r -= I_OR;
            if (r < I_OA) { p0_transpose64_item(w_o_att, 1024, 1024, WOA, 0, scr, r, lane); continue; } r -= I_OA;
            p0_transpose64_item(w_out, 1024, 1024, WOUT, 0, scr, r, lane);
        }
        }
        {
            const int rpw = (MALL + NGW - 1) / NGW, m0 = gw * rpw, m1 = m0 + rpw < MALL ? m0 + rpw : MALL;
            v4f nwv[4];
#pragma unroll
            for (int j = 0; j < 4; ++j) nwv[j] = ((const v4f*)norm_w)[lane + 64 * j];
            for (int m = m0; m < m1; m += 9) p1_rowsN<9>(x, ctx, MOD, nwv, HX, m, m1 - 1, lane);
        }
        if (BOTH(1)) GRID_BAR();
    }
    STAMP(2);
    if (IN(2)) {
        STAGGER();
        pg8::Gemm g{HX, WIN, MALL, N1, 1024}; pg8::Sched1 S; S.init(G, bid);
        pg8::Epi1 E{RK, RV, AK, AV, RQ, AQ, nullptr};
#if MK_P2PROBE == 4
        { pg8::Epi1T<2> EC{RK, RV, AK, AV, RQ, AQ, nullptr}; pg8::gemm_phase<pg8::Epi1T<2>, pg8::Sched1, true, true, MK_EPIW>((PG8_LAS unsigned char*)lds, g, S, EC); }
        __syncthreads();
#endif
        for (int rep = 0; rep < MK_REP_P2; ++rep) pg8::gemm_phase<pg8::Epi1, pg8::Sched1, true, true, MK_EPIW>((PG8_LAS unsigned char*)lds, g, S, E);
#if MK_P2PROBE == 1
        { pg8::Epi1T<1> ED{RK, RV, AK, AV, RQ, AQ, (bf16_t*)(ws + WS_END)}; pg8::gemm_phase<pg8::Epi1T<1>, pg8::Sched1, true, true, MK_EPIW>((PG8_LAS unsigned char*)lds, g, S, ED); }
#endif
#if MK_P2PROBE == 3
        { pg8::Epi1T<0> ER{RK, RV, AK, AV, RQ, AQ, nullptr}; pg8::gemm_phase<pg8::Epi1T<0>, pg8::Sched1, true, true, MK_EPIW>((PG8_LAS unsigned char*)lds, g, S, ER); }
#endif
#if MK_P2PROBE == 2
        { pg8::EpiNull EN; pg8::gemm_phase<pg8::EpiNull, pg8::Sched1, true, true, 0>((PG8_LAS unsigned char*)lds, g, S, EN); }
#endif
        if (BOTH(2)) GRID_BAR();
    }
    STAMP(3);
#if MK_NAIVE_ATTN
    if (IN(3)) {
        constexpr size_t IQ = (size_t)MLAT * 1024 / 512, IK = (size_t)NB * LT * 256 / 512;
        for (size_t it = gw; it < IQ + IK; it += NGW) {
            if (it < IQ) p3_item(AQ, 10, false, q_norm_w, ROPE, it, lane); else p3_item(AK, 8, true, k_norm_w, ROPE, it - IQ, lane);
        }
        if (BOTH(3)) GRID_BAR();
    }
#endif
#if MK_DEBUG_ATTN
    {
        bf16_t* AQ2 = (bf16_t*)(ws + WS_RK); float* acc2 = (float*)(ws + WS_CTL) + 64;
        for (size_t i = (size_t)bid * NTHR + tid; i < (size_t)MLAT * 1024 / 8; i += (size_t)G * NTHR) ((v4u*)AQ2)[i] = ((const v4u*)AQ)[i];
        { int tl = threadIdx.x; asm volatile("" : "+v"(tl)); const int lane_l = tl & 63, gw_l = bid * NWAVES + (tl >> 6);
          constexpr size_t IK = (size_t)NB * LT * 256 / 512; for (size_t it = gw_l; it < IK; it += NGW) p3_item(AK, 8, true, k_norm_w, ROPE, it, lane_l); }
        GRID_BAR();
        { int tl = threadIdx.x; asm volatile("" : "+v"(tl)); const int lane_l = tl & 63, gw_l = bid * NWAVES + (tl >> 6);
          constexpr size_t IQ = (size_t)MLAT * 1024 / 512; for (size_t it = gw_l; it < IQ; it += NGW) p3_item(AQ2, 10, false, q_norm_w, ROPE, it, lane_l); }
        GRID_BAR();
        { const int vcu = (bid & 7) * (G >> 3) + (bid >> 3);
          for (int idx = vcu; idx < NB * AH * 8; idx += G) { const int qb = idx & 7, r = (idx >> 3) & 3, g = (idx >> 5) & 1, b = idx >> 6, head = g * 4 + r;
            bf16_t* Q = AQ + ((size_t)(b * SEQ + qb * 256)) * 1024 + head * 128; const bf16_t* K = AK + (size_t)(b * LT) * 256 + g * 128; const bf16_t* V = AV + (size_t)(b * LT) * 256 + g * 128;
            attn::attn_dense_body<attn::bf16>(Q, K, V, Q, LT, (char*)lds, q_norm_w, ROPE, qb * 256); } }
        __syncthreads();
        { const int vcu = (bid & 7) * (G >> 3) + (bid >> 3);
          for (int idx = vcu; idx < NB * AH * 8; idx += G) { const int qb = idx & 7, r = (idx >> 3) & 3, g = (idx >> 5) & 1, b = idx >> 6, head = g * 4 + r;
            bf16_t* Q = AQ2 + ((size_t)(b * SEQ + qb * 256)) * 1024 + head * 128; const bf16_t* K = AK + (size_t)(b * LT) * 256 + g * 128; const bf16_t* V = AV + (size_t)(b * LT) * 256 + g * 128;
            attn::attn_dense_body<attn::bf16>(Q, K, V, Q, LT, (char*)lds, nullptr, ROPE, qb * 256); } }
        GRID_BAR();
        float sd = 0.f, sb = 0.f;
        for (size_t i = (size_t)bid * NTHR + tid; i < (size_t)MLAT * 1024; i += (size_t)G * NTHR) { const float a = bf2f(AQ[i]), b2 = bf2f(AQ2[i]); sd += (a - b2) * (a - b2); sb += b2 * b2; }
        sd = wave_sum(sd); sb = wave_sum(sb);
        if (lane == 0) { atomicAdd(acc2, sd); atomicAdd(acc2 + 1, sb); }
        GRID_BAR();
        if (bid == 0 && tid == 0) { const float s0 = __hip_atomic_load(acc2, __ATOMIC_RELAXED, __HIP_MEMORY_SCOPE_AGENT), s1 = __hip_atomic_load(acc2 + 1, __ATOMIC_RELAXED, __HIP_MEMORY_SCOPE_AGENT);
            args.out[0] = 1e6f * sqrtf(s0 / s1); args.out[1] = 1e3f * sqrtf(s1 / ((float)MLAT * 1024.f)); }
        return;
    }
#endif
    STAMP(4);
#if MK_DEBUG_RET
    {
        bf16_t* YR2 = (bf16_t*)(ws + WS_AQ); float* acc2 = (float*)(ws + WS_CTL) + 64;
        for (int it = bid; it < 8 * RH * 256; it += G) p4_naive_item(RQ, RK, RV, YR, SSQ, l2d, ldsf, it, tid);
        __syncthreads();
        { GridBarF gb{bar}; ret::scan_unit(RQ, RK, RV, YR2, SSQ + 2 * MLAT * 8, l2d, (LAS unsigned char*)lds, bid, gb, 8); }
        GRID_BAR();
        float sd = 0.f, sb = 0.f;
        for (size_t i = (size_t)bid * NTHR + tid; i < (size_t)8 * SEQ * 2048; i += (size_t)G * NTHR) { const int l = (int)((i >> 11) & 2047); if (l < MK_DBG_L0 || l >= MK_DBG_L1 || (int)((i >> 9) & 3) != MK_DBG_H) continue; const float a = bf2f(YR2[i]), b2 = bf2f(YR[i]); sd += (a - b2) * (a - b2); sb += b2 * b2; }
        sd = wave_sum(sd); sb = wave_sum(sb);
        if (lane == 0) { atomicAdd(acc2, sd); atomicAdd(acc2 + 1, sb); }
        GRID_BAR();
        if (bid == 0 && tid == 0) { const float s0 = __hip_atomic_load(acc2, __ATOMIC_RELAXED, __HIP_MEMORY_SCOPE_AGENT), s1 = __hip_atomic_load(acc2 + 1, __ATOMIC_RELAXED, __HIP_MEMORY_SCOPE_AGENT);
            ((float*)(ws + WS_SSQ))[0] = 1e6f * sqrtf(s0 / s1); ((float*)(ws + WS_SSQ))[1] = 1e3f * sqrtf(s1 / (8.f * SEQ * 2048.f)); }
        GRID_BAR();
        if (bid == 0 && tid == 0) { args.out[0] = ((float*)(ws + WS_SSQ))[0]; args.out[1] = ((float*)(ws + WS_SSQ))[1]; }
        return;
    }
#endif
    if (IN(4)) {
        auto kfix = [&]() {
#if !MK_NAIVE_ATTN
          int tl = threadIdx.x; asm volatile("" : "+v"(tl)); const int lane_l = tl & 63, gw_l = bid * NWAVES + (tl >> 6);
          constexpr size_t IK = (size_t)NB * LT * 256 / 512; const size_t ipw = (IK + NGW - 1) / NGW, i0 = (size_t)gw_l * ipw, i1 = i0 + ipw < IK ? i0 + ipw : IK;
          for (size_t it = i0; it < i1; it += 3) p3_items_k<3>(AK, k_norm_w, ROPE, it, i1, lane_l, ws + WS_K8);
#endif
        };
#if MK_NAIVE_RET
        kfix(); for (int it = bid; it < NB * RH * 256; it += G) p4_naive_item(RQ, RK, RV, YR, SSQ, l2d, ldsf, it, tid);
#else
        if (G == 256) { GridBarF gb{bar}; ret::scan_unit(RQ, RK, RV, YR, SSQ, l2d, (LAS unsigned char*)lds, bid, gb, NB, kfix); if (MK_MIX && BOTH(4)) GRID_BAR(); }
        else { kfix(); for (int it = bid; it < NB * RH * 256; it += G) p4_naive_item(RQ, RK, RV, YR, SSQ, l2d, ldsf, it, tid); if (BOTH(4)) GRID_BAR(); }
#endif
    }
    STAMP(5);
    if (IN(5)) {
#if MK_NAIVE_ATTN
        for (int it = bid; it < NB * AH * 256; it += G) p5_naive_item(AQ, AK, AV, ldsf, it, tid);
#else
        const int vcu = (G % 8 == 0) ? (bid & 7) * (G >> 3) + (bid >> 3) : bid;
#define ATT_UNIT(idx_, Q_, K_, V_, qb_) const int qb_ = (idx_) & 7; bf16_t* Q_; const bf16_t *K_, *V_; \
            { const int r_ = ((idx_) >> 3) & 3, g_ = ((idx_) >> 5) & 1, b_ = (idx_) >> 6, head_ = g_ * 4 + r_; Q_ = AQ + ((size_t)(b_ * SEQ + qb_ * 256)) * 1024 + head_ * 128; \
              K_ = MK_FP8K ? (const bf16_t*)(ws + WS_K8 + ((size_t)(b_ * LT) * 256 + g_ * 128)) : AK + (size_t)(b_ * LT) * 256 + g_ * 128; V_ = AV + (size_t)(b_ * LT) * 256 + g_ * 128; }
        auto run_attn = [&](const int nkeys, const bool store) {
        attn::Pre pre;
        if (vcu < NB * AH * 8) { ATT_UNIT(vcu, Q0, K0, V0, qb0); attn::attn_prefetch(Q0, K0, V0, pre); }
        for (int idx = vcu; idx < NB * AH * 8; idx += G) {
            ATT_UNIT(idx, Q, K, V, qb);
            const int nidx = idx + G; const bool hn = nidx < NB * AH * 8; ATT_UNIT(hn ? nidx : idx, Qn, Kn, Vn, qbn);
            attn::attn_dense_body<attn::bf16>(Q, K, V, store ? Q : (bf16_t*)nullptr, nkeys, (char*)lds, q_norm_w, ROPE, qb * 256, pre, Qn, Kn, Vn); __syncthreads();
        } };
#if MK_MIX
        auto run_gates = [&](int mode) { pg8::Gemm g{HX, WIN + (size_t)N1 * 1024, MLAT, NG, 1024}; pg8::SchedGates S; S.init(G, bid, mode); pg8::Epi5 E{YR, AQ, U1, U2, SSQ, 0};
            pg8::gemm_phase<pg8::Epi5, pg8::SchedGates, true, true, MK_EPIW>((PG8_LAS unsigned char*)lds, g, S, E); };
        const bool attn_first = (bid & 4) == 0;
        if (attn_first) { run_attn(LT, true); __syncthreads(); run_gates(0); } else { run_gates(0); __syncthreads(); run_attn(LT, true); }
        __syncthreads(); GRID_BAR(); run_gates(1);
#else
        for (int rep = 0; rep < (MK_ATTN_PROBE > 0 ? 2 : 1); ++rep) run_attn(rep ? MK_ATTN_PROBE : LT, rep == 0);
#endif
#undef ATT_UNIT
#endif
#if !MK_NAIVE_RET
        if (G != 256) { int tl = threadIdx.x; asm volatile("" : "+v"(tl)); const int lane_l = tl & 63, gw_l = bid * NWAVES + (tl >> 6);
          for (int it = gw_l; it < MLAT * 4; it += NGW) ssq_item(YR, SSQ, it, lane_l); }
#endif
        if (BOTH(5)) GRID_BAR();
    }
    STAMP(6);
    if (IN(6) && !MK_MIX) {
        STAGGER();
        pg8::Gemm g{HX, WIN + (size_t)N1 * 1024, MLAT, NG, 1024}; pg8::StaticOrder S; S.init(MLAT, NG, G, bid);
        pg8::Epi5 E{YR, AQ, U1, U2, SSQ, 0};
        pg8::gemm_phase<pg8::Epi5, pg8::StaticOrder, true, true, MK_EPIW>((PG8_LAS unsigned char*)lds, g, S, E);
        if (BOTH(6)) GRID_BAR();
    }
    STAMP(7);
    if (IN(7)) {
        pg8::Gemm g{YR, WOR, MLAT, 1024, 2048}; pg8::StaticOrder S; S.init(MLAT, 1024, G, bid);
        pg8::Epi6 E{U1};
        pg8::gemm_phase<pg8::Epi6, pg8::StaticOrder, true, true, MK_EPIW>((PG8_LAS unsigned char*)lds, g, S, E);
    }
    STAMP(8);
    if (IN(8)) {
        pg8::Gemm g{AQ, WOA, MLAT, 1024, 1024}; pg8::StaticOrder S; S.init(MLAT, 1024, G, bid);
        pg8::Epi7 E{U1, U2};
        pg8::gemm_phase<pg8::Epi7, pg8::StaticOrder, true, true, MK_EPIW>((PG8_LAS unsigned char*)lds, g, S, E);
        if (BOTH(8)) GRID_BAR();
    }
    STAMP(9);
    if (IN(9)) {
        pg8::Gemm g{U1, WOUT, MLAT, 1024, 1024}; pg8::StaticOrder S; S.init(MLAT, 1024, G, bid);
        pg8::Epi8 E{x, MOD, args.out};
        { pg8::RepOrder SR; SR.so = S; SR.reps = MK_REP_P9; pg8::gemm_phase<pg8::Epi8, pg8::RepOrder, true, true, MK_EPIW>((PG8_LAS unsigned char*)lds, g, SR, E); }
    }
    STAMP(10);
#if MK_TIMING
    if (bid == 0) { const unsigned spin = __builtin_amdgcn_readfirstlane(((const unsigned*)SSQ - 64)[MK_TSEL]); const unsigned long long t0_ = __builtin_amdgcn_s_memrealtime();
        while (__builtin_amdgcn_s_memrealtime() - t0_ < (unsigned long long)spin) __builtin_amdgcn_s_sleep(8); }
#endif
#if MK_STAMP_A >= 0
    __syncthreads();
    if (bid == 0) { __syncthreads(); const unsigned sp = ((volatile LAS unsigned*)(lds + MISC_OFF))[18] - ((volatile LAS unsigned*)(lds + MISC_OFF))[17]; const unsigned long long t0_ = __builtin_amdgcn_s_memrealtime();
        while (__builtin_amdgcn_s_memrealtime() - t0_ < (unsigned long long)sp) __builtin_amdgcn_s_sleep(8); }
#endif
#undef IN
#undef BOTH
}

extern "C" void kernel_launch(void* const* d_in, const int* in_sizes, int n_in, void* d_out, int out_size, void* d_ws, size_t ws_size, hipStream_t stream) {
    static int grid = 0;
    if (grid == 0) {
        if (n_in != 14 || in_sizes[0] != MLAT * DM || out_size != MLAT * DM || ws_size < WS_END) {
            fprintf(stderr, "kernel_launch: unexpected shapes: n_in %d in0 %d out %d ws %zu (need >= %zu)\n", n_in, n_in > 0 ? in_sizes[0] : -1, out_size, ws_size, (size_t)WS_END); grid = -1; return; }
        int dev = 0, cus = 0;
        if (hipGetDevice(&dev) != hipSuccess || hipDeviceGetAttribute(&cus, hipDeviceAttributeMultiprocessorCount, dev) != hipSuccess) { grid = -1; return; }
        if (hipFuncSetAttribute((const void*)mk_fwd, hipFuncAttributeMaxDynamicSharedMemorySize, LDS_BYTES) != hipSuccess) { fprintf(stderr, "kernel_launch: hipFuncSetAttribute failed\n"); grid = -1; return; }
        grid = cus;
    }
    if (grid < 0) return;
    Args a{};
    for (int i = 0; i < 14; ++i) a.in[i] = (const float*)d_in[i];
    a.out = (float*)d_out; a.ws = (unsigned char*)d_ws;
#if MK_ONE_LAUNCH
    a.ph_lo = 0; a.ph_hi = N_PHASES;
#if MK_BARRIER == 1
    if (hipMemsetAsync((char*)d_ws + WS_CTL, 0, CTL_ZERO_BYTES, stream) != hipSuccess) { fprintf(stderr, "kernel_launch: hipMemsetAsync failed\n"); return; }
    hipLaunchKernelGGL(mk_fwd, dim3(grid), dim3(NTHR), LDS_BYTES, stream, a);
#else
    void* kargs[] = {&a};
    const hipError_t ce = hipLaunchCooperativeKernel((const void*)mk_fwd, dim3(grid), dim3(NTHR), kargs, LDS_BYTES, stream);
    if (ce != hipSuccess) fprintf(stderr, "kernel_launch: cooperative launch failed: %s\n", hipGetErrorName(ce));
#endif
#else
    for (int ph = 0; ph < N_PHASES; ++ph) {
        a.ph_lo = ph; a.ph_hi = ph + 1;
        hipLaunchKernelGGL(mk_fwd, dim3(grid), dim3(NTHR), LDS_BYTES, stream, a);
    }
#endif
    const hipError_t le = hipPeekAtLastError();
    if (le != hipSuccess) fprintf(stderr, "kernel_launch: launch failed: %s\n", hipGetErrorName(le));
}
```

```cpp
#include <hip/hip_runtime.h>
#include <cstdio>
#include <cstdint>
#include <hip/hip_cooperative_groups.h>

constexpr int NB = 16, SEQ = 2048, DM = 1024, LC = 256, LT = LC + SEQ;
constexpr int MLAT = NB * SEQ, MCTX = NB * LC, MALL = MLAT + MCTX;
constexpr int RH = 4, RDK = 256, RDV = 512;
constexpr int AH = 8, AKV = 2, AHD = 128;
constexpr int NIN = 10752, NKV = 3584, N1 = 5632, NG = 5120;
constexpr float EPS = 1e-6f;
#ifndef MK_TIMING
#define MK_TIMING 0
#define MK_TSEL 0
#endif
#ifndef MK_WT
#define MK_WT 1
#endif
#ifndef MK_WT_AUX
#define MK_WT_AUX 18
#endif
#ifndef MK_FP8K
#define MK_FP8K 1
#endif
#ifndef MK_FP8V
#define MK_FP8V 1
#endif
#ifndef MK_E6B
#define MK_E6B 4
#define MK_E7B 2
#define MK_E8B 2
#endif
#ifndef MK_E5B
#define MK_E5B 1
#endif
#ifndef MK_P2PROBE
#define MK_P2PROBE 0
#endif
#ifndef MK_RPROBE
#define MK_RPROBE 0
#endif
#ifndef MK_DBG_NOCTX
#define MK_DBG_NOCTX 0
#endif
constexpr int NWAVES = 8, NTHR = 512;
#define LAS __attribute__((address_space(3)))

typedef unsigned short bf16_t;
typedef unsigned v4u __attribute__((ext_vector_type(4)));
typedef unsigned v2u __attribute__((ext_vector_type(2)));
typedef float v4f __attribute__((ext_vector_type(4)));
typedef float v2f __attribute__((ext_vector_type(2)));

__device__ __forceinline__ float bf2f(unsigned h) { return __uint_as_float(h << 16); }
__device__ __forceinline__ unsigned f2bf(float f) { unsigned u = __float_as_uint(f); return (u + 0x7fffu + ((u >> 16) & 1u)) >> 16; }
__device__ __forceinline__ unsigned pk2(float lo, float hi) { return f2bf(lo) | (f2bf(hi) << 16); }
__device__ __forceinline__ float bflo(unsigned w) { return __uint_as_float(w << 16); }
__device__ __forceinline__ float bfhi(unsigned w) { return __uint_as_float(w & 0xffff0000u); }
__device__ __forceinline__ float fast_sigmoid(float x) { return __builtin_amdgcn_rcpf(1.0f + __builtin_amdgcn_exp2f(-1.4426950408889634f * x)); }
__device__ __forceinline__ float fast_silu(float x) { return x * fast_sigmoid(x); }
__device__ __forceinline__ void sigmoid4(const float (&x)[4], float (&s)[4]) {
    float a[4];
#pragma unroll
    for (int k = 0; k < 4; ++k) a[k] = 1.0f + __builtin_amdgcn_exp2f(-1.4426950408889634f * fmaxf(x[k], -20.0f));
    const float p01 = a[0] * a[1], p23 = a[2] * a[3], r = __builtin_amdgcn_rcpf(p01 * p23), r01 = r * p23, r23 = r * p01;
    s[0] = r01 * a[1]; s[1] = r01 * a[0]; s[2] = r23 * a[3]; s[3] = r23 * a[2];
}
__device__ __forceinline__ float wave_sum(float v) {
#pragma unroll
    for (int o = 1; o < 64; o <<= 1) v += __shfl_xor(v, o);
    return v;
}

typedef __bf16 bf16x2_t __attribute__((ext_vector_type(2)));
__device__ __forceinline__ unsigned cvt_pk_bf16(float lo, float hi) { v2f v = {lo, hi}; bf16x2_t b = __builtin_convertvector(v, bf16x2_t); return __builtin_bit_cast(unsigned, b); }
__device__ __forceinline__ void unpack8(const v4u w, float (&o)[8]) {
    o[0] = bflo(w.x); o[1] = bfhi(w.x); o[2] = bflo(w.y); o[3] = bfhi(w.y); o[4] = bflo(w.z); o[5] = bfhi(w.z); o[6] = bflo(w.w); o[7] = bfhi(w.w);
}
__device__ __forceinline__ v4u pack8(const float (&o)[8]) {
    v4u w; w.x = cvt_pk_bf16(o[0], o[1]); w.y = cvt_pk_bf16(o[2], o[3]); w.z = cvt_pk_bf16(o[4], o[5]); w.w = cvt_pk_bf16(o[6], o[7]); return w;
}

constexpr size_t MiB = 1u << 20;
constexpr size_t WS_CTL = 0;
constexpr size_t WS_MOD = 1 * MiB;
constexpr size_t WS_ROPE = WS_MOD + 256 * 1024;
constexpr size_t WS_SSQ = 2 * MiB;
constexpr size_t WS_WIN = 4 * MiB;
constexpr size_t WS_WOR = 25 * MiB;
constexpr size_t WS_WOA = 29 * MiB;
constexpr size_t WS_WOUT = 31 * MiB;
constexpr size_t WS_HX = 33 * MiB;
constexpr size_t WS_RK = 105 * MiB;
constexpr size_t WS_RV = 177 * MiB;
constexpr size_t WS_RQ = 321 * MiB;
constexpr size_t WS_AK = 385 * MiB;
constexpr size_t WS_AV = 403 * MiB;
constexpr size_t WS_AQ = 421 * MiB;
constexpr size_t WS_K8 = 485 * MiB;
constexpr size_t WS_VT8 = 495 * MiB;
constexpr size_t WS_END = 505 * MiB;
constexpr size_t WS_U1 = WS_RK;
constexpr size_t WS_U2 = WS_RV;

__host__ __device__ __forceinline__ int orig_col(int n) { return n < 4608 ? n : (n < 5632 ? n + 2048 : (n < 7680 ? n - 1024 : n)); }
namespace pg8 {
#define PG8_LAS __attribute__((address_space(3)))
typedef unsigned short bf16_t;
typedef short bf16x8 __attribute__((ext_vector_type(8)));
typedef float f32x4 __attribute__((ext_vector_type(4)));
typedef unsigned u32x4 __attribute__((ext_vector_type(4)));
constexpr int BM = 256, BK = 64, HALF = 128, HTB = HALF * BK * 2  , STAGE_BYTES = 8 * HTB, NXCD = 8, WGM = 8;

__host__ __device__ __forceinline__ int lds_byte(int r, int c) { const int st = (r >> 4) * 2 + (c >> 5), rr = r & 15, cc = c & 31, ob = rr * 64 + cc * 2; return st * 1024 + (ob ^ (((ob >> 9) & 1) << 5)); }
__host__ __device__ __forceinline__ void stage_rc(int b, int& R, int& C) { const int st = b / 1024, sb = b % 1024, swz = sb ^ (((sb >> 9) & 1) << 5); R = (st >> 1) * 16 + swz / 64; C = (st & 1) * 32 + (swz % 64) / 2; }
__host__ __device__ __forceinline__ int perm32(int rho) { const int n = rho >> 4, i = rho & 15; return 8 * (i >> 2) + 4 * n + (i & 3); }

struct Unit { int pm, pn; };
struct Gemm { const bf16_t* A; const bf16_t* Bt; int M, N, K; };

struct StaticOrder {
    int nM, nN, nwg, G, c;
    __host__ __device__ void init(int M, int N, int G_, int c_) { nM = M / BM; nN = N / BM; nwg = nM * nN; G = G_; c = c_; }
    __host__ __device__ bool next(int i, Unit& u) const {
        const long L = (long)i * G + c; if (L >= nwg) return false;
        int wgid = (int)L; { const int q = nwg / NXCD, r = nwg % NXCD, xcd = wgid % NXCD, off = wgid / NXCD; wgid = (xcd < r ? xcd * (q + 1) : r * (q + 1) + (xcd - r) * q) + off; }
        const int nig = WGM * nN, gid = wgid / nig, fm = gid * WGM, gsz = (nM - fm) < WGM ? (nM - fm) : WGM;
        u.pm = fm + ((wgid % nig) % gsz); u.pn = (wgid % nig) / gsz; return true;
    }
    __device__ __forceinline__ void a_ready(const Unit&) const {}
    __device__ __forceinline__ void done(const Unit&) const {}
};


#if MK_WT
#define WT_RSRC(name, baseptr) const __amdgpu_buffer_rsrc_t name = __builtin_amdgcn_make_buffer_rsrc((void*)(baseptr), 0, 0x7ffffff0, 0x00020000)
#define WT_ST16(name, byteoff, val) __builtin_amdgcn_raw_buffer_store_b128((val), name, (unsigned)(byteoff), 0, MK_WT_AUX)
#endif
struct Sched1 {
    int G, c; StaticOrder so;
    __device__ void init(int G_, int c_) { G = G_; c = c_; so.init(MLAT, N1, G_, c_); }
    __device__ bool next(int i, Unit& u) const {
        long L = (long)i * G + c; if (L < 2816) return so.next(i, u);
        L -= 2816; if (L >= 224) return false;
        u.pm = 128 + (int)(L & 15); u.pn = (int)(L >> 4); return true;
    }
    __device__ __forceinline__ void a_ready(const Unit&) const {}
    __device__ __forceinline__ void done(const Unit&) const {}
};

struct SchedGates {
    StaticOrder so; int mode;
    __device__ void init(int G_, int c_, int mode_) { mode = mode_; so.init(MLAT, (mode_ ? 4 : 16) * 256, G_, c_); }
    __device__ bool next(int i, Unit& u) const { if (!so.next(i, u)) return false; u.pn = mode ? u.pn + 8 : (u.pn < 8 ? u.pn : u.pn + 4); return true; }
    __device__ __forceinline__ void a_ready(const Unit&) const {}
    __device__ __forceinline__ void done(const Unit&) const {}
};
struct RepOrder {
    StaticOrder so; int reps;
    __device__ bool next(int i, Unit& u) const { const int per = (so.nwg - so.c + so.G - 1) / so.G; if (i >= per * reps) return false; return so.next(i % per, u); }
    __device__ __forceinline__ void a_ready(const Unit&) const {}
    __device__ __forceinline__ void done(const Unit&) const {}
};

#define EPI_ROWS_BEGIN const int rt0 = wr * 64 + fr, ct0 = wc * 32 + 8 * fq; \
    _Pragma("unroll") for (int ai = 0; ai < 2; ++ai) _Pragma("unroll") for (int m = 0; m < 4; ++m) { const int rt = rt0 + ai * HALF + m * 16;
#define EPI_ROWS_END }

template <int DUM> struct Epi1T {
    static constexpr bool PERM = true, AFTER_DRAIN = false;
    bf16_t *RK, *RV, *AK, *AV, *RQ, *AQ; bf16_t* DUMMY;
    __device__ __forceinline__ void operator()(const f32x4 (&acc)[2][2][4][2], const Unit& u, int wr, int wc, int fr, int fq) const {
        const int pm = u.pm, pn = u.pn;
        const int kvrow0 = pm < 128 ? ((pm >> 3) * LT + LC + (pm & 7) * 256) : ((pm - 128) * LT);
        bf16_t* base; int ld; float sc = 1.f;
        if (pn < 4) { base = RK + (size_t)kvrow0 * 1024 + pn * 256; ld = 1024; sc = 0.0625f; }
        else if (pn < 12) { base = RV + (size_t)kvrow0 * 2048 + (pn - 4) * 256; ld = 2048; }
        else if (pn == 12) { base = AK + (size_t)kvrow0 * 256; ld = 256; }
        else if (pn == 13) { base = AV + (size_t)kvrow0 * 256; ld = 256; }
        else if (pn < 18) { base = RQ + (size_t)pm * 256 * 1024 + (pn - 14) * 256; ld = 1024; }
        else { base = AQ + (size_t)pm * 256 * 1024 + (pn - 18) * 256; ld = 1024; }
#if MK_P2PROBE
        if constexpr (DUM == 1) { base = DUMMY + (size_t)blockIdx.x * 32768; ld = 256; }
        if constexpr (DUM == 2) {
            const int rb = kvrow0 >> 8;
            if (pn < 4) base = RK + ((size_t)rb * 4 + pn) * 65536; else if (pn < 12) base = RV + ((size_t)rb * 8 + (pn - 4)) * 65536;
            else if (pn < 14) { } else if (pn < 18) base = RQ + ((size_t)pm * 4 + (pn - 14)) * 65536; else base = AQ + ((size_t)pm * 4 + (pn - 18)) * 65536;
            ld = 256; }
#endif
#if (MK_WT & 1)
        const __amdgpu_buffer_rsrc_t rs = __builtin_amdgcn_make_buffer_rsrc((void*)base, 0, 0x7ffffff0, 0x00020000);
#endif
        EPI_ROWS_BEGIN
            bf16_t* rowp = base + (size_t)(DUM == 1 ? (rt & 127) : rt) * ld + ct0;
#pragma unroll
            for (int bj = 0; bj < 2; ++bj) { const f32x4 v0 = acc[ai][bj][m][0] * sc, v1 = acc[ai][bj][m][1] * sc;
                u32x4 w; w.x = cvt_pk_bf16(v0[0], v0[1]); w.y = cvt_pk_bf16(v0[2], v0[3]); w.z = cvt_pk_bf16(v1[0], v1[1]); w.w = cvt_pk_bf16(v1[2], v1[3]);
#if (MK_WT & 1)
                __builtin_amdgcn_raw_buffer_store_b128(w, rs, (unsigned)(((DUM == 1 ? (rt & 127) : rt) * ld + ct0 + bj * HALF) * 2), 0, MK_WT_AUX);
#else
                *(u32x4*)(rowp + bj * HALF) = w;
#endif
                }
        EPI_ROWS_END
    }
};

typedef Epi1T<0> Epi1;
#define EPI_FOR_PIECES _Pragma("unroll") for (int ai = 0; ai < 2; ++ai) _Pragma("unroll") for (int m = 0; m < 4; ++m) _Pragma("unroll") for (int bj = 0; bj < 2; ++bj)
struct Epi5 {
    static constexpr bool PERM = true, AFTER_DRAIN = false;
    bf16_t *YR, *YA, *U1, *U2; const float* SSQ; int dry_unused;
    __device__ __forceinline__ void operator()(const f32x4 (&acc)[2][2][4][2], const Unit& u, int wr, int wc, int fr, int fq) const {
        const int pn = u.pn; const size_t row0 = (size_t)u.pm * 256;
        if (pn < 8) {
            const int head = pn >> 1;
            EPI_ROWS_BEGIN
                const size_t row = row0 + rt;
                const float ss = SSQ[row * 8 + head * 2] + SSQ[row * 8 + head * 2 + 1];
                const float rstd = __builtin_amdgcn_rsqf(ss * (1.0f / 512.0f) + EPS);
#pragma unroll
                for (int bj = 0; bj < 2; ++bj) { u32x4* p = (u32x4*)(YR + row * 2048 + pn * 256 + bj * HALF + ct0); float o[8]; unpack8(*p, o);
                    const f32x4 v0 = acc[ai][bj][m][0], v1 = acc[ai][bj][m][1];
                    { const float x0[4] = {v0[0], v0[1], v0[2], v0[3]}, x1[4] = {v1[0], v1[1], v1[2], v1[3]}; float s0[4], s1[4]; sigmoid4(x0, s0); sigmoid4(x1, s1);
#pragma unroll
                    for (int k = 0; k < 4; ++k) { o[k] = o[k] * rstd * (x0[k] * s0[k]); o[4 + k] = o[4 + k] * rstd * (x1[k] * s1[k]); } }
                    *p = pack8(o); }
            EPI_ROWS_END
        } else if (pn < 12) {
            EPI_ROWS_BEGIN
                const size_t row = row0 + rt;
#pragma unroll
                for (int bj = 0; bj < 2; ++bj) { u32x4* p = (u32x4*)(YA + row * 1024 + (pn - 8) * 256 + bj * HALF + ct0); float o[8]; unpack8(*p, o);
                    const f32x4 v0 = acc[ai][bj][m][0], v1 = acc[ai][bj][m][1];
                    { const float x0[4] = {v0[0], v0[1], v0[2], v0[3]}, x1[4] = {v1[0], v1[1], v1[2], v1[3]}; float s0[4], s1[4]; sigmoid4(x0, s0); sigmoid4(x1, s1);
#pragma unroll
                    for (int k = 0; k < 4; ++k) { o[k] = o[k] * (x0[k] * s0[k]); o[4 + k] = o[4 + k] * (x1[k] * s1[k]); } }
                    *p = pack8(o); }
            EPI_ROWS_END
        } else {
            bf16_t* U = pn < 16 ? U1 + (pn - 12) * 256 : U2 + (pn - 16) * 256;
            EPI_ROWS_BEGIN
                const size_t row = row0 + rt;
#pragma unroll
                for (int bj = 0; bj < 2; ++bj) { float o[8]; const f32x4 v0 = acc[ai][bj][m][0], v1 = acc[ai][bj][m][1];
                    { const float x0[4] = {v0[0], v0[1], v0[2], v0[3]}, x1[4] = {v1[0], v1[1], v1[2], v1[3]}; float s0[4], s1[4]; sigmoid4(x0, s0); sigmoid4(x1, s1);
#pragma unroll
                    for (int k = 0; k < 4; ++k) { o[k] = s0[k]; o[4 + k] = s1[k]; } }
                    *(u32x4*)(U + row * 1024 + bj * HALF + ct0) = pack8(o); }
            EPI_ROWS_END
        }
    }
};

struct Epi6 {
    static constexpr bool PERM = true, AFTER_DRAIN = false;
    bf16_t* U1;
    __device__ __forceinline__ void operator()(const f32x4 (&acc)[2][2][4][2], const Unit& u, int wr, int wc, int fr, int fq) const {
        bf16_t* base = U1 + ((size_t)u.pm * 256 + wr * 64 + fr) * 1024 + u.pn * 256 + wc * 32 + 8 * fq;
#if (MK_WT & 2)
        WT_RSRC(rs, U1 + (size_t)u.pm * 256 * 1024 + u.pn * 256);
#endif
#pragma unroll
        for (int ai = 0; ai < 2; ++ai)
#pragma unroll
          for (int mb = 0; mb < 4; mb += MK_E6B) {
            u32x4 pc[MK_E6B][2];
#pragma unroll
            for (int mi = 0; mi < MK_E6B; ++mi)
#pragma unroll
                for (int bj = 0; bj < 2; ++bj) pc[mi][bj] = *(const u32x4*)(base + (size_t)(ai * HALF + (mb + mi) * 16) * 1024 + bj * HALF);
#pragma unroll
            for (int mi = 0; mi < MK_E6B; ++mi)
#pragma unroll
                for (int bj = 0; bj < 2; ++bj) { const int m = mb + mi; float o[8]; unpack8(pc[mi][bj], o); const f32x4 v0 = acc[ai][bj][m][0], v1 = acc[ai][bj][m][1];
#pragma unroll
                    for (int k = 0; k < 4; ++k) { o[k] *= v0[k]; o[4 + k] *= v1[k]; }
                    *(u32x4*)(base + (size_t)(ai * HALF + m * 16) * 1024 + bj * HALF) = pack8(o); }
          }
    }
};
struct Epi7 {
    static constexpr bool PERM = true, AFTER_DRAIN = false;
    bf16_t* U1; const bf16_t* U2;
    __device__ __forceinline__ void operator()(const f32x4 (&acc)[2][2][4][2], const Unit& u, int wr, int wc, int fr, int fq) const {
        const size_t off0 = ((size_t)u.pm * 256 + wr * 64 + fr) * 1024 + u.pn * 256 + wc * 32 + 8 * fq;
#if (MK_WT & 4)
        WT_RSRC(rs, U1 + (size_t)u.pm * 256 * 1024 + u.pn * 256);
#endif
#pragma unroll
        for (int q4 = 0; q4 < 8; q4 += MK_E7B) {
            const int ai = q4 >> 2, mb = q4 & 3; u32x4 pc[MK_E7B][2], pg[MK_E7B][2];
#pragma unroll
            for (int m2 = 0; m2 < MK_E7B; ++m2)
#pragma unroll
                for (int bj = 0; bj < 2; ++bj) { const size_t off = off0 + (size_t)(ai * HALF + (mb + m2) * 16) * 1024 + bj * HALF; pc[m2][bj] = *(const u32x4*)(U1 + off); pg[m2][bj] = *(const u32x4*)(U2 + off); }
#pragma unroll
            for (int m2 = 0; m2 < MK_E7B; ++m2)
#pragma unroll
                for (int bj = 0; bj < 2; ++bj) { const int m = mb + m2; const size_t off = off0 + (size_t)(ai * HALF + m * 16) * 1024 + bj * HALF; float o[8], g[8]; unpack8(pc[m2][bj], o); unpack8(pg[m2][bj], g);
                    const f32x4 v0 = acc[ai][bj][m][0], v1 = acc[ai][bj][m][1];
#pragma unroll
                    for (int k = 0; k < 4; ++k) { o[k] += g[k] * v0[k]; o[4 + k] += g[4 + k] * v1[k]; }
                    *(u32x4*)(U1 + off) = pack8(o); }
        }
    }
};
struct Epi8 {
    static constexpr bool PERM = true, AFTER_DRAIN = false;
    const float* X; const float* MOD; float* OUT;
    __device__ __forceinline__ void operator()(const f32x4 (&acc)[2][2][4][2], const Unit& u, int wr, int wc, int fr, int fq) const {
        const int col0 = u.pn * 256 + wc * 32 + 8 * fq; const size_t off0 = ((size_t)u.pm * 256 + wr * 64 + fr) * 1024 + col0; const float* gate = MOD + (size_t)(u.pm >> 3) * 3072 + 2048 + col0;
        f32x4 gv[2][2];
#if (MK_WT & 8)
        WT_RSRC(rs, OUT + (size_t)u.pm * 256 * 1024 + u.pn * 256);
#endif
#pragma unroll
        for (int bj = 0; bj < 2; ++bj)
#pragma unroll
            for (int n = 0; n < 2; ++n) gv[bj][n] = *(const f32x4*)(gate + bj * HALF + 4 * n);
#pragma unroll
        for (int q4 = 0; q4 < 8; q4 += MK_E8B) {
            const int ai = q4 >> 2, mb = q4 & 3; f32x4 xv[MK_E8B][2][2];
#pragma unroll
            for (int m2 = 0; m2 < MK_E8B; ++m2)
#pragma unroll
                for (int bj = 0; bj < 2; ++bj)
#pragma unroll
                    for (int n = 0; n < 2; ++n) xv[m2][bj][n] = *(const f32x4*)(X + off0 + (size_t)(ai * HALF + (mb + m2) * 16) * 1024 + bj * HALF + 4 * n);
#pragma unroll
            for (int m2 = 0; m2 < MK_E8B; ++m2)
#pragma unroll
                for (int bj = 0; bj < 2; ++bj)
#pragma unroll
                    for (int n = 0; n < 2; ++n) *(f32x4*)(OUT + off0 + (size_t)(ai * HALF + (mb + m2) * 16) * 1024 + bj * HALF + 4 * n) = xv[m2][bj][n] + gv[bj][n] * acc[ai][bj][mb + m2][n];
        }
    }
};
struct EpiNull {
    static constexpr bool PERM = true, AFTER_DRAIN = false;
    __device__ __forceinline__ void operator()(const f32x4 (&acc)[2][2][4][2], const Unit& u, int wr, int wc, int fr, int fq) const {
#pragma unroll
        for (int ai = 0; ai < 2; ++ai)
#pragma unroll
            for (int bj = 0; bj < 2; ++bj)
#pragma unroll
                for (int m = 0; m < 4; ++m)
#pragma unroll
                    for (int n = 0; n < 2; ++n) asm volatile("" :: "v"(acc[ai][bj][m][n]));
    }
};
template <int N> __device__ __forceinline__ void wait_vm_sel(int sel) { asm volatile("s_waitcnt vmcnt(%1)\n\ts_cmp_lg_u32 %0, 0\n\ts_cbranch_scc1 .Lwvs%=\n\ts_waitcnt vmcnt(8)\n.Lwvs%=:" :: "s"(sel), "n"(N) : "memory", "scc"); }
template <class Epi, class Sched, bool ALIGN_EPI = false, bool SP2 = false, int EPIW = 0>
__device__ __forceinline__ void gemm_phase(PG8_LAS unsigned char* lds, const Gemm g, const Sched& S, const Epi& E) {
    const int tid = threadIdx.x, wid = __builtin_amdgcn_readfirstlane(tid >> 6), lane = tid & 63, wr = wid >> 2, wc = wid & 3, fr = lane & 15, fq = lane >> 4;
    const int K = g.K, nt = K / BK;
    unsigned voffA[2], voffB[2];
#pragma unroll
    for (int i = 0; i < 2; ++i) { int R, C; stage_rc(tid * 16 + i * 8192, R, C); const int Rb = Epi::PERM ? ((R & ~31) + perm32(R & 31)) : R;
        voffA[i] = (unsigned)(R * K + C) * 2u; voffB[i] = (unsigned)(Rb * K + C) * 2u; }
    const size_t kstep = (size_t)(BK * 2);
    const size_t hstep = (size_t)HALF * K * 2;
    const size_t tstep = 2 * hstep;
    const unsigned ldsw = (unsigned)wid * 1024u;
    const int aoff = lds_byte(wr * 64 + fr, fq * 8), boff = lds_byte(wc * 32 + fr, fq * 8);
#define PG8_SA(b, h) (((b) * 2 + (h)) * HTB)
#define PG8_SB(b, h) ((4 + (b) * 2 + (h)) * HTB)
#define PG8_STAGE(bufoff, gbase, voff) do { _Pragma("unroll") for (int _i = 0; _i < 2; ++_i) \
        __builtin_amdgcn_global_load_lds((const unsigned*)((const char*)(gbase) + (voff)[_i]), (PG8_LAS unsigned*)(lds + (bufoff) + ldsw + _i * 8192), 16, 0, 0); } while (0)
#define PG8_LDA(dst, b, h) do { _Pragma("unroll") for (int m = 0; m < 4; ++m) _Pragma("unroll") for (int k = 0; k < 2; ++k) dst[m][k] = *(const PG8_LAS bf16x8*)(lds + PG8_SA(b, h) + aoff + m * 2048 + k * 1024); } while (0)
#define PG8_LDB(dst, b, h) do { _Pragma("unroll") for (int n = 0; n < 2; ++n) _Pragma("unroll") for (int k = 0; k < 2; ++k) dst[n][k] = *(const PG8_LAS bf16x8*)(lds + PG8_SB(b, h) + boff + n * 2048 + k * 1024); } while (0)
#define PG8_MMA(ai, bj, At, Bt) do { __builtin_amdgcn_s_setprio(1); _Pragma("unroll") for (int m = 0; m < 4; ++m) _Pragma("unroll") for (int n = 0; n < 2; ++n) _Pragma("unroll") for (int k = 0; k < 2; ++k) \
        acc[ai][bj][m][n] = __builtin_amdgcn_mfma_f32_16x16x32_bf16(Bt[n][k], At[m][k], acc[ai][bj][m][n], 0, 0, 0); __builtin_amdgcn_s_setprio(0); } while (0)
#define PG8_WAIT_V(n) asm volatile("s_waitcnt vmcnt(" #n ")" ::: "memory")
#define PG8_WAIT_L(n) asm volatile("s_waitcnt lgkmcnt(" #n ")" ::: "memory")
#define PG8_BAR __builtin_amdgcn_s_barrier()
#define PG8_SCHED __builtin_amdgcn_sched_barrier(0)
    Unit cur, nxt; int ui = 0;
    if (!S.next(0, cur)) return;
    f32x4 acc[2][2][4][2];
#pragma unroll
    for (int a = 0; a < 2; ++a)
#pragma unroll
        for (int b = 0; b < 2; ++b)
#pragma unroll
            for (int m = 0; m < 4; ++m)
#pragma unroll
                for (int n = 0; n < 2; ++n) acc[a][b][m][n] = (f32x4){0.f, 0.f, 0.f, 0.f};
    bf16x8 At[4][2], B0[2][2], B1[2][2];
    const char* cA = (const char*)g.A + (size_t)cur.pm * tstep; const char* cB = (const char*)g.Bt + (size_t)cur.pn * tstep;
    S.a_ready(cur);
    if constexpr (SP2) {
        PG8_STAGE(PG8_SB(0, 0), cB, voffB); PG8_STAGE(PG8_SB(0, 1), cB + hstep, voffB); PG8_STAGE(PG8_SA(0, 0), cA, voffA); PG8_STAGE(PG8_SA(0, 1), cA + hstep, voffA);
        if (wr == 1) PG8_BAR;
        PG8_WAIT_V(2); PG8_BAR;
        PG8_STAGE(PG8_SB(1, 0), cB + kstep, voffB); PG8_STAGE(PG8_SA(1, 0), cA + kstep, voffA); PG8_STAGE(PG8_SB(1, 1), cB + hstep + kstep, voffB);
        PG8_WAIT_V(6); PG8_BAR;
    } else {
        PG8_STAGE(PG8_SB(0, 0), cB, voffB); PG8_STAGE(PG8_SA(0, 0), cA, voffA); PG8_STAGE(PG8_SB(0, 1), cB + hstep, voffB); PG8_STAGE(PG8_SA(0, 1), cA + hstep, voffA);
        if (wr == 1) PG8_BAR;
        PG8_WAIT_V(4); PG8_BAR;
        PG8_STAGE(PG8_SB(1, 0), cB + kstep, voffB); PG8_STAGE(PG8_SA(1, 0), cA + kstep, voffA); PG8_STAGE(PG8_SB(1, 1), cB + hstep + kstep, voffB);
        PG8_WAIT_V(6); PG8_BAR;
    }
    for (;;) {
        const bool has_next = S.next(ui + 1, nxt);
        const char* nA = has_next ? (const char*)g.A + (size_t)nxt.pm * tstep : cA; const char* nB = has_next ? (const char*)g.Bt + (size_t)nxt.pn * tstep : cB;
        for (int t = 0; t < nt; t += 2) {
            const bool last = (t == nt - 2);
            const char* a1 = cA + (size_t)(t + 1) * kstep;
            const char* a2 = last ? nA : cA + (size_t)(t + 2) * kstep; const char* b2 = last ? nB : cB + (size_t)(t + 2) * kstep;
            const char* a3 = a2 + kstep; const char* b3 = b2 + kstep;
            if (last && has_next) S.a_ready(nxt);
            const int fe = __builtin_amdgcn_readfirstlane(((EPIW > 0) && (t == 0) && (ui > 0)) ? 1 : 0);
            if constexpr (SP2) {
            PG8_LDB(B0, 0, 0); PG8_LDB(B1, 0, 1); PG8_SCHED; PG8_LDA(At, 0, 0); PG8_STAGE(PG8_SA(1, 1), a1 + hstep, voffA);
            if constexpr (EPIW > 0) wait_vm_sel<8 + EPIW>(fe); else PG8_WAIT_V(8); PG8_WAIT_L(0); PG8_BAR; PG8_MMA(0, 0, At, B0); PG8_MMA(0, 1, At, B1); PG8_BAR; PG8_SCHED;
            PG8_LDA(At, 0, 1); PG8_STAGE(PG8_SB(0, 0), b2, voffB); PG8_STAGE(PG8_SB(0, 1), b2 + hstep, voffB); PG8_STAGE(PG8_SA(0, 0), a2, voffA);
            if constexpr (EPIW > 0) wait_vm_sel<8 + EPIW>(fe); else PG8_WAIT_V(8); PG8_WAIT_L(0); PG8_BAR; PG8_MMA(1, 0, At, B0); PG8_MMA(1, 1, At, B1); PG8_BAR; PG8_SCHED;
            PG8_LDB(B0, 1, 0); PG8_LDB(B1, 1, 1); PG8_SCHED; PG8_LDA(At, 1, 0); PG8_STAGE(PG8_SA(0, 1), a2 + hstep, voffA);
            PG8_WAIT_V(8); PG8_WAIT_L(0); PG8_BAR; PG8_MMA(0, 0, At, B0); PG8_MMA(0, 1, At, B1); PG8_BAR; PG8_SCHED;
            PG8_LDA(At, 1, 1); PG8_STAGE(PG8_SB(1, 0), b3, voffB); PG8_STAGE(PG8_SB(1, 1), b3 + hstep, voffB); PG8_STAGE(PG8_SA(1, 0), a3, voffA);
            PG8_WAIT_V(8); PG8_WAIT_L(0); PG8_BAR; PG8_MMA(1, 0, At, B0); PG8_MMA(1, 1, At, B1); PG8_BAR; PG8_SCHED;
            } else {
            PG8_LDB(B0, 0, 0); PG8_SCHED; PG8_LDA(At, 0, 0); PG8_STAGE(PG8_SA(1, 1), a1 + hstep, voffA);
            PG8_WAIT_L(8); PG8_BAR; PG8_WAIT_L(0); PG8_MMA(0, 0, At, B0); PG8_BAR; PG8_SCHED;
            PG8_LDB(B1, 0, 1); PG8_STAGE(PG8_SB(0, 0), b2, voffB);
            PG8_BAR; PG8_WAIT_L(0); PG8_MMA(0, 1, At, B1); PG8_BAR;
            PG8_LDA(At, 0, 1); PG8_STAGE(PG8_SA(0, 0), a2, voffA);
            PG8_BAR; PG8_WAIT_L(0); PG8_MMA(1, 0, At, B0); PG8_BAR; PG8_SCHED;
            PG8_STAGE(PG8_SB(0, 1), b2 + hstep, voffB);
            PG8_WAIT_V(6); PG8_BAR; PG8_MMA(1, 1, At, B1); PG8_BAR;
            PG8_LDB(B0, 1, 0); PG8_SCHED; PG8_LDA(At, 1, 0); PG8_STAGE(PG8_SA(0, 1), a2 + hstep, voffA);
            PG8_WAIT_L(8); PG8_BAR; PG8_WAIT_L(0); PG8_MMA(0, 0, At, B0); PG8_BAR; PG8_SCHED;
            PG8_LDB(B1, 1, 1); PG8_STAGE(PG8_SB(1, 0), b3, voffB);
            PG8_BAR; PG8_WAIT_L(0); PG8_MMA(0, 1, At, B1); PG8_BAR;
            PG8_LDA(At, 1, 1); PG8_STAGE(PG8_SA(1, 0), a3, voffA);
            PG8_BAR; PG8_WAIT_L(0); PG8_MMA(1, 0, At, B0); PG8_BAR; PG8_SCHED;
            PG8_STAGE(PG8_SB(1, 1), b3 + hstep, voffB);
            PG8_WAIT_V(6); PG8_BAR; PG8_MMA(1, 1, At, B1); PG8_BAR;
            }
        }
        if constexpr (ALIGN_EPI) { if (wr == 0) PG8_BAR; }
        if constexpr (EPIW > 0) { static_assert(EPIW == 0 || (ALIGN_EPI && SP2), "EPIW needs ALIGN_EPI and SP2");
            }
        if constexpr (!Epi::AFTER_DRAIN) { E(acc, cur, wr, wc, fr, fq); S.done(cur); }
        if (!has_next) break;
#pragma unroll
        for (int a = 0; a < 2; ++a)
#pragma unroll
            for (int b = 0; b < 2; ++b)
#pragma unroll
                for (int m = 0; m < 4; ++m)
#pragma unroll
                    for (int n = 0; n < 2; ++n) acc[a][b][m][n] = (f32x4){0.f, 0.f, 0.f, 0.f};
        cur = nxt; cA = nA; cB = nB; ++ui;
        if constexpr (ALIGN_EPI) { if (wr == 1) PG8_BAR; }
    }
    PG8_WAIT_V(0);
    if constexpr (!ALIGN_EPI) { if (wr == 0) PG8_BAR; }
    PG8_BAR;
    if constexpr (Epi::AFTER_DRAIN) { E.fused(acc, cur, wr, wc, fr, fq, lds, wid, lane); S.done(cur); }
#undef PG8_SA
#undef PG8_SB
#undef PG8_STAGE
#undef PG8_LDA
#undef PG8_LDB
#undef PG8_MMA
#undef PG8_WAIT_V
#undef PG8_WAIT_L
#undef PG8_BAR
#undef PG8_SCHED
}
}

namespace attn {
constexpr int   D = 128, NW = 8, QBLK = 32, KVBLK = 64;
constexpr float SCALE = 0.088388347648318440f;
constexpr float THR = MK_FP8V ? 2.f : 8.f;
constexpr float POFF = MK_FP8V ? 5.f : 0.f;
constexpr int V8STR = 80;
constexpr int SDEPTH = 2;
constexpr int LDQ = 1024, LDK = 256, LDO = 1024;
constexpr size_t SHM_V = KVBLK * D * 2, SHM_K = KVBLK * D * 2, SHM_ATTN = 2 * SHM_V + 2 * SHM_K + NW * 64 * 4;
typedef unsigned short bf16;
using bf16x8 = __attribute__((ext_vector_type(8))) short;
using s16x4  = __attribute__((ext_vector_type(4))) short;
using f32x16 = __attribute__((ext_vector_type(16))) float;
using f32x8  = __attribute__((ext_vector_type(8))) float;
using u32x4  = __attribute__((ext_vector_type(4))) unsigned;
#define KSWZ(row, colB) ((row) * 256 + ((colB) ^ (((row) & 7) << 4)))
#define K8SWZ(row, c16) ((row) * 128 + ((((c16) ^ ((row) & 7))) << 4))
typedef int v8i __attribute__((ext_vector_type(8)));
#define SBAR() __builtin_amdgcn_sched_barrier(0)
__device__ __forceinline__ int crow(int r, int hi) { return (r & 3) + 8 * (r >> 2) + 4 * hi; }
__device__ __forceinline__ unsigned cvtpk(float lo, float hi) { return cvt_pk_bf16(lo, hi); }
template <typename TIn> struct Stage;
template <> struct Stage<bf16>  { using T = bf16x8;
  __device__ static __forceinline__ T ld8(const bf16* p) { return *reinterpret_cast<const bf16x8*>(p); }
  __device__ static __forceinline__ bf16x8 tobf(T x) { return x; } };
__device__ __forceinline__ void partialSM(f32x16& p0, f32x16& p1, float& m_reg, float& mn, float& alpha) {
  constexpr float C = SCALE * 1.4426950408889634f;
  float pmax = p0[0]; for (int r = 1; r < 16; ++r) pmax = fmaxf(pmax, p0[r]); for (int r = 0; r < 16; ++r) pmax = fmaxf(pmax, p1[r]);
  { auto rr = __builtin_amdgcn_permlane32_swap(__float_as_uint(pmax), __float_as_uint(pmax), false, false);
    pmax = fmaxf(__uint_as_float(rr[0]), __uint_as_float(rr[1])); }
  if (__builtin_expect(__all(pmax - m_reg <= THR / SCALE), 1)) { mn = m_reg; alpha = 1.f; }
  else { mn = fmaxf(m_reg, pmax); alpha = __builtin_amdgcn_exp2f((m_reg - mn) * C); m_reg = mn; }
  float mnC = -mn * C + POFF;
  for (int r = 0; r < 16; ++r) p0[r] = fmaf(p0[r], C, mnC); for (int r = 0; r < 16; ++r) p1[r] = fmaf(p1[r], C, mnC);
  for (int r = 0; r < 16; ++r) p0[r] = __builtin_amdgcn_exp2f(p0[r]);
}
__device__ __forceinline__ void finishSM8(f32x16& p0, f32x16& p1, float alpha, float& l_reg, v8i& P8) {
  for (int r = 0; r < 16; ++r) p1[r] = __builtin_amdgcn_exp2f(p1[r]);
  float ps = 0; for (int r = 0; r < 16; ++r) ps += p0[r]; for (int r = 0; r < 16; ++r) ps += p1[r];
  { auto rr = __builtin_amdgcn_permlane32_swap(__float_as_uint(ps), __float_as_uint(ps), false, false);
    ps = __uint_as_float(rr[0]) + __uint_as_float(rr[1]); }
  l_reg = l_reg * alpha + ps;
#pragma unroll
  for (int i = 0; i < 4; ++i) {
    int a = __builtin_amdgcn_cvt_pk_fp8_f32(p0[4 * i], p0[4 * i + 1], 0, false); a = __builtin_amdgcn_cvt_pk_fp8_f32(p0[4 * i + 2], p0[4 * i + 3], a, true);
    int b = __builtin_amdgcn_cvt_pk_fp8_f32(p1[4 * i], p1[4 * i + 1], 0, false); b = __builtin_amdgcn_cvt_pk_fp8_f32(p1[4 * i + 2], p1[4 * i + 3], b, true);
    auto rr = __builtin_amdgcn_permlane32_swap((unsigned)a, (unsigned)b, false, false); P8[i] = (int)rr[0]; P8[4 + i] = (int)rr[1]; }
}
__device__ __forceinline__ void pv8(f32x16* o, const char* Vb, const v8i& P8, int r32, int hi) {
#pragma unroll
  for (int d0 = 0; d0 < 4; ++d0) { const char* pp = Vb + (32 * d0 + r32) * V8STR + 32 * hi;
    const u32x4 x0 = *reinterpret_cast<const u32x4*>(pp), x1 = *reinterpret_cast<const u32x4*>(pp + 16);
    const v8i B = {(int)x0.x, (int)x0.y, (int)x0.z, (int)x0.w, (int)x1.x, (int)x1.y, (int)x1.z, (int)x1.w};
    o[d0] = __builtin_amdgcn_mfma_scale_f32_32x32x64_f8f6f4(P8, B, o[d0], 0, 0, 0, 0x7F7F7F7F, 0, 0x7F7F7F7F); }
}
__device__ __forceinline__ void finishSM(f32x16& p0, f32x16& p1, float alpha, float& l_reg, bf16x8& pa0, bf16x8& pa1, bf16x8& pa2, bf16x8& pa3) {
  for (int r = 0; r < 16; ++r) p1[r] = __builtin_amdgcn_exp2f(p1[r]);
  float ps = 0; for (int r = 0; r < 16; ++r) ps += p0[r]; for (int r = 0; r < 16; ++r) ps += p1[r];
  { auto rr = __builtin_amdgcn_permlane32_swap(__float_as_uint(ps), __float_as_uint(ps), false, false);
    ps = __uint_as_float(rr[0]) + __uint_as_float(rr[1]); }
  l_reg = l_reg * alpha + ps;
#define PK4(P, BASE, OUT) do { unsigned a0 = cvtpk(P[BASE + 0], P[BASE + 1]), a1 = cvtpk(P[BASE + 2], P[BASE + 3]);   \
    unsigned b0 = cvtpk(P[BASE + 4], P[BASE + 5]), b1 = cvtpk(P[BASE + 6], P[BASE + 7]);                              \
    auto r0 = __builtin_amdgcn_permlane32_swap(a0, b0, false, false); auto r1 = __builtin_amdgcn_permlane32_swap(a1, b1, false, false); \
    u32x4 w = {r0[0], r1[0], r0[1], r1[1]}; OUT = *reinterpret_cast<bf16x8*>(&w); } while (0)
  PK4(p0, 0, pa0); PK4(p0, 8, pa1); PK4(p1, 0, pa2); PK4(p1, 8, pa3);
#undef PK4
}
__device__ __forceinline__ void qkt(f32x16& p0, f32x16& p1, const bf16* Ks, const bf16x8* qr, int r32, int hi) {
  p0 = f32x16{}; p1 = f32x16{};
  for (int d0 = 0; d0 < 8; ++d0) { int cb = (d0 * 16 + hi * 8) * 2;
    bf16x8 b0 = *reinterpret_cast<const bf16x8*>((const char*)Ks + KSWZ(r32, cb));
    bf16x8 b1 = *reinterpret_cast<const bf16x8*>((const char*)Ks + KSWZ(32 + r32, cb));
    p0 = __builtin_amdgcn_mfma_f32_32x32x16_bf16(b0, qr[d0], p0, 0, 0, 0);
    p1 = __builtin_amdgcn_mfma_f32_32x32x16_bf16(b1, qr[d0], p1, 0, 0, 0); }
}
__device__ __forceinline__ void qkt8(f32x16& p0, f32x16& p1, const char* Ks, const v8i* q8, int r32, int hi) {
  p0 = f32x16{}; p1 = f32x16{};
#pragma unroll
  for (int m = 0; m < 2; ++m) { const int c = 4 * m + 2 * hi;
    const u32x4 a00 = *reinterpret_cast<const u32x4*>(Ks + K8SWZ(r32, c)), a01 = *reinterpret_cast<const u32x4*>(Ks + K8SWZ(r32, c + 1));
    const u32x4 a10 = *reinterpret_cast<const u32x4*>(Ks + K8SWZ(32 + r32, c)), a11 = *reinterpret_cast<const u32x4*>(Ks + K8SWZ(32 + r32, c + 1));
    const v8i A0 = {(int)a00.x, (int)a00.y, (int)a00.z, (int)a00.w, (int)a01.x, (int)a01.y, (int)a01.z, (int)a01.w};
    const v8i A1 = {(int)a10.x, (int)a10.y, (int)a10.z, (int)a10.w, (int)a11.x, (int)a11.y, (int)a11.z, (int)a11.w};
    p0 = __builtin_amdgcn_mfma_scale_f32_32x32x64_f8f6f4(A0, q8[m], p0, 0, 0, 0, 0x7F7F7F7F, 0, 0x7F7F7F7F);
    p1 = __builtin_amdgcn_mfma_scale_f32_32x32x64_f8f6f4(A1, q8[m], p1, 0, 0, 0, 0x7F7F7F7F, 0, 0x7F7F7F7F); }
}
__device__ __forceinline__ int v_st(int k, int c) { const int kk = (k & ~0xC) | ((k & 4) << 1) | ((k & 8) >> 1); return ((kk >> 3) * 4 + (c >> 5)) * 512 + ((kk & 7) * 32 + (c & 31)) * 2; }
__device__ __forceinline__ int v_rd_base(int lane) { return ((lane & 3) << 3) | (((lane >> 2) & 3) << 6) | (((lane >> 4) & 1) << 5) | (((lane >> 5) & 1) << 8); }
constexpr int v_rd_off(int d0, int ks, int half) { return d0 * 512 + ks * 4096 + half * 2048; }
template <int OFF> __device__ __forceinline__ s16x4 tr_read(int vb) {
  s16x4 r; asm volatile("ds_read_b64_tr_b16 %0, %1 offset:%2" : "=&v"(r) : "v"(vb), "i"(OFF) : "memory"); return r;
}
template <int D0> __device__ __forceinline__ void pv_one(f32x16& od, int vb, bf16x8 pa0, bf16x8 pa1, bf16x8 pa2, bf16x8 pa3) {
  const s16x4 l0 = tr_read<v_rd_off(D0, 0, 0)>(vb), h0 = tr_read<v_rd_off(D0, 0, 1)>(vb), l1 = tr_read<v_rd_off(D0, 1, 0)>(vb), h1 = tr_read<v_rd_off(D0, 1, 1)>(vb);
  const s16x4 l2 = tr_read<v_rd_off(D0, 2, 0)>(vb), h2 = tr_read<v_rd_off(D0, 2, 1)>(vb), l3 = tr_read<v_rd_off(D0, 3, 0)>(vb), h3 = tr_read<v_rd_off(D0, 3, 1)>(vb);
  asm volatile("s_waitcnt lgkmcnt(0)" ::: "memory"); SBAR();
#define PK(L, H) (bf16x8){L[0], L[1], L[2], L[3], H[0], H[1], H[2], H[3]}
  od = __builtin_amdgcn_mfma_f32_32x32x16_bf16(pa0, PK(l0, h0), od, 0, 0, 0);
  od = __builtin_amdgcn_mfma_f32_32x32x16_bf16(pa1, PK(l1, h1), od, 0, 0, 0);
  od = __builtin_amdgcn_mfma_f32_32x32x16_bf16(pa2, PK(l2, h2), od, 0, 0, 0);
  od = __builtin_amdgcn_mfma_f32_32x32x16_bf16(pa3, PK(l3, h3), od, 0, 0, 0);
#undef PK
}
__device__ __forceinline__ void pv_d0(f32x16* o, int vb, bf16x8 pa0, bf16x8 pa1, bf16x8 pa2, bf16x8 pa3) {
  pv_one<0>(o[0], vb, pa0, pa1, pa2, pa3); pv_one<1>(o[1], vb, pa0, pa1, pa2, pa3); pv_one<2>(o[2], vb, pa0, pa1, pa2, pa3); pv_one<3>(o[3], vb, pa0, pa1, pa2, pa3);
}

struct Pre { bf16x8 q[8]; };
__device__ __forceinline__ void attn_prefetch(const bf16* Qb, const bf16* __restrict__ Kh, const bf16* __restrict__ Vh, Pre& p) {
  const int tid = threadIdx.x, wid = tid >> 6, lane = tid & 63, r32 = lane & 31, hi = lane >> 5;
  const bf16* Qw = Qb + (long)(wid * QBLK + r32) * LDQ + hi * 8;
#pragma unroll
  for (int d0 = 0; d0 < 8; ++d0) p.q[d0] = *reinterpret_cast<const bf16x8*>(Qw + d0 * 16);
}
template <typename TQ>
__device__ __forceinline__ void attn_dense_body(const TQ* Qb, const bf16* __restrict__ Kh, const bf16* __restrict__ Vh,
                                                bf16* Ob, int seq, char* lds, const float* __restrict__ qnw, const float* __restrict__ rope, int lpos0,
                                                Pre& pre, const bf16* Qn, const bf16* Kn, const bf16* Vn) {
  using St = Stage<bf16>; using SQ = Stage<TQ>;
  const int tid = threadIdx.x, wid = __builtin_amdgcn_readfirstlane(tid >> 6), lane = tid & 63, r32 = lane & 31, hi = lane >> 5;
  bf16* V_lds = (bf16*)lds; bf16* K_lds = (bf16*)(lds + 2 * SHM_V);
  float* ws = (float*)(lds + 2 * SHM_V + 2 * SHM_K) + wid * 64; float* li_l = ws; float* al_l = ws + 32;
  float m_reg = -1e30f, l_reg = 0; f32x16 o[4] = {}; bf16x8 qr[8];
#if MK_FP8K
  v8i q8[2]; const unsigned char* K8h = (const unsigned char*)Kh;
#endif
#pragma unroll
  for (int d0 = 0; d0 < 8; ++d0) qr[d0] = pre.q[d0];
  const int sr = tid >> 4, sc = (tid & 15) * 8, vst0 = v_st(sr, sc), vst1 = v_st(32 + sr, sc);
  const int vb0 = (int)(uintptr_t)V_lds + v_rd_base(lane);
#if MK_FP8K && MK_FP8V
  const unsigned char* V8h = (const unsigned char*)Vh;
  struct { u32x4 v8, k8; } sr_[SDEPTH];
  const unsigned ko = (unsigned)((tid >> 3) * 256 + (tid & 7) * 16);
#define SLOAD(i, k0) do { sr_[i].v8 = *reinterpret_cast<const u32x4*>(V8h + (size_t)((k0) >> 6) * 8192 + (unsigned)tid * 16u); \
    sr_[i].k8 = *reinterpret_cast<const u32x4*>(K8h + (size_t)(k0) * 256 + ko); } while (0)
#define SWRITE(b, i) do { *(u32x4*)((char*)V_lds + (b) * SHM_V + (tid >> 2) * V8STR + (tid & 3) * 16) = sr_[i].v8; \
    *(u32x4*)((char*)K_lds + (b) * SHM_K + K8SWZ(tid >> 3, tid & 7)) = sr_[i].k8; } while (0)
#define SWAIT() asm volatile("s_waitcnt vmcnt(2)" ::: "memory")
#define QKT(P0, P1, KB) qkt8(P0, P1, (const char*)K_lds + (KB) * SHM_K, q8, r32, hi)
#define FINISH(P0, P1, AL) finishSM8(P0, P1, AL, l_reg, P8)
#define PV(VB) pv8(o, (const char*)V_lds + (VB) * SHM_V, P8, r32, hi)
  v8i P8;
#elif MK_FP8K
#define FINISH(P0, P1, AL) finishSM(P0, P1, AL, l_reg, pa0, pa1, pa2, pa3)
#define PV(VB) pv_d0(o, vb0 + (VB) * (int)SHM_V, pa0, pa1, pa2, pa3)
  struct { typename St::T vs0, vs1; u32x4 k8; } sr_[SDEPTH];
  const unsigned vo0 = (unsigned)(sr * LDK + sc), vo1 = vo0 + 32u * LDK, ko = (unsigned)((tid >> 3) * 256 + (tid & 7) * 16);
#define SLOAD(i, k0) do { const bf16* vt_ = Vh + (size_t)(k0) * LDK; const unsigned char* kt_ = K8h + (size_t)(k0) * 256; \
    sr_[i].vs0 = *reinterpret_cast<const bf16x8*>(vt_ + vo0); sr_[i].vs1 = *reinterpret_cast<const bf16x8*>(vt_ + vo1); sr_[i].k8 = *reinterpret_cast<const u32x4*>(kt_ + ko); } while (0)
#define SWRITE(b, i) do { *(bf16x8*)((char*)V_lds + (b) * SHM_V + vst0) = St::tobf(sr_[i].vs0);          \
    *(bf16x8*)((char*)V_lds + (b) * SHM_V + vst1) = St::tobf(sr_[i].vs1);                                \
    *(u32x4*)((char*)K_lds + (b) * SHM_K + K8SWZ(tid >> 3, tid & 7)) = sr_[i].k8; } while (0)
#define SWAIT() asm volatile("s_waitcnt vmcnt(3)" ::: "memory")
#define QKT(P0, P1, KB) qkt8(P0, P1, (const char*)K_lds + (KB) * SHM_K, q8, r32, hi)
#else
#define FINISH(P0, P1, AL) finishSM(P0, P1, AL, l_reg, pa0, pa1, pa2, pa3)
#define PV(VB) pv_d0(o, vb0 + (VB) * (int)SHM_V, pa0, pa1, pa2, pa3)
#define QKT(P0, P1, KB) qkt(P0, P1, (bf16*)((char*)K_lds + (KB) * SHM_K), qr, r32, hi)
  struct { typename St::T vs0, vs1, ks0, ks1; } sr_[SDEPTH];
#define SLOAD(i, k0) do { sr_[i].vs0 = St::ld8(&Vh[(long)((k0) + sr) * LDK + sc]); sr_[i].vs1 = St::ld8(&Vh[(long)((k0) + 32 + sr) * LDK + sc]); \
    sr_[i].ks0 = St::ld8(&Kh[(long)((k0) + sr) * LDK + sc]); sr_[i].ks1 = St::ld8(&Kh[(long)((k0) + 32 + sr) * LDK + sc]); } while (0)
#define SWRITE(b, i) do { *(bf16x8*)((char*)V_lds + (b) * SHM_V + vst0) = St::tobf(sr_[i].vs0);          \
    *(bf16x8*)((char*)V_lds + (b) * SHM_V + vst1) = St::tobf(sr_[i].vs1); int kc = sc * 2;               \
    *(bf16x8*)((char*)K_lds + (b) * SHM_K + KSWZ(sr, kc)) = St::tobf(sr_[i].ks0);                       \
    *(bf16x8*)((char*)K_lds + (b) * SHM_K + KSWZ(32 + sr, kc)) = St::tobf(sr_[i].ks1); } while (0)
#define SWAIT() do { if constexpr (SDEPTH == 2) asm volatile("s_waitcnt vmcnt(4)" ::: "memory"); else asm volatile("s_waitcnt vmcnt(0)" ::: "memory"); } while (0)
#endif
#define RESC(a) do { if (__any((a) < 1.f)) { if (hi == 0) al_l[r32] = (a); asm volatile("s_waitcnt lgkmcnt(0)" ::: "memory"); \
    for (int d = 0; d < 4; ++d) for (int r = 0; r < 16; ++r) o[d][r] *= al_l[crow(r, hi)]; } } while (0)
  f32x16 pA0, pA1, pB0, pB1; float mnA, mnB, alA, alB; bf16x8 pa0, pa1, pa2, pa3; const int NT = seq / KVBLK;
  constexpr int SE = 0, SO = SDEPTH - 1;
  SLOAD(SE, 0); SLOAD(SO, KVBLK);
  if (qnw) {
    float ssq = 0.f;
#pragma unroll
    for (int d0 = 0; d0 < 8; ++d0)
#pragma unroll
      for (int j = 0; j < 8; ++j) { const float f = bf2f((unsigned short)qr[d0][j]); ssq += f * f; }
    { auto rr = __builtin_amdgcn_permlane32_swap(__float_as_uint(ssq), __float_as_uint(ssq), false, false); ssq = __uint_as_float(rr[0]) + __uint_as_float(rr[1]); }
    const float rstd = 1.0f / sqrtf(ssq * (1.0f / 128.0f) + 1e-6f);
    const int lq = lpos0 + wid * QBLK + r32, ri = lq >> 6, ci = lq & 63;
#pragma unroll
    for (int d0 = 0; d0 < 8; ++d0) {
      const float* wp = qnw + 16 * d0 + 8 * hi; const v4f w0 = *(const v4f*)wp, w1 = *(const v4f*)(wp + 4);
      const float* tp = d0 < 4 ? rope + (ri * 32 + 8 * d0 + 4 * hi) * 2 : rope + (ci * 32 + 8 * (d0 - 4) + 4 * hi) * 2; const v4f t0 = *(const v4f*)tp, t1 = *(const v4f*)(tp + 4);
      const float wv[8] = {w0.x, w0.y, w0.z, w0.w, w1.x, w1.y, w1.z, w1.w}, tv[8] = {t0.x, t0.y, t0.z, t0.w, t1.x, t1.y, t1.z, t1.w};
      float y[8];
#pragma unroll
      for (int q = 0; q < 4; ++q) { const float x0 = bf2f((unsigned short)qr[d0][2 * q]) * rstd * wv[2 * q], x1 = bf2f((unsigned short)qr[d0][2 * q + 1]) * rstd * wv[2 * q + 1], cs = tv[2 * q], sn = tv[2 * q + 1];
        y[2 * q] = x0 * cs - x1 * sn; y[2 * q + 1] = x0 * sn + x1 * cs; }
#if MK_FP8K
      { int w0 = __builtin_amdgcn_cvt_pk_fp8_f32(y[0], y[1], 0, false); w0 = __builtin_amdgcn_cvt_pk_fp8_f32(y[2], y[3], w0, true);
        int w1 = __builtin_amdgcn_cvt_pk_fp8_f32(y[4], y[5], 0, false); w1 = __builtin_amdgcn_cvt_pk_fp8_f32(y[6], y[7], w1, true);
        q8[d0 >> 2][2 * (d0 & 3)] = w0; q8[d0 >> 2][2 * (d0 & 3) + 1] = w1; }
#else
      u32x4 pw = {cvtpk(y[0], y[1]), cvtpk(y[2], y[3]), cvtpk(y[4], y[5]), cvtpk(y[6], y[7])}; qr[d0] = *reinterpret_cast<bf16x8*>(&pw);
#endif
    }
  }
  SWAIT(); SWRITE(0, SE); if constexpr (SDEPTH == 2) { if (2 < NT) SLOAD(SE, 2 * KVBLK); } __syncthreads();
  QKT(pA0, pA1, 0); partialSM(pA0, pA1, m_reg, mnA, alA);
  SWAIT(); SWRITE(1, SO); __syncthreads();
  for (int j = 1; j + 1 < NT; j += 2) {
    SBAR(); QKT(pB0, pB1, 1);
    FINISH(pA0, pA1, alA); SBAR();
    SLOAD(SO, (j + SDEPTH) * KVBLK); SBAR();
    PV(0); partialSM(pB0, pB1, m_reg, mnB, alB);
    __syncthreads(); SWAIT(); SWRITE(0, SE);
    RESC(alB); __syncthreads();
    SBAR(); QKT(pA0, pA1, 0);
    FINISH(pB0, pB1, alB); SBAR();
    if (SDEPTH == 1 || j + 3 < NT) SLOAD(SE, (j + 1 + SDEPTH) * KVBLK); SBAR();
    PV(1); partialSM(pA0, pA1, m_reg, mnA, alA);
    __syncthreads(); SWAIT(); SWRITE(1, SO);
    RESC(alA); __syncthreads();
  }
  attn_prefetch(Qn, Kn, Vn, pre);
  SBAR(); QKT(pB0, pB1, 1);
  FINISH(pA0, pA1, alA); SBAR();
  PV(0); partialSM(pB0, pB1, m_reg, mnB, alB);
  __syncthreads(); RESC(alB);
  FINISH(pB0, pB1, alB); SBAR();
  PV(1);
  if (hi == 0) li_l[r32] = l_reg; asm volatile("s_waitcnt lgkmcnt(0)" ::: "memory");
  float rli[16];
#pragma unroll
  for (int r = 0; r < 16; ++r) rli[r] = __builtin_amdgcn_rcpf(li_l[crow(r, hi)]);
  if (!Ob) return;
  bf16* Ow = Ob + (long)(wid * QBLK) * LDO;
#pragma unroll
  for (int r = 0; r < 16; ++r) { int orow = crow(r, hi);
    for (int d0 = 0; d0 < 4; ++d0) Ow[(long)orow * LDO + d0 * 32 + r32] = (bf16)f2bf(o[d0][r] * rli[r]); }
#undef SLOAD
#undef QKT
#undef FINISH
#undef PV
#undef SWRITE
#undef SWAIT
#undef RESC
}

#undef KSWZ
#undef SBAR
}

namespace ret {
typedef short bf16x8 __attribute__((ext_vector_type(8)));
typedef short s16x4 __attribute__((ext_vector_type(4)));
typedef float f32x16 __attribute__((ext_vector_type(16)));
constexpr int QSTR = 528, KSTR = 576, VSTR = 576, PSTR = 144;
constexpr int QS = 0, KS = QS + 64 * QSTR, VS = KS + 64 * KSTR, PS = VS + 64 * VSTR, OST = PS + 64 * PSTR, OSTR = 144, SSL = OST + 8 * 32 * OSTR, LDS_RET = SSL + 64 * 8 * 4;
constexpr int NSTEP = 36, SPLIT = 20;
__device__ __forceinline__ int crow(int r, int hi) { return (r & 3) + 8 * (r >> 2) + 4 * hi; }
__device__ __forceinline__ s16x4 tr_read(const LAS unsigned char* p) { return __builtin_bit_cast(s16x4, __builtin_amdgcn_ds_read_tr16_b64_v4i16((LAS s16x4*)p)); }
__device__ __forceinline__ bf16x8 cat(s16x4 lo, s16x4 hi) { return (bf16x8){lo[0], lo[1], lo[2], lo[3], hi[0], hi[1], hi[2], hi[3]}; }

struct NoPre { __device__ __forceinline__ void operator()() const {} };
template <class GridBar, class PreWork = NoPre>
__device__ __forceinline__ void scan_unit(const bf16_t* RQ, const bf16_t* RK, const bf16_t* RV, bf16_t* YR, float* SSQ, const float* l2d, LAS unsigned char* lds, int unit, const GridBar& gridbar, int nb_limit, const PreWork& prework = PreWork()) {
    const int tid = threadIdx.x, lane = tid & 63, w = __builtin_amdgcn_readfirstlane(tid >> 6), r = lane & 31, hh = lane >> 5;
    const int x = unit & 7, y = unit >> 3, eh = y & 1, dir = (y >> 1) & 1, bh = (y >> 2) * 8 + x, b = bh >> 2, h = bh & 3;
    if (b >= nb_limit) { prework(); gridbar(); return; }
    const float lg2 = log1pf(-exp2f(l2d[dir * 4 + h])) * 1.4426950408889634f;
    const float gC = exp2f(lg2 * 64.0f);
#if MK_TIMING
    unsigned long long tl_ = __builtin_amdgcn_s_memrealtime(); unsigned ta0 = 0, ta1 = 0, ta2 = 0, ta3 = 0, ta4 = 0, ta5 = 0, ta6 = 0;
#define TMARK(v_) do { const unsigned long long n_ = __builtin_amdgcn_s_memrealtime(); v_ += (unsigned)(n_ - tl_); tl_ = n_; } while (0)
#else
#define TMARK(v_) do { } while (0)
#endif
    f32x16 S[8];
#pragma unroll
    for (int T = 0; T < 8; ++T) S[T] = (f32x16){0.f};
#define STEP_ROWS(s_, krow_, qrow_) do { const bool l_ = (s_) >= 4; const int lc_ = l_ ? (dir ? 35 - (s_) : (s_) - 4) : 0; \
        krow_ = b * LT + (l_ ? LC + 64 * lc_ : (dir ? 64 * (3 - (s_)) : 64 * (s_))); qrow_ = b * SEQ + 64 * lc_; } while (0)
    v4u kv[4], vv[4], qv[4];
    const int poff = (tid >> 5) * 1024 + (tid & 31) * 8, voff = (tid >> 5) * 2048 + (tid & 31) * 8;
#define PREFETCHK(s_) do { int kr_, qr_; STEP_ROWS(s_, kr_, qr_); const bf16_t* kb_ = RK + (size_t)kr_ * 1024 + h * 256; \
        _Pragma("unroll") for (int n = 0; n < 4; ++n) { const bf16_t* kbn_ = kb_ + n * 16 * 1024; kv[n] = *(const v4u*)(kbn_ + poff); } } while (0)
#define PREFETCHQ(s_) do { int kr_, qr_; STEP_ROWS(s_, kr_, qr_); const bf16_t* qb_ = RQ + (size_t)qr_ * 1024 + h * 256; \
        _Pragma("unroll") for (int n = 0; n < 4; ++n) { const bf16_t* qbn_ = qb_ + n * 16 * 1024; qv[n] = *(const v4u*)(qbn_ + poff); } } while (0)
#define LOADV(s_) do { int kr_, qr_; STEP_ROWS(s_, kr_, qr_); const bf16_t* vb_ = RV + (size_t)kr_ * 2048 + h * 512 + eh * 256; \
        _Pragma("unroll") for (int n = 0; n < 4; ++n) { const bf16_t* vbn_ = vb_ + n * 16 * 2048; vv[n] = *(const v4u*)(vbn_ + voff); } } while (0)
#define WRITEQ() do { _Pragma("unroll") for (int n = 0; n < 4; ++n) { const int c = tid + NTHR * n, row = c >> 5, ch = c & 31; *(LAS v4u*)(lds + QS + row * QSTR + ch * 16) = qv[n]; } } while (0)
    PREFETCHK(0); PREFETCHQ(0); LOADV(0);
    prework(); __syncthreads();
    LAS unsigned char* ost = lds + OST + w * (32 * OSTR);
    for (int s = 0; s < NSTEP; ++s) {
        if (s == SPLIT) gridbar();
        int krow0, qrow0; STEP_ROWS(s, krow0, qrow0); const bool latent = s >= 4; const int sn = s + 1 < NSTEP ? s + 1 : s;
        float lg2s = lg2; int hv = hh, rv = r; asm volatile("" : "+v"(lg2s), "+v"(hv), "+v"(rv));
        const int lane_l = hv * 32 + rv;
        const int qA = QS + rv * QSTR + hv * 16, pA = PS + rv * PSTR + hv * 16;
        const int sw = ((lane_l & 1) << 1) | ((lane_l >> 1) & 1);
        const int trrow = (hv * 8 + ((lane_l >> 2) & 3));
        const int ktr = KS + trrow * KSTR + (16 * ((lane_l >> 4) & 1) + 4 * sw) * 2;
        const int vtr = VS + trrow * VSTR + (32 * w + 16 * ((lane_l >> 4) & 1) + 4 * (lane_l & 3)) * 2;
        { float wgt = __builtin_amdgcn_exp2f(lg2s * (float)(dir ? (tid >> 5) : 63 - (tid >> 5))); const float wstep = __builtin_amdgcn_exp2f(lg2s * (dir ? 16.0f : -16.0f));
#pragma unroll
          for (int n = 0; n < 4; ++n) { const int c = tid + NTHR * n, row = c >> 5, ch = c & 31;
            *(LAS v4u*)(lds + KS + row * KSTR + ch * 16) = kv[n];
            *(LAS v4u*)(lds + QS + row * QSTR + ch * 16) = qv[n];
            float t[8]; unpack8(vv[n], t);
#pragma unroll
            for (int k = 0; k < 8; ++k) t[k] *= wgt;
            wgt *= wstep;
            *(LAS v4u*)(lds + VS + row * VSTR + ch * 16) = pack8(t); } }
        __syncthreads();
        TMARK(ta0);
        v4u pp[4]; bf16_t* op = YR + (size_t)qrow0 * 2048 + h * 512 + eh * 256 + 32 * w + (size_t)((hv * 32 + rv) >> 2) * 2048 + ((hv * 32 + rv) & 3) * 8;
        if (s >= SPLIT) {
#pragma unroll
            for (int x4 = 0; x4 < 4; ++x4) pp[x4] = *(const v4u*)(op + (size_t)(16 * x4) * 2048); }
        if (latent) {
            { typedef float f32x4_t __attribute__((ext_vector_type(4)));
              const int i0 = 16 * (w >> 1), j0 = 32 * (w & 1), l15 = rv & 15, g4 = (hv << 1) | (rv >> 4);
              const LAS unsigned char* qp = lds + QS + (i0 + l15) * QSTR + g4 * 16; const LAS unsigned char* kp0 = lds + KS + (j0 + l15) * KSTR + g4 * 16; const LAS unsigned char* kp1 = kp0 + 16 * KSTR;
              f32x4_t s0 = (f32x4_t){0.f, 0.f, 0.f, 0.f}, s1 = s0;
              bf16x8 qn = *(const LAS bf16x8*)qp, k0n = *(const LAS bf16x8*)kp0, k1n = *(const LAS bf16x8*)kp1;
#pragma unroll
              for (int kk = 0; kk < 8; ++kk) { const bf16x8 qc = qn, k0c = k0n, k1c = k1n;
                if (kk + 1 < 8) { qn = *(const LAS bf16x8*)(qp + (kk + 1) * 64); k0n = *(const LAS bf16x8*)(kp0 + (kk + 1) * 64); k1n = *(const LAS bf16x8*)(kp1 + (kk + 1) * 64); }
                __builtin_amdgcn_sched_barrier(0);
                s0 = __builtin_amdgcn_mfma_f32_16x16x32_bf16(k0c, qc, s0, 0, 0, 0); s1 = __builtin_amdgcn_mfma_f32_16x16x32_bf16(k1c, qc, s1, 0, 0, 0); }
              const int i = i0 + l15;
#pragma unroll
              for (int t2 = 0; t2 < 2; ++t2) { const f32x4_t sv = t2 ? s1 : s0; const int jb = j0 + 16 * t2 + 4 * g4; float v4[4];
#pragma unroll
                for (int k = 0; k < 4; ++k) { const int j = jb + k; const bool keep = dir ? (j >= i) : (j <= i); v4[k] = keep ? sv[k] : 0.f; }
                v2u pw; pw.x = cvt_pk_bf16(v4[0], v4[1]); pw.y = cvt_pk_bf16(v4[2], v4[3]);
                *(LAS v2u*)(lds + PS + i * PSTR + jb * 2) = pw; } }
            TMARK(ta1);
            f32x16 acc[2]; acc[0] = (f32x16){0.f}; acc[1] = (f32x16){0.f};
            { const LAS unsigned char* q0 = lds + qA; const LAS unsigned char* q1 = lds + qA + 32 * QSTR;
              bf16x8 n0 = *(const LAS bf16x8*)q0, n1 = *(const LAS bf16x8*)q1, m0 = *(const LAS bf16x8*)(q0 + 32), m1 = *(const LAS bf16x8*)(q1 + 32);
#pragma unroll
              for (int ix = 0; ix < 16; ++ix) { const int T = ix >> 1, s2 = ix & 1; const bf16x8 a0 = n0, a1 = n1; n0 = m0; n1 = m1;
                if (ix + 2 < 16) { m0 = *(const LAS bf16x8*)(q0 + (ix + 2) * 32); m1 = *(const LAS bf16x8*)(q1 + (ix + 2) * 32); }
                v4u bw; bw.x = cvt_pk_bf16(S[T][8 * s2 + 0], S[T][8 * s2 + 1]); bw.y = cvt_pk_bf16(S[T][8 * s2 + 2], S[T][8 * s2 + 3]);
                bw.z = cvt_pk_bf16(S[T][8 * s2 + 4], S[T][8 * s2 + 5]); bw.w = cvt_pk_bf16(S[T][8 * s2 + 6], S[T][8 * s2 + 7]); const bf16x8 bs = __builtin_bit_cast(bf16x8, bw);
                __builtin_amdgcn_sched_barrier(0);
                acc[0] = __builtin_amdgcn_mfma_f32_32x32x16_bf16(a0, bs, acc[0], 0, 0, 0); acc[1] = __builtin_amdgcn_mfma_f32_32x32x16_bf16(a1, bs, acc[1], 0, 0, 0); } }
            TMARK(ta2);
            __syncthreads();
            LOADV(sn);
            TMARK(ta3);
            { bf16x8 vn = cat(tr_read(lds + vtr), tr_read(lds + vtr + 4 * VSTR)), pn0 = *(const LAS bf16x8*)(lds + pA), pn1 = *(const LAS bf16x8*)(lds + pA + 32 * PSTR);
#pragma unroll
              for (int js = 0; js < 4; ++js) { const bf16x8 vfj = vn, p0 = pn0, p1 = pn1;
                if (js + 1 < 4) { vn = cat(tr_read(lds + vtr + (16 * (js + 1)) * VSTR), tr_read(lds + vtr + (16 * (js + 1) + 4) * VSTR)); pn0 = *(const LAS bf16x8*)(lds + pA + (js + 1) * 32); pn1 = *(const LAS bf16x8*)(lds + pA + 32 * PSTR + (js + 1) * 32); }
                __builtin_amdgcn_sched_barrier(0);
                acc[0] = __builtin_amdgcn_mfma_f32_32x32x16_bf16(p0, vfj, acc[0], 0, 0, 0); acc[1] = __builtin_amdgcn_mfma_f32_32x32x16_bf16(p1, vfj, acc[1], 0, 0, 0); } }
#pragma unroll
            for (int it = 0; it < 2; ++it) {
#pragma unroll
                for (int q = 0; q < 16; ++q) { const int il = crow(q, hv); const int i = it * 32 + il; const float rf = __builtin_amdgcn_exp2f(lg2s * (float)(dir ? -i : i - 63));
                    *(LAS float*)(ost + il * OSTR + rv * 4) = acc[it][q] * rf; }
#pragma unroll
                for (int n = 0; n < 2; ++n) { const int c = (hv * 32 + rv) + 64 * n, row = c >> 2, cq = c & 3;
                    const v4f x0 = *(const LAS v4f*)(ost + row * OSTR + cq * 32), x1 = *(const LAS v4f*)(ost + row * OSTR + cq * 32 + 16);
                    float o[8] = {x0.x, x0.y, x0.z, x0.w, x1.x, x1.y, x1.z, x1.w};
                    if (s >= SPLIT) { float pv[8]; unpack8(pp[2 * it + n], pv); float ss = 0.f;
#pragma unroll
                        for (int k = 0; k < 8; ++k) { o[k] += pv[k]; ss += o[k] * o[k]; }
                        ss += __shfl_xor(ss, 1); ss += __shfl_xor(ss, 2);
                        if (cq == 0) *(LAS float*)(lds + SSL + ((it * 32 + row) * 8 + w) * 4) = ss; }
                    *(v4u*)(op + (size_t)(it * 32 + 16 * n) * 2048) = pack8(o); }
            }
        }
        TMARK(ta4);
        __builtin_amdgcn_sched_barrier(0);
        PREFETCHK(sn);
        PREFETCHQ(sn);
        if (!latent) LOADV(sn);
        {
#define KA_LD(ix_) cat(tr_read(lds + ktr + (16 * ((ix_) >> 3)) * KSTR + ((ix_) & 7) * 64), tr_read(lds + ktr + (16 * ((ix_) >> 3) + 4) * KSTR + ((ix_) & 7) * 64))
#define VF_LD(js_) cat(tr_read(lds + vtr + (16 * (js_)) * VSTR), tr_read(lds + vtr + (16 * (js_) + 4) * VSTR))
          bf16x8 vcur = VF_LD(0), vnx = vcur, kn0 = KA_LD(0), kn1 = KA_LD(1);
#pragma unroll
          for (int ix = 0; ix < 32; ++ix) { const int T = ix & 7, js = ix >> 3; const bf16x8 ka = kn0; kn0 = kn1;
            if (ix + 2 < 32) kn1 = KA_LD(ix + 2);
            if (T == 4 && js < 3) vnx = VF_LD(js + 1);
            __builtin_amdgcn_sched_barrier(0);
            S[T] = __builtin_amdgcn_mfma_f32_32x32x16_bf16(ka, vcur, S[T], 0, 0, 0);
            if (T == 7) vcur = vnx; }
#undef KA_LD
#undef VF_LD
        }
#pragma unroll
        for (int T = 0; T < 8; ++T) S[T] *= gC;
        TMARK(ta5);
        __syncthreads();
        TMARK(ta6);
        if (s >= SPLIT && tid < 64) { const LAS float* pr = (const LAS float*)(lds + SSL + tid * 32); const v4f a = *(const LAS v4f*)pr, c4 = *(const LAS v4f*)(pr + 4);
            SSQ[(size_t)(qrow0 + tid) * 8 + h * 2 + eh] = ((a.x + a.y) + (a.z + a.w)) + ((c4.x + c4.y) + (c4.z + c4.w)); }
    }
#if MK_TIMING
    if (unit == 0 && tid == 0) { unsigned* tw = (unsigned*)SSQ - 64; tw[0] = ta0; tw[1] = ta1; tw[2] = ta2; tw[3] = ta3; tw[4] = ta4; tw[5] = ta5; tw[6] = ta6; }
#endif
#undef STEP_ROWS
#undef PREFETCHK
#undef PREFETCHQ
#undef WRITEQ
#undef LOADV
}
}

constexpr int RING_BYTES = 131072, LDS_BYTES = 157696;
#ifndef MK_ONE_LAUNCH
#define MK_ONE_LAUNCH 1
#endif
constexpr int N_PHASES = 10;
#define LDS_WAIT() asm volatile("s_waitcnt lgkmcnt(0)" ::: "memory")
constexpr int MISC_OFF = 155648 + 320;
constexpr int CW_BAR = 4096;
constexpr size_t CTL_ZERO_BYTES = 65536;
#ifndef MK_NAIVE_ATTN
#define MK_NAIVE_ATTN 0
#endif
#ifndef MK_NAIVE_RET
#define MK_NAIVE_RET 0
#endif
#ifndef MK_DEBUG_ATTN
#define MK_DEBUG_ATTN 0
#endif
#ifndef MK_DBG_H
#define MK_DBG_H 0
#endif
#ifndef MK_DBG_L0
#define MK_DBG_L0 768
#define MK_DBG_L1 1280
#endif
#ifndef MK_DEBUG_RET
#define MK_DEBUG_RET 0
#endif
#ifndef MK_STAMP_A
#define MK_STAMP_A -1
#define MK_STAMP_B -1
#endif
#ifndef MK_REP_P4
#define MK_REP_P4 1
#endif
#ifndef MK_REP_P5
#define MK_REP_P5 1
#endif
#ifndef MK_REP_P6
#define MK_REP_P6 1
#endif
#ifndef MK_REP_P2
#define MK_REP_P2 1
#endif
#ifndef MK_REP_P9
#define MK_REP_P9 1
#endif
#ifndef MK_NSTAG
#define MK_NSTAG 1
#define MK_STAG_TICKS 500
#endif
#ifndef MK_ATTN_PROBE
#define MK_ATTN_PROBE 0
#endif
#ifndef MK_MIX
#define MK_MIX 0
#endif
#ifndef MK_EPIW
#define MK_EPIW 16
#endif
#ifndef MK_BARRIER
#define MK_BARRIER 1
#endif
#define XB_TMO      128
#define XB_XCNT(j)  (256  + 64 * (j))
#define XB_XSUB(j)  (1280 + 64 * (j))
#define XB_XGEN(j)  (2304 + 64 * (j))
#define XB_TOP      3328
#define XB_TOPGEN   3392
#define XCD_BAR_WORDS 3456
#define XB_SPIN_CAP (1u << 18)

__device__ __forceinline__ unsigned xb_ld(unsigned* p)              { return __hip_atomic_load(p, __ATOMIC_RELAXED, __HIP_MEMORY_SCOPE_AGENT); }
__device__ __forceinline__ unsigned xb_add(unsigned* p, unsigned v) { return __hip_atomic_fetch_add(p, v, __ATOMIC_RELAXED, __HIP_MEMORY_SCOPE_AGENT); }
__device__ __forceinline__ unsigned xb_xcc_id() { return (unsigned)__builtin_amdgcn_s_getreg((3 << 11) | 20) & 0xFu; }
#define XB_SPIN(cond, bar) do { unsigned _sp = 0; while (cond) { __builtin_amdgcn_s_sleep(1); \
    if ((++_sp & 255u) == 0u) { if (xb_ld(&(bar)[XB_TMO])) break; if (_sp > XB_SPIN_CAP) { atomicAdd(&(bar)[XB_TMO], 1u); break; } } } } while (0)

struct XcdBarrier {
    unsigned* bar; unsigned x;
    volatile LAS unsigned* st;
};

__device__ __forceinline__ XcdBarrier xcd_barrier_post(unsigned* bar, volatile LAS unsigned* st) {
    XcdBarrier b; b.bar = bar; b.x = xb_xcc_id(); b.st = st;
    if (threadIdx.x == 0) (void)xb_add(&bar[XB_XCNT(b.x)], 1u);
    return b;
}
__device__ __forceinline__ void xcd_barrier_complete(unsigned* bar, unsigned x, unsigned& nloc, unsigned& nx) {
    const unsigned G = gridDim.x * gridDim.y * gridDim.z;
    unsigned sum, cnt, mine, sp = 0u;
    for (;;) {
        sum = 0u; cnt = 0u; mine = 0u;
#pragma unroll
        for (unsigned j = 0; j < 16; ++j) { const unsigned c = xb_ld(&bar[XB_XCNT(j)]); sum += c; cnt += (c > 0u) ? 1u : 0u; mine = (j == x) ? c : mine; }
        if (sum == G) break;
        __builtin_amdgcn_s_sleep(1);
        if ((++sp & 255u) == 0u) { if (xb_ld(&bar[XB_TMO])) break; if (sp > XB_SPIN_CAP) { atomicAdd(&bar[XB_TMO], 1u); break; } }
    }
    nloc = mine > 0u ? mine : 1u; nx = cnt > 0u ? cnt : 1u;
}

__device__ __forceinline__ void xcd_barrier(const XcdBarrier& b) {
    asm volatile("s_waitcnt vmcnt(0)" ::: "memory");
    __syncthreads();
    if (threadIdx.x == 0) {
        unsigned* bar = b.bar;
        __builtin_amdgcn_s_waitcnt(0);
        unsigned nloc = b.st[0], nx = b.st[1];
        if (nloc == 0u) { xcd_barrier_complete(bar, b.x, nloc, nx); b.st[0] = nloc; b.st[1] = nx; }
        const unsigned old = xb_add(&bar[XB_XSUB(b.x)], 1u);
        const unsigned gen = old / nloc;
        if (old + 1u == (gen + 1u) * nloc) {
            __builtin_amdgcn_fence(__ATOMIC_RELEASE, "agent");
            asm volatile("s_waitcnt vmcnt(0)" ::: "memory");
            const unsigned og = xb_add(&bar[XB_TOP], 1u);
            const unsigned tg = og / nx;
            if (og + 1u == (tg + 1u) * nx) xb_add(&bar[XB_TOPGEN], 1u);
            else XB_SPIN(xb_ld(&bar[XB_TOPGEN]) == tg, bar);
            __builtin_amdgcn_fence(__ATOMIC_ACQUIRE, "agent");
            xb_add(&bar[XB_XGEN(b.x)], 1u);
            asm volatile("s_waitcnt vmcnt(0)" ::: "memory");
        } else {
            XB_SPIN(xb_ld(&bar[XB_XGEN(b.x)]) == gen, bar);
            __builtin_amdgcn_fence(__ATOMIC_ACQUIRE, "agent");
            asm volatile("s_waitcnt vmcnt(0)" ::: "memory");
        }
    }
    __syncthreads();
}


struct Args { const float* in[14]; float* out; unsigned char* ws; int ph_lo, ph_hi; };

__device__ __forceinline__ void p0_mod_item(const float* c, const float* c_ctx, const float* w_ada, const float* b_ada, float* MOD, float* ldsf, int item, int tid) {
    float* sc = ldsf; float* red = ldsf + 17 * 1024;
    for (int i = tid; i < 17 * 1024; i += NTHR) { const float v = i < 16 * 1024 ? c[i] : c_ctx[i - 16 * 1024]; sc[i] = v / (1.0f + expf(-v)); }
    const int col = tid & 15, ks = tid >> 4, n = item * 16 + col;
    float wv[32];
#pragma unroll
    for (int k = 0; k < 32; ++k) wv[k] = w_ada[(size_t)(ks * 32 + k) * 3072 + n];
    __syncthreads();
    float acc[17];
#pragma unroll
    for (int r = 0; r < 17; ++r) acc[r] = 0.f;
#pragma unroll
    for (int k = 0; k < 32; ++k) {
#pragma unroll
        for (int r = 0; r < 17; ++r) acc[r] += sc[r * 1024 + ks * 32 + k] * wv[k]; }
#pragma unroll
    for (int r = 0; r < 17; ++r) red[(ks * 17 + r) * 16 + col] = acc[r];
    __syncthreads();
    if (tid < 17 * 16) { const int r = tid >> 4, cc = tid & 15; float s = b_ada[item * 16 + cc];
        for (int k2 = 0; k2 < 32; ++k2) s += red[(k2 * 17 + r) * 16 + cc];
        MOD[r * 3072 + item * 16 + cc] = s; }
    __syncthreads();
}
__device__ __forceinline__ void p0_transpose_item(const float* W, int K, int N, bf16_t* WT, int row_off, float* scr, int item, int lane) {
    const int nblk = N / 32, kb = item / nblk, nb = item % nblk, k0 = 64 * kb, n0 = 32 * nb;
    float tv[32];
#pragma unroll
    for (int i = 0; i < 32; ++i) { const int kk = 2 * i + (lane >> 5); tv[i] = W[(size_t)(k0 + kk) * N + n0 + (lane & 31)]; }
#pragma unroll
    for (int i = 0; i < 32; ++i) { const int kk = 2 * i + (lane >> 5); scr[kk * 33 + (lane & 31)] = tv[i]; }
    LDS_WAIT(); asm volatile("" ::: "memory");
    const int c = lane & 7;
#pragma unroll
    for (int j = 0; j < 4; ++j) { const int n = (lane >> 3) + 8 * j; const float* s = scr + (8 * c) * 33 + n;
        v4u o; o.x = pk2(s[0 * 33], s[1 * 33]); o.y = pk2(s[2 * 33], s[3 * 33]); o.z = pk2(s[4 * 33], s[5 * 33]); o.w = pk2(s[6 * 33], s[7 * 33]);
        *(v4u*)(WT + (size_t)(row_off + n0 + n) * K + k0 + 8 * c) = o; }
    LDS_WAIT(); asm volatile("" ::: "memory");
}
__device__ __forceinline__ void p0_transpose64_item(const float* W, int K, int N, bf16_t* WT, int row_off, float* scr, int item, int lane) {
    const int nblk = N / 64, kb = item / nblk, nb = item % nblk, k0 = 64 * kb, n0 = 64 * nb;
    v4f tv[16]; const int lr = lane >> 4, lc = (lane & 15) * 4;
#pragma unroll
    for (int i = 0; i < 16; ++i) tv[i] = *(const v4f*)(W + (size_t)(k0 + 4 * i + lr) * N + n0 + lc);
#pragma unroll
    for (int i = 0; i < 16; ++i) { float* d = scr + (4 * i + lr) * 65 + lc; d[0] = tv[i].x; d[1] = tv[i].y; d[2] = tv[i].z; d[3] = tv[i].w; }
    LDS_WAIT(); asm volatile("" ::: "memory");
    const int c = lane & 7;
#pragma unroll
    for (int j = 0; j < 8; ++j) { const int n = (lane >> 3) + 8 * j; const float* s = scr + (8 * c) * 65 + n;
        v4u o; o.x = pk2(s[0 * 65], s[1 * 65]); o.y = pk2(s[2 * 65], s[3 * 65]); o.z = pk2(s[4 * 65], s[5 * 65]); o.w = pk2(s[6 * 65], s[7 * 65]);
        *(v4u*)(WT + (size_t)(row_off + n0 + n) * K + k0 + 8 * c) = o; }
    LDS_WAIT(); asm volatile("" ::: "memory");
}
__device__ __forceinline__ int new_col(int o) { return o < 4608 ? o : (o < 6656 ? o + 1024 : (o < 7680 ? o - 2048 : o)); }

__device__ __forceinline__ void sincos_d(double a, float& c, float& s) {
    const double TWO_PI = 6.283185307179586476925;
    const double k = (double)(long long)(a / TWO_PI + (a >= 0 ? 0.5 : -0.5)); const double r = a - k * TWO_PI, r2 = r * r;
    double ts = r, ss = r, tc = 1.0, cc = 1.0;
    for (int n = 1; n <= 15; ++n) { tc *= -r2 / (double)((2 * n - 1) * (2 * n)); cc += tc; ts *= -r2 / (double)((2 * n) * (2 * n + 1)); ss += ts; }
    c = (float)cc; s = (float)ss;
}

__device__ __forceinline__ void p1_row(const float* xrow, const float* nw, const float* shift, const float* scale, bf16_t* orow, int lane) {
    const v4f* xr = (const v4f*)xrow + lane; v4f v[4]; float s = 0.f;
#pragma unroll
    for (int j = 0; j < 4; ++j) { v[j] = xr[64 * j]; s += (v[j].x * v[j].x + v[j].y * v[j].y) + (v[j].z * v[j].z + v[j].w * v[j].w); }
    const float rstd = 1.0f / sqrtf(wave_sum(s) * (1.0f / 1024.0f) + EPS);
    v2u* o8 = (v2u*)orow + lane;
#pragma unroll
    for (int j = 0; j < 4; ++j) { const v4f w = ((const v4f*)nw)[lane + 64 * j], sh = ((const v4f*)shift)[lane + 64 * j], sc = ((const v4f*)scale)[lane + 64 * j];
        const v4f y = v[j] * rstd * w * (sc + 1.0f) + sh; v2u o; o.x = pk2(y.x, y.y); o.y = pk2(y.z, y.w); o8[64 * j] = o; }
}

template <int NR>
__device__ __forceinline__ void p1_rowsN(const float* x, const float* ctx, const float* MOD, const v4f (&nwv)[4], bf16_t* HX, int r0, int rlast, int lane) {
    v4f v[NR][4];
#pragma unroll
    for (int k = 0; k < NR; ++k) { const int m = r0 + k < rlast ? r0 + k : rlast; const float* xr = m < MLAT ? x + (size_t)m * 1024 : ctx + (size_t)(m - MLAT) * 1024;
#pragma unroll
        for (int j = 0; j < 4; ++j) v[k][j] = __builtin_nontemporal_load((const v4f*)xr + lane + 64 * j); }
#pragma unroll
    for (int k = 0; k < NR; ++k) { const int m = r0 + k < rlast ? r0 + k : rlast; const float* mp = MOD + (m < MLAT ? (m >> 11) : 16) * 3072; float s = 0.f;
        v4f sh[4], sc[4];
#pragma unroll
        for (int j = 0; j < 4; ++j) { sh[j] = ((const v4f*)mp)[lane + 64 * j]; sc[j] = ((const v4f*)(mp + 1024))[lane + 64 * j]; }
#pragma unroll
        for (int j = 0; j < 4; ++j) s += (v[k][j].x * v[k][j].x + v[k][j].y * v[k][j].y) + (v[k][j].z * v[k][j].z + v[k][j].w * v[k][j].w);
        const float rstd = 1.0f / sqrtf(wave_sum(s) * (1.0f / 1024.0f) + EPS);
        v2u* o8 = (v2u*)(HX + (size_t)m * 1024) + lane;
#pragma unroll
        for (int j = 0; j < 4; ++j) { const v4f y = v[k][j] * rstd * nwv[j] * (sc[j] + 1.0f) + sh[j]; v2u o; o.x = pk2(y.x, y.y); o.y = pk2(y.z, y.w); o8[64 * j] = o; } }
}

__device__ __forceinline__ void p3_item(bf16_t* buf, int ldlog2, bool isK, const float* nw, const float* ROPE, size_t item, int lane) {
    const size_t e = item * 512 + (size_t)lane * 8; const size_t row = e >> ldlog2; const int col = (int)(e & ((1u << ldlog2) - 1)), d0 = col & 127;
    float t[8]; unpack8(*(const v4u*)(buf + e), t);
    float ss = 0.f;
#pragma unroll
    for (int k = 0; k < 8; ++k) ss += t[k] * t[k];
    ss += __shfl_xor(ss, 1); ss += __shfl_xor(ss, 2); ss += __shfl_xor(ss, 4); ss += __shfl_xor(ss, 8);
    const float rstd = 1.0f / sqrtf(ss * (1.0f / 128.0f) + EPS);
#pragma unroll
    for (int k = 0; k < 8; ++k) t[k] = t[k] * rstd * nw[d0 + k];
    int l; bool rope = true;
    if (isK) { const int p = (int)(row % LT); rope = p >= LC; l = p - LC; } else l = (int)(row & (SEQ - 1));
    if (rope) { const int ri = l >> 6, ci = l & 63, p0 = d0 >> 1; const float* tab = p0 < 32 ? ROPE + (ri * 32 + p0) * 2 : ROPE + (ci * 32 + (p0 - 32)) * 2;
#pragma unroll
        for (int q = 0; q < 4; ++q) { const float cs = tab[2 * q], sn = tab[2 * q + 1], x0 = t[2 * q], x1 = t[2 * q + 1]; t[2 * q] = x0 * cs - x1 * sn; t[2 * q + 1] = x0 * sn + x1 * cs; } }
    *(v4u*)(buf + e) = pack8(t);
}

template <int NI>
__device__ __forceinline__ void p3_items_k(bf16_t* AK, const float* nw, const float* ROPE, size_t it0, size_t itend, int lane, unsigned char* K8 = nullptr) {
    v4u raw[NI];
#pragma unroll
    for (int i = 0; i < NI; ++i) if (it0 + i < itend) raw[i] = *(const v4u*)(AK + (it0 + i) * 512 + (size_t)lane * 8);
#pragma unroll
    for (int i = 0; i < NI; ++i) if (it0 + i < itend) {
        const size_t e = (it0 + i) * 512 + (size_t)lane * 8; const size_t row = e >> 8; const int d0 = (int)(e & 255) & 127;
        float t[8]; unpack8(raw[i], t); float ss = 0.f;
#pragma unroll
        for (int k = 0; k < 8; ++k) ss += t[k] * t[k];
        ss += __shfl_xor(ss, 1); ss += __shfl_xor(ss, 2); ss += __shfl_xor(ss, 4); ss += __shfl_xor(ss, 8);
        const float rstd = 1.0f / sqrtf(ss * (1.0f / 128.0f) + EPS);
#pragma unroll
        for (int k = 0; k < 8; ++k) t[k] = t[k] * rstd * nw[d0 + k];
        const int p = (int)(row % LT);
        if (p >= LC) { const int l = p - LC, ri = l >> 6, ci = l & 63, p0 = d0 >> 1; const float* tab = p0 < 32 ? ROPE + (ri * 32 + p0) * 2 : ROPE + (ci * 32 + (p0 - 32)) * 2;
#pragma unroll
            for (int q = 0; q < 4; ++q) { const float cs = tab[2 * q], sn = tab[2 * q + 1], x0 = t[2 * q], x1 = t[2 * q + 1]; t[2 * q] = x0 * cs - x1 * sn; t[2 * q + 1] = x0 * sn + x1 * cs; } }
        *(v4u*)(AK + e) = pack8(t);
#if MK_FP8K
        if (K8) { int w0 = __builtin_amdgcn_cvt_pk_fp8_f32(t[0], t[1], 0, false); w0 = __builtin_amdgcn_cvt_pk_fp8_f32(t[2], t[3], w0, true);
            int w1 = __builtin_amdgcn_cvt_pk_fp8_f32(t[4], t[5], 0, false); w1 = __builtin_amdgcn_cvt_pk_fp8_f32(t[6], t[7], w1, true);
            const int g = ((int)(e & 255)) >> 7, pb = (d0 & 64) + 32 * ((d0 >> 3) & 1) + 8 * ((d0 >> 4) & 3); v2u w; w.x = (unsigned)w0; w.y = (unsigned)w1;
            *(v2u*)(K8 + row * 256 + g * 128 + pb) = w; }
#endif
        }
}

__device__ __forceinline__ void vt8_item(const bf16_t* AV, unsigned char* VT8, LAS unsigned char* scr, int item, int lane) {
    const int T = item % 36, bg = item / 36, b = bg >> 1, g = bg & 1;
    const bf16_t* src = AV + ((size_t)(b * LT + 64 * T)) * 256 + g * 128;
    v4u v[16];
#pragma unroll
    for (int i = 0; i < 16; ++i) { const int ci = lane + 64 * i, row = ci >> 4, c16 = ci & 15; v[i] = *(const v4u*)(src + (size_t)row * 256 + c16 * 8); }
#pragma unroll
    for (int i = 0; i < 16; ++i) { const int ci = lane + 64 * i, row = ci >> 4, c16 = ci & 15; *(LAS v4u*)(scr + row * 272 + c16 * 16) = v[i]; }
    asm volatile("s_waitcnt lgkmcnt(0)" ::: "memory");
    unsigned char* dst = VT8 + (size_t)item * 8192;
#pragma unroll
    for (int j = 0; j < 8; ++j) { const int oc = lane + 64 * j, d = oc >> 2, cc = oc & 3; float f[16];
#pragma unroll
        for (int i = 0; i < 16; ++i) { const int key = 32 * (cc >> 1) + (i & 3) + 8 * ((i >> 2) & 3) + 4 * (cc & 1); f[i] = bf2f(*(const LAS unsigned short*)(scr + key * 272 + d * 2)); }
        v4u w;
        { int a = __builtin_amdgcn_cvt_pk_fp8_f32(f[0], f[1], 0, false); a = __builtin_amdgcn_cvt_pk_fp8_f32(f[2], f[3], a, true); w.x = (unsigned)a; }
        { int a = __builtin_amdgcn_cvt_pk_fp8_f32(f[4], f[5], 0, false); a = __builtin_amdgcn_cvt_pk_fp8_f32(f[6], f[7], a, true); w.y = (unsigned)a; }
        { int a = __builtin_amdgcn_cvt_pk_fp8_f32(f[8], f[9], 0, false); a = __builtin_amdgcn_cvt_pk_fp8_f32(f[10], f[11], a, true); w.z = (unsigned)a; }
        { int a = __builtin_amdgcn_cvt_pk_fp8_f32(f[12], f[13], 0, false); a = __builtin_amdgcn_cvt_pk_fp8_f32(f[14], f[15], a, true); w.w = (unsigned)a; }
        *(v4u*)(dst + d * 64 + cc * 16) = w; }
    asm volatile("s_waitcnt lgkmcnt(0)" ::: "memory");
}

__device__ __forceinline__ void p4_naive_item(const bf16_t* RQ, const bf16_t* RK, const bf16_t* RV, bf16_t* YR, float* SSQ, const float* l2d, float* ldsf, int item, int tid) {
    const int rb = item & 255, h = (item >> 8) & 3, b = item >> 10, i0 = rb * 8;
    float* qs = ldsf; float* sc = ldsf + 2048; float* red = sc + 8 * LT;
    for (int t = tid; t < 2048; t += NTHR) { const int r = t >> 8, d = t & 255; qs[t] = bf2f(RQ[((size_t)(b * SEQ + i0 + r)) * 1024 + h * 256 + d]); }
    __syncthreads();
    const float lgf = log1pf(-exp2f(l2d[h])), lgb = log1pf(-exp2f(l2d[4 + h]));
    for (int p = tid; p < LT; p += NTHR) {
        const bf16_t* kr = RK + ((size_t)(b * LT + p)) * 1024 + h * 256;
        float dot[8];
#pragma unroll
        for (int r = 0; r < 8; ++r) dot[r] = 0.f;
        for (int d8 = 0; d8 < 32; ++d8) { float kk[8]; unpack8(*(const v4u*)(kr + d8 * 8), kk);
#pragma unroll
            for (int r = 0; r < 8; ++r)
#pragma unroll
                for (int k = 0; k < 8; ++k) dot[r] += qs[r * 256 + d8 * 8 + k] * kk[k]; }
#pragma unroll
        for (int r = 0; r < 8; ++r) { const int i = i0 + r; float W;
            if (p < LC) W = MK_DBG_NOCTX ? 0.f : expf(lgf * (float)(i + LC - p)) + expf(lgb * (float)(SEQ - i + p));
            else { const int j = p - LC; W = (j <= i ? expf(lgf * (float)(i - j)) : 0.f) + (j >= i ? expf(lgb * (float)(j - i)) : 0.f); }
            sc[r * LT + p] = dot[r] * W; }
    }
    __syncthreads();
    float acc[8];
#pragma unroll
    for (int r = 0; r < 8; ++r) acc[r] = 0.f;
    const bf16_t* vp = RV + (size_t)(b * LT) * 2048 + h * 512 + tid;
    for (int p = 0; p < LT; ++p) { const float v = bf2f(vp[(size_t)p * 2048]);
#pragma unroll
        for (int r = 0; r < 8; ++r) acc[r] += sc[r * LT + p] * v; }
    const int wid = tid >> 6, lane = tid & 63;
#pragma unroll
    for (int r = 0; r < 8; ++r) { YR[((size_t)(b * SEQ + i0 + r)) * 2048 + h * 512 + tid] = (bf16_t)f2bf(acc[r]); const float s = wave_sum(acc[r] * acc[r]); if (lane == 0) red[r * 8 + wid] = s; }
    __syncthreads();
    if (tid < 16) { const int r = tid >> 1, hf = tid & 1; const float s = (red[r * 8 + hf * 4] + red[r * 8 + hf * 4 + 1]) + (red[r * 8 + hf * 4 + 2] + red[r * 8 + hf * 4 + 3]);
        SSQ[((size_t)(b * SEQ + i0 + r)) * 8 + h * 2 + hf] = s; }
    __syncthreads();
}

__device__ __forceinline__ void p5_naive_item(bf16_t* AQ, const bf16_t* AK, const bf16_t* AV, float* ldsf, int item, int tid) {
    const int rb = item & 255, head = (item >> 8) & 7, b = item >> 11, g = head >> 2, i0 = rb * 8;
    float* qs = ldsf; float* sc = ldsf + 1024;
    for (int t = tid; t < 1024; t += NTHR) { const int r = t >> 7, d = t & 127; qs[t] = bf2f(AQ[((size_t)(b * SEQ + i0 + r)) * 1024 + head * 128 + d]); }
    __syncthreads();
    for (int p = tid; p < LT; p += NTHR) {
        const bf16_t* kr = AK + ((size_t)(b * LT + p)) * 256 + g * 128;
        float dot[8];
#pragma unroll
        for (int r = 0; r < 8; ++r) dot[r] = 0.f;
        for (int d8 = 0; d8 < 16; ++d8) { float kk[8]; unpack8(*(const v4u*)(kr + d8 * 8), kk);
#pragma unroll
            for (int r = 0; r < 8; ++r)
#pragma unroll
                for (int k = 0; k < 8; ++k) dot[r] += qs[r * 128 + d8 * 8 + k] * kk[k]; }
#pragma unroll
        for (int r = 0; r < 8; ++r) sc[r * LT + p] = dot[r] * 0.08838834764831845f;
    }
    __syncthreads();
    { const int wid = tid >> 6, lane = tid & 63; float* row = sc + wid * LT; float m = -1e30f;
      for (int p = lane; p < LT; p += 64) m = fmaxf(m, row[p]);
#pragma unroll
      for (int o = 1; o < 64; o <<= 1) m = fmaxf(m, __shfl_xor(m, o));
      float s = 0.f;
      for (int p = lane; p < LT; p += 64) { const float ex = expf(row[p] - m); row[p] = ex; s += ex; }
      s = wave_sum(s); const float inv = 1.0f / s;
      for (int p = lane; p < LT; p += 64) row[p] *= inv; }
    __syncthreads();
    const int e = tid & 127, r0 = (tid >> 7) * 2; float a0 = 0.f, a1 = 0.f;
    const bf16_t* vp = AV + (size_t)(b * LT) * 256 + g * 128 + e;
    for (int p = 0; p < LT; ++p) { const float v = bf2f(vp[(size_t)p * 256]); a0 += sc[r0 * LT + p] * v; a1 += sc[(r0 + 1) * LT + p] * v; }
    AQ[((size_t)(b * SEQ + i0 + r0)) * 1024 + head * 128 + e] = (bf16_t)f2bf(a0);
    AQ[((size_t)(b * SEQ + i0 + r0 + 1)) * 1024 + head * 128 + e] = (bf16_t)f2bf(a1);
    __syncthreads();
}

#if MK_BARRIER == 1
struct GridBarF { XcdBarrier b; __device__ __forceinline__ void operator()() const { xcd_barrier(b); } };
#else
struct GridBarF { __device__ __forceinline__ void operator()() const { cooperative_groups::this_grid().sync(); } };
#endif
__device__ __forceinline__ void ssq_item(const bf16_t* YR, float* SSQ, int it, int lane) {
    const int row = it >> 2, head = it & 3; float t[8]; unpack8(*(const v4u*)(YR + (size_t)row * 2048 + head * 512 + lane * 8), t);
    float ss = 0.f;
#pragma unroll
    for (int k = 0; k < 8; ++k) ss += t[k] * t[k];
    ss = wave_sum(ss);
    if (lane == 0) { SSQ[(size_t)row * 8 + head * 2] = ss; SSQ[(size_t)row * 8 + head * 2 + 1] = 0.f; }
}
__global__ void __launch_bounds__(NTHR, 2) mk_fwd(Args args) {
    extern __shared__ __attribute__((aligned(16))) unsigned char lds[];
    const int tid = threadIdx.x, lane = tid & 63, wave = __builtin_amdgcn_readfirstlane(tid >> 6);
    const int G = gridDim.x, bid = blockIdx.x;
    const int gw = bid * NWAVES + wave, NGW = G * NWAVES;
    float* ldsf = (float*)lds;
    unsigned char* ws = args.ws;
    const float *x = args.in[0], *cvec = args.in[1], *ctx = args.in[2], *c_ctx = args.in[3], *norm_w = args.in[4], *w_ada = args.in[5], *b_ada = args.in[6], *w_in = args.in[7],
                *l2d = args.in[8], *q_norm_w = args.in[9], *k_norm_w = args.in[10], *w_o_ret = args.in[11], *w_o_att = args.in[12], *w_out = args.in[13];
    float* MOD = (float*)(ws + WS_MOD); float* ROPE = (float*)(ws + WS_ROPE); float* SSQ = (float*)(ws + WS_SSQ);
    bf16_t *WIN = (bf16_t*)(ws + WS_WIN), *WOR = (bf16_t*)(ws + WS_WOR), *WOA = (bf16_t*)(ws + WS_WOA), *WOUT = (bf16_t*)(ws + WS_WOUT), *HX = (bf16_t*)(ws + WS_HX);
    bf16_t *RK = (bf16_t*)(ws + WS_RK), *RV = (bf16_t*)(ws + WS_RV), *RQ = (bf16_t*)(ws + WS_RQ), *AK = (bf16_t*)(ws + WS_AK), *AV = (bf16_t*)(ws + WS_AV), *AQ = (bf16_t*)(ws + WS_AQ);
    bf16_t *U1 = (bf16_t*)(ws + WS_U1), *U2 = (bf16_t*)(ws + WS_U2), *YR = (bf16_t*)args.out;
    const int lo = args.ph_lo, hi = args.ph_hi;
#define IN(k) (lo <= (k) && (k) < hi)
#define BOTH(k) (IN(k) && IN((k) + 1))
    if (tid < 32) ((LAS unsigned*)(lds + MISC_OFF))[tid] = 0u;
    __syncthreads();
#if MK_BARRIER == 1
    XcdBarrier bar; bar.bar = (unsigned*)(ws + WS_CTL) + CW_BAR; bar.x = 0; bar.st = nullptr;
    if (hi - lo > 1) bar = xcd_barrier_post((unsigned*)(ws + WS_CTL) + CW_BAR, (volatile LAS unsigned*)(lds + MISC_OFF) + 8);
#define GRID_BAR() xcd_barrier(bar)
#else
#define GRID_BAR() cooperative_groups::this_grid().sync()
#endif

#if MK_STAMP_A >= 0
#define STAMP(k) do { if (bid == 0 && tid == 0) { if ((k) == MK_STAMP_A) ((volatile LAS unsigned*)(lds + MISC_OFF))[17] = (unsigned)__builtin_amdgcn_s_memrealtime(); if ((k) == MK_STAMP_B) ((volatile LAS unsigned*)(lds + MISC_OFF))[18] = (unsigned)__builtin_amdgcn_s_memrealtime(); } } while (0)
#else
#define STAMP(k) do { } while (0)
#endif
#define STAGGER() do { if (MK_NSTAG > 1) { const unsigned grp = ((unsigned)bid >> 3) % MK_NSTAG; const unsigned long long t0_ = __builtin_amdgcn_s_memrealtime(); \
        while (__builtin_amdgcn_s_memrealtime() - t0_ < (unsigned long long)grp * MK_STAG_TICKS) __builtin_amdgcn_s_sleep(16); } } while (0)
    STAMP(0);
    if (IN(0)) {
        for (int it = bid; it < 192; it += G) p0_mod_item(cvec, c_ctx, w_ada, b_ada, MOD, ldsf, it, tid);
        if (bid == G - 1) for (int t = tid; t < 2048; t += NTHR) { const int v = t >> 5, i = t & 31; double fd = 1.0; for (int k = 0; k < i; ++k) fd *= 0.7498942093324559;
            const float ang = (float)v * (float)fd; float cs, sn; sincos_d((double)ang, cs, sn); ROPE[2 * t] = cs; ROPE[2 * t + 1] = sn; }
        if (BOTH(0)) GRID_BAR();
    }
    STAMP(1);
    if (IN(1)) {
        {
        float* scr = ldsf + wave * (64 * 65);
        constexpr int I_IN = 16 * (NIN / 64), I_OR = 32 * 16, I_OA = 16 * 16, I_OUT = 16 * 16;
        for (int it = gw; it < I_IN + I_OR + I_OA + I_OUT; it += NGW) {
            int r = it;
            if (r < I_IN) { const int n0 = 64 * (r % (NIN / 64)); p0_transpose64_item(w_in, 1024, NIN, WIN, new_col(n0) - n0, scr, r, lane); continue; } r -= I_IN;
            if (r < I_OR) { p0_transpose64_item(w_o_ret, 2048, 1024, WOR, 0, scr, r, lane); continue; } r -= I_OR;
            if (r < I_OA) { p0_transpose64_item(w_o_att, 1024, 1024, WOA, 0, scr, r, lane); continue; } r -= I_OA;
            p0_transpose64_item(w_out, 1024, 1024, WOUT, 0, scr, r, lane);
        }
        }
        {
            const int rpw = (MALL + NGW - 1) / NGW, m0 = gw * rpw, m1 = m0 + rpw < MALL ? m0 + rpw : MALL;
            v4f nwv[4];
#pragma unroll
            for (int j = 0; j < 4; ++j) nwv[j] = ((const v4f*)norm_w)[lane + 64 * j];
            for (int m = m0; m < m1; m += 9) p1_rowsN<9>(x, ctx, MOD, nwv, HX, m, m1 - 1, lane);
        }
        if (BOTH(1)) GRID_BAR();
    }
    STAMP(2);
    if (IN(2)) {
        STAGGER();
        pg8::Gemm g{HX, WIN, MALL, N1, 1024}; pg8::Sched1 S; S.init(G, bid);
        pg8::Epi1 E{RK, RV, AK, AV, RQ, AQ, nullptr};
#if MK_P2PROBE == 4
        { pg8::Epi1T<2> EC{RK, RV, AK, AV, RQ, AQ, nullptr}; pg8::gemm_phase<pg8::Epi1T<2>, pg8::Sched1, true, true, MK_EPIW>((PG8_LAS unsigned char*)lds, g, S, EC); }
        __syncthreads();
#endif
        for (int rep = 0; rep < MK_REP_P2; ++rep) pg8::gemm_phase<pg8::Epi1, pg8::Sched1, true, true, MK_EPIW>((PG8_LAS unsigned char*)lds, g, S, E);
#if MK_P2PROBE == 1
        { pg8::Epi1T<1> ED{RK, RV, AK, AV, RQ, AQ, (bf16_t*)(ws + WS_END)}; pg8::gemm_phase<pg8::Epi1T<1>, pg8::Sched1, true, true, MK_EPIW>((PG8_LAS unsigned char*)lds, g, S, ED); }
#endif
#if MK_P2PROBE == 3
        { pg8::Epi1T<0> ER{RK, RV, AK, AV, RQ, AQ, nullptr}; pg8::gemm_phase<pg8::Epi1T<0>, pg8::Sched1, true, true, MK_EPIW>((PG8_LAS unsigned char*)lds, g, S, ER); }
#endif
#if MK_P2PROBE == 2
        { pg8::EpiNull EN; pg8::gemm_phase<pg8::EpiNull, pg8::Sched1, true, true, 0>((PG8_LAS unsigned char*)lds, g, S, EN); }
#endif
        if (BOTH(2)) GRID_BAR();
    }
    STAMP(3);
#if MK_NAIVE_ATTN
    if (IN(3)) {
        constexpr size_t IQ = (size_t)MLAT * 1024 / 512, IK = (size_t)NB * LT * 256 / 512;
        for (size_t it = gw; it < IQ + IK; it += NGW) {
            if (it < IQ) p3_item(AQ, 10, false, q_norm_w, ROPE, it, lane); else p3_item(AK, 8, true, k_norm_w, ROPE, it - IQ, lane);
        }
        if (BOTH(3)) GRID_BAR();
    }
#endif
#if MK_DEBUG_ATTN
    {
        bf16_t* AQ2 = (bf16_t*)(ws + WS_RK); float* acc2 = (float*)(ws + WS_CTL) + 64;
        for (size_t i = (size_t)bid * NTHR + tid; i < (size_t)MLAT * 1024 / 8; i += (size_t)G * NTHR) ((v4u*)AQ2)[i] = ((const v4u*)AQ)[i];
        { int tl = threadIdx.x; asm volatile("" : "+v"(tl)); const int lane_l = tl & 63, gw_l = bid * NWAVES + (tl >> 6);
          constexpr size_t IK = (size_t)NB * LT * 256 / 512; for (size_t it = gw_l; it < IK; it += NGW) p3_item(AK, 8, true, k_norm_w, ROPE, it, lane_l); }
        GRID_BAR();
        { int tl = threadIdx.x; asm volatile("" : "+v"(tl)); const int lane_l = tl & 63, gw_l = bid * NWAVES + (tl >> 6);
          constexpr size_t IQ = (size_t)MLAT * 1024 / 512; for (size_t it = gw_l; it < IQ; it += NGW) p3_item(AQ2, 10, false, q_norm_w, ROPE, it, lane_l); }
        GRID_BAR();
        { const int vcu = (bid & 7) * (G >> 3) + (bid >> 3);
          for (int idx = vcu; idx < NB * AH * 8; idx += G) { const int qb = idx & 7, r = (idx >> 3) & 3, g = (idx >> 5) & 1, b = idx >> 6, head = g * 4 + r;
            bf16_t* Q = AQ + ((size_t)(b * SEQ + qb * 256)) * 1024 + head * 128; const bf16_t* K = AK + (size_t)(b * LT) * 256 + g * 128; const bf16_t* V = AV + (size_t)(b * LT) * 256 + g * 128;
            attn::attn_dense_body<attn::bf16>(Q, K, V, Q, LT, (char*)lds, q_norm_w, ROPE, qb * 256); } }
        __syncthreads();
        { const int vcu = (bid & 7) * (G >> 3) + (bid >> 3);
          for (int idx = vcu; idx < NB * AH * 8; idx += G) { const int qb = idx & 7, r = (idx >> 3) & 3, g = (idx >> 5) & 1, b = idx >> 6, head = g * 4 + r;
            bf16_t* Q = AQ2 + ((size_t)(b * SEQ + qb * 256)) * 1024 + head * 128; const bf16_t* K = AK + (size_t)(b * LT) * 256 + g * 128; const bf16_t* V = AV + (size_t)(b * LT) * 256 + g * 128;
            attn::attn_dense_body<attn::bf16>(Q, K, V, Q, LT, (char*)lds, nullptr, ROPE, qb * 256); } }
        GRID_BAR();
        float sd = 0.f, sb = 0.f;
        for (size_t i = (size_t)bid * NTHR + tid; i < (size_t)MLAT * 1024; i += (size_t)G * NTHR) { const float a = bf2f(AQ[i]), b2 = bf2f(AQ2[i]); sd += (a - b2) * (a - b2); sb += b2 * b2; }
        sd = wave_sum(sd); sb = wave_sum(sb);
        if (lane == 0) { atomicAdd(acc2, sd); atomicAdd(acc2 + 1, sb); }
        GRID_BAR();
        if (bid == 0 && tid == 0) { const float s0 = __hip_atomic_load(acc2, __ATOMIC_RELAXED, __HIP_MEMORY_SCOPE_AGENT), s1 = __hip_atomic_load(acc2 + 1, __ATOMIC_RELAXED, __HIP_MEMORY_SCOPE_AGENT);
            args.out[0] = 1e6f * sqrtf(s0 / s1); args.out[1] = 1e3f * sqrtf(s1 / ((float)MLAT * 1024.f)); }
        return;
    }
#endif
    STAMP(4);
#if MK_DEBUG_RET
    {
        bf16_t* YR2 = (bf16_t*)(ws + WS_AQ); float* acc2 = (float*)(ws + WS_CTL) + 64;
        for (int it = bid; it < 8 * RH * 256; it += G) p4_naive_item(RQ, RK, RV, YR, SSQ, l2d, ldsf, it, tid);
        __syncthreads();
        { GridBarF gb{bar}; ret::scan_unit(RQ, RK, RV, YR2, SSQ + 2 * MLAT * 8, l2d, (LAS unsigned char*)lds, bid, gb, 8); }
        GRID_BAR();
        float sd = 0.f, sb = 0.f;
        for (size_t i = (size_t)bid * NTHR + tid; i < (size_t)8 * SEQ * 2048; i += (size_t)G * NTHR) { const int l = (int)((i >> 11) & 2047); if (l < MK_DBG_L0 || l >= MK_DBG_L1 || (int)((i >> 9) & 3) != MK_DBG_H) continue; const float a = bf2f(YR2[i]), b2 = bf2f(YR[i]); sd += (a - b2) * (a - b2); sb += b2 * b2; }
        sd = wave_sum(sd); sb = wave_sum(sb);
        if (lane == 0) { atomicAdd(acc2, sd); atomicAdd(acc2 + 1, sb); }
        GRID_BAR();
        if (bid == 0 && tid == 0) { const float s0 = __hip_atomic_load(acc2, __ATOMIC_RELAXED, __HIP_MEMORY_SCOPE_AGENT), s1 = __hip_atomic_load(acc2 + 1, __ATOMIC_RELAXED, __HIP_MEMORY_SCOPE_AGENT);
            ((float*)(ws + WS_SSQ))[0] = 1e6f * sqrtf(s0 / s1); ((float*)(ws + WS_SSQ))[1] = 1e3f * sqrtf(s1 / (8.f * SEQ * 2048.f)); }
        GRID_BAR();
        if (bid == 0 && tid == 0) { args.out[0] = ((float*)(ws + WS_SSQ))[0]; args.out[1] = ((float*)(ws + WS_SSQ))[1]; }
        return;
    }
#endif
    if (IN(4)) {
        auto kfix = [&]() {
#if !MK_NAIVE_ATTN
          int tl = threadIdx.x; asm volatile("" : "+v"(tl)); const int lane_l = tl & 63, gw_l = bid * NWAVES + (tl >> 6);
          constexpr size_t IK = (size_t)NB * LT * 256 / 512; const size_t ipw = (IK + NGW - 1) / NGW, i0 = (size_t)gw_l * ipw, i1 = i0 + ipw < IK ? i0 + ipw : IK;
          for (size_t it = i0; it < i1; it += 3) p3_items_k<3>(AK, k_norm_w, ROPE, it, i1, lane_l, ws + WS_K8);
#if MK_FP8V
          { const int wv = __builtin_amdgcn_readfirstlane(tl >> 6); for (int it = gw_l; it < NB * 2 * 36; it += NGW) vt8_item(AV, ws + WS_VT8, (LAS unsigned char*)lds + wv * (64 * 272), it, lane_l); }
#endif
#endif
        };
#if MK_NAIVE_RET
        kfix(); for (int it = bid; it < NB * RH * 256; it += G) p4_naive_item(RQ, RK, RV, YR, SSQ, l2d, ldsf, it, tid);
#else
        if (G == 256) { GridBarF gb{bar}; ret::scan_unit(RQ, RK, RV, YR, SSQ, l2d, (LAS unsigned char*)lds, bid, gb, NB, kfix); if (MK_MIX && BOTH(4)) GRID_BAR(); }
        else { kfix(); for (int it = bid; it < NB * RH * 256; it += G) p4_naive_item(RQ, RK, RV, YR, SSQ, l2d, ldsf, it, tid); if (BOTH(4)) GRID_BAR(); }
#endif
    }
    STAMP(5);
    if (IN(5)) {
#if MK_NAIVE_ATTN
        for (int it = bid; it < NB * AH * 256; it += G) p5_naive_item(AQ, AK, AV, ldsf, it, tid);
#else
        const int vcu = (G % 8 == 0) ? (bid & 7) * (G >> 3) + (bid >> 3) : bid;
#define ATT_UNIT(idx_, Q_, K_, V_, qb_) const int qb_ = (idx_) & 7; bf16_t* Q_; const bf16_t *K_, *V_; \
            { const int r_ = ((idx_) >> 3) & 3, g_ = ((idx_) >> 5) & 1, b_ = (idx_) >> 6, head_ = g_ * 4 + r_; Q_ = AQ + ((size_t)(b_ * SEQ + qb_ * 256)) * 1024 + head_ * 128; \
              K_ = MK_FP8K ? (const bf16_t*)(ws + WS_K8 + ((size_t)(b_ * LT) * 256 + g_ * 128)) : AK + (size_t)(b_ * LT) * 256 + g_ * 128; V_ = MK_FP8V ? (const bf16_t*)(ws + WS_VT8 + (size_t)((b_ * 2 + g_) * 36) * 8192) : AV + (size_t)(b_ * LT) * 256 + g_ * 128; }
        auto run_attn = [&](const int nkeys, const bool store) {
        attn::Pre pre;
        if (vcu < NB * AH * 8) { ATT_UNIT(vcu, Q0, K0, V0, qb0); attn::attn_prefetch(Q0, K0, V0, pre); }
        for (int idx = vcu; idx < NB * AH * 8; idx += G) {
            ATT_UNIT(idx, Q, K, V, qb);
            const int nidx = idx + G; const bool hn = nidx < NB * AH * 8; ATT_UNIT(hn ? nidx : idx, Qn, Kn, Vn, qbn);
            attn::attn_dense_body<attn::bf16>(Q, K, V, store ? Q : (bf16_t*)nullptr, nkeys, (char*)lds, q_norm_w, ROPE, qb * 256, pre, Qn, Kn, Vn); __syncthreads();
        } };
#if MK_MIX
        auto run_gates = [&](int mode) { pg8::Gemm g{HX, WIN + (size_t)N1 * 1024, MLAT, NG, 1024}; pg8::SchedGates S; S.init(G, bid, mode); pg8::Epi5 E{YR, AQ, U1, U2, SSQ, 0};
            pg8::gemm_phase<pg8::Epi5, pg8::SchedGates, true, true, MK_EPIW>((PG8_LAS unsigned char*)lds, g, S, E); };
        const bool attn_first = (bid & 4) == 0;
        if (attn_first) { run_attn(LT, true); __syncthreads(); run_gates(0); } else { run_gates(0); __syncthreads(); run_attn(LT, true); }
        __syncthreads(); GRID_BAR(); run_gates(1);
#else
        for (int rep = 0; rep < (MK_ATTN_PROBE > 0 ? 2 : 1); ++rep) run_attn(rep ? MK_ATTN_PROBE : LT, rep == 0);
#endif
#undef ATT_UNIT
#endif
#if !MK_NAIVE_RET
        if (G != 256) { int tl = threadIdx.x; asm volatile("" : "+v"(tl)); const int lane_l = tl & 63, gw_l = bid * NWAVES + (tl >> 6);
          for (int it = gw_l; it < MLAT * 4; it += NGW) ssq_item(YR, SSQ, it, lane_l); }
#endif
        if (BOTH(5)) GRID_BAR();
    }
    STAMP(6);
    if (IN(6) && !MK_MIX) {
        STAGGER();
        pg8::Gemm g{HX, WIN + (size_t)N1 * 1024, MLAT, NG, 1024}; pg8::StaticOrder S; S.init(MLAT, NG, G, bid);
        pg8::Epi5 E{YR, AQ, U1, U2, SSQ, 0};
        pg8::gemm_phase<pg8::Epi5, pg8::StaticOrder, true, true, MK_EPIW>((PG8_LAS unsigned char*)lds, g, S, E);
        if (BOTH(6)) GRID_BAR();
    }
    STAMP(7);
    if (IN(7)) {
        pg8::Gemm g{YR, WOR, MLAT, 1024, 2048}; pg8::StaticOrder S; S.init(MLAT, 1024, G, bid);
        pg8::Epi6 E{U1};
        pg8::gemm_phase<pg8::Epi6, pg8::StaticOrder, true, true, MK_EPIW>((PG8_LAS unsigned char*)lds, g, S, E);
    }
    STAMP(8);
    if (IN(8)) {
        pg8::Gemm g{AQ, WOA, MLAT, 1024, 1024}; pg8::StaticOrder S; S.init(MLAT, 1024, G, bid);
        pg8::Epi7 E{U1, U2};
        pg8::gemm_phase<pg8::Epi7, pg8::StaticOrder, true, true, MK_EPIW>((PG8_LAS unsigned char*)lds, g, S, E);
        if (BOTH(8)) GRID_BAR();
    }
    STAMP(9);
    if (IN(9)) {
        pg8::Gemm g{U1, WOUT, MLAT, 1024, 1024}; pg8::StaticOrder S; S.init(MLAT, 1024, G, bid);
        pg8::Epi8 E{x, MOD, args.out};
        { pg8::RepOrder SR; SR.so = S; SR.reps = MK_REP_P9; pg8::gemm_phase<pg8::Epi8, pg8::RepOrder, true, true, MK_EPIW>((PG8_LAS unsigned char*)lds, g, SR, E); }
    }
    STAMP(10);
#if MK_TIMING
    if (bid == 0) { const unsigned spin = __builtin_amdgcn_readfirstlane(((const unsigned*)SSQ - 64)[MK_TSEL]); const unsigned long long t0_ = __builtin_amdgcn_s_memrealtime();
        while (__builtin_amdgcn_s_memrealtime() - t0_ < (unsigned long long)spin) __builtin_amdgcn_s_sleep(8); }
#endif
#if MK_STAMP_A >= 0
    __syncthreads();
    if (bid == 0) { __syncthreads(); const unsigned sp = ((volatile LAS unsigned*)(lds + MISC_OFF))[18] - ((volatile LAS unsigned*)(lds + MISC_OFF))[17]; const unsigned long long t0_ = __builtin_amdgcn_s_memrealtime();
        while (__builtin_amdgcn_s_memrealtime() - t0_ < (unsigned long long)sp) __builtin_amdgcn_s_sleep(8); }
#endif
#undef IN
#undef BOTH
}

extern "C" void kernel_launch(void* const* d_in, const int* in_sizes, int n_in, void* d_out, int out_size, void* d_ws, size_t ws_size, hipStream_t stream) {
    static int grid = 0;
    if (grid == 0) {
        if (n_in != 14 || in_sizes[0] != MLAT * DM || out_size != MLAT * DM || ws_size < WS_END) {
            fprintf(stderr, "kernel_launch: unexpected shapes: n_in %d in0 %d out %d ws %zu (need >= %zu)\n", n_in, n_in > 0 ? in_sizes[0] : -1, out_size, ws_size, (size_t)WS_END); grid = -1; return; }
        int dev = 0, cus = 0;
        if (hipGetDevice(&dev) != hipSuccess || hipDeviceGetAttribute(&cus, hipDeviceAttributeMultiprocessorCount, dev) != hipSuccess) { grid = -1; return; }
        if (hipFuncSetAttribute((const void*)mk_fwd, hipFuncAttributeMaxDynamicSharedMemorySize, LDS_BYTES) != hipSuccess) { fprintf(stderr, "kernel_launch: hipFuncSetAttribute failed\n"); grid = -1; return; }
        grid = cus;
    }
    if (grid < 0) return;
    Args a{};
    for (int i = 0; i < 14; ++i) a.in[i] = (const float*)d_in[i];
    a.out = (float*)d_out; a.ws = (unsigned char*)d_ws;
#if MK_ONE_LAUNCH
    a.ph_lo = 0; a.ph_hi = N_PHASES;
#if MK_BARRIER == 1
    if (hipMemsetAsync((char*)d_ws + WS_CTL, 0, CTL_ZERO_BYTES, stream) != hipSuccess) { fprintf(stderr, "kernel_launch: hipMemsetAsync failed\n"); return; }
    hipLaunchKernelGGL(mk_fwd, dim3(grid), dim3(NTHR), LDS_BYTES, stream, a);
#else
    void* kargs[] = {&a};
    const hipError_t ce = hipLaunchCooperativeKernel((const void*)mk_fwd, dim3(grid), dim3(NTHR), kargs, LDS_BYTES, stream);
    if (ce != hipSuccess) fprintf(stderr, "kernel_launch: cooperative launch failed: %s\n", hipGetErrorName(ce));
#endif
#else
    for (int ph = 0; ph < N_PHASES; ++ph) {
        a.ph_lo = ph; a.ph_hi = ph + 1;
        hipLaunchKernelGGL(mk_fwd, dim3(grid), dim3(NTHR), LDS_BYTES, stream, a);
    }
#endif
    const hipError_t le = hipPeekAtLastError();
    if (le != hipSuccess) fprintf(stderr, "kernel_launch: launch failed: %s\n", hipGetErrorName(le));
}
```

```cpp
#include <hip/hip_runtime.h>
#include <cstdio>
#include <cstdint>
#include <hip/hip_cooperative_groups.h>

constexpr int NB = 16, SEQ = 2048, DM = 1024, LC = 256, LT = LC + SEQ;
constexpr int MLAT = NB * SEQ, MCTX = NB * LC, MALL = MLAT + MCTX;
constexpr int RH = 4, RDK = 256, RDV = 512;
constexpr int AH = 8, AKV = 2, AHD = 128;
constexpr int NIN = 10752, NKV = 3584, N1 = 5632, NG = 5120;
constexpr float EPS = 1e-6f;
#ifndef MK_TIMING
#define MK_TIMING 0
#define MK_TSEL 0
#endif
#ifndef MK_WT
#define MK_WT 1
#endif
#ifndef MK_WT_AUX
#define MK_WT_AUX 18
#endif
#ifndef MK_FP8K
#define MK_FP8K 1
#endif
#ifndef MK_FP8G
#define MK_FP8G 2
#endif
#ifndef MK_FP8V
#define MK_FP8V 1
#endif
#ifndef MK_E6B
#define MK_E6B 4
#define MK_E7B 2
#define MK_E8B 2
#endif
#ifndef MK_E5B
#define MK_E5B 1
#endif
#ifndef MK_P2PROBE
#define MK_P2PROBE 0
#endif
#ifndef MK_RPROBE
#define MK_RPROBE 0
#endif
#ifndef MK_DBG_NOCTX
#define MK_DBG_NOCTX 0
#endif
constexpr int NWAVES = 8, NTHR = 512;
#define LAS __attribute__((address_space(3)))

typedef unsigned short bf16_t;
typedef unsigned v4u __attribute__((ext_vector_type(4)));
typedef unsigned v2u __attribute__((ext_vector_type(2)));
typedef float v4f __attribute__((ext_vector_type(4)));
typedef float v2f __attribute__((ext_vector_type(2)));

__device__ __forceinline__ float bf2f(unsigned h) { return __uint_as_float(h << 16); }
__device__ __forceinline__ unsigned f2bf(float f) { unsigned u = __float_as_uint(f); return (u + 0x7fffu + ((u >> 16) & 1u)) >> 16; }
__device__ __forceinline__ unsigned pk2(float lo, float hi) { return f2bf(lo) | (f2bf(hi) << 16); }
__device__ __forceinline__ float bflo(unsigned w) { return __uint_as_float(w << 16); }
__device__ __forceinline__ float bfhi(unsigned w) { return __uint_as_float(w & 0xffff0000u); }
__device__ __forceinline__ float fast_sigmoid(float x) { return __builtin_amdgcn_rcpf(1.0f + __builtin_amdgcn_exp2f(-1.4426950408889634f * x)); }
__device__ __forceinline__ float fast_silu(float x) { return x * fast_sigmoid(x); }
__device__ __forceinline__ void sigmoid4(const float (&x)[4], float (&s)[4]) {
    float a[4];
#pragma unroll
    for (int k = 0; k < 4; ++k) a[k] = 1.0f + __builtin_amdgcn_exp2f(-1.4426950408889634f * fmaxf(x[k], -20.0f));
    const float p01 = a[0] * a[1], p23 = a[2] * a[3], r = __builtin_amdgcn_rcpf(p01 * p23), r01 = r * p23, r23 = r * p01;
    s[0] = r01 * a[1]; s[1] = r01 * a[0]; s[2] = r23 * a[3]; s[3] = r23 * a[2];
}
__device__ __forceinline__ float sat8(float v) { return __builtin_amdgcn_fmed3f(v, -448.0f, 448.0f); }
__device__ __forceinline__ unsigned pk4_fp8(float a, float b, float c, float d) { int w = __builtin_amdgcn_cvt_pk_fp8_f32(sat8(a), sat8(b), 0, false); w = __builtin_amdgcn_cvt_pk_fp8_f32(sat8(c), sat8(d), w, true); return (unsigned)w; }
constexpr float F8W_MUL = 128.0f;  constexpr int F8W_SC = 0x78787878;
constexpr float F8Y_MUL = 64.0f;   constexpr int F8Y_SC = 0x79797979;
__device__ __forceinline__ float wave_sum(float v) {
#pragma unroll
    for (int o = 1; o < 64; o <<= 1) v += __shfl_xor(v, o);
    return v;
}

typedef __bf16 bf16x2_t __attribute__((ext_vector_type(2)));
__device__ __forceinline__ unsigned cvt_pk_bf16(float lo, float hi) { v2f v = {lo, hi}; bf16x2_t b = __builtin_convertvector(v, bf16x2_t); return __builtin_bit_cast(unsigned, b); }
__device__ __forceinline__ void unpack8(const v4u w, float (&o)[8]) {
    o[0] = bflo(w.x); o[1] = bfhi(w.x); o[2] = bflo(w.y); o[3] = bfhi(w.y); o[4] = bflo(w.z); o[5] = bfhi(w.z); o[6] = bflo(w.w); o[7] = bfhi(w.w);
}
__device__ __forceinline__ v4u pack8(const float (&o)[8]) {
    v4u w; w.x = cvt_pk_bf16(o[0], o[1]); w.y = cvt_pk_bf16(o[2], o[3]); w.z = cvt_pk_bf16(o[4], o[5]); w.w = cvt_pk_bf16(o[6], o[7]); return w;
}

constexpr size_t MiB = 1u << 20;
constexpr size_t WS_CTL = 0;
constexpr size_t WS_MOD = 1 * MiB;
constexpr size_t WS_ROPE = WS_MOD + 256 * 1024;
constexpr size_t WS_SSQ = 2 * MiB;
constexpr size_t WS_WIN = 4 * MiB;
constexpr size_t WS_WOR = 25 * MiB;
constexpr size_t WS_WOA = 29 * MiB;
constexpr size_t WS_WOUT = 31 * MiB;
constexpr size_t WS_HX = 33 * MiB;
constexpr size_t WS_RK = 105 * MiB;
constexpr size_t WS_RV = 177 * MiB;
constexpr size_t WS_RQ = 321 * MiB;
constexpr size_t WS_AK = 385 * MiB;
constexpr size_t WS_AV = 403 * MiB;
constexpr size_t WS_AQ = 421 * MiB;
constexpr size_t WS_K8 = 485 * MiB;
constexpr size_t WS_VT8 = 495 * MiB;
constexpr size_t WS_WOA8 = 505 * MiB;
constexpr size_t WS_WIN8 = 506 * MiB;
constexpr size_t WS_END = 508 * MiB;
constexpr size_t WS_YA8 = WS_RQ;
constexpr size_t WS_U1 = WS_RK;
constexpr size_t WS_U2 = WS_RV;

__host__ __device__ __forceinline__ int orig_col(int n) { return n < 4608 ? n : (n < 5632 ? n + 2048 : (n < 7680 ? n - 1024 : n)); }
namespace pg8 {
#define PG8_LAS __attribute__((address_space(3)))
typedef unsigned short bf16_t;
typedef short bf16x8 __attribute__((ext_vector_type(8)));
typedef float f32x4 __attribute__((ext_vector_type(4)));
typedef unsigned u32x4 __attribute__((ext_vector_type(4)));
constexpr int BM = 256, BK = 64, HALF = 128, HTB = HALF * BK * 2  , STAGE_BYTES = 8 * HTB, NXCD = 8, WGM = 8;

__host__ __device__ __forceinline__ int lds_byte(int r, int c) { const int st = (r >> 4) * 2 + (c >> 5), rr = r & 15, cc = c & 31, ob = rr * 64 + cc * 2; return st * 1024 + (ob ^ (((ob >> 9) & 1) << 5)); }
__host__ __device__ __forceinline__ void stage_rc(int b, int& R, int& C) { const int st = b / 1024, sb = b % 1024, swz = sb ^ (((sb >> 9) & 1) << 5); R = (st >> 1) * 16 + swz / 64; C = (st & 1) * 32 + (swz % 64) / 2; }
__host__ __device__ __forceinline__ int perm32(int rho) { const int n = rho >> 4, i = rho & 15; return 8 * (i >> 2) + 4 * n + (i & 3); }

struct Unit { int pm, pn; };
struct Gemm { const bf16_t* A; const bf16_t* Bt; int M, N, K; int scA = 0x7F7F7F7F, scB = 0x7F7F7F7F; };

struct StaticOrder {
    int nM, nN, nwg, G, c;
    __host__ __device__ void init(int M, int N, int G_, int c_) { nM = M / BM; nN = N / BM; nwg = nM * nN; G = G_; c = c_; }
    __host__ __device__ bool next(int i, Unit& u) const {
        const long L = (long)i * G + c; if (L >= nwg) return false;
        int wgid = (int)L; { const int q = nwg / NXCD, r = nwg % NXCD, xcd = wgid % NXCD, off = wgid / NXCD; wgid = (xcd < r ? xcd * (q + 1) : r * (q + 1) + (xcd - r) * q) + off; }
        const int nig = WGM * nN, gid = wgid / nig, fm = gid * WGM, gsz = (nM - fm) < WGM ? (nM - fm) : WGM;
        u.pm = fm + ((wgid % nig) % gsz); u.pn = (wgid % nig) / gsz; return true;
    }
    __device__ __forceinline__ void a_ready(const Unit&) const {}
    __device__ __forceinline__ void done(const Unit&) const {}
};


#if MK_WT
#define WT_RSRC(name, baseptr) const __amdgpu_buffer_rsrc_t name = __builtin_amdgcn_make_buffer_rsrc((void*)(baseptr), 0, 0x7ffffff0, 0x00020000)
#define WT_ST16(name, byteoff, val) __builtin_amdgcn_raw_buffer_store_b128((val), name, (unsigned)(byteoff), 0, MK_WT_AUX)
#endif
struct Sched1 {
    int G, c; StaticOrder so;
    __device__ void init(int G_, int c_) { G = G_; c = c_; so.init(MLAT, N1, G_, c_); }
    __device__ bool next(int i, Unit& u) const {
        long L = (long)i * G + c; if (L < 2816) return so.next(i, u);
        L -= 2816; if (L >= 224) return false;
        u.pm = 128 + (int)(L & 15); u.pn = (int)(L >> 4); return true;
    }
    __device__ __forceinline__ void a_ready(const Unit&) const {}
    __device__ __forceinline__ void done(const Unit&) const {}
};

struct SchedG1 {
    StaticOrder so; int G, c, mode, nlat, nctx, ncol;
    __device__ void init(int G_, int c_, int mode_) { G = G_; c = c_; mode = mode_; ncol = mode_ ? 6 : 16; so.init(MLAT, ncol * 256, G_, c_); nlat = 128 * ncol; nctx = mode_ ? 0 : 16 * 14; }
    __device__ bool next(int i, Unit& u) const {
        long L = (long)i * G + c;
        if (L < nlat) { so.next(i, u); if (!mode) u.pn = u.pn < 12 ? u.pn : u.pn + 2; return true; }
        L -= nlat; if (L >= nctx) return false;
        u.pm = 128 + (int)(L & 15); u.pn = (int)(L >> 4); return true;
    }
    __device__ __forceinline__ void a_ready(const Unit&) const {}
    __device__ __forceinline__ void done(const Unit&) const {}
};
struct SchedGates {
    StaticOrder so; int mode;
    __device__ void init(int G_, int c_, int mode_) { mode = mode_; so.init(MLAT, (mode_ ? 4 : 16) * 256, G_, c_); }
    __device__ bool next(int i, Unit& u) const { if (!so.next(i, u)) return false; u.pn = mode ? u.pn + 8 : (u.pn < 8 ? u.pn : u.pn + 4); return true; }
    __device__ __forceinline__ void a_ready(const Unit&) const {}
    __device__ __forceinline__ void done(const Unit&) const {}
};
struct RepOrder {
    StaticOrder so; int reps;
    __device__ bool next(int i, Unit& u) const { const int per = (so.nwg - so.c + so.G - 1) / so.G; if (i >= per * reps) return false; return so.next(i % per, u); }
    __device__ __forceinline__ void a_ready(const Unit&) const {}
    __device__ __forceinline__ void done(const Unit&) const {}
};

#define EPI_ROWS_BEGIN const int rt0 = wr * 64 + fr, ct0 = wc * 32 + 8 * fq; \
    _Pragma("unroll") for (int ai = 0; ai < 2; ++ai) _Pragma("unroll") for (int m = 0; m < 4; ++m) { const int rt = rt0 + ai * HALF + m * 16;
#define EPI_ROWS_END }

template <int DUM> struct Epi1T {
    static constexpr bool PERM = true, AFTER_DRAIN = false;
    bf16_t *RK, *RV, *AK, *AV, *RQ, *AQ; bf16_t* DUMMY;
    __device__ __forceinline__ void operator()(const f32x4 (&acc)[2][2][4][2], const Unit& u, int wr, int wc, int fr, int fq) const {
        const int pm = u.pm, pn = u.pn;
        const int kvrow0 = pm < 128 ? ((pm >> 3) * LT + LC + (pm & 7) * 256) : ((pm - 128) * LT);
        bf16_t* base; int ld; float sc = 1.f;
        if (pn < 4) { base = RK + (size_t)kvrow0 * 1024 + pn * 256; ld = 1024; sc = 0.0625f; }
        else if (pn < 12) { base = RV + (size_t)kvrow0 * 2048 + (pn - 4) * 256; ld = 2048; }
        else if (pn == 12) { base = AK + (size_t)kvrow0 * 256; ld = 256; }
        else if (pn == 13) { base = AV + (size_t)kvrow0 * 256; ld = 256; }
        else if (pn < 18) { base = RQ + (size_t)pm * 256 * 1024 + (pn - 14) * 256; ld = 1024; }
        else { base = AQ + (size_t)pm * 256 * 1024 + (pn - 18) * 256; ld = 1024; }
#if MK_P2PROBE
        if constexpr (DUM == 1) { base = DUMMY + (size_t)blockIdx.x * 32768; ld = 256; }
        if constexpr (DUM == 2) {
            const int rb = kvrow0 >> 8;
            if (pn < 4) base = RK + ((size_t)rb * 4 + pn) * 65536; else if (pn < 12) base = RV + ((size_t)rb * 8 + (pn - 4)) * 65536;
            else if (pn < 14) { } else if (pn < 18) base = RQ + ((size_t)pm * 4 + (pn - 14)) * 65536; else base = AQ + ((size_t)pm * 4 + (pn - 18)) * 65536;
            ld = 256; }
#endif
#if (MK_WT & 1)
        const __amdgpu_buffer_rsrc_t rs = __builtin_amdgcn_make_buffer_rsrc((void*)base, 0, 0x7ffffff0, 0x00020000);
#endif
        EPI_ROWS_BEGIN
            bf16_t* rowp = base + (size_t)(DUM == 1 ? (rt & 127) : rt) * ld + ct0;
#pragma unroll
            for (int bj = 0; bj < 2; ++bj) { const f32x4 v0 = acc[ai][bj][m][0] * sc, v1 = acc[ai][bj][m][1] * sc;
                u32x4 w; w.x = cvt_pk_bf16(v0[0], v0[1]); w.y = cvt_pk_bf16(v0[2], v0[3]); w.z = cvt_pk_bf16(v1[0], v1[1]); w.w = cvt_pk_bf16(v1[2], v1[3]);
#if (MK_WT & 1)
                __builtin_amdgcn_raw_buffer_store_b128(w, rs, (unsigned)(((DUM == 1 ? (rt & 127) : rt) * ld + ct0 + bj * HALF) * 2), 0, MK_WT_AUX);
#else
                *(u32x4*)(rowp + bj * HALF) = w;
#endif
                }
        EPI_ROWS_END
    }
};

typedef Epi1T<0> Epi1;
struct Epi1F8 {
    static constexpr bool PERM = true, AFTER_DRAIN = false;
    Epi1 e;
    __device__ __forceinline__ void operator()(const f32x4 (&acc)[2][2][4][2], const Unit& u, int wr, int wc, int fr, int fq) const { Unit v = u; v.pn = u.pn < 2 ? 12 + u.pn : 16 + u.pn; e(acc, v, wr, wc, fr, fq); }
};
#define EPI_FOR_PIECES _Pragma("unroll") for (int ai = 0; ai < 2; ++ai) _Pragma("unroll") for (int m = 0; m < 4; ++m) _Pragma("unroll") for (int bj = 0; bj < 2; ++bj)
struct Epi5 {
    static constexpr bool PERM = true, AFTER_DRAIN = false;
    bf16_t *YR, *YA, *U1, *U2; const float* SSQ; int dry_unused; unsigned char* YA8;
    __device__ __forceinline__ void operator()(const f32x4 (&acc)[2][2][4][2], const Unit& u, int wr, int wc, int fr, int fq) const {
        const int pn = u.pn; const size_t row0 = (size_t)u.pm * 256;
        if (pn < 8) {
            const int head = pn >> 1;
            EPI_ROWS_BEGIN
                const size_t row = row0 + rt;
                const float ss = SSQ[row * 8 + head * 2] + SSQ[row * 8 + head * 2 + 1];
                const float rstd = __builtin_amdgcn_rsqf(ss * (1.0f / 512.0f) + EPS);
#pragma unroll
                for (int bj = 0; bj < 2; ++bj) { u32x4* p = (u32x4*)(YR + row * 2048 + pn * 256 + bj * HALF + ct0); float o[8]; unpack8(*p, o);
                    const f32x4 v0 = acc[ai][bj][m][0], v1 = acc[ai][bj][m][1];
                    { const float x0[4] = {v0[0], v0[1], v0[2], v0[3]}, x1[4] = {v1[0], v1[1], v1[2], v1[3]}; float s0[4], s1[4]; sigmoid4(x0, s0); sigmoid4(x1, s1);
#pragma unroll
                    for (int k = 0; k < 4; ++k) { o[k] = o[k] * rstd * (x0[k] * s0[k]); o[4 + k] = o[4 + k] * rstd * (x1[k] * s1[k]); } }
                    *p = pack8(o); }
            EPI_ROWS_END
        } else if (pn < 12) {
            EPI_ROWS_BEGIN
                const size_t row = row0 + rt;
#pragma unroll
                for (int bj = 0; bj < 2; ++bj) { u32x4* p = (u32x4*)(YA + row * 1024 + (pn - 8) * 256 + bj * HALF + ct0); float o[8]; unpack8(*p, o);
                    const f32x4 v0 = acc[ai][bj][m][0], v1 = acc[ai][bj][m][1];
                    { const float x0[4] = {v0[0], v0[1], v0[2], v0[3]}, x1[4] = {v1[0], v1[1], v1[2], v1[3]}; float s0[4], s1[4]; sigmoid4(x0, s0); sigmoid4(x1, s1);
#pragma unroll
                    for (int k = 0; k < 4; ++k) { o[k] = o[k] * (x0[k] * s0[k]); o[4 + k] = o[4 + k] * (x1[k] * s1[k]); } }
#if MK_FP8G
                    { v2u w; w.x = pk4_fp8(o[0] * F8Y_MUL, o[1] * F8Y_MUL, o[2] * F8Y_MUL, o[3] * F8Y_MUL); w.y = pk4_fp8(o[4] * F8Y_MUL, o[5] * F8Y_MUL, o[6] * F8Y_MUL, o[7] * F8Y_MUL);
                      *(v2u*)(YA8 + row * 1024 + (pn - 8) * 256 + bj * HALF + ct0) = w; }
#else
                    *p = pack8(o);
#endif
                    }
            EPI_ROWS_END
        } else {
            bf16_t* U = pn < 16 ? U1 + (pn - 12) * 256 : U2 + (pn - 16) * 256;
            EPI_ROWS_BEGIN
                const size_t row = row0 + rt;
#pragma unroll
                for (int bj = 0; bj < 2; ++bj) { float o[8]; const f32x4 v0 = acc[ai][bj][m][0], v1 = acc[ai][bj][m][1];
                    { const float x0[4] = {v0[0], v0[1], v0[2], v0[3]}, x1[4] = {v1[0], v1[1], v1[2], v1[3]}; float s0[4], s1[4]; sigmoid4(x0, s0); sigmoid4(x1, s1);
#pragma unroll
                    for (int k = 0; k < 4; ++k) { o[k] = s0[k]; o[4 + k] = s1[k]; } }
                    *(u32x4*)(U + row * 1024 + bj * HALF + ct0) = pack8(o); }
            EPI_ROWS_END
        }
    }
};

struct Epi6 {
    static constexpr bool PERM = true, AFTER_DRAIN = false;
    bf16_t* U1;
    __device__ __forceinline__ void operator()(const f32x4 (&acc)[2][2][4][2], const Unit& u, int wr, int wc, int fr, int fq) const {
        bf16_t* base = U1 + ((size_t)u.pm * 256 + wr * 64 + fr) * 1024 + u.pn * 256 + wc * 32 + 8 * fq;
#if (MK_WT & 2)
        WT_RSRC(rs, U1 + (size_t)u.pm * 256 * 1024 + u.pn * 256);
#endif
#pragma unroll
        for (int ai = 0; ai < 2; ++ai)
#pragma unroll
          for (int mb = 0; mb < 4; mb += MK_E6B) {
            u32x4 pc[MK_E6B][2];
#pragma unroll
            for (int mi = 0; mi < MK_E6B; ++mi)
#pragma unroll
                for (int bj = 0; bj < 2; ++bj) pc[mi][bj] = *(const u32x4*)(base + (size_t)(ai * HALF + (mb + mi) * 16) * 1024 + bj * HALF);
#pragma unroll
            for (int mi = 0; mi < MK_E6B; ++mi)
#pragma unroll
                for (int bj = 0; bj < 2; ++bj) { const int m = mb + mi; float o[8]; unpack8(pc[mi][bj], o); const f32x4 v0 = acc[ai][bj][m][0], v1 = acc[ai][bj][m][1];
#pragma unroll
                    for (int k = 0; k < 4; ++k) { o[k] *= v0[k]; o[4 + k] *= v1[k]; }
                    *(u32x4*)(base + (size_t)(ai * HALF + m * 16) * 1024 + bj * HALF) = pack8(o); }
          }
    }
};
struct Epi7 {
    static constexpr bool PERM = true, AFTER_DRAIN = false;
    bf16_t* U1; const bf16_t* U2;
    __device__ __forceinline__ void operator()(const f32x4 (&acc)[2][2][4][2], const Unit& u, int wr, int wc, int fr, int fq) const {
        const size_t off0 = ((size_t)u.pm * 256 + wr * 64 + fr) * 1024 + u.pn * 256 + wc * 32 + 8 * fq;
#if (MK_WT & 4)
        WT_RSRC(rs, U1 + (size_t)u.pm * 256 * 1024 + u.pn * 256);
#endif
#pragma unroll
        for (int q4 = 0; q4 < 8; q4 += MK_E7B) {
            const int ai = q4 >> 2, mb = q4 & 3; u32x4 pc[MK_E7B][2], pg[MK_E7B][2];
#pragma unroll
            for (int m2 = 0; m2 < MK_E7B; ++m2)
#pragma unroll
                for (int bj = 0; bj < 2; ++bj) { const size_t off = off0 + (size_t)(ai * HALF + (mb + m2) * 16) * 1024 + bj * HALF; pc[m2][bj] = *(const u32x4*)(U1 + off); pg[m2][bj] = *(const u32x4*)(U2 + off); }
#pragma unroll
            for (int m2 = 0; m2 < MK_E7B; ++m2)
#pragma unroll
                for (int bj = 0; bj < 2; ++bj) { const int m = mb + m2; const size_t off = off0 + (size_t)(ai * HALF + m * 16) * 1024 + bj * HALF; float o[8], g[8]; unpack8(pc[m2][bj], o); unpack8(pg[m2][bj], g);
                    const f32x4 v0 = acc[ai][bj][m][0], v1 = acc[ai][bj][m][1];
#pragma unroll
                    for (int k = 0; k < 4; ++k) { o[k] += g[k] * v0[k]; o[4 + k] += g[4 + k] * v1[k]; }
                    *(u32x4*)(U1 + off) = pack8(o); }
        }
    }
};
struct Epi8 {
    static constexpr bool PERM = true, AFTER_DRAIN = false;
    const float* X; const float* MOD; float* OUT;
    __device__ __forceinline__ void operator()(const f32x4 (&acc)[2][2][4][2], const Unit& u, int wr, int wc, int fr, int fq) const {
        const int col0 = u.pn * 256 + wc * 32 + 8 * fq; const size_t off0 = ((size_t)u.pm * 256 + wr * 64 + fr) * 1024 + col0; const float* gate = MOD + (size_t)(u.pm >> 3) * 3072 + 2048 + col0;
        f32x4 gv[2][2];
#if (MK_WT & 8)
        WT_RSRC(rs, OUT + (size_t)u.pm * 256 * 1024 + u.pn * 256);
#endif
#pragma unroll
        for (int bj = 0; bj < 2; ++bj)
#pragma unroll
            for (int n = 0; n < 2; ++n) gv[bj][n] = *(const f32x4*)(gate + bj * HALF + 4 * n);
#pragma unroll
        for (int q4 = 0; q4 < 8; q4 += MK_E8B) {
            const int ai = q4 >> 2, mb = q4 & 3; f32x4 xv[MK_E8B][2][2];
#pragma unroll
            for (int m2 = 0; m2 < MK_E8B; ++m2)
#pragma unroll
                for (int bj = 0; bj < 2; ++bj)
#pragma unroll
                    for (int n = 0; n < 2; ++n) xv[m2][bj][n] = *(const f32x4*)(X + off0 + (size_t)(ai * HALF + (mb + m2) * 16) * 1024 + bj * HALF + 4 * n);
#pragma unroll
            for (int m2 = 0; m2 < MK_E8B; ++m2)
#pragma unroll
                for (int bj = 0; bj < 2; ++bj)
#pragma unroll
                    for (int n = 0; n < 2; ++n) *(f32x4*)(OUT + off0 + (size_t)(ai * HALF + (mb + m2) * 16) * 1024 + bj * HALF + 4 * n) = xv[m2][bj][n] + gv[bj][n] * acc[ai][bj][mb + m2][n];
        }
    }
};
struct EpiNull {
    static constexpr bool PERM = true, AFTER_DRAIN = false;
    __device__ __forceinline__ void operator()(const f32x4 (&acc)[2][2][4][2], const Unit& u, int wr, int wc, int fr, int fq) const {
#pragma unroll
        for (int ai = 0; ai < 2; ++ai)
#pragma unroll
            for (int bj = 0; bj < 2; ++bj)
#pragma unroll
                for (int m = 0; m < 4; ++m)
#pragma unroll
                    for (int n = 0; n < 2; ++n) asm volatile("" :: "v"(acc[ai][bj][m][n]));
    }
};
template <int N> __device__ __forceinline__ void wait_vm_sel(int sel) { asm volatile("s_waitcnt vmcnt(%1)\n\ts_cmp_lg_u32 %0, 0\n\ts_cbranch_scc1 .Lwvs%=\n\ts_waitcnt vmcnt(8)\n.Lwvs%=:" :: "s"(sel), "n"(N) : "memory", "scc"); }
typedef int v8i_t __attribute__((ext_vector_type(8))); typedef int v4i_t __attribute__((ext_vector_type(4)));
__device__ __forceinline__ v8i_t cat8(const bf16x8 lo, const bf16x8 hi) { const v4i_t a = __builtin_bit_cast(v4i_t, lo), b = __builtin_bit_cast(v4i_t, hi); return (v8i_t){a.x, a.y, a.z, a.w, b.x, b.y, b.z, b.w}; }
__device__ __forceinline__ void mx16(f32x4& c, const v8i_t a, const v8i_t b, const int sca, const int scb) {
    asm volatile("v_mfma_scale_f32_16x16x128_f8f6f4 %0, %1, %2, %0, %3, %4 op_sel_hi:[0,0,0]" : "+v"(c) : "v"(a), "v"(b), "v"(sca), "v"(scb)); }
template <class Epi, class Sched, bool ALIGN_EPI = false, bool SP2 = false, int EPIW = 0, bool F8 = false>
__device__ __forceinline__ void gemm_phase(PG8_LAS unsigned char* lds, const Gemm g, const Sched& S, const Epi& E) {
    const int tid = threadIdx.x, wid = __builtin_amdgcn_readfirstlane(tid >> 6), lane = tid & 63, wr = wid >> 2, wc = wid & 3, fr = lane & 15, fq = lane >> 4;
    int Kv = g.K; if constexpr (F8) asm volatile("" : "+s"(Kv));
    const int K = Kv, nt = K / BK;
    int mxsa = g.scA, mxsb = g.scB; if constexpr (F8) asm volatile("" : "+v"(mxsa), "+v"(mxsb));
    unsigned voffA[2], voffB[2];
#pragma unroll
    for (int i = 0; i < 2; ++i) { int R, C; stage_rc(tid * 16 + i * 8192, R, C); const int Rb = Epi::PERM ? ((R & ~31) + perm32(R & 31)) : R;
        voffA[i] = (unsigned)(R * K + C) * 2u; voffB[i] = (unsigned)(Rb * K + C) * 2u; }
    const size_t kstep = (size_t)(BK * 2);
    const size_t hstep = (size_t)HALF * K * 2;
    const size_t tstep = 2 * hstep;
    const unsigned ldsw = (unsigned)wid * 1024u;
    const int aoff = lds_byte(wr * 64 + fr, fq * 8), boff = lds_byte(wc * 32 + fr, fq * 8);
#define PG8_SA(b, h) (((b) * 2 + (h)) * HTB)
#define PG8_SB(b, h) ((4 + (b) * 2 + (h)) * HTB)
#define PG8_STAGE(bufoff, gbase, voff) do { _Pragma("unroll") for (int _i = 0; _i < 2; ++_i) \
        __builtin_amdgcn_global_load_lds((const unsigned*)((const char*)(gbase) + (voff)[_i]), (PG8_LAS unsigned*)(lds + (bufoff) + ldsw + _i * 8192), 16, 0, 0); } while (0)
#define PG8_LDA(dst, b, h) do { _Pragma("unroll") for (int m = 0; m < 4; ++m) _Pragma("unroll") for (int k = 0; k < 2; ++k) dst[m][k] = *(const PG8_LAS bf16x8*)(lds + PG8_SA(b, h) + aoff + m * 2048 + k * 1024); } while (0)
#define PG8_LDB(dst, b, h) do { _Pragma("unroll") for (int n = 0; n < 2; ++n) _Pragma("unroll") for (int k = 0; k < 2; ++k) dst[n][k] = *(const PG8_LAS bf16x8*)(lds + PG8_SB(b, h) + boff + n * 2048 + k * 1024); } while (0)
#define PG8_MMA(ai, bj, At, Bt) do { __builtin_amdgcn_s_setprio(1); \
        if constexpr (F8) { _Pragma("unroll") for (int m = 0; m < 4; ++m) _Pragma("unroll") for (int n = 0; n < 2; ++n) \
            mx16(acc[ai][bj][m][n], cat8(Bt[n][0], Bt[n][1]), cat8(At[m][0], At[m][1]), mxsb, mxsa); } \
        else { _Pragma("unroll") for (int m = 0; m < 4; ++m) _Pragma("unroll") for (int n = 0; n < 2; ++n) _Pragma("unroll") for (int k = 0; k < 2; ++k) \
            acc[ai][bj][m][n] = __builtin_amdgcn_mfma_f32_16x16x32_bf16(Bt[n][k], At[m][k], acc[ai][bj][m][n], 0, 0, 0); } \
        __builtin_amdgcn_s_setprio(0); } while (0)
#define PG8_WAIT_V(n) asm volatile("s_waitcnt vmcnt(" #n ")" ::: "memory")
#define PG8_WAIT_L(n) asm volatile("s_waitcnt lgkmcnt(" #n ")" ::: "memory")
#define PG8_BAR __builtin_amdgcn_s_barrier()
#define PG8_SCHED __builtin_amdgcn_sched_barrier(0)
    Unit cur, nxt; int ui = 0;
    if (!S.next(0, cur)) return;
    f32x4 acc[2][2][4][2];
#pragma unroll
    for (int a = 0; a < 2; ++a)
#pragma unroll
        for (int b = 0; b < 2; ++b)
#pragma unroll
            for (int m = 0; m < 4; ++m)
#pragma unroll
                for (int n = 0; n < 2; ++n) acc[a][b][m][n] = (f32x4){0.f, 0.f, 0.f, 0.f};
    bf16x8 At[4][2], B0[2][2], B1[2][2];
    const char* cA = (const char*)g.A + (size_t)cur.pm * tstep; const char* cB = (const char*)g.Bt + (size_t)cur.pn * tstep;
    S.a_ready(cur);
    if constexpr (SP2) {
        PG8_STAGE(PG8_SB(0, 0), cB, voffB); PG8_STAGE(PG8_SB(0, 1), cB + hstep, voffB); PG8_STAGE(PG8_SA(0, 0), cA, voffA); PG8_STAGE(PG8_SA(0, 1), cA + hstep, voffA);
        if (wr == 1) PG8_BAR;
        PG8_WAIT_V(2); PG8_BAR;
        PG8_STAGE(PG8_SB(1, 0), cB + kstep, voffB); PG8_STAGE(PG8_SA(1, 0), cA + kstep, voffA); PG8_STAGE(PG8_SB(1, 1), cB + hstep + kstep, voffB);
        PG8_WAIT_V(6); PG8_BAR;
    } else {
        PG8_STAGE(PG8_SB(0, 0), cB, voffB); PG8_STAGE(PG8_SA(0, 0), cA, voffA); PG8_STAGE(PG8_SB(0, 1), cB + hstep, voffB); PG8_STAGE(PG8_SA(0, 1), cA + hstep, voffA);
        if (wr == 1) PG8_BAR;
        PG8_WAIT_V(4); PG8_BAR;
        PG8_STAGE(PG8_SB(1, 0), cB + kstep, voffB); PG8_STAGE(PG8_SA(1, 0), cA + kstep, voffA); PG8_STAGE(PG8_SB(1, 1), cB + hstep + kstep, voffB);
        PG8_WAIT_V(6); PG8_BAR;
    }
    for (;;) {
        const bool has_next = S.next(ui + 1, nxt);
        const char* nA = has_next ? (const char*)g.A + (size_t)nxt.pm * tstep : cA; const char* nB = has_next ? (const char*)g.Bt + (size_t)nxt.pn * tstep : cB;
        for (int t = 0; t < nt; t += 2) {
            const bool last = (t == nt - 2);
            const char* a1 = cA + (size_t)(t + 1) * kstep;
            const char* a2 = last ? nA : cA + (size_t)(t + 2) * kstep; const char* b2 = last ? nB : cB + (size_t)(t + 2) * kstep;
            const char* a3 = a2 + kstep; const char* b3 = b2 + kstep;
            if (last && has_next) S.a_ready(nxt);
            const int fe = __builtin_amdgcn_readfirstlane(((EPIW > 0) && (t == 0) && (ui > 0)) ? 1 : 0);
            if constexpr (SP2) {
            PG8_LDB(B0, 0, 0); PG8_LDB(B1, 0, 1); PG8_SCHED; PG8_LDA(At, 0, 0); PG8_STAGE(PG8_SA(1, 1), a1 + hstep, voffA);
            if constexpr (EPIW > 0) wait_vm_sel<8 + EPIW>(fe); else PG8_WAIT_V(8); PG8_WAIT_L(0); PG8_BAR; PG8_MMA(0, 0, At, B0); PG8_MMA(0, 1, At, B1); PG8_BAR; PG8_SCHED;
            PG8_LDA(At, 0, 1); PG8_STAGE(PG8_SB(0, 0), b2, voffB); PG8_STAGE(PG8_SB(0, 1), b2 + hstep, voffB); PG8_STAGE(PG8_SA(0, 0), a2, voffA);
            if constexpr (EPIW > 0) wait_vm_sel<8 + EPIW>(fe); else PG8_WAIT_V(8); PG8_WAIT_L(0); PG8_BAR; PG8_MMA(1, 0, At, B0); PG8_MMA(1, 1, At, B1); PG8_BAR; PG8_SCHED;
            PG8_LDB(B0, 1, 0); PG8_LDB(B1, 1, 1); PG8_SCHED; PG8_LDA(At, 1, 0); PG8_STAGE(PG8_SA(0, 1), a2 + hstep, voffA);
            PG8_WAIT_V(8); PG8_WAIT_L(0); PG8_BAR; PG8_MMA(0, 0, At, B0); PG8_MMA(0, 1, At, B1); PG8_BAR; PG8_SCHED;
            PG8_LDA(At, 1, 1); PG8_STAGE(PG8_SB(1, 0), b3, voffB); PG8_STAGE(PG8_SB(1, 1), b3 + hstep, voffB); PG8_STAGE(PG8_SA(1, 0), a3, voffA);
            PG8_WAIT_V(8); PG8_WAIT_L(0); PG8_BAR; PG8_MMA(1, 0, At, B0); PG8_MMA(1, 1, At, B1); PG8_BAR; PG8_SCHED;
            } else {
            PG8_LDB(B0, 0, 0); PG8_SCHED; PG8_LDA(At, 0, 0); PG8_STAGE(PG8_SA(1, 1), a1 + hstep, voffA);
            PG8_WAIT_L(8); PG8_BAR; PG8_WAIT_L(0); PG8_MMA(0, 0, At, B0); PG8_BAR; PG8_SCHED;
            PG8_LDB(B1, 0, 1); PG8_STAGE(PG8_SB(0, 0), b2, voffB);
            PG8_BAR; PG8_WAIT_L(0); PG8_MMA(0, 1, At, B1); PG8_BAR;
            PG8_LDA(At, 0, 1); PG8_STAGE(PG8_SA(0, 0), a2, voffA);
            PG8_BAR; PG8_WAIT_L(0); PG8_MMA(1, 0, At, B0); PG8_BAR; PG8_SCHED;
            PG8_STAGE(PG8_SB(0, 1), b2 + hstep, voffB);
            PG8_WAIT_V(6); PG8_BAR; PG8_MMA(1, 1, At, B1); PG8_BAR;
            PG8_LDB(B0, 1, 0); PG8_SCHED; PG8_LDA(At, 1, 0); PG8_STAGE(PG8_SA(0, 1), a2 + hstep, voffA);
            PG8_WAIT_L(8); PG8_BAR; PG8_WAIT_L(0); PG8_MMA(0, 0, At, B0); PG8_BAR; PG8_SCHED;
            PG8_LDB(B1, 1, 1); PG8_STAGE(PG8_SB(1, 0), b3, voffB);
            PG8_BAR; PG8_WAIT_L(0); PG8_MMA(0, 1, At, B1); PG8_BAR;
            PG8_LDA(At, 1, 1); PG8_STAGE(PG8_SA(1, 0), a3, voffA);
            PG8_BAR; PG8_WAIT_L(0); PG8_MMA(1, 0, At, B0); PG8_BAR; PG8_SCHED;
            PG8_STAGE(PG8_SB(1, 1), b3 + hstep, voffB);
            PG8_WAIT_V(6); PG8_BAR; PG8_MMA(1, 1, At, B1); PG8_BAR;
            }
        }
        if constexpr (F8) asm volatile("s_nop 15\n\ts_nop 15" ::: "memory");
        if constexpr (ALIGN_EPI) { if (wr == 0) PG8_BAR; }
        if constexpr (EPIW > 0) { static_assert(EPIW == 0 || (ALIGN_EPI && SP2), "EPIW needs ALIGN_EPI and SP2");
            }
        if constexpr (!Epi::AFTER_DRAIN) { E(acc, cur, wr, wc, fr, fq); S.done(cur); }
        if (!has_next) break;
#pragma unroll
        for (int a = 0; a < 2; ++a)
#pragma unroll
            for (int b = 0; b < 2; ++b)
#pragma unroll
                for (int m = 0; m < 4; ++m)
#pragma unroll
                    for (int n = 0; n < 2; ++n) acc[a][b][m][n] = (f32x4){0.f, 0.f, 0.f, 0.f};
        cur = nxt; cA = nA; cB = nB; ++ui;
        if constexpr (ALIGN_EPI) { if (wr == 1) PG8_BAR; }
    }
    PG8_WAIT_V(0);
    if constexpr (!ALIGN_EPI) { if (wr == 0) PG8_BAR; }
    PG8_BAR;
    if constexpr (Epi::AFTER_DRAIN) { E.fused(acc, cur, wr, wc, fr, fq, lds, wid, lane); S.done(cur); }
#undef PG8_SA
#undef PG8_SB
#undef PG8_STAGE
#undef PG8_LDA
#undef PG8_LDB
#undef PG8_MMA
#undef PG8_WAIT_V
#undef PG8_WAIT_L
#undef PG8_BAR
#undef PG8_SCHED
}
}

namespace attn {
constexpr int   D = 128, NW = 8, QBLK = 32, KVBLK = 64;
constexpr float SCALE = 0.088388347648318440f;
constexpr float THR = MK_FP8V ? 2.f : 8.f;
constexpr float POFF = MK_FP8V ? 5.f : 0.f;
constexpr int V8STR = 80;
constexpr int SDEPTH = 2;
constexpr int LDQ = 1024, LDK = 256, LDO = 1024;
constexpr size_t SHM_V = KVBLK * D * 2, SHM_K = KVBLK * D * 2, SHM_ATTN = 2 * SHM_V + 2 * SHM_K + NW * 64 * 4;
typedef unsigned short bf16;
using bf16x8 = __attribute__((ext_vector_type(8))) short;
using s16x4  = __attribute__((ext_vector_type(4))) short;
using f32x16 = __attribute__((ext_vector_type(16))) float;
using f32x8  = __attribute__((ext_vector_type(8))) float;
using u32x4  = __attribute__((ext_vector_type(4))) unsigned;
#define KSWZ(row, colB) ((row) * 256 + ((colB) ^ (((row) & 7) << 4)))
#define K8SWZ(row, c16) ((row) * 128 + ((((c16) ^ ((row) & 7))) << 4))
typedef int v8i __attribute__((ext_vector_type(8)));
#define SBAR() __builtin_amdgcn_sched_barrier(0)
__device__ __forceinline__ int crow(int r, int hi) { return (r & 3) + 8 * (r >> 2) + 4 * hi; }
__device__ __forceinline__ unsigned cvtpk(float lo, float hi) { return cvt_pk_bf16(lo, hi); }
template <typename TIn> struct Stage;
template <> struct Stage<bf16>  { using T = bf16x8;
  __device__ static __forceinline__ T ld8(const bf16* p) { return *reinterpret_cast<const bf16x8*>(p); }
  __device__ static __forceinline__ bf16x8 tobf(T x) { return x; } };
__device__ __forceinline__ void partialSM(f32x16& p0, f32x16& p1, float& m_reg, float& mn, float& alpha) {
  constexpr float C = SCALE * 1.4426950408889634f;
  float pmax = p0[0]; for (int r = 1; r < 16; ++r) pmax = fmaxf(pmax, p0[r]); for (int r = 0; r < 16; ++r) pmax = fmaxf(pmax, p1[r]);
  { auto rr = __builtin_amdgcn_permlane32_swap(__float_as_uint(pmax), __float_as_uint(pmax), false, false);
    pmax = fmaxf(__uint_as_float(rr[0]), __uint_as_float(rr[1])); }
  if (__builtin_expect(__all(pmax - m_reg <= THR / SCALE), 1)) { mn = m_reg; alpha = 1.f; }
  else { mn = fmaxf(m_reg, pmax); alpha = __builtin_amdgcn_exp2f((m_reg - mn) * C); m_reg = mn; }
  float mnC = -mn * C + POFF;
  for (int r = 0; r < 16; ++r) p0[r] = fmaf(p0[r], C, mnC); for (int r = 0; r < 16; ++r) p1[r] = fmaf(p1[r], C, mnC);
  for (int r = 0; r < 16; ++r) p0[r] = __builtin_amdgcn_exp2f(p0[r]);
}
__device__ __forceinline__ void finishSM8(f32x16& p0, f32x16& p1, float alpha, float& l_reg, v8i& P8) {
  for (int r = 0; r < 16; ++r) p1[r] = __builtin_amdgcn_exp2f(p1[r]);
  float ps = 0; for (int r = 0; r < 16; ++r) ps += p0[r]; for (int r = 0; r < 16; ++r) ps += p1[r];
  { auto rr = __builtin_amdgcn_permlane32_swap(__float_as_uint(ps), __float_as_uint(ps), false, false);
    ps = __uint_as_float(rr[0]) + __uint_as_float(rr[1]); }
  l_reg = l_reg * alpha + ps;
#pragma unroll
  for (int i = 0; i < 4; ++i) {
    int a = __builtin_amdgcn_cvt_pk_fp8_f32(p0[4 * i], p0[4 * i + 1], 0, false); a = __builtin_amdgcn_cvt_pk_fp8_f32(p0[4 * i + 2], p0[4 * i + 3], a, true);
    int b = __builtin_amdgcn_cvt_pk_fp8_f32(p1[4 * i], p1[4 * i + 1], 0, false); b = __builtin_amdgcn_cvt_pk_fp8_f32(p1[4 * i + 2], p1[4 * i + 3], b, true);
    auto rr = __builtin_amdgcn_permlane32_swap((unsigned)a, (unsigned)b, false, false); P8[i] = (int)rr[0]; P8[4 + i] = (int)rr[1]; }
}
__device__ __forceinline__ void pv8(f32x16* o, const char* Vb, const v8i& P8, int r32, int hi) {
#pragma unroll
  for (int d0 = 0; d0 < 4; ++d0) { const char* pp = Vb + (32 * d0 + r32) * V8STR + 32 * hi;
    const u32x4 x0 = *reinterpret_cast<const u32x4*>(pp), x1 = *reinterpret_cast<const u32x4*>(pp + 16);
    const v8i B = {(int)x0.x, (int)x0.y, (int)x0.z, (int)x0.w, (int)x1.x, (int)x1.y, (int)x1.z, (int)x1.w};
    o[d0] = __builtin_amdgcn_mfma_scale_f32_32x32x64_f8f6f4(P8, B, o[d0], 0, 0, 0, 0x7F7F7F7F, 0, 0x7F7F7F7F); }
}
__device__ __forceinline__ void finishSM(f32x16& p0, f32x16& p1, float alpha, float& l_reg, bf16x8& pa0, bf16x8& pa1, bf16x8& pa2, bf16x8& pa3) {
  for (int r = 0; r < 16; ++r) p1[r] = __builtin_amdgcn_exp2f(p1[r]);
  float ps = 0; for (int r = 0; r < 16; ++r) ps += p0[r]; for (int r = 0; r < 16; ++r) ps += p1[r];
  { auto rr = __builtin_amdgcn_permlane32_swap(__float_as_uint(ps), __float_as_uint(ps), false, false);
    ps = __uint_as_float(rr[0]) + __uint_as_float(rr[1]); }
  l_reg = l_reg * alpha + ps;
#define PK4(P, BASE, OUT) do { unsigned a0 = cvtpk(P[BASE + 0], P[BASE + 1]), a1 = cvtpk(P[BASE + 2], P[BASE + 3]);   \
    unsigned b0 = cvtpk(P[BASE + 4], P[BASE + 5]), b1 = cvtpk(P[BASE + 6], P[BASE + 7]);                              \
    auto r0 = __builtin_amdgcn_permlane32_swap(a0, b0, false, false); auto r1 = __builtin_amdgcn_permlane32_swap(a1, b1, false, false); \
    u32x4 w = {r0[0], r1[0], r0[1], r1[1]}; OUT = *reinterpret_cast<bf16x8*>(&w); } while (0)
  PK4(p0, 0, pa0); PK4(p0, 8, pa1); PK4(p1, 0, pa2); PK4(p1, 8, pa3);
#undef PK4
}
__device__ __forceinline__ void qkt(f32x16& p0, f32x16& p1, const bf16* Ks, const bf16x8* qr, int r32, int hi) {
  p0 = f32x16{}; p1 = f32x16{};
  for (int d0 = 0; d0 < 8; ++d0) { int cb = (d0 * 16 + hi * 8) * 2;
    bf16x8 b0 = *reinterpret_cast<const bf16x8*>((const char*)Ks + KSWZ(r32, cb));
    bf16x8 b1 = *reinterpret_cast<const bf16x8*>((const char*)Ks + KSWZ(32 + r32, cb));
    p0 = __builtin_amdgcn_mfma_f32_32x32x16_bf16(b0, qr[d0], p0, 0, 0, 0);
    p1 = __builtin_amdgcn_mfma_f32_32x32x16_bf16(b1, qr[d0], p1, 0, 0, 0); }
}
__device__ __forceinline__ void qkt8(f32x16& p0, f32x16& p1, const char* Ks, const v8i* q8, int r32, int hi) {
  p0 = f32x16{}; p1 = f32x16{};
#pragma unroll
  for (int m = 0; m < 2; ++m) { const int c = 4 * m + 2 * hi;
    const u32x4 a00 = *reinterpret_cast<const u32x4*>(Ks + K8SWZ(r32, c)), a01 = *reinterpret_cast<const u32x4*>(Ks + K8SWZ(r32, c + 1));
    const u32x4 a10 = *reinterpret_cast<const u32x4*>(Ks + K8SWZ(32 + r32, c)), a11 = *reinterpret_cast<const u32x4*>(Ks + K8SWZ(32 + r32, c + 1));
    const v8i A0 = {(int)a00.x, (int)a00.y, (int)a00.z, (int)a00.w, (int)a01.x, (int)a01.y, (int)a01.z, (int)a01.w};
    const v8i A1 = {(int)a10.x, (int)a10.y, (int)a10.z, (int)a10.w, (int)a11.x, (int)a11.y, (int)a11.z, (int)a11.w};
    p0 = __builtin_amdgcn_mfma_scale_f32_32x32x64_f8f6f4(A0, q8[m], p0, 0, 0, 0, 0x7F7F7F7F, 0, 0x7F7F7F7F);
    p1 = __builtin_amdgcn_mfma_scale_f32_32x32x64_f8f6f4(A1, q8[m], p1, 0, 0, 0, 0x7F7F7F7F, 0, 0x7F7F7F7F); }
}
__device__ __forceinline__ int v_st(int k, int c) { const int kk = (k & ~0xC) | ((k & 4) << 1) | ((k & 8) >> 1); return ((kk >> 3) * 4 + (c >> 5)) * 512 + ((kk & 7) * 32 + (c & 31)) * 2; }
__device__ __forceinline__ int v_rd_base(int lane) { return ((lane & 3) << 3) | (((lane >> 2) & 3) << 6) | (((lane >> 4) & 1) << 5) | (((lane >> 5) & 1) << 8); }
constexpr int v_rd_off(int d0, int ks, int half) { return d0 * 512 + ks * 4096 + half * 2048; }
template <int OFF> __device__ __forceinline__ s16x4 tr_read(int vb) {
  s16x4 r; asm volatile("ds_read_b64_tr_b16 %0, %1 offset:%2" : "=&v"(r) : "v"(vb), "i"(OFF) : "memory"); return r;
}
template <int D0> __device__ __forceinline__ void pv_one(f32x16& od, int vb, bf16x8 pa0, bf16x8 pa1, bf16x8 pa2, bf16x8 pa3) {
  const s16x4 l0 = tr_read<v_rd_off(D0, 0, 0)>(vb), h0 = tr_read<v_rd_off(D0, 0, 1)>(vb), l1 = tr_read<v_rd_off(D0, 1, 0)>(vb), h1 = tr_read<v_rd_off(D0, 1, 1)>(vb);
  const s16x4 l2 = tr_read<v_rd_off(D0, 2, 0)>(vb), h2 = tr_read<v_rd_off(D0, 2, 1)>(vb), l3 = tr_read<v_rd_off(D0, 3, 0)>(vb), h3 = tr_read<v_rd_off(D0, 3, 1)>(vb);
  asm volatile("s_waitcnt lgkmcnt(0)" ::: "memory"); SBAR();
#define PK(L, H) (bf16x8){L[0], L[1], L[2], L[3], H[0], H[1], H[2], H[3]}
  od = __builtin_amdgcn_mfma_f32_32x32x16_bf16(pa0, PK(l0, h0), od, 0, 0, 0);
  od = __builtin_amdgcn_mfma_f32_32x32x16_bf16(pa1, PK(l1, h1), od, 0, 0, 0);
  od = __builtin_amdgcn_mfma_f32_32x32x16_bf16(pa2, PK(l2, h2), od, 0, 0, 0);
  od = __builtin_amdgcn_mfma_f32_32x32x16_bf16(pa3, PK(l3, h3), od, 0, 0, 0);
#undef PK
}
__device__ __forceinline__ void pv_d0(f32x16* o, int vb, bf16x8 pa0, bf16x8 pa1, bf16x8 pa2, bf16x8 pa3) {
  pv_one<0>(o[0], vb, pa0, pa1, pa2, pa3); pv_one<1>(o[1], vb, pa0, pa1, pa2, pa3); pv_one<2>(o[2], vb, pa0, pa1, pa2, pa3); pv_one<3>(o[3], vb, pa0, pa1, pa2, pa3);
}

struct Pre { bf16x8 q[8]; };
__device__ __forceinline__ void attn_prefetch(const bf16* Qb, const bf16* __restrict__ Kh, const bf16* __restrict__ Vh, Pre& p) {
  const int tid = threadIdx.x, wid = tid >> 6, lane = tid & 63, r32 = lane & 31, hi = lane >> 5;
  const bf16* Qw = Qb + (long)(wid * QBLK + r32) * LDQ + hi * 8;
#pragma unroll
  for (int d0 = 0; d0 < 8; ++d0) p.q[d0] = *reinterpret_cast<const bf16x8*>(Qw + d0 * 16);
}
template <typename TQ>
__device__ __forceinline__ void attn_dense_body(const TQ* Qb, const bf16* __restrict__ Kh, const bf16* __restrict__ Vh,
                                                bf16* Ob, int seq, char* lds, const float* __restrict__ qnw, const float* __restrict__ rope, int lpos0,
                                                Pre& pre, const bf16* Qn, const bf16* Kn, const bf16* Vn) {
  using St = Stage<bf16>; using SQ = Stage<TQ>;
  const int tid = threadIdx.x, wid = __builtin_amdgcn_readfirstlane(tid >> 6), lane = tid & 63, r32 = lane & 31, hi = lane >> 5;
  bf16* V_lds = (bf16*)lds; bf16* K_lds = (bf16*)(lds + 2 * SHM_V);
  float* ws = (float*)(lds + 2 * SHM_V + 2 * SHM_K) + wid * 64; float* li_l = ws; float* al_l = ws + 32;
  float m_reg = -1e30f, l_reg = 0; f32x16 o[4] = {}; bf16x8 qr[8];
#if MK_FP8K
  v8i q8[2]; const unsigned char* K8h = (const unsigned char*)Kh;
#endif
#pragma unroll
  for (int d0 = 0; d0 < 8; ++d0) qr[d0] = pre.q[d0];
  const int sr = tid >> 4, sc = (tid & 15) * 8, vst0 = v_st(sr, sc), vst1 = v_st(32 + sr, sc);
  const int vb0 = (int)(uintptr_t)V_lds + v_rd_base(lane);
#if MK_FP8K && MK_FP8V
  const unsigned char* V8h = (const unsigned char*)Vh;
  struct { u32x4 v8, k8; } sr_[SDEPTH];
  const unsigned ko = (unsigned)((tid >> 3) * 256 + (tid & 7) * 16);
#define SLOAD(i, k0) do { sr_[i].v8 = *reinterpret_cast<const u32x4*>(V8h + (size_t)((k0) >> 6) * 8192 + (unsigned)tid * 16u); \
    sr_[i].k8 = *reinterpret_cast<const u32x4*>(K8h + (size_t)(k0) * 256 + ko); } while (0)
#define SWRITE(b, i) do { *(u32x4*)((char*)V_lds + (b) * SHM_V + (tid >> 2) * V8STR + (tid & 3) * 16) = sr_[i].v8; \
    *(u32x4*)((char*)K_lds + (b) * SHM_K + K8SWZ(tid >> 3, tid & 7)) = sr_[i].k8; } while (0)
#define SWAIT() asm volatile("s_waitcnt vmcnt(2)" ::: "memory")
#define QKT(P0, P1, KB) qkt8(P0, P1, (const char*)K_lds + (KB) * SHM_K, q8, r32, hi)
#define FINISH(P0, P1, AL) finishSM8(P0, P1, AL, l_reg, P8)
#define PV(VB) pv8(o, (const char*)V_lds + (VB) * SHM_V, P8, r32, hi)
  v8i P8;
#elif MK_FP8K
#define FINISH(P0, P1, AL) finishSM(P0, P1, AL, l_reg, pa0, pa1, pa2, pa3)
#define PV(VB) pv_d0(o, vb0 + (VB) * (int)SHM_V, pa0, pa1, pa2, pa3)
  struct { typename St::T vs0, vs1; u32x4 k8; } sr_[SDEPTH];
  const unsigned vo0 = (unsigned)(sr * LDK + sc), vo1 = vo0 + 32u * LDK, ko = (unsigned)((tid >> 3) * 256 + (tid & 7) * 16);
#define SLOAD(i, k0) do { const bf16* vt_ = Vh + (size_t)(k0) * LDK; const unsigned char* kt_ = K8h + (size_t)(k0) * 256; \
    sr_[i].vs0 = *reinterpret_cast<const bf16x8*>(vt_ + vo0); sr_[i].vs1 = *reinterpret_cast<const bf16x8*>(vt_ + vo1); sr_[i].k8 = *reinterpret_cast<const u32x4*>(kt_ + ko); } while (0)
#define SWRITE(b, i) do { *(bf16x8*)((char*)V_lds + (b) * SHM_V + vst0) = St::tobf(sr_[i].vs0);          \
    *(bf16x8*)((char*)V_lds + (b) * SHM_V + vst1) = St::tobf(sr_[i].vs1);                                \
    *(u32x4*)((char*)K_lds + (b) * SHM_K + K8SWZ(tid >> 3, tid & 7)) = sr_[i].k8; } while (0)
#define SWAIT() asm volatile("s_waitcnt vmcnt(3)" ::: "memory")
#define QKT(P0, P1, KB) qkt8(P0, P1, (const char*)K_lds + (KB) * SHM_K, q8, r32, hi)
#else
#define FINISH(P0, P1, AL) finishSM(P0, P1, AL, l_reg, pa0, pa1, pa2, pa3)
#define PV(VB) pv_d0(o, vb0 + (VB) * (int)SHM_V, pa0, pa1, pa2, pa3)
#define QKT(P0, P1, KB) qkt(P0, P1, (bf16*)((char*)K_lds + (KB) * SHM_K), qr, r32, hi)
  struct { typename St::T vs0, vs1, ks0, ks1; } sr_[SDEPTH];
#define SLOAD(i, k0) do { sr_[i].vs0 = St::ld8(&Vh[(long)((k0) + sr) * LDK + sc]); sr_[i].vs1 = St::ld8(&Vh[(long)((k0) + 32 + sr) * LDK + sc]); \
    sr_[i].ks0 = St::ld8(&Kh[(long)((k0) + sr) * LDK + sc]); sr_[i].ks1 = St::ld8(&Kh[(long)((k0) + 32 + sr) * LDK + sc]); } while (0)
#define SWRITE(b, i) do { *(bf16x8*)((char*)V_lds + (b) * SHM_V + vst0) = St::tobf(sr_[i].vs0);          \
    *(bf16x8*)((char*)V_lds + (b) * SHM_V + vst1) = St::tobf(sr_[i].vs1); int kc = sc * 2;               \
    *(bf16x8*)((char*)K_lds + (b) * SHM_K + KSWZ(sr, kc)) = St::tobf(sr_[i].ks0);                       \
    *(bf16x8*)((char*)K_lds + (b) * SHM_K + KSWZ(32 + sr, kc)) = St::tobf(sr_[i].ks1); } while (0)
#define SWAIT() do { if constexpr (SDEPTH == 2) asm volatile("s_waitcnt vmcnt(4)" ::: "memory"); else asm volatile("s_waitcnt vmcnt(0)" ::: "memory"); } while (0)
#endif
#define RESC(a) do { if (__any((a) < 1.f)) { if (hi == 0) al_l[r32] = (a); asm volatile("s_waitcnt lgkmcnt(0)" ::: "memory"); \
    for (int d = 0; d < 4; ++d) for (int r = 0; r < 16; ++r) o[d][r] *= al_l[crow(r, hi)]; } } while (0)
  f32x16 pA0, pA1, pB0, pB1; float mnA, mnB, alA, alB; bf16x8 pa0, pa1, pa2, pa3; const int NT = seq / KVBLK;
  constexpr int SE = 0, SO = SDEPTH - 1;
  SLOAD(SE, 0); SLOAD(SO, KVBLK);
  if (qnw) {
    float ssq = 0.f;
#pragma unroll
    for (int d0 = 0; d0 < 8; ++d0)
#pragma unroll
      for (int j = 0; j < 8; ++j) { const float f = bf2f((unsigned short)qr[d0][j]); ssq += f * f; }
    { auto rr = __builtin_amdgcn_permlane32_swap(__float_as_uint(ssq), __float_as_uint(ssq), false, false); ssq = __uint_as_float(rr[0]) + __uint_as_float(rr[1]); }
    const float rstd = 1.0f / sqrtf(ssq * (1.0f / 128.0f) + 1e-6f);
    const int lq = lpos0 + wid * QBLK + r32, ri = lq >> 6, ci = lq & 63;
#pragma unroll
    for (int d0 = 0; d0 < 8; ++d0) {
      const float* wp = qnw + 16 * d0 + 8 * hi; const v4f w0 = *(const v4f*)wp, w1 = *(const v4f*)(wp + 4);
      const float* tp = d0 < 4 ? rope + (ri * 32 + 8 * d0 + 4 * hi) * 2 : rope + (ci * 32 + 8 * (d0 - 4) + 4 * hi) * 2; const v4f t0 = *(const v4f*)tp, t1 = *(const v4f*)(tp + 4);
      const float wv[8] = {w0.x, w0.y, w0.z, w0.w, w1.x, w1.y, w1.z, w1.w}, tv[8] = {t0.x, t0.y, t0.z, t0.w, t1.x, t1.y, t1.z, t1.w};
      float y[8];
#pragma unroll
      for (int q = 0; q < 4; ++q) { const float x0 = bf2f((unsigned short)qr[d0][2 * q]) * rstd * wv[2 * q], x1 = bf2f((unsigned short)qr[d0][2 * q + 1]) * rstd * wv[2 * q + 1], cs = tv[2 * q], sn = tv[2 * q + 1];
        y[2 * q] = x0 * cs - x1 * sn; y[2 * q + 1] = x0 * sn + x1 * cs; }
#if MK_FP8K
      { int w0 = __builtin_amdgcn_cvt_pk_fp8_f32(y[0], y[1], 0, false); w0 = __builtin_amdgcn_cvt_pk_fp8_f32(y[2], y[3], w0, true);
        int w1 = __builtin_amdgcn_cvt_pk_fp8_f32(y[4], y[5], 0, false); w1 = __builtin_amdgcn_cvt_pk_fp8_f32(y[6], y[7], w1, true);
        q8[d0 >> 2][2 * (d0 & 3)] = w0; q8[d0 >> 2][2 * (d0 & 3) + 1] = w1; }
#else
      u32x4 pw = {cvtpk(y[0], y[1]), cvtpk(y[2], y[3]), cvtpk(y[4], y[5]), cvtpk(y[6], y[7])}; qr[d0] = *reinterpret_cast<bf16x8*>(&pw);
#endif
    }
  }
  SWAIT(); SWRITE(0, SE); if constexpr (SDEPTH == 2) { if (2 < NT) SLOAD(SE, 2 * KVBLK); } __syncthreads();
  QKT(pA0, pA1, 0); partialSM(pA0, pA1, m_reg, mnA, alA);
  SWAIT(); SWRITE(1, SO); __syncthreads();
  for (int j = 1; j + 1 < NT; j += 2) {
    SBAR(); QKT(pB0, pB1, 1);
    FINISH(pA0, pA1, alA); SBAR();
    SLOAD(SO, (j + SDEPTH) * KVBLK); SBAR();
    PV(0); partialSM(pB0, pB1, m_reg, mnB, alB);
    __syncthreads(); SWAIT(); SWRITE(0, SE);
    RESC(alB); __syncthreads();
    SBAR(); QKT(pA0, pA1, 0);
    FINISH(pB0, pB1, alB); SBAR();
    if (SDEPTH == 1 || j + 3 < NT) SLOAD(SE, (j + 1 + SDEPTH) * KVBLK); SBAR();
    PV(1); partialSM(pA0, pA1, m_reg, mnA, alA);
    __syncthreads(); SWAIT(); SWRITE(1, SO);
    RESC(alA); __syncthreads();
  }
  attn_prefetch(Qn, Kn, Vn, pre);
  SBAR(); QKT(pB0, pB1, 1);
  FINISH(pA0, pA1, alA); SBAR();
  PV(0); partialSM(pB0, pB1, m_reg, mnB, alB);
  __syncthreads(); RESC(alB);
  FINISH(pB0, pB1, alB); SBAR();
  PV(1);
  if (hi == 0) li_l[r32] = l_reg; asm volatile("s_waitcnt lgkmcnt(0)" ::: "memory");
  float rli[16];
#pragma unroll
  for (int r = 0; r < 16; ++r) rli[r] = __builtin_amdgcn_rcpf(li_l[crow(r, hi)]);
  if (!Ob) return;
  bf16* Ow = Ob + (long)(wid * QBLK) * LDO;
#pragma unroll
  for (int r = 0; r < 16; ++r) { int orow = crow(r, hi);
    for (int d0 = 0; d0 < 4; ++d0) Ow[(long)orow * LDO + d0 * 32 + r32] = (bf16)f2bf(o[d0][r] * rli[r]); }
#undef SLOAD
#undef QKT
#undef FINISH
#undef PV
#undef SWRITE
#undef SWAIT
#undef RESC
}

#undef KSWZ
#undef SBAR
}

namespace ret {
typedef short bf16x8 __attribute__((ext_vector_type(8)));
typedef short s16x4 __attribute__((ext_vector_type(4)));
typedef float f32x16 __attribute__((ext_vector_type(16)));
constexpr int QSTR = 528, KSTR = 576, VSTR = 576, PSTR = 144;
constexpr int QS = 0, KS = QS + 64 * QSTR, VS = KS + 64 * KSTR, PS = VS + 64 * VSTR, OST = PS + 64 * PSTR, OSTR = 144, SSL = OST + 8 * 32 * OSTR, LDS_RET = SSL + 64 * 8 * 4;
constexpr int NSTEP = 36, SPLIT = 20;
__device__ __forceinline__ int crow(int r, int hi) { return (r & 3) + 8 * (r >> 2) + 4 * hi; }
__device__ __forceinline__ s16x4 tr_read(const LAS unsigned char* p) { return __builtin_bit_cast(s16x4, __builtin_amdgcn_ds_read_tr16_b64_v4i16((LAS s16x4*)p)); }
__device__ __forceinline__ bf16x8 cat(s16x4 lo, s16x4 hi) { return (bf16x8){lo[0], lo[1], lo[2], lo[3], hi[0], hi[1], hi[2], hi[3]}; }

struct NoPre { __device__ __forceinline__ void operator()() const {} };
template <class GridBar, class PreWork = NoPre>
__device__ __forceinline__ void scan_unit(const bf16_t* RQ, const bf16_t* RK, const bf16_t* RV, bf16_t* YR, float* SSQ, const float* l2d, LAS unsigned char* lds, int unit, const GridBar& gridbar, int nb_limit, const PreWork& prework = PreWork()) {
    const int tid = threadIdx.x, lane = tid & 63, w = __builtin_amdgcn_readfirstlane(tid >> 6), r = lane & 31, hh = lane >> 5;
    const int x = unit & 7, y = unit >> 3, eh = y & 1, dir = (y >> 1) & 1, bh = (y >> 2) * 8 + x, b = bh >> 2, h = bh & 3;
    if (b >= nb_limit) { prework(); gridbar(); return; }
    const float lg2 = log1pf(-exp2f(l2d[dir * 4 + h])) * 1.4426950408889634f;
    const float gC = exp2f(lg2 * 64.0f);
#if MK_TIMING
    unsigned long long tl_ = __builtin_amdgcn_s_memrealtime(); unsigned ta0 = 0, ta1 = 0, ta2 = 0, ta3 = 0, ta4 = 0, ta5 = 0, ta6 = 0;
#define TMARK(v_) do { const unsigned long long n_ = __builtin_amdgcn_s_memrealtime(); v_ += (unsigned)(n_ - tl_); tl_ = n_; } while (0)
#else
#define TMARK(v_) do { } while (0)
#endif
    f32x16 S[8];
#pragma unroll
    for (int T = 0; T < 8; ++T) S[T] = (f32x16){0.f};
#define STEP_ROWS(s_, krow_, qrow_) do { const bool l_ = (s_) >= 4; const int lc_ = l_ ? (dir ? 35 - (s_) : (s_) - 4) : 0; \
        krow_ = b * LT + (l_ ? LC + 64 * lc_ : (dir ? 64 * (3 - (s_)) : 64 * (s_))); qrow_ = b * SEQ + 64 * lc_; } while (0)
    v4u kv[4], vv[4], qv[4];
    const int poff = (tid >> 5) * 1024 + (tid & 31) * 8, voff = (tid >> 5) * 2048 + (tid & 31) * 8;
#define PREFETCHK(s_) do { int kr_, qr_; STEP_ROWS(s_, kr_, qr_); const bf16_t* kb_ = RK + (size_t)kr_ * 1024 + h * 256; \
        _Pragma("unroll") for (int n = 0; n < 4; ++n) { const bf16_t* kbn_ = kb_ + n * 16 * 1024; kv[n] = *(const v4u*)(kbn_ + poff); } } while (0)
#define PREFETCHQ(s_) do { int kr_, qr_; STEP_ROWS(s_, kr_, qr_); const bf16_t* qb_ = RQ + (size_t)qr_ * 1024 + h * 256; \
        _Pragma("unroll") for (int n = 0; n < 4; ++n) { const bf16_t* qbn_ = qb_ + n * 16 * 1024; qv[n] = *(const v4u*)(qbn_ + poff); } } while (0)
#define LOADV(s_) do { int kr_, qr_; STEP_ROWS(s_, kr_, qr_); const bf16_t* vb_ = RV + (size_t)kr_ * 2048 + h * 512 + eh * 256; \
        _Pragma("unroll") for (int n = 0; n < 4; ++n) { const bf16_t* vbn_ = vb_ + n * 16 * 2048; vv[n] = *(const v4u*)(vbn_ + voff); } } while (0)
#define WRITEQ() do { _Pragma("unroll") for (int n = 0; n < 4; ++n) { const int c = tid + NTHR * n, row = c >> 5, ch = c & 31; *(LAS v4u*)(lds + QS + row * QSTR + ch * 16) = qv[n]; } } while (0)
    PREFETCHK(0); PREFETCHQ(0); LOADV(0);
    prework(); __syncthreads();
    LAS unsigned char* ost = lds + OST + w * (32 * OSTR);
    for (int s = 0; s < NSTEP; ++s) {
        if (s == SPLIT) gridbar();
        int krow0, qrow0; STEP_ROWS(s, krow0, qrow0); const bool latent = s >= 4; const int sn = s + 1 < NSTEP ? s + 1 : s;
        float lg2s = lg2; int hv = hh, rv = r; asm volatile("" : "+v"(lg2s), "+v"(hv), "+v"(rv));
        const int lane_l = hv * 32 + rv;
        const int qA = QS + rv * QSTR + hv * 16, pA = PS + rv * PSTR + hv * 16;
        const int sw = ((lane_l & 1) << 1) | ((lane_l >> 1) & 1);
        const int trrow = (hv * 8 + ((lane_l >> 2) & 3));
        const int ktr = KS + trrow * KSTR + (16 * ((lane_l >> 4) & 1) + 4 * sw) * 2;
        const int vtr = VS + trrow * VSTR + (32 * w + 16 * ((lane_l >> 4) & 1) + 4 * (lane_l & 3)) * 2;
        { float wgt = __builtin_amdgcn_exp2f(lg2s * (float)(dir ? (tid >> 5) : 63 - (tid >> 5))); const float wstep = __builtin_amdgcn_exp2f(lg2s * (dir ? 16.0f : -16.0f));
#pragma unroll
          for (int n = 0; n < 4; ++n) { const int c = tid + NTHR * n, row = c >> 5, ch = c & 31;
            *(LAS v4u*)(lds + KS + row * KSTR + ch * 16) = kv[n];
            *(LAS v4u*)(lds + QS + row * QSTR + ch * 16) = qv[n];
            float t[8]; unpack8(vv[n], t);
#pragma unroll
            for (int k = 0; k < 8; ++k) t[k] *= wgt;
            wgt *= wstep;
            *(LAS v4u*)(lds + VS + row * VSTR + ch * 16) = pack8(t); } }
        __syncthreads();
        TMARK(ta0);
        v4u pp[4]; bf16_t* op = YR + (size_t)qrow0 * 2048 + h * 512 + eh * 256 + 32 * w + (size_t)((hv * 32 + rv) >> 2) * 2048 + ((hv * 32 + rv) & 3) * 8;
        if (s >= SPLIT) {
#pragma unroll
            for (int x4 = 0; x4 < 4; ++x4) pp[x4] = *(const v4u*)(op + (size_t)(16 * x4) * 2048); }
        if (latent) {
            { typedef float f32x4_t __attribute__((ext_vector_type(4)));
              const int i0 = 16 * (w >> 1), j0 = 32 * (w & 1), l15 = rv & 15, g4 = (hv << 1) | (rv >> 4);
              const LAS unsigned char* qp = lds + QS + (i0 + l15) * QSTR + g4 * 16; const LAS unsigned char* kp0 = lds + KS + (j0 + l15) * KSTR + g4 * 16; const LAS unsigned char* kp1 = kp0 + 16 * KSTR;
              f32x4_t s0 = (f32x4_t){0.f, 0.f, 0.f, 0.f}, s1 = s0;
              bf16x8 qn = *(const LAS bf16x8*)qp, k0n = *(const LAS bf16x8*)kp0, k1n = *(const LAS bf16x8*)kp1;
#pragma unroll
              for (int kk = 0; kk < 8; ++kk) { const bf16x8 qc = qn, k0c = k0n, k1c = k1n;
                if (kk + 1 < 8) { qn = *(const LAS bf16x8*)(qp + (kk + 1) * 64); k0n = *(const LAS bf16x8*)(kp0 + (kk + 1) * 64); k1n = *(const LAS bf16x8*)(kp1 + (kk + 1) * 64); }
                __builtin_amdgcn_sched_barrier(0);
                s0 = __builtin_amdgcn_mfma_f32_16x16x32_bf16(k0c, qc, s0, 0, 0, 0); s1 = __builtin_amdgcn_mfma_f32_16x16x32_bf16(k1c, qc, s1, 0, 0, 0); }
              const int i = i0 + l15;
#pragma unroll
              for (int t2 = 0; t2 < 2; ++t2) { const f32x4_t sv = t2 ? s1 : s0; const int jb = j0 + 16 * t2 + 4 * g4; float v4[4];
#pragma unroll
                for (int k = 0; k < 4; ++k) { const int j = jb + k; const bool keep = dir ? (j >= i) : (j <= i); v4[k] = keep ? sv[k] : 0.f; }
                v2u pw; pw.x = cvt_pk_bf16(v4[0], v4[1]); pw.y = cvt_pk_bf16(v4[2], v4[3]);
                *(LAS v2u*)(lds + PS + i * PSTR + jb * 2) = pw; } }
            TMARK(ta1);
            f32x16 acc[2]; acc[0] = (f32x16){0.f}; acc[1] = (f32x16){0.f};
            { const LAS unsigned char* q0 = lds + qA; const LAS unsigned char* q1 = lds + qA + 32 * QSTR;
              bf16x8 n0 = *(const LAS bf16x8*)q0, n1 = *(const LAS bf16x8*)q1, m0 = *(const LAS bf16x8*)(q0 + 32), m1 = *(const LAS bf16x8*)(q1 + 32);
#pragma unroll
              for (int ix = 0; ix < 16; ++ix) { const int T = ix >> 1, s2 = ix & 1; const bf16x8 a0 = n0, a1 = n1; n0 = m0; n1 = m1;
                if (ix + 2 < 16) { m0 = *(const LAS bf16x8*)(q0 + (ix + 2) * 32); m1 = *(const LAS bf16x8*)(q1 + (ix + 2) * 32); }
                v4u bw; bw.x = cvt_pk_bf16(S[T][8 * s2 + 0], S[T][8 * s2 + 1]); bw.y = cvt_pk_bf16(S[T][8 * s2 + 2], S[T][8 * s2 + 3]);
                bw.z = cvt_pk_bf16(S[T][8 * s2 + 4], S[T][8 * s2 + 5]); bw.w = cvt_pk_bf16(S[T][8 * s2 + 6], S[T][8 * s2 + 7]); const bf16x8 bs = __builtin_bit_cast(bf16x8, bw);
                __builtin_amdgcn_sched_barrier(0);
                acc[0] = __builtin_amdgcn_mfma_f32_32x32x16_bf16(a0, bs, acc[0], 0, 0, 0); acc[1] = __builtin_amdgcn_mfma_f32_32x32x16_bf16(a1, bs, acc[1], 0, 0, 0); } }
            TMARK(ta2);
            __syncthreads();
            LOADV(sn);
            TMARK(ta3);
            { bf16x8 vn = cat(tr_read(lds + vtr), tr_read(lds + vtr + 4 * VSTR)), pn0 = *(const LAS bf16x8*)(lds + pA), pn1 = *(const LAS bf16x8*)(lds + pA + 32 * PSTR);
#pragma unroll
              for (int js = 0; js < 4; ++js) { const bf16x8 vfj = vn, p0 = pn0, p1 = pn1;
                if (js + 1 < 4) { vn = cat(tr_read(lds + vtr + (16 * (js + 1)) * VSTR), tr_read(lds + vtr + (16 * (js + 1) + 4) * VSTR)); pn0 = *(const LAS bf16x8*)(lds + pA + (js + 1) * 32); pn1 = *(const LAS bf16x8*)(lds + pA + 32 * PSTR + (js + 1) * 32); }
                __builtin_amdgcn_sched_barrier(0);
                acc[0] = __builtin_amdgcn_mfma_f32_32x32x16_bf16(p0, vfj, acc[0], 0, 0, 0); acc[1] = __builtin_amdgcn_mfma_f32_32x32x16_bf16(p1, vfj, acc[1], 0, 0, 0); } }
#pragma unroll
            for (int it = 0; it < 2; ++it) {
#pragma unroll
                for (int q = 0; q < 16; ++q) { const int il = crow(q, hv); const int i = it * 32 + il; const float rf = __builtin_amdgcn_exp2f(lg2s * (float)(dir ? -i : i - 63));
                    *(LAS float*)(ost + il * OSTR + rv * 4) = acc[it][q] * rf; }
#pragma unroll
                for (int n = 0; n < 2; ++n) { const int c = (hv * 32 + rv) + 64 * n, row = c >> 2, cq = c & 3;
                    const v4f x0 = *(const LAS v4f*)(ost + row * OSTR + cq * 32), x1 = *(const LAS v4f*)(ost + row * OSTR + cq * 32 + 16);
                    float o[8] = {x0.x, x0.y, x0.z, x0.w, x1.x, x1.y, x1.z, x1.w};
                    if (s >= SPLIT) { float pv[8]; unpack8(pp[2 * it + n], pv); float ss = 0.f;
#pragma unroll
                        for (int k = 0; k < 8; ++k) { o[k] += pv[k]; ss += o[k] * o[k]; }
                        ss += __shfl_xor(ss, 1); ss += __shfl_xor(ss, 2);
                        if (cq == 0) *(LAS float*)(lds + SSL + ((it * 32 + row) * 8 + w) * 4) = ss; }
                    *(v4u*)(op + (size_t)(it * 32 + 16 * n) * 2048) = pack8(o); }
            }
        }
        TMARK(ta4);
        __builtin_amdgcn_sched_barrier(0);
        PREFETCHK(sn);
        PREFETCHQ(sn);
        if (!latent) LOADV(sn);
        {
#define KA_LD(ix_) cat(tr_read(lds + ktr + (16 * ((ix_) >> 3)) * KSTR + ((ix_) & 7) * 64), tr_read(lds + ktr + (16 * ((ix_) >> 3) + 4) * KSTR + ((ix_) & 7) * 64))
#define VF_LD(js_) cat(tr_read(lds + vtr + (16 * (js_)) * VSTR), tr_read(lds + vtr + (16 * (js_) + 4) * VSTR))
          bf16x8 vcur = VF_LD(0), vnx = vcur, kn0 = KA_LD(0), kn1 = KA_LD(1);
#pragma unroll
          for (int ix = 0; ix < 32; ++ix) { const int T = ix & 7, js = ix >> 3; const bf16x8 ka = kn0; kn0 = kn1;
            if (ix + 2 < 32) kn1 = KA_LD(ix + 2);
            if (T == 4 && js < 3) vnx = VF_LD(js + 1);
            __builtin_amdgcn_sched_barrier(0);
            S[T] = __builtin_amdgcn_mfma_f32_32x32x16_bf16(ka, vcur, S[T], 0, 0, 0);
            if (T == 7) vcur = vnx; }
#undef KA_LD
#undef VF_LD
        }
#pragma unroll
        for (int T = 0; T < 8; ++T) S[T] *= gC;
        TMARK(ta5);
        __syncthreads();
        TMARK(ta6);
        if (s >= SPLIT && tid < 64) { const LAS float* pr = (const LAS float*)(lds + SSL + tid * 32); const v4f a = *(const LAS v4f*)pr, c4 = *(const LAS v4f*)(pr + 4);
            SSQ[(size_t)(qrow0 + tid) * 8 + h * 2 + eh] = ((a.x + a.y) + (a.z + a.w)) + ((c4.x + c4.y) + (c4.z + c4.w)); }
    }
#if MK_TIMING
    if (unit == 0 && tid == 0) { unsigned* tw = (unsigned*)SSQ - 64; tw[0] = ta0; tw[1] = ta1; tw[2] = ta2; tw[3] = ta3; tw[4] = ta4; tw[5] = ta5; tw[6] = ta6; }
#endif
#undef STEP_ROWS
#undef PREFETCHK
#undef PREFETCHQ
#undef WRITEQ
#undef LOADV
}
}

constexpr int RING_BYTES = 131072, LDS_BYTES = 157696;
#ifndef MK_ONE_LAUNCH
#define MK_ONE_LAUNCH 1
#endif
constexpr int N_PHASES = 10;
#define LDS_WAIT() asm volatile("s_waitcnt lgkmcnt(0)" ::: "memory")
constexpr int MISC_OFF = 155648 + 320;
constexpr int CW_BAR = 4096;
constexpr size_t CTL_ZERO_BYTES = 65536;
#ifndef MK_NAIVE_ATTN
#define MK_NAIVE_ATTN 0
#endif
#ifndef MK_NAIVE_RET
#define MK_NAIVE_RET 0
#endif
#ifndef MK_DEBUG_ATTN
#define MK_DEBUG_ATTN 0
#endif
#ifndef MK_DBG_H
#define MK_DBG_H 0
#endif
#ifndef MK_DBG_L0
#define MK_DBG_L0 768
#define MK_DBG_L1 1280
#endif
#ifndef MK_DEBUG_RET
#define MK_DEBUG_RET 0
#endif
#ifndef MK_STAMP_A
#define MK_STAMP_A -1
#define MK_STAMP_B -1
#endif
#ifndef MK_REP_P4
#define MK_REP_P4 1
#endif
#ifndef MK_REP_P5
#define MK_REP_P5 1
#endif
#ifndef MK_REP_P6
#define MK_REP_P6 1
#endif
#ifndef MK_REP_P2
#define MK_REP_P2 1
#endif
#ifndef MK_REP_P9
#define MK_REP_P9 1
#endif
#ifndef MK_NSTAG
#define MK_NSTAG 1
#define MK_STAG_TICKS 500
#endif
#ifndef MK_ATTN_PROBE
#define MK_ATTN_PROBE 0
#endif
#ifndef MK_MIX
#define MK_MIX 0
#endif
#ifndef MK_EPIW
#define MK_EPIW 0
#endif
#ifndef MK_BARRIER
#define MK_BARRIER 1
#endif
#define XB_TMO      128
#define XB_XCNT(j)  (256  + 64 * (j))
#define XB_XSUB(j)  (1280 + 64 * (j))
#define XB_XGEN(j)  (2304 + 64 * (j))
#define XB_TOP      3328
#define XB_TOPGEN   3392
#define XCD_BAR_WORDS 3456
#define XB_SPIN_CAP (1u << 18)

__device__ __forceinline__ unsigned xb_ld(unsigned* p)              { return __hip_atomic_load(p, __ATOMIC_RELAXED, __HIP_MEMORY_SCOPE_AGENT); }
__device__ __forceinline__ unsigned xb_add(unsigned* p, unsigned v) { return __hip_atomic_fetch_add(p, v, __ATOMIC_RELAXED, __HIP_MEMORY_SCOPE_AGENT); }
__device__ __forceinline__ unsigned xb_xcc_id() { return (unsigned)__builtin_amdgcn_s_getreg((3 << 11) | 20) & 0xFu; }
#define XB_SPIN(cond, bar) do { unsigned _sp = 0; while (cond) { __builtin_amdgcn_s_sleep(1); \
    if ((++_sp & 255u) == 0u) { if (xb_ld(&(bar)[XB_TMO])) break; if (_sp > XB_SPIN_CAP) { atomicAdd(&(bar)[XB_TMO], 1u); break; } } } } while (0)

struct XcdBarrier {
    unsigned* bar; unsigned x;
    volatile LAS unsigned* st;
};

__device__ __forceinline__ XcdBarrier xcd_barrier_post(unsigned* bar, volatile LAS unsigned* st) {
    XcdBarrier b; b.bar = bar; b.x = xb_xcc_id(); b.st = st;
    if (threadIdx.x == 0) (void)xb_add(&bar[XB_XCNT(b.x)], 1u);
    return b;
}
__device__ __forceinline__ void xcd_barrier_complete(unsigned* bar, unsigned x, unsigned& nloc, unsigned& nx) {
    const unsigned G = gridDim.x * gridDim.y * gridDim.z;
    unsigned sum, cnt, mine, sp = 0u;
    for (;;) {
        sum = 0u; cnt = 0u; mine = 0u;
#pragma unroll
        for (unsigned j = 0; j < 16; ++j) { const unsigned c = xb_ld(&bar[XB_XCNT(j)]); sum += c; cnt += (c > 0u) ? 1u : 0u; mine = (j == x) ? c : mine; }
        if (sum == G) break;
        __builtin_amdgcn_s_sleep(1);
        if ((++sp & 255u) == 0u) { if (xb_ld(&bar[XB_TMO])) break; if (sp > XB_SPIN_CAP) { atomicAdd(&bar[XB_TMO], 1u); break; } }
    }
    nloc = mine > 0u ? mine : 1u; nx = cnt > 0u ? cnt : 1u;
}

__device__ __forceinline__ void xcd_barrier(const XcdBarrier& b) {
    asm volatile("s_waitcnt vmcnt(0)" ::: "memory");
    __syncthreads();
    if (threadIdx.x == 0) {
        unsigned* bar = b.bar;
        __builtin_amdgcn_s_waitcnt(0);
        unsigned nloc = b.st[0], nx = b.st[1];
        if (nloc == 0u) { xcd_barrier_complete(bar, b.x, nloc, nx); b.st[0] = nloc; b.st[1] = nx; }
        const unsigned old = xb_add(&bar[XB_XSUB(b.x)], 1u);
        const unsigned gen = old / nloc;
        if (old + 1u == (gen + 1u) * nloc) {
            __builtin_amdgcn_fence(__ATOMIC_RELEASE, "agent");
            asm volatile("s_waitcnt vmcnt(0)" ::: "memory");
            const unsigned og = xb_add(&bar[XB_TOP], 1u);
            const unsigned tg = og / nx;
            if (og + 1u == (tg + 1u) * nx) xb_add(&bar[XB_TOPGEN], 1u);
            else XB_SPIN(xb_ld(&bar[XB_TOPGEN]) == tg, bar);
            __builtin_amdgcn_fence(__ATOMIC_ACQUIRE, "agent");
            xb_add(&bar[XB_XGEN(b.x)], 1u);
            asm volatile("s_waitcnt vmcnt(0)" ::: "memory");
        } else {
            XB_SPIN(xb_ld(&bar[XB_XGEN(b.x)]) == gen, bar);
            __builtin_amdgcn_fence(__ATOMIC_ACQUIRE, "agent");
            asm volatile("s_waitcnt vmcnt(0)" ::: "memory");
        }
    }
    __syncthreads();
}


struct Args { const float* in[14]; float* out; unsigned char* ws; int ph_lo, ph_hi; };

__device__ __forceinline__ void p0_mod_item(const float* c, const float* c_ctx, const float* w_ada, const float* b_ada, float* MOD, float* ldsf, int item, int tid) {
    float* sc = ldsf; float* red = ldsf + 17 * 1024;
    for (int i = tid; i < 17 * 1024; i += NTHR) { const float v = i < 16 * 1024 ? c[i] : c_ctx[i - 16 * 1024]; sc[i] = v / (1.0f + expf(-v)); }
    const int col = tid & 15, ks = tid >> 4, n = item * 16 + col;
    float wv[32];
#pragma unroll
    for (int k = 0; k < 32; ++k) wv[k] = w_ada[(size_t)(ks * 32 + k) * 3072 + n];
    __syncthreads();
    float acc[17];
#pragma unroll
    for (int r = 0; r < 17; ++r) acc[r] = 0.f;
#pragma unroll
    for (int k = 0; k < 32; ++k) {
#pragma unroll
        for (int r = 0; r < 17; ++r) acc[r] += sc[r * 1024 + ks * 32 + k] * wv[k]; }
#pragma unroll
    for (int r = 0; r < 17; ++r) red[(ks * 17 + r) * 16 + col] = acc[r];
    __syncthreads();
    if (tid < 17 * 16) { const int r = tid >> 4, cc = tid & 15; float s = b_ada[item * 16 + cc];
        for (int k2 = 0; k2 < 32; ++k2) s += red[(k2 * 17 + r) * 16 + cc];
        MOD[r * 3072 + item * 16 + cc] = s; }
    __syncthreads();
}
__device__ __forceinline__ void p0_transpose_item(const float* W, int K, int N, bf16_t* WT, int row_off, float* scr, int item, int lane) {
    const int nblk = N / 32, kb = item / nblk, nb = item % nblk, k0 = 64 * kb, n0 = 32 * nb;
    float tv[32];
#pragma unroll
    for (int i = 0; i < 32; ++i) { const int kk = 2 * i + (lane >> 5); tv[i] = W[(size_t)(k0 + kk) * N + n0 + (lane & 31)]; }
#pragma unroll
    for (int i = 0; i < 32; ++i) { const int kk = 2 * i + (lane >> 5); scr[kk * 33 + (lane & 31)] = tv[i]; }
    LDS_WAIT(); asm volatile("" ::: "memory");
    const int c = lane & 7;
#pragma unroll
    for (int j = 0; j < 4; ++j) { const int n = (lane >> 3) + 8 * j; const float* s = scr + (8 * c) * 33 + n;
        v4u o; o.x = pk2(s[0 * 33], s[1 * 33]); o.y = pk2(s[2 * 33], s[3 * 33]); o.z = pk2(s[4 * 33], s[5 * 33]); o.w = pk2(s[6 * 33], s[7 * 33]);
        *(v4u*)(WT + (size_t)(row_off + n0 + n) * K + k0 + 8 * c) = o; }
    LDS_WAIT(); asm volatile("" ::: "memory");
}
__device__ __forceinline__ void p0_transpose64_item(const float* W, int K, int N, bf16_t* WT, int row_off, float* scr, int item, int lane, unsigned char* WT8 = nullptr, int row_off8 = 0) {
    const int nblk = N / 64, kb = item / nblk, nb = item % nblk, k0 = 64 * kb, n0 = 64 * nb;
    v4f tv[16]; const int lr = lane >> 4, lc = (lane & 15) * 4;
#pragma unroll
    for (int i = 0; i < 16; ++i) tv[i] = *(const v4f*)(W + (size_t)(k0 + 4 * i + lr) * N + n0 + lc);
#pragma unroll
    for (int i = 0; i < 16; ++i) { float* d = scr + (4 * i + lr) * 65 + lc; d[0] = tv[i].x; d[1] = tv[i].y; d[2] = tv[i].z; d[3] = tv[i].w; }
    LDS_WAIT(); asm volatile("" ::: "memory");
    const int c = lane & 7;
#pragma unroll
    for (int j = 0; j < 8; ++j) { const int n = (lane >> 3) + 8 * j; const float* s = scr + (8 * c) * 65 + n;
        v4u o; o.x = pk2(s[0 * 65], s[1 * 65]); o.y = pk2(s[2 * 65], s[3 * 65]); o.z = pk2(s[4 * 65], s[5 * 65]); o.w = pk2(s[6 * 65], s[7 * 65]);
        *(v4u*)(WT + (size_t)(row_off + n0 + n) * K + k0 + 8 * c) = o;
        if (WT8) { v2u w; w.x = pk4_fp8(s[0 * 65] * F8W_MUL, s[1 * 65] * F8W_MUL, s[2 * 65] * F8W_MUL, s[3 * 65] * F8W_MUL); w.y = pk4_fp8(s[4 * 65] * F8W_MUL, s[5 * 65] * F8W_MUL, s[6 * 65] * F8W_MUL, s[7 * 65] * F8W_MUL);
            *(v2u*)(WT8 + (size_t)(row_off8 + n0 + n) * K + k0 + 8 * c) = w; } }
    LDS_WAIT(); asm volatile("" ::: "memory");
}
__device__ __forceinline__ int new_col(int o) { return o < 4608 ? o : (o < 6656 ? o + 1024 : (o < 7680 ? o - 2048 : o)); }

__device__ __forceinline__ void sincos_d(double a, float& c, float& s) {
    const double TWO_PI = 6.283185307179586476925;
    const double k = (double)(long long)(a / TWO_PI + (a >= 0 ? 0.5 : -0.5)); const double r = a - k * TWO_PI, r2 = r * r;
    double ts = r, ss = r, tc = 1.0, cc = 1.0;
    for (int n = 1; n <= 15; ++n) { tc *= -r2 / (double)((2 * n - 1) * (2 * n)); cc += tc; ts *= -r2 / (double)((2 * n) * (2 * n + 1)); ss += ts; }
    c = (float)cc; s = (float)ss;
}

__device__ __forceinline__ void p1_row(const float* xrow, const float* nw, const float* shift, const float* scale, bf16_t* orow, int lane) {
    const v4f* xr = (const v4f*)xrow + lane; v4f v[4]; float s = 0.f;
#pragma unroll
    for (int j = 0; j < 4; ++j) { v[j] = xr[64 * j]; s += (v[j].x * v[j].x + v[j].y * v[j].y) + (v[j].z * v[j].z + v[j].w * v[j].w); }
    const float rstd = 1.0f / sqrtf(wave_sum(s) * (1.0f / 1024.0f) + EPS);
    v2u* o8 = (v2u*)orow + lane;
#pragma unroll
    for (int j = 0; j < 4; ++j) { const v4f w = ((const v4f*)nw)[lane + 64 * j], sh = ((const v4f*)shift)[lane + 64 * j], sc = ((const v4f*)scale)[lane + 64 * j];
        const v4f y = v[j] * rstd * w * (sc + 1.0f) + sh; v2u o; o.x = pk2(y.x, y.y); o.y = pk2(y.z, y.w); o8[64 * j] = o; }
}

template <int NR>
__device__ __forceinline__ void p1_rowsN(const float* x, const float* ctx, const float* MOD, const v4f (&nwv)[4], bf16_t* HX, int r0, int rlast, int lane, unsigned char* HX8 = nullptr) {
    v4f v[NR][4];
#pragma unroll
    for (int k = 0; k < NR; ++k) { const int m = r0 + k < rlast ? r0 + k : rlast; const float* xr = m < MLAT ? x + (size_t)m * 1024 : ctx + (size_t)(m - MLAT) * 1024;
#pragma unroll
        for (int j = 0; j < 4; ++j) v[k][j] = __builtin_nontemporal_load((const v4f*)xr + lane + 64 * j); }
#pragma unroll
    for (int k = 0; k < NR; ++k) { const int m = r0 + k < rlast ? r0 + k : rlast; const float* mp = MOD + (m < MLAT ? (m >> 11) : 16) * 3072; float s = 0.f;
        v4f sh[4], sc[4];
#pragma unroll
        for (int j = 0; j < 4; ++j) { sh[j] = ((const v4f*)mp)[lane + 64 * j]; sc[j] = ((const v4f*)(mp + 1024))[lane + 64 * j]; }
#pragma unroll
        for (int j = 0; j < 4; ++j) s += (v[k][j].x * v[k][j].x + v[k][j].y * v[k][j].y) + (v[k][j].z * v[k][j].z + v[k][j].w * v[k][j].w);
        const float rstd = 1.0f / sqrtf(wave_sum(s) * (1.0f / 1024.0f) + EPS);
        v2u* o8 = (v2u*)(HX + (size_t)m * 1024) + lane;
#pragma unroll
        for (int j = 0; j < 4; ++j) { const v4f y = v[k][j] * rstd * nwv[j] * (sc[j] + 1.0f) + sh[j]; v2u o; o.x = pk2(y.x, y.y); o.y = pk2(y.z, y.w); o8[64 * j] = o;
            if (HX8) ((unsigned*)(HX8 + (size_t)m * 1024))[lane + 64 * j] = pk4_fp8(y.x, y.y, y.z, y.w); } }
}

__device__ __forceinline__ void p3_item(bf16_t* buf, int ldlog2, bool isK, const float* nw, const float* ROPE, size_t item, int lane) {
    const size_t e = item * 512 + (size_t)lane * 8; const size_t row = e >> ldlog2; const int col = (int)(e & ((1u << ldlog2) - 1)), d0 = col & 127;
    float t[8]; unpack8(*(const v4u*)(buf + e), t);
    float ss = 0.f;
#pragma unroll
    for (int k = 0; k < 8; ++k) ss += t[k] * t[k];
    ss += __shfl_xor(ss, 1); ss += __shfl_xor(ss, 2); ss += __shfl_xor(ss, 4); ss += __shfl_xor(ss, 8);
    const float rstd = 1.0f / sqrtf(ss * (1.0f / 128.0f) + EPS);
#pragma unroll
    for (int k = 0; k < 8; ++k) t[k] = t[k] * rstd * nw[d0 + k];
    int l; bool rope = true;
    if (isK) { const int p = (int)(row % LT); rope = p >= LC; l = p - LC; } else l = (int)(row & (SEQ - 1));
    if (rope) { const int ri = l >> 6, ci = l & 63, p0 = d0 >> 1; const float* tab = p0 < 32 ? ROPE + (ri * 32 + p0) * 2 : ROPE + (ci * 32 + (p0 - 32)) * 2;
#pragma unroll
        for (int q = 0; q < 4; ++q) { const float cs = tab[2 * q], sn = tab[2 * q + 1], x0 = t[2 * q], x1 = t[2 * q + 1]; t[2 * q] = x0 * cs - x1 * sn; t[2 * q + 1] = x0 * sn + x1 * cs; } }
    *(v4u*)(buf + e) = pack8(t);
}

template <int NI>
__device__ __forceinline__ void p3_items_k(bf16_t* AK, const float* nw, const float* ROPE, size_t it0, size_t itend, int lane, unsigned char* K8 = nullptr) {
    v4u raw[NI];
#pragma unroll
    for (int i = 0; i < NI; ++i) if (it0 + i < itend) raw[i] = *(const v4u*)(AK + (it0 + i) * 512 + (size_t)lane * 8);
#pragma unroll
    for (int i = 0; i < NI; ++i) if (it0 + i < itend) {
        const size_t e = (it0 + i) * 512 + (size_t)lane * 8; const size_t row = e >> 8; const int d0 = (int)(e & 255) & 127;
        float t[8]; unpack8(raw[i], t); float ss = 0.f;
#pragma unroll
        for (int k = 0; k < 8; ++k) ss += t[k] * t[k];
        ss += __shfl_xor(ss, 1); ss += __shfl_xor(ss, 2); ss += __shfl_xor(ss, 4); ss += __shfl_xor(ss, 8);
        const float rstd = 1.0f / sqrtf(ss * (1.0f / 128.0f) + EPS);
#pragma unroll
        for (int k = 0; k < 8; ++k) t[k] = t[k] * rstd * nw[d0 + k];
        const int p = (int)(row % LT);
        if (p >= LC) { const int l = p - LC, ri = l >> 6, ci = l & 63, p0 = d0 >> 1; const float* tab = p0 < 32 ? ROPE + (ri * 32 + p0) * 2 : ROPE + (ci * 32 + (p0 - 32)) * 2;
#pragma unroll
            for (int q = 0; q < 4; ++q) { const float cs = tab[2 * q], sn = tab[2 * q + 1], x0 = t[2 * q], x1 = t[2 * q + 1]; t[2 * q] = x0 * cs - x1 * sn; t[2 * q + 1] = x0 * sn + x1 * cs; } }
        *(v4u*)(AK + e) = pack8(t);
#if MK_FP8K
        if (K8) { int w0 = __builtin_amdgcn_cvt_pk_fp8_f32(t[0], t[1], 0, false); w0 = __builtin_amdgcn_cvt_pk_fp8_f32(t[2], t[3], w0, true);
            int w1 = __builtin_amdgcn_cvt_pk_fp8_f32(t[4], t[5], 0, false); w1 = __builtin_amdgcn_cvt_pk_fp8_f32(t[6], t[7], w1, true);
            const int g = ((int)(e & 255)) >> 7, pb = (d0 & 64) + 32 * ((d0 >> 3) & 1) + 8 * ((d0 >> 4) & 3); v2u w; w.x = (unsigned)w0; w.y = (unsigned)w1;
            *(v2u*)(K8 + row * 256 + g * 128 + pb) = w; }
#endif
        }
}

__device__ __forceinline__ void vt8_item(const bf16_t* AV, unsigned char* VT8, LAS unsigned char* scr, int item, int lane) {
    const int T = item % 36, bg = item / 36, b = bg >> 1, g = bg & 1;
    const bf16_t* src = AV + ((size_t)(b * LT + 64 * T)) * 256 + g * 128;
    v4u v[16];
#pragma unroll
    for (int i = 0; i < 16; ++i) { const int ci = lane + 64 * i, row = ci >> 4, c16 = ci & 15; v[i] = *(const v4u*)(src + (size_t)row * 256 + c16 * 8); }
#pragma unroll
    for (int i = 0; i < 16; ++i) { const int ci = lane + 64 * i, row = ci >> 4, c16 = ci & 15; *(LAS v4u*)(scr + row * 272 + c16 * 16) = v[i]; }
    asm volatile("s_waitcnt lgkmcnt(0)" ::: "memory");
    unsigned char* dst = VT8 + (size_t)item * 8192;
#pragma unroll
    for (int j = 0; j < 8; ++j) { const int oc = lane + 64 * j, d = oc >> 2, cc = oc & 3; float f[16];
#pragma unroll
        for (int i = 0; i < 16; ++i) { const int key = 32 * (cc >> 1) + (i & 3) + 8 * ((i >> 2) & 3) + 4 * (cc & 1); f[i] = bf2f(*(const LAS unsigned short*)(scr + key * 272 + d * 2)); }
        v4u w;
        { int a = __builtin_amdgcn_cvt_pk_fp8_f32(f[0], f[1], 0, false); a = __builtin_amdgcn_cvt_pk_fp8_f32(f[2], f[3], a, true); w.x = (unsigned)a; }
        { int a = __builtin_amdgcn_cvt_pk_fp8_f32(f[4], f[5], 0, false); a = __builtin_amdgcn_cvt_pk_fp8_f32(f[6], f[7], a, true); w.y = (unsigned)a; }
        { int a = __builtin_amdgcn_cvt_pk_fp8_f32(f[8], f[9], 0, false); a = __builtin_amdgcn_cvt_pk_fp8_f32(f[10], f[11], a, true); w.z = (unsigned)a; }
        { int a = __builtin_amdgcn_cvt_pk_fp8_f32(f[12], f[13], 0, false); a = __builtin_amdgcn_cvt_pk_fp8_f32(f[14], f[15], a, true); w.w = (unsigned)a; }
        *(v4u*)(dst + d * 64 + cc * 16) = w; }
    asm volatile("s_waitcnt lgkmcnt(0)" ::: "memory");
}

__device__ __forceinline__ void p4_naive_item(const bf16_t* RQ, const bf16_t* RK, const bf16_t* RV, bf16_t* YR, float* SSQ, const float* l2d, float* ldsf, int item, int tid) {
    const int rb = item & 255, h = (item >> 8) & 3, b = item >> 10, i0 = rb * 8;
    float* qs = ldsf; float* sc = ldsf + 2048; float* red = sc + 8 * LT;
    for (int t = tid; t < 2048; t += NTHR) { const int r = t >> 8, d = t & 255; qs[t] = bf2f(RQ[((size_t)(b * SEQ + i0 + r)) * 1024 + h * 256 + d]); }
    __syncthreads();
    const float lgf = log1pf(-exp2f(l2d[h])), lgb = log1pf(-exp2f(l2d[4 + h]));
    for (int p = tid; p < LT; p += NTHR) {
        const bf16_t* kr = RK + ((size_t)(b * LT + p)) * 1024 + h * 256;
        float dot[8];
#pragma unroll
        for (int r = 0; r < 8; ++r) dot[r] = 0.f;
        for (int d8 = 0; d8 < 32; ++d8) { float kk[8]; unpack8(*(const v4u*)(kr + d8 * 8), kk);
#pragma unroll
            for (int r = 0; r < 8; ++r)
#pragma unroll
                for (int k = 0; k < 8; ++k) dot[r] += qs[r * 256 + d8 * 8 + k] * kk[k]; }
#pragma unroll
        for (int r = 0; r < 8; ++r) { const int i = i0 + r; float W;
            if (p < LC) W = MK_DBG_NOCTX ? 0.f : expf(lgf * (float)(i + LC - p)) + expf(lgb * (float)(SEQ - i + p));
            else { const int j = p - LC; W = (j <= i ? expf(lgf * (float)(i - j)) : 0.f) + (j >= i ? expf(lgb * (float)(j - i)) : 0.f); }
            sc[r * LT + p] = dot[r] * W; }
    }
    __syncthreads();
    float acc[8];
#pragma unroll
    for (int r = 0; r < 8; ++r) acc[r] = 0.f;
    const bf16_t* vp = RV + (size_t)(b * LT) * 2048 + h * 512 + tid;
    for (int p = 0; p < LT; ++p) { const float v = bf2f(vp[(size_t)p * 2048]);
#pragma unroll
        for (int r = 0; r < 8; ++r) acc[r] += sc[r * LT + p] * v; }
    const int wid = tid >> 6, lane = tid & 63;
#pragma unroll
    for (int r = 0; r < 8; ++r) { YR[((size_t)(b * SEQ + i0 + r)) * 2048 + h * 512 + tid] = (bf16_t)f2bf(acc[r]); const float s = wave_sum(acc[r] * acc[r]); if (lane == 0) red[r * 8 + wid] = s; }
    __syncthreads();
    if (tid < 16) { const int r = tid >> 1, hf = tid & 1; const float s = (red[r * 8 + hf * 4] + red[r * 8 + hf * 4 + 1]) + (red[r * 8 + hf * 4 + 2] + red[r * 8 + hf * 4 + 3]);
        SSQ[((size_t)(b * SEQ + i0 + r)) * 8 + h * 2 + hf] = s; }
    __syncthreads();
}

__device__ __forceinline__ void p5_naive_item(bf16_t* AQ, const bf16_t* AK, const bf16_t* AV, float* ldsf, int item, int tid) {
    const int rb = item & 255, head = (item >> 8) & 7, b = item >> 11, g = head >> 2, i0 = rb * 8;
    float* qs = ldsf; float* sc = ldsf + 1024;
    for (int t = tid; t < 1024; t += NTHR) { const int r = t >> 7, d = t & 127; qs[t] = bf2f(AQ[((size_t)(b * SEQ + i0 + r)) * 1024 + head * 128 + d]); }
    __syncthreads();
    for (int p = tid; p < LT; p += NTHR) {
        const bf16_t* kr = AK + ((size_t)(b * LT + p)) * 256 + g * 128;
        float dot[8];
#pragma unroll
        for (int r = 0; r < 8; ++r) dot[r] = 0.f;
        for (int d8 = 0; d8 < 16; ++d8) { float kk[8]; unpack8(*(const v4u*)(kr + d8 * 8), kk);
#pragma unroll
            for (int r = 0; r < 8; ++r)
#pragma unroll
                for (int k = 0; k < 8; ++k) dot[r] += qs[r * 128 + d8 * 8 + k] * kk[k]; }
#pragma unroll
        for (int r = 0; r < 8; ++r) sc[r * LT + p] = dot[r] * 0.08838834764831845f;
    }
    __syncthreads();
    { const int wid = tid >> 6, lane = tid & 63; float* row = sc + wid * LT; float m = -1e30f;
      for (int p = lane; p < LT; p += 64) m = fmaxf(m, row[p]);
#pragma unroll
      for (int o = 1; o < 64; o <<= 1) m = fmaxf(m, __shfl_xor(m, o));
      float s = 0.f;
      for (int p = lane; p < LT; p += 64) { const float ex = expf(row[p] - m); row[p] = ex; s += ex; }
      s = wave_sum(s); const float inv = 1.0f / s;
      for (int p = lane; p < LT; p += 64) row[p] *= inv; }
    __syncthreads();
    const int e = tid & 127, r0 = (tid >> 7) * 2; float a0 = 0.f, a1 = 0.f;
    const bf16_t* vp = AV + (size_t)(b * LT) * 256 + g * 128 + e;
    for (int p = 0; p < LT; ++p) { const float v = bf2f(vp[(size_t)p * 256]); a0 += sc[r0 * LT + p] * v; a1 += sc[(r0 + 1) * LT + p] * v; }
    AQ[((size_t)(b * SEQ + i0 + r0)) * 1024 + head * 128 + e] = (bf16_t)f2bf(a0);
    AQ[((size_t)(b * SEQ + i0 + r0 + 1)) * 1024 + head * 128 + e] = (bf16_t)f2bf(a1);
    __syncthreads();
}

#if MK_BARRIER == 1
struct GridBarF { XcdBarrier b; __device__ __forceinline__ void operator()() const { xcd_barrier(b); } };
#else
struct GridBarF { __device__ __forceinline__ void operator()() const { cooperative_groups::this_grid().sync(); } };
#endif
__device__ __forceinline__ void ssq_item(const bf16_t* YR, float* SSQ, int it, int lane) {
    const int row = it >> 2, head = it & 3; float t[8]; unpack8(*(const v4u*)(YR + (size_t)row * 2048 + head * 512 + lane * 8), t);
    float ss = 0.f;
#pragma unroll
    for (int k = 0; k < 8; ++k) ss += t[k] * t[k];
    ss = wave_sum(ss);
    if (lane == 0) { SSQ[(size_t)row * 8 + head * 2] = ss; SSQ[(size_t)row * 8 + head * 2 + 1] = 0.f; }
}
__global__ void __launch_bounds__(NTHR, 2) mk_fwd(Args args) {
    extern __shared__ __attribute__((aligned(16))) unsigned char lds[];
    const int tid = threadIdx.x, lane = tid & 63, wave = __builtin_amdgcn_readfirstlane(tid >> 6);
    const int G = gridDim.x, bid = blockIdx.x;
    const int gw = bid * NWAVES + wave, NGW = G * NWAVES;
    float* ldsf = (float*)lds;
    unsigned char* ws = args.ws;
    const float *x = args.in[0], *cvec = args.in[1], *ctx = args.in[2], *c_ctx = args.in[3], *norm_w = args.in[4], *w_ada = args.in[5], *b_ada = args.in[6], *w_in = args.in[7],
                *l2d = args.in[8], *q_norm_w = args.in[9], *k_norm_w = args.in[10], *w_o_ret = args.in[11], *w_o_att = args.in[12], *w_out = args.in[13];
    float* MOD = (float*)(ws + WS_MOD); float* ROPE = (float*)(ws + WS_ROPE); float* SSQ = (float*)(ws + WS_SSQ);
    bf16_t *WIN = (bf16_t*)(ws + WS_WIN), *WOR = (bf16_t*)(ws + WS_WOR), *WOA = (bf16_t*)(ws + WS_WOA), *WOUT = (bf16_t*)(ws + WS_WOUT), *HX = (bf16_t*)(ws + WS_HX);
    bf16_t *RK = (bf16_t*)(ws + WS_RK), *RV = (bf16_t*)(ws + WS_RV), *RQ = (bf16_t*)(ws + WS_RQ), *AK = (bf16_t*)(ws + WS_AK), *AV = (bf16_t*)(ws + WS_AV), *AQ = (bf16_t*)(ws + WS_AQ);
    bf16_t *U1 = (bf16_t*)(ws + WS_U1), *U2 = (bf16_t*)(ws + WS_U2), *YR = (bf16_t*)args.out;
    const int lo = args.ph_lo, hi = args.ph_hi;
#define IN(k) (lo <= (k) && (k) < hi)
#define BOTH(k) (IN(k) && IN((k) + 1))
    if (tid < 32) ((LAS unsigned*)(lds + MISC_OFF))[tid] = 0u;
    __syncthreads();
#if MK_BARRIER == 1
    XcdBarrier bar; bar.bar = (unsigned*)(ws + WS_CTL) + CW_BAR; bar.x = 0; bar.st = nullptr;
    if (hi - lo > 1) bar = xcd_barrier_post((unsigned*)(ws + WS_CTL) + CW_BAR, (volatile LAS unsigned*)(lds + MISC_OFF) + 8);
#define GRID_BAR() xcd_barrier(bar)
#else
#define GRID_BAR() cooperative_groups::this_grid().sync()
#endif

#if MK_STAMP_A >= 0
#define STAMP(k) do { if (bid == 0 && tid == 0) { if ((k) == MK_STAMP_A) ((volatile LAS unsigned*)(lds + MISC_OFF))[17] = (unsigned)__builtin_amdgcn_s_memrealtime(); if ((k) == MK_STAMP_B) ((volatile LAS unsigned*)(lds + MISC_OFF))[18] = (unsigned)__builtin_amdgcn_s_memrealtime(); } } while (0)
#else
#define STAMP(k) do { } while (0)
#endif
#define STAGGER() do { if (MK_NSTAG > 1) { const unsigned grp = ((unsigned)bid >> 3) % MK_NSTAG; const unsigned long long t0_ = __builtin_amdgcn_s_memrealtime(); \
        while (__builtin_amdgcn_s_memrealtime() - t0_ < (unsigned long long)grp * MK_STAG_TICKS) __builtin_amdgcn_s_sleep(16); } } while (0)
    STAMP(0);
    if (IN(0)) {
        for (int it = bid; it < 192; it += G) p0_mod_item(cvec, c_ctx, w_ada, b_ada, MOD, ldsf, it, tid);
        if (bid == G - 1) for (int t = tid; t < 2048; t += NTHR) { const int v = t >> 5, i = t & 31; double fd = 1.0; for (int k = 0; k < i; ++k) fd *= 0.7498942093324559;
            const float ang = (float)v * (float)fd; float cs, sn; sincos_d((double)ang, cs, sn); ROPE[2 * t] = cs; ROPE[2 * t + 1] = sn; }
        if (BOTH(0)) GRID_BAR();
    }
    STAMP(1);
    if (IN(1)) {
        {
        float* scr = ldsf + wave * (64 * 65);
        constexpr int I_IN = 16 * (NIN / 64), I_OR = 32 * 16, I_OA = 16 * 16, I_OUT = 16 * 16;
        for (int it = gw; it < I_IN + I_OR + I_OA + I_OUT; it += NGW) {
            int r = it;
            if (r < I_IN) { const int n0 = 64 * (r % (NIN / 64)), gr = new_col(n0);
                const int r8 = (MK_FP8G >= 2) ? ((gr >= 3072 && gr < 3584) ? gr - 3072 : ((gr >= 4608 && gr < 5632) ? gr - 4608 + 512 : -1)) : -1;
                p0_transpose64_item(w_in, 1024, NIN, WIN, gr - n0, scr, r, lane, r8 >= 0 ? ws + WS_WIN8 : (unsigned char*)nullptr, r8 - n0); continue; } r -= I_IN;
            if (r < I_OR) { p0_transpose64_item(w_o_ret, 2048, 1024, WOR, 0, scr, r, lane); continue; } r -= I_OR;
            if (r < I_OA) { p0_transpose64_item(w_o_att, 1024, 1024, WOA, 0, scr, r, lane, MK_FP8G ? ws + WS_WOA8 : (unsigned char*)nullptr, 0); continue; } r -= I_OA;
            p0_transpose64_item(w_out, 1024, 1024, WOUT, 0, scr, r, lane);
        }
        }
        {
            const int rpw = (MALL + NGW - 1) / NGW, m0 = gw * rpw, m1 = m0 + rpw < MALL ? m0 + rpw : MALL;
            v4f nwv[4];
#pragma unroll
            for (int j = 0; j < 4; ++j) nwv[j] = ((const v4f*)norm_w)[lane + 64 * j];
            for (int m = m0; m < m1; m += 9) p1_rowsN<9>(x, ctx, MOD, nwv, HX, m, m1 - 1, lane, MK_FP8G >= 2 ? (unsigned char*)args.out : (unsigned char*)nullptr);
        }
        if (BOTH(1)) GRID_BAR();
    }
    STAMP(2);
    if (IN(2)) {
        STAGGER();
        pg8::Gemm g{HX, WIN, MALL, N1, 1024}; pg8::Sched1 S; S.init(G, bid);
        pg8::Epi1 E{RK, RV, AK, AV, RQ, AQ, nullptr};
#if MK_P2PROBE == 4
        { pg8::Epi1T<2> EC{RK, RV, AK, AV, RQ, AQ, nullptr}; pg8::gemm_phase<pg8::Epi1T<2>, pg8::Sched1, true, true, MK_EPIW>((PG8_LAS unsigned char*)lds, g, S, EC); }
        __syncthreads();
#endif
#if MK_FP8G >= 2
        { pg8::SchedG1 S0; S0.init(G, bid, 0); pg8::gemm_phase<pg8::Epi1, pg8::SchedG1, true, true, MK_EPIW>((PG8_LAS unsigned char*)lds, g, S0, E); }
        { pg8::SchedG1 S1; S1.init(G, bid, 1); pg8::Gemm g8{(const bf16_t*)args.out, (const bf16_t*)(ws + WS_WIN8), MALL, 1536, 512, 0x7F7F7F7F, F8W_SC}; pg8::Epi1F8 E8{E};
          pg8::gemm_phase<pg8::Epi1F8, pg8::SchedG1, true, true, MK_EPIW, true>((PG8_LAS unsigned char*)lds, g8, S1, E8); }
#else
        for (int rep = 0; rep < MK_REP_P2; ++rep) pg8::gemm_phase<pg8::Epi1, pg8::Sched1, true, true, MK_EPIW>((PG8_LAS unsigned char*)lds, g, S, E);
#endif
#if MK_P2PROBE == 1
        { pg8::Epi1T<1> ED{RK, RV, AK, AV, RQ, AQ, (bf16_t*)(ws + WS_END)}; pg8::gemm_phase<pg8::Epi1T<1>, pg8::Sched1, true, true, MK_EPIW>((PG8_LAS unsigned char*)lds, g, S, ED); }
#endif
#if MK_P2PROBE == 3
        { pg8::Epi1T<0> ER{RK, RV, AK, AV, RQ, AQ, nullptr}; pg8::gemm_phase<pg8::Epi1T<0>, pg8::Sched1, true, true, MK_EPIW>((PG8_LAS unsigned char*)lds, g, S, ER); }
#endif
#if MK_P2PROBE == 2
        { pg8::EpiNull EN; pg8::gemm_phase<pg8::EpiNull, pg8::Sched1, true, true, 0>((PG8_LAS unsigned char*)lds, g, S, EN); }
#endif
        if (BOTH(2)) GRID_BAR();
    }
    STAMP(3);
#if MK_NAIVE_ATTN
    if (IN(3)) {
        constexpr size_t IQ = (size_t)MLAT * 1024 / 512, IK = (size_t)NB * LT * 256 / 512;
        for (size_t it = gw; it < IQ + IK; it += NGW) {
            if (it < IQ) p3_item(AQ, 10, false, q_norm_w, ROPE, it, lane); else p3_item(AK, 8, true, k_norm_w, ROPE, it - IQ, lane);
        }
        if (BOTH(3)) GRID_BAR();
    }
#endif
#if MK_DEBUG_ATTN
    {
        bf16_t* AQ2 = (bf16_t*)(ws + WS_RK); float* acc2 = (float*)(ws + WS_CTL) + 64;
        for (size_t i = (size_t)bid * NTHR + tid; i < (size_t)MLAT * 1024 / 8; i += (size_t)G * NTHR) ((v4u*)AQ2)[i] = ((const v4u*)AQ)[i];
        { int tl = threadIdx.x; asm volatile("" : "+v"(tl)); const int lane_l = tl & 63, gw_l = bid * NWAVES + (tl >> 6);
          constexpr size_t IK = (size_t)NB * LT * 256 / 512; for (size_t it = gw_l; it < IK; it += NGW) p3_item(AK, 8, true, k_norm_w, ROPE, it, lane_l); }
        GRID_BAR();
        { int tl = threadIdx.x; asm volatile("" : "+v"(tl)); const int lane_l = tl & 63, gw_l = bid * NWAVES + (tl >> 6);
          constexpr size_t IQ = (size_t)MLAT * 1024 / 512; for (size_t it = gw_l; it < IQ; it += NGW) p3_item(AQ2, 10, false, q_norm_w, ROPE, it, lane_l); }
        GRID_BAR();
        { const int vcu = (bid & 7) * (G >> 3) + (bid >> 3);
          for (int idx = vcu; idx < NB * AH * 8; idx += G) { const int qb = idx & 7, r = (idx >> 3) & 3, g = (idx >> 5) & 1, b = idx >> 6, head = g * 4 + r;
            bf16_t* Q = AQ + ((size_t)(b * SEQ + qb * 256)) * 1024 + head * 128; const bf16_t* K = AK + (size_t)(b * LT) * 256 + g * 128; const bf16_t* V = AV + (size_t)(b * LT) * 256 + g * 128;
            attn::attn_dense_body<attn::bf16>(Q, K, V, Q, LT, (char*)lds, q_norm_w, ROPE, qb * 256); } }
        __syncthreads();
        { const int vcu = (bid & 7) * (G >> 3) + (bid >> 3);
          for (int idx = vcu; idx < NB * AH * 8; idx += G) { const int qb = idx & 7, r = (idx >> 3) & 3, g = (idx >> 5) & 1, b = idx >> 6, head = g * 4 + r;
            bf16_t* Q = AQ2 + ((size_t)(b * SEQ + qb * 256)) * 1024 + head * 128; const bf16_t* K = AK + (size_t)(b * LT) * 256 + g * 128; const bf16_t* V = AV + (size_t)(b * LT) * 256 + g * 128;
            attn::attn_dense_body<attn::bf16>(Q, K, V, Q, LT, (char*)lds, nullptr, ROPE, qb * 256); } }
        GRID_BAR();
        float sd = 0.f, sb = 0.f;
        for (size_t i = (size_t)bid * NTHR + tid; i < (size_t)MLAT * 1024; i += (size_t)G * NTHR) { const float a = bf2f(AQ[i]), b2 = bf2f(AQ2[i]); sd += (a - b2) * (a - b2); sb += b2 * b2; }
        sd = wave_sum(sd); sb = wave_sum(sb);
        if (lane == 0) { atomicAdd(acc2, sd); atomicAdd(acc2 + 1, sb); }
        GRID_BAR();
        if (bid == 0 && tid == 0) { const float s0 = __hip_atomic_load(acc2, __ATOMIC_RELAXED, __HIP_MEMORY_SCOPE_AGENT), s1 = __hip_atomic_load(acc2 + 1, __ATOMIC_RELAXED, __HIP_MEMORY_SCOPE_AGENT);
            args.out[0] = 1e6f * sqrtf(s0 / s1); args.out[1] = 1e3f * sqrtf(s1 / ((float)MLAT * 1024.f)); }
        return;
    }
#endif
    STAMP(4);
#if MK_DEBUG_RET
    {
        bf16_t* YR2 = (bf16_t*)(ws + WS_AQ); float* acc2 = (float*)(ws + WS_CTL) + 64;
        for (int it = bid; it < 8 * RH * 256; it += G) p4_naive_item(RQ, RK, RV, YR, SSQ, l2d, ldsf, it, tid);
        __syncthreads();
        { GridBarF gb{bar}; ret::scan_unit(RQ, RK, RV, YR2, SSQ + 2 * MLAT * 8, l2d, (LAS unsigned char*)lds, bid, gb, 8); }
        GRID_BAR();
        float sd = 0.f, sb = 0.f;
        for (size_t i = (size_t)bid * NTHR + tid; i < (size_t)8 * SEQ * 2048; i += (size_t)G * NTHR) { const int l = (int)((i >> 11) & 2047); if (l < MK_DBG_L0 || l >= MK_DBG_L1 || (int)((i >> 9) & 3) != MK_DBG_H) continue; const float a = bf2f(YR2[i]), b2 = bf2f(YR[i]); sd += (a - b2) * (a - b2); sb += b2 * b2; }
        sd = wave_sum(sd); sb = wave_sum(sb);
        if (lane == 0) { atomicAdd(acc2, sd); atomicAdd(acc2 + 1, sb); }
        GRID_BAR();
        if (bid == 0 && tid == 0) { const float s0 = __hip_atomic_load(acc2, __ATOMIC_RELAXED, __HIP_MEMORY_SCOPE_AGENT), s1 = __hip_atomic_load(acc2 + 1, __ATOMIC_RELAXED, __HIP_MEMORY_SCOPE_AGENT);
            ((float*)(ws + WS_SSQ))[0] = 1e6f * sqrtf(s0 / s1); ((float*)(ws + WS_SSQ))[1] = 1e3f * sqrtf(s1 / (8.f * SEQ * 2048.f)); }
        GRID_BAR();
        if (bid == 0 && tid == 0) { args.out[0] = ((float*)(ws + WS_SSQ))[0]; args.out[1] = ((float*)(ws + WS_SSQ))[1]; }
        return;
    }
#endif
    if (IN(4)) {
        auto kfix = [&]() {
#if !MK_NAIVE_ATTN
          int tl = threadIdx.x; asm volatile("" : "+v"(tl)); const int lane_l = tl & 63, gw_l = bid * NWAVES + (tl >> 6);
          constexpr size_t IK = (size_t)NB * LT * 256 / 512; const size_t ipw = (IK + NGW - 1) / NGW, i0 = (size_t)gw_l * ipw, i1 = i0 + ipw < IK ? i0 + ipw : IK;
          for (size_t it = i0; it < i1; it += 3) p3_items_k<3>(AK, k_norm_w, ROPE, it, i1, lane_l, ws + WS_K8);
#if MK_FP8V
          { const int wv = __builtin_amdgcn_readfirstlane(tl >> 6); for (int it = gw_l; it < NB * 2 * 36; it += NGW) vt8_item(AV, ws + WS_VT8, (LAS unsigned char*)lds + wv * (64 * 272), it, lane_l); }
#endif
#endif
        };
#if MK_NAIVE_RET
        kfix(); for (int it = bid; it < NB * RH * 256; it += G) p4_naive_item(RQ, RK, RV, YR, SSQ, l2d, ldsf, it, tid);
#else
        if (G == 256) { GridBarF gb{bar}; ret::scan_unit(RQ, RK, RV, YR, SSQ, l2d, (LAS unsigned char*)lds, bid, gb, NB, kfix); if (MK_MIX && BOTH(4)) GRID_BAR(); }
        else { kfix(); for (int it = bid; it < NB * RH * 256; it += G) p4_naive_item(RQ, RK, RV, YR, SSQ, l2d, ldsf, it, tid); if (BOTH(4)) GRID_BAR(); }
#endif
    }
    STAMP(5);
    if (IN(5)) {
#if MK_NAIVE_ATTN
        for (int it = bid; it < NB * AH * 256; it += G) p5_naive_item(AQ, AK, AV, ldsf, it, tid);
#else
        const int vcu = (G % 8 == 0) ? (bid & 7) * (G >> 3) + (bid >> 3) : bid;
#define ATT_UNIT(idx_, Q_, K_, V_, qb_) const int qb_ = (idx_) & 7; bf16_t* Q_; const bf16_t *K_, *V_; \
            { const int r_ = ((idx_) >> 3) & 3, g_ = ((idx_) >> 5) & 1, b_ = (idx_) >> 6, head_ = g_ * 4 + r_; Q_ = AQ + ((size_t)(b_ * SEQ + qb_ * 256)) * 1024 + head_ * 128; \
              K_ = MK_FP8K ? (const bf16_t*)(ws + WS_K8 + ((size_t)(b_ * LT) * 256 + g_ * 128)) : AK + (size_t)(b_ * LT) * 256 + g_ * 128; V_ = MK_FP8V ? (const bf16_t*)(ws + WS_VT8 + (size_t)((b_ * 2 + g_) * 36) * 8192) : AV + (size_t)(b_ * LT) * 256 + g_ * 128; }
        auto run_attn = [&](const int nkeys, const bool store) {
        attn::Pre pre;
        if (vcu < NB * AH * 8) { ATT_UNIT(vcu, Q0, K0, V0, qb0); attn::attn_prefetch(Q0, K0, V0, pre); }
        for (int idx = vcu; idx < NB * AH * 8; idx += G) {
            ATT_UNIT(idx, Q, K, V, qb);
            const int nidx = idx + G; const bool hn = nidx < NB * AH * 8; ATT_UNIT(hn ? nidx : idx, Qn, Kn, Vn, qbn);
            attn::attn_dense_body<attn::bf16>(Q, K, V, store ? Q : (bf16_t*)nullptr, nkeys, (char*)lds, q_norm_w, ROPE, qb * 256, pre, Qn, Kn, Vn); __syncthreads();
        } };
#if MK_MIX
        auto run_gates = [&](int mode) { pg8::Gemm g{HX, WIN + (size_t)N1 * 1024, MLAT, NG, 1024}; pg8::SchedGates S; S.init(G, bid, mode); pg8::Epi5 E{YR, AQ, U1, U2, SSQ, 0, ws + WS_YA8};
            pg8::gemm_phase<pg8::Epi5, pg8::SchedGates, true, true, MK_EPIW>((PG8_LAS unsigned char*)lds, g, S, E); };
        const bool attn_first = (bid & 4) == 0;
        if (attn_first) { run_attn(LT, true); __syncthreads(); run_gates(0); } else { run_gates(0); __syncthreads(); run_attn(LT, true); }
        __syncthreads(); GRID_BAR(); run_gates(1);
#else
        for (int rep = 0; rep < (MK_ATTN_PROBE > 0 ? 2 : 1); ++rep) run_attn(rep ? MK_ATTN_PROBE : LT, rep == 0);
#endif
#undef ATT_UNIT
#endif
#if !MK_NAIVE_RET
        if (G != 256) { int tl = threadIdx.x; asm volatile("" : "+v"(tl)); const int lane_l = tl & 63, gw_l = bid * NWAVES + (tl >> 6);
          for (int it = gw_l; it < MLAT * 4; it += NGW) ssq_item(YR, SSQ, it, lane_l); }
#endif
        if (BOTH(5)) GRID_BAR();
    }
    STAMP(6);
    if (IN(6) && !MK_MIX) {
        STAGGER();
        pg8::Gemm g{HX, WIN + (size_t)N1 * 1024, MLAT, NG, 1024}; pg8::StaticOrder S; S.init(MLAT, NG, G, bid);
        pg8::Epi5 E{YR, AQ, U1, U2, SSQ, 0, ws + WS_YA8};
        pg8::gemm_phase<pg8::Epi5, pg8::StaticOrder, true, true, MK_EPIW>((PG8_LAS unsigned char*)lds, g, S, E);
        if (BOTH(6)) GRID_BAR();
    }
    STAMP(7);
    if (IN(7)) {
        pg8::Gemm g{YR, WOR, MLAT, 1024, 2048}; pg8::StaticOrder S; S.init(MLAT, 1024, G, bid);
        pg8::Epi6 E{U1};
        pg8::gemm_phase<pg8::Epi6, pg8::StaticOrder, true, true, MK_EPIW>((PG8_LAS unsigned char*)lds, g, S, E);
    }
    STAMP(8);
    if (IN(8)) {
        pg8::StaticOrder S; S.init(MLAT, 1024, G, bid);
        pg8::Epi7 E{U1, U2};
#if MK_FP8G
        { pg8::Gemm g{(const bf16_t*)(ws + WS_YA8), (const bf16_t*)(ws + WS_WOA8), MLAT, 1024, 512, F8Y_SC, F8W_SC};
          pg8::gemm_phase<pg8::Epi7, pg8::StaticOrder, true, true, MK_EPIW, true>((PG8_LAS unsigned char*)lds, g, S, E); }
#else
        { pg8::Gemm g{AQ, WOA, MLAT, 1024, 1024};
          pg8::gemm_phase<pg8::Epi7, pg8::StaticOrder, true, true, MK_EPIW>((PG8_LAS unsigned char*)lds, g, S, E); }
#endif
        if (BOTH(8)) GRID_BAR();
    }
    STAMP(9);
    if (IN(9)) {
        pg8::Gemm g{U1, WOUT, MLAT, 1024, 1024}; pg8::StaticOrder S; S.init(MLAT, 1024, G, bid);
        pg8::Epi8 E{x, MOD, args.out};
        { pg8::RepOrder SR; SR.so = S; SR.reps = MK_REP_P9; pg8::gemm_phase<pg8::Epi8, pg8::RepOrder, true, true, MK_EPIW>((PG8_LAS unsigned char*)lds, g, SR, E); }
    }
    STAMP(10);
#if MK_TIMING
    if (bid == 0) { const unsigned spin = __builtin_amdgcn_readfirstlane(((const unsigned*)SSQ - 64)[MK_TSEL]); const unsigned long long t0_ = __builtin_amdgcn_s_memrealtime();
        while (__builtin_amdgcn_s_memrealtime() - t0_ < (unsigned long long)spin) __builtin_amdgcn_s_sleep(8); }
#endif
#if MK_STAMP_A >= 0
    __syncthreads();
    if (bid == 0) { __syncthreads(); const unsigned sp = ((volatile LAS unsigned*)(lds + MISC_OFF))[18] - ((volatile LAS unsigned*)(lds + MISC_OFF))[17]; const unsigned long long t0_ = __builtin_amdgcn_s_memrealtime();
        while (__builtin_amdgcn_s_memrealtime() - t0_ < (unsigned long long)sp) __builtin_amdgcn_s_sleep(8); }
#endif
#undef IN
#undef BOTH
}

extern "C" void kernel_launch(void* const* d_in, const int* in_sizes, int n_in, void* d_out, int out_size, void* d_ws, size_t ws_size, hipStream_t stream) {
    static int grid = 0;
    if (grid == 0) {
        if (n_in != 14 || in_sizes[0] != MLAT * DM || out_size != MLAT * DM || ws_size < WS_END) {
            fprintf(stderr, "kernel_launch: unexpected shapes: n_in %d in0 %d out %d ws %zu (need >= %zu)\n", n_in, n_in > 0 ? in_sizes[0] : -1, out_size, ws_size, (size_t)WS_END); grid = -1; return; }
        int dev = 0, cus = 0;
        if (hipGetDevice(&dev) != hipSuccess || hipDeviceGetAttribute(&cus, hipDeviceAttributeMultiprocessorCount, dev) != hipSuccess) { grid = -1; return; }
        if (hipFuncSetAttribute((const void*)mk_fwd, hipFuncAttributeMaxDynamicSharedMemorySize, LDS_BYTES) != hipSuccess) { fprintf(stderr, "kernel_launch: hipFuncSetAttribute failed\n"); grid = -1; return; }
        grid = cus;
    }
    if (grid < 0) return;
    Args a{};
    for (int i = 0; i < 14; ++i) a.in[i] = (const float*)d_in[i];
    a.out = (float*)d_out; a.ws = (unsigned char*)d_ws;
#if MK_ONE_LAUNCH
    a.ph_lo = 0; a.ph_hi = N_PHASES;
#if MK_BARRIER == 1
    if (hipMemsetAsync((char*)d_ws + WS_CTL, 0, CTL_ZERO_BYTES, stream) != hipSuccess) { fprintf(stderr, "kernel_launch: hipMemsetAsync failed\n"); return; }
    hipLaunchKernelGGL(mk_fwd, dim3(grid), dim3(NTHR), LDS_BYTES, stream, a);
#else
    void* kargs[] = {&a};
    const hipError_t ce = hipLaunchCooperativeKernel((const void*)mk_fwd, dim3(grid), dim3(NTHR), kargs, LDS_BYTES, stream);
    if (ce != hipSuccess) fprintf(stderr, "kernel_launch: cooperative launch failed: %s\n", hipGetErrorName(ce));
#endif
#else
    for (int ph = 0; ph < N_PHASES; ++ph) {
        a.ph_lo = ph; a.ph_hi = ph + 1;
        hipLaunchKernelGGL(mk_fwd, dim3(grid), dim3(NTHR), LDS_BYTES, stream, a);
    }
#endif
    const hipError_t le = hipPeekAtLastError();
    if (le != hipSuccess) fprintf(stderr, "kernel_launch: launch failed: %s\n", hipGetErrorName(le));
}
```

```cpp
#include <hip/hip_runtime.h>
#include <cstdio>
#include <cstdint>
#include <hip/hip_cooperative_groups.h>

constexpr int NB = 16, SEQ = 2048, DM = 1024, LC = 256, LT = LC + SEQ;
constexpr int MLAT = NB * SEQ, MCTX = NB * LC, MALL = MLAT + MCTX;
constexpr int RH = 4, RDK = 256, RDV = 512;
constexpr int AH = 8, AKV = 2, AHD = 128;
constexpr int NIN = 10752, NKV = 3584, N1 = 5632, NG = 5120;
constexpr float EPS = 1e-6f;
#ifndef MK_TIMING
#define MK_TIMING 0
#define MK_TSEL 0
#endif
#ifndef MK_WT
#define MK_WT 1
#endif
#ifndef MK_WT_AUX
#define MK_WT_AUX 18
#endif
#ifndef MK_FP8K
#define MK_FP8K 1
#endif
#ifndef MK_FP8G
#define MK_FP8G 2
#endif
#ifndef MK_FP8V
#define MK_FP8V 1
#endif
#ifndef MK_E6B
#define MK_E6B 4
#define MK_E7B 2
#define MK_E8B 2
#endif
#ifndef MK_E5B
#define MK_E5B 1
#endif
#ifndef MK_P2PROBE
#define MK_P2PROBE 0
#endif
#ifndef MK_RPROBE
#define MK_RPROBE 0
#endif
#ifndef MK_DBG_NOCTX
#define MK_DBG_NOCTX 0
#endif
constexpr int NWAVES = 8, NTHR = 512;
#define LAS __attribute__((address_space(3)))

typedef unsigned short bf16_t;
typedef unsigned v4u __attribute__((ext_vector_type(4)));
typedef unsigned v2u __attribute__((ext_vector_type(2)));
typedef float v4f __attribute__((ext_vector_type(4)));
typedef float v2f __attribute__((ext_vector_type(2)));

__device__ __forceinline__ float bf2f(unsigned h) { return __uint_as_float(h << 16); }
__device__ __forceinline__ unsigned f2bf(float f) { unsigned u = __float_as_uint(f); return (u + 0x7fffu + ((u >> 16) & 1u)) >> 16; }
__device__ __forceinline__ unsigned pk2(float lo, float hi) { return f2bf(lo) | (f2bf(hi) << 16); }
__device__ __forceinline__ float bflo(unsigned w) { return __uint_as_float(w << 16); }
__device__ __forceinline__ float bfhi(unsigned w) { return __uint_as_float(w & 0xffff0000u); }
__device__ __forceinline__ float fast_sigmoid(float x) { return __builtin_amdgcn_rcpf(1.0f + __builtin_amdgcn_exp2f(-1.4426950408889634f * x)); }
__device__ __forceinline__ float fast_silu(float x) { return x * fast_sigmoid(x); }
__device__ __forceinline__ void sigmoid4(const float (&x)[4], float (&s)[4]) {
    float a[4];
#pragma unroll
    for (int k = 0; k < 4; ++k) a[k] = 1.0f + __builtin_amdgcn_exp2f(-1.4426950408889634f * fmaxf(x[k], -20.0f));
    const float p01 = a[0] * a[1], p23 = a[2] * a[3], r = __builtin_amdgcn_rcpf(p01 * p23), r01 = r * p23, r23 = r * p01;
    s[0] = r01 * a[1]; s[1] = r01 * a[0]; s[2] = r23 * a[3]; s[3] = r23 * a[2];
}
__device__ __forceinline__ float sat8(float v) { return __builtin_amdgcn_fmed3f(v, -448.0f, 448.0f); }
__device__ __forceinline__ unsigned pk4_fp8(float a, float b, float c, float d) { int w = __builtin_amdgcn_cvt_pk_fp8_f32(sat8(a), sat8(b), 0, false); w = __builtin_amdgcn_cvt_pk_fp8_f32(sat8(c), sat8(d), w, true); return (unsigned)w; }
constexpr float F8W_MUL = 128.0f;  constexpr int F8W_SC = 0x78787878;
constexpr float F8Y_MUL = 64.0f;   constexpr int F8Y_SC = 0x79797979;
__device__ __forceinline__ float wave_sum(float v) {
#pragma unroll
    for (int o = 1; o < 64; o <<= 1) v += __shfl_xor(v, o);
    return v;
}

typedef __bf16 bf16x2_t __attribute__((ext_vector_type(2)));
__device__ __forceinline__ unsigned cvt_pk_bf16(float lo, float hi) { v2f v = {lo, hi}; bf16x2_t b = __builtin_convertvector(v, bf16x2_t); return __builtin_bit_cast(unsigned, b); }
__device__ __forceinline__ void unpack8(const v4u w, float (&o)[8]) {
    o[0] = bflo(w.x); o[1] = bfhi(w.x); o[2] = bflo(w.y); o[3] = bfhi(w.y); o[4] = bflo(w.z); o[5] = bfhi(w.z); o[6] = bflo(w.w); o[7] = bfhi(w.w);
}
__device__ __forceinline__ v4u pack8(const float (&o)[8]) {
    v4u w; w.x = cvt_pk_bf16(o[0], o[1]); w.y = cvt_pk_bf16(o[2], o[3]); w.z = cvt_pk_bf16(o[4], o[5]); w.w = cvt_pk_bf16(o[6], o[7]); return w;
}

constexpr size_t MiB = 1u << 20;
constexpr size_t WS_CTL = 0;
constexpr size_t WS_MOD = 1 * MiB;
constexpr size_t WS_ROPE = WS_MOD + 256 * 1024;
constexpr size_t WS_SSQ = 2 * MiB;
constexpr size_t WS_WIN = 4 * MiB;
constexpr size_t WS_WOR = 25 * MiB;
constexpr size_t WS_WOA = 29 * MiB;
constexpr size_t WS_WOUT = 31 * MiB;
constexpr size_t WS_HX = 33 * MiB;
constexpr size_t WS_RK = 105 * MiB;
constexpr size_t WS_RV = 177 * MiB;
constexpr size_t WS_RQ = 321 * MiB;
constexpr size_t WS_AK = 385 * MiB;
constexpr size_t WS_AV = 403 * MiB;
constexpr size_t WS_AQ = 421 * MiB;
constexpr size_t WS_K8 = 485 * MiB;
constexpr size_t WS_VT8 = 495 * MiB;
constexpr size_t WS_WOA8 = 505 * MiB;
constexpr size_t WS_WIN8 = 506 * MiB;
constexpr size_t WS_END = 508 * MiB;
constexpr size_t WS_YA8 = WS_RQ;
constexpr size_t WS_U1 = WS_RK;
constexpr size_t WS_U2 = WS_RV;

__host__ __device__ __forceinline__ int orig_col(int n) { return n < 4608 ? n : (n < 5632 ? n + 2048 : (n < 7680 ? n - 1024 : n)); }
namespace pg8 {
#define PG8_LAS __attribute__((address_space(3)))
typedef unsigned short bf16_t;
typedef short bf16x8 __attribute__((ext_vector_type(8)));
typedef float f32x4 __attribute__((ext_vector_type(4)));
typedef unsigned u32x4 __attribute__((ext_vector_type(4)));
constexpr int BM = 256, BK = 64, HALF = 128, HTB = HALF * BK * 2  , STAGE_BYTES = 8 * HTB, NXCD = 8, WGM = 8;

__host__ __device__ __forceinline__ int lds_byte(int r, int c) { const int st = (r >> 4) * 2 + (c >> 5), rr = r & 15, cc = c & 31, ob = rr * 64 + cc * 2; return st * 1024 + (ob ^ (((ob >> 9) & 1) << 5)); }
__host__ __device__ __forceinline__ void stage_rc(int b, int& R, int& C) { const int st = b / 1024, sb = b % 1024, swz = sb ^ (((sb >> 9) & 1) << 5); R = (st >> 1) * 16 + swz / 64; C = (st & 1) * 32 + (swz % 64) / 2; }
__host__ __device__ __forceinline__ int perm32(int rho) { const int n = rho >> 4, i = rho & 15; return 8 * (i >> 2) + 4 * n + (i & 3); }

struct Unit { int pm, pn; };
struct Gemm { const bf16_t* A; const bf16_t* Bt; int M, N, K; int scA = 0x7F7F7F7F, scB = 0x7F7F7F7F; };

struct StaticOrder {
    int nM, nN, nwg, G, c;
    __host__ __device__ void init(int M, int N, int G_, int c_) { nM = M / BM; nN = N / BM; nwg = nM * nN; G = G_; c = c_; }
    __host__ __device__ bool next(int i, Unit& u) const {
        const long L = (long)i * G + c; if (L >= nwg) return false;
        int wgid = (int)L; { const int q = nwg / NXCD, r = nwg % NXCD, xcd = wgid % NXCD, off = wgid / NXCD; wgid = (xcd < r ? xcd * (q + 1) : r * (q + 1) + (xcd - r) * q) + off; }
        const int nig = WGM * nN, gid = wgid / nig, fm = gid * WGM, gsz = (nM - fm) < WGM ? (nM - fm) : WGM;
        u.pm = fm + ((wgid % nig) % gsz); u.pn = (wgid % nig) / gsz; return true;
    }
    __device__ __forceinline__ void a_ready(const Unit&) const {}
    __device__ __forceinline__ void done(const Unit&) const {}
};


#if MK_WT
#define WT_RSRC(name, baseptr) const __amdgpu_buffer_rsrc_t name = __builtin_amdgcn_make_buffer_rsrc((void*)(baseptr), 0, 0x7ffffff0, 0x00020000)
#define WT_ST16(name, byteoff, val) __builtin_amdgcn_raw_buffer_store_b128((val), name, (unsigned)(byteoff), 0, MK_WT_AUX)
#endif
struct Sched1 {
    int G, c; StaticOrder so;
    __device__ void init(int G_, int c_) { G = G_; c = c_; so.init(MLAT, N1, G_, c_); }
    __device__ bool next(int i, Unit& u) const {
        long L = (long)i * G + c; if (L < 2816) return so.next(i, u);
        L -= 2816; if (L >= 224) return false;
        u.pm = 128 + (int)(L & 15); u.pn = (int)(L >> 4); return true;
    }
    __device__ __forceinline__ void a_ready(const Unit&) const {}
    __device__ __forceinline__ void done(const Unit&) const {}
};

struct SchedG1 {
    StaticOrder so; int G, c, mode, nlat, nctx, ncol;
    __device__ void init(int G_, int c_, int mode_) { G = G_; c = c_; mode = mode_; ncol = mode_ ? 6 : 16; so.init(MLAT, ncol * 256, G_, c_); nlat = 128 * ncol; nctx = mode_ ? 0 : 16 * 14; }
    __device__ bool next(int i, Unit& u) const {
        long L = (long)i * G + c;
        if (L < nlat) { so.next(i, u); if (!mode) u.pn = u.pn < 12 ? u.pn : u.pn + 2; return true; }
        L -= nlat; if (L >= nctx) return false;
        u.pm = 128 + (int)(L & 15); u.pn = (int)(L >> 4); return true;
    }
    __device__ __forceinline__ void a_ready(const Unit&) const {}
    __device__ __forceinline__ void done(const Unit&) const {}
};
struct SchedGates {
    StaticOrder so; int mode;
    __device__ void init(int G_, int c_, int mode_) { mode = mode_; so.init(MLAT, (mode_ ? 4 : 16) * 256, G_, c_); }
    __device__ bool next(int i, Unit& u) const { if (!so.next(i, u)) return false; u.pn = mode ? u.pn + 8 : (u.pn < 8 ? u.pn : u.pn + 4); return true; }
    __device__ __forceinline__ void a_ready(const Unit&) const {}
    __device__ __forceinline__ void done(const Unit&) const {}
};
struct RepOrder {
    StaticOrder so; int reps;
    __device__ bool next(int i, Unit& u) const { const int per = (so.nwg - so.c + so.G - 1) / so.G; if (i >= per * reps) return false; return so.next(i % per, u); }
    __device__ __forceinline__ void a_ready(const Unit&) const {}
    __device__ __forceinline__ void done(const Unit&) const {}
};

#define EPI_ROWS_BEGIN const int rt0 = wr * 64 + fr, ct0 = wc * 32 + 8 * fq; \
    _Pragma("unroll") for (int ai = 0; ai < 2; ++ai) _Pragma("unroll") for (int m = 0; m < 4; ++m) { const int rt = rt0 + ai * HALF + m * 16;
#define EPI_ROWS_END }

template <int DUM> struct Epi1T {
    static constexpr bool PERM = true, AFTER_DRAIN = false;
    bf16_t *RK, *RV, *AK, *AV, *RQ, *AQ; bf16_t* DUMMY;
    __device__ __forceinline__ void operator()(const f32x4 (&acc)[2][2][4][2], const Unit& u, int wr, int wc, int fr, int fq) const {
        const int pm = u.pm, pn = u.pn;
        const int kvrow0 = pm < 128 ? ((pm >> 3) * LT + LC + (pm & 7) * 256) : ((pm - 128) * LT);
        bf16_t* base; int ld; float sc = 1.f;
        if (pn < 4) { base = RK + (size_t)kvrow0 * 1024 + pn * 256; ld = 1024; sc = 0.0625f; }
        else if (pn < 12) { base = RV + (size_t)kvrow0 * 2048 + (pn - 4) * 256; ld = 2048; }
        else if (pn == 12) { base = AK + (size_t)kvrow0 * 256; ld = 256; }
        else if (pn == 13) { base = AV + (size_t)kvrow0 * 256; ld = 256; }
        else if (pn < 18) { base = RQ + (size_t)pm * 256 * 1024 + (pn - 14) * 256; ld = 1024; }
        else { base = AQ + (size_t)pm * 256 * 1024 + (pn - 18) * 256; ld = 1024; }
#if MK_P2PROBE
        if constexpr (DUM == 1) { base = DUMMY + (size_t)blockIdx.x * 32768; ld = 256; }
        if constexpr (DUM == 2) {
            const int rb = kvrow0 >> 8;
            if (pn < 4) base = RK + ((size_t)rb * 4 + pn) * 65536; else if (pn < 12) base = RV + ((size_t)rb * 8 + (pn - 4)) * 65536;
            else if (pn < 14) { } else if (pn < 18) base = RQ + ((size_t)pm * 4 + (pn - 14)) * 65536; else base = AQ + ((size_t)pm * 4 + (pn - 18)) * 65536;
            ld = 256; }
#endif
#if (MK_WT & 1)
        const __amdgpu_buffer_rsrc_t rs = __builtin_amdgcn_make_buffer_rsrc((void*)base, 0, 0x7ffffff0, 0x00020000);
#endif
        EPI_ROWS_BEGIN
            bf16_t* rowp = base + (size_t)(DUM == 1 ? (rt & 127) : rt) * ld + ct0;
#pragma unroll
            for (int bj = 0; bj < 2; ++bj) { const f32x4 v0 = acc[ai][bj][m][0] * sc, v1 = acc[ai][bj][m][1] * sc;
                u32x4 w; w.x = cvt_pk_bf16(v0[0], v0[1]); w.y = cvt_pk_bf16(v0[2], v0[3]); w.z = cvt_pk_bf16(v1[0], v1[1]); w.w = cvt_pk_bf16(v1[2], v1[3]);
#if (MK_WT & 1)
                __builtin_amdgcn_raw_buffer_store_b128(w, rs, (unsigned)(((DUM == 1 ? (rt & 127) : rt) * ld + ct0 + bj * HALF) * 2), 0, MK_WT_AUX);
#else
                *(u32x4*)(rowp + bj * HALF) = w;
#endif
                }
        EPI_ROWS_END
    }
};

typedef Epi1T<0> Epi1;
struct Epi1F8 {
    static constexpr bool PERM = true, AFTER_DRAIN = false;
    Epi1 e;
    __device__ __forceinline__ void operator()(const f32x4 (&acc)[2][2][4][2], const Unit& u, int wr, int wc, int fr, int fq) const { Unit v = u; v.pn = u.pn < 2 ? 12 + u.pn : 16 + u.pn; e(acc, v, wr, wc, fr, fq); }
};
#define EPI_FOR_PIECES _Pragma("unroll") for (int ai = 0; ai < 2; ++ai) _Pragma("unroll") for (int m = 0; m < 4; ++m) _Pragma("unroll") for (int bj = 0; bj < 2; ++bj)
struct Epi5 {
    static constexpr bool PERM = true, AFTER_DRAIN = false;
    bf16_t *YR, *YA, *U1, *U2; const float* SSQ; int dry_unused; unsigned char* YA8;
    __device__ __forceinline__ void operator()(const f32x4 (&acc)[2][2][4][2], const Unit& u, int wr, int wc, int fr, int fq) const {
        const int pn = u.pn; const size_t row0 = (size_t)u.pm * 256;
        if (pn < 8) {
            const int head = pn >> 1;
            EPI_ROWS_BEGIN
                const size_t row = row0 + rt;
                const float ss = SSQ[row * 8 + head * 2] + SSQ[row * 8 + head * 2 + 1];
                const float rstd = __builtin_amdgcn_rsqf(ss * (1.0f / 512.0f) + EPS);
#pragma unroll
                for (int bj = 0; bj < 2; ++bj) { u32x4* p = (u32x4*)(YR + row * 2048 + pn * 256 + bj * HALF + ct0); float o[8]; unpack8(*p, o);
                    const f32x4 v0 = acc[ai][bj][m][0], v1 = acc[ai][bj][m][1];
                    { const float x0[4] = {v0[0], v0[1], v0[2], v0[3]}, x1[4] = {v1[0], v1[1], v1[2], v1[3]}; float s0[4], s1[4]; sigmoid4(x0, s0); sigmoid4(x1, s1);
#pragma unroll
                    for (int k = 0; k < 4; ++k) { o[k] = o[k] * rstd * (x0[k] * s0[k]); o[4 + k] = o[4 + k] * rstd * (x1[k] * s1[k]); } }
                    *p = pack8(o); }
            EPI_ROWS_END
        } else if (pn < 12) {
            EPI_ROWS_BEGIN
                const size_t row = row0 + rt;
#pragma unroll
                for (int bj = 0; bj < 2; ++bj) { u32x4* p = (u32x4*)(YA + row * 1024 + (pn - 8) * 256 + bj * HALF + ct0); float o[8]; unpack8(*p, o);
                    const f32x4 v0 = acc[ai][bj][m][0], v1 = acc[ai][bj][m][1];
                    { const float x0[4] = {v0[0], v0[1], v0[2], v0[3]}, x1[4] = {v1[0], v1[1], v1[2], v1[3]}; float s0[4], s1[4]; sigmoid4(x0, s0); sigmoid4(x1, s1);
#pragma unroll
                    for (int k = 0; k < 4; ++k) { o[k] = o[k] * (x0[k] * s0[k]); o[4 + k] = o[4 + k] * (x1[k] * s1[k]); } }
#if MK_FP8G
                    { v2u w; w.x = pk4_fp8(o[0] * F8Y_MUL, o[1] * F8Y_MUL, o[2] * F8Y_MUL, o[3] * F8Y_MUL); w.y = pk4_fp8(o[4] * F8Y_MUL, o[5] * F8Y_MUL, o[6] * F8Y_MUL, o[7] * F8Y_MUL);
                      *(v2u*)(YA8 + row * 1024 + (pn - 8) * 256 + bj * HALF + ct0) = w; }
#else
                    *p = pack8(o);
#endif
                    }
            EPI_ROWS_END
        } else {
            bf16_t* U = pn < 16 ? U1 + (pn - 12) * 256 : U2 + (pn - 16) * 256;
            EPI_ROWS_BEGIN
                const size_t row = row0 + rt;
#pragma unroll
                for (int bj = 0; bj < 2; ++bj) { float o[8]; const f32x4 v0 = acc[ai][bj][m][0], v1 = acc[ai][bj][m][1];
                    { const float x0[4] = {v0[0], v0[1], v0[2], v0[3]}, x1[4] = {v1[0], v1[1], v1[2], v1[3]}; float s0[4], s1[4]; sigmoid4(x0, s0); sigmoid4(x1, s1);
#pragma unroll
                    for (int k = 0; k < 4; ++k) { o[k] = s0[k]; o[4 + k] = s1[k]; } }
                    *(u32x4*)(U + row * 1024 + bj * HALF + ct0) = pack8(o); }
            EPI_ROWS_END
        }
    }
};

struct Epi6 {
    static constexpr bool PERM = true, AFTER_DRAIN = false;
    bf16_t* U1;
    __device__ __forceinline__ void operator()(const f32x4 (&acc)[2][2][4][2], const Unit& u, int wr, int wc, int fr, int fq) const {
        bf16_t* base = U1 + ((size_t)u.pm * 256 + wr * 64 + fr) * 1024 + u.pn * 256 + wc * 32 + 8 * fq;
#if (MK_WT & 2)
        WT_RSRC(rs, U1 + (size_t)u.pm * 256 * 1024 + u.pn * 256);
#endif
#pragma unroll
        for (int ai = 0; ai < 2; ++ai)
#pragma unroll
          for (int mb = 0; mb < 4; mb += MK_E6B) {
            u32x4 pc[MK_E6B][2];
#pragma unroll
            for (int mi = 0; mi < MK_E6B; ++mi)
#pragma unroll
                for (int bj = 0; bj < 2; ++bj) pc[mi][bj] = *(const u32x4*)(base + (size_t)(ai * HALF + (mb + mi) * 16) * 1024 + bj * HALF);
#pragma unroll
            for (int mi = 0; mi < MK_E6B; ++mi)
#pragma unroll
                for (int bj = 0; bj < 2; ++bj) { const int m = mb + mi; float o[8]; unpack8(pc[mi][bj], o); const f32x4 v0 = acc[ai][bj][m][0], v1 = acc[ai][bj][m][1];
#pragma unroll
                    for (int k = 0; k < 4; ++k) { o[k] *= v0[k]; o[4 + k] *= v1[k]; }
                    *(u32x4*)(base + (size_t)(ai * HALF + m * 16) * 1024 + bj * HALF) = pack8(o); }
          }
    }
};
struct Epi7 {
    static constexpr bool PERM = true, AFTER_DRAIN = false;
    bf16_t* U1; const bf16_t* U2;
    __device__ __forceinline__ void operator()(const f32x4 (&acc)[2][2][4][2], const Unit& u, int wr, int wc, int fr, int fq) const {
        const size_t off0 = ((size_t)u.pm * 256 + wr * 64 + fr) * 1024 + u.pn * 256 + wc * 32 + 8 * fq;
#if (MK_WT & 4)
        WT_RSRC(rs, U1 + (size_t)u.pm * 256 * 1024 + u.pn * 256);
#endif
#pragma unroll
        for (int q4 = 0; q4 < 8; q4 += MK_E7B) {
            const int ai = q4 >> 2, mb = q4 & 3; u32x4 pc[MK_E7B][2], pg[MK_E7B][2];
#pragma unroll
            for (int m2 = 0; m2 < MK_E7B; ++m2)
#pragma unroll
                for (int bj = 0; bj < 2; ++bj) { const size_t off = off0 + (size_t)(ai * HALF + (mb + m2) * 16) * 1024 + bj * HALF; pc[m2][bj] = *(const u32x4*)(U1 + off); pg[m2][bj] = *(const u32x4*)(U2 + off); }
#pragma unroll
            for (int m2 = 0; m2 < MK_E7B; ++m2)
#pragma unroll
                for (int bj = 0; bj < 2; ++bj) { const int m = mb + m2; const size_t off = off0 + (size_t)(ai * HALF + m * 16) * 1024 + bj * HALF; float o[8], g[8]; unpack8(pc[m2][bj], o); unpack8(pg[m2][bj], g);
                    const f32x4 v0 = acc[ai][bj][m][0], v1 = acc[ai][bj][m][1];
#pragma unroll
                    for (int k = 0; k < 4; ++k) { o[k] += g[k] * v0[k]; o[4 + k] += g[4 + k] * v1[k]; }
                    *(u32x4*)(U1 + off) = pack8(o); }
        }
    }
};
struct Epi8 {
    static constexpr bool PERM = true, AFTER_DRAIN = false;
    const float* X; const float* MOD; float* OUT;
    __device__ __forceinline__ void operator()(const f32x4 (&acc)[2][2][4][2], const Unit& u, int wr, int wc, int fr, int fq) const {
        const int col0 = u.pn * 256 + wc * 32 + 8 * fq; const size_t off0 = ((size_t)u.pm * 256 + wr * 64 + fr) * 1024 + col0; const float* gate = MOD + (size_t)(u.pm >> 3) * 3072 + 2048 + col0;
        f32x4 gv[2][2];
#if (MK_WT & 8)
        WT_RSRC(rs, OUT + (size_t)u.pm * 256 * 1024 + u.pn * 256);
#endif
#pragma unroll
        for (int bj = 0; bj < 2; ++bj)
#pragma unroll
            for (int n = 0; n < 2; ++n) gv[bj][n] = *(const f32x4*)(gate + bj * HALF + 4 * n);
#pragma unroll
        for (int q4 = 0; q4 < 8; q4 += MK_E8B) {
            const int ai = q4 >> 2, mb = q4 & 3; f32x4 xv[MK_E8B][2][2];
#pragma unroll
            for (int m2 = 0; m2 < MK_E8B; ++m2)
#pragma unroll
                for (int bj = 0; bj < 2; ++bj)
#pragma unroll
                    for (int n = 0; n < 2; ++n) xv[m2][bj][n] = *(const f32x4*)(X + off0 + (size_t)(ai * HALF + (mb + m2) * 16) * 1024 + bj * HALF + 4 * n);
#pragma unroll
            for (int m2 = 0; m2 < MK_E8B; ++m2)
#pragma unroll
                for (int bj = 0; bj < 2; ++bj)
#pragma unroll
                    for (int n = 0; n < 2; ++n) *(f32x4*)(OUT + off0 + (size_t)(ai * HALF + (mb + m2) * 16) * 1024 + bj * HALF + 4 * n) = xv[m2][bj][n] + gv[bj][n] * acc[ai][bj][mb + m2][n];
        }
    }
};
struct EpiNull {
    static constexpr bool PERM = true, AFTER_DRAIN = false;
    __device__ __forceinline__ void operator()(const f32x4 (&acc)[2][2][4][2], const Unit& u, int wr, int wc, int fr, int fq) const {
#pragma unroll
        for (int ai = 0; ai < 2; ++ai)
#pragma unroll
            for (int bj = 0; bj < 2; ++bj)
#pragma unroll
                for (int m = 0; m < 4; ++m)
#pragma unroll
                    for (int n = 0; n < 2; ++n) asm volatile("" :: "v"(acc[ai][bj][m][n]));
    }
};
template <int N> __device__ __forceinline__ void wait_vm_sel(int sel) { asm volatile("s_waitcnt vmcnt(%1)\n\ts_cmp_lg_u32 %0, 0\n\ts_cbranch_scc1 .Lwvs%=\n\ts_waitcnt vmcnt(8)\n.Lwvs%=:" :: "s"(sel), "n"(N) : "memory", "scc"); }
typedef int v8i_t __attribute__((ext_vector_type(8))); typedef int v4i_t __attribute__((ext_vector_type(4)));
__device__ __forceinline__ v8i_t cat8(const bf16x8 lo, const bf16x8 hi) { const v4i_t a = __builtin_bit_cast(v4i_t, lo), b = __builtin_bit_cast(v4i_t, hi); return (v8i_t){a.x, a.y, a.z, a.w, b.x, b.y, b.z, b.w}; }
__device__ __forceinline__ void mx16(f32x4& c, const v8i_t a, const v8i_t b, const int sca, const int scb) {
    asm volatile("v_mfma_scale_f32_16x16x128_f8f6f4 %0, %1, %2, %0, %3, %4 op_sel_hi:[0,0,0]" : "+v"(c) : "v"(a), "v"(b), "v"(sca), "v"(scb)); }
template <class Epi, class Sched, bool ALIGN_EPI = false, bool SP2 = false, int EPIW = 0, bool F8 = false>
__device__ __forceinline__ void gemm_phase(PG8_LAS unsigned char* lds, const Gemm g, const Sched& S, const Epi& E) {
    const int tid = threadIdx.x, wid = __builtin_amdgcn_readfirstlane(tid >> 6), lane = tid & 63, wr = wid >> 2, wc = wid & 3, fr = lane & 15, fq = lane >> 4;
    int Kv = g.K; if constexpr (F8) asm volatile("" : "+s"(Kv));
    const int K = Kv, nt = K / BK;
    int mxsa = g.scA, mxsb = g.scB; if constexpr (F8) asm volatile("" : "+v"(mxsa), "+v"(mxsb));
    unsigned voffA[2], voffB[2];
#pragma unroll
    for (int i = 0; i < 2; ++i) { int R, C; stage_rc(tid * 16 + i * 8192, R, C); const int Rb = Epi::PERM ? ((R & ~31) + perm32(R & 31)) : R;
        voffA[i] = (unsigned)(R * K + C) * 2u; voffB[i] = (unsigned)(Rb * K + C) * 2u; }
    const size_t kstep = (size_t)(BK * 2);
    const size_t hstep = (size_t)HALF * K * 2;
    const size_t tstep = 2 * hstep;
    const unsigned ldsw = (unsigned)wid * 1024u;
    const int aoff = lds_byte(wr * 64 + fr, fq * 8), boff = lds_byte(wc * 32 + fr, fq * 8);
#define PG8_SA(b, h) (((b) * 2 + (h)) * HTB)
#define PG8_SB(b, h) ((4 + (b) * 2 + (h)) * HTB)
#define PG8_STAGE(bufoff, gbase, voff) do { _Pragma("unroll") for (int _i = 0; _i < 2; ++_i) \
        __builtin_amdgcn_global_load_lds((const unsigned*)((const char*)(gbase) + (voff)[_i]), (PG8_LAS unsigned*)(lds + (bufoff) + ldsw + _i * 8192), 16, 0, 0); } while (0)
#define PG8_LDA(dst, b, h) do { _Pragma("unroll") for (int m = 0; m < 4; ++m) _Pragma("unroll") for (int k = 0; k < 2; ++k) dst[m][k] = *(const PG8_LAS bf16x8*)(lds + PG8_SA(b, h) + aoff + m * 2048 + k * 1024); } while (0)
#define PG8_LDB(dst, b, h) do { _Pragma("unroll") for (int n = 0; n < 2; ++n) _Pragma("unroll") for (int k = 0; k < 2; ++k) dst[n][k] = *(const PG8_LAS bf16x8*)(lds + PG8_SB(b, h) + boff + n * 2048 + k * 1024); } while (0)
#define PG8_MMA(ai, bj, At, Bt) do { __builtin_amdgcn_s_setprio(1); \
        if constexpr (F8) { _Pragma("unroll") for (int m = 0; m < 4; ++m) _Pragma("unroll") for (int n = 0; n < 2; ++n) \
            mx16(acc[ai][bj][m][n], cat8(Bt[n][0], Bt[n][1]), cat8(At[m][0], At[m][1]), mxsb, mxsa); } \
        else { _Pragma("unroll") for (int m = 0; m < 4; ++m) _Pragma("unroll") for (int n = 0; n < 2; ++n) _Pragma("unroll") for (int k = 0; k < 2; ++k) \
            acc[ai][bj][m][n] = __builtin_amdgcn_mfma_f32_16x16x32_bf16(Bt[n][k], At[m][k], acc[ai][bj][m][n], 0, 0, 0); } \
        __builtin_amdgcn_s_setprio(0); } while (0)
#define PG8_WAIT_V(n) asm volatile("s_waitcnt vmcnt(" #n ")" ::: "memory")
#define PG8_WAIT_L(n) asm volatile("s_waitcnt lgkmcnt(" #n ")" ::: "memory")
#define PG8_BAR __builtin_amdgcn_s_barrier()
#define PG8_SCHED __builtin_amdgcn_sched_barrier(0)
    Unit cur, nxt; int ui = 0;
    if (!S.next(0, cur)) return;
    f32x4 acc[2][2][4][2];
#pragma unroll
    for (int a = 0; a < 2; ++a)
#pragma unroll
        for (int b = 0; b < 2; ++b)
#pragma unroll
            for (int m = 0; m < 4; ++m)
#pragma unroll
                for (int n = 0; n < 2; ++n) acc[a][b][m][n] = (f32x4){0.f, 0.f, 0.f, 0.f};
    bf16x8 At[4][2], B0[2][2], B1[2][2];
    const char* cA = (const char*)g.A + (size_t)cur.pm * tstep; const char* cB = (const char*)g.Bt + (size_t)cur.pn * tstep;
    S.a_ready(cur);
    if constexpr (SP2) {
        PG8_STAGE(PG8_SB(0, 0), cB, voffB); PG8_STAGE(PG8_SB(0, 1), cB + hstep, voffB); PG8_STAGE(PG8_SA(0, 0), cA, voffA); PG8_STAGE(PG8_SA(0, 1), cA + hstep, voffA);
        if (wr == 1) PG8_BAR;
        PG8_WAIT_V(2); PG8_BAR;
        PG8_STAGE(PG8_SB(1, 0), cB + kstep, voffB); PG8_STAGE(PG8_SA(1, 0), cA + kstep, voffA); PG8_STAGE(PG8_SB(1, 1), cB + hstep + kstep, voffB);
        PG8_WAIT_V(6); PG8_BAR;
    } else {
        PG8_STAGE(PG8_SB(0, 0), cB, voffB); PG8_STAGE(PG8_SA(0, 0), cA, voffA); PG8_STAGE(PG8_SB(0, 1), cB + hstep, voffB); PG8_STAGE(PG8_SA(0, 1), cA + hstep, voffA);
        if (wr == 1) PG8_BAR;
        PG8_WAIT_V(4); PG8_BAR;
        PG8_STAGE(PG8_SB(1, 0), cB + kstep, voffB); PG8_STAGE(PG8_SA(1, 0), cA + kstep, voffA); PG8_STAGE(PG8_SB(1, 1), cB + hstep + kstep, voffB);
        PG8_WAIT_V(6); PG8_BAR;
    }
    for (;;) {
        const bool has_next = S.next(ui + 1, nxt);
        const char* nA = has_next ? (const char*)g.A + (size_t)nxt.pm * tstep : cA; const char* nB = has_next ? (const char*)g.Bt + (size_t)nxt.pn * tstep : cB;
        for (int t = 0; t < nt; t += 2) {
            const bool last = (t == nt - 2);
            const char* a1 = cA + (size_t)(t + 1) * kstep;
            const char* a2 = last ? nA : cA + (size_t)(t + 2) * kstep; const char* b2 = last ? nB : cB + (size_t)(t + 2) * kstep;
            const char* a3 = a2 + kstep; const char* b3 = b2 + kstep;
            if (last && has_next) S.a_ready(nxt);
            const int fe = __builtin_amdgcn_readfirstlane(((EPIW > 0) && (t == 0) && (ui > 0)) ? 1 : 0);
            if constexpr (SP2) {
            PG8_LDB(B0, 0, 0); PG8_LDB(B1, 0, 1); PG8_SCHED; PG8_LDA(At, 0, 0); PG8_STAGE(PG8_SA(1, 1), a1 + hstep, voffA);
            if constexpr (EPIW > 0) wait_vm_sel<8 + EPIW>(fe); else PG8_WAIT_V(8); PG8_WAIT_L(0); PG8_BAR; PG8_MMA(0, 0, At, B0); PG8_MMA(0, 1, At, B1); PG8_BAR; PG8_SCHED;
            PG8_LDA(At, 0, 1); PG8_STAGE(PG8_SB(0, 0), b2, voffB); PG8_STAGE(PG8_SB(0, 1), b2 + hstep, voffB); PG8_STAGE(PG8_SA(0, 0), a2, voffA);
            if constexpr (EPIW > 0) wait_vm_sel<8 + EPIW>(fe); else PG8_WAIT_V(8); PG8_WAIT_L(0); PG8_BAR; PG8_MMA(1, 0, At, B0); PG8_MMA(1, 1, At, B1); PG8_BAR; PG8_SCHED;
            PG8_LDB(B0, 1, 0); PG8_LDB(B1, 1, 1); PG8_SCHED; PG8_LDA(At, 1, 0); PG8_STAGE(PG8_SA(0, 1), a2 + hstep, voffA);
            PG8_WAIT_V(8); PG8_WAIT_L(0); PG8_BAR; PG8_MMA(0, 0, At, B0); PG8_MMA(0, 1, At, B1); PG8_BAR; PG8_SCHED;
            PG8_LDA(At, 1, 1); PG8_STAGE(PG8_SB(1, 0), b3, voffB); PG8_STAGE(PG8_SB(1, 1), b3 + hstep, voffB); PG8_STAGE(PG8_SA(1, 0), a3, voffA);
            PG8_WAIT_V(8); PG8_WAIT_L(0); PG8_BAR; PG8_MMA(1, 0, At, B0); PG8_MMA(1, 1, At, B1); PG8_BAR; PG8_SCHED;
            } else {
            PG8_LDB(B0, 0, 0); PG8_SCHED; PG8_LDA(At, 0, 0); PG8_STAGE(PG8_SA(1, 1), a1 + hstep, voffA);
            PG8_WAIT_L(8); PG8_BAR; PG8_WAIT_L(0); PG8_MMA(0, 0, At, B0); PG8_BAR; PG8_SCHED;
            PG8_LDB(B1, 0, 1); PG8_STAGE(PG8_SB(0, 0), b2, voffB);
            PG8_BAR; PG8_WAIT_L(0); PG8_MMA(0, 1, At, B1); PG8_BAR;
            PG8_LDA(At, 0, 1); PG8_STAGE(PG8_SA(0, 0), a2, voffA);
            PG8_BAR; PG8_WAIT_L(0); PG8_MMA(1, 0, At, B0); PG8_BAR; PG8_SCHED;
            PG8_STAGE(PG8_SB(0, 1), b2 + hstep, voffB);
            PG8_WAIT_V(6); PG8_BAR; PG8_MMA(1, 1, At, B1); PG8_BAR;
            PG8_LDB(B0, 1, 0); PG8_SCHED; PG8_LDA(At, 1, 0); PG8_STAGE(PG8_SA(0, 1), a2 + hstep, voffA);
            PG8_WAIT_L(8); PG8_BAR; PG8_WAIT_L(0); PG8_MMA(0, 0, At, B0); PG8_BAR; PG8_SCHED;
            PG8_LDB(B1, 1, 1); PG8_STAGE(PG8_SB(1, 0), b3, voffB);
            PG8_BAR; PG8_WAIT_L(0); PG8_MMA(0, 1, At, B1); PG8_BAR;
            PG8_LDA(At, 1, 1); PG8_STAGE(PG8_SA(1, 0), a3, voffA);
            PG8_BAR; PG8_WAIT_L(0); PG8_MMA(1, 0, At, B0); PG8_BAR; PG8_SCHED;
            PG8_STAGE(PG8_SB(1, 1), b3 + hstep, voffB);
            PG8_WAIT_V(6); PG8_BAR; PG8_MMA(1, 1, At, B1); PG8_BAR;
            }
        }
        if constexpr (F8) asm volatile("s_nop 15\n\ts_nop 15" ::: "memory");
        if constexpr (ALIGN_EPI) { if (wr == 0) PG8_BAR; }
        if constexpr (EPIW > 0) { static_assert(EPIW == 0 || (ALIGN_EPI && SP2), "EPIW needs ALIGN_EPI and SP2");
            }
        if constexpr (!Epi::AFTER_DRAIN) { E(acc, cur, wr, wc, fr, fq); S.done(cur); }
        if (!has_next) break;
#pragma unroll
        for (int a = 0; a < 2; ++a)
#pragma unroll
            for (int b = 0; b < 2; ++b)
#pragma unroll
                for (int m = 0; m < 4; ++m)
#pragma unroll
                    for (int n = 0; n < 2; ++n) acc[a][b][m][n] = (f32x4){0.f, 0.f, 0.f, 0.f};
        cur = nxt; cA = nA; cB = nB; ++ui;
        if constexpr (ALIGN_EPI) { if (wr == 1) PG8_BAR; }
    }
    PG8_WAIT_V(0);
    if constexpr (!ALIGN_EPI) { if (wr == 0) PG8_BAR; }
    PG8_BAR;
    if constexpr (Epi::AFTER_DRAIN) { E.fused(acc, cur, wr, wc, fr, fq, lds, wid, lane); S.done(cur); }
#undef PG8_SA
#undef PG8_SB
#undef PG8_STAGE
#undef PG8_LDA
#undef PG8_LDB
#undef PG8_MMA
#undef PG8_WAIT_V
#undef PG8_WAIT_L
#undef PG8_BAR
#undef PG8_SCHED
}
}

namespace attn {
constexpr int   D = 128, NW = 8, QBLK = 32, KVBLK = 64;
constexpr float SCALE = 0.088388347648318440f;
constexpr float THR = MK_FP8V ? 2.f : 8.f;
constexpr float POFF = MK_FP8V ? 5.f : 0.f;
constexpr int V8STR = 80;
constexpr int SDEPTH = 2;
constexpr int LDQ = 1024, LDK = 256, LDO = 1024;
constexpr size_t SHM_V = KVBLK * D * 2, SHM_K = KVBLK * D * 2, SHM_ATTN = 2 * SHM_V + 2 * SHM_K + NW * 64 * 4;
typedef unsigned short bf16;
using bf16x8 = __attribute__((ext_vector_type(8))) short;
using s16x4  = __attribute__((ext_vector_type(4))) short;
using f32x16 = __attribute__((ext_vector_type(16))) float;
using f32x8  = __attribute__((ext_vector_type(8))) float;
using u32x4  = __attribute__((ext_vector_type(4))) unsigned;
#define KSWZ(row, colB) ((row) * 256 + ((colB) ^ (((row) & 7) << 4)))
#define K8SWZ(row, c16) ((row) * 128 + ((((c16) ^ ((row) & 7))) << 4))
typedef int v8i __attribute__((ext_vector_type(8)));
#define SBAR() __builtin_amdgcn_sched_barrier(0)
__device__ __forceinline__ int crow(int r, int hi) { return (r & 3) + 8 * (r >> 2) + 4 * hi; }
__device__ __forceinline__ unsigned cvtpk(float lo, float hi) { return cvt_pk_bf16(lo, hi); }
template <typename TIn> struct Stage;
template <> struct Stage<bf16>  { using T = bf16x8;
  __device__ static __forceinline__ T ld8(const bf16* p) { return *reinterpret_cast<const bf16x8*>(p); }
  __device__ static __forceinline__ bf16x8 tobf(T x) { return x; } };
__device__ __forceinline__ void partialSM(f32x16& p0, f32x16& p1, float& m_reg, float& mn, float& alpha) {
  constexpr float C = SCALE * 1.4426950408889634f;
  float pmax = p0[0]; for (int r = 1; r < 16; ++r) pmax = fmaxf(pmax, p0[r]); for (int r = 0; r < 16; ++r) pmax = fmaxf(pmax, p1[r]);
  { auto rr = __builtin_amdgcn_permlane32_swap(__float_as_uint(pmax), __float_as_uint(pmax), false, false);
    pmax = fmaxf(__uint_as_float(rr[0]), __uint_as_float(rr[1])); }
  if (__builtin_expect(__all(pmax - m_reg <= THR / SCALE), 1)) { mn = m_reg; alpha = 1.f; }
  else { mn = fmaxf(m_reg, pmax); alpha = __builtin_amdgcn_exp2f((m_reg - mn) * C); m_reg = mn; }
  float mnC = -mn * C + POFF;
  for (int r = 0; r < 16; ++r) p0[r] = fmaf(p0[r], C, mnC); for (int r = 0; r < 16; ++r) p1[r] = fmaf(p1[r], C, mnC);
  for (int r = 0; r < 16; ++r) p0[r] = __builtin_amdgcn_exp2f(p0[r]);
}
__device__ __forceinline__ void finishSM8(f32x16& p0, f32x16& p1, float alpha, float& l_reg, v8i& P8) {
  for (int r = 0; r < 16; ++r) p1[r] = __builtin_amdgcn_exp2f(p1[r]);
  float ps = 0; for (int r = 0; r < 16; ++r) ps += p0[r]; for (int r = 0; r < 16; ++r) ps += p1[r];
  { auto rr = __builtin_amdgcn_permlane32_swap(__float_as_uint(ps), __float_as_uint(ps), false, false);
    ps = __uint_as_float(rr[0]) + __uint_as_float(rr[1]); }
  l_reg = l_reg * alpha + ps;
#pragma unroll
  for (int i = 0; i < 4; ++i) {
    int a = __builtin_amdgcn_cvt_pk_fp8_f32(p0[4 * i], p0[4 * i + 1], 0, false); a = __builtin_amdgcn_cvt_pk_fp8_f32(p0[4 * i + 2], p0[4 * i + 3], a, true);
    int b = __builtin_amdgcn_cvt_pk_fp8_f32(p1[4 * i], p1[4 * i + 1], 0, false); b = __builtin_amdgcn_cvt_pk_fp8_f32(p1[4 * i + 2], p1[4 * i + 3], b, true);
    auto rr = __builtin_amdgcn_permlane32_swap((unsigned)a, (unsigned)b, false, false); P8[i] = (int)rr[0]; P8[4 + i] = (int)rr[1]; }
}
__device__ __forceinline__ void pv8(f32x16* o, const char* Vb, const v8i& P8, int r32, int hi) {
#pragma unroll
  for (int d0 = 0; d0 < 4; ++d0) { const char* pp = Vb + (32 * d0 + r32) * V8STR + 32 * hi;
    const u32x4 x0 = *reinterpret_cast<const u32x4*>(pp), x1 = *reinterpret_cast<const u32x4*>(pp + 16);
    const v8i B = {(int)x0.x, (int)x0.y, (int)x0.z, (int)x0.w, (int)x1.x, (int)x1.y, (int)x1.z, (int)x1.w};
    o[d0] = __builtin_amdgcn_mfma_scale_f32_32x32x64_f8f6f4(P8, B, o[d0], 0, 0, 0, 0x7F7F7F7F, 0, 0x7F7F7F7F); }
}
__device__ __forceinline__ void finishSM(f32x16& p0, f32x16& p1, float alpha, float& l_reg, bf16x8& pa0, bf16x8& pa1, bf16x8& pa2, bf16x8& pa3) {
  for (int r = 0; r < 16; ++r) p1[r] = __builtin_amdgcn_exp2f(p1[r]);
  float ps = 0; for (int r = 0; r < 16; ++r) ps += p0[r]; for (int r = 0; r < 16; ++r) ps += p1[r];
  { auto rr = __builtin_amdgcn_permlane32_swap(__float_as_uint(ps), __float_as_uint(ps), false, false);
    ps = __uint_as_float(rr[0]) + __uint_as_float(rr[1]); }
  l_reg = l_reg * alpha + ps;
#define PK4(P, BASE, OUT) do { unsigned a0 = cvtpk(P[BASE + 0], P[BASE + 1]), a1 = cvtpk(P[BASE + 2], P[BASE + 3]);   \
    unsigned b0 = cvtpk(P[BASE + 4], P[BASE + 5]), b1 = cvtpk(P[BASE + 6], P[BASE + 7]);                              \
    auto r0 = __builtin_amdgcn_permlane32_swap(a0, b0, false, false); auto r1 = __builtin_amdgcn_permlane32_swap(a1, b1, false, false); \
    u32x4 w = {r0[0], r1[0], r0[1], r1[1]}; OUT = *reinterpret_cast<bf16x8*>(&w); } while (0)
  PK4(p0, 0, pa0); PK4(p0, 8, pa1); PK4(p1, 0, pa2); PK4(p1, 8, pa3);
#undef PK4
}
__device__ __forceinline__ void qkt(f32x16& p0, f32x16& p1, const bf16* Ks, const bf16x8* qr, int r32, int hi) {
  p0 = f32x16{}; p1 = f32x16{};
  for (int d0 = 0; d0 < 8; ++d0) { int cb = (d0 * 16 + hi * 8) * 2;
    bf16x8 b0 = *reinterpret_cast<const bf16x8*>((const char*)Ks + KSWZ(r32, cb));
    bf16x8 b1 = *reinterpret_cast<const bf16x8*>((const char*)Ks + KSWZ(32 + r32, cb));
    p0 = __builtin_amdgcn_mfma_f32_32x32x16_bf16(b0, qr[d0], p0, 0, 0, 0);
    p1 = __builtin_amdgcn_mfma_f32_32x32x16_bf16(b1, qr[d0], p1, 0, 0, 0); }
}
__device__ __forceinline__ void qkt8(f32x16& p0, f32x16& p1, const char* Ks, const v8i* q8, int r32, int hi) {
  p0 = f32x16{}; p1 = f32x16{};
#pragma unroll
  for (int m = 0; m < 2; ++m) { const int c = 4 * m + 2 * hi;
    const u32x4 a00 = *reinterpret_cast<const u32x4*>(Ks + K8SWZ(r32, c)), a01 = *reinterpret_cast<const u32x4*>(Ks + K8SWZ(r32, c + 1));
    const u32x4 a10 = *reinterpret_cast<const u32x4*>(Ks + K8SWZ(32 + r32, c)), a11 = *reinterpret_cast<const u32x4*>(Ks + K8SWZ(32 + r32, c + 1));
    const v8i A0 = {(int)a00.x, (int)a00.y, (int)a00.z, (int)a00.w, (int)a01.x, (int)a01.y, (int)a01.z, (int)a01.w};
    const v8i A1 = {(int)a10.x, (int)a10.y, (int)a10.z, (int)a10.w, (int)a11.x, (int)a11.y, (int)a11.z, (int)a11.w};
    p0 = __builtin_amdgcn_mfma_scale_f32_32x32x64_f8f6f4(A0, q8[m], p0, 0, 0, 0, 0x7F7F7F7F, 0, 0x7F7F7F7F);
    p1 = __builtin_amdgcn_mfma_scale_f32_32x32x64_f8f6f4(A1, q8[m], p1, 0, 0, 0, 0x7F7F7F7F, 0, 0x7F7F7F7F); }
}
__device__ __forceinline__ int v_st(int k, int c) { const int kk = (k & ~0xC) | ((k & 4) << 1) | ((k & 8) >> 1); return ((kk >> 3) * 4 + (c >> 5)) * 512 + ((kk & 7) * 32 + (c & 31)) * 2; }
__device__ __forceinline__ int v_rd_base(int lane) { return ((lane & 3) << 3) | (((lane >> 2) & 3) << 6) | (((lane >> 4) & 1) << 5) | (((lane >> 5) & 1) << 8); }
constexpr int v_rd_off(int d0, int ks, int half) { return d0 * 512 + ks * 4096 + half * 2048; }
template <int OFF> __device__ __forceinline__ s16x4 tr_read(int vb) {
  s16x4 r; asm volatile("ds_read_b64_tr_b16 %0, %1 offset:%2" : "=&v"(r) : "v"(vb), "i"(OFF) : "memory"); return r;
}
template <int D0> __device__ __forceinline__ void pv_one(f32x16& od, int vb, bf16x8 pa0, bf16x8 pa1, bf16x8 pa2, bf16x8 pa3) {
  const s16x4 l0 = tr_read<v_rd_off(D0, 0, 0)>(vb), h0 = tr_read<v_rd_off(D0, 0, 1)>(vb), l1 = tr_read<v_rd_off(D0, 1, 0)>(vb), h1 = tr_read<v_rd_off(D0, 1, 1)>(vb);
  const s16x4 l2 = tr_read<v_rd_off(D0, 2, 0)>(vb), h2 = tr_read<v_rd_off(D0, 2, 1)>(vb), l3 = tr_read<v_rd_off(D0, 3, 0)>(vb), h3 = tr_read<v_rd_off(D0, 3, 1)>(vb);
  asm volatile("s_waitcnt lgkmcnt(0)" ::: "memory"); SBAR();
#define PK(L, H) (bf16x8){L[0], L[1], L[2], L[3], H[0], H[1], H[2], H[3]}
  od = __builtin_amdgcn_mfma_f32_32x32x16_bf16(pa0, PK(l0, h0), od, 0, 0, 0);
  od = __builtin_amdgcn_mfma_f32_32x32x16_bf16(pa1, PK(l1, h1), od, 0, 0, 0);
  od = __builtin_amdgcn_mfma_f32_32x32x16_bf16(pa2, PK(l2, h2), od, 0, 0, 0);
  od = __builtin_amdgcn_mfma_f32_32x32x16_bf16(pa3, PK(l3, h3), od, 0, 0, 0);
#undef PK
}
__device__ __forceinline__ void pv_d0(f32x16* o, int vb, bf16x8 pa0, bf16x8 pa1, bf16x8 pa2, bf16x8 pa3) {
  pv_one<0>(o[0], vb, pa0, pa1, pa2, pa3); pv_one<1>(o[1], vb, pa0, pa1, pa2, pa3); pv_one<2>(o[2], vb, pa0, pa1, pa2, pa3); pv_one<3>(o[3], vb, pa0, pa1, pa2, pa3);
}

struct Pre { bf16x8 q[8]; };
__device__ __forceinline__ void attn_prefetch(const bf16* Qb, const bf16* __restrict__ Kh, const bf16* __restrict__ Vh, Pre& p) {
  const int tid = threadIdx.x, wid = tid >> 6, lane = tid & 63, r32 = lane & 31, hi = lane >> 5;
  const bf16* Qw = Qb + (long)(wid * QBLK + r32) * LDQ + hi * 8;
#pragma unroll
  for (int d0 = 0; d0 < 8; ++d0) p.q[d0] = *reinterpret_cast<const bf16x8*>(Qw + d0 * 16);
}
template <typename TQ>
__device__ __forceinline__ void attn_dense_body(const TQ* Qb, const bf16* __restrict__ Kh, const bf16* __restrict__ Vh,
                                                bf16* Ob, int seq, char* lds, const float* __restrict__ qnw, const float* __restrict__ rope, int lpos0,
                                                Pre& pre, const bf16* Qn, const bf16* Kn, const bf16* Vn) {
  using St = Stage<bf16>; using SQ = Stage<TQ>;
  const int tid = threadIdx.x, wid = __builtin_amdgcn_readfirstlane(tid >> 6), lane = tid & 63, r32 = lane & 31, hi = lane >> 5;
  bf16* V_lds = (bf16*)lds; bf16* K_lds = (bf16*)(lds + 2 * SHM_V);
  float* ws = (float*)(lds + 2 * SHM_V + 2 * SHM_K) + wid * 64; float* li_l = ws; float* al_l = ws + 32;
  float m_reg = -1e30f, l_reg = 0; f32x16 o[4] = {}; bf16x8 qr[8];
#if MK_FP8K
  v8i q8[2]; const unsigned char* K8h = (const unsigned char*)Kh;
#endif
#pragma unroll
  for (int d0 = 0; d0 < 8; ++d0) qr[d0] = pre.q[d0];
  const int sr = tid >> 4, sc = (tid & 15) * 8, vst0 = v_st(sr, sc), vst1 = v_st(32 + sr, sc);
  const int vb0 = (int)(uintptr_t)V_lds + v_rd_base(lane);
#if MK_FP8K && MK_FP8V
  const unsigned char* V8h = (const unsigned char*)Vh;
  struct { u32x4 v8, k8; } sr_[SDEPTH];
  const unsigned ko = (unsigned)((tid >> 3) * 256 + (tid & 7) * 16);
#define SLOAD(i, k0) do { sr_[i].v8 = *reinterpret_cast<const u32x4*>(V8h + (size_t)((k0) >> 6) * 8192 + (unsigned)tid * 16u); \
    sr_[i].k8 = *reinterpret_cast<const u32x4*>(K8h + (size_t)(k0) * 256 + ko); } while (0)
#define SWRITE(b, i) do { *(u32x4*)((char*)V_lds + (b) * SHM_V + (tid >> 2) * V8STR + (tid & 3) * 16) = sr_[i].v8; \
    *(u32x4*)((char*)K_lds + (b) * SHM_K + K8SWZ(tid >> 3, tid & 7)) = sr_[i].k8; } while (0)
#define SWAIT() asm volatile("s_waitcnt vmcnt(2)" ::: "memory")
#define QKT(P0, P1, KB) qkt8(P0, P1, (const char*)K_lds + (KB) * SHM_K, q8, r32, hi)
#define FINISH(P0, P1, AL) finishSM8(P0, P1, AL, l_reg, P8)
#define PV(VB) pv8(o, (const char*)V_lds + (VB) * SHM_V, P8, r32, hi)
  v8i P8;
#elif MK_FP8K
#define FINISH(P0, P1, AL) finishSM(P0, P1, AL, l_reg, pa0, pa1, pa2, pa3)
#define PV(VB) pv_d0(o, vb0 + (VB) * (int)SHM_V, pa0, pa1, pa2, pa3)
  struct { typename St::T vs0, vs1; u32x4 k8; } sr_[SDEPTH];
  const unsigned vo0 = (unsigned)(sr * LDK + sc), vo1 = vo0 + 32u * LDK, ko = (unsigned)((tid >> 3) * 256 + (tid & 7) * 16);
#define SLOAD(i, k0) do { const bf16* vt_ = Vh + (size_t)(k0) * LDK; const unsigned char* kt_ = K8h + (size_t)(k0) * 256; \
    sr_[i].vs0 = *reinterpret_cast<const bf16x8*>(vt_ + vo0); sr_[i].vs1 = *reinterpret_cast<const bf16x8*>(vt_ + vo1); sr_[i].k8 = *reinterpret_cast<const u32x4*>(kt_ + ko); } while (0)
#define SWRITE(b, i) do { *(bf16x8*)((char*)V_lds + (b) * SHM_V + vst0) = St::tobf(sr_[i].vs0);          \
    *(bf16x8*)((char*)V_lds + (b) * SHM_V + vst1) = St::tobf(sr_[i].vs1);                                \
    *(u32x4*)((char*)K_lds + (b) * SHM_K + K8SWZ(tid >> 3, tid & 7)) = sr_[i].k8; } while (0)
#define SWAIT() asm volatile("s_waitcnt vmcnt(3)" ::: "memory")
#define QKT(P0, P1, KB) qkt8(P0, P1, (const char*)K_lds + (KB) * SHM_K, q8, r32, hi)
#else
#define FINISH(P0, P1, AL) finishSM(P0, P1, AL, l_reg, pa0, pa1, pa2, pa3)
#define PV(VB) pv_d0(o, vb0 + (VB) * (int)SHM_V, pa0, pa1, pa2, pa3)
#define QKT(P0, P1, KB) qkt(P0, P1, (bf16*)((char*)K_lds + (KB) * SHM_K), qr, r32, hi)
  struct { typename St::T vs0, vs1, ks0, ks1; } sr_[SDEPTH];
#define SLOAD(i, k0) do { sr_[i].vs0 = St::ld8(&Vh[(long)((k0) + sr) * LDK + sc]); sr_[i].vs1 = St::ld8(&Vh[(long)((k0) + 32 + sr) * LDK + sc]); \
    sr_[i].ks0 = St::ld8(&Kh[(long)((k0) + sr) * LDK + sc]); sr_[i].ks1 = St::ld8(&Kh[(long)((k0) + 32 + sr) * LDK + sc]); } while (0)
#define SWRITE(b, i) do { *(bf16x8*)((char*)V_lds + (b) * SHM_V + vst0) = St::tobf(sr_[i].vs0);          \
    *(bf16x8*)((char*)V_lds + (b) * SHM_V + vst1) = St::tobf(sr_[i].vs1); int kc = sc * 2;               \
    *(bf16x8*)((char*)K_lds + (b) * SHM_K + KSWZ(sr, kc)) = St::tobf(sr_[i].ks0);                       \
    *(bf16x8*)((char*)K_lds + (b) * SHM_K + KSWZ(32 + sr, kc)) = St::tobf(sr_[i].ks1); } while (0)
#define SWAIT() do { if constexpr (SDEPTH == 2) asm volatile("s_waitcnt vmcnt(4)" ::: "memory"); else asm volatile("s_waitcnt vmcnt(0)" ::: "memory"); } while (0)
#endif
#define RESC(a) do { if (__any((a) < 1.f)) { if (hi == 0) al_l[r32] = (a); asm volatile("s_waitcnt lgkmcnt(0)" ::: "memory"); \
    for (int d = 0; d < 4; ++d) for (int r = 0; r < 16; ++r) o[d][r] *= al_l[crow(r, hi)]; } } while (0)
  f32x16 pA0, pA1, pB0, pB1; float mnA, mnB, alA, alB; bf16x8 pa0, pa1, pa2, pa3; const int NT = seq / KVBLK;
  constexpr int SE = 0, SO = SDEPTH - 1;
  SLOAD(SE, 0); SLOAD(SO, KVBLK);
  if (qnw) {
    float ssq = 0.f;
#pragma unroll
    for (int d0 = 0; d0 < 8; ++d0)
#pragma unroll
      for (int j = 0; j < 8; ++j) { const float f = bf2f((unsigned short)qr[d0][j]); ssq += f * f; }
    { auto rr = __builtin_amdgcn_permlane32_swap(__float_as_uint(ssq), __float_as_uint(ssq), false, false); ssq = __uint_as_float(rr[0]) + __uint_as_float(rr[1]); }
    const float rstd = 1.0f / sqrtf(ssq * (1.0f / 128.0f) + 1e-6f);
    const int lq = lpos0 + wid * QBLK + r32, ri = lq >> 6, ci = lq & 63;
#pragma unroll
    for (int d0 = 0; d0 < 8; ++d0) {
      const float* wp = qnw + 16 * d0 + 8 * hi; const v4f w0 = *(const v4f*)wp, w1 = *(const v4f*)(wp + 4);
      const float* tp = d0 < 4 ? rope + (ri * 32 + 8 * d0 + 4 * hi) * 2 : rope + (ci * 32 + 8 * (d0 - 4) + 4 * hi) * 2; const v4f t0 = *(const v4f*)tp, t1 = *(const v4f*)(tp + 4);
      const float wv[8] = {w0.x, w0.y, w0.z, w0.w, w1.x, w1.y, w1.z, w1.w}, tv[8] = {t0.x, t0.y, t0.z, t0.w, t1.x, t1.y, t1.z, t1.w};
      float y[8];
#pragma unroll
      for (int q = 0; q < 4; ++q) { const float x0 = bf2f((unsigned short)qr[d0][2 * q]) * rstd * wv[2 * q], x1 = bf2f((unsigned short)qr[d0][2 * q + 1]) * rstd * wv[2 * q + 1], cs = tv[2 * q], sn = tv[2 * q + 1];
        y[2 * q] = x0 * cs - x1 * sn; y[2 * q + 1] = x0 * sn + x1 * cs; }
#if MK_FP8K
      { int w0 = __builtin_amdgcn_cvt_pk_fp8_f32(y[0], y[1], 0, false); w0 = __builtin_amdgcn_cvt_pk_fp8_f32(y[2], y[3], w0, true);
        int w1 = __builtin_amdgcn_cvt_pk_fp8_f32(y[4], y[5], 0, false); w1 = __builtin_amdgcn_cvt_pk_fp8_f32(y[6], y[7], w1, true);
        q8[d0 >> 2][2 * (d0 & 3)] = w0; q8[d0 >> 2][2 * (d0 & 3) + 1] = w1; }
#else
      u32x4 pw = {cvtpk(y[0], y[1]), cvtpk(y[2], y[3]), cvtpk(y[4], y[5]), cvtpk(y[6], y[7])}; qr[d0] = *reinterpret_cast<bf16x8*>(&pw);
#endif
    }
  }
  SWAIT(); SWRITE(0, SE); if constexpr (SDEPTH == 2) { if (2 < NT) SLOAD(SE, 2 * KVBLK); } __syncthreads();
  QKT(pA0, pA1, 0); partialSM(pA0, pA1, m_reg, mnA, alA);
  SWAIT(); SWRITE(1, SO); __syncthreads();
  for (int j = 1; j + 1 < NT; j += 2) {
    SBAR(); QKT(pB0, pB1, 1);
    FINISH(pA0, pA1, alA); SBAR();
    SLOAD(SO, (j + SDEPTH) * KVBLK); SBAR();
    PV(0); partialSM(pB0, pB1, m_reg, mnB, alB);
    __syncthreads(); SWAIT(); SWRITE(0, SE);
    RESC(alB); __syncthreads();
    SBAR(); QKT(pA0, pA1, 0);
    FINISH(pB0, pB1, alB); SBAR();
    if (SDEPTH == 1 || j + 3 < NT) SLOAD(SE, (j + 1 + SDEPTH) * KVBLK); SBAR();
    PV(1); partialSM(pA0, pA1, m_reg, mnA, alA);
    __syncthreads(); SWAIT(); SWRITE(1, SO);
    RESC(alA); __syncthreads();
  }
  attn_prefetch(Qn, Kn, Vn, pre);
  SBAR(); QKT(pB0, pB1, 1);
  FINISH(pA0, pA1, alA); SBAR();
  PV(0); partialSM(pB0, pB1, m_reg, mnB, alB);
  __syncthreads(); RESC(alB);
  FINISH(pB0, pB1, alB); SBAR();
  PV(1);
  if (hi == 0) li_l[r32] = l_reg; asm volatile("s_waitcnt lgkmcnt(0)" ::: "memory");
  float rli[16];
#pragma unroll
  for (int r = 0; r < 16; ++r) rli[r] = __builtin_amdgcn_rcpf(li_l[crow(r, hi)]);
  if (!Ob) return;
  bf16* Ow = Ob + (long)(wid * QBLK) * LDO;
#pragma unroll
  for (int r = 0; r < 16; ++r) { int orow = crow(r, hi);
    for (int d0 = 0; d0 < 4; ++d0) Ow[(long)orow * LDO + d0 * 32 + r32] = (bf16)f2bf(o[d0][r] * rli[r]); }
#undef SLOAD
#undef QKT
#undef FINISH
#undef PV
#undef SWRITE
#undef SWAIT
#undef RESC
}

#undef KSWZ
#undef SBAR
}

namespace ret {
typedef short bf16x8 __attribute__((ext_vector_type(8)));
typedef short s16x4 __attribute__((ext_vector_type(4)));
typedef float f32x16 __attribute__((ext_vector_type(16)));
constexpr int QSTR = 528, KSTR = 576, VSTR = 576, PSTR = 144;
constexpr int QS = 0, KS = QS + 64 * QSTR, VS = KS + 64 * KSTR, PS = VS + 64 * VSTR, OST = PS + 64 * PSTR, OSTR = 144, SSL = OST + 8 * 32 * OSTR, LDS_RET = SSL + 64 * 8 * 4;
constexpr int NSTEP = 36, SPLIT = 20;
__device__ __forceinline__ int crow(int r, int hi) { return (r & 3) + 8 * (r >> 2) + 4 * hi; }
__device__ __forceinline__ s16x4 tr_read(const LAS unsigned char* p) { return __builtin_bit_cast(s16x4, __builtin_amdgcn_ds_read_tr16_b64_v4i16((LAS s16x4*)p)); }
__device__ __forceinline__ bf16x8 cat(s16x4 lo, s16x4 hi) { return (bf16x8){lo[0], lo[1], lo[2], lo[3], hi[0], hi[1], hi[2], hi[3]}; }

struct NoPre { __device__ __forceinline__ void operator()() const {} };
template <class GridBar, class PreWork = NoPre>
__device__ __forceinline__ void scan_unit(const bf16_t* RQ, const bf16_t* RK, const bf16_t* RV, bf16_t* YR, float* SSQ, const float* l2d, LAS unsigned char* lds, int unit, const GridBar& gridbar, int nb_limit, const PreWork& prework = PreWork()) {
    const int tid = threadIdx.x, lane = tid & 63, w = __builtin_amdgcn_readfirstlane(tid >> 6), r = lane & 31, hh = lane >> 5;
    const int x = unit & 7, y = unit >> 3, eh = y & 1, dir = (y >> 1) & 1, bh = (y >> 2) * 8 + x, b = bh >> 2, h = bh & 3;
    if (b >= nb_limit) { prework(); gridbar(); return; }
    const float lg2 = log1pf(-exp2f(l2d[dir * 4 + h])) * 1.4426950408889634f;
    const float gC = exp2f(lg2 * 64.0f);
#if MK_TIMING
    unsigned long long tl_ = __builtin_amdgcn_s_memrealtime(); unsigned ta0 = 0, ta1 = 0, ta2 = 0, ta3 = 0, ta4 = 0, ta5 = 0, ta6 = 0;
#define TMARK(v_) do { const unsigned long long n_ = __builtin_amdgcn_s_memrealtime(); v_ += (unsigned)(n_ - tl_); tl_ = n_; } while (0)
#else
#define TMARK(v_) do { } while (0)
#endif
    f32x16 S[8];
#pragma unroll
    for (int T = 0; T < 8; ++T) S[T] = (f32x16){0.f};
#define STEP_ROWS(s_, krow_, qrow_) do { const bool l_ = (s_) >= 4; const int lc_ = l_ ? (dir ? 35 - (s_) : (s_) - 4) : 0; \
        krow_ = b * LT + (l_ ? LC + 64 * lc_ : (dir ? 64 * (3 - (s_)) : 64 * (s_))); qrow_ = b * SEQ + 64 * lc_; } while (0)
    v4u kv[4], vv[4], qv[4];
    const int poff = (tid >> 5) * 1024 + (tid & 31) * 8, voff = (tid >> 5) * 2048 + (tid & 31) * 8;
#define PREFETCHK(s_) do { int kr_, qr_; STEP_ROWS(s_, kr_, qr_); const bf16_t* kb_ = RK + (size_t)kr_ * 1024 + h * 256; \
        _Pragma("unroll") for (int n = 0; n < 4; ++n) { const bf16_t* kbn_ = kb_ + n * 16 * 1024; kv[n] = *(const v4u*)(kbn_ + poff); } } while (0)
#define PREFETCHQ(s_) do { int kr_, qr_; STEP_ROWS(s_, kr_, qr_); const bf16_t* qb_ = RQ + (size_t)qr_ * 1024 + h * 256; \
        _Pragma("unroll") for (int n = 0; n < 4; ++n) { const bf16_t* qbn_ = qb_ + n * 16 * 1024; qv[n] = *(const v4u*)(qbn_ + poff); } } while (0)
#define LOADV(s_) do { int kr_, qr_; STEP_ROWS(s_, kr_, qr_); const bf16_t* vb_ = RV + (size_t)kr_ * 2048 + h * 512 + eh * 256; \
        _Pragma("unroll") for (int n = 0; n < 4; ++n) { const bf16_t* vbn_ = vb_ + n * 16 * 2048; vv[n] = *(const v4u*)(vbn_ + voff); } } while (0)
#define WRITEQ() do { _Pragma("unroll") for (int n = 0; n < 4; ++n) { const int c = tid + NTHR * n, row = c >> 5, ch = c & 31; *(LAS v4u*)(lds + QS + row * QSTR + ch * 16) = qv[n]; } } while (0)
    PREFETCHK(0); PREFETCHQ(0); LOADV(0);
    prework(); __syncthreads();
    LAS unsigned char* ost = lds + OST + w * (32 * OSTR);
    for (int s = 0; s < NSTEP; ++s) {
        if (s == SPLIT) gridbar();
        int krow0, qrow0; STEP_ROWS(s, krow0, qrow0); const bool latent = s >= 4; const int sn = s + 1 < NSTEP ? s + 1 : s;
        float lg2s = lg2; int hv = hh, rv = r; asm volatile("" : "+v"(lg2s), "+v"(hv), "+v"(rv));
        const int lane_l = hv * 32 + rv;
        const int qA = QS + rv * QSTR + hv * 16, pA = PS + rv * PSTR + hv * 16;
        const int sw = ((lane_l & 1) << 1) | ((lane_l >> 1) & 1);
        const int trrow = (hv * 8 + ((lane_l >> 2) & 3));
        const int ktr = KS + trrow * KSTR + (16 * ((lane_l >> 4) & 1) + 4 * sw) * 2;
        const int vtr = VS + trrow * VSTR + (32 * w + 16 * ((lane_l >> 4) & 1) + 4 * (lane_l & 3)) * 2;
        { float wgt = __builtin_amdgcn_exp2f(lg2s * (float)(dir ? (tid >> 5) : 63 - (tid >> 5))); const float wstep = __builtin_amdgcn_exp2f(lg2s * (dir ? 16.0f : -16.0f));
#pragma unroll
          for (int n = 0; n < 4; ++n) { const int c = tid + NTHR * n, row = c >> 5, ch = c & 31;
            *(LAS v4u*)(lds + KS + row * KSTR + ch * 16) = kv[n];
            *(LAS v4u*)(lds + QS + row * QSTR + ch * 16) = qv[n];
            float t[8]; unpack8(vv[n], t);
#pragma unroll
            for (int k = 0; k < 8; ++k) t[k] *= wgt;
            wgt *= wstep;
            *(LAS v4u*)(lds + VS + row * VSTR + ch * 16) = pack8(t); } }
        __syncthreads();
        TMARK(ta0);
        v4u pp[4]; bf16_t* op = YR + (size_t)qrow0 * 2048 + h * 512 + eh * 256 + 32 * w + (size_t)((hv * 32 + rv) >> 2) * 2048 + ((hv * 32 + rv) & 3) * 8;
        if (s >= SPLIT) {
#pragma unroll
            for (int x4 = 0; x4 < 4; ++x4) pp[x4] = *(const v4u*)(op + (size_t)(16 * x4) * 2048); }
        if (latent) {
            { typedef float f32x4_t __attribute__((ext_vector_type(4)));
              const int i0 = 16 * (w >> 1), j0 = 32 * (w & 1), l15 = rv & 15, g4 = (hv << 1) | (rv >> 4);
              const LAS unsigned char* qp = lds + QS + (i0 + l15) * QSTR + g4 * 16; const LAS unsigned char* kp0 = lds + KS + (j0 + l15) * KSTR + g4 * 16; const LAS unsigned char* kp1 = kp0 + 16 * KSTR;
              f32x4_t s0 = (f32x4_t){0.f, 0.f, 0.f, 0.f}, s1 = s0;
              bf16x8 qn = *(const LAS bf16x8*)qp, k0n = *(const LAS bf16x8*)kp0, k1n = *(const LAS bf16x8*)kp1;
#pragma unroll
              for (int kk = 0; kk < 8; ++kk) { const bf16x8 qc = qn, k0c = k0n, k1c = k1n;
                if (kk + 1 < 8) { qn = *(const LAS bf16x8*)(qp + (kk + 1) * 64); k0n = *(const LAS bf16x8*)(kp0 + (kk + 1) * 64); k1n = *(const LAS bf16x8*)(kp1 + (kk + 1) * 64); }
                __builtin_amdgcn_sched_barrier(0);
                s0 = __builtin_amdgcn_mfma_f32_16x16x32_bf16(k0c, qc, s0, 0, 0, 0); s1 = __builtin_amdgcn_mfma_f32_16x16x32_bf16(k1c, qc, s1, 0, 0, 0); }
              const int i = i0 + l15;
#pragma unroll
              for (int t2 = 0; t2 < 2; ++t2) { const f32x4_t sv = t2 ? s1 : s0; const int jb = j0 + 16 * t2 + 4 * g4; float v4[4];
#pragma unroll
                for (int k = 0; k < 4; ++k) { const int j = jb + k; const bool keep = dir ? (j >= i) : (j <= i); v4[k] = keep ? sv[k] : 0.f; }
                v2u pw; pw.x = cvt_pk_bf16(v4[0], v4[1]); pw.y = cvt_pk_bf16(v4[2], v4[3]);
                *(LAS v2u*)(lds + PS + i * PSTR + jb * 2) = pw; } }
            TMARK(ta1);
            f32x16 acc[2]; acc[0] = (f32x16){0.f}; acc[1] = (f32x16){0.f};
            { const LAS unsigned char* q0 = lds + qA; const LAS unsigned char* q1 = lds + qA + 32 * QSTR;
              bf16x8 n0 = *(const LAS bf16x8*)q0, n1 = *(const LAS bf16x8*)q1, m0 = *(const LAS bf16x8*)(q0 + 32), m1 = *(const LAS bf16x8*)(q1 + 32);
#pragma unroll
              for (int ix = 0; ix < 16; ++ix) { const int T = ix >> 1, s2 = ix & 1; const bf16x8 a0 = n0, a1 = n1; n0 = m0; n1 = m1;
                if (ix + 2 < 16) { m0 = *(const LAS bf16x8*)(q0 + (ix + 2) * 32); m1 = *(const LAS bf16x8*)(q1 + (ix + 2) * 32); }
                v4u bw; bw.x = cvt_pk_bf16(S[T][8 * s2 + 0], S[T][8 * s2 + 1]); bw.y = cvt_pk_bf16(S[T][8 * s2 + 2], S[T][8 * s2 + 3]);
                bw.z = cvt_pk_bf16(S[T][8 * s2 + 4], S[T][8 * s2 + 5]); bw.w = cvt_pk_bf16(S[T][8 * s2 + 6], S[T][8 * s2 + 7]); const bf16x8 bs = __builtin_bit_cast(bf16x8, bw);
                __builtin_amdgcn_sched_barrier(0);
                acc[0] = __builtin_amdgcn_mfma_f32_32x32x16_bf16(a0, bs, acc[0], 0, 0, 0); acc[1] = __builtin_amdgcn_mfma_f32_32x32x16_bf16(a1, bs, acc[1], 0, 0, 0); } }
            TMARK(ta2);
            __syncthreads();
            LOADV(sn);
            TMARK(ta3);
            { bf16x8 vn = cat(tr_read(lds + vtr), tr_read(lds + vtr + 4 * VSTR)), pn0 = *(const LAS bf16x8*)(lds + pA), pn1 = *(const LAS bf16x8*)(lds + pA + 32 * PSTR);
#pragma unroll
              for (int js = 0; js < 4; ++js) { const bf16x8 vfj = vn, p0 = pn0, p1 = pn1;
                if (js + 1 < 4) { vn = cat(tr_read(lds + vtr + (16 * (js + 1)) * VSTR), tr_read(lds + vtr + (16 * (js + 1) + 4) * VSTR)); pn0 = *(const LAS bf16x8*)(lds + pA + (js + 1) * 32); pn1 = *(const LAS bf16x8*)(lds + pA + 32 * PSTR + (js + 1) * 32); }
                __builtin_amdgcn_sched_barrier(0);
                acc[0] = __builtin_amdgcn_mfma_f32_32x32x16_bf16(p0, vfj, acc[0], 0, 0, 0); acc[1] = __builtin_amdgcn_mfma_f32_32x32x16_bf16(p1, vfj, acc[1], 0, 0, 0); } }
#pragma unroll
            for (int it = 0; it < 2; ++it) {
#pragma unroll
                for (int q = 0; q < 16; ++q) { const int il = crow(q, hv); const int i = it * 32 + il; const float rf = __builtin_amdgcn_exp2f(lg2s * (float)(dir ? -i : i - 63));
                    *(LAS float*)(ost + il * OSTR + rv * 4) = acc[it][q] * rf; }
#pragma unroll
                for (int n = 0; n < 2; ++n) { const int c = (hv * 32 + rv) + 64 * n, row = c >> 2, cq = c & 3;
                    const v4f x0 = *(const LAS v4f*)(ost + row * OSTR + cq * 32), x1 = *(const LAS v4f*)(ost + row * OSTR + cq * 32 + 16);
                    float o[8] = {x0.x, x0.y, x0.z, x0.w, x1.x, x1.y, x1.z, x1.w};
                    if (s >= SPLIT) { float pv[8]; unpack8(pp[2 * it + n], pv); float ss = 0.f;
#pragma unroll
                        for (int k = 0; k < 8; ++k) { o[k] += pv[k]; ss += o[k] * o[k]; }
                        ss += __shfl_xor(ss, 1); ss += __shfl_xor(ss, 2);
                        if (cq == 0) *(LAS float*)(lds + SSL + ((it * 32 + row) * 8 + w) * 4) = ss; }
                    *(v4u*)(op + (size_t)(it * 32 + 16 * n) * 2048) = pack8(o); }
            }
        }
        TMARK(ta4);
        __builtin_amdgcn_sched_barrier(0);
        PREFETCHK(sn);
        PREFETCHQ(sn);
        if (!latent) LOADV(sn);
        {
#define KA_LD(ix_) cat(tr_read(lds + ktr + (16 * ((ix_) >> 3)) * KSTR + ((ix_) & 7) * 64), tr_read(lds + ktr + (16 * ((ix_) >> 3) + 4) * KSTR + ((ix_) & 7) * 64))
#define VF_LD(js_) cat(tr_read(lds + vtr + (16 * (js_)) * VSTR), tr_read(lds + vtr + (16 * (js_) + 4) * VSTR))
          bf16x8 vcur = VF_LD(0), vnx = vcur, kn0 = KA_LD(0), kn1 = KA_LD(1);
#pragma unroll
          for (int ix = 0; ix < 32; ++ix) { const int T = ix & 7, js = ix >> 3; const bf16x8 ka = kn0; kn0 = kn1;
            if (ix + 2 < 32) kn1 = KA_LD(ix + 2);
            if (T == 4 && js < 3) vnx = VF_LD(js + 1);
            __builtin_amdgcn_sched_barrier(0);
            S[T] = __builtin_amdgcn_mfma_f32_32x32x16_bf16(ka, vcur, S[T], 0, 0, 0);
            if (T == 7) vcur = vnx; }
#undef KA_LD
#undef VF_LD
        }
#pragma unroll
        for (int T = 0; T < 8; ++T) S[T] *= gC;
        TMARK(ta5);
        __syncthreads();
        TMARK(ta6);
        if (s >= SPLIT && tid < 64) { const LAS float* pr = (const LAS float*)(lds + SSL + tid * 32); const v4f a = *(const LAS v4f*)pr, c4 = *(const LAS v4f*)(pr + 4);
            SSQ[(size_t)(qrow0 + tid) * 8 + h * 2 + eh] = ((a.x + a.y) + (a.z + a.w)) + ((c4.x + c4.y) + (c4.z + c4.w)); }
    }
#if MK_TIMING
    if (unit == 0 && tid == 0) { unsigned* tw = (unsigned*)SSQ - 64; tw[0] = ta0; tw[1] = ta1; tw[2] = ta2; tw[3] = ta3; tw[4] = ta4; tw[5] = ta5; tw[6] = ta6; }
#endif
#undef STEP_ROWS
#undef PREFETCHK
#undef PREFETCHQ
#undef WRITEQ
#undef LOADV
}
}

constexpr int RING_BYTES = 131072, LDS_BYTES = 157696;
#ifndef MK_ONE_LAUNCH
#define MK_ONE_LAUNCH 1
#endif
constexpr int N_PHASES = 10;
#define LDS_WAIT() asm volatile("s_waitcnt lgkmcnt(0)" ::: "memory")
constexpr int MISC_OFF = 155648 + 320;
constexpr int CW_BAR = 4096;
constexpr size_t CTL_ZERO_BYTES = 65536;
#ifndef MK_NAIVE_ATTN
#define MK_NAIVE_ATTN 0
#endif
#ifndef MK_NAIVE_RET
#define MK_NAIVE_RET 0
#endif
#ifndef MK_DEBUG_ATTN
#define MK_DEBUG_ATTN 0
#endif
#ifndef MK_DBG_H
#define MK_DBG_H 0
#endif
#ifndef MK_DBG_L0
#define MK_DBG_L0 768
#define MK_DBG_L1 1280
#endif
#ifndef MK_DEBUG_RET
#define MK_DEBUG_RET 0
#endif
#ifndef MK_STAMP_A
#define MK_STAMP_A -1
#define MK_STAMP_B -1
#endif
#ifndef MK_REP_P4
#define MK_REP_P4 1
#endif
#ifndef MK_REP_P5
#define MK_REP_P5 1
#endif
#ifndef MK_REP_P6
#define MK_REP_P6 1
#endif
#ifndef MK_REP_P2
#define MK_REP_P2 1
#endif
#ifndef MK_REP_P9
#define MK_REP_P9 1
#endif
#ifndef MK_NSTAG
#define MK_NSTAG 1
#define MK_STAG_TICKS 500
#endif
#ifndef MK_ATTN_PROBE
#define MK_ATTN_PROBE 0
#endif
#ifndef MK_MIX
#define MK_MIX 0
#endif
#ifndef MK_EPIW
#define MK_EPIW 0
#endif
#ifndef MK_BARRIER
#define MK_BARRIER 1
#endif
#define XB_TMO      128
#define XB_XCNT(j)  (256  + 64 * (j))
#define XB_XSUB(j)  (1280 + 64 * (j))
#define XB_XGEN(j)  (2304 + 64 * (j))
#define XB_TOP      3328
#define XB_TOPGEN   3392
#define XCD_BAR_WORDS 3456
#define XB_SPIN_CAP (1u << 18)

__device__ __forceinline__ unsigned xb_ld(unsigned* p)              { return __hip_atomic_load(p, __ATOMIC_RELAXED, __HIP_MEMORY_SCOPE_AGENT); }
__device__ __forceinline__ unsigned xb_add(unsigned* p, unsigned v) { return __hip_atomic_fetch_add(p, v, __ATOMIC_RELAXED, __HIP_MEMORY_SCOPE_AGENT); }
__device__ __forceinline__ unsigned xb_xcc_id() { return (unsigned)__builtin_amdgcn_s_getreg((3 << 11) | 20) & 0xFu; }
#define XB_SPIN(cond, bar) do { unsigned _sp = 0; while (cond) { __builtin_amdgcn_s_sleep(1); \
    if ((++_sp & 255u) == 0u) { if (xb_ld(&(bar)[XB_TMO])) break; if (_sp > XB_SPIN_CAP) { atomicAdd(&(bar)[XB_TMO], 1u); break; } } } } while (0)

struct XcdBarrier {
    unsigned* bar; unsigned x;
    volatile LAS unsigned* st;
};

__device__ __forceinline__ XcdBarrier xcd_barrier_post(unsigned* bar, volatile LAS unsigned* st) {
    XcdBarrier b; b.bar = bar; b.x = xb_xcc_id(); b.st = st;
    if (threadIdx.x == 0) (void)xb_add(&bar[XB_XCNT(b.x)], 1u);
    return b;
}
__device__ __forceinline__ void xcd_barrier_complete(unsigned* bar, unsigned x, unsigned& nloc, unsigned& nx) {
    const unsigned G = gridDim.x * gridDim.y * gridDim.z;
    unsigned sum, cnt, mine, sp = 0u;
    for (;;) {
        sum = 0u; cnt = 0u; mine = 0u;
#pragma unroll
        for (unsigned j = 0; j < 16; ++j) { const unsigned c = xb_ld(&bar[XB_XCNT(j)]); sum += c; cnt += (c > 0u) ? 1u : 0u; mine = (j == x) ? c : mine; }
        if (sum == G) break;
        __builtin_amdgcn_s_sleep(1);
        if ((++sp & 255u) == 0u) { if (xb_ld(&bar[XB_TMO])) break; if (sp > XB_SPIN_CAP) { atomicAdd(&bar[XB_TMO], 1u); break; } }
    }
    nloc = mine > 0u ? mine : 1u; nx = cnt > 0u ? cnt : 1u;
}

__device__ __forceinline__ void xcd_barrier(const XcdBarrier& b) {
    asm volatile("s_waitcnt vmcnt(0)" ::: "memory");
    __syncthreads();
    if (threadIdx.x == 0) {
        unsigned* bar = b.bar;
        __builtin_amdgcn_s_waitcnt(0);
        unsigned nloc = b.st[0], nx = b.st[1];
        if (nloc == 0u) { xcd_barrier_complete(bar, b.x, nloc, nx); b.st[0] = nloc; b.st[1] = nx; }
        const unsigned old = xb_add(&bar[XB_XSUB(b.x)], 1u);
        const unsigned gen = old / nloc;
        if (old + 1u == (gen + 1u) * nloc) {
            __builtin_amdgcn_fence(__ATOMIC_RELEASE, "agent");
            asm volatile("s_waitcnt vmcnt(0)" ::: "memory");
            const unsigned og = xb_add(&bar[XB_TOP], 1u);
            const unsigned tg = og / nx;
            if (og + 1u == (tg + 1u) * nx) xb_add(&bar[XB_TOPGEN], 1u);
            else XB_SPIN(xb_ld(&bar[XB_TOPGEN]) == tg, bar);
            __builtin_amdgcn_fence(__ATOMIC_ACQUIRE, "agent");
            xb_add(&bar[XB_XGEN(b.x)], 1u);
            asm volatile("s_waitcnt vmcnt(0)" ::: "memory");
        } else {
            XB_SPIN(xb_ld(&bar[XB_XGEN(b.x)]) == gen, bar);
            __builtin_amdgcn_fence(__ATOMIC_ACQUIRE, "agent");
            asm volatile("s_waitcnt vmcnt(0)" ::: "memory");
        }
    }
    __syncthreads();
}


struct Args { const float* in[14]; float* out; unsigned char* ws; int ph_lo, ph_hi; };

__device__ __forceinline__ void p0_mod_item(const float* c, const float* c_ctx, const float* w_ada, const float* b_ada, float* MOD, float* ldsf, int item, int tid) {
    float* sc = ldsf; float* red = ldsf + 17 * 1024;
    for (int i = tid; i < 17 * 1024; i += NTHR) { const float v = i < 16 * 1024 ? c[i] : c_ctx[i - 16 * 1024]; sc[i] = v / (1.0f + expf(-v)); }
    const int col = tid & 15, ks = tid >> 4, n = item * 16 + col;
    float wv[32];
#pragma unroll
    for (int k = 0; k < 32; ++k) wv[k] = w_ada[(size_t)(ks * 32 + k) * 3072 + n];
    __syncthreads();
    float acc[17];
#pragma unroll
    for (int r = 0; r < 17; ++r) acc[r] = 0.f;
#pragma unroll
    for (int k = 0; k < 32; ++k) {
#pragma unroll
        for (int r = 0; r < 17; ++r) acc[r] += sc[r * 1024 + ks * 32 + k] * wv[k]; }
#pragma unroll
    for (int r = 0; r < 17; ++r) red[(ks * 17 + r) * 16 + col] = acc[r];
    __syncthreads();
    if (tid < 17 * 16) { const int r = tid >> 4, cc = tid & 15; float s = b_ada[item * 16 + cc];
        for (int k2 = 0; k2 < 32; ++k2) s += red[(k2 * 17 + r) * 16 + cc];
        MOD[r * 3072 + item * 16 + cc] = s; }
    __syncthreads();
}
__device__ __forceinline__ void p0_transpose_item(const float* W, int K, int N, bf16_t* WT, int row_off, float* scr, int item, int lane) {
    const int nblk = N / 32, kb = item / nblk, nb = item % nblk, k0 = 64 * kb, n0 = 32 * nb;
    float tv[32];
#pragma unroll
    for (int i = 0; i < 32; ++i) { const int kk = 2 * i + (lane >> 5); tv[i] = W[(size_t)(k0 + kk) * N + n0 + (lane & 31)]; }
#pragma unroll
    for (int i = 0; i < 32; ++i) { const int kk = 2 * i + (lane >> 5); scr[kk * 33 + (lane & 31)] = tv[i]; }
    LDS_WAIT(); asm volatile("" ::: "memory");
    const int c = lane & 7;
#pragma unroll
    for (int j = 0; j < 4; ++j) { const int n = (lane >> 3) + 8 * j; const float* s = scr + (8 * c) * 33 + n;
        v4u o; o.x = pk2(s[0 * 33], s[1 * 33]); o.y = pk2(s[2 * 33], s[3 * 33]); o.z = pk2(s[4 * 33], s[5 * 33]); o.w = pk2(s[6 * 33], s[7 * 33]);
        *(v4u*)(WT + (size_t)(row_off + n0 + n) * K + k0 + 8 * c) = o; }
    LDS_WAIT(); asm volatile("" ::: "memory");
}
__device__ __forceinline__ void p0_transpose64_item(const float* W, int K, int N, bf16_t* WT, int row_off, float* scr, int item, int lane, unsigned char* WT8 = nullptr, int row_off8 = 0) {
    const int nblk = N / 64, kb = item / nblk, nb = item % nblk, k0 = 64 * kb, n0 = 64 * nb;
    v4f tv[16]; const int lr = lane >> 4, lc = (lane & 15) * 4;
#pragma unroll
    for (int i = 0; i < 16; ++i) tv[i] = *(const v4f*)(W + (size_t)(k0 + 4 * i + lr) * N + n0 + lc);
#pragma unroll
    for (int i = 0; i < 16; ++i) { float* d = scr + (4 * i + lr) * 65 + lc; d[0] = tv[i].x; d[1] = tv[i].y; d[2] = tv[i].z; d[3] = tv[i].w; }
    LDS_WAIT(); asm volatile("" ::: "memory");
    const int c = lane & 7;
#pragma unroll
    for (int j = 0; j < 8; ++j) { const int n = (lane >> 3) + 8 * j; const float* s = scr + (8 * c) * 65 + n;
        v4u o; o.x = pk2(s[0 * 65], s[1 * 65]); o.y = pk2(s[2 * 65], s[3 * 65]); o.z = pk2(s[4 * 65], s[5 * 65]); o.w = pk2(s[6 * 65], s[7 * 65]);
        *(v4u*)(WT + (size_t)(row_off + n0 + n) * K + k0 + 8 * c) = o;
        if (WT8) { v2u w; w.x = pk4_fp8(s[0 * 65] * F8W_MUL, s[1 * 65] * F8W_MUL, s[2 * 65] * F8W_MUL, s[3 * 65] * F8W_MUL); w.y = pk4_fp8(s[4 * 65] * F8W_MUL, s[5 * 65] * F8W_MUL, s[6 * 65] * F8W_MUL, s[7 * 65] * F8W_MUL);
            *(v2u*)(WT8 + (size_t)(row_off8 + n0 + n) * K + k0 + 8 * c) = w; } }
    LDS_WAIT(); asm volatile("" ::: "memory");
}
__device__ __forceinline__ int new_col(int o) { return o < 4608 ? o : (o < 6656 ? o + 1024 : (o < 7680 ? o - 2048 : o)); }

__device__ __forceinline__ void sincos_d(double a, float& c, float& s) {
    const double TWO_PI = 6.283185307179586476925;
    const double k = (double)(long long)(a / TWO_PI + (a >= 0 ? 0.5 : -0.5)); const double r = a - k * TWO_PI, r2 = r * r;
    double ts = r, ss = r, tc = 1.0, cc = 1.0;
    for (int n = 1; n <= 15; ++n) { tc *= -r2 / (double)((2 * n - 1) * (2 * n)); cc += tc; ts *= -r2 / (double)((2 * n) * (2 * n + 1)); ss += ts; }
    c = (float)cc; s = (float)ss;
}

__device__ __forceinline__ void p1_row(const float* xrow, const float* nw, const float* shift, const float* scale, bf16_t* orow, int lane) {
    const v4f* xr = (const v4f*)xrow + lane; v4f v[4]; float s = 0.f;
#pragma unroll
    for (int j = 0; j < 4; ++j) { v[j] = xr[64 * j]; s += (v[j].x * v[j].x + v[j].y * v[j].y) + (v[j].z * v[j].z + v[j].w * v[j].w); }
    const float rstd = 1.0f / sqrtf(wave_sum(s) * (1.0f / 1024.0f) + EPS);
    v2u* o8 = (v2u*)orow + lane;
#pragma unroll
    for (int j = 0; j < 4; ++j) { const v4f w = ((const v4f*)nw)[lane + 64 * j], sh = ((const v4f*)shift)[lane + 64 * j], sc = ((const v4f*)scale)[lane + 64 * j];
        const v4f y = v[j] * rstd * w * (sc + 1.0f) + sh; v2u o; o.x = pk2(y.x, y.y); o.y = pk2(y.z, y.w); o8[64 * j] = o; }
}

template <int NR>
__device__ __forceinline__ void p1_rowsN(const float* x, const float* ctx, const float* MOD, const v4f (&nwv)[4], bf16_t* HX, int r0, int rlast, int lane, unsigned char* HX8 = nullptr) {
    v4f v[NR][4];
#pragma unroll
    for (int k = 0; k < NR; ++k) { const int m = r0 + k < rlast ? r0 + k : rlast; const float* xr = m < MLAT ? x + (size_t)m * 1024 : ctx + (size_t)(m - MLAT) * 1024;
#pragma unroll
        for (int j = 0; j < 4; ++j) v[k][j] = __builtin_nontemporal_load((const v4f*)xr + lane + 64 * j); }
#pragma unroll
    for (int k = 0; k < NR; ++k) { const int m = r0 + k < rlast ? r0 + k : rlast; const float* mp = MOD + (m < MLAT ? (m >> 11) : 16) * 3072; float s = 0.f;
        v4f sh[4], sc[4];
#pragma unroll
        for (int j = 0; j < 4; ++j) { sh[j] = ((const v4f*)mp)[lane + 64 * j]; sc[j] = ((const v4f*)(mp + 1024))[lane + 64 * j]; }
#pragma unroll
        for (int j = 0; j < 4; ++j) s += (v[k][j].x * v[k][j].x + v[k][j].y * v[k][j].y) + (v[k][j].z * v[k][j].z + v[k][j].w * v[k][j].w);
        const float rstd = 1.0f / sqrtf(wave_sum(s) * (1.0f / 1024.0f) + EPS);
        v2u* o8 = (v2u*)(HX + (size_t)m * 1024) + lane;
#pragma unroll
        for (int j = 0; j < 4; ++j) { const v4f y = v[k][j] * rstd * nwv[j] * (sc[j] + 1.0f) + sh[j]; v2u o; o.x = pk2(y.x, y.y); o.y = pk2(y.z, y.w); o8[64 * j] = o;
            if (HX8) ((unsigned*)(HX8 + (size_t)m * 1024))[lane + 64 * j] = pk4_fp8(y.x, y.y, y.z, y.w); } }
}

__device__ __forceinline__ void p3_item(bf16_t* buf, int ldlog2, bool isK, const float* nw, const float* ROPE, size_t item, int lane) {
    const size_t e = item * 512 + (size_t)lane * 8; const size_t row = e >> ldlog2; const int col = (int)(e & ((1u << ldlog2) - 1)), d0 = col & 127;
    float t[8]; unpack8(*(const v4u*)(buf + e), t);
    float ss = 0.f;
#pragma unroll
    for (int k = 0; k < 8; ++k) ss += t[k] * t[k];
    ss += __shfl_xor(ss, 1); ss += __shfl_xor(ss, 2); ss += __shfl_xor(ss, 4); ss += __shfl_xor(ss, 8);
    const float rstd = 1.0f / sqrtf(ss * (1.0f / 128.0f) + EPS);
#pragma unroll
    for (int k = 0; k < 8; ++k) t[k] = t[k] * rstd * nw[d0 + k];
    int l; bool rope = true;
    if (isK) { const int p = (int)(row % LT); rope = p >= LC; l = p - LC; } else l = (int)(row & (SEQ - 1));
    if (rope) { const int ri = l >> 6, ci = l & 63, p0 = d0 >> 1; const float* tab = p0 < 32 ? ROPE + (ri * 32 + p0) * 2 : ROPE + (ci * 32 + (p0 - 32)) * 2;
#pragma unroll
        for (int q = 0; q < 4; ++q) { const float cs = tab[2 * q], sn = tab[2 * q + 1], x0 = t[2 * q], x1 = t[2 * q + 1]; t[2 * q] = x0 * cs - x1 * sn; t[2 * q + 1] = x0 * sn + x1 * cs; } }
    *(v4u*)(buf + e) = pack8(t);
}

template <int NI>
__device__ __forceinline__ void p3_items_k(bf16_t* AK, const float* nw, const float* ROPE, size_t it0, size_t itend, int lane, unsigned char* K8 = nullptr) {
    v4u raw[NI];
#pragma unroll
    for (int i = 0; i < NI; ++i) if (it0 + i < itend) raw[i] = *(const v4u*)(AK + (it0 + i) * 512 + (size_t)lane * 8);
#pragma unroll
    for (int i = 0; i < NI; ++i) if (it0 + i < itend) {
        const size_t e = (it0 + i) * 512 + (size_t)lane * 8; const size_t row = e >> 8; const int d0 = (int)(e & 255) & 127;
        float t[8]; unpack8(raw[i], t); float ss = 0.f;
#pragma unroll
        for (int k = 0; k < 8; ++k) ss += t[k] * t[k];
        ss += __shfl_xor(ss, 1); ss += __shfl_xor(ss, 2); ss += __shfl_xor(ss, 4); ss += __shfl_xor(ss, 8);
        const float rstd = 1.0f / sqrtf(ss * (1.0f / 128.0f) + EPS);
#pragma unroll
        for (int k = 0; k < 8; ++k) t[k] = t[k] * rstd * nw[d0 + k];
        const int p = (int)(row % LT);
        if (p >= LC) { const int l = p - LC, ri = l >> 6, ci = l & 63, p0 = d0 >> 1; const float* tab = p0 < 32 ? ROPE + (ri * 32 + p0) * 2 : ROPE + (ci * 32 + (p0 - 32)) * 2;
#pragma unroll
            for (int q = 0; q < 4; ++q) { const float cs = tab[2 * q], sn = tab[2 * q + 1], x0 = t[2 * q], x1 = t[2 * q + 1]; t[2 * q] = x0 * cs - x1 * sn; t[2 * q + 1] = x0 * sn + x1 * cs; } }
#if !(MK_FP8K) || MK_NAIVE_ATTN || MK_DEBUG_ATTN
        *(v4u*)(AK + e) = pack8(t);
#endif
#if MK_FP8K
        if (K8) { int w0 = __builtin_amdgcn_cvt_pk_fp8_f32(t[0], t[1], 0, false); w0 = __builtin_amdgcn_cvt_pk_fp8_f32(t[2], t[3], w0, true);
            int w1 = __builtin_amdgcn_cvt_pk_fp8_f32(t[4], t[5], 0, false); w1 = __builtin_amdgcn_cvt_pk_fp8_f32(t[6], t[7], w1, true);
            const int g = ((int)(e & 255)) >> 7, pb = (d0 & 64) + 32 * ((d0 >> 3) & 1) + 8 * ((d0 >> 4) & 3); v2u w; w.x = (unsigned)w0; w.y = (unsigned)w1;
            *(v2u*)(K8 + row * 256 + g * 128 + pb) = w; }
#endif
        }
}

__device__ __forceinline__ void vt8_item(const bf16_t* AV, unsigned char* VT8, LAS unsigned char* scr, int item, int lane) {
    const int dq = item & 3, tl = item >> 2, T = tl % 36, bg = tl / 36, b = bg >> 1, g = bg & 1;
    const bf16_t* src = AV + ((size_t)(b * LT + 64 * T)) * 256 + g * 128 + dq * 32;
    v4u v[4];
#pragma unroll
    for (int i = 0; i < 4; ++i) { const int ci = lane + 64 * i, row = ci >> 2, c16 = ci & 3; v[i] = *(const v4u*)(src + (size_t)row * 256 + c16 * 8); }
#pragma unroll
    for (int i = 0; i < 4; ++i) { const int ci = lane + 64 * i, row = ci >> 2, c16 = ci & 3; *(LAS v4u*)(scr + row * 80 + c16 * 16) = v[i]; }
    asm volatile("s_waitcnt lgkmcnt(0)" ::: "memory");
    const int dp = lane >> 2, cc = lane & 3; float f0[16], f1[16];
#pragma unroll
    for (int i = 0; i < 16; ++i) { const int key = 32 * (cc >> 1) + (i & 3) + 8 * ((i >> 2) & 3) + 4 * (cc & 1); const unsigned w = *(const LAS unsigned*)(scr + key * 80 + dp * 4); f0[i] = bflo(w); f1[i] = bfhi(w); }
    unsigned char* dst = VT8 + (size_t)tl * 8192 + (size_t)(dq * 32 + 2 * dp) * 64 + cc * 16;
    v4u w0, w1;
    w0.x = pk4_fp8(f0[0], f0[1], f0[2], f0[3]); w0.y = pk4_fp8(f0[4], f0[5], f0[6], f0[7]); w0.z = pk4_fp8(f0[8], f0[9], f0[10], f0[11]); w0.w = pk4_fp8(f0[12], f0[13], f0[14], f0[15]);
    w1.x = pk4_fp8(f1[0], f1[1], f1[2], f1[3]); w1.y = pk4_fp8(f1[4], f1[5], f1[6], f1[7]); w1.z = pk4_fp8(f1[8], f1[9], f1[10], f1[11]); w1.w = pk4_fp8(f1[12], f1[13], f1[14], f1[15]);
    *(v4u*)dst = w0; *(v4u*)(dst + 64) = w1;
    asm volatile("s_waitcnt lgkmcnt(0)" ::: "memory");
}

__device__ __forceinline__ void p4_naive_item(const bf16_t* RQ, const bf16_t* RK, const bf16_t* RV, bf16_t* YR, float* SSQ, const float* l2d, float* ldsf, int item, int tid) {
    const int rb = item & 255, h = (item >> 8) & 3, b = item >> 10, i0 = rb * 8;
    float* qs = ldsf; float* sc = ldsf + 2048; float* red = sc + 8 * LT;
    for (int t = tid; t < 2048; t += NTHR) { const int r = t >> 8, d = t & 255; qs[t] = bf2f(RQ[((size_t)(b * SEQ + i0 + r)) * 1024 + h * 256 + d]); }
    __syncthreads();
    const float lgf = log1pf(-exp2f(l2d[h])), lgb = log1pf(-exp2f(l2d[4 + h]));
    for (int p = tid; p < LT; p += NTHR) {
        const bf16_t* kr = RK + ((size_t)(b * LT + p)) * 1024 + h * 256;
        float dot[8];
#pragma unroll
        for (int r = 0; r < 8; ++r) dot[r] = 0.f;
        for (int d8 = 0; d8 < 32; ++d8) { float kk[8]; unpack8(*(const v4u*)(kr + d8 * 8), kk);
#pragma unroll
            for (int r = 0; r < 8; ++r)
#pragma unroll
                for (int k = 0; k < 8; ++k) dot[r] += qs[r * 256 + d8 * 8 + k] * kk[k]; }
#pragma unroll
        for (int r = 0; r < 8; ++r) { const int i = i0 + r; float W;
            if (p < LC) W = MK_DBG_NOCTX ? 0.f : expf(lgf * (float)(i + LC - p)) + expf(lgb * (float)(SEQ - i + p));
            else { const int j = p - LC; W = (j <= i ? expf(lgf * (float)(i - j)) : 0.f) + (j >= i ? expf(lgb * (float)(j - i)) : 0.f); }
            sc[r * LT + p] = dot[r] * W; }
    }
    __syncthreads();
    float acc[8];
#pragma unroll
    for (int r = 0; r < 8; ++r) acc[r] = 0.f;
    const bf16_t* vp = RV + (size_t)(b * LT) * 2048 + h * 512 + tid;
    for (int p = 0; p < LT; ++p) { const float v = bf2f(vp[(size_t)p * 2048]);
#pragma unroll
        for (int r = 0; r < 8; ++r) acc[r] += sc[r * LT + p] * v; }
    const int wid = tid >> 6, lane = tid & 63;
#pragma unroll
    for (int r = 0; r < 8; ++r) { YR[((size_t)(b * SEQ + i0 + r)) * 2048 + h * 512 + tid] = (bf16_t)f2bf(acc[r]); const float s = wave_sum(acc[r] * acc[r]); if (lane == 0) red[r * 8 + wid] = s; }
    __syncthreads();
    if (tid < 16) { const int r = tid >> 1, hf = tid & 1; const float s = (red[r * 8 + hf * 4] + red[r * 8 + hf * 4 + 1]) + (red[r * 8 + hf * 4 + 2] + red[r * 8 + hf * 4 + 3]);
        SSQ[((size_t)(b * SEQ + i0 + r)) * 8 + h * 2 + hf] = s; }
    __syncthreads();
}

__device__ __forceinline__ void p5_naive_item(bf16_t* AQ, const bf16_t* AK, const bf16_t* AV, float* ldsf, int item, int tid) {
    const int rb = item & 255, head = (item >> 8) & 7, b = item >> 11, g = head >> 2, i0 = rb * 8;
    float* qs = ldsf; float* sc = ldsf + 1024;
    for (int t = tid; t < 1024; t += NTHR) { const int r = t >> 7, d = t & 127; qs[t] = bf2f(AQ[((size_t)(b * SEQ + i0 + r)) * 1024 + head * 128 + d]); }
    __syncthreads();
    for (int p = tid; p < LT; p += NTHR) {
        const bf16_t* kr = AK + ((size_t)(b * LT + p)) * 256 + g * 128;
        float dot[8];
#pragma unroll
        for (int r = 0; r < 8; ++r) dot[r] = 0.f;
        for (int d8 = 0; d8 < 16; ++d8) { float kk[8]; unpack8(*(const v4u*)(kr + d8 * 8), kk);
#pragma unroll
            for (int r = 0; r < 8; ++r)
#pragma unroll
                for (int k = 0; k < 8; ++k) dot[r] += qs[r * 128 + d8 * 8 + k] * kk[k]; }
#pragma unroll
        for (int r = 0; r < 8; ++r) sc[r * LT + p] = dot[r] * 0.08838834764831845f;
    }
    __syncthreads();
    { const int wid = tid >> 6, lane = tid & 63; float* row = sc + wid * LT; float m = -1e30f;
      for (int p = lane; p < LT; p += 64) m = fmaxf(m, row[p]);
#pragma unroll
      for (int o = 1; o < 64; o <<= 1) m = fmaxf(m, __shfl_xor(m, o));
      float s = 0.f;
      for (int p = lane; p < LT; p += 64) { const float ex = expf(row[p] - m); row[p] = ex; s += ex; }
      s = wave_sum(s); const float inv = 1.0f / s;
      for (int p = lane; p < LT; p += 64) row[p] *= inv; }
    __syncthreads();
    const int e = tid & 127, r0 = (tid >> 7) * 2; float a0 = 0.f, a1 = 0.f;
    const bf16_t* vp = AV + (size_t)(b * LT) * 256 + g * 128 + e;
    for (int p = 0; p < LT; ++p) { const float v = bf2f(vp[(size_t)p * 256]); a0 += sc[r0 * LT + p] * v; a1 += sc[(r0 + 1) * LT + p] * v; }
    AQ[((size_t)(b * SEQ + i0 + r0)) * 1024 + head * 128 + e] = (bf16_t)f2bf(a0);
    AQ[((size_t)(b * SEQ + i0 + r0 + 1)) * 1024 + head * 128 + e] = (bf16_t)f2bf(a1);
    __syncthreads();
}

#if MK_BARRIER == 1
struct GridBarF { XcdBarrier b; __device__ __forceinline__ void operator()() const { xcd_barrier(b); } };
#else
struct GridBarF { __device__ __forceinline__ void operator()() const { cooperative_groups::this_grid().sync(); } };
#endif
__device__ __forceinline__ void ssq_item(const bf16_t* YR, float* SSQ, int it, int lane) {
    const int row = it >> 2, head = it & 3; float t[8]; unpack8(*(const v4u*)(YR + (size_t)row * 2048 + head * 512 + lane * 8), t);
    float ss = 0.f;
#pragma unroll
    for (int k = 0; k < 8; ++k) ss += t[k] * t[k];
    ss = wave_sum(ss);
    if (lane == 0) { SSQ[(size_t)row * 8 + head * 2] = ss; SSQ[(size_t)row * 8 + head * 2 + 1] = 0.f; }
}
__global__ void __launch_bounds__(NTHR, 2) mk_fwd(Args args) {
    extern __shared__ __attribute__((aligned(16))) unsigned char lds[];
    const int tid = threadIdx.x, lane = tid & 63, wave = __builtin_amdgcn_readfirstlane(tid >> 6);
    const int G = gridDim.x, bid = blockIdx.x;
    const int gw = bid * NWAVES + wave, NGW = G * NWAVES;
    float* ldsf = (float*)lds;
    unsigned char* ws = args.ws;
    const float *x = args.in[0], *cvec = args.in[1], *ctx = args.in[2], *c_ctx = args.in[3], *norm_w = args.in[4], *w_ada = args.in[5], *b_ada = args.in[6], *w_in = args.in[7],
                *l2d = args.in[8], *q_norm_w = args.in[9], *k_norm_w = args.in[10], *w_o_ret = args.in[11], *w_o_att = args.in[12], *w_out = args.in[13];
    float* MOD = (float*)(ws + WS_MOD); float* ROPE = (float*)(ws + WS_ROPE); float* SSQ = (float*)(ws + WS_SSQ);
    bf16_t *WIN = (bf16_t*)(ws + WS_WIN), *WOR = (bf16_t*)(ws + WS_WOR), *WOA = (bf16_t*)(ws + WS_WOA), *WOUT = (bf16_t*)(ws + WS_WOUT), *HX = (bf16_t*)(ws + WS_HX);
    bf16_t *RK = (bf16_t*)(ws + WS_RK), *RV = (bf16_t*)(ws + WS_RV), *RQ = (bf16_t*)(ws + WS_RQ), *AK = (bf16_t*)(ws + WS_AK), *AV = (bf16_t*)(ws + WS_AV), *AQ = (bf16_t*)(ws + WS_AQ);
    bf16_t *U1 = (bf16_t*)(ws + WS_U1), *U2 = (bf16_t*)(ws + WS_U2), *YR = (bf16_t*)args.out;
    const int lo = args.ph_lo, hi = args.ph_hi;
#define IN(k) (lo <= (k) && (k) < hi)
#define BOTH(k) (IN(k) && IN((k) + 1))
    if (tid < 32) ((LAS unsigned*)(lds + MISC_OFF))[tid] = 0u;
    __syncthreads();
#if MK_BARRIER == 1
    XcdBarrier bar; bar.bar = (unsigned*)(ws + WS_CTL) + CW_BAR; bar.x = 0; bar.st = nullptr;
    if (hi - lo > 1) bar = xcd_barrier_post((unsigned*)(ws + WS_CTL) + CW_BAR, (volatile LAS unsigned*)(lds + MISC_OFF) + 8);
#define GRID_BAR() xcd_barrier(bar)
#else
#define GRID_BAR() cooperative_groups::this_grid().sync()
#endif

#if MK_STAMP_A >= 0
#define STAMP(k) do { if (bid == 0 && tid == 0) { if ((k) == MK_STAMP_A) ((volatile LAS unsigned*)(lds + MISC_OFF))[17] = (unsigned)__builtin_amdgcn_s_memrealtime(); if ((k) == MK_STAMP_B) ((volatile LAS unsigned*)(lds + MISC_OFF))[18] = (unsigned)__builtin_amdgcn_s_memrealtime(); } } while (0)
#else
#define STAMP(k) do { } while (0)
#endif
#define STAGGER() do { if (MK_NSTAG > 1) { const unsigned grp = ((unsigned)bid >> 3) % MK_NSTAG; const unsigned long long t0_ = __builtin_amdgcn_s_memrealtime(); \
        while (__builtin_amdgcn_s_memrealtime() - t0_ < (unsigned long long)grp * MK_STAG_TICKS) __builtin_amdgcn_s_sleep(16); } } while (0)
    STAMP(0);
    if (IN(0)) {
        for (int it = bid; it < 192; it += G) p0_mod_item(cvec, c_ctx, w_ada, b_ada, MOD, ldsf, it, tid);
        if (bid == G - 1) for (int t = tid; t < 2048; t += NTHR) { const int v = t >> 5, i = t & 31; double fd = 1.0; for (int k = 0; k < i; ++k) fd *= 0.7498942093324559;
            const float ang = (float)v * (float)fd; float cs, sn; sincos_d((double)ang, cs, sn); ROPE[2 * t] = cs; ROPE[2 * t + 1] = sn; }
        if (BOTH(0)) GRID_BAR();
    }
    STAMP(1);
    if (IN(1)) {
        {
        float* scr = ldsf + wave * (64 * 65);
        constexpr int I_IN = 16 * (NIN / 64), I_OR = 32 * 16, I_OA = 16 * 16, I_OUT = 16 * 16;
        for (int it = gw; it < I_IN + I_OR + I_OA + I_OUT; it += NGW) {
            int r = it;
            if (r < I_IN) { const int n0 = 64 * (r % (NIN / 64)), gr = new_col(n0);
                const int r8 = (MK_FP8G >= 2) ? ((gr >= 3072 && gr < 3584) ? gr - 3072 : ((gr >= 4608 && gr < 5632) ? gr - 4608 + 512 : -1)) : -1;
                p0_transpose64_item(w_in, 1024, NIN, WIN, gr - n0, scr, r, lane, r8 >= 0 ? ws + WS_WIN8 : (unsigned char*)nullptr, r8 - n0); continue; } r -= I_IN;
            if (r < I_OR) { p0_transpose64_item(w_o_ret, 2048, 1024, WOR, 0, scr, r, lane); continue; } r -= I_OR;
            if (r < I_OA) { p0_transpose64_item(w_o_att, 1024, 1024, WOA, 0, scr, r, lane, MK_FP8G ? ws + WS_WOA8 : (unsigned char*)nullptr, 0); continue; } r -= I_OA;
            p0_transpose64_item(w_out, 1024, 1024, WOUT, 0, scr, r, lane);
        }
        }
        {
            const int rpw = (MALL + NGW - 1) / NGW, m0 = gw * rpw, m1 = m0 + rpw < MALL ? m0 + rpw : MALL;
            v4f nwv[4];
#pragma unroll
            for (int j = 0; j < 4; ++j) nwv[j] = ((const v4f*)norm_w)[lane + 64 * j];
            for (int m = m0; m < m1; m += 9) p1_rowsN<9>(x, ctx, MOD, nwv, HX, m, m1 - 1, lane, MK_FP8G >= 2 ? (unsigned char*)args.out : (unsigned char*)nullptr);
        }
        if (BOTH(1)) GRID_BAR();
    }
    STAMP(2);
    if (IN(2)) {
        STAGGER();
        pg8::Gemm g{HX, WIN, MALL, N1, 1024}; pg8::Sched1 S; S.init(G, bid);
        pg8::Epi1 E{RK, RV, AK, AV, RQ, AQ, nullptr};
#if MK_P2PROBE == 4
        { pg8::Epi1T<2> EC{RK, RV, AK, AV, RQ, AQ, nullptr}; pg8::gemm_phase<pg8::Epi1T<2>, pg8::Sched1, true, true, MK_EPIW>((PG8_LAS unsigned char*)lds, g, S, EC); }
        __syncthreads();
#endif
#if MK_FP8G >= 2
        { pg8::SchedG1 S0; S0.init(G, bid, 0); pg8::gemm_phase<pg8::Epi1, pg8::SchedG1, true, true, MK_EPIW>((PG8_LAS unsigned char*)lds, g, S0, E); }
        { pg8::SchedG1 S1; S1.init(G, bid, 1); pg8::Gemm g8{(const bf16_t*)args.out, (const bf16_t*)(ws + WS_WIN8), MALL, 1536, 512, 0x7F7F7F7F, F8W_SC}; pg8::Epi1F8 E8{E};
          pg8::gemm_phase<pg8::Epi1F8, pg8::SchedG1, true, true, MK_EPIW, true>((PG8_LAS unsigned char*)lds, g8, S1, E8); }
#else
        for (int rep = 0; rep < MK_REP_P2; ++rep) pg8::gemm_phase<pg8::Epi1, pg8::Sched1, true, true, MK_EPIW>((PG8_LAS unsigned char*)lds, g, S, E);
#endif
#if MK_P2PROBE == 1
        { pg8::Epi1T<1> ED{RK, RV, AK, AV, RQ, AQ, (bf16_t*)(ws + WS_END)}; pg8::gemm_phase<pg8::Epi1T<1>, pg8::Sched1, true, true, MK_EPIW>((PG8_LAS unsigned char*)lds, g, S, ED); }
#endif
#if MK_P2PROBE == 3
        { pg8::Epi1T<0> ER{RK, RV, AK, AV, RQ, AQ, nullptr}; pg8::gemm_phase<pg8::Epi1T<0>, pg8::Sched1, true, true, MK_EPIW>((PG8_LAS unsigned char*)lds, g, S, ER); }
#endif
#if MK_P2PROBE == 2
        { pg8::EpiNull EN; pg8::gemm_phase<pg8::EpiNull, pg8::Sched1, true, true, 0>((PG8_LAS unsigned char*)lds, g, S, EN); }
#endif
        if (BOTH(2)) GRID_BAR();
    }
    STAMP(3);
#if MK_NAIVE_ATTN
    if (IN(3)) {
        constexpr size_t IQ = (size_t)MLAT * 1024 / 512, IK = (size_t)NB * LT * 256 / 512;
        for (size_t it = gw; it < IQ + IK; it += NGW) {
            if (it < IQ) p3_item(AQ, 10, false, q_norm_w, ROPE, it, lane); else p3_item(AK, 8, true, k_norm_w, ROPE, it - IQ, lane);
        }
        if (BOTH(3)) GRID_BAR();
    }
#endif
#if MK_DEBUG_ATTN
    {
        bf16_t* AQ2 = (bf16_t*)(ws + WS_RK); float* acc2 = (float*)(ws + WS_CTL) + 64;
        for (size_t i = (size_t)bid * NTHR + tid; i < (size_t)MLAT * 1024 / 8; i += (size_t)G * NTHR) ((v4u*)AQ2)[i] = ((const v4u*)AQ)[i];
        { int tl = threadIdx.x; asm volatile("" : "+v"(tl)); const int lane_l = tl & 63, gw_l = bid * NWAVES + (tl >> 6);
          constexpr size_t IK = (size_t)NB * LT * 256 / 512; for (size_t it = gw_l; it < IK; it += NGW) p3_item(AK, 8, true, k_norm_w, ROPE, it, lane_l); }
        GRID_BAR();
        { int tl = threadIdx.x; asm volatile("" : "+v"(tl)); const int lane_l = tl & 63, gw_l = bid * NWAVES + (tl >> 6);
          constexpr size_t IQ = (size_t)MLAT * 1024 / 512; for (size_t it = gw_l; it < IQ; it += NGW) p3_item(AQ2, 10, false, q_norm_w, ROPE, it, lane_l); }
        GRID_BAR();
        { const int vcu = (bid & 7) * (G >> 3) + (bid >> 3);
          for (int idx = vcu; idx < NB * AH * 8; idx += G) { const int qb = idx & 7, r = (idx >> 3) & 3, g = (idx >> 5) & 1, b = idx >> 6, head = g * 4 + r;
            bf16_t* Q = AQ + ((size_t)(b * SEQ + qb * 256)) * 1024 + head * 128; const bf16_t* K = AK + (size_t)(b * LT) * 256 + g * 128; const bf16_t* V = AV + (size_t)(b * LT) * 256 + g * 128;
            attn::attn_dense_body<attn::bf16>(Q, K, V, Q, LT, (char*)lds, q_norm_w, ROPE, qb * 256); } }
        __syncthreads();
        { const int vcu = (bid & 7) * (G >> 3) + (bid >> 3);
          for (int idx = vcu; idx < NB * AH * 8; idx += G) { const int qb = idx & 7, r = (idx >> 3) & 3, g = (idx >> 5) & 1, b = idx >> 6, head = g * 4 + r;
            bf16_t* Q = AQ2 + ((size_t)(b * SEQ + qb * 256)) * 1024 + head * 128; const bf16_t* K = AK + (size_t)(b * LT) * 256 + g * 128; const bf16_t* V = AV + (size_t)(b * LT) * 256 + g * 128;
            attn::attn_dense_body<attn::bf16>(Q, K, V, Q, LT, (char*)lds, nullptr, ROPE, qb * 256); } }
        GRID_BAR();
        float sd = 0.f, sb = 0.f;
        for (size_t i = (size_t)bid * NTHR + tid; i < (size_t)MLAT * 1024; i += (size_t)G * NTHR) { const float a = bf2f(AQ[i]), b2 = bf2f(AQ2[i]); sd += (a - b2) * (a - b2); sb += b2 * b2; }
        sd = wave_sum(sd); sb = wave_sum(sb);
        if (lane == 0) { atomicAdd(acc2, sd); atomicAdd(acc2 + 1, sb); }
        GRID_BAR();
        if (bid == 0 && tid == 0) { const float s0 = __hip_atomic_load(acc2, __ATOMIC_RELAXED, __HIP_MEMORY_SCOPE_AGENT), s1 = __hip_atomic_load(acc2 + 1, __ATOMIC_RELAXED, __HIP_MEMORY_SCOPE_AGENT);
            args.out[0] = 1e6f * sqrtf(s0 / s1); args.out[1] = 1e3f * sqrtf(s1 / ((float)MLAT * 1024.f)); }
        return;
    }
#endif
    STAMP(4);
#if MK_DEBUG_RET
    {
        bf16_t* YR2 = (bf16_t*)(ws + WS_AQ); float* acc2 = (float*)(ws + WS_CTL) + 64;
        for (int it = bid; it < 8 * RH * 256; it += G) p4_naive_item(RQ, RK, RV, YR, SSQ, l2d, ldsf, it, tid);
        __syncthreads();
        { GridBarF gb{bar}; ret::scan_unit(RQ, RK, RV, YR2, SSQ + 2 * MLAT * 8, l2d, (LAS unsigned char*)lds, bid, gb, 8); }
        GRID_BAR();
        float sd = 0.f, sb = 0.f;
        for (size_t i = (size_t)bid * NTHR + tid; i < (size_t)8 * SEQ * 2048; i += (size_t)G * NTHR) { const int l = (int)((i >> 11) & 2047); if (l < MK_DBG_L0 || l >= MK_DBG_L1 || (int)((i >> 9) & 3) != MK_DBG_H) continue; const float a = bf2f(YR2[i]), b2 = bf2f(YR[i]); sd += (a - b2) * (a - b2); sb += b2 * b2; }
        sd = wave_sum(sd); sb = wave_sum(sb);
        if (lane == 0) { atomicAdd(acc2, sd); atomicAdd(acc2 + 1, sb); }
        GRID_BAR();
        if (bid == 0 && tid == 0) { const float s0 = __hip_atomic_load(acc2, __ATOMIC_RELAXED, __HIP_MEMORY_SCOPE_AGENT), s1 = __hip_atomic_load(acc2 + 1, __ATOMIC_RELAXED, __HIP_MEMORY_SCOPE_AGENT);
            ((float*)(ws + WS_SSQ))[0] = 1e6f * sqrtf(s0 / s1); ((float*)(ws + WS_SSQ))[1] = 1e3f * sqrtf(s1 / (8.f * SEQ * 2048.f)); }
        GRID_BAR();
        if (bid == 0 && tid == 0) { args.out[0] = ((float*)(ws + WS_SSQ))[0]; args.out[1] = ((float*)(ws + WS_SSQ))[1]; }
        return;
    }
#endif
    if (IN(4)) {
        auto kfix = [&]() {
#if !MK_NAIVE_ATTN
          int tl = threadIdx.x; asm volatile("" : "+v"(tl)); const int lane_l = tl & 63, gw_l = bid * NWAVES + (tl >> 6);
          constexpr size_t IK = (size_t)NB * LT * 256 / 512; const size_t ipw = (IK + NGW - 1) / NGW, i0 = (size_t)gw_l * ipw, i1 = i0 + ipw < IK ? i0 + ipw : IK;
          for (size_t it = i0; it < i1; it += 3) p3_items_k<3>(AK, k_norm_w, ROPE, it, i1, lane_l, ws + WS_K8);
#if MK_FP8V
          { const int wv = __builtin_amdgcn_readfirstlane(tl >> 6); for (int it = gw_l; it < NB * 2 * 36 * 4; it += NGW) vt8_item(AV, ws + WS_VT8, (LAS unsigned char*)lds + wv * (64 * 80), it, lane_l); }
#endif
#endif
        };
#if MK_NAIVE_RET
        kfix(); for (int it = bid; it < NB * RH * 256; it += G) p4_naive_item(RQ, RK, RV, YR, SSQ, l2d, ldsf, it, tid);
#else
        if (G == 256) { GridBarF gb{bar}; ret::scan_unit(RQ, RK, RV, YR, SSQ, l2d, (LAS unsigned char*)lds, bid, gb, NB, kfix); if (MK_MIX && BOTH(4)) GRID_BAR(); }
        else { kfix(); for (int it = bid; it < NB * RH * 256; it += G) p4_naive_item(RQ, RK, RV, YR, SSQ, l2d, ldsf, it, tid); if (BOTH(4)) GRID_BAR(); }
#endif
    }
    STAMP(5);
    if (IN(5)) {
#if MK_NAIVE_ATTN
        for (int it = bid; it < NB * AH * 256; it += G) p5_naive_item(AQ, AK, AV, ldsf, it, tid);
#else
        const int vcu = (G % 8 == 0) ? (bid & 7) * (G >> 3) + (bid >> 3) : bid;
#define ATT_UNIT(idx_, Q_, K_, V_, qb_) const int qb_ = (idx_) & 7; bf16_t* Q_; const bf16_t *K_, *V_; \
            { const int r_ = ((idx_) >> 3) & 3, g_ = ((idx_) >> 5) & 1, b_ = (idx_) >> 6, head_ = g_ * 4 + r_; Q_ = AQ + ((size_t)(b_ * SEQ + qb_ * 256)) * 1024 + head_ * 128; \
              K_ = MK_FP8K ? (const bf16_t*)(ws + WS_K8 + ((size_t)(b_ * LT) * 256 + g_ * 128)) : AK + (size_t)(b_ * LT) * 256 + g_ * 128; V_ = MK_FP8V ? (const bf16_t*)(ws + WS_VT8 + (size_t)((b_ * 2 + g_) * 36) * 8192) : AV + (size_t)(b_ * LT) * 256 + g_ * 128; }
        auto run_attn = [&](const int nkeys, const bool store) {
        attn::Pre pre;
        if (vcu < NB * AH * 8) { ATT_UNIT(vcu, Q0, K0, V0, qb0); attn::attn_prefetch(Q0, K0, V0, pre); }
        for (int idx = vcu; idx < NB * AH * 8; idx += G) {
            ATT_UNIT(idx, Q, K, V, qb);
            const int nidx = idx + G; const bool hn = nidx < NB * AH * 8; ATT_UNIT(hn ? nidx : idx, Qn, Kn, Vn, qbn);
            attn::attn_dense_body<attn::bf16>(Q, K, V, store ? Q : (bf16_t*)nullptr, nkeys, (char*)lds, q_norm_w, ROPE, qb * 256, pre, Qn, Kn, Vn); __syncthreads();
        } };
#if MK_MIX
        auto run_gates = [&](int mode) { pg8::Gemm g{HX, WIN + (size_t)N1 * 1024, MLAT, NG, 1024}; pg8::SchedGates S; S.init(G, bid, mode); pg8::Epi5 E{YR, AQ, U1, U2, SSQ, 0, ws + WS_YA8};
            pg8::gemm_phase<pg8::Epi5, pg8::SchedGates, true, true, MK_EPIW>((PG8_LAS unsigned char*)lds, g, S, E); };
        const bool attn_first = (bid & 4) == 0;
        if (attn_first) { run_attn(LT, true); __syncthreads(); run_gates(0); } else { run_gates(0); __syncthreads(); run_attn(LT, true); }
        __syncthreads(); GRID_BAR(); run_gates(1);
#else
        for (int rep = 0; rep < (MK_ATTN_PROBE > 0 ? 2 : 1); ++rep) run_attn(rep ? MK_ATTN_PROBE : LT, rep == 0);
#endif
#undef ATT_UNIT
#endif
#if !MK_NAIVE_RET
        if (G != 256) { int tl = threadIdx.x; asm volatile("" : "+v"(tl)); const int lane_l = tl & 63, gw_l = bid * NWAVES + (tl >> 6);
          for (int it = gw_l; it < MLAT * 4; it += NGW) ssq_item(YR, SSQ, it, lane_l); }
#endif
        if (BOTH(5)) GRID_BAR();
    }
    STAMP(6);
    if (IN(6) && !MK_MIX) {
        STAGGER();
        pg8::Gemm g{HX, WIN + (size_t)N1 * 1024, MLAT, NG, 1024}; pg8::StaticOrder S; S.init(MLAT, NG, G, bid);
        pg8::Epi5 E{YR, AQ, U1, U2, SSQ, 0, ws + WS_YA8};
        pg8::gemm_phase<pg8::Epi5, pg8::StaticOrder, true, true, MK_EPIW>((PG8_LAS unsigned char*)lds, g, S, E);
        if (BOTH(6)) GRID_BAR();
    }
    STAMP(7);
    if (IN(7)) {
        pg8::Gemm g{YR, WOR, MLAT, 1024, 2048}; pg8::StaticOrder S; S.init(MLAT, 1024, G, bid);
        pg8::Epi6 E{U1};
        pg8::gemm_phase<pg8::Epi6, pg8::StaticOrder, true, true, MK_EPIW>((PG8_LAS unsigned char*)lds, g, S, E);
    }
    STAMP(8);
    if (IN(8)) {
        pg8::StaticOrder S; S.init(MLAT, 1024, G, bid);
        pg8::Epi7 E{U1, U2};
#if MK_FP8G
        { pg8::Gemm g{(const bf16_t*)(ws + WS_YA8), (const bf16_t*)(ws + WS_WOA8), MLAT, 1024, 512, F8Y_SC, F8W_SC};
          pg8::gemm_phase<pg8::Epi7, pg8::StaticOrder, true, true, MK_EPIW, true>((PG8_LAS unsigned char*)lds, g, S, E); }
#else
        { pg8::Gemm g{AQ, WOA, MLAT, 1024, 1024};
          pg8::gemm_phase<pg8::Epi7, pg8::StaticOrder, true, true, MK_EPIW>((PG8_LAS unsigned char*)lds, g, S, E); }
#endif
        if (BOTH(8)) GRID_BAR();
    }
    STAMP(9);
    if (IN(9)) {
        pg8::Gemm g{U1, WOUT, MLAT, 1024, 1024}; pg8::StaticOrder S; S.init(MLAT, 1024, G, bid);
        pg8::Epi8 E{x, MOD, args.out};
        { pg8::RepOrder SR; SR.so = S; SR.reps = MK_REP_P9; pg8::gemm_phase<pg8::Epi8, pg8::RepOrder, true, true, MK_EPIW>((PG8_LAS unsigned char*)lds, g, SR, E); }
    }
    STAMP(10);
#if MK_TIMING
    if (bid == 0) { const unsigned spin = __builtin_amdgcn_readfirstlane(((const unsigned*)SSQ - 64)[MK_TSEL]); const unsigned long long t0_ = __builtin_amdgcn_s_memrealtime();
        while (__builtin_amdgcn_s_memrealtime() - t0_ < (unsigned long long)spin) __builtin_amdgcn_s_sleep(8); }
#endif
#if MK_STAMP_A >= 0
    __syncthreads();
    if (bid == 0) { __syncthreads(); const unsigned sp = ((volatile LAS unsigned*)(lds + MISC_OFF))[18] - ((volatile LAS unsigned*)(lds + MISC_OFF))[17]; const unsigned long long t0_ = __builtin_amdgcn_s_memrealtime();
        while (__builtin_amdgcn_s_memrealtime() - t0_ < (unsigned long long)sp) __builtin_amdgcn_s_sleep(8); }
#endif
#undef IN
#undef BOTH
}

extern "C" void kernel_launch(void* const* d_in, const int* in_sizes, int n_in, void* d_out, int out_size, void* d_ws, size_t ws_size, hipStream_t stream) {
    static int grid = 0;
    if (grid == 0) {
        if (n_in != 14 || in_sizes[0] != MLAT * DM || out_size != MLAT * DM || ws_size < WS_END) {
            fprintf(stderr, "kernel_launch: unexpected shapes: n_in %d in0 %d out %d ws %zu (need >= %zu)\n", n_in, n_in > 0 ? in_sizes[0] : -1, out_size, ws_size, (size_t)WS_END); grid = -1; return; }
        int dev = 0, cus = 0;
        if (hipGetDevice(&dev) != hipSuccess || hipDeviceGetAttribute(&cus, hipDeviceAttributeMultiprocessorCount, dev) != hipSuccess) { grid = -1; return; }
        if (hipFuncSetAttribute((const void*)mk_fwd, hipFuncAttributeMaxDynamicSharedMemorySize, LDS_BYTES) != hipSuccess) { fprintf(stderr, "kernel_launch: hipFuncSetAttribute failed\n"); grid = -1; return; }
        grid = cus;
    }
    if (grid < 0) return;
    Args a{};
    for (int i = 0; i < 14; ++i) a.in[i] = (const float*)d_in[i];
    a.out = (float*)d_out; a.ws = (unsigned char*)d_ws;
#if MK_ONE_LAUNCH
    a.ph_lo = 0; a.ph_hi = N_PHASES;
#if MK_BARRIER == 1
    if (hipMemsetAsync((char*)d_ws + WS_CTL, 0, CTL_ZERO_BYTES, stream) != hipSuccess) { fprintf(stderr, "kernel_launch: hipMemsetAsync failed\n"); return; }
    hipLaunchKernelGGL(mk_fwd, dim3(grid), dim3(NTHR), LDS_BYTES, stream, a);
#else
    void* kargs[] = {&a};
    const hipError_t ce = hipLaunchCooperativeKernel((const void*)mk_fwd, dim3(grid), dim3(NTHR), kargs, LDS_BYTES, stream);
    if (ce != hipSuccess) fprintf(stderr, "kernel_launch: cooperative launch failed: %s\n", hipGetErrorName(ce));
#endif
#else
    for (int ph = 0; ph < N_PHASES; ++ph) {
        a.ph_lo = ph; a.ph_hi = ph + 1;
        hipLaunchKernelGGL(mk_fwd, dim3(grid), dim3(NTHR), LDS_BYTES, stream, a);
    }
#endif
    const hipError_t le = hipPeekAtLastError();
    if (le != hipSuccess) fprintf(stderr, "kernel_launch: launch failed: %s\n", hipGetErrorName(le));
}
```

```cpp
#include <hip/hip_runtime.h>
#include <cstdio>
#include <cstdint>
#include <hip/hip_cooperative_groups.h>

constexpr int NB = 16, SEQ = 2048, DM = 1024, LC = 256, LT = LC + SEQ;
constexpr int MLAT = NB * SEQ, MCTX = NB * LC, MALL = MLAT + MCTX;
constexpr int RH = 4, RDK = 256, RDV = 512;
constexpr int AH = 8, AKV = 2, AHD = 128;
constexpr int NIN = 10752, NKV = 3584, N1 = 5632, NG = 5120;
constexpr float EPS = 1e-6f;
#ifndef MK_TIMING
#define MK_TIMING 0
#define MK_TSEL 0
#endif
#ifndef MK_WT
#define MK_WT 1
#endif
#ifndef MK_WT_AUX
#define MK_WT_AUX 18
#endif
#ifndef MK_FP8K
#define MK_FP8K 1
#endif
#ifndef MK_LMFMA
#define MK_LMFMA 1
#endif
#ifndef MK_MACC
#define MK_MACC 1
#endif
#ifndef MK_AG8
#define MK_AG8 1
#endif
#ifndef MK_FP8G
#define MK_FP8G 2
#endif
#ifndef MK_FP8V
#define MK_FP8V 1
#endif
#ifndef MK_E6B
#define MK_E6B 4
#define MK_E7B 2
#define MK_E8B 2
#endif
#ifndef MK_QPRE
#define MK_QPRE 0
#endif
#ifndef MK_RAWG
#define MK_RAWG 0
#endif
#ifndef MK_E67D
#define MK_E67D 0
#endif
#ifndef MK_E5D
#define MK_E5D 3
#endif
#ifndef MK_E5B
#define MK_E5B 1
#endif
#ifndef MK_P2PROBE
#define MK_P2PROBE 0
#endif
#ifndef MK_RPROBE
#define MK_RPROBE 0
#endif
#ifndef MK_DBG_NOCTX
#define MK_DBG_NOCTX 0
#endif
constexpr int NWAVES = 8, NTHR = 512;
#define LAS __attribute__((address_space(3)))

typedef unsigned short bf16_t;
typedef unsigned v4u __attribute__((ext_vector_type(4)));
typedef unsigned v2u __attribute__((ext_vector_type(2)));
typedef float v4f __attribute__((ext_vector_type(4)));
typedef float v2f __attribute__((ext_vector_type(2)));

__device__ __forceinline__ float bf2f(unsigned h) { return __uint_as_float(h << 16); }
__device__ __forceinline__ unsigned f2bf(float f) { unsigned u = __float_as_uint(f); return (u + 0x7fffu + ((u >> 16) & 1u)) >> 16; }
__device__ __forceinline__ unsigned pk2(float lo, float hi) { return f2bf(lo) | (f2bf(hi) << 16); }
__device__ __forceinline__ float bflo(unsigned w) { return __uint_as_float(w << 16); }
__device__ __forceinline__ float bfhi(unsigned w) { return __uint_as_float(w & 0xffff0000u); }
__device__ __forceinline__ float fast_sigmoid(float x) { return __builtin_amdgcn_rcpf(1.0f + __builtin_amdgcn_exp2f(-1.4426950408889634f * x)); }
__device__ __forceinline__ float fast_silu(float x) { return x * fast_sigmoid(x); }
__device__ __forceinline__ void sigmoid4(const float (&x)[4], float (&s)[4]) {
#pragma unroll
    for (int k = 0; k < 4; ++k) s[k] = __builtin_amdgcn_rcpf(1.0f + __builtin_amdgcn_exp2f(-1.4426950408889634f * x[k]));
}
__device__ __forceinline__ float sat8(float v) { return __builtin_amdgcn_fmed3f(v, -448.0f, 448.0f); }
__device__ __forceinline__ unsigned pk4_fp8(float a, float b, float c, float d) { int w = __builtin_amdgcn_cvt_pk_fp8_f32(sat8(a), sat8(b), 0, false); w = __builtin_amdgcn_cvt_pk_fp8_f32(sat8(c), sat8(d), w, true); return (unsigned)w; }
constexpr float F8W_MUL = 128.0f;  constexpr int F8W_SC = 0x78787878;
constexpr float F8Y_MUL = 64.0f;   constexpr int F8Y_SC = 0x79797979;
__device__ __forceinline__ float wave_sum(float v) {
#pragma unroll
    for (int o = 1; o < 64; o <<= 1) v += __shfl_xor(v, o);
    return v;
}

typedef __bf16 bf16x2_t __attribute__((ext_vector_type(2)));
__device__ __forceinline__ unsigned cvt_pk_bf16(float lo, float hi) { v2f v = {lo, hi}; bf16x2_t b = __builtin_convertvector(v, bf16x2_t); return __builtin_bit_cast(unsigned, b); }
__device__ __forceinline__ void unpack8(const v4u w, float (&o)[8]) {
    o[0] = bflo(w.x); o[1] = bfhi(w.x); o[2] = bflo(w.y); o[3] = bfhi(w.y); o[4] = bflo(w.z); o[5] = bfhi(w.z); o[6] = bflo(w.w); o[7] = bfhi(w.w);
}
__device__ __forceinline__ v4u pack8(const float (&o)[8]) {
    v4u w; w.x = cvt_pk_bf16(o[0], o[1]); w.y = cvt_pk_bf16(o[2], o[3]); w.z = cvt_pk_bf16(o[4], o[5]); w.w = cvt_pk_bf16(o[6], o[7]); return w;
}

constexpr size_t MiB = 1u << 20;
constexpr size_t WS_CTL = 0;
constexpr size_t WS_MOD = 1 * MiB;
constexpr size_t WS_ROPE = WS_MOD + 256 * 1024;
constexpr size_t WS_SSQ = 2 * MiB;
constexpr size_t WS_WIN = 4 * MiB;
constexpr size_t WS_WOR = 25 * MiB;
constexpr size_t WS_WOA = 29 * MiB;
constexpr size_t WS_WOUT = 31 * MiB;
constexpr size_t WS_HX = 33 * MiB;
constexpr size_t WS_RK = 105 * MiB;
constexpr size_t WS_RV = 177 * MiB;
constexpr size_t WS_RQ = 321 * MiB;
constexpr size_t WS_AK = 385 * MiB;
constexpr size_t WS_AV = 403 * MiB;
constexpr size_t WS_AQ = 421 * MiB;
constexpr size_t WS_K8 = 485 * MiB;
constexpr size_t WS_VT8 = 495 * MiB;
constexpr size_t WS_WOA8 = 505 * MiB;
constexpr size_t WS_WIN8 = 506 * MiB;
constexpr size_t WS_END = 509 * MiB;
constexpr size_t WS_Q8 = WS_AQ;
constexpr size_t WS_G8 = WS_AQ + 32 * MiB;
constexpr size_t WS_YA8 = WS_RQ;
constexpr size_t WS_U1 = WS_RK;
constexpr size_t WS_U2 = WS_RV;

__host__ __device__ __forceinline__ int orig_col(int n) { return n < 4608 ? n : (n < 5632 ? n + 2048 : (n < 7680 ? n - 1024 : n)); }
namespace pg8 {
#define PG8_LAS __attribute__((address_space(3)))
typedef unsigned short bf16_t;
typedef short bf16x8 __attribute__((ext_vector_type(8)));
typedef float f32x4 __attribute__((ext_vector_type(4)));
typedef unsigned u32x4 __attribute__((ext_vector_type(4)));
constexpr int BM = 256, BK = 64, HALF = 128, HTB = HALF * BK * 2  , STAGE_BYTES = 8 * HTB, NXCD = 8, WGM = 8;

__host__ __device__ __forceinline__ int lds_byte(int r, int c) { const int st = (r >> 4) * 2 + (c >> 5), rr = r & 15, cc = c & 31, ob = rr * 64 + cc * 2; return st * 1024 + (ob ^ (((ob >> 9) & 1) << 5)); }
__host__ __device__ __forceinline__ void stage_rc(int b, int& R, int& C) { const int st = b / 1024, sb = b % 1024, swz = sb ^ (((sb >> 9) & 1) << 5); R = (st >> 1) * 16 + swz / 64; C = (st & 1) * 32 + (swz % 64) / 2; }
__host__ __device__ __forceinline__ int perm32(int rho) { const int n = rho >> 4, i = rho & 15; return 8 * (i >> 2) + 4 * n + (i & 3); }

struct Unit { int pm, pn; };
struct Gemm { const bf16_t* A; const bf16_t* Bt; int M, N, K; int scA = 0x7F7F7F7F, scB = 0x7F7F7F7F; };

struct StaticOrder {
    int nM, nN, nwg, G, c;
    __host__ __device__ void init(int M, int N, int G_, int c_) { nM = M / BM; nN = N / BM; nwg = nM * nN; G = G_; c = c_; }
    __host__ __device__ bool next(int i, Unit& u) const {
        const long L = (long)i * G + c; if (L >= nwg) return false;
        int wgid = (int)L; { const int q = nwg / NXCD, r = nwg % NXCD, xcd = wgid % NXCD, off = wgid / NXCD; wgid = (xcd < r ? xcd * (q + 1) : r * (q + 1) + (xcd - r) * q) + off; }
        const int nig = WGM * nN, gid = wgid / nig, fm = gid * WGM, gsz = (nM - fm) < WGM ? (nM - fm) : WGM;
        u.pm = fm + ((wgid % nig) % gsz); u.pn = (wgid % nig) / gsz; return true;
    }
    __device__ __forceinline__ void a_ready(const Unit&) const {}
    __device__ __forceinline__ void done(const Unit&) const {}
};


#if MK_WT
#define WT_RSRC(name, baseptr) const __amdgpu_buffer_rsrc_t name = __builtin_amdgcn_make_buffer_rsrc((void*)(baseptr), 0, 0x7ffffff0, 0x00020000)
#define WT_ST16(name, byteoff, val) __builtin_amdgcn_raw_buffer_store_b128((val), name, (unsigned)(byteoff), 0, MK_WT_AUX)
#endif
struct Sched1 {
    int G, c; StaticOrder so;
    __device__ void init(int G_, int c_) { G = G_; c = c_; so.init(MLAT, N1, G_, c_); }
    __device__ bool next(int i, Unit& u) const {
        long L = (long)i * G + c; if (L < 2816) return so.next(i, u);
        L -= 2816; if (L >= 224) return false;
        u.pm = 128 + (int)(L & 15); u.pn = (int)(L >> 4); return true;
    }
    __device__ __forceinline__ void a_ready(const Unit&) const {}
    __device__ __forceinline__ void done(const Unit&) const {}
};

struct SchedG1 {
    StaticOrder so; int G, c, mode, nlat, nctx, ncol;
    __device__ void init(int G_, int c_, int mode_) { G = G_; c = c_; mode = mode_; ncol = mode_ ? (MK_AG8 ? 10 : 6) : 16; so.init(MLAT, ncol * 256, G_, c_); nlat = 128 * ncol; nctx = mode_ ? 0 : 16 * 14; }
    __device__ bool next(int i, Unit& u) const {
        long L = (long)i * G + c;
        if (L < nlat) { so.next(i, u); if (!mode) u.pn = u.pn < 12 ? u.pn : u.pn + 2; return true; }
        L -= nlat; if (L >= nctx) return false;
        u.pm = 128 + (int)(L & 15); u.pn = (int)(L >> 4); return true;
    }
    __device__ __forceinline__ void a_ready(const Unit&) const {}
    __device__ __forceinline__ void done(const Unit&) const {}
};
struct SchedGates {
    StaticOrder so; int mode;
    __device__ void init(int G_, int c_, int mode_) { mode = mode_; so.init(MLAT, (mode_ ? 4 : 16) * 256, G_, c_); }
    __device__ bool next(int i, Unit& u) const { if (!so.next(i, u)) return false; u.pn = mode ? u.pn + 8 : (u.pn < 8 ? u.pn : u.pn + 4); return true; }
    __device__ __forceinline__ void a_ready(const Unit&) const {}
    __device__ __forceinline__ void done(const Unit&) const {}
};
struct RepOrder {
    StaticOrder so; int reps;
    __device__ bool next(int i, Unit& u) const { const int per = (so.nwg - so.c + so.G - 1) / so.G; if (i >= per * reps) return false; return so.next(i % per, u); }
    __device__ __forceinline__ void a_ready(const Unit&) const {}
    __device__ __forceinline__ void done(const Unit&) const {}
};

#define EPI_ROWS_BEGIN const int rt0 = wr * 64 + fr, ct0 = wc * 32 + 8 * fq; \
    _Pragma("unroll") for (int ai = 0; ai < 2; ++ai) _Pragma("unroll") for (int m = 0; m < 4; ++m) { const int rt = rt0 + ai * HALF + m * 16;
#define EPI_ROWS_END }

template <int DUM> struct Epi1T {
    static constexpr bool PERM = true, AFTER_DRAIN = false;
    bf16_t *RK, *RV, *AK, *AV, *RQ, *AQ; bf16_t* DUMMY;
    __device__ __forceinline__ void operator()(const f32x4 (&acc)[2][2][4][2], const Unit& u, int wr, int wc, int fr, int fq) const {
        const int pm = u.pm, pn = u.pn;
        const int kvrow0 = pm < 128 ? ((pm >> 3) * LT + LC + (pm & 7) * 256) : ((pm - 128) * LT);
        bf16_t* base; int ld; float sc = 1.f;
        if (pn < 4) { base = RK + (size_t)kvrow0 * 1024 + pn * 256; ld = 1024; sc = 0.0625f; }
        else if (pn < 12) { base = RV + (size_t)kvrow0 * 2048 + (pn - 4) * 256; ld = 2048; }
        else if (pn == 12) { base = AK + (size_t)kvrow0 * 256; ld = 256; }
        else if (pn == 13) { base = AV + (size_t)kvrow0 * 256; ld = 256; }
        else if (pn < 18) { base = RQ + (size_t)pm * 256 * 1024 + (pn - 14) * 256; ld = 1024; }
        else { base = AQ + (size_t)pm * 256 * 1024 + (pn - 18) * 256; ld = 1024; }
#if MK_P2PROBE
        if constexpr (DUM == 1) { base = DUMMY + (size_t)blockIdx.x * 32768; ld = 256; }
        if constexpr (DUM == 2) {
            const int rb = kvrow0 >> 8;
            if (pn < 4) base = RK + ((size_t)rb * 4 + pn) * 65536; else if (pn < 12) base = RV + ((size_t)rb * 8 + (pn - 4)) * 65536;
            else if (pn < 14) { } else if (pn < 18) base = RQ + ((size_t)pm * 4 + (pn - 14)) * 65536; else base = AQ + ((size_t)pm * 4 + (pn - 18)) * 65536;
            ld = 256; }
#endif
#if (MK_WT & 1)
        const __amdgpu_buffer_rsrc_t rs = __builtin_amdgcn_make_buffer_rsrc((void*)base, 0, 0x7ffffff0, 0x00020000);
#endif
        EPI_ROWS_BEGIN
            bf16_t* rowp = base + (size_t)(DUM == 1 ? (rt & 127) : rt) * ld + ct0;
#pragma unroll
            for (int bj = 0; bj < 2; ++bj) { const f32x4 v0 = acc[ai][bj][m][0] * sc, v1 = acc[ai][bj][m][1] * sc;
                u32x4 w; w.x = cvt_pk_bf16(v0[0], v0[1]); w.y = cvt_pk_bf16(v0[2], v0[3]); w.z = cvt_pk_bf16(v1[0], v1[1]); w.w = cvt_pk_bf16(v1[2], v1[3]);
#if (MK_WT & 1)
                __builtin_amdgcn_raw_buffer_store_b128(w, rs, (unsigned)(((DUM == 1 ? (rt & 127) : rt) * ld + ct0 + bj * HALF) * 2), 0, MK_WT_AUX);
#else
                *(u32x4*)(rowp + bj * HALF) = w;
#endif
                }
        EPI_ROWS_END
    }
};

typedef Epi1T<0> Epi1;
struct Epi1F8 {
    static constexpr bool PERM = true, AFTER_DRAIN = false;
    Epi1 e; unsigned char *Q8, *G8;
    __device__ __forceinline__ void operator()(const f32x4 (&acc)[2][2][4][2], const Unit& u, int wr, int wc, int fr, int fq) const {
#if MK_AG8
        if (u.pn < 2) { Unit v = u; v.pn = 12 + u.pn; e(acc, v, wr, wc, fr, fq); return; }
        const bool isg = u.pn >= 6;
        unsigned char* base8 = (isg ? G8 + (u.pn - 6) * 256 : Q8 + (u.pn - 2) * 256) + (size_t)u.pm * 256 * 1024;
        EPI_ROWS_BEGIN
#pragma unroll
            for (int bj = 0; bj < 2; ++bj) { const f32x4 v0 = acc[ai][bj][m][0], v1 = acc[ai][bj][m][1]; float o[8] = {v0[0], v0[1], v0[2], v0[3], v1[0], v1[1], v1[2], v1[3]};
                if (isg) { const float x0[4] = {o[0], o[1], o[2], o[3]}, x1[4] = {o[4], o[5], o[6], o[7]}; float s0[4], s1[4]; sigmoid4(x0, s0); sigmoid4(x1, s1);
#pragma unroll
                    for (int k = 0; k < 4; ++k) { o[k] = x0[k] * s0[k] * F8Y_MUL; o[4 + k] = x1[k] * s1[k] * F8Y_MUL; } }
                v2u w; w.x = pk4_fp8(o[0], o[1], o[2], o[3]); w.y = pk4_fp8(o[4], o[5], o[6], o[7]);
                *(v2u*)(base8 + (size_t)rt * 1024 + ct0 + bj * HALF) = w; }
        EPI_ROWS_END
#else
        Unit v = u; v.pn = u.pn < 2 ? 12 + u.pn : 16 + u.pn; e(acc, v, wr, wc, fr, fq);
#endif
    }
};
#define EPI_FOR_PIECES _Pragma("unroll") for (int ai = 0; ai < 2; ++ai) _Pragma("unroll") for (int m = 0; m < 4; ++m) _Pragma("unroll") for (int bj = 0; bj < 2; ++bj)
struct Epi5 {
    static constexpr bool PERM = true, AFTER_DRAIN = false;
    bf16_t *YR, *YA, *U1, *U2; const float* SSQ; int dry_unused; unsigned char* YA8;
    __device__ __forceinline__ void operator()(const f32x4 (&acc)[2][2][4][2], const Unit& u, int wr, int wc, int fr, int fq) const {
        const int pn = u.pn; const size_t row0 = (size_t)u.pm * 256;
        if (pn < 8) {
            const int head = pn >> 1; const int rt0 = wr * 64 + fr, ct0 = wc * 32 + 8 * fq;
            u32x4 pc[8][2]; float sa[8], sb[8];
#define E5_LOAD(r_) do { const size_t row_ = row0 + rt0 + ((r_) >> 2) * HALF + ((r_) & 3) * 16; sa[r_] = SSQ[row_ * 8 + head * 2]; sb[r_] = SSQ[row_ * 8 + head * 2 + 1]; \
                pc[r_][0] = *(const u32x4*)(YR + row_ * 2048 + pn * 256 + ct0); pc[r_][1] = *(const u32x4*)(YR + row_ * 2048 + pn * 256 + HALF + ct0); } while (0)
#pragma unroll
            for (int r = 0; r < MK_E5D; ++r) E5_LOAD(r);
#pragma unroll
            for (int r = 0; r < 8; ++r) { const int ai = r >> 2, m = r & 3; const size_t row = row0 + rt0 + ai * HALF + m * 16;
                if (r + MK_E5D < 8) E5_LOAD(r + MK_E5D);
                __builtin_amdgcn_sched_barrier(0);
                const float rstd = __builtin_amdgcn_rsqf((sa[r] + sb[r]) * (1.0f / 512.0f) + EPS);
#pragma unroll
                for (int bj = 0; bj < 2; ++bj) { float o[8]; unpack8(pc[r][bj], o);
                    const f32x4 v0 = acc[ai][bj][m][0], v1 = acc[ai][bj][m][1];
                    { const float x0[4] = {v0[0], v0[1], v0[2], v0[3]}, x1[4] = {v1[0], v1[1], v1[2], v1[3]}; float s0[4], s1[4]; sigmoid4(x0, s0); sigmoid4(x1, s1);
#pragma unroll
                    for (int k = 0; k < 4; ++k) { o[k] = o[k] * rstd * (x0[k] * s0[k]); o[4 + k] = o[4 + k] * rstd * (x1[k] * s1[k]); } }
                    *(u32x4*)(YR + row * 2048 + pn * 256 + bj * HALF + ct0) = pack8(o); }
                __builtin_amdgcn_sched_barrier(0); }
#undef E5_LOAD
        } else if (pn < 12) {
            const int rt0 = wr * 64 + fr, ct0 = wc * 32 + 8 * fq;
            u32x4 pc[8][2];
#define E5A_LOAD(r_) do { const size_t row_ = row0 + rt0 + ((r_) >> 2) * HALF + ((r_) & 3) * 16; \
                pc[r_][0] = *(const u32x4*)(YA + row_ * 1024 + (pn - 8) * 256 + ct0); pc[r_][1] = *(const u32x4*)(YA + row_ * 1024 + (pn - 8) * 256 + HALF + ct0); } while (0)
#pragma unroll
            for (int r = 0; r < MK_E5D; ++r) E5A_LOAD(r);
#pragma unroll
            for (int r = 0; r < 8; ++r) { const int ai = r >> 2, m = r & 3; const size_t row = row0 + rt0 + ai * HALF + m * 16;
                if (r + MK_E5D < 8) E5A_LOAD(r + MK_E5D);
                __builtin_amdgcn_sched_barrier(0);
#pragma unroll
                for (int bj = 0; bj < 2; ++bj) { float o[8]; unpack8(pc[r][bj], o);
                    const f32x4 v0 = acc[ai][bj][m][0], v1 = acc[ai][bj][m][1];
                    { const float x0[4] = {v0[0], v0[1], v0[2], v0[3]}, x1[4] = {v1[0], v1[1], v1[2], v1[3]}; float s0[4], s1[4]; sigmoid4(x0, s0); sigmoid4(x1, s1);
#pragma unroll
                    for (int k = 0; k < 4; ++k) { o[k] = o[k] * (x0[k] * s0[k]); o[4 + k] = o[4 + k] * (x1[k] * s1[k]); } }
#if MK_FP8G
                    { v2u w; w.x = pk4_fp8(o[0] * F8Y_MUL, o[1] * F8Y_MUL, o[2] * F8Y_MUL, o[3] * F8Y_MUL); w.y = pk4_fp8(o[4] * F8Y_MUL, o[5] * F8Y_MUL, o[6] * F8Y_MUL, o[7] * F8Y_MUL);
                      *(v2u*)(YA8 + row * 1024 + (pn - 8) * 256 + bj * HALF + ct0) = w; }
#else
                    *(u32x4*)(YA + row * 1024 + (pn - 8) * 256 + bj * HALF + ct0) = pack8(o);
#endif
                    }
                __builtin_amdgcn_sched_barrier(0); }
#undef E5A_LOAD
        } else {
            bf16_t* U = pn < 16 ? U1 + (pn - 12) * 256 : U2 + (pn - 16) * 256;
            EPI_ROWS_BEGIN
                const size_t row = row0 + rt;
#pragma unroll
                for (int bj = 0; bj < 2; ++bj) { float o[8]; const f32x4 v0 = acc[ai][bj][m][0], v1 = acc[ai][bj][m][1];
#if MK_RAWG
                    { o[0] = v0[0]; o[1] = v0[1]; o[2] = v0[2]; o[3] = v0[3]; o[4] = v1[0]; o[5] = v1[1]; o[6] = v1[2]; o[7] = v1[3]; }
#else
                    { const float x0[4] = {v0[0], v0[1], v0[2], v0[3]}, x1[4] = {v1[0], v1[1], v1[2], v1[3]}; float s0[4], s1[4]; sigmoid4(x0, s0); sigmoid4(x1, s1);
#pragma unroll
                    for (int k = 0; k < 4; ++k) { o[k] = s0[k]; o[4 + k] = s1[k]; } }
#endif
                    *(u32x4*)(U + row * 1024 + bj * HALF + ct0) = pack8(o); }
            EPI_ROWS_END
        }
    }
};

struct Epi6 {
    static constexpr bool PERM = true, AFTER_DRAIN = false;
    bf16_t* U1;
    __device__ __forceinline__ void operator()(const f32x4 (&acc)[2][2][4][2], const Unit& u, int wr, int wc, int fr, int fq) const {
        bf16_t* base = U1 + ((size_t)u.pm * 256 + wr * 64 + fr) * 1024 + u.pn * 256 + wc * 32 + 8 * fq;
#if (MK_WT & 2)
        WT_RSRC(rs, U1 + (size_t)u.pm * 256 * 1024 + u.pn * 256);
#endif
#if MK_E67D > 0
        u32x4 pc[8][2];
#define E6_LOAD(r_) do { pc[r_][0] = *(const u32x4*)(base + (size_t)(((r_) >> 2) * HALF + ((r_) & 3) * 16) * 1024); pc[r_][1] = *(const u32x4*)(base + (size_t)(((r_) >> 2) * HALF + ((r_) & 3) * 16) * 1024 + HALF); } while (0)
#pragma unroll
        for (int r = 0; r < MK_E67D; ++r) E6_LOAD(r);
#pragma unroll
        for (int r = 0; r < 8; ++r) { const int ai = r >> 2, m = r & 3;
            if (r + MK_E67D < 8) E6_LOAD(r + MK_E67D);
            __builtin_amdgcn_sched_barrier(0);
#pragma unroll
            for (int bj = 0; bj < 2; ++bj) { float o[8]; unpack8(pc[r][bj], o); const f32x4 v0 = acc[ai][bj][m][0], v1 = acc[ai][bj][m][1];
#pragma unroll
                for (int k = 0; k < 4; ++k) { o[k] *= v0[k]; o[4 + k] *= v1[k]; }
                *(u32x4*)(base + (size_t)(ai * HALF + m * 16) * 1024 + bj * HALF) = pack8(o); }
            __builtin_amdgcn_sched_barrier(0); }
#undef E6_LOAD
#else
#pragma unroll
        for (int ai = 0; ai < 2; ++ai)
#pragma unroll
          for (int mb = 0; mb < 4; mb += MK_E6B) {
            u32x4 pc[MK_E6B][2];
#pragma unroll
            for (int mi = 0; mi < MK_E6B; ++mi)
#pragma unroll
                for (int bj = 0; bj < 2; ++bj) pc[mi][bj] = *(const u32x4*)(base + (size_t)(ai * HALF + (mb + mi) * 16) * 1024 + bj * HALF);
#pragma unroll
            for (int mi = 0; mi < MK_E6B; ++mi)
#pragma unroll
                for (int bj = 0; bj < 2; ++bj) { const int m = mb + mi; float o[8]; unpack8(pc[mi][bj], o); const f32x4 v0 = acc[ai][bj][m][0], v1 = acc[ai][bj][m][1];
#if MK_RAWG
                    { const float x0[4] = {o[0], o[1], o[2], o[3]}, x1[4] = {o[4], o[5], o[6], o[7]}; float s0[4], s1[4]; sigmoid4(x0, s0); sigmoid4(x1, s1);
#pragma unroll
                      for (int k = 0; k < 4; ++k) { o[k] = s0[k]; o[4 + k] = s1[k]; } }
#endif
#pragma unroll
                    for (int k = 0; k < 4; ++k) { o[k] *= v0[k]; o[4 + k] *= v1[k]; }
                    *(u32x4*)(base + (size_t)(ai * HALF + m * 16) * 1024 + bj * HALF) = pack8(o); }
          }
#endif
    }
};
struct Epi7 {
    static constexpr bool PERM = true, AFTER_DRAIN = false;
    bf16_t* U1; const bf16_t* U2;
    __device__ __forceinline__ void operator()(const f32x4 (&acc)[2][2][4][2], const Unit& u, int wr, int wc, int fr, int fq) const {
        const size_t off0 = ((size_t)u.pm * 256 + wr * 64 + fr) * 1024 + u.pn * 256 + wc * 32 + 8 * fq;
#if (MK_WT & 4)
        WT_RSRC(rs, U1 + (size_t)u.pm * 256 * 1024 + u.pn * 256);
#endif
#if MK_E67D > 0
        u32x4 pc[8][2], pg[8][2];
#define E7_LOAD(r_) do { _Pragma("unroll") for (int bj_ = 0; bj_ < 2; ++bj_) { const size_t off_ = off0 + (size_t)(((r_) >> 2) * HALF + ((r_) & 3) * 16) * 1024 + bj_ * HALF; pc[r_][bj_] = *(const u32x4*)(U1 + off_); pg[r_][bj_] = *(const u32x4*)(U2 + off_); } } while (0)
#pragma unroll
        for (int r = 0; r < MK_E67D; ++r) E7_LOAD(r);
#pragma unroll
        for (int r = 0; r < 8; ++r) { const int ai = r >> 2, m = r & 3;
            if (r + MK_E67D < 8) E7_LOAD(r + MK_E67D);
            __builtin_amdgcn_sched_barrier(0);
#pragma unroll
            for (int bj = 0; bj < 2; ++bj) { const size_t off = off0 + (size_t)(ai * HALF + m * 16) * 1024 + bj * HALF; float o[8], g[8]; unpack8(pc[r][bj], o); unpack8(pg[r][bj], g);
                const f32x4 v0 = acc[ai][bj][m][0], v1 = acc[ai][bj][m][1];
#pragma unroll
                for (int k = 0; k < 4; ++k) { o[k] += g[k] * v0[k]; o[4 + k] += g[4 + k] * v1[k]; }
                *(u32x4*)(U1 + off) = pack8(o); }
            __builtin_amdgcn_sched_barrier(0); }
#undef E7_LOAD
#else
#pragma unroll
        for (int q4 = 0; q4 < 8; q4 += MK_E7B) {
            const int ai = q4 >> 2, mb = q4 & 3; u32x4 pc[MK_E7B][2], pg[MK_E7B][2];
#pragma unroll
            for (int m2 = 0; m2 < MK_E7B; ++m2)
#pragma unroll
                for (int bj = 0; bj < 2; ++bj) { const size_t off = off0 + (size_t)(ai * HALF + (mb + m2) * 16) * 1024 + bj * HALF; pc[m2][bj] = *(const u32x4*)(U1 + off); pg[m2][bj] = *(const u32x4*)(U2 + off); }
#pragma unroll
            for (int m2 = 0; m2 < MK_E7B; ++m2)
#pragma unroll
                for (int bj = 0; bj < 2; ++bj) { const int m = mb + m2; const size_t off = off0 + (size_t)(ai * HALF + m * 16) * 1024 + bj * HALF; float o[8], g[8]; unpack8(pc[m2][bj], o); unpack8(pg[m2][bj], g);
                    const f32x4 v0 = acc[ai][bj][m][0], v1 = acc[ai][bj][m][1];
#if MK_RAWG
                    { const float x0[4] = {g[0], g[1], g[2], g[3]}, x1[4] = {g[4], g[5], g[6], g[7]}; float s0[4], s1[4]; sigmoid4(x0, s0); sigmoid4(x1, s1);
#pragma unroll
                      for (int k = 0; k < 4; ++k) { g[k] = s0[k]; g[4 + k] = s1[k]; } }
#endif
#pragma unroll
                    for (int k = 0; k < 4; ++k) { o[k] += g[k] * v0[k]; o[4 + k] += g[4 + k] * v1[k]; }
                    *(u32x4*)(U1 + off) = pack8(o); }
        }
#endif
    }
};
struct Epi8 {
    static constexpr bool PERM = true, AFTER_DRAIN = false;
    const float* X; const float* MOD; float* OUT;
    __device__ __forceinline__ void operator()(const f32x4 (&acc)[2][2][4][2], const Unit& u, int wr, int wc, int fr, int fq) const {
        const int col0 = u.pn * 256 + wc * 32 + 8 * fq; const size_t off0 = ((size_t)u.pm * 256 + wr * 64 + fr) * 1024 + col0; const float* gate = MOD + (size_t)(u.pm >> 3) * 3072 + 2048 + col0;
        f32x4 gv[2][2];
#if (MK_WT & 8)
        WT_RSRC(rs, OUT + (size_t)u.pm * 256 * 1024 + u.pn * 256);
#endif
#pragma unroll
        for (int bj = 0; bj < 2; ++bj)
#pragma unroll
            for (int n = 0; n < 2; ++n) gv[bj][n] = *(const f32x4*)(gate + bj * HALF + 4 * n);
#pragma unroll
        for (int q4 = 0; q4 < 8; q4 += MK_E8B) {
            const int ai = q4 >> 2, mb = q4 & 3; f32x4 xv[MK_E8B][2][2];
#pragma unroll
            for (int m2 = 0; m2 < MK_E8B; ++m2)
#pragma unroll
                for (int bj = 0; bj < 2; ++bj)
#pragma unroll
                    for (int n = 0; n < 2; ++n) xv[m2][bj][n] = *(const f32x4*)(X + off0 + (size_t)(ai * HALF + (mb + m2) * 16) * 1024 + bj * HALF + 4 * n);
#pragma unroll
            for (int m2 = 0; m2 < MK_E8B; ++m2)
#pragma unroll
                for (int bj = 0; bj < 2; ++bj)
#pragma unroll
                    for (int n = 0; n < 2; ++n) *(f32x4*)(OUT + off0 + (size_t)(ai * HALF + (mb + m2) * 16) * 1024 + bj * HALF + 4 * n) = xv[m2][bj][n] + gv[bj][n] * acc[ai][bj][mb + m2][n];
        }
    }
};
struct EpiNull {
    static constexpr bool PERM = true, AFTER_DRAIN = false;
    __device__ __forceinline__ void operator()(const f32x4 (&acc)[2][2][4][2], const Unit& u, int wr, int wc, int fr, int fq) const {
#pragma unroll
        for (int ai = 0; ai < 2; ++ai)
#pragma unroll
            for (int bj = 0; bj < 2; ++bj)
#pragma unroll
                for (int m = 0; m < 4; ++m)
#pragma unroll
                    for (int n = 0; n < 2; ++n) asm volatile("" :: "v"(acc[ai][bj][m][n]));
    }
};
template <int N> __device__ __forceinline__ void wait_vm_sel(int sel) { asm volatile("s_waitcnt vmcnt(%1)\n\ts_cmp_lg_u32 %0, 0\n\ts_cbranch_scc1 .Lwvs%=\n\ts_waitcnt vmcnt(8)\n.Lwvs%=:" :: "s"(sel), "n"(N) : "memory", "scc"); }
typedef int v8i_t __attribute__((ext_vector_type(8))); typedef int v4i_t __attribute__((ext_vector_type(4)));
__device__ __forceinline__ v8i_t cat8(const bf16x8 lo, const bf16x8 hi) { const v4i_t a = __builtin_bit_cast(v4i_t, lo), b = __builtin_bit_cast(v4i_t, hi); return (v8i_t){a.x, a.y, a.z, a.w, b.x, b.y, b.z, b.w}; }
__device__ __forceinline__ void mx16(f32x4& c, const v8i_t a, const v8i_t b, const int sca, const int scb) {
    asm volatile("v_mfma_scale_f32_16x16x128_f8f6f4 %0, %1, %2, %0, %3, %4 op_sel_hi:[0,0,0]" : "+v"(c) : "v"(a), "v"(b), "v"(sca), "v"(scb)); }
template <class Epi, class Sched, bool ALIGN_EPI = false, bool SP2 = false, int EPIW = 0, bool F8 = false>
__device__ __forceinline__ void gemm_phase(PG8_LAS unsigned char* lds, const Gemm g, const Sched& S, const Epi& E) {
    const int tid = threadIdx.x, wid = __builtin_amdgcn_readfirstlane(tid >> 6), lane = tid & 63, wr = wid >> 2, wc = wid & 3, fr = lane & 15, fq = lane >> 4;
    int Kv = g.K; if constexpr (F8) asm volatile("" : "+s"(Kv));
    const int K = Kv, nt = K / BK;
    int mxsa = g.scA, mxsb = g.scB; if constexpr (F8) asm volatile("" : "+v"(mxsa), "+v"(mxsb));
    unsigned voffA[2], voffB[2];
#pragma unroll
    for (int i = 0; i < 2; ++i) { int R, C; stage_rc(tid * 16 + i * 8192, R, C); const int Rb = Epi::PERM ? ((R & ~31) + perm32(R & 31)) : R;
        voffA[i] = (unsigned)(R * K + C) * 2u; voffB[i] = (unsigned)(Rb * K + C) * 2u; }
    const size_t kstep = (size_t)(BK * 2);
    const size_t hstep = (size_t)HALF * K * 2;
    const size_t tstep = 2 * hstep;
    const unsigned ldsw = (unsigned)wid * 1024u;
    const int aoff = lds_byte(wr * 64 + fr, fq * 8), boff = lds_byte(wc * 32 + fr, fq * 8);
#define PG8_SA(b, h) (((b) * 2 + (h)) * HTB)
#define PG8_SB(b, h) ((4 + (b) * 2 + (h)) * HTB)
#define PG8_STAGE(bufoff, gbase, voff) do { _Pragma("unroll") for (int _i = 0; _i < 2; ++_i) \
        __builtin_amdgcn_global_load_lds((const unsigned*)((const char*)(gbase) + (voff)[_i]), (PG8_LAS unsigned*)(lds + (bufoff) + ldsw + _i * 8192), 16, 0, 0); } while (0)
#define PG8_LDA(dst, b, h) do { _Pragma("unroll") for (int m = 0; m < 4; ++m) _Pragma("unroll") for (int k = 0; k < 2; ++k) dst[m][k] = *(const PG8_LAS bf16x8*)(lds + PG8_SA(b, h) + aoff + m * 2048 + k * 1024); } while (0)
#define PG8_LDB(dst, b, h) do { _Pragma("unroll") for (int n = 0; n < 2; ++n) _Pragma("unroll") for (int k = 0; k < 2; ++k) dst[n][k] = *(const PG8_LAS bf16x8*)(lds + PG8_SB(b, h) + boff + n * 2048 + k * 1024); } while (0)
#define PG8_MMA(ai, bj, At, Bt) do { __builtin_amdgcn_s_setprio(1); \
        if constexpr (F8) { _Pragma("unroll") for (int m = 0; m < 4; ++m) _Pragma("unroll") for (int n = 0; n < 2; ++n) \
            mx16(acc[ai][bj][m][n], cat8(Bt[n][0], Bt[n][1]), cat8(At[m][0], At[m][1]), mxsb, mxsa); } \
        else { _Pragma("unroll") for (int m = 0; m < 4; ++m) _Pragma("unroll") for (int n = 0; n < 2; ++n) _Pragma("unroll") for (int k = 0; k < 2; ++k) \
            acc[ai][bj][m][n] = __builtin_amdgcn_mfma_f32_16x16x32_bf16(Bt[n][k], At[m][k], acc[ai][bj][m][n], 0, 0, 0); } \
        __builtin_amdgcn_s_setprio(0); } while (0)
#define PG8_WAIT_V(n) asm volatile("s_waitcnt vmcnt(" #n ")" ::: "memory")
#define PG8_WAIT_L(n) asm volatile("s_waitcnt lgkmcnt(" #n ")" ::: "memory")
#define PG8_BAR __builtin_amdgcn_s_barrier()
#define PG8_SCHED __builtin_amdgcn_sched_barrier(0)
    Unit cur, nxt; int ui = 0;
    if (!S.next(0, cur)) return;
    f32x4 acc[2][2][4][2];
#pragma unroll
    for (int a = 0; a < 2; ++a)
#pragma unroll
        for (int b = 0; b < 2; ++b)
#pragma unroll
            for (int m = 0; m < 4; ++m)
#pragma unroll
                for (int n = 0; n < 2; ++n) acc[a][b][m][n] = (f32x4){0.f, 0.f, 0.f, 0.f};
    bf16x8 At[4][2], B0[2][2], B1[2][2];
    const char* cA = (const char*)g.A + (size_t)cur.pm * tstep; const char* cB = (const char*)g.Bt + (size_t)cur.pn * tstep;
    S.a_ready(cur);
    if constexpr (SP2) {
        PG8_STAGE(PG8_SB(0, 0), cB, voffB); PG8_STAGE(PG8_SB(0, 1), cB + hstep, voffB); PG8_STAGE(PG8_SA(0, 0), cA, voffA); PG8_STAGE(PG8_SA(0, 1), cA + hstep, voffA);
        if (wr == 1) PG8_BAR;
        PG8_WAIT_V(2); PG8_BAR;
        PG8_STAGE(PG8_SB(1, 0), cB + kstep, voffB); PG8_STAGE(PG8_SA(1, 0), cA + kstep, voffA); PG8_STAGE(PG8_SB(1, 1), cB + hstep + kstep, voffB);
        PG8_WAIT_V(6); PG8_BAR;
    } else {
        PG8_STAGE(PG8_SB(0, 0), cB, voffB); PG8_STAGE(PG8_SA(0, 0), cA, voffA); PG8_STAGE(PG8_SB(0, 1), cB + hstep, voffB); PG8_STAGE(PG8_SA(0, 1), cA + hstep, voffA);
        if (wr == 1) PG8_BAR;
        PG8_WAIT_V(4); PG8_BAR;
        PG8_STAGE(PG8_SB(1, 0), cB + kstep, voffB); PG8_STAGE(PG8_SA(1, 0), cA + kstep, voffA); PG8_STAGE(PG8_SB(1, 1), cB + hstep + kstep, voffB);
        PG8_WAIT_V(6); PG8_BAR;
    }
    for (;;) {
        const bool has_next = S.next(ui + 1, nxt);
        const char* nA = has_next ? (const char*)g.A + (size_t)nxt.pm * tstep : cA; const char* nB = has_next ? (const char*)g.Bt + (size_t)nxt.pn * tstep : cB;
        for (int t = 0; t < nt; t += 2) {
            const bool last = (t == nt - 2);
            const char* a1 = cA + (size_t)(t + 1) * kstep;
            const char* a2 = last ? nA : cA + (size_t)(t + 2) * kstep; const char* b2 = last ? nB : cB + (size_t)(t + 2) * kstep;
            const char* a3 = a2 + kstep; const char* b3 = b2 + kstep;
            if (last && has_next) S.a_ready(nxt);
            const int fe = __builtin_amdgcn_readfirstlane(((EPIW > 0) && (t == 0) && (ui > 0)) ? 1 : 0);
            if constexpr (SP2) {
            PG8_LDB(B0, 0, 0); PG8_LDB(B1, 0, 1); PG8_SCHED; PG8_LDA(At, 0, 0); PG8_STAGE(PG8_SA(1, 1), a1 + hstep, voffA);
            if constexpr (EPIW > 0) wait_vm_sel<8 + EPIW>(fe); else PG8_WAIT_V(8); PG8_WAIT_L(0); PG8_BAR; PG8_MMA(0, 0, At, B0); PG8_MMA(0, 1, At, B1); PG8_BAR; PG8_SCHED;
            PG8_LDA(At, 0, 1); PG8_STAGE(PG8_SB(0, 0), b2, voffB); PG8_STAGE(PG8_SB(0, 1), b2 + hstep, voffB); PG8_STAGE(PG8_SA(0, 0), a2, voffA);
            if constexpr (EPIW > 0) wait_vm_sel<8 + EPIW>(fe); else PG8_WAIT_V(8); PG8_WAIT_L(0); PG8_BAR; PG8_MMA(1, 0, At, B0); PG8_MMA(1, 1, At, B1); PG8_BAR; PG8_SCHED;
            PG8_LDB(B0, 1, 0); PG8_LDB(B1, 1, 1); PG8_SCHED; PG8_LDA(At, 1, 0); PG8_STAGE(PG8_SA(0, 1), a2 + hstep, voffA);
            PG8_WAIT_V(8); PG8_WAIT_L(0); PG8_BAR; PG8_MMA(0, 0, At, B0); PG8_MMA(0, 1, At, B1); PG8_BAR; PG8_SCHED;
            PG8_LDA(At, 1, 1); PG8_STAGE(PG8_SB(1, 0), b3, voffB); PG8_STAGE(PG8_SB(1, 1), b3 + hstep, voffB); PG8_STAGE(PG8_SA(1, 0), a3, voffA);
            PG8_WAIT_V(8); PG8_WAIT_L(0); PG8_BAR; PG8_MMA(1, 0, At, B0); PG8_MMA(1, 1, At, B1); PG8_BAR; PG8_SCHED;
            } else {
            PG8_LDB(B0, 0, 0); PG8_SCHED; PG8_LDA(At, 0, 0); PG8_STAGE(PG8_SA(1, 1), a1 + hstep, voffA);
            PG8_WAIT_L(8); PG8_BAR; PG8_WAIT_L(0); PG8_MMA(0, 0, At, B0); PG8_BAR; PG8_SCHED;
            PG8_LDB(B1, 0, 1); PG8_STAGE(PG8_SB(0, 0), b2, voffB);
            PG8_BAR; PG8_WAIT_L(0); PG8_MMA(0, 1, At, B1); PG8_BAR;
            PG8_LDA(At, 0, 1); PG8_STAGE(PG8_SA(0, 0), a2, voffA);
            PG8_BAR; PG8_WAIT_L(0); PG8_MMA(1, 0, At, B0); PG8_BAR; PG8_SCHED;
            PG8_STAGE(PG8_SB(0, 1), b2 + hstep, voffB);
            PG8_WAIT_V(6); PG8_BAR; PG8_MMA(1, 1, At, B1); PG8_BAR;
            PG8_LDB(B0, 1, 0); PG8_SCHED; PG8_LDA(At, 1, 0); PG8_STAGE(PG8_SA(0, 1), a2 + hstep, voffA);
            PG8_WAIT_L(8); PG8_BAR; PG8_WAIT_L(0); PG8_MMA(0, 0, At, B0); PG8_BAR; PG8_SCHED;
            PG8_LDB(B1, 1, 1); PG8_STAGE(PG8_SB(1, 0), b3, voffB);
            PG8_BAR; PG8_WAIT_L(0); PG8_MMA(0, 1, At, B1); PG8_BAR;
            PG8_LDA(At, 1, 1); PG8_STAGE(PG8_SA(1, 0), a3, voffA);
            PG8_BAR; PG8_WAIT_L(0); PG8_MMA(1, 0, At, B0); PG8_BAR; PG8_SCHED;
            PG8_STAGE(PG8_SB(1, 1), b3 + hstep, voffB);
            PG8_WAIT_V(6); PG8_BAR; PG8_MMA(1, 1, At, B1); PG8_BAR;
            }
        }
        if constexpr (F8) asm volatile("s_nop 15\n\ts_nop 15" ::: "memory");
        if constexpr (ALIGN_EPI) { if (wr == 0) PG8_BAR; }
        if constexpr (EPIW > 0) { static_assert(EPIW == 0 || (ALIGN_EPI && SP2), "EPIW needs ALIGN_EPI and SP2");
            }
        if constexpr (!Epi::AFTER_DRAIN) { E(acc, cur, wr, wc, fr, fq); S.done(cur); }
        if (!has_next) break;
#pragma unroll
        for (int a = 0; a < 2; ++a)
#pragma unroll
            for (int b = 0; b < 2; ++b)
#pragma unroll
                for (int m = 0; m < 4; ++m)
#pragma unroll
                    for (int n = 0; n < 2; ++n) acc[a][b][m][n] = (f32x4){0.f, 0.f, 0.f, 0.f};
        cur = nxt; cA = nA; cB = nB; ++ui;
        if constexpr (ALIGN_EPI) { if (wr == 1) PG8_BAR; }
    }
    PG8_WAIT_V(0);
    if constexpr (!ALIGN_EPI) { if (wr == 0) PG8_BAR; }
    PG8_BAR;
    if constexpr (Epi::AFTER_DRAIN) { E.fused(acc, cur, wr, wc, fr, fq, lds, wid, lane); S.done(cur); }
#undef PG8_SA
#undef PG8_SB
#undef PG8_STAGE
#undef PG8_LDA
#undef PG8_LDB
#undef PG8_MMA
#undef PG8_WAIT_V
#undef PG8_WAIT_L
#undef PG8_BAR
#undef PG8_SCHED
}
}

namespace attn {
constexpr int   D = 128, NW = 8, QBLK = 32, KVBLK = 64;
constexpr float SCALE = 0.088388347648318440f;
constexpr float THR = MK_FP8V ? 2.f : 8.f;
constexpr float POFF = MK_FP8V ? 5.f : 0.f;
constexpr long GOFF = 32l << 20;
constexpr int V8STR = 80;
constexpr int SDEPTH = 2;
constexpr int LDQ = 1024, LDK = 256, LDO = 1024;
constexpr size_t SHM_V = KVBLK * D * 2, SHM_K = KVBLK * D * 2, SHM_ATTN = 2 * SHM_V + 2 * SHM_K + NW * 64 * 4;
typedef unsigned short bf16;
using bf16x8 = __attribute__((ext_vector_type(8))) short;
using s16x4  = __attribute__((ext_vector_type(4))) short;
using f32x16 = __attribute__((ext_vector_type(16))) float;
using f32x8  = __attribute__((ext_vector_type(8))) float;
using u32x4  = __attribute__((ext_vector_type(4))) unsigned;
#define KSWZ(row, colB) ((row) * 256 + ((colB) ^ (((row) & 7) << 4)))
#define K8SWZ(row, c16) ((row) * 128 + ((((c16) ^ ((row) & 7))) << 4))
typedef int v8i __attribute__((ext_vector_type(8)));
#define SBAR() __builtin_amdgcn_sched_barrier(0)
__device__ __forceinline__ int crow(int r, int hi) { return (r & 3) + 8 * (r >> 2) + 4 * hi; }
__device__ __forceinline__ unsigned cvtpk(float lo, float hi) { return cvt_pk_bf16(lo, hi); }
template <typename TIn> struct Stage;
template <> struct Stage<bf16>  { using T = bf16x8;
  __device__ static __forceinline__ T ld8(const bf16* p) { return *reinterpret_cast<const bf16x8*>(p); }
  __device__ static __forceinline__ bf16x8 tobf(T x) { return x; } };
__device__ __forceinline__ void partialSM(f32x16& p0, f32x16& p1, float& m_reg, float& mn, float& alpha) {
  constexpr float C = SCALE * 1.4426950408889634f;
  float pmax = p0[0]; for (int r = 1; r < 16; ++r) pmax = fmaxf(pmax, p0[r]); for (int r = 0; r < 16; ++r) pmax = fmaxf(pmax, p1[r]);
  { auto rr = __builtin_amdgcn_permlane32_swap(__float_as_uint(pmax), __float_as_uint(pmax), false, false);
    pmax = fmaxf(__uint_as_float(rr[0]), __uint_as_float(rr[1])); }
  if (__builtin_expect(__all(pmax - m_reg <= THR / SCALE), 1)) { mn = m_reg; alpha = 1.f; }
  else { mn = fmaxf(m_reg, pmax); alpha = __builtin_amdgcn_exp2f((m_reg - mn) * C); m_reg = mn; }
  float mnC = -mn * C + POFF;
  for (int r = 0; r < 16; ++r) p0[r] = fmaf(p0[r], C, mnC); for (int r = 0; r < 16; ++r) p1[r] = fmaf(p1[r], C, mnC);
  for (int r = 0; r < 16; ++r) p0[r] = __builtin_amdgcn_exp2f(p0[r]);
}
constexpr float THRL = THR * 1.4426950408889634f;
constexpr int SC1R = 0x7F7F7C7F;
__device__ __forceinline__ void partialSMm(f32x16& p0, f32x16& p1, float& m_reg, float& alpha, f32x16& M16, bool force) {
  float pmax = p0[0]; for (int r = 1; r < 16; ++r) pmax = fmaxf(pmax, p0[r]); for (int r = 0; r < 16; ++r) pmax = fmaxf(pmax, p1[r]);
  { auto rr = __builtin_amdgcn_permlane32_swap(__float_as_uint(pmax), __float_as_uint(pmax), false, false);
    pmax = fmaxf(__uint_as_float(rr[0]), __uint_as_float(rr[1])); }
  const float ex = pmax - POFF;
  if (__builtin_expect(!force && __all(ex <= THRL), 1)) { alpha = 1.f; }
  else { const float d = force ? ex : fmaxf(ex, 0.f); alpha = __builtin_amdgcn_exp2f(-d);
    for (int r = 0; r < 16; ++r) { p0[r] -= d; p1[r] -= d; }
    const float c0 = M16[0] - d; for (int r = 0; r < 16; ++r) M16[r] = c0; }
  for (int r = 0; r < 16; ++r) p0[r] = __builtin_amdgcn_exp2f(p0[r]);
}
__device__ __forceinline__ void finishSM8(f32x16& p0, f32x16& p1, float alpha, float& l_reg, v8i& P8) {
  for (int r = 0; r < 16; ++r) p1[r] = __builtin_amdgcn_exp2f(p1[r]);
#if !MK_LMFMA
  float ps = 0; for (int r = 0; r < 16; ++r) ps += p0[r]; for (int r = 0; r < 16; ++r) ps += p1[r];
  { auto rr = __builtin_amdgcn_permlane32_swap(__float_as_uint(ps), __float_as_uint(ps), false, false);
    ps = __uint_as_float(rr[0]) + __uint_as_float(rr[1]); }
  l_reg = l_reg * alpha + ps;
#endif
#if MK_LMFMA
#define DC_(ID) asm("; dc" #ID " %0 %1" : "=v"(ua_), "=v"(ub_))
#else
#define DC_(ID) do { } while (0)
#endif
#define PK8_(i) do { int ua_ = 0, ub_ = 0; DC_(i); \
    int a = __builtin_amdgcn_cvt_pk_fp8_f32(p0[4 * i], p0[4 * i + 1], ua_, false); a = __builtin_amdgcn_cvt_pk_fp8_f32(p0[4 * i + 2], p0[4 * i + 3], a, true); \
    int b = __builtin_amdgcn_cvt_pk_fp8_f32(p1[4 * i], p1[4 * i + 1], ub_, false); b = __builtin_amdgcn_cvt_pk_fp8_f32(p1[4 * i + 2], p1[4 * i + 3], b, true); \
    auto rr = __builtin_amdgcn_permlane32_swap((unsigned)a, (unsigned)b, false, false); P8[i] = (int)rr[0]; P8[4 + i] = (int)rr[1]; } while (0)
  PK8_(0); PK8_(1); PK8_(2); PK8_(3);
#undef PK8_
#undef DC_
}
__device__ __forceinline__ void pv8(f32x16* o, f32x16& ol, const char* Vb, const v8i& P8, int r32, int hi) {
#if MK_LMFMA
  { const v8i ONES = {0x22222222, 0x22222222, 0x22222222, 0x22222222, 0, 0, 0, 0};
    ol = __builtin_amdgcn_mfma_scale_f32_32x32x64_f8f6f4(P8, ONES, ol, 0, 4, 0, SC1R, 0, SC1R); }
#endif
#pragma unroll
  for (int d0 = 0; d0 < 4; ++d0) { const char* pp = Vb + (32 * d0 + r32) * V8STR + 32 * hi;
    const u32x4 x0 = *reinterpret_cast<const u32x4*>(pp), x1 = *reinterpret_cast<const u32x4*>(pp + 16);
    const v8i B = {(int)x0.x, (int)x0.y, (int)x0.z, (int)x0.w, (int)x1.x, (int)x1.y, (int)x1.z, (int)x1.w};
    o[d0] = __builtin_amdgcn_mfma_scale_f32_32x32x64_f8f6f4(P8, B, o[d0], 0, 0, 0, SC1R, 0, SC1R); }
}
__device__ __forceinline__ void finishSM(f32x16& p0, f32x16& p1, float alpha, float& l_reg, bf16x8& pa0, bf16x8& pa1, bf16x8& pa2, bf16x8& pa3) {
  for (int r = 0; r < 16; ++r) p1[r] = __builtin_amdgcn_exp2f(p1[r]);
  float ps = 0; for (int r = 0; r < 16; ++r) ps += p0[r]; for (int r = 0; r < 16; ++r) ps += p1[r];
  { auto rr = __builtin_amdgcn_permlane32_swap(__float_as_uint(ps), __float_as_uint(ps), false, false);
    ps = __uint_as_float(rr[0]) + __uint_as_float(rr[1]); }
  l_reg = l_reg * alpha + ps;
#define PK4(P, BASE, OUT) do { unsigned a0 = cvtpk(P[BASE + 0], P[BASE + 1]), a1 = cvtpk(P[BASE + 2], P[BASE + 3]);   \
    unsigned b0 = cvtpk(P[BASE + 4], P[BASE + 5]), b1 = cvtpk(P[BASE + 6], P[BASE + 7]);                              \
    auto r0 = __builtin_amdgcn_permlane32_swap(a0, b0, false, false); auto r1 = __builtin_amdgcn_permlane32_swap(a1, b1, false, false); \
    u32x4 w = {r0[0], r1[0], r0[1], r1[1]}; OUT = *reinterpret_cast<bf16x8*>(&w); } while (0)
  PK4(p0, 0, pa0); PK4(p0, 8, pa1); PK4(p1, 0, pa2); PK4(p1, 8, pa3);
#undef PK4
}
__device__ __forceinline__ void qkt(f32x16& p0, f32x16& p1, const bf16* Ks, const bf16x8* qr, int r32, int hi) {
  p0 = f32x16{}; p1 = f32x16{};
  for (int d0 = 0; d0 < 8; ++d0) { int cb = (d0 * 16 + hi * 8) * 2;
    bf16x8 b0 = *reinterpret_cast<const bf16x8*>((const char*)Ks + KSWZ(r32, cb));
    bf16x8 b1 = *reinterpret_cast<const bf16x8*>((const char*)Ks + KSWZ(32 + r32, cb));
    p0 = __builtin_amdgcn_mfma_f32_32x32x16_bf16(b0, qr[d0], p0, 0, 0, 0);
    p1 = __builtin_amdgcn_mfma_f32_32x32x16_bf16(b1, qr[d0], p1, 0, 0, 0); }
}
__device__ __forceinline__ void qkt8(f32x16& p0, f32x16& p1, const char* Ks, const v8i* q8, int r32, int hi, const f32x16& M16) {
#if MK_MACC
  constexpr int QSC = 0x7C7C7C7C;
#else
  constexpr int QSC = 0x7F7F7F7F;
#endif
#pragma unroll
  for (int m = 0; m < 2; ++m) { const int c = 4 * m + 2 * hi;
    const u32x4 a00 = *reinterpret_cast<const u32x4*>(Ks + K8SWZ(r32, c)), a01 = *reinterpret_cast<const u32x4*>(Ks + K8SWZ(r32, c + 1));
    const u32x4 a10 = *reinterpret_cast<const u32x4*>(Ks + K8SWZ(32 + r32, c)), a11 = *reinterpret_cast<const u32x4*>(Ks + K8SWZ(32 + r32, c + 1));
    const v8i A0 = {(int)a00.x, (int)a00.y, (int)a00.z, (int)a00.w, (int)a01.x, (int)a01.y, (int)a01.z, (int)a01.w};
    const v8i A1 = {(int)a10.x, (int)a10.y, (int)a10.z, (int)a10.w, (int)a11.x, (int)a11.y, (int)a11.z, (int)a11.w};
    p0 = __builtin_amdgcn_mfma_scale_f32_32x32x64_f8f6f4(A0, q8[m], m == 0 ? M16 : p0, 0, 0, 0, SC1R, MK_MACC ? 1 : 0, SC1R);
    p1 = __builtin_amdgcn_mfma_scale_f32_32x32x64_f8f6f4(A1, q8[m], m == 0 ? M16 : p1, 0, 0, 0, SC1R, MK_MACC ? 1 : 0, SC1R); }
}
__device__ __forceinline__ int v_st(int k, int c) { const int kk = (k & ~0xC) | ((k & 4) << 1) | ((k & 8) >> 1); return ((kk >> 3) * 4 + (c >> 5)) * 512 + ((kk & 7) * 32 + (c & 31)) * 2; }
__device__ __forceinline__ int v_rd_base(int lane) { return ((lane & 3) << 3) | (((lane >> 2) & 3) << 6) | (((lane >> 4) & 1) << 5) | (((lane >> 5) & 1) << 8); }
constexpr int v_rd_off(int d0, int ks, int half) { return d0 * 512 + ks * 4096 + half * 2048; }
template <int OFF> __device__ __forceinline__ s16x4 tr_read(int vb) {
  s16x4 r; asm volatile("ds_read_b64_tr_b16 %0, %1 offset:%2" : "=&v"(r) : "v"(vb), "i"(OFF) : "memory"); return r;
}
template <int D0> __device__ __forceinline__ void pv_one(f32x16& od, int vb, bf16x8 pa0, bf16x8 pa1, bf16x8 pa2, bf16x8 pa3) {
  const s16x4 l0 = tr_read<v_rd_off(D0, 0, 0)>(vb), h0 = tr_read<v_rd_off(D0, 0, 1)>(vb), l1 = tr_read<v_rd_off(D0, 1, 0)>(vb), h1 = tr_read<v_rd_off(D0, 1, 1)>(vb);
  const s16x4 l2 = tr_read<v_rd_off(D0, 2, 0)>(vb), h2 = tr_read<v_rd_off(D0, 2, 1)>(vb), l3 = tr_read<v_rd_off(D0, 3, 0)>(vb), h3 = tr_read<v_rd_off(D0, 3, 1)>(vb);
  asm volatile("s_waitcnt lgkmcnt(0)" ::: "memory"); SBAR();
#define PK(L, H) (bf16x8){L[0], L[1], L[2], L[3], H[0], H[1], H[2], H[3]}
  od = __builtin_amdgcn_mfma_f32_32x32x16_bf16(pa0, PK(l0, h0), od, 0, 0, 0);
  od = __builtin_amdgcn_mfma_f32_32x32x16_bf16(pa1, PK(l1, h1), od, 0, 0, 0);
  od = __builtin_amdgcn_mfma_f32_32x32x16_bf16(pa2, PK(l2, h2), od, 0, 0, 0);
  od = __builtin_amdgcn_mfma_f32_32x32x16_bf16(pa3, PK(l3, h3), od, 0, 0, 0);
#undef PK
}
__device__ __forceinline__ void pv_d0(f32x16* o, int vb, bf16x8 pa0, bf16x8 pa1, bf16x8 pa2, bf16x8 pa3) {
  pv_one<0>(o[0], vb, pa0, pa1, pa2, pa3); pv_one<1>(o[1], vb, pa0, pa1, pa2, pa3); pv_one<2>(o[2], vb, pa0, pa1, pa2, pa3); pv_one<3>(o[3], vb, pa0, pa1, pa2, pa3);
}

__device__ __forceinline__ void dec8(const v2u w, float (&f)[8]) {
  const auto a0 = __builtin_amdgcn_cvt_pk_f32_fp8((int)w.x, false), a1 = __builtin_amdgcn_cvt_pk_f32_fp8((int)w.x, true), a2 = __builtin_amdgcn_cvt_pk_f32_fp8((int)w.y, false), a3 = __builtin_amdgcn_cvt_pk_f32_fp8((int)w.y, true);
  f[0] = a0[0]; f[1] = a0[1]; f[2] = a1[0]; f[3] = a1[1]; f[4] = a2[0]; f[5] = a2[1]; f[6] = a3[0]; f[7] = a3[1]; }
#if MK_AG8
struct Pre { v2u q[8]; };
#else
struct Pre { bf16x8 q[8]; };
#endif
__device__ __forceinline__ void attn_prefetch(const bf16* Qb, const bf16* __restrict__ Kh, const bf16* __restrict__ Vh, Pre& p) {
  const int tid = threadIdx.x, wid = tid >> 6, lane = tid & 63, r32 = lane & 31, hi = lane >> 5;
#if MK_AG8
  int t_ = tid; asm volatile("" : "+v"(t_));
  const unsigned char* Qw = (const unsigned char*)Qb + (unsigned)(((t_ >> 6) * QBLK + (t_ & 31)) * 1024 + ((t_ >> 5) & 1) * 8);
#pragma unroll
  for (int d0 = 0; d0 < 8; ++d0) p.q[d0] = *reinterpret_cast<const v2u*>(Qw + d0 * 16);
#else
  const bf16* Qw = Qb + (long)(wid * QBLK + r32) * LDQ + hi * 8;
#pragma unroll
  for (int d0 = 0; d0 < 8; ++d0) p.q[d0] = *reinterpret_cast<const bf16x8*>(Qw + d0 * 16);
#endif
}
template <typename TQ>
__device__ __forceinline__ void attn_dense_body(const TQ* Qb, const bf16* __restrict__ Kh, const bf16* __restrict__ Vh,
                                                bf16* Ob, int seq, char* lds, const float* __restrict__ qnw, const float* __restrict__ rope, int lpos0,
                                                Pre& pre, const bf16* Qn, const bf16* Kn, const bf16* Vn) {
  using St = Stage<bf16>; using SQ = Stage<TQ>;
  const int tid = threadIdx.x, wid = __builtin_amdgcn_readfirstlane(tid >> 6), lane = tid & 63, r32 = lane & 31, hi = lane >> 5;
  bf16* V_lds = (bf16*)lds; bf16* K_lds = (bf16*)(lds + 2 * SHM_V);
  float* ws = (float*)(lds + 2 * SHM_V + 2 * SHM_K) + wid * 64; float* li_l = ws; float* al_l = ws + 32;
  float m_reg = -1e30f, l_reg = 0; f32x16 o[4] = {}; bf16x8 qr[8];
#if MK_FP8K
  v8i q8[2]; const unsigned char* K8h = (const unsigned char*)Kh;
#if MK_MACC
  f32x16 M16; for (int r = 0; r < 16; ++r) M16[r] = POFF; m_reg = 0.f;
#else
  f32x16 M16 = {};
#endif
#endif
#if MK_AG8
#define QDEC(d0_) float qd_[8]; dec8(pre.q[d0_], qd_)
#define QF(d0_, j_) qd_[j_]
#else
#define QDEC(d0_) do { } while (0)
#define QF(d0_, j_) bf2f((unsigned short)qr[d0_][j_])
#pragma unroll
  for (int d0 = 0; d0 < 8; ++d0) qr[d0] = pre.q[d0];
#endif
  const int sr = tid >> 4, sc = (tid & 15) * 8, vst0 = v_st(sr, sc), vst1 = v_st(32 + sr, sc);
  const int vb0 = (int)(uintptr_t)V_lds + v_rd_base(lane);
#if MK_FP8K && MK_FP8V
  const unsigned char* V8h = (const unsigned char*)Vh;
  struct { u32x4 v8, k8; } sr_[SDEPTH];
  const unsigned ko = (unsigned)((tid >> 3) * 256 + (tid & 7) * 16);
#define SLOAD(i, k0) do { sr_[i].v8 = *reinterpret_cast<const u32x4*>(V8h + (size_t)((k0) >> 6) * 8192 + (unsigned)tid * 16u); \
    sr_[i].k8 = *reinterpret_cast<const u32x4*>(K8h + (size_t)(k0) * 256 + ko); } while (0)
#define SWRITE(b, i) do { *(u32x4*)((char*)V_lds + (b) * SHM_V + (tid >> 2) * V8STR + (tid & 3) * 16) = sr_[i].v8; \
    *(u32x4*)((char*)K_lds + (b) * SHM_K + K8SWZ(tid >> 3, tid & 7)) = sr_[i].k8; } while (0)
#define SWAIT() asm volatile("s_waitcnt vmcnt(2)" ::: "memory")
#define QKT(P0, P1, KB) qkt8(P0, P1, (const char*)K_lds + (KB) * SHM_K, q8, r32, hi, M16)
#define FINISH(P0, P1, AL) finishSM8(P0, P1, AL, l_reg, P8)
#if MK_MACC
#define PSM(P0, P1, AL, FORCE) partialSMm(P0, P1, m_reg, AL, M16, FORCE)
#else
#define PSM(P0, P1, AL, FORCE) do { float mn_; partialSM(P0, P1, m_reg, mn_, AL); } while (0)
#endif
#define PV(VB) pv8(o, ol, (const char*)V_lds + (VB) * SHM_V, P8, r32, hi)
  v8i P8; f32x16 ol = {};
#elif MK_FP8K
#define FINISH(P0, P1, AL) finishSM(P0, P1, AL, l_reg, pa0, pa1, pa2, pa3)
#define PSM(P0, P1, AL, FORCE) do { float mn_; partialSM(P0, P1, m_reg, mn_, AL); } while (0)
#define PV(VB) pv_d0(o, vb0 + (VB) * (int)SHM_V, pa0, pa1, pa2, pa3)
  struct { typename St::T vs0, vs1; u32x4 k8; } sr_[SDEPTH];
  const unsigned vo0 = (unsigned)(sr * LDK + sc), vo1 = vo0 + 32u * LDK, ko = (unsigned)((tid >> 3) * 256 + (tid & 7) * 16);
#define SLOAD(i, k0) do { const bf16* vt_ = Vh + (size_t)(k0) * LDK; const unsigned char* kt_ = K8h + (size_t)(k0) * 256; \
    sr_[i].vs0 = *reinterpret_cast<const bf16x8*>(vt_ + vo0); sr_[i].vs1 = *reinterpret_cast<const bf16x8*>(vt_ + vo1); sr_[i].k8 = *reinterpret_cast<const u32x4*>(kt_ + ko); } while (0)
#define SWRITE(b, i) do { *(bf16x8*)((char*)V_lds + (b) * SHM_V + vst0) = St::tobf(sr_[i].vs0);          \
    *(bf16x8*)((char*)V_lds + (b) * SHM_V + vst1) = St::tobf(sr_[i].vs1);                                \
    *(u32x4*)((char*)K_lds + (b) * SHM_K + K8SWZ(tid >> 3, tid & 7)) = sr_[i].k8; } while (0)
#define SWAIT() asm volatile("s_waitcnt vmcnt(3)" ::: "memory")
#define QKT(P0, P1, KB) qkt8(P0, P1, (const char*)K_lds + (KB) * SHM_K, q8, r32, hi, M16)
#else
#define FINISH(P0, P1, AL) finishSM(P0, P1, AL, l_reg, pa0, pa1, pa2, pa3)
#define PSM(P0, P1, AL, FORCE) do { float mn_; partialSM(P0, P1, m_reg, mn_, AL); } while (0)
#define PV(VB) pv_d0(o, vb0 + (VB) * (int)SHM_V, pa0, pa1, pa2, pa3)
#define QKT(P0, P1, KB) qkt(P0, P1, (bf16*)((char*)K_lds + (KB) * SHM_K), qr, r32, hi)
  struct { typename St::T vs0, vs1, ks0, ks1; } sr_[SDEPTH];
#define SLOAD(i, k0) do { sr_[i].vs0 = St::ld8(&Vh[(long)((k0) + sr) * LDK + sc]); sr_[i].vs1 = St::ld8(&Vh[(long)((k0) + 32 + sr) * LDK + sc]); \
    sr_[i].ks0 = St::ld8(&Kh[(long)((k0) + sr) * LDK + sc]); sr_[i].ks1 = St::ld8(&Kh[(long)((k0) + 32 + sr) * LDK + sc]); } while (0)
#define SWRITE(b, i) do { *(bf16x8*)((char*)V_lds + (b) * SHM_V + vst0) = St::tobf(sr_[i].vs0);          \
    *(bf16x8*)((char*)V_lds + (b) * SHM_V + vst1) = St::tobf(sr_[i].vs1); int kc = sc * 2;               \
    *(bf16x8*)((char*)K_lds + (b) * SHM_K + KSWZ(sr, kc)) = St::tobf(sr_[i].ks0);                       \
    *(bf16x8*)((char*)K_lds + (b) * SHM_K + KSWZ(32 + sr, kc)) = St::tobf(sr_[i].ks1); } while (0)
#define SWAIT() do { if constexpr (SDEPTH == 2) asm volatile("s_waitcnt vmcnt(4)" ::: "memory"); else asm volatile("s_waitcnt vmcnt(0)" ::: "memory"); } while (0)
#endif
#if MK_LMFMA && MK_FP8K && MK_FP8V
#define RESCL() do { for (int r = 0; r < 16; ++r) ol[r] *= al_l[crow(r, hi)]; } while (0)
#else
#define RESCL() do { } while (0)
#endif
#define RESC(a) do { if (__any((a) < 1.f)) { if (hi == 0) al_l[r32] = (a); asm volatile("s_waitcnt lgkmcnt(0)" ::: "memory"); \
    for (int d = 0; d < 4; ++d) for (int r = 0; r < 16; ++r) o[d][r] *= al_l[crow(r, hi)]; RESCL(); } } while (0)
  f32x16 pA0, pA1, pB0, pB1; float mnA, mnB, alA, alB; bf16x8 pa0, pa1, pa2, pa3; const int NT = seq / KVBLK;
  constexpr int SE = 0, SO = SDEPTH - 1;
  SLOAD(SE, 0); SLOAD(SO, KVBLK);
  if (qnw) {
    float ssq = 0.f;
#pragma unroll
    for (int d0 = 0; d0 < 8; ++d0)
      { QDEC(d0);
#pragma unroll
      for (int j = 0; j < 8; ++j) { const float f = QF(d0, j); ssq += f * f; } }
    { auto rr = __builtin_amdgcn_permlane32_swap(__float_as_uint(ssq), __float_as_uint(ssq), false, false); ssq = __uint_as_float(rr[0]) + __uint_as_float(rr[1]); }
    const float rstd = (1.0f / sqrtf(ssq * (1.0f / 128.0f) + 1e-6f)) * (MK_MACC ? SCALE * 1.4426950408889634f * 8.0f : 1.0f);
    const int lq = lpos0 + wid * QBLK + r32, ri = lq >> 6, ci = lq & 63;
#pragma unroll
    for (int d0 = 0; d0 < 8; ++d0) {
      const float* wp = qnw + 16 * d0 + 8 * hi; const v4f w0 = *(const v4f*)wp, w1 = *(const v4f*)(wp + 4);
      const float* tp = d0 < 4 ? rope + (ri * 32 + 8 * d0 + 4 * hi) * 2 : rope + (ci * 32 + 8 * (d0 - 4) + 4 * hi) * 2; const v4f t0 = *(const v4f*)tp, t1 = *(const v4f*)(tp + 4);
      const float wv[8] = {w0.x, w0.y, w0.z, w0.w, w1.x, w1.y, w1.z, w1.w}, tv[8] = {t0.x, t0.y, t0.z, t0.w, t1.x, t1.y, t1.z, t1.w};
      float y[8]; QDEC(d0);
#pragma unroll
      for (int q = 0; q < 4; ++q) { const float x0 = QF(d0, 2 * q) * rstd * wv[2 * q], x1 = QF(d0, 2 * q + 1) * rstd * wv[2 * q + 1], cs = tv[2 * q], sn = tv[2 * q + 1];
        y[2 * q] = x0 * cs - x1 * sn; y[2 * q + 1] = x0 * sn + x1 * cs; }
#if MK_FP8K
      { int w0 = __builtin_amdgcn_cvt_pk_fp8_f32(y[0], y[1], 0, false); w0 = __builtin_amdgcn_cvt_pk_fp8_f32(y[2], y[3], w0, true);
        int w1 = __builtin_amdgcn_cvt_pk_fp8_f32(y[4], y[5], 0, false); w1 = __builtin_amdgcn_cvt_pk_fp8_f32(y[6], y[7], w1, true);
        q8[d0 >> 2][2 * (d0 & 3)] = w0; q8[d0 >> 2][2 * (d0 & 3) + 1] = w1; }
#else
      u32x4 pw = {cvtpk(y[0], y[1]), cvtpk(y[2], y[3]), cvtpk(y[4], y[5]), cvtpk(y[6], y[7])}; qr[d0] = *reinterpret_cast<bf16x8*>(&pw);
#endif
    }
  }
  SWAIT(); SWRITE(0, SE); if constexpr (SDEPTH == 2) { if (2 < NT) SLOAD(SE, 2 * KVBLK); } __syncthreads();
  QKT(pA0, pA1, 0); PSM(pA0, pA1, alA, true);
  SWAIT(); SWRITE(1, SO); __syncthreads();
  for (int j = 1; j + 1 < NT; j += 2) {
    SBAR(); QKT(pB0, pB1, 1);
    FINISH(pA0, pA1, alA); SBAR();
    SLOAD(SO, (j + SDEPTH) * KVBLK); SBAR();
    PV(0); PSM(pB0, pB1, alB, false);
    __syncthreads(); SWAIT(); SWRITE(0, SE);
    RESC(alB); __syncthreads();
    SBAR(); QKT(pA0, pA1, 0);
    FINISH(pB0, pB1, alB); SBAR();
    if (SDEPTH == 1 || j + 3 < NT) SLOAD(SE, (j + 1 + SDEPTH) * KVBLK); SBAR();
    PV(1); PSM(pA0, pA1, alA, false);
    __syncthreads(); SWAIT(); SWRITE(1, SO);
    RESC(alA); __syncthreads();
  }
  attn_prefetch(Qn, Kn, Vn, pre);
#if MK_AG8
  char* gl = lds + 98304 + wid * 4096;
  { const unsigned char* Gw = (const unsigned char*)Qb + GOFF + (long)(wid * QBLK) * 1024;
    int l_ = lane; asm volatile("" : "+v"(l_)); const unsigned char* Gl = Gw + (unsigned)((l_ >> 3) * 1024 + (l_ & 7) * 16);
#pragma unroll
    for (int i = 0; i < 4; ++i)
      __builtin_amdgcn_global_load_lds((const unsigned*)(Gl + i * 8192), (__attribute__((address_space(3))) unsigned*)(gl + i * 1024), 16, 0, 0); }
#endif
  SBAR(); QKT(pB0, pB1, 1);
  FINISH(pA0, pA1, alA); SBAR();
  PV(0); PSM(pB0, pB1, alB, false);
  __syncthreads(); RESC(alB);
  FINISH(pB0, pB1, alB); SBAR();
  PV(1);
  float rli[16];
#if MK_LMFMA && MK_FP8K && MK_FP8V
#pragma unroll
  for (int r = 0; r < 16; ++r) rli[r] = __builtin_amdgcn_rcpf(ol[r]);
#else
  if (hi == 0) li_l[r32] = l_reg; asm volatile("s_waitcnt lgkmcnt(0)" ::: "memory");
#pragma unroll
  for (int r = 0; r < 16; ++r) rli[r] = __builtin_amdgcn_rcpf(li_l[crow(r, hi)]);
#endif
  if (!Ob) return;
#if MK_AG8
  asm volatile("s_waitcnt vmcnt(0)" ::: "memory");
  { int hio = hi, ro = r32; asm volatile("" : "+v"(hio), "+v"(ro));
    const char* glb = gl + hio * 512 + ro;
    unsigned char* Ow8 = (unsigned char*)Ob + (long)(wid * QBLK) * 1024 + (hio * 4) * 1024 + ro;
#pragma unroll
    for (int r = 0; r < 16; ++r) { const int rr = (r & 3) + 8 * (r >> 2);
#pragma unroll
      for (int d0 = 0; d0 < 4; ++d0) { const float gv = __builtin_amdgcn_cvt_f32_fp8((int)*(const unsigned char*)(glb + rr * 128 + d0 * 32), 0);
        const float y = __builtin_amdgcn_fmed3f(o[d0][r] * rli[r] * gv, -448.0f, 448.0f);
        Ow8[rr * 1024 + d0 * 32] = (unsigned char)(__builtin_amdgcn_cvt_pk_fp8_f32(y, 0.0f, 0, false) & 0xff); } } }
#else
  bf16* Ow = Ob + (long)(wid * QBLK) * LDO;
#pragma unroll
  for (int r = 0; r < 16; ++r) { int orow = crow(r, hi);
    for (int d0 = 0; d0 < 4; ++d0) Ow[(long)orow * LDO + d0 * 32 + r32] = (bf16)f2bf(o[d0][r] * rli[r]); }
#endif
#undef SLOAD
#undef QKT
#undef QF
#undef QDEC
#undef FINISH
#undef PSM
#undef PV
#undef SWRITE
#undef SWAIT
#undef RESC
#undef RESCL
}

#undef KSWZ
#undef SBAR
}

namespace ret {
typedef short bf16x8 __attribute__((ext_vector_type(8)));
typedef short s16x4 __attribute__((ext_vector_type(4)));
typedef float f32x16 __attribute__((ext_vector_type(16)));
constexpr int QSTR = 528, KSTR = 576, VSTR = 576, PSTR = 144;
constexpr int QS = 0, KS = QS + 64 * QSTR, VS = KS + 64 * KSTR, PS = VS + 64 * VSTR, OST = PS + 64 * PSTR, OSTR = 144, SSL = OST + 8 * 32 * OSTR, LDS_RET = SSL + 64 * 8 * 4;
constexpr int NSTEP = 36, SPLIT = 20;
__device__ __forceinline__ int crow(int r, int hi) { return (r & 3) + 8 * (r >> 2) + 4 * hi; }
__device__ __forceinline__ s16x4 tr_read(const LAS unsigned char* p) { return __builtin_bit_cast(s16x4, __builtin_amdgcn_ds_read_tr16_b64_v4i16((LAS s16x4*)p)); }
__device__ __forceinline__ bf16x8 cat(s16x4 lo, s16x4 hi) { return (bf16x8){lo[0], lo[1], lo[2], lo[3], hi[0], hi[1], hi[2], hi[3]}; }

struct NoPre { __device__ __forceinline__ void operator()() const {} };
template <class GridBar, class PreWork = NoPre>
__device__ __forceinline__ void scan_unit(const bf16_t* RQ, const bf16_t* RK, const bf16_t* RV, bf16_t* YR, float* SSQ, const float* l2d, LAS unsigned char* lds, int unit, const GridBar& gridbar, int nb_limit, const PreWork& prework = PreWork()) {
    const int tid = threadIdx.x, lane = tid & 63, w = __builtin_amdgcn_readfirstlane(tid >> 6), r = lane & 31, hh = lane >> 5;
    const int x = unit & 7, y = unit >> 3, eh = y & 1, dir = (y >> 1) & 1, bh = (y >> 2) * 8 + x, b = bh >> 2, h = bh & 3;
    if (b >= nb_limit) { prework(); gridbar(); return; }
    const float lg2 = log1pf(-exp2f(l2d[dir * 4 + h])) * 1.4426950408889634f;
    const float gC2 = exp2f(lg2 * 128.0f);
#if MK_TIMING
    unsigned long long tl_ = __builtin_amdgcn_s_memrealtime(); unsigned ta0 = 0, ta1 = 0, ta2 = 0, ta3 = 0, ta4 = 0, ta5 = 0, ta6 = 0;
#define TMARK(v_) do { const unsigned long long n_ = __builtin_amdgcn_s_memrealtime(); v_ += (unsigned)(n_ - tl_); tl_ = n_; } while (0)
#else
#define TMARK(v_) do { } while (0)
#endif
    f32x16 S[8];
#pragma unroll
    for (int T = 0; T < 8; ++T) S[T] = (f32x16){0.f};
#define STEP_ROWS(s_, krow_, qrow_) do { const bool l_ = (s_) >= 4; const int lc_ = l_ ? (dir ? 35 - (s_) : (s_) - 4) : 0; \
        krow_ = b * LT + (l_ ? LC + 64 * lc_ : (dir ? 64 * (3 - (s_)) : 64 * (s_))); qrow_ = b * SEQ + 64 * lc_; } while (0)
    v4u kv[4], vv[4], qv[4];
    const int poff = (tid >> 5) * 1024 + (tid & 31) * 8, voff = (tid >> 5) * 2048 + (tid & 31) * 8;
#define PREFETCHK(s_) do { int kr_, qr_; STEP_ROWS(s_, kr_, qr_); const bf16_t* kb_ = RK + (size_t)kr_ * 1024 + h * 256; \
        _Pragma("unroll") for (int n = 0; n < 4; ++n) { const bf16_t* kbn_ = kb_ + n * 16 * 1024; kv[n] = *(const v4u*)(kbn_ + poff); } } while (0)
#define PREFETCHQ(s_) do { int kr_, qr_; STEP_ROWS(s_, kr_, qr_); const bf16_t* qb_ = RQ + (size_t)qr_ * 1024 + h * 256; \
        _Pragma("unroll") for (int n = 0; n < 4; ++n) { const bf16_t* qbn_ = qb_ + n * 16 * 1024; qv[n] = *(const v4u*)(qbn_ + poff); } } while (0)
#define LOADV(s_) do { int kr_, qr_; STEP_ROWS(s_, kr_, qr_); const bf16_t* vb_ = RV + (size_t)kr_ * 2048 + h * 512 + eh * 256; \
        _Pragma("unroll") for (int n = 0; n < 4; ++n) { const bf16_t* vbn_ = vb_ + n * 16 * 2048; vv[n] = *(const v4u*)(vbn_ + voff); } } while (0)
#define WRITEQ() do { _Pragma("unroll") for (int n = 0; n < 4; ++n) { const int c = tid + NTHR * n, row = c >> 5, ch = c & 31; *(LAS v4u*)(lds + QS + row * QSTR + ch * 16) = qv[n]; } } while (0)
    PREFETCHK(0); PREFETCHQ(0); LOADV(0);
    prework(); __syncthreads();
    LAS unsigned char* ost = lds + OST + w * (32 * OSTR);
    for (int s = 0; s < NSTEP; ++s) {
        if (s == SPLIT) gridbar();
        int krow0, qrow0; STEP_ROWS(s, krow0, qrow0); const bool latent = s >= 4; const int sn = s + 1 < NSTEP ? s + 1 : s;
        float lg2s = lg2; int hv = hh, rv = r; asm volatile("" : "+v"(lg2s), "+v"(hv), "+v"(rv));
        const int lane_l = hv * 32 + rv;
        const int qA = QS + rv * QSTR + hv * 16, pA = PS + rv * PSTR + hv * 16;
        const int sw = ((lane_l & 1) << 1) | ((lane_l >> 1) & 1);
        const int trrow = (hv * 8 + ((lane_l >> 2) & 3));
        const int ktr = KS + trrow * KSTR + (16 * ((lane_l >> 4) & 1) + 4 * sw) * 2;
        const int vtr = VS + trrow * VSTR + (32 * w + 16 * ((lane_l >> 4) & 1) + 4 * (lane_l & 3)) * 2;
        const int odd64 = (s & 1) ? 64 : 0;
        { float wgt = __builtin_amdgcn_exp2f(lg2s * (float)((dir ? (tid >> 5) : 63 - (tid >> 5)) - odd64)); const float wstep = __builtin_amdgcn_exp2f(lg2s * (dir ? 16.0f : -16.0f));
#pragma unroll
          for (int n = 0; n < 4; ++n) { const int c = tid + NTHR * n, row = c >> 5, ch = c & 31;
            *(LAS v4u*)(lds + KS + row * KSTR + ch * 16) = kv[n];
            *(LAS v4u*)(lds + QS + row * QSTR + ch * 16) = qv[n];
            float t[8]; unpack8(vv[n], t);
#pragma unroll
            for (int k = 0; k < 8; ++k) t[k] *= wgt;
            wgt *= wstep;
            *(LAS v4u*)(lds + VS + row * VSTR + ch * 16) = pack8(t); } }
        __syncthreads();
        TMARK(ta0);
        v4u pp[4]; bf16_t* op = YR + (size_t)qrow0 * 2048 + h * 512 + eh * 256 + 32 * w + (size_t)((hv * 32 + rv) >> 2) * 2048 + ((hv * 32 + rv) & 3) * 8;
        if (s >= SPLIT) {
#pragma unroll
            for (int x4 = 0; x4 < 4; ++x4) pp[x4] = *(const v4u*)(op + (size_t)(16 * x4) * 2048); }
        if (latent) {
            { typedef float f32x4_t __attribute__((ext_vector_type(4)));
              const int i0 = 16 * (w >> 1), j0 = 32 * (w & 1), l15 = rv & 15, g4 = (hv << 1) | (rv >> 4);
              const LAS unsigned char* qp = lds + QS + (i0 + l15) * QSTR + g4 * 16; const LAS unsigned char* kp0 = lds + KS + (j0 + l15) * KSTR + g4 * 16; const LAS unsigned char* kp1 = kp0 + 16 * KSTR;
              f32x4_t s0 = (f32x4_t){0.f, 0.f, 0.f, 0.f}, s1 = s0;
              bf16x8 qn = *(const LAS bf16x8*)qp, k0n = *(const LAS bf16x8*)kp0, k1n = *(const LAS bf16x8*)kp1;
#pragma unroll
              for (int kk = 0; kk < 8; ++kk) { const bf16x8 qc = qn, k0c = k0n, k1c = k1n;
                if (kk + 1 < 8) { qn = *(const LAS bf16x8*)(qp + (kk + 1) * 64); k0n = *(const LAS bf16x8*)(kp0 + (kk + 1) * 64); k1n = *(const LAS bf16x8*)(kp1 + (kk + 1) * 64); }
                __builtin_amdgcn_sched_barrier(0);
                s0 = __builtin_amdgcn_mfma_f32_16x16x32_bf16(k0c, qc, s0, 0, 0, 0); s1 = __builtin_amdgcn_mfma_f32_16x16x32_bf16(k1c, qc, s1, 0, 0, 0); }
              const int i = i0 + l15; const int sg_ = dir ? -1 : 1;
#pragma unroll
              for (int t2 = 0; t2 < 2; ++t2) { const f32x4_t sv = t2 ? s1 : s0; const int jb = j0 + 16 * t2 + 4 * g4; float v4[4];
#pragma unroll
                for (int k = 0; k < 4; ++k) { const bool keep = (jb - i) * sg_ + k * sg_ <= 0; v4[k] = keep ? sv[k] : 0.f; }
                v2u pw; pw.x = cvt_pk_bf16(v4[0], v4[1]); pw.y = cvt_pk_bf16(v4[2], v4[3]);
                *(LAS v2u*)(lds + PS + i * PSTR + jb * 2) = pw; } }
            TMARK(ta1);
            f32x16 acc[2]; acc[0] = (f32x16){0.f}; acc[1] = (f32x16){0.f};
            { const LAS unsigned char* q0 = lds + qA; const LAS unsigned char* q1 = lds + qA + 32 * QSTR;
              bf16x8 n0 = *(const LAS bf16x8*)q0, n1 = *(const LAS bf16x8*)q1, m0 = *(const LAS bf16x8*)(q0 + 32), m1 = *(const LAS bf16x8*)(q1 + 32);
#pragma unroll
              for (int ix = 0; ix < 16; ++ix) { const int T = ix >> 1, s2 = ix & 1; const bf16x8 a0 = n0, a1 = n1; n0 = m0; n1 = m1;
                if (ix + 2 < 16) { m0 = *(const LAS bf16x8*)(q0 + (ix + 2) * 32); m1 = *(const LAS bf16x8*)(q1 + (ix + 2) * 32); }
                v4u bw; bw.x = cvt_pk_bf16(S[T][8 * s2 + 0], S[T][8 * s2 + 1]); bw.y = cvt_pk_bf16(S[T][8 * s2 + 2], S[T][8 * s2 + 3]);
                bw.z = cvt_pk_bf16(S[T][8 * s2 + 4], S[T][8 * s2 + 5]); bw.w = cvt_pk_bf16(S[T][8 * s2 + 6], S[T][8 * s2 + 7]); const bf16x8 bs = __builtin_bit_cast(bf16x8, bw);
                __builtin_amdgcn_sched_barrier(0);
                acc[0] = __builtin_amdgcn_mfma_f32_32x32x16_bf16(a0, bs, acc[0], 0, 0, 0); acc[1] = __builtin_amdgcn_mfma_f32_32x32x16_bf16(a1, bs, acc[1], 0, 0, 0); } }
            TMARK(ta2);
            __syncthreads();
            LOADV(sn);
            TMARK(ta3);
            { bf16x8 vn = cat(tr_read(lds + vtr), tr_read(lds + vtr + 4 * VSTR)), pn0 = *(const LAS bf16x8*)(lds + pA), pn1 = *(const LAS bf16x8*)(lds + pA + 32 * PSTR);
#pragma unroll
              for (int js = 0; js < 4; ++js) { const bf16x8 vfj = vn, p0 = pn0, p1 = pn1;
                if (js + 1 < 4) { vn = cat(tr_read(lds + vtr + (16 * (js + 1)) * VSTR), tr_read(lds + vtr + (16 * (js + 1) + 4) * VSTR)); pn0 = *(const LAS bf16x8*)(lds + pA + (js + 1) * 32); pn1 = *(const LAS bf16x8*)(lds + pA + 32 * PSTR + (js + 1) * 32); }
                __builtin_amdgcn_sched_barrier(0);
                acc[0] = __builtin_amdgcn_mfma_f32_32x32x16_bf16(p0, vfj, acc[0], 0, 0, 0); acc[1] = __builtin_amdgcn_mfma_f32_32x32x16_bf16(p1, vfj, acc[1], 0, 0, 0); } }
            const float rstep = __builtin_amdgcn_exp2f(dir ? -lg2s : lg2s), rstep2 = rstep * rstep, rstep5 = rstep2 * rstep2 * rstep;
            const float rf00 = __builtin_amdgcn_exp2f(lg2s * (float)((dir ? -(4 * hv) : 4 * hv - 63) + odd64)), rf32 = __builtin_amdgcn_exp2f(lg2s * (dir ? -32.0f : 32.0f));
#pragma unroll
            for (int it = 0; it < 2; ++it) { float rf = it ? rf00 * rf32 : rf00;
#pragma unroll
                for (int q = 0; q < 16; ++q) { const int il = crow(q, hv);
                    *(LAS float*)(ost + il * OSTR + rv * 4) = acc[it][q] * rf; rf *= ((q & 3) == 3) ? rstep5 : rstep; }
#pragma unroll
                for (int n = 0; n < 2; ++n) { const int c = (hv * 32 + rv) + 64 * n, row = c >> 2, cq = c & 3;
                    const v4f x0 = *(const LAS v4f*)(ost + row * OSTR + cq * 32), x1 = *(const LAS v4f*)(ost + row * OSTR + cq * 32 + 16);
                    float o[8] = {x0.x, x0.y, x0.z, x0.w, x1.x, x1.y, x1.z, x1.w};
                    if (s >= SPLIT) { float pv[8]; unpack8(pp[2 * it + n], pv); float ss = 0.f;
#pragma unroll
                        for (int k = 0; k < 8; ++k) { o[k] += pv[k]; ss += o[k] * o[k]; }
                        ss += __shfl_xor(ss, 1); ss += __shfl_xor(ss, 2);
                        if (cq == 0) *(LAS float*)(lds + SSL + ((it * 32 + row) * 8 + w) * 4) = ss; }
                    *(v4u*)(op + (size_t)(it * 32 + 16 * n) * 2048) = pack8(o); }
            }
        }
        TMARK(ta4);
        __builtin_amdgcn_sched_barrier(0);
        PREFETCHK(sn);
        PREFETCHQ(sn);
        if (!latent) LOADV(sn);
        {
#define KA_LD(ix_) cat(tr_read(lds + ktr + (16 * ((ix_) >> 3)) * KSTR + ((ix_) & 7) * 64), tr_read(lds + ktr + (16 * ((ix_) >> 3) + 4) * KSTR + ((ix_) & 7) * 64))
#define VF_LD(js_) cat(tr_read(lds + vtr + (16 * (js_)) * VSTR), tr_read(lds + vtr + (16 * (js_) + 4) * VSTR))
          bf16x8 vcur = VF_LD(0), vnx = vcur, kn0 = KA_LD(0), kn1 = KA_LD(1);
#pragma unroll
          for (int ix = 0; ix < 32; ++ix) { const int T = ix & 7, js = ix >> 3; const bf16x8 ka = kn0; kn0 = kn1;
            if (ix + 2 < 32) kn1 = KA_LD(ix + 2);
            if (T == 4 && js < 3) vnx = VF_LD(js + 1);
            __builtin_amdgcn_sched_barrier(0);
            S[T] = __builtin_amdgcn_mfma_f32_32x32x16_bf16(ka, vcur, S[T], 0, 0, 0);
            if (T == 7) vcur = vnx; }
#undef KA_LD
#undef VF_LD
        }
        if (s & 1) {
#pragma unroll
            for (int T = 0; T < 8; ++T) S[T] *= gC2; }
        TMARK(ta5);
        __syncthreads();
        TMARK(ta6);
        if (s >= SPLIT && tid < 64) { const LAS float* pr = (const LAS float*)(lds + SSL + tid * 32); const v4f a = *(const LAS v4f*)pr, c4 = *(const LAS v4f*)(pr + 4);
            SSQ[(size_t)(qrow0 + tid) * 8 + h * 2 + eh] = ((a.x + a.y) + (a.z + a.w)) + ((c4.x + c4.y) + (c4.z + c4.w)); }
    }
#if MK_TIMING
    if (unit == 0 && tid == 0) { unsigned* tw = (unsigned*)SSQ - 64; tw[0] = ta0; tw[1] = ta1; tw[2] = ta2; tw[3] = ta3; tw[4] = ta4; tw[5] = ta5; tw[6] = ta6; }
#endif
#undef STEP_ROWS
#undef PREFETCHK
#undef PREFETCHQ
#undef WRITEQ
#undef LOADV
}
}

constexpr int RING_BYTES = 131072, LDS_BYTES = 157696;
#ifndef MK_ONE_LAUNCH
#define MK_ONE_LAUNCH 1
#endif
constexpr int N_PHASES = 10;
#define LDS_WAIT() asm volatile("s_waitcnt lgkmcnt(0)" ::: "memory")
constexpr int MISC_OFF = 155648 + 320;
constexpr int CW_BAR = 4096;
constexpr size_t CTL_ZERO_BYTES = 65536;
#ifndef MK_NAIVE_ATTN
#define MK_NAIVE_ATTN 0
#endif
#ifndef MK_NAIVE_RET
#define MK_NAIVE_RET 0
#endif
#ifndef MK_DEBUG_ATTN
#define MK_DEBUG_ATTN 0
#endif
#ifndef MK_DBG_H
#define MK_DBG_H 0
#endif
#ifndef MK_DBG_L0
#define MK_DBG_L0 768
#define MK_DBG_L1 1280
#endif
#ifndef MK_DEBUG_RET
#define MK_DEBUG_RET 0
#endif
#ifndef MK_STAMP_A
#define MK_STAMP_A -1
#define MK_STAMP_B -1
#endif
#ifndef MK_REP_P4
#define MK_REP_P4 1
#endif
#ifndef MK_REP_P5
#define MK_REP_P5 1
#endif
#ifndef MK_REP_P6
#define MK_REP_P6 1
#endif
#ifndef MK_REP_P2
#define MK_REP_P2 1
#endif
#ifndef MK_REP_P9
#define MK_REP_P9 1
#endif
#ifndef MK_NSTAG
#define MK_NSTAG 1
#define MK_STAG_TICKS 500
#endif
#ifndef MK_ATTN_PROBE
#define MK_ATTN_PROBE 0
#endif
#ifndef MK_TR_IN_P0
#define MK_TR_IN_P0 0
#endif
#ifndef MK_P1ORD
#define MK_P1ORD 1
#endif
#ifndef MK_MIX
#define MK_MIX 0
#endif
#ifndef MK_EPIW
#define MK_EPIW 0
#endif
#ifndef MK_BARRIER
#define MK_BARRIER 1
#endif
#define XB_TMO      128
#define XB_XCNT(j)  (256  + 64 * (j))
#define XB_XSUB(j)  (1280 + 64 * (j))
#define XB_XGEN(j)  (2304 + 64 * (j))
#define XB_TOP      3328
#define XB_TOPGEN   3392
#define XCD_BAR_WORDS 3456
#define XB_SPIN_CAP (1u << 18)

__device__ __forceinline__ unsigned xb_ld(unsigned* p)              { return __hip_atomic_load(p, __ATOMIC_RELAXED, __HIP_MEMORY_SCOPE_AGENT); }
__device__ __forceinline__ unsigned xb_add(unsigned* p, unsigned v) { return __hip_atomic_fetch_add(p, v, __ATOMIC_RELAXED, __HIP_MEMORY_SCOPE_AGENT); }
__device__ __forceinline__ unsigned xb_xcc_id() { return (unsigned)__builtin_amdgcn_s_getreg((3 << 11) | 20) & 0xFu; }
#define XB_SPIN(cond, bar) do { unsigned _sp = 0; while (cond) { __builtin_amdgcn_s_sleep(1); \
    if ((++_sp & 255u) == 0u) { if (xb_ld(&(bar)[XB_TMO])) break; if (_sp > XB_SPIN_CAP) { atomicAdd(&(bar)[XB_TMO], 1u); break; } } } } while (0)

struct XcdBarrier {
    unsigned* bar; unsigned x;
    volatile LAS unsigned* st;
};

__device__ __forceinline__ XcdBarrier xcd_barrier_post(unsigned* bar, volatile LAS unsigned* st) {
    XcdBarrier b; b.bar = bar; b.x = xb_xcc_id(); b.st = st;
    if (threadIdx.x == 0) (void)xb_add(&bar[XB_XCNT(b.x)], 1u);
    return b;
}
__device__ __forceinline__ void xcd_barrier_complete(unsigned* bar, unsigned x, unsigned& nloc, unsigned& nx) {
    const unsigned G = gridDim.x * gridDim.y * gridDim.z;
    unsigned sum, cnt, mine, sp = 0u;
    for (;;) {
        sum = 0u; cnt = 0u; mine = 0u;
#pragma unroll
        for (unsigned j = 0; j < 16; ++j) { const unsigned c = xb_ld(&bar[XB_XCNT(j)]); sum += c; cnt += (c > 0u) ? 1u : 0u; mine = (j == x) ? c : mine; }
        if (sum == G) break;
        __builtin_amdgcn_s_sleep(1);
        if ((++sp & 255u) == 0u) { if (xb_ld(&bar[XB_TMO])) break; if (sp > XB_SPIN_CAP) { atomicAdd(&bar[XB_TMO], 1u); break; } }
    }
    nloc = mine > 0u ? mine : 1u; nx = cnt > 0u ? cnt : 1u;
}

__device__ __forceinline__ void xcd_barrier(const XcdBarrier& b) {
    asm volatile("s_waitcnt vmcnt(0)" ::: "memory");
    __syncthreads();
    if (threadIdx.x == 0) {
        unsigned* bar = b.bar;
        __builtin_amdgcn_s_waitcnt(0);
        unsigned nloc = b.st[0], nx = b.st[1];
        if (nloc == 0u) { xcd_barrier_complete(bar, b.x, nloc, nx); b.st[0] = nloc; b.st[1] = nx; }
        const unsigned old = xb_add(&bar[XB_XSUB(b.x)], 1u);
        const unsigned gen = old / nloc;
        if (old + 1u == (gen + 1u) * nloc) {
            __builtin_amdgcn_fence(__ATOMIC_RELEASE, "agent");
            asm volatile("s_waitcnt vmcnt(0)" ::: "memory");
            const unsigned og = xb_add(&bar[XB_TOP], 1u);
            const unsigned tg = og / nx;
            if (og + 1u == (tg + 1u) * nx) xb_add(&bar[XB_TOPGEN], 1u);
            else XB_SPIN(xb_ld(&bar[XB_TOPGEN]) == tg, bar);
            __builtin_amdgcn_fence(__ATOMIC_ACQUIRE, "agent");
            xb_add(&bar[XB_XGEN(b.x)], 1u);
            asm volatile("s_waitcnt vmcnt(0)" ::: "memory");
        } else {
            XB_SPIN(xb_ld(&bar[XB_XGEN(b.x)]) == gen, bar);
            __builtin_amdgcn_fence(__ATOMIC_ACQUIRE, "agent");
            asm volatile("s_waitcnt vmcnt(0)" ::: "memory");
        }
    }
    __syncthreads();
}


struct Args { const float* in[14]; float* out; unsigned char* ws; int ph_lo, ph_hi; };

__device__ __forceinline__ void p0_mod_item(const float* c, const float* c_ctx, const float* w_ada, const float* b_ada, float* MOD, float* ldsf, int item, int tid) {
    float* sc = ldsf; float* red = ldsf + 17 * 1024;
    for (int i = tid; i < 17 * 1024; i += NTHR) { const float v = i < 16 * 1024 ? c[i] : c_ctx[i - 16 * 1024]; sc[i] = v / (1.0f + expf(-v)); }
    const int col = tid & 15, ks = tid >> 4, n = item * 16 + col;
    float wv[32];
#pragma unroll
    for (int k = 0; k < 32; ++k) wv[k] = w_ada[(size_t)(ks * 32 + k) * 3072 + n];
    __syncthreads();
    float acc[17];
#pragma unroll
    for (int r = 0; r < 17; ++r) acc[r] = 0.f;
#pragma unroll
    for (int k = 0; k < 32; ++k) {
#pragma unroll
        for (int r = 0; r < 17; ++r) acc[r] += sc[r * 1024 + ks * 32 + k] * wv[k]; }
#pragma unroll
    for (int r = 0; r < 17; ++r) red[(ks * 17 + r) * 16 + col] = acc[r];
    __syncthreads();
    if (tid < 17 * 16) { const int r = tid >> 4, cc = tid & 15; float s = b_ada[item * 16 + cc];
        for (int k2 = 0; k2 < 32; ++k2) s += red[(k2 * 17 + r) * 16 + cc];
        MOD[r * 3072 + item * 16 + cc] = s; }
    __syncthreads();
}
__device__ __forceinline__ void p0_transpose_item(const float* W, int K, int N, bf16_t* WT, int row_off, float* scr, int item, int lane) {
    const int nblk = N / 32, kb = item / nblk, nb = item % nblk, k0 = 64 * kb, n0 = 32 * nb;
    float tv[32];
#pragma unroll
    for (int i = 0; i < 32; ++i) { const int kk = 2 * i + (lane >> 5); tv[i] = W[(size_t)(k0 + kk) * N + n0 + (lane & 31)]; }
#pragma unroll
    for (int i = 0; i < 32; ++i) { const int kk = 2 * i + (lane >> 5); scr[kk * 33 + (lane & 31)] = tv[i]; }
    LDS_WAIT(); asm volatile("" ::: "memory");
    const int c = lane & 7;
#pragma unroll
    for (int j = 0; j < 4; ++j) { const int n = (lane >> 3) + 8 * j; const float* s = scr + (8 * c) * 33 + n;
        v4u o; o.x = pk2(s[0 * 33], s[1 * 33]); o.y = pk2(s[2 * 33], s[3 * 33]); o.z = pk2(s[4 * 33], s[5 * 33]); o.w = pk2(s[6 * 33], s[7 * 33]);
        *(v4u*)(WT + (size_t)(row_off + n0 + n) * K + k0 + 8 * c) = o; }
    LDS_WAIT(); asm volatile("" ::: "memory");
}
__device__ __forceinline__ void p0_transpose64_item(const float* W, int K, int N, bf16_t* WT, int row_off, float* scr, int item, int lane, unsigned char* WT8 = nullptr, int row_off8 = 0) {
    const int nblk = N / 64, kb = item / nblk, nb = item % nblk, k0 = 64 * kb, n0 = 64 * nb;
    v4f tv[16]; const int lr = lane >> 4, lc = (lane & 15) * 4;
#pragma unroll
    for (int i = 0; i < 16; ++i) tv[i] = *(const v4f*)(W + (size_t)(k0 + 4 * i + lr) * N + n0 + lc);
#pragma unroll
    for (int i = 0; i < 16; ++i) { float* d = scr + (4 * i + lr) * 65 + lc; d[0] = tv[i].x; d[1] = tv[i].y; d[2] = tv[i].z; d[3] = tv[i].w; }
    LDS_WAIT(); asm volatile("" ::: "memory");
    const int c = lane & 7;
#pragma unroll
    for (int j = 0; j < 8; ++j) { const int n = (lane >> 3) + 8 * j; const float* s = scr + (8 * c) * 65 + n;
        v4u o; o.x = pk2(s[0 * 65], s[1 * 65]); o.y = pk2(s[2 * 65], s[3 * 65]); o.z = pk2(s[4 * 65], s[5 * 65]); o.w = pk2(s[6 * 65], s[7 * 65]);
        *(v4u*)(WT + (size_t)(row_off + n0 + n) * K + k0 + 8 * c) = o;
        if (WT8) { v2u w; w.x = pk4_fp8(s[0 * 65] * F8W_MUL, s[1 * 65] * F8W_MUL, s[2 * 65] * F8W_MUL, s[3 * 65] * F8W_MUL); w.y = pk4_fp8(s[4 * 65] * F8W_MUL, s[5 * 65] * F8W_MUL, s[6 * 65] * F8W_MUL, s[7 * 65] * F8W_MUL);
            *(v2u*)(WT8 + (size_t)(row_off8 + n0 + n) * K + k0 + 8 * c) = w; } }
    LDS_WAIT(); asm volatile("" ::: "memory");
}
__device__ __forceinline__ int new_col(int o) { return o < 4608 ? o : (o < 6656 ? o + 1024 : (o < 7680 ? o - 2048 : o)); }

__device__ __forceinline__ void sincos_d(double a, float& c, float& s) {
    const double TWO_PI = 6.283185307179586476925;
    const double k = (double)(long long)(a / TWO_PI + (a >= 0 ? 0.5 : -0.5)); const double r = a - k * TWO_PI, r2 = r * r;
    double ts = r, ss = r, tc = 1.0, cc = 1.0;
    for (int n = 1; n <= 15; ++n) { tc *= -r2 / (double)((2 * n - 1) * (2 * n)); cc += tc; ts *= -r2 / (double)((2 * n) * (2 * n + 1)); ss += ts; }
    c = (float)cc; s = (float)ss;
}

__device__ __forceinline__ void p1_row(const float* xrow, const float* nw, const float* shift, const float* scale, bf16_t* orow, int lane) {
    const v4f* xr = (const v4f*)xrow + lane; v4f v[4]; float s = 0.f;
#pragma unroll
    for (int j = 0; j < 4; ++j) { v[j] = xr[64 * j]; s += (v[j].x * v[j].x + v[j].y * v[j].y) + (v[j].z * v[j].z + v[j].w * v[j].w); }
    const float rstd = 1.0f / sqrtf(wave_sum(s) * (1.0f / 1024.0f) + EPS);
    v2u* o8 = (v2u*)orow + lane;
#pragma unroll
    for (int j = 0; j < 4; ++j) { const v4f w = ((const v4f*)nw)[lane + 64 * j], sh = ((const v4f*)shift)[lane + 64 * j], sc = ((const v4f*)scale)[lane + 64 * j];
        const v4f y = v[j] * rstd * w * (sc + 1.0f) + sh; v2u o; o.x = pk2(y.x, y.y); o.y = pk2(y.z, y.w); o8[64 * j] = o; }
}

template <int NR>
__device__ __forceinline__ void p1_rowsN(const float* x, const float* ctx, const float* MOD, const v4f (&nwv)[4], bf16_t* HX, int r0, int rlast, int lane, unsigned char* HX8 = nullptr) {
    v4f v[NR][4];
#pragma unroll
    for (int k = 0; k < NR; ++k) { const int m = r0 + k < rlast ? r0 + k : rlast; const float* xr = m < MLAT ? x + (size_t)m * 1024 : ctx + (size_t)(m - MLAT) * 1024;
#pragma unroll
        for (int j = 0; j < 4; ++j) v[k][j] = __builtin_nontemporal_load((const v4f*)xr + lane + 64 * j); }
#pragma unroll
    for (int k = 0; k < NR; ++k) { const int m = r0 + k < rlast ? r0 + k : rlast; const float* mp = MOD + (m < MLAT ? (m >> 11) : 16) * 3072; float s = 0.f;
        v4f sh[4], sc[4];
#pragma unroll
        for (int j = 0; j < 4; ++j) { sh[j] = ((const v4f*)mp)[lane + 64 * j]; sc[j] = ((const v4f*)(mp + 1024))[lane + 64 * j]; }
#pragma unroll
        for (int j = 0; j < 4; ++j) s += (v[k][j].x * v[k][j].x + v[k][j].y * v[k][j].y) + (v[k][j].z * v[k][j].z + v[k][j].w * v[k][j].w);
        const float rstd = 1.0f / sqrtf(wave_sum(s) * (1.0f / 1024.0f) + EPS);
        v2u* o8 = (v2u*)(HX + (size_t)m * 1024) + lane;
#pragma unroll
        for (int j = 0; j < 4; ++j) { const v4f y = v[k][j] * rstd * nwv[j] * (sc[j] + 1.0f) + sh[j]; v2u o; o.x = pk2(y.x, y.y); o.y = pk2(y.z, y.w); o8[64 * j] = o;
            if (HX8) ((unsigned*)(HX8 + (size_t)m * 1024))[lane + 64 * j] = pk4_fp8(y.x, y.y, y.z, y.w); } }
}

__device__ __forceinline__ void p3_item(bf16_t* buf, int ldlog2, bool isK, const float* nw, const float* ROPE, size_t item, int lane) {
    const size_t e = item * 512 + (size_t)lane * 8; const size_t row = e >> ldlog2; const int col = (int)(e & ((1u << ldlog2) - 1)), d0 = col & 127;
    float t[8]; unpack8(*(const v4u*)(buf + e), t);
    float ss = 0.f;
#pragma unroll
    for (int k = 0; k < 8; ++k) ss += t[k] * t[k];
    ss += __shfl_xor(ss, 1); ss += __shfl_xor(ss, 2); ss += __shfl_xor(ss, 4); ss += __shfl_xor(ss, 8);
    const float rstd = 1.0f / sqrtf(ss * (1.0f / 128.0f) + EPS);
#pragma unroll
    for (int k = 0; k < 8; ++k) t[k] = t[k] * rstd * nw[d0 + k];
    int l; bool rope = true;
    if (isK) { const int p = (int)(row % LT); rope = p >= LC; l = p - LC; } else l = (int)(row & (SEQ - 1));
    if (rope) { const int ri = l >> 6, ci = l & 63, p0 = d0 >> 1; const float* tab = p0 < 32 ? ROPE + (ri * 32 + p0) * 2 : ROPE + (ci * 32 + (p0 - 32)) * 2;
#pragma unroll
        for (int q = 0; q < 4; ++q) { const float cs = tab[2 * q], sn = tab[2 * q + 1], x0 = t[2 * q], x1 = t[2 * q + 1]; t[2 * q] = x0 * cs - x1 * sn; t[2 * q + 1] = x0 * sn + x1 * cs; } }
    *(v4u*)(buf + e) = pack8(t);
}

template <int NI>
__device__ __forceinline__ void p3_items_k(bf16_t* AK, const float* nw, const float* ROPE, size_t it0, size_t itend, int lane, unsigned char* K8 = nullptr) {
    v4u raw[NI];
#pragma unroll
    for (int i = 0; i < NI; ++i) if (it0 + i < itend) raw[i] = *(const v4u*)(AK + (it0 + i) * 512 + (size_t)lane * 8);
#pragma unroll
    for (int i = 0; i < NI; ++i) if (it0 + i < itend) {
        const size_t e = (it0 + i) * 512 + (size_t)lane * 8; const size_t row = e >> 8; const int d0 = (int)(e & 255) & 127;
        float t[8]; unpack8(raw[i], t); float ss = 0.f;
#pragma unroll
        for (int k = 0; k < 8; ++k) ss += t[k] * t[k];
        ss += __shfl_xor(ss, 1); ss += __shfl_xor(ss, 2); ss += __shfl_xor(ss, 4); ss += __shfl_xor(ss, 8);
        const float rstd = 1.0f / sqrtf(ss * (1.0f / 128.0f) + EPS);
#pragma unroll
        for (int k = 0; k < 8; ++k) t[k] = t[k] * rstd * nw[d0 + k];
        const int p = (int)(row % LT);
        if (p >= LC) { const int l = p - LC, ri = l >> 6, ci = l & 63, p0 = d0 >> 1; const float* tab = p0 < 32 ? ROPE + (ri * 32 + p0) * 2 : ROPE + (ci * 32 + (p0 - 32)) * 2;
#pragma unroll
            for (int q = 0; q < 4; ++q) { const float cs = tab[2 * q], sn = tab[2 * q + 1], x0 = t[2 * q], x1 = t[2 * q + 1]; t[2 * q] = x0 * cs - x1 * sn; t[2 * q + 1] = x0 * sn + x1 * cs; } }
#if !(MK_FP8K) || MK_NAIVE_ATTN || MK_DEBUG_ATTN
        *(v4u*)(AK + e) = pack8(t);
#endif
#if MK_FP8K
        if (K8) { int w0 = __builtin_amdgcn_cvt_pk_fp8_f32(t[0], t[1], 0, false); w0 = __builtin_amdgcn_cvt_pk_fp8_f32(t[2], t[3], w0, true);
            int w1 = __builtin_amdgcn_cvt_pk_fp8_f32(t[4], t[5], 0, false); w1 = __builtin_amdgcn_cvt_pk_fp8_f32(t[6], t[7], w1, true);
            const int g = ((int)(e & 255)) >> 7, pb = (d0 & 64) + 32 * ((d0 >> 3) & 1) + 8 * ((d0 >> 4) & 3); v2u w; w.x = (unsigned)w0; w.y = (unsigned)w1;
            *(v2u*)(K8 + row * 256 + g * 128 + pb) = w; }
#endif
        }
}

__device__ __forceinline__ void vt8_load(const bf16_t* AV, int item, int lane, v4u (&v)[4]) {
    const int dq = item & 3, tl = item >> 2, T = tl % 36, bg = tl / 36, b = bg >> 1, g = bg & 1;
    const bf16_t* src = AV + ((size_t)(b * LT + 64 * T)) * 256 + g * 128 + dq * 32;
#pragma unroll
    for (int i = 0; i < 4; ++i) { const int ci = lane + 64 * i, row = ci >> 2, c16 = ci & 3; v[i] = *(const v4u*)(src + (size_t)row * 256 + c16 * 8); }
}
__device__ __forceinline__ void vt8_proc(unsigned char* VT8, LAS unsigned char* scr, int item, int lane, const v4u (&v)[4]) {
    const int dq = item & 3, tl = item >> 2;
#pragma unroll
    for (int i = 0; i < 4; ++i) { const int ci = lane + 64 * i, row = ci >> 2, c16 = ci & 3; *(LAS v4u*)(scr + row * 80 + c16 * 16) = v[i]; }
    asm volatile("s_waitcnt lgkmcnt(0)" ::: "memory");
    const int dp = lane >> 2, cc = lane & 3; float f0[16], f1[16];
#pragma unroll
    for (int i = 0; i < 16; ++i) { const int key = 32 * (cc >> 1) + (i & 3) + 8 * ((i >> 2) & 3) + 4 * (cc & 1); const unsigned w = *(const LAS unsigned*)(scr + key * 80 + dp * 4); f0[i] = bflo(w); f1[i] = bfhi(w); }
    unsigned char* dst = VT8 + (size_t)tl * 8192 + (size_t)(dq * 32 + 2 * dp) * 64 + cc * 16;
    v4u w0, w1;
    w0.x = pk4_fp8(f0[0], f0[1], f0[2], f0[3]); w0.y = pk4_fp8(f0[4], f0[5], f0[6], f0[7]); w0.z = pk4_fp8(f0[8], f0[9], f0[10], f0[11]); w0.w = pk4_fp8(f0[12], f0[13], f0[14], f0[15]);
    w1.x = pk4_fp8(f1[0], f1[1], f1[2], f1[3]); w1.y = pk4_fp8(f1[4], f1[5], f1[6], f1[7]); w1.z = pk4_fp8(f1[8], f1[9], f1[10], f1[11]); w1.w = pk4_fp8(f1[12], f1[13], f1[14], f1[15]);
    *(v4u*)dst = w0; *(v4u*)(dst + 64) = w1;
    asm volatile("s_waitcnt lgkmcnt(0)" ::: "memory");
}

__device__ __forceinline__ void p4_naive_item(const bf16_t* RQ, const bf16_t* RK, const bf16_t* RV, bf16_t* YR, float* SSQ, const float* l2d, float* ldsf, int item, int tid) {
    const int rb = item & 255, h = (item >> 8) & 3, b = item >> 10, i0 = rb * 8;
    float* qs = ldsf; float* sc = ldsf + 2048; float* red = sc + 8 * LT;
    for (int t = tid; t < 2048; t += NTHR) { const int r = t >> 8, d = t & 255; qs[t] = bf2f(RQ[((size_t)(b * SEQ + i0 + r)) * 1024 + h * 256 + d]); }
    __syncthreads();
    const float lgf = log1pf(-exp2f(l2d[h])), lgb = log1pf(-exp2f(l2d[4 + h]));
    for (int p = tid; p < LT; p += NTHR) {
        const bf16_t* kr = RK + ((size_t)(b * LT + p)) * 1024 + h * 256;
        float dot[8];
#pragma unroll
        for (int r = 0; r < 8; ++r) dot[r] = 0.f;
        for (int d8 = 0; d8 < 32; ++d8) { float kk[8]; unpack8(*(const v4u*)(kr + d8 * 8), kk);
#pragma unroll
            for (int r = 0; r < 8; ++r)
#pragma unroll
                for (int k = 0; k < 8; ++k) dot[r] += qs[r * 256 + d8 * 8 + k] * kk[k]; }
#pragma unroll
        for (int r = 0; r < 8; ++r) { const int i = i0 + r; float W;
            if (p < LC) W = MK_DBG_NOCTX ? 0.f : expf(lgf * (float)(i + LC - p)) + expf(lgb * (float)(SEQ - i + p));
            else { const int j = p - LC; W = (j <= i ? expf(lgf * (float)(i - j)) : 0.f) + (j >= i ? expf(lgb * (float)(j - i)) : 0.f); }
            sc[r * LT + p] = dot[r] * W; }
    }
    __syncthreads();
    float acc[8];
#pragma unroll
    for (int r = 0; r < 8; ++r) acc[r] = 0.f;
    const bf16_t* vp = RV + (size_t)(b * LT) * 2048 + h * 512 + tid;
    for (int p = 0; p < LT; ++p) { const float v = bf2f(vp[(size_t)p * 2048]);
#pragma unroll
        for (int r = 0; r < 8; ++r) acc[r] += sc[r * LT + p] * v; }
    const int wid = tid >> 6, lane = tid & 63;
#pragma unroll
    for (int r = 0; r < 8; ++r) { YR[((size_t)(b * SEQ + i0 + r)) * 2048 + h * 512 + tid] = (bf16_t)f2bf(acc[r]); const float s = wave_sum(acc[r] * acc[r]); if (lane == 0) red[r * 8 + wid] = s; }
    __syncthreads();
    if (tid < 16) { const int r = tid >> 1, hf = tid & 1; const float s = (red[r * 8 + hf * 4] + red[r * 8 + hf * 4 + 1]) + (red[r * 8 + hf * 4 + 2] + red[r * 8 + hf * 4 + 3]);
        SSQ[((size_t)(b * SEQ + i0 + r)) * 8 + h * 2 + hf] = s; }
    __syncthreads();
}

__device__ __forceinline__ void p5_naive_item(bf16_t* AQ, const bf16_t* AK, const bf16_t* AV, float* ldsf, int item, int tid) {
    const int rb = item & 255, head = (item >> 8) & 7, b = item >> 11, g = head >> 2, i0 = rb * 8;
    float* qs = ldsf; float* sc = ldsf + 1024;
    for (int t = tid; t < 1024; t += NTHR) { const int r = t >> 7, d = t & 127; qs[t] = bf2f(AQ[((size_t)(b * SEQ + i0 + r)) * 1024 + head * 128 + d]); }
    __syncthreads();
    for (int p = tid; p < LT; p += NTHR) {
        const bf16_t* kr = AK + ((size_t)(b * LT + p)) * 256 + g * 128;
        float dot[8];
#pragma unroll
        for (int r = 0; r < 8; ++r) dot[r] = 0.f;
        for (int d8 = 0; d8 < 16; ++d8) { float kk[8]; unpack8(*(const v4u*)(kr + d8 * 8), kk);
#pragma unroll
            for (int r = 0; r < 8; ++r)
#pragma unroll
                for (int k = 0; k < 8; ++k) dot[r] += qs[r * 128 + d8 * 8 + k] * kk[k]; }
#pragma unroll
        for (int r = 0; r < 8; ++r) sc[r * LT + p] = dot[r] * 0.08838834764831845f;
    }
    __syncthreads();
    { const int wid = tid >> 6, lane = tid & 63; float* row = sc + wid * LT; float m = -1e30f;
      for (int p = lane; p < LT; p += 64) m = fmaxf(m, row[p]);
#pragma unroll
      for (int o = 1; o < 64; o <<= 1) m = fmaxf(m, __shfl_xor(m, o));
      float s = 0.f;
      for (int p = lane; p < LT; p += 64) { const float ex = expf(row[p] - m); row[p] = ex; s += ex; }
      s = wave_sum(s); const float inv = 1.0f / s;
      for (int p = lane; p < LT; p += 64) row[p] *= inv; }
    __syncthreads();
    const int e = tid & 127, r0 = (tid >> 7) * 2; float a0 = 0.f, a1 = 0.f;
    const bf16_t* vp = AV + (size_t)(b * LT) * 256 + g * 128 + e;
    for (int p = 0; p < LT; ++p) { const float v = bf2f(vp[(size_t)p * 256]); a0 += sc[r0 * LT + p] * v; a1 += sc[(r0 + 1) * LT + p] * v; }
    AQ[((size_t)(b * SEQ + i0 + r0)) * 1024 + head * 128 + e] = (bf16_t)f2bf(a0);
    AQ[((size_t)(b * SEQ + i0 + r0 + 1)) * 1024 + head * 128 + e] = (bf16_t)f2bf(a1);
    __syncthreads();
}

#if MK_BARRIER == 1
struct GridBarF { XcdBarrier b; __device__ __forceinline__ void operator()() const { xcd_barrier(b); } };
#else
struct GridBarF { __device__ __forceinline__ void operator()() const { cooperative_groups::this_grid().sync(); } };
#endif
__device__ __forceinline__ void ssq_item(const bf16_t* YR, float* SSQ, int it, int lane) {
    const int row = it >> 2, head = it & 3; float t[8]; unpack8(*(const v4u*)(YR + (size_t)row * 2048 + head * 512 + lane * 8), t);
    float ss = 0.f;
#pragma unroll
    for (int k = 0; k < 8; ++k) ss += t[k] * t[k];
    ss = wave_sum(ss);
    if (lane == 0) { SSQ[(size_t)row * 8 + head * 2] = ss; SSQ[(size_t)row * 8 + head * 2 + 1] = 0.f; }
}
__global__ void __launch_bounds__(NTHR, 2) mk_fwd(Args args) {
    extern __shared__ __attribute__((aligned(16))) unsigned char lds[];
    const int tid = threadIdx.x, lane = tid & 63, wave = __builtin_amdgcn_readfirstlane(tid >> 6);
    const int G = gridDim.x, bid = blockIdx.x;
    const int gw = bid * NWAVES + wave, NGW = G * NWAVES;
    float* ldsf = (float*)lds;
    unsigned char* ws = args.ws;
    const float *x = args.in[0], *cvec = args.in[1], *ctx = args.in[2], *c_ctx = args.in[3], *norm_w = args.in[4], *w_ada = args.in[5], *b_ada = args.in[6], *w_in = args.in[7],
                *l2d = args.in[8], *q_norm_w = args.in[9], *k_norm_w = args.in[10], *w_o_ret = args.in[11], *w_o_att = args.in[12], *w_out = args.in[13];
    float* MOD = (float*)(ws + WS_MOD); float* ROPE = (float*)(ws + WS_ROPE); float* SSQ = (float*)(ws + WS_SSQ);
    bf16_t *WIN = (bf16_t*)(ws + WS_WIN), *WOR = (bf16_t*)(ws + WS_WOR), *WOA = (bf16_t*)(ws + WS_WOA), *WOUT = (bf16_t*)(ws + WS_WOUT), *HX = (bf16_t*)(ws + WS_HX);
    bf16_t *RK = (bf16_t*)(ws + WS_RK), *RV = (bf16_t*)(ws + WS_RV), *RQ = (bf16_t*)(ws + WS_RQ), *AK = (bf16_t*)(ws + WS_AK), *AV = (bf16_t*)(ws + WS_AV), *AQ = (bf16_t*)(ws + WS_AQ);
    bf16_t *U1 = (bf16_t*)(ws + WS_U1), *U2 = (bf16_t*)(ws + WS_U2), *YR = (bf16_t*)args.out;
    const int lo = args.ph_lo, hi = args.ph_hi;
#define IN(k) (lo <= (k) && (k) < hi)
#define BOTH(k) (IN(k) && IN((k) + 1))
    if (tid < 32) ((LAS unsigned*)(lds + MISC_OFF))[tid] = 0u;
    __syncthreads();
#if MK_BARRIER == 1
    XcdBarrier bar; bar.bar = (unsigned*)(ws + WS_CTL) + CW_BAR; bar.x = 0; bar.st = nullptr;
    if (hi - lo > 1) bar = xcd_barrier_post((unsigned*)(ws + WS_CTL) + CW_BAR, (volatile LAS unsigned*)(lds + MISC_OFF) + 8);
#define GRID_BAR() xcd_barrier(bar)
#else
#define GRID_BAR() cooperative_groups::this_grid().sync()
#endif

#if MK_STAMP_A >= 0
#define STAMP(k) do { if (bid == 0 && tid == 0) { if ((k) == MK_STAMP_A) ((volatile LAS unsigned*)(lds + MISC_OFF))[17] = (unsigned)__builtin_amdgcn_s_memrealtime(); if ((k) == MK_STAMP_B) ((volatile LAS unsigned*)(lds + MISC_OFF))[18] = (unsigned)__builtin_amdgcn_s_memrealtime(); } } while (0)
#else
#define STAMP(k) do { } while (0)
#endif
#define STAGGER() do { if (MK_NSTAG > 1) { const unsigned grp = ((unsigned)bid >> 3) % MK_NSTAG; const unsigned long long t0_ = __builtin_amdgcn_s_memrealtime(); \
        while (__builtin_amdgcn_s_memrealtime() - t0_ < (unsigned long long)grp * MK_STAG_TICKS) __builtin_amdgcn_s_sleep(16); } } while (0)
    auto p1_transposes = [&]()
        {
        float* scr = ldsf + wave * (64 * 65);
        constexpr int I_IN = 16 * (NIN / 64), I_OR = 32 * 16, I_OA = 16 * 16, I_OUT = 16 * 16;
        for (int it = gw; it < I_IN + I_OR + I_OA + I_OUT; it += NGW) {
            int r = it;
            if (r < I_IN) { const int n0 = 64 * (r % (NIN / 64)), gr = new_col(n0);
                const int r8 = (MK_FP8G >= 2) ? ((gr >= 3072 && gr < 3584) ? gr - 3072 : ((gr >= 4608 && gr < 5632) ? gr - 4608 + 512 : ((MK_AG8 && gr >= 7680 && gr < 8704) ? gr - 7680 + 1536 : -1))) : -1;
                p0_transpose64_item(w_in, 1024, NIN, WIN, gr - n0, scr, r, lane, r8 >= 0 ? ws + WS_WIN8 : (unsigned char*)nullptr, r8 - n0); continue; } r -= I_IN;
            if (r < I_OR) { p0_transpose64_item(w_o_ret, 2048, 1024, WOR, 0, scr, r, lane); continue; } r -= I_OR;
            if (r < I_OA) { p0_transpose64_item(w_o_att, 1024, 1024, WOA, 0, scr, r, lane, MK_FP8G ? ws + WS_WOA8 : (unsigned char*)nullptr, 0); continue; } r -= I_OA;
            p0_transpose64_item(w_out, 1024, 1024, WOUT, 0, scr, r, lane);
        }
        };
    STAMP(0);
    if (IN(0)) {
        for (int it = bid; it < 192; it += G) p0_mod_item(cvec, c_ctx, w_ada, b_ada, MOD, ldsf, it, tid);
        if (bid == G - 1) for (int t = tid; t < 2048; t += NTHR) { const int v = t >> 5, i = t & 31; double fd = 1.0; for (int k = 0; k < i; ++k) fd *= 0.7498942093324559;
            const float ang = (float)v * (float)fd; float cs, sn; sincos_d((double)ang, cs, sn); ROPE[2 * t] = cs; ROPE[2 * t + 1] = sn; }
#if MK_TR_IN_P0
        __syncthreads(); p1_transposes();
#endif
        if (BOTH(0)) GRID_BAR();
    }
    STAMP(1);
    if (IN(1)) {
        auto p1_rows = [&]()
        {
            const int rpw = (MALL + NGW - 1) / NGW, m0 = gw * rpw, m1 = m0 + rpw < MALL ? m0 + rpw : MALL;
            v4f nwv[4];
#pragma unroll
            for (int j = 0; j < 4; ++j) nwv[j] = ((const v4f*)norm_w)[lane + 64 * j];
            for (int m = m0; m < m1; m += 9) p1_rowsN<9>(x, ctx, MOD, nwv, HX, m, m1 - 1, lane, MK_FP8G >= 2 ? (unsigned char*)args.out : (unsigned char*)nullptr);
        };
#if MK_TR_IN_P0
        p1_rows();
#else
        if ((wave & 1) == MK_P1ORD) { p1_rows(); p1_transposes(); } else { p1_transposes(); p1_rows(); }
#endif
        if (BOTH(1)) GRID_BAR();
    }
    STAMP(2);
    if (IN(2)) {
        STAGGER();
        pg8::Gemm g{HX, WIN, MALL, N1, 1024}; pg8::Sched1 S; S.init(G, bid);
        pg8::Epi1 E{RK, RV, AK, AV, RQ, AQ, nullptr};
#if MK_P2PROBE == 4
        { pg8::Epi1T<2> EC{RK, RV, AK, AV, RQ, AQ, nullptr}; pg8::gemm_phase<pg8::Epi1T<2>, pg8::Sched1, true, true, MK_EPIW>((PG8_LAS unsigned char*)lds, g, S, EC); }
        __syncthreads();
#endif
#if MK_FP8G >= 2
        { pg8::SchedG1 S0; S0.init(G, bid, 0); pg8::gemm_phase<pg8::Epi1, pg8::SchedG1, true, true, MK_EPIW>((PG8_LAS unsigned char*)lds, g, S0, E); }
        { pg8::SchedG1 S1; S1.init(G, bid, 1); pg8::Gemm g8{(const bf16_t*)args.out, (const bf16_t*)(ws + WS_WIN8), MALL, MK_AG8 ? 2560 : 1536, 512, 0x7F7F7F7F, F8W_SC}; pg8::Epi1F8 E8{E, ws + WS_Q8, ws + WS_G8};
          pg8::gemm_phase<pg8::Epi1F8, pg8::SchedG1, true, true, MK_EPIW, true>((PG8_LAS unsigned char*)lds, g8, S1, E8); }
#else
        for (int rep = 0; rep < MK_REP_P2; ++rep) pg8::gemm_phase<pg8::Epi1, pg8::Sched1, true, true, MK_EPIW>((PG8_LAS unsigned char*)lds, g, S, E);
#endif
#if MK_P2PROBE == 1
        { pg8::Epi1T<1> ED{RK, RV, AK, AV, RQ, AQ, (bf16_t*)(ws + WS_END)}; pg8::gemm_phase<pg8::Epi1T<1>, pg8::Sched1, true, true, MK_EPIW>((PG8_LAS unsigned char*)lds, g, S, ED); }
#endif
#if MK_P2PROBE == 3
        { pg8::Epi1T<0> ER{RK, RV, AK, AV, RQ, AQ, nullptr}; pg8::gemm_phase<pg8::Epi1T<0>, pg8::Sched1, true, true, MK_EPIW>((PG8_LAS unsigned char*)lds, g, S, ER); }
#endif
#if MK_P2PROBE == 2
        { pg8::EpiNull EN; pg8::gemm_phase<pg8::EpiNull, pg8::Sched1, true, true, 0>((PG8_LAS unsigned char*)lds, g, S, EN); }
#endif
        if (BOTH(2)) GRID_BAR();
    }
    STAMP(3);
#if MK_NAIVE_ATTN
    if (IN(3)) {
        constexpr size_t IQ = (size_t)MLAT * 1024 / 512, IK = (size_t)NB * LT * 256 / 512;
        for (size_t it = gw; it < IQ + IK; it += NGW) {
            if (it < IQ) p3_item(AQ, 10, false, q_norm_w, ROPE, it, lane); else p3_item(AK, 8, true, k_norm_w, ROPE, it - IQ, lane);
        }
        if (BOTH(3)) GRID_BAR();
    }
#endif
#if MK_DEBUG_ATTN
    {
        bf16_t* AQ2 = (bf16_t*)(ws + WS_RK); float* acc2 = (float*)(ws + WS_CTL) + 64;
        for (size_t i = (size_t)bid * NTHR + tid; i < (size_t)MLAT * 1024 / 8; i += (size_t)G * NTHR) ((v4u*)AQ2)[i] = ((const v4u*)AQ)[i];
        { int tl = threadIdx.x; asm volatile("" : "+v"(tl)); const int lane_l = tl & 63, gw_l = bid * NWAVES + (tl >> 6);
          constexpr size_t IK = (size_t)NB * LT * 256 / 512; for (size_t it = gw_l; it < IK; it += NGW) p3_item(AK, 8, true, k_norm_w, ROPE, it, lane_l); }
        GRID_BAR();
        { int tl = threadIdx.x; asm volatile("" : "+v"(tl)); const int lane_l = tl & 63, gw_l = bid * NWAVES + (tl >> 6);
          constexpr size_t IQ = (size_t)MLAT * 1024 / 512; for (size_t it = gw_l; it < IQ; it += NGW) p3_item(AQ2, 10, false, q_norm_w, ROPE, it, lane_l); }
        GRID_BAR();
        { const int vcu = (bid & 7) * (G >> 3) + (bid >> 3);
          for (int idx = vcu; idx < NB * AH * 8; idx += G) { const int qb = idx & 7, r = (idx >> 3) & 3, g = (idx >> 5) & 1, b = idx >> 6, head = g * 4 + r;
            bf16_t* Q = AQ + ((size_t)(b * SEQ + qb * 256)) * 1024 + head * 128; const bf16_t* K = AK + (size_t)(b * LT) * 256 + g * 128; const bf16_t* V = AV + (size_t)(b * LT) * 256 + g * 128;
            attn::attn_dense_body<attn::bf16>(Q, K, V, Q, LT, (char*)lds, q_norm_w, ROPE, qb * 256); } }
        __syncthreads();
        { const int vcu = (bid & 7) * (G >> 3) + (bid >> 3);
          for (int idx = vcu; idx < NB * AH * 8; idx += G) { const int qb = idx & 7, r = (idx >> 3) & 3, g = (idx >> 5) & 1, b = idx >> 6, head = g * 4 + r;
            bf16_t* Q = AQ2 + ((size_t)(b * SEQ + qb * 256)) * 1024 + head * 128; const bf16_t* K = AK + (size_t)(b * LT) * 256 + g * 128; const bf16_t* V = AV + (size_t)(b * LT) * 256 + g * 128;
            attn::attn_dense_body<attn::bf16>(Q, K, V, Q, LT, (char*)lds, nullptr, ROPE, qb * 256); } }
        GRID_BAR();
        float sd = 0.f, sb = 0.f;
        for (size_t i = (size_t)bid * NTHR + tid; i < (size_t)MLAT * 1024; i += (size_t)G * NTHR) { const float a = bf2f(AQ[i]), b2 = bf2f(AQ2[i]); sd += (a - b2) * (a - b2); sb += b2 * b2; }
        sd = wave_sum(sd); sb = wave_sum(sb);
        if (lane == 0) { atomicAdd(acc2, sd); atomicAdd(acc2 + 1, sb); }
        GRID_BAR();
        if (bid == 0 && tid == 0) { const float s0 = __hip_atomic_load(acc2, __ATOMIC_RELAXED, __HIP_MEMORY_SCOPE_AGENT), s1 = __hip_atomic_load(acc2 + 1, __ATOMIC_RELAXED, __HIP_MEMORY_SCOPE_AGENT);
            args.out[0] = 1e6f * sqrtf(s0 / s1); args.out[1] = 1e3f * sqrtf(s1 / ((float)MLAT * 1024.f)); }
        return;
    }
#endif
    STAMP(4);
#if MK_DEBUG_RET
    {
        bf16_t* YR2 = (bf16_t*)(ws + WS_AQ); float* acc2 = (float*)(ws + WS_CTL) + 64;
        for (int it = bid; it < 8 * RH * 256; it += G) p4_naive_item(RQ, RK, RV, YR, SSQ, l2d, ldsf, it, tid);
        __syncthreads();
        { GridBarF gb{bar}; ret::scan_unit(RQ, RK, RV, YR2, SSQ + 2 * MLAT * 8, l2d, (LAS unsigned char*)lds, bid, gb, 8); }
        GRID_BAR();
        float sd = 0.f, sb = 0.f;
        for (size_t i = (size_t)bid * NTHR + tid; i < (size_t)8 * SEQ * 2048; i += (size_t)G * NTHR) { const int l = (int)((i >> 11) & 2047); if (l < MK_DBG_L0 || l >= MK_DBG_L1 || (int)((i >> 9) & 3) != MK_DBG_H) continue; const float a = bf2f(YR2[i]), b2 = bf2f(YR[i]); sd += (a - b2) * (a - b2); sb += b2 * b2; }
        sd = wave_sum(sd); sb = wave_sum(sb);
        if (lane == 0) { atomicAdd(acc2, sd); atomicAdd(acc2 + 1, sb); }
        GRID_BAR();
        if (bid == 0 && tid == 0) { const float s0 = __hip_atomic_load(acc2, __ATOMIC_RELAXED, __HIP_MEMORY_SCOPE_AGENT), s1 = __hip_atomic_load(acc2 + 1, __ATOMIC_RELAXED, __HIP_MEMORY_SCOPE_AGENT);
            ((float*)(ws + WS_SSQ))[0] = 1e6f * sqrtf(s0 / s1); ((float*)(ws + WS_SSQ))[1] = 1e3f * sqrtf(s1 / (8.f * SEQ * 2048.f)); }
        GRID_BAR();
        if (bid == 0 && tid == 0) { args.out[0] = ((float*)(ws + WS_SSQ))[0]; args.out[1] = ((float*)(ws + WS_SSQ))[1]; }
        return;
    }
#endif
    if (IN(4)) {
        auto kfix = [&]() {
#if !MK_NAIVE_ATTN
          int tl = threadIdx.x; asm volatile("" : "+v"(tl)); const int lane_l = tl & 63, gw_l = bid * NWAVES + (tl >> 6);
          constexpr size_t IK = (size_t)NB * LT * 256 / 512; const size_t ipw = (IK + NGW - 1) / NGW, i0 = (size_t)gw_l * ipw, i1 = i0 + ipw < IK ? i0 + ipw : IK;
          for (size_t it = i0; it < i1; it += 3) p3_items_k<3>(AK, k_norm_w, ROPE, it, i1, lane_l, ws + WS_K8);
#if MK_FP8V
          { const int wv = __builtin_amdgcn_readfirstlane(tl >> 6); constexpr int NI = NB * 2 * 36 * 4; LAS unsigned char* scr = (LAS unsigned char*)lds + wv * (64 * 80);
            v4u va[4], vb[4]; int it = gw_l; if (it < NI) vt8_load(AV, it, lane_l, va);
            for (; it < NI; it += 2 * NGW) { const int i2 = it + NGW; if (i2 < NI) vt8_load(AV, i2, lane_l, vb); vt8_proc(ws + WS_VT8, scr, it, lane_l, va);
                if (i2 < NI) { const int i3 = i2 + NGW; if (i3 < NI) vt8_load(AV, i3, lane_l, va); vt8_proc(ws + WS_VT8, scr, i2, lane_l, vb); } } }
#endif
#endif
        };
#if MK_NAIVE_RET
        kfix(); for (int it = bid; it < NB * RH * 256; it += G) p4_naive_item(RQ, RK, RV, YR, SSQ, l2d, ldsf, it, tid);
#else
        if (G == 256) { GridBarF gb{bar}; ret::scan_unit(RQ, RK, RV, YR, SSQ, l2d, (LAS unsigned char*)lds, bid, gb, NB, kfix); if (MK_MIX && BOTH(4)) GRID_BAR(); }
        else { kfix(); for (int it = bid; it < NB * RH * 256; it += G) p4_naive_item(RQ, RK, RV, YR, SSQ, l2d, ldsf, it, tid); if (BOTH(4)) GRID_BAR(); }
#endif
    }
    STAMP(5);
    if (IN(5)) {
#if MK_NAIVE_ATTN
        for (int it = bid; it < NB * AH * 256; it += G) p5_naive_item(AQ, AK, AV, ldsf, it, tid);
#else
        const int vcu = (G % 8 == 0) ? (bid & 7) * (G >> 3) + (bid >> 3) : bid;
#define ATT_UNIT(idx_, Q_, K_, V_, qb_) const int qb_ = (idx_) & 7; bf16_t* Q_; const bf16_t *K_, *V_; \
            { const int r_ = ((idx_) >> 3) & 3, g_ = ((idx_) >> 5) & 1, b_ = (idx_) >> 6, head_ = g_ * 4 + r_; \
              Q_ = MK_AG8 ? (bf16_t*)(ws + WS_Q8 + ((size_t)(b_ * SEQ + qb_ * 256)) * 1024 + head_ * 128) : AQ + ((size_t)(b_ * SEQ + qb_ * 256)) * 1024 + head_ * 128;     \
              K_ = MK_FP8K ? (const bf16_t*)(ws + WS_K8 + ((size_t)(b_ * LT) * 256 + g_ * 128)) : AK + (size_t)(b_ * LT) * 256 + g_ * 128; V_ = MK_FP8V ? (const bf16_t*)(ws + WS_VT8 + (size_t)((b_ * 2 + g_) * 36) * 8192) : AV + (size_t)(b_ * LT) * 256 + g_ * 128; }
        auto run_attn = [&](const int nkeys, const bool store) {
        attn::Pre pre;
        if (vcu < NB * AH * 8) { ATT_UNIT(vcu, Q0, K0, V0, qb0); attn::attn_prefetch(Q0, K0, V0, pre); }
        for (int idx = vcu; idx < NB * AH * 8; idx += G) {
            ATT_UNIT(idx, Q, K, V, qb);
            const int nidx = idx + G; const bool hn = nidx < NB * AH * 8; ATT_UNIT(hn ? nidx : idx, Qn, Kn, Vn, qbn);
            attn::attn_dense_body<attn::bf16>(Q, K, V, store ? Q : (bf16_t*)nullptr, nkeys, (char*)lds, q_norm_w, ROPE, qb * 256, pre, Qn, Kn, Vn); __syncthreads();
        } };
#if MK_MIX
        auto run_gates = [&](int mode) { pg8::Gemm g{HX, WIN + (size_t)N1 * 1024, MLAT, NG, 1024}; pg8::SchedGates S; S.init(G, bid, mode); pg8::Epi5 E{YR, AQ, U1, U2, SSQ, 0, ws + WS_YA8};
            pg8::gemm_phase<pg8::Epi5, pg8::SchedGates, true, true, MK_EPIW>((PG8_LAS unsigned char*)lds, g, S, E); };
        const bool attn_first = (bid & 4) == 0;
        if (attn_first) { run_attn(LT, true); __syncthreads(); run_gates(0); } else { run_gates(0); __syncthreads(); run_attn(LT, true); }
        __syncthreads(); GRID_BAR(); run_gates(1);
#else
        for (int rep = 0; rep < (MK_ATTN_PROBE > 0 ? 2 : 1); ++rep) run_attn(rep ? MK_ATTN_PROBE : LT, rep == 0);
#endif
#undef ATT_UNIT
#endif
#if !MK_NAIVE_RET
        if (G != 256) { int tl = threadIdx.x; asm volatile("" : "+v"(tl)); const int lane_l = tl & 63, gw_l = bid * NWAVES + (tl >> 6);
          for (int it = gw_l; it < MLAT * 4; it += NGW) ssq_item(YR, SSQ, it, lane_l); }
#endif
        if (BOTH(5)) GRID_BAR();
    }
    STAMP(6);
    if (IN(6) && !MK_MIX) {
        STAGGER();
        pg8::Gemm g{HX, WIN + (size_t)N1 * 1024, MLAT, NG, 1024};
        pg8::Epi5 E{YR, AQ, U1, U2, SSQ, 0, ws + WS_YA8};
#if MK_AG8
        { pg8::SchedGates S; S.init(G, bid, 0); pg8::gemm_phase<pg8::Epi5, pg8::SchedGates, true, true, MK_EPIW>((PG8_LAS unsigned char*)lds, g, S, E); }
#else
        { pg8::StaticOrder S; S.init(MLAT, NG, G, bid); pg8::gemm_phase<pg8::Epi5, pg8::StaticOrder, true, true, MK_EPIW>((PG8_LAS unsigned char*)lds, g, S, E); }
#endif
        if (BOTH(6)) GRID_BAR();
    }
    STAMP(7);
    if (IN(7)) {
        pg8::Gemm g{YR, WOR, MLAT, 1024, 2048}; pg8::StaticOrder S; S.init(MLAT, 1024, G, bid);
        pg8::Epi6 E{U1};
        pg8::gemm_phase<pg8::Epi6, pg8::StaticOrder, true, true, MK_EPIW>((PG8_LAS unsigned char*)lds, g, S, E);
    }
    STAMP(8);
    if (IN(8)) {
        pg8::StaticOrder S; S.init(MLAT, 1024, G, bid);
        pg8::Epi7 E{U1, U2};
#if MK_FP8G
        { pg8::Gemm g{(const bf16_t*)(ws + (MK_AG8 ? WS_Q8 : WS_YA8)), (const bf16_t*)(ws + WS_WOA8), MLAT, 1024, 512, F8Y_SC, F8W_SC};
          pg8::gemm_phase<pg8::Epi7, pg8::StaticOrder, true, true, MK_EPIW, true>((PG8_LAS unsigned char*)lds, g, S, E); }
#else
        { pg8::Gemm g{AQ, WOA, MLAT, 1024, 1024};
          pg8::gemm_phase<pg8::Epi7, pg8::StaticOrder, true, true, MK_EPIW>((PG8_LAS unsigned char*)lds, g, S, E); }
#endif
        if (BOTH(8)) GRID_BAR();
    }
    STAMP(9);
    if (IN(9)) {
        pg8::Gemm g{U1, WOUT, MLAT, 1024, 1024}; pg8::StaticOrder S; S.init(MLAT, 1024, G, bid);
        pg8::Epi8 E{x, MOD, args.out};
        { pg8::RepOrder SR; SR.so = S; SR.reps = MK_REP_P9; pg8::gemm_phase<pg8::Epi8, pg8::RepOrder, true, true, MK_EPIW>((PG8_LAS unsigned char*)lds, g, SR, E); }
    }
    STAMP(10);
#if MK_TIMING
    if (bid == 0) { const unsigned spin = __builtin_amdgcn_readfirstlane(((const unsigned*)SSQ - 64)[MK_TSEL]); const unsigned long long t0_ = __builtin_amdgcn_s_memrealtime();
        while (__builtin_amdgcn_s_memrealtime() - t0_ < (unsigned long long)spin) __builtin_amdgcn_s_sleep(8); }
#endif
#if MK_STAMP_A >= 0
    __syncthreads();
    if (bid == 0) { __syncthreads(); const unsigned sp = ((volatile LAS unsigned*)(lds + MISC_OFF))[18] - ((volatile LAS unsigned*)(lds + MISC_OFF))[17]; const unsigned long long t0_ = __builtin_amdgcn_s_memrealtime();
        while (__builtin_amdgcn_s_memrealtime() - t0_ < (unsigned long long)sp) __builtin_amdgcn_s_sleep(8); }
#endif
#undef IN
#undef BOTH
}

extern "C" void kernel_launch(void* const* d_in, const int* in_sizes, int n_in, void* d_out, int out_size, void* d_ws, size_t ws_size, hipStream_t stream) {
    static int grid = 0;
    if (grid == 0) {
        if (n_in != 14 || in_sizes[0] != MLAT * DM || out_size != MLAT * DM || ws_size < WS_END) {
            fprintf(stderr, "kernel_launch: unexpected shapes: n_in %d in0 %d out %d ws %zu (need >= %zu)\n", n_in, n_in > 0 ? in_sizes[0] : -1, out_size, ws_size, (size_t)WS_END); grid = -1; return; }
        int dev = 0, cus = 0;
        if (hipGetDevice(&dev) != hipSuccess || hipDeviceGetAttribute(&cus, hipDeviceAttributeMultiprocessorCount, dev) != hipSuccess) { grid = -1; return; }
        if (hipFuncSetAttribute((const void*)mk_fwd, hipFuncAttributeMaxDynamicSharedMemorySize, LDS_BYTES) != hipSuccess) { fprintf(stderr, "kernel_launch: hipFuncSetAttribute failed\n"); grid = -1; return; }
        grid = cus;
    }
    if (grid < 0) return;
    Args a{};
    for (int i = 0; i < 14; ++i) a.in[i] = (const float*)d_in[i];
    a.out = (float*)d_out; a.ws = (unsigned char*)d_ws;
#if MK_ONE_LAUNCH
    a.ph_lo = 0; a.ph_hi = N_PHASES;
#if MK_BARRIER == 1
    if (hipMemsetAsync((char*)d_ws + WS_CTL, 0, CTL_ZERO_BYTES, stream) != hipSuccess) { fprintf(stderr, "kernel_launch: hipMemsetAsync failed\n"); return; }
    hipLaunchKernelGGL(mk_fwd, dim3(grid), dim3(NTHR), LDS_BYTES, stream, a);
#else
    void* kargs[] = {&a};
    const hipError_t ce = hipLaunchCooperativeKernel((const void*)mk_fwd, dim3(grid), dim3(NTHR), kargs, LDS_BYTES, stream);
    if (ce != hipSuccess) fprintf(stderr, "kernel_launch: cooperative launch failed: %s\n", hipGetErrorName(ce));
#endif
#else
    for (int ph = 0; ph < N_PHASES; ++ph) {
        a.ph_lo = ph; a.ph_hi = ph + 1;
        hipLaunchKernelGGL(mk_fwd, dim3(grid), dim3(NTHR), LDS_BYTES, stream, a);
    }
#endif
    const hipError_t le = hipPeekAtLastError();
    if (le != hipSuccess) fprintf(stderr, "kernel_launch: launch failed: %s\n", hipGetErrorName(le));
}
```
